# Optimizing an MI355X kernel written in HIP

```python
import math
import jax, jax.numpy as jnp
from jax import lax
import numpy as np

D_MODEL = 2048
BATCH = 4
SEQ = 2048
DEPTH = 1
DEC_BATCH = 8
DEC_SEQ = 1
PAST_LEN = 16384
PAGE_SIZE = 128

NSA_HEADS = 16
NSA_KV_HEADS = 4
NSA_HPG = NSA_HEADS // NSA_KV_HEADS
NSA_HEAD_DIM = 64
NSA_Q = NSA_HEADS * NSA_HEAD_DIM
NSA_KV = NSA_KV_HEADS * NSA_HEAD_DIM
CMP_STRIDE = 16
CMP_BLOCK = 32
CMP_HIDDEN = 128
SLC_BLOCK = 64
N_SELECT = 16
WINDOW = 512
NSA_Q_BLOCK = 64
GLA_HEADS = 4
GLA_DK = (D_MODEL // 4) // GLA_HEADS
GLA_DV = (D_MODEL // 2) // GLA_HEADS
GLA_RANK = 16
GLA_TAU = 16.0
GLA_CHUNK = 16
D_FF = 4 * D_MODEL
EPS = 1e-6
NEG = -1e30
FORCE = 1e4
SPLITS = (NSA_Q, 6 * NSA_KV, 3 * NSA_HEADS,
          GLA_HEADS * GLA_DK, GLA_HEADS * GLA_DK, GLA_HEADS * GLA_DV, GLA_HEADS * GLA_DV,
          GLA_RANK, 2 * D_MODEL)
D_IN = sum(SPLITS)

kernel_name = 'nsa_gla_hybrid_decode_step'


def rmsnorm(x, g):
    xf = x.astype(jnp.float32)
    y = xf * lax.rsqrt(jnp.mean(xf * xf, axis=-1, keepdims=True) + EPS)
    return (y * g.astype(jnp.float32)).astype(x.dtype)


def softmax_masked(s, mask):
    p = jax.nn.softmax(jnp.where(mask, s, NEG), axis=-1)
    return jnp.where(mask, p, 0.0)


def compress(k, pe, w1, w2):
    B, L, G, dh = k.shape
    m = CMP_BLOCK // CMP_STRIDE
    n_chunk = L // CMP_STRIDE
    n_cmp = n_chunk - m + 1
    ch = k[:, :n_chunk * CMP_STRIDE].reshape(B, n_chunk, CMP_STRIDE, G, dh)
    blk = jnp.concatenate([ch[:, j:j + n_cmp] for j in range(m)], axis=2)
    blk = blk + pe[None, None, :, None, :].astype(k.dtype)
    blk = blk.transpose(0, 1, 3, 2, 4).reshape(B, n_cmp, G, CMP_BLOCK * dh)
    return jax.nn.gelu(blk @ w1) @ w2


def slc_importance(p_cmp, n_slc):
    r = SLC_BLOCK // CMP_STRIDE
    m = CMP_BLOCK // CMP_STRIDE
    n_cmp = p_cmp.shape[-1]
    pad = [(0, 0)] * (p_cmp.ndim - 1) + [(m - 1, n_slc * r + r - n_cmp)]
    pp = jnp.pad(p_cmp, pad)
    return sum(pp[..., o:o + n_slc * r:r] for o in range(r + m - 1))


def nsa_attend(q, gates, kc, vc, ks, vs, kw, vw, start, w):
    B, T, G, HPG, dh = q.shape
    L = kc.shape[1]
    scale = dh ** -0.5
    kcmp = compress(kc, w['cmp_pe_k'], w['cmp_k_w1'], w['cmp_k_w2'])
    vcmp = compress(vc, w['cmp_pe_v'], w['cmp_v_w1'], w['cmp_v_w2'])
    n_cmp = kcmp.shape[1]
    cmp_end = jnp.arange(n_cmp) * CMP_STRIDE + CMP_BLOCK - 1
    n_slc = -(-L // SLC_BLOCK)
    n_sel = min(N_SELECT, n_slc)
    pad_l = n_slc * SLC_BLOCK - L

    def blocks(a):
        a = jnp.pad(a, ((0, 0), (0, pad_l), (0, 0), (0, 0)))
        return a.reshape(B, n_slc, SLC_BLOCK, G, dh).transpose(0, 3, 1, 2, 4)

    ks_b, vs_b = blocks(ks), blocks(vs)
    qb = min(NSA_Q_BLOCK, T)
    n_qb = -(-T // qb)
    Tp = n_qb * qb
    qpad = ((0, 0), (0, Tp - T), (0, 0), (0, 0), (0, 0))
    q = jnp.pad(q, qpad)
    gates = jnp.pad(gates, qpad)
    kvpad = ((0, 0), (0, Tp - T), (0, 0), (0, 0))
    kw = jnp.pad(kw, kvpad)
    vw = jnp.pad(vw, kvpad)
    b_ix = jnp.arange(B)[:, None, None, None]
    g_ix = jnp.arange(G)[None, None, :, None]
    slc_ids = jnp.arange(n_slc)
    f32 = jnp.float32

    def body(i):
        q_b = lax.dynamic_slice_in_dim(q, i * qb, qb, axis=1)
        g_b = lax.dynamic_slice_in_dim(gates, i * qb, qb, axis=1)
        pos = start + i * qb + jnp.arange(qb)
        s_c = jnp.einsum('bqghd,bngd->bqghn', q_b, kcmp, preferred_element_type=f32) * scale
        m_c = (cmp_end[None, :] <= pos[:, None])[None, :, None, None, :]
        p_c = softmax_masked(s_c, m_c)
        o_c = jnp.einsum('bqghn,bngd->bqghd', p_c.astype(vcmp.dtype), vcmp)
        imp = slc_importance(p_c.sum(axis=3), n_slc)
        valid = (slc_ids[None, :] * SLC_BLOCK <= pos[:, None])
        forced = (slc_ids[None, :] == 0) | (slc_ids[None, :] == pos[:, None] // SLC_BLOCK)
        score = jnp.where(valid[None, :, None, :],
                          imp + jnp.where(forced, FORCE, 0.0)[None, :, None, :], NEG)
        _, idx = lax.top_k(score, n_sel)
        k_sel = ks_b[b_ix, g_ix, idx]
        v_sel = vs_b[b_ix, g_ix, idx]
        kpos = idx[..., None] * SLC_BLOCK + jnp.arange(SLC_BLOCK)
        m_s = (kpos <= pos[None, :, None, None, None])[:, :, :, None]
        s_s = jnp.einsum('bqghd,bqgnkd->bqghnk', q_b, k_sel, preferred_element_type=f32) * scale
        p_s = softmax_masked(s_s.reshape(B, qb, G, HPG, n_sel * SLC_BLOCK),
                             m_s.reshape(B, qb, G, 1, n_sel * SLC_BLOCK)).reshape(s_s.shape)
        o_s = jnp.einsum('bqghnk,bqgnkd->bqghd', p_s.astype(v_sel.dtype), v_sel)
        k_w = lax.dynamic_slice_in_dim(kw, i * qb, WINDOW + qb, axis=1)
        v_w = lax.dynamic_slice_in_dim(vw, i * qb, WINDOW + qb, axis=1)
        wpos = start - WINDOW + i * qb + jnp.arange(WINDOW + qb)
        m_w = ((wpos[None, :] <= pos[:, None]) & (wpos[None, :] >= pos[:, None] - WINDOW)
               & (wpos[None, :] >= 0))[None, :, None, None, :]
        s_w = jnp.einsum('bqghd,bkgd->bqghk', q_b, k_w, preferred_element_type=f32) * scale
        p_w = softmax_masked(s_w, m_w)
        o_w = jnp.einsum('bqghk,bkgd->bqghd', p_w.astype(v_w.dtype), v_w)
        return g_b[..., 0:1] * o_c + g_b[..., 1:2] * o_s + g_b[..., 2:3] * o_w

    out = lax.map(body, jnp.arange(n_qb))
    return out.transpose(1, 0, 2, 3, 4, 5).reshape(B, Tp, G, HPG, dh)[:, :T]


def gla_chunked(q, k, v, g, s0):
    B, T, H, dk = q.shape
    C = min(GLA_CHUNK, T)
    n = -(-T // C)
    Tp = n * C

    def chunks(a):
        a = jnp.pad(a, ((0, 0), (0, Tp - T), (0, 0), (0, 0)))
        return a.reshape(B, n, C, H, a.shape[-1]).transpose(1, 0, 3, 2, 4)

    qc, kc, vc, gc = chunks(q), chunks(k), chunks(v), chunks(g)
    causal = jnp.tril(jnp.ones((C, C), dtype=bool))

    def step(S, inp):
        qi, ki, vi, gi = inp
        b = jnp.cumsum(gi, axis=2)
        b_last = b[:, :, -1:, :]
        q_t = qi * jnp.exp(b)
        k_t = ki * jnp.exp(-b)
        a = jnp.where(causal, jnp.einsum('bhcd,bhsd->bhcs', q_t, k_t), 0.0)
        o = jnp.einsum('bhcd,bhde->bhce', q_t, S) + jnp.einsum('bhcs,bhse->bhce', a, vi)
        S = (jnp.exp(b_last)[:, :, 0, :, None] * S
             + jnp.einsum('bhcd,bhce->bhde', ki * jnp.exp(b_last - b), vi))
        return S, o

    S, o = lax.scan(step, s0, (qc, kc, vc, gc))
    o = o.transpose(1, 0, 3, 2, 4).reshape(B, Tp, H, v.shape[-1])[:, :T]
    return o, S


def layer(x, past, win, s0, w):
    B, T, _ = x.shape
    G, HPG, dh = NSA_KV_HEADS, NSA_HPG, NSA_HEAD_DIM
    f32 = jnp.float32
    start = past[0].shape[1]
    h = rmsnorm(x, w['norm1_g'])
    proj = h @ w['w_in']
    pts = np.cumsum(SPLITS)[:-1].tolist()
    q_n, kv_n, g_n, q_l, k_l, v_l, r_l, lr_l, br = jnp.split(proj, pts, axis=-1)
    kv = kv_n.reshape(B, T, 6, G, dh)
    rows = [kv[:, :, j] for j in range(6)]
    full = [jnp.concatenate([p.astype(x.dtype), r], axis=1) for p, r in zip(past, rows[:4])]
    wext = [jnp.concatenate([jnp.zeros((B, WINDOW - b.shape[1], G, dh), x.dtype), b.astype(x.dtype), r], axis=1)
            for b, r in zip(win, rows[4:])]
    n_keep = min(WINDOW, win[0].shape[1] + T)
    new_win = [a[:, a.shape[1] - n_keep:] for a in wext]
    q = q_n.reshape(B, T, G, HPG, dh)
    gates = jax.nn.sigmoid(g_n + w['b_nsa_gate']).reshape(B, T, G, HPG, 3)
    o_a = nsa_attend(q, gates, full[0], full[1], full[2], full[3], wext[0], wext[1], start, w)
    o_a = o_a.reshape(B, T, NSA_Q)
    gq = q_l.reshape(B, T, GLA_HEADS, GLA_DK).astype(f32) * (GLA_DK ** -0.5)
    gk = k_l.reshape(B, T, GLA_HEADS, GLA_DK).astype(f32)
    gv = v_l.reshape(B, T, GLA_HEADS, GLA_DV).astype(f32)
    log_a = jax.nn.log_sigmoid((lr_l @ w['gla_w_a2'] + w['gla_b_a']).astype(f32)) / GLA_TAU
    log_a = log_a.reshape(B, T, GLA_HEADS, GLA_DK)
    o_g, s_new = gla_chunked(gq, gk, gv, log_a, s0.astype(f32))
    o_g = rmsnorm(o_g, w['gla_norm_g']) * jax.nn.silu(r_l.reshape(B, T, GLA_HEADS, GLA_DV).astype(f32))
    o_b = o_g.reshape(B, T, GLA_HEADS * GLA_DV).astype(x.dtype)
    ga, gb = jnp.split(br, 2, axis=-1)
    mix = (jax.nn.sigmoid(ga) * (o_a @ w['w_br_a']) + jax.nn.sigmoid(gb) * (o_b @ w['w_br_b'])) @ w['w_o']
    x = x + mix
    hf = jax.nn.relu(rmsnorm(x, w['norm2_g']) @ w['w_up'])
    x = x + (hf * hf) @ w['w_down']
    return x, rows[:4], new_win, s_new


def setup_inputs(seed: int = 0) -> dict:
    key = jax.random.key(seed)
    keys = iter(jax.random.split(key, 48))

    def nrm(shape, scale):
        return jax.random.normal(next(keys), shape, jnp.float32) * scale

    n_pages = PAST_LEN // PAGE_SIZE
    n_pool = (DEC_BATCH * n_pages * 5) // 4
    win_buf = min(WINDOW, PAST_LEN)
    kv_shape = (DEPTH, n_pool, PAGE_SIZE, NSA_KV_HEADS, NSA_HEAD_DIM)
    win_shape = (DEPTH, DEC_BATCH, win_buf, NSA_KV_HEADS, NSA_HEAD_DIM)
    x_prompt = nrm((BATCH, SEQ, D_MODEL), 1.0)
    x_sample = nrm((DEC_BATCH, DEC_SEQ, D_MODEL), 1.0)
    cache_cmp_k = nrm(kv_shape, 1.0)
    cache_cmp_v = nrm(kv_shape, 1.0)
    cache_slc_k = nrm(kv_shape, 1.0)
    cache_slc_v = nrm(kv_shape, 1.0)
    cache_win_k = nrm(win_shape, 1.0)
    cache_win_v = nrm(win_shape, 1.0)
    state_gla = nrm((DEPTH, DEC_BATCH, GLA_HEADS, GLA_DK, GLA_DV), 1.0)
    page_table = jax.random.permutation(next(keys), n_pool)[:DEC_BATCH * n_pages]
    page_table = page_table.reshape(DEC_BATCH, n_pages).astype(jnp.int32)
    return {
        'x_prompt': x_prompt,
        'x_sample': x_sample,
        'cache_cmp_k': cache_cmp_k,
        'cache_cmp_v': cache_cmp_v,
        'cache_slc_k': cache_slc_k,
        'cache_slc_v': cache_slc_v,
        'cache_win_k': cache_win_k,
        'cache_win_v': cache_win_v,
        'state_gla': state_gla,
        'page_table': page_table,
        'norm1_g': 1.0 + nrm((DEPTH, D_MODEL), 0.05),
        'w_in': nrm((DEPTH, D_MODEL, D_IN), D_MODEL ** -0.5),
        'b_nsa_gate': nrm((DEPTH, 3 * NSA_HEADS), 0.01),
        'cmp_pe_k': nrm((DEPTH, CMP_BLOCK, NSA_HEAD_DIM), 0.1),
        'cmp_pe_v': nrm((DEPTH, CMP_BLOCK, NSA_HEAD_DIM), 0.1),
        'cmp_k_w1': nrm((DEPTH, CMP_BLOCK * NSA_HEAD_DIM, CMP_HIDDEN), (CMP_BLOCK * NSA_HEAD_DIM) ** -0.5),
        'cmp_k_w2': nrm((DEPTH, CMP_HIDDEN, NSA_HEAD_DIM), CMP_HIDDEN ** -0.5),
        'cmp_v_w1': nrm((DEPTH, CMP_BLOCK * NSA_HEAD_DIM, CMP_HIDDEN), (CMP_BLOCK * NSA_HEAD_DIM) ** -0.5),
        'cmp_v_w2': nrm((DEPTH, CMP_HIDDEN, NSA_HEAD_DIM), CMP_HIDDEN ** -0.5),
        'gla_w_a2': nrm((DEPTH, GLA_RANK, GLA_HEADS * GLA_DK), GLA_RANK ** -0.5),
        'gla_b_a': nrm((DEPTH, GLA_HEADS * GLA_DK), 0.1),
        'gla_norm_g': 1.0 + nrm((DEPTH, GLA_DV), 0.05),
        'w_br_a': nrm((DEPTH, NSA_Q, D_MODEL), NSA_Q ** -0.5),
        'w_br_b': nrm((DEPTH, GLA_HEADS * GLA_DV, D_MODEL), (GLA_HEADS * GLA_DV) ** -0.5),
        'w_o': nrm((DEPTH, D_MODEL, D_MODEL), D_MODEL ** -0.5),
        'norm2_g': 1.0 + nrm((DEPTH, D_MODEL), 0.05),
        'w_up': nrm((DEPTH, D_MODEL, D_FF), D_MODEL ** -0.5),
        'w_down': nrm((DEPTH, D_FF, D_MODEL), D_FF ** -0.5),
        'norm_f': 1.0 + nrm((D_MODEL,), 0.05),
    }


def reference(x_prompt, x_sample, cache_cmp_k, cache_cmp_v, cache_slc_k, cache_slc_v, cache_win_k,
              cache_win_v, state_gla, page_table, norm1_g, w_in, b_nsa_gate, cmp_pe_k, cmp_pe_v,
              cmp_k_w1, cmp_k_w2, cmp_v_w1, cmp_v_w2, gla_w_a2, gla_b_a, gla_norm_g, w_br_a, w_br_b,
              w_o, norm2_g, w_up, w_down, norm_f):
    G, dh = NSA_KV_HEADS, NSA_HEAD_DIM
    xp, xs = x_prompt, x_sample
    bp, db = xp.shape[0], xs.shape[0]
    outs_p = [[] for _ in range(7)]
    outs_s = [[] for _ in range(7)]
    for l in range(DEPTH):
        w = dict(norm1_g=norm1_g[l], w_in=w_in[l], b_nsa_gate=b_nsa_gate[l], cmp_pe_k=cmp_pe_k[l],
                 cmp_pe_v=cmp_pe_v[l], cmp_k_w1=cmp_k_w1[l], cmp_k_w2=cmp_k_w2[l], cmp_v_w1=cmp_v_w1[l],
                 cmp_v_w2=cmp_v_w2[l], gla_w_a2=gla_w_a2[l], gla_b_a=gla_b_a[l], gla_norm_g=gla_norm_g[l],
                 w_br_a=w_br_a[l], w_br_b=w_br_b[l], w_o=w_o[l], norm2_g=norm2_g[l], w_up=w_up[l],
                 w_down=w_down[l])
        empty = jnp.zeros((bp, 0, G, dh), xp.dtype)
        s0_p = jnp.zeros((bp, GLA_HEADS, GLA_DK, GLA_DV), jnp.float32)
        xp, rows_p, win_p, s_p = layer(xp, [empty, empty, empty, empty], [empty, empty], s0_p, w)
        past_s = [c[l][page_table].reshape(db, -1, G, dh)
                  for c in (cache_cmp_k, cache_cmp_v, cache_slc_k, cache_slc_v)]
        xs, rows_s, win_s, s_s = layer(xs, past_s, [cache_win_k[l], cache_win_v[l]], state_gla[l], w)
        for lst, a in zip(outs_p, rows_p + win_p + [s_p]):
            lst.append(a)
        for lst, a in zip(outs_s, rows_s + win_s + [s_s]):
            lst.append(a)
    y_prompt = rmsnorm(xp, norm_f)
    y_sample = rmsnorm(xs, norm_f)
    p_cmp_k, p_cmp_v, p_slc_k, p_slc_v, p_win_k, p_win_v, p_gla = [jnp.stack(a) for a in outs_p]
    s_cmp_k, s_cmp_v, s_slc_k, s_slc_v, s_win_k, s_win_v, s_gla = [jnp.stack(a) for a in outs_s]
    return (y_prompt, y_sample, p_cmp_k, p_cmp_v, p_slc_k, p_slc_v, p_win_k, p_win_v, p_gla,
            s_cmp_k, s_cmp_v, s_slc_k, s_slc_v, s_win_k, s_win_v, s_gla)
```

```cpp
#include <hip/hip_runtime.h>
#include <stdint.h>
#include <cstdio>

typedef unsigned short bf16_t;

constexpr int DM = 2048, NB = 4, SEQ = 2048, NPT = NB * SEQ, DB = 8, NTOK = NPT + DB;
constexpr int PAST = 16384, PAGE = 128, NPAGES = 128;
constexpr int NG = 4, HPG = 4, DH = 64;
constexpr int DIN = 9792, DFF = 8192;
constexpr int C_Q = 0, C_KV = 1024, C_G = 2560, C_QL = 2608, C_KL = 3120, C_VL = 3632, C_RL = 4656, C_LR = 5680, C_BR = 5696;
constexpr float EPS = 1e-6f;
constexpr size_t OFF_Y = 0, OFF_YS = (size_t)NPT * DM, OFF_PCK = OFF_YS + (size_t)DB * DM;
constexpr size_t SZ_PROW = (size_t)NPT * 256;
constexpr size_t OFF_PWK = OFF_PCK + 4 * SZ_PROW, SZ_PWIN = (size_t)NB * 512 * 256;
constexpr size_t OFF_PGLA = OFF_PWK + 2 * SZ_PWIN, SZ_PGLA = (size_t)NB * 4 * 128 * 256;
constexpr size_t OFF_SCK = OFF_PGLA + SZ_PGLA, SZ_SROW = (size_t)DB * 256;
constexpr size_t OFF_SWK = OFF_SCK + 4 * SZ_SROW, SZ_SWIN = (size_t)DB * 512 * 256;
constexpr size_t OFF_SGLA = OFF_SWK + 2 * SZ_SWIN, SZ_SGLA = (size_t)DB * 4 * 128 * 256;
constexpr size_t OUT_TOTAL = OFF_SGLA + SZ_SGLA;
static_assert(OUT_TOTAL == 29908992, "output size");

__device__ __forceinline__ bf16_t f2bf(float f) { unsigned u = __builtin_bit_cast(unsigned, f); return (bf16_t)((u + 0x7fffu + ((u >> 16) & 1u)) >> 16); }
__device__ __forceinline__ float bf2f(bf16_t h) { return __builtin_bit_cast(float, (unsigned)h << 16); }
__device__ __forceinline__ float sigmoidf_(float x) { return 1.f / (1.f + __expf(-x)); }
__device__ __forceinline__ float siluf_(float x) { return x / (1.f + __expf(-x)); }
__device__ __forceinline__ float gelu_tanh(float x) { const float u = 0.7978845608028654f * (x + 0.044715f * x * x * x); return 0.5f * x * (1.f + tanhf(u)); }
__device__ __forceinline__ float logsigmoidf_(float x) { return fminf(x, 0.f) - log1pf(__expf(-fabsf(x))); }
__device__ __forceinline__ float wave_sum(float v) {
#pragma unroll
    for (int o = 1; o < 64; o <<= 1) v += __shfl_xor(v, o);
    return v;
}
__device__ __forceinline__ float wave_max(float v) {
#pragma unroll
    for (int o = 1; o < 64; o <<= 1) v = fmaxf(v, __shfl_xor(v, o));
    return v;
}

struct Params {
    const float *x_prompt, *x_sample, *cck, *ccv, *csk, *csv, *cwk, *cwv, *state;
    const int* page_table;
    const float *norm1_g, *w_in, *b_gate, *pe_k, *pe_v, *w1k, *w2k, *w1v, *w2v, *w_a2, *b_a, *gnorm, *w_br_a, *w_br_b, *w_o, *norm2_g, *w_up, *w_down, *norm_f;
    float* out;
    bf16_t *XB, *QN, *KV6, *GQ, *GK, *GV, *GR, *BR, *KCMP_P, *VCMPT_P, *KCMP_S, *VCMP_S, *OA, *OB, *MB, *X1B, *HF;
    float *RSTD1, *GATE, *LR, *TMP, *X1, *RSTD2;
};

__device__ __forceinline__ float xval(const Params& p, int row, int n) { return row < NPT ? p.x_prompt[(size_t)row * DM + n] : p.x_sample[(size_t)(row - NPT) * DM + n]; }

__device__ __forceinline__ void proj_store(const Params& p, int row, int n, float v) {
    if (n < C_KV) p.QN[(size_t)row * 1024 + n] = f2bf(v * 0.125f);
    else if (n < C_G) {
        const int c = n - C_KV; p.KV6[(size_t)row * 1536 + c] = f2bf(v); const int j = c >> 8, cc = c & 255;
        if (row < NPT) { const int b = row >> 11, t = row & 2047;
            if (j < 4) p.out[OFF_PCK + j * SZ_PROW + (size_t)row * 256 + cc] = v;
            else if (t >= 1536) p.out[OFF_PWK + (j - 4) * SZ_PWIN + ((size_t)b * 512 + t - 1536) * 256 + cc] = v; }
        else { const int b = row - NPT;
            if (j < 4) p.out[OFF_SCK + j * SZ_SROW + (size_t)b * 256 + cc] = v;
            else p.out[OFF_SWK + (j - 4) * SZ_SWIN + ((size_t)b * 512 + 511) * 256 + cc] = v; }
    }
    else if (n < C_QL) { const int c = n - C_G; p.GATE[(size_t)row * 48 + c] = sigmoidf_(v + p.b_gate[c]); }
    else if (n < C_KL) p.GQ[(size_t)row * 512 + (n - C_QL)] = f2bf(v * 0.08838834764831845f);
    else if (n < C_VL) p.GK[(size_t)row * 512 + (n - C_KL)] = f2bf(v);
    else if (n < C_RL) p.GV[(size_t)row * 1024 + (n - C_VL)] = f2bf(v);
    else if (n < C_LR) p.GR[(size_t)row * 1024 + (n - C_RL)] = f2bf(siluf_(v));
    else if (n < C_BR) p.LR[(size_t)row * 16 + (n - C_LR)] = v;
    else p.BR[(size_t)row * 4096 + (n - C_BR)] = f2bf(sigmoidf_(v));
}

__global__ void __launch_bounds__(256) k_prep_x(Params p) {
    const int lane = threadIdx.x & 63, row = blockIdx.x * 4 + (threadIdx.x >> 6);
    if (row >= NTOK) return;
    const float* xr = row < NPT ? p.x_prompt + (size_t)row * DM : p.x_sample + (size_t)(row - NPT) * DM;
    float ss = 0.f;
    for (int i = lane; i < DM; i += 64) { const float v = xr[i]; ss += v * v; p.XB[(size_t)row * DM + i] = f2bf(v); }
    ss = wave_sum(ss);
    if (lane == 0) p.RSTD1[row] = rsqrtf(ss * (1.f / DM) + EPS);
}
__global__ void __launch_bounds__(256) k_copy_swin(Params p) {
    const size_t i = (size_t)blockIdx.x * 256 + threadIdx.x;
    if (i >= (size_t)DB * 511 * 256) return;
    const int c = (int)(i & 255); const int r = (int)((i >> 8) % 511); const int b = (int)((i >> 8) / 511);
    p.out[OFF_SWK + ((size_t)b * 512 + r) * 256 + c] = p.cwk[((size_t)b * 512 + r + 1) * 256 + c];
    p.out[OFF_SWK + SZ_SWIN + ((size_t)b * 512 + r) * 256 + c] = p.cwv[((size_t)b * 512 + r + 1) * 256 + c];
}
__global__ void __launch_bounds__(256) k_rms_rows(const float* X, float* rstd, int nrows) {
    const int lane = threadIdx.x & 63, row = blockIdx.x * 4 + (threadIdx.x >> 6);
    if (row >= nrows) return;
    float ss = 0.f;
    for (int i = lane; i < DM; i += 64) { const float v = X[(size_t)row * DM + i]; ss += v * v; }
    ss = wave_sum(ss);
    if (lane == 0) rstd[row] = rsqrtf(ss * (1.f / DM) + EPS);
}
__global__ void __launch_bounds__(256) k_final_norm(Params p) {
    const int lane = threadIdx.x & 63, row = blockIdx.x * 4 + (threadIdx.x >> 6);
    if (row >= NTOK) return;
    float* yr = row < NPT ? p.out + OFF_Y + (size_t)row * DM : p.out + OFF_YS + (size_t)(row - NPT) * DM;
    float ss = 0.f;
    for (int i = lane; i < DM; i += 64) { const float v = yr[i]; ss += v * v; }
    ss = wave_sum(ss);
    const float r = rsqrtf(ss * (1.f / DM) + EPS);
    for (int i = lane; i < DM; i += 64) yr[i] = yr[i] * r * p.norm_f[i];
}

template <class AF, class BF, class EF>
__global__ void __launch_bounds__(256) k_gemm_naive(int M, int N, int K, AF af, BF bf, EF ef) {
    __shared__ float As[16][68], Bs[16][68];
    const int tid = threadIdx.x, tx = tid & 15, ty = tid >> 4, m0 = blockIdx.y * 64, n0 = blockIdx.x * 64;
    float acc[4][4];
#pragma unroll
    for (int i = 0; i < 4; ++i)
#pragma unroll
        for (int j = 0; j < 4; ++j) acc[i][j] = 0.f;
    for (int k0 = 0; k0 < K; k0 += 16) {
#pragma unroll
        for (int i = 0; i < 4; ++i) { const int idx = tid + 256 * i, r = idx >> 4, kk = idx & 15; As[kk][r] = (m0 + r < M) ? af(m0 + r, k0 + kk) : 0.f; }
#pragma unroll
        for (int i = 0; i < 4; ++i) { const int idx = tid + 256 * i, kk = idx >> 6, c = idx & 63; Bs[kk][c] = (n0 + c < N) ? bf(k0 + kk, n0 + c) : 0.f; }
        __syncthreads();
#pragma unroll
        for (int kk = 0; kk < 16; ++kk) {
            float a[4], b[4];
#pragma unroll
            for (int i = 0; i < 4; ++i) { a[i] = As[kk][ty * 4 + i]; b[i] = Bs[kk][tx * 4 + i]; }
#pragma unroll
            for (int i = 0; i < 4; ++i)
#pragma unroll
                for (int j = 0; j < 4; ++j) acc[i][j] += a[i] * b[j];
        }
        __syncthreads();
    }
#pragma unroll
    for (int i = 0; i < 4; ++i)
#pragma unroll
        for (int j = 0; j < 4; ++j) { const int r = m0 + ty * 4 + i, c = n0 + tx * 4 + j; if (r < M && c < N) ef(r, c, acc[i][j]); }
}
struct AF_x_g1 { Params p; __device__ float operator()(int r, int k) const { return xval(p, r, k) * p.norm1_g[k]; } };
struct BF_rowmajor { const float* W; long ld; __device__ float operator()(int k, int n) const { return W[(size_t)k * ld + n]; } };
struct EF_proj { Params p; __device__ void operator()(int r, int n, float acc) const { proj_store(p, r, n, acc * p.RSTD1[r]); } };
struct AF_bf { const bf16_t* A; long ld; __device__ float operator()(int r, int k) const { return bf2f(A[(size_t)r * ld + k]); } };
struct EF_bra { Params p; __device__ void operator()(int r, int n, float acc) const { p.TMP[(size_t)r * DM + n] = acc * bf2f(p.BR[(size_t)r * 4096 + n]); } };
struct EF_brb { Params p; __device__ void operator()(int r, int n, float acc) const { p.MB[(size_t)r * DM + n] = f2bf(p.TMP[(size_t)r * DM + n] + acc * bf2f(p.BR[(size_t)r * 4096 + 2048 + n])); } };
struct EF_wo { Params p; __device__ void operator()(int r, int n, float acc) const { const float x1 = xval(p, r, n) + acc; p.X1[(size_t)r * DM + n] = x1; p.X1B[(size_t)r * DM + n] = f2bf(x1); } };
struct AF_x1_g2 { Params p; __device__ float operator()(int r, int k) const { return bf2f(p.X1B[(size_t)r * DM + k]) * p.norm2_g[k]; } };
struct EF_up { Params p; __device__ void operator()(int r, int n, float acc) const { const float v = fmaxf(acc * p.RSTD2[r], 0.f); p.HF[(size_t)r * DFF + n] = f2bf(v * v); } };
struct EF_down { Params p; __device__ void operator()(int r, int n, float acc) const { const float x2 = p.X1[(size_t)r * DM + n] + acc;
    if (r < NPT) p.out[OFF_Y + (size_t)r * DM + n] = x2; else p.out[OFF_YS + (size_t)(r - NPT) * DM + n] = x2; } };

__global__ void __launch_bounds__(128) k_compress_naive(Params p, int is_s) {
    const int n_cmp = is_s ? 1023 : 127, n_pad = is_s ? 1024 : 128;
    const int kv = blockIdx.y, tid = threadIdx.x;
    const int i = blockIdx.x % n_pad, bg = blockIdx.x / n_pad, b = bg >> 2, g = bg & 3;
    __shared__ float blk[2048]; __shared__ float hid[128];
    if (i >= n_cmp) {
        if (tid < 64) { if (is_s) { (kv ? p.VCMP_S : p.KCMP_S)[((size_t)bg * 1024 + i) * 64 + tid] = 0; }
                        else { if (kv) p.VCMPT_P[((size_t)bg * 64 + tid) * 128 + i] = 0; else p.KCMP_P[((size_t)bg * 128 + i) * 64 + tid] = 0; } }
        return;
    }
    const float* pe = kv ? p.pe_v : p.pe_k; const float* w1 = kv ? p.w1v : p.w1k; const float* w2 = kv ? p.w2v : p.w2k;
    for (int e = tid; e < 2048; e += 128) { const int l = e >> 6, d = e & 63; const int pos = 16 * i + l; float v;
        if (is_s) { const int page = p.page_table[b * NPAGES + (pos >> 7)]; v = (kv ? p.ccv : p.cck)[(((size_t)page * PAGE + (pos & 127)) * 4 + g) * 64 + d]; }
        else v = bf2f(p.KV6[((size_t)b * SEQ + pos) * 1536 + kv * 256 + g * 64 + d]);
        blk[e] = v + pe[e]; }
    __syncthreads();
    float h = 0.f;
    for (int k = 0; k < 2048; ++k) h += blk[k] * w1[(size_t)k * 128 + tid];
    hid[tid] = gelu_tanh(h);
    __syncthreads();
    if (tid < 64) { float o = 0.f; for (int j = 0; j < 128; ++j) o += hid[j] * w2[j * 64 + tid];
        if (is_s) (kv ? p.VCMP_S : p.KCMP_S)[((size_t)bg * 1024 + i) * 64 + tid] = f2bf(o);
        else { if (kv) p.VCMPT_P[((size_t)bg * 64 + tid) * 128 + i] = f2bf(o); else p.KCMP_P[((size_t)bg * 128 + i) * 64 + tid] = f2bf(o); } }
}

struct RowRef { const float* pf; const bf16_t* pb; };
__device__ __forceinline__ float rr_get(const RowRef& r, int d) { return r.pf ? r.pf[d] : bf2f(r.pb[d]); }

template <class KF, class VF>
__device__ __forceinline__ void attend_naive(int nk, KF keyf, VF valf, const float (*q)[64], float (*sc)[1088], float (*oacc)[64], const float* gate3, int gsel, int tid) {
    const int lane = tid & 63, wv = tid >> 6;
    for (int kk = tid; kk < nk; kk += 256) { bool valid; const RowRef r = keyf(kk, valid);
        if (valid) { float d0 = 0.f, d1 = 0.f, d2 = 0.f, d3 = 0.f;
            for (int d = 0; d < 64; ++d) { const float kx = rr_get(r, d); d0 += q[0][d] * kx; d1 += q[1][d] * kx; d2 += q[2][d] * kx; d3 += q[3][d] * kx; }
            sc[0][kk] = d0; sc[1][kk] = d1; sc[2][kk] = d2; sc[3][kk] = d3; }
        else { sc[0][kk] = -INFINITY; sc[1][kk] = -INFINITY; sc[2][kk] = -INFINITY; sc[3][kk] = -INFINITY; } }
    __syncthreads();
    {
        float m = -INFINITY; for (int kk = lane; kk < nk; kk += 64) m = fmaxf(m, sc[wv][kk]);
        m = wave_max(m);
        float s = 0.f;
        for (int kk = lane; kk < nk; kk += 64) { const float x = sc[wv][kk]; const float e = (x == -INFINITY) ? 0.f : __expf(x - m); sc[wv][kk] = e; s += e; }
        s = wave_sum(s);
        const float inv = s > 0.f ? 1.f / s : 0.f;
        for (int kk = lane; kk < nk; kk += 64) sc[wv][kk] *= inv;
    }
    __syncthreads();
    {
        float o = 0.f;
        for (int kk = 0; kk < nk; ++kk) { const float pr = sc[wv][kk]; if (pr != 0.f) o += pr * valf(kk, lane); }
        oacc[wv][lane] += gate3[wv * 3 + gsel] * o;
    }
    __syncthreads();
}

__global__ void __launch_bounds__(256) k_nsa_naive(Params p, int row0) {
    const int row = row0 + blockIdx.x, g = blockIdx.y, tid = threadIdx.x;
    const bool is_s = row >= NPT; const int b = is_s ? row - NPT : row >> 11, t = is_s ? 0 : row & 2047;
    const int start = is_s ? PAST : 0, pos = start + t, rowbase = is_s ? NPT + b : b * SEQ;
    const int n_cmp = is_s ? 1023 : 127, n_slc = is_s ? 257 : 32;
    __shared__ float q[4][64]; __shared__ float sc[4][1088]; __shared__ float oacc[4][64]; __shared__ float gate3[12];
    __shared__ float score[260]; __shared__ int selidx[16];
    { const int hd = tid >> 6, d = tid & 63; q[hd][d] = bf2f(p.QN[(size_t)row * 1024 + (g * 4 + hd) * 64 + d]); oacc[hd][d] = 0.f; }
    if (tid < 12) gate3[tid] = p.GATE[(size_t)row * 48 + g * 12 + tid];
    __syncthreads();
    const int bg = b * 4 + g;
    const bf16_t* kc = is_s ? p.KCMP_S + (size_t)bg * 1024 * 64 : p.KCMP_P + (size_t)bg * 128 * 64;
    const bf16_t* vc_s = p.VCMP_S + (size_t)bg * 1024 * 64; const bf16_t* vc_p = p.VCMPT_P + (size_t)bg * 64 * 128;
    auto kf_c = [&](int kk, bool& valid) { valid = (16 * kk + 31 <= pos); return RowRef{nullptr, kc + (size_t)kk * 64}; };
    auto vf_c = [&](int kk, int d) { return is_s ? bf2f(vc_s[(size_t)kk * 64 + d]) : bf2f(vc_p[(size_t)d * 128 + kk]); };
    attend_naive(n_cmp, kf_c, vf_c, q, sc, oacc, gate3, 0, tid);
    for (int j = tid; j < n_slc; j += 256) { float s = 0.f;
        for (int i = 4 * j - 1; i <= 4 * j + 3; ++i) if (i >= 0 && i < n_cmp) s += (sc[0][i] + sc[1][i]) + (sc[2][i] + sc[3][i]);
        score[j] = (j * 64 <= pos) ? s + ((j == 0 || j == pos / 64) ? 1e4f : 0.f) : -1e30f; }
    __syncthreads();
    for (int j = tid; j < n_slc; j += 256) { const float sj = score[j]; int rank = 0;
        for (int j2 = 0; j2 < n_slc; ++j2) { const float s2 = score[j2]; rank += (s2 > sj || (s2 == sj && j2 < j)) ? 1 : 0; }
        if (rank < 16) selidx[rank] = j; }
    __syncthreads();
    auto row_at = [&](int kp, int which) -> RowRef {
        if (kp < start) {
            if (which < 4) { const int page = p.page_table[b * NPAGES + (kp >> 7)]; const float* c = (which == 2) ? p.csk : p.csv; return RowRef{c + (((size_t)page * PAGE + (kp & 127)) * 4 + g) * 64, nullptr}; }
            const float* c = (which == 4) ? p.cwk : p.cwv; return RowRef{c + (((size_t)b * 512 + (kp - (PAST - 512))) * 4 + g) * 64, nullptr};
        }
        return RowRef{nullptr, p.KV6 + (size_t)(rowbase + kp - start) * 1536 + which * 256 + g * 64};
    };
    auto kf_s = [&](int kk, bool& valid) { const int kp = selidx[kk >> 6] * 64 + (kk & 63); valid = (kp <= pos); return valid ? row_at(kp, 2) : RowRef{nullptr, nullptr}; };
    auto vf_s = [&](int kk, int d) { const int kp = selidx[kk >> 6] * 64 + (kk & 63); return rr_get(row_at(kp, 3), d); };
    attend_naive(1024, kf_s, vf_s, q, sc, oacc, gate3, 1, tid);
    auto kf_w = [&](int kk, bool& valid) { const int kp = pos - 512 + kk; valid = (kp >= 0); return valid ? row_at(kp, 4) : RowRef{nullptr, nullptr}; };
    auto vf_w = [&](int kk, int d) { const int kp = pos - 512 + kk; return rr_get(row_at(kp, 5), d); };
    attend_naive(513, kf_w, vf_w, q, sc, oacc, gate3, 2, tid);
    { const int hd = tid >> 6, d = tid & 63; p.OA[(size_t)row * 1024 + (g * 4 + hd) * 64 + d] = f2bf(oacc[hd][d]); }
}

__global__ void __launch_bounds__(512) k_gla_naive(Params p, int is_s) {
    const int b = blockIdx.x >> 2, h = blockIdx.x & 3, tid = threadIdx.x, e = tid & 255, half = tid >> 8;
    const int T = is_s ? 1 : SEQ, rowbase = is_s ? NPT + b : b * SEQ;
    __shared__ float a_s[128], q_s[128], k_s[128], part[2][256], red[8];
    float S[64];
#pragma unroll
    for (int dd = 0; dd < 64; ++dd) S[dd] = is_s ? p.state[(((size_t)b * 4 + h) * 128 + half * 64 + dd) * 256 + e] : 0.f;
    for (int t = 0; t < T; ++t) {
        const int row = rowbase + t;
        if (tid < 128) { float x = p.b_a[h * 128 + tid];
            for (int r = 0; r < 16; ++r) x += p.LR[(size_t)row * 16 + r] * p.w_a2[r * 512 + h * 128 + tid];
            a_s[tid] = __expf(logsigmoidf_(x) * (1.f / 16.f));
            q_s[tid] = bf2f(p.GQ[(size_t)row * 512 + h * 128 + tid]); k_s[tid] = bf2f(p.GK[(size_t)row * 512 + h * 128 + tid]); }
        const float v = bf2f(p.GV[(size_t)row * 1024 + h * 256 + e]);
        __syncthreads();
        float po = 0.f;
#pragma unroll
        for (int dd = 0; dd < 64; ++dd) { const int d = half * 64 + dd; S[dd] = a_s[d] * S[dd] + k_s[d] * v; po += q_s[d] * S[dd]; }
        part[half][e] = po;
        __syncthreads();
        float o = 0.f;
        if (tid < 256) { o = part[0][e] + part[1][e]; const float ss = wave_sum(o * o); if ((tid & 63) == 0) red[tid >> 6] = ss; }
        __syncthreads();
        if (tid < 256) { const float ss = (red[0] + red[1]) + (red[2] + red[3]); const float r = rsqrtf(ss * (1.f / 256.f) + EPS);
            p.OB[(size_t)row * 1024 + h * 256 + e] = f2bf(o * r * p.gnorm[e] * bf2f(p.GR[(size_t)row * 1024 + h * 256 + e])); }
    }
    float* so = p.out + (is_s ? OFF_SGLA : OFF_PGLA);
#pragma unroll
    for (int dd = 0; dd < 64; ++dd) so[(((size_t)b * 4 + h) * 128 + half * 64 + dd) * 256 + e] = S[dd];
}

static inline size_t align_up(size_t x) { return (x + 255) & ~(size_t)255; }

extern "C" void kernel_launch(void* const* d_in, const int* in_sizes, int n_in, void* d_out, int out_size, void* d_ws, size_t ws_size, hipStream_t stream) {
    if (n_in != 29 || out_size != (int)OUT_TOTAL) { fprintf(stderr, "kernel_launch: unexpected n_in %d / out_size %d\n", n_in, out_size); return; }
    Params p{};
    p.x_prompt = (const float*)d_in[0]; p.x_sample = (const float*)d_in[1]; p.cck = (const float*)d_in[2]; p.ccv = (const float*)d_in[3];
    p.csk = (const float*)d_in[4]; p.csv = (const float*)d_in[5]; p.cwk = (const float*)d_in[6]; p.cwv = (const float*)d_in[7]; p.state = (const float*)d_in[8];
    p.page_table = (const int*)d_in[9]; p.norm1_g = (const float*)d_in[10]; p.w_in = (const float*)d_in[11]; p.b_gate = (const float*)d_in[12];
    p.pe_k = (const float*)d_in[13]; p.pe_v = (const float*)d_in[14]; p.w1k = (const float*)d_in[15]; p.w2k = (const float*)d_in[16]; p.w1v = (const float*)d_in[17]; p.w2v = (const float*)d_in[18];
    p.w_a2 = (const float*)d_in[19]; p.b_a = (const float*)d_in[20]; p.gnorm = (const float*)d_in[21]; p.w_br_a = (const float*)d_in[22]; p.w_br_b = (const float*)d_in[23];
    p.w_o = (const float*)d_in[24]; p.norm2_g = (const float*)d_in[25]; p.w_up = (const float*)d_in[26]; p.w_down = (const float*)d_in[27]; p.norm_f = (const float*)d_in[28];
    p.out = (float*)d_out;
    char* ws = (char*)d_ws; size_t off = 0;
    auto take = [&](size_t bytes) { char* r = ws + off; off = align_up(off + bytes); return r; };
    p.XB = (bf16_t*)take((size_t)NTOK * DM * 2); p.RSTD1 = (float*)take(NTOK * 4); p.QN = (bf16_t*)take((size_t)NTOK * 1024 * 2); p.KV6 = (bf16_t*)take((size_t)NTOK * 1536 * 2);
    p.GATE = (float*)take((size_t)NTOK * 48 * 4); p.GQ = (bf16_t*)take((size_t)NTOK * 512 * 2); p.GK = (bf16_t*)take((size_t)NTOK * 512 * 2); p.GV = (bf16_t*)take((size_t)NTOK * 1024 * 2);
    p.GR = (bf16_t*)take((size_t)NTOK * 1024 * 2); p.LR = (float*)take((size_t)NTOK * 16 * 4); p.BR = (bf16_t*)take((size_t)NTOK * 4096 * 2);
    p.KCMP_P = (bf16_t*)take(16 * 128 * 64 * 2); p.VCMPT_P = (bf16_t*)take(16 * 128 * 64 * 2); p.KCMP_S = (bf16_t*)take(32 * 1024 * 64 * 2); p.VCMP_S = (bf16_t*)take(32 * 1024 * 64 * 2);
    p.OA = (bf16_t*)take((size_t)NTOK * 1024 * 2); p.OB = (bf16_t*)take((size_t)NTOK * 1024 * 2); p.TMP = (float*)take((size_t)NTOK * DM * 4); p.MB = (bf16_t*)take((size_t)NTOK * DM * 2);
    p.X1 = (float*)take((size_t)NTOK * DM * 4); p.X1B = (bf16_t*)take((size_t)NTOK * DM * 2); p.RSTD2 = (float*)take(NTOK * 4); p.HF = (bf16_t*)take((size_t)NTOK * DFF * 2);
    if (off > ws_size) { fprintf(stderr, "kernel_launch: workspace too small: need %zu have %zu\n", off, ws_size); return; }

    k_prep_x<<<(NTOK + 3) / 4, 256, 0, stream>>>(p);
    k_copy_swin<<<(DB * 511 * 256 + 255) / 256, 256, 0, stream>>>(p);
    k_gemm_naive<<<dim3(DIN / 64, (NTOK + 63) / 64), 256, 0, stream>>>(NTOK, DIN, DM, AF_x_g1{p}, BF_rowmajor{p.w_in, DIN}, EF_proj{p});
    k_compress_naive<<<dim3(16 * 128, 2), 128, 0, stream>>>(p, 0);
    k_compress_naive<<<dim3(32 * 1024, 2), 128, 0, stream>>>(p, 1);
    k_nsa_naive<<<dim3(NTOK, 4), 256, 0, stream>>>(p, 0);
    k_gla_naive<<<16, 512, 0, stream>>>(p, 0);
    k_gla_naive<<<32, 512, 0, stream>>>(p, 1);
    k_gemm_naive<<<dim3(DM / 64, (NTOK + 63) / 64), 256, 0, stream>>>(NTOK, DM, 1024, AF_bf{p.OA, 1024}, BF_rowmajor{p.w_br_a, DM}, EF_bra{p});
    k_gemm_naive<<<dim3(DM / 64, (NTOK + 63) / 64), 256, 0, stream>>>(NTOK, DM, 1024, AF_bf{p.OB, 1024}, BF_rowmajor{p.w_br_b, DM}, EF_brb{p});
    k_gemm_naive<<<dim3(DM / 64, (NTOK + 63) / 64), 256, 0, stream>>>(NTOK, DM, DM, AF_bf{p.MB, DM}, BF_rowmajor{p.w_o, DM}, EF_wo{p});
    k_rms_rows<<<(NTOK + 3) / 4, 256, 0, stream>>>(p.X1, p.RSTD2, NTOK);
    k_gemm_naive<<<dim3(DFF / 64, (NTOK + 63) / 64), 256, 0, stream>>>(NTOK, DFF, DM, AF_x1_g2{p}, BF_rowmajor{p.w_up, DFF}, EF_up{p});
    k_gemm_naive<<<dim3(DM / 64, (NTOK + 63) / 64), 256, 0, stream>>>(NTOK, DM, DFF, AF_bf{p.HF, DFF}, BF_rowmajor{p.w_down, DM}, EF_down{p});
    k_final_norm<<<(NTOK + 3) / 4, 256, 0, stream>>>(p);
}
```

```cpp
#include <hip/hip_runtime.h>
#include <stdint.h>
#include <cstdio>

typedef unsigned short bf16_t;

constexpr int DM = 2048, NB = 4, SEQ = 2048, NPT = NB * SEQ, DB = 8, NTOK = NPT + DB;
constexpr int PAST = 16384, PAGE = 128, NPAGES = 128;
constexpr int NG = 4, HPG = 4, DH = 64;
constexpr int DIN = 9792, DFF = 8192;
constexpr int C_Q = 0, C_KV = 1024, C_G = 2560, C_QL = 2608, C_KL = 3120, C_VL = 3632, C_RL = 4656, C_LR = 5680, C_BR = 5696;
constexpr float EPS = 1e-6f;
constexpr size_t OFF_Y = 0, OFF_YS = (size_t)NPT * DM, OFF_PCK = OFF_YS + (size_t)DB * DM;
constexpr size_t SZ_PROW = (size_t)NPT * 256;
constexpr size_t OFF_PWK = OFF_PCK + 4 * SZ_PROW, SZ_PWIN = (size_t)NB * 512 * 256;
constexpr size_t OFF_PGLA = OFF_PWK + 2 * SZ_PWIN, SZ_PGLA = (size_t)NB * 4 * 128 * 256;
constexpr size_t OFF_SCK = OFF_PGLA + SZ_PGLA, SZ_SROW = (size_t)DB * 256;
constexpr size_t OFF_SWK = OFF_SCK + 4 * SZ_SROW, SZ_SWIN = (size_t)DB * 512 * 256;
constexpr size_t OFF_SGLA = OFF_SWK + 2 * SZ_SWIN, SZ_SGLA = (size_t)DB * 4 * 128 * 256;
constexpr size_t OUT_TOTAL = OFF_SGLA + SZ_SGLA;
static_assert(OUT_TOTAL == 29908992, "output size");

__device__ __forceinline__ bf16_t f2bf(float f) { unsigned u = __builtin_bit_cast(unsigned, f); return (bf16_t)((u + 0x7fffu + ((u >> 16) & 1u)) >> 16); }
__device__ __forceinline__ float bf2f(bf16_t h) { return __builtin_bit_cast(float, (unsigned)h << 16); }
__device__ __forceinline__ float sigmoidf_(float x) { return 1.f / (1.f + __expf(-x)); }
__device__ __forceinline__ float siluf_(float x) { return x / (1.f + __expf(-x)); }
__device__ __forceinline__ float gelu_tanh(float x) { const float u = 0.7978845608028654f * (x + 0.044715f * x * x * x); return 0.5f * x * (1.f + tanhf(u)); }
__device__ __forceinline__ float logsigmoidf_(float x) { return fminf(x, 0.f) - log1pf(__expf(-fabsf(x))); }
__device__ __forceinline__ float wave_sum(float v) {
#pragma unroll
    for (int o = 1; o < 64; o <<= 1) v += __shfl_xor(v, o);
    return v;
}
__device__ __forceinline__ float wave_max(float v) {
#pragma unroll
    for (int o = 1; o < 64; o <<= 1) v = fmaxf(v, __shfl_xor(v, o));
    return v;
}

struct Params {
    const float *x_prompt, *x_sample, *cck, *ccv, *csk, *csv, *cwk, *cwv, *state;
    const int* page_table;
    const float *norm1_g, *w_in, *b_gate, *pe_k, *pe_v, *w1k, *w2k, *w1v, *w2v, *w_a2, *b_a, *gnorm, *w_br_a, *w_br_b, *w_o, *norm2_g, *w_up, *w_down, *norm_f;
    float* out;
    bf16_t *XB, *QN, *KV6, *GQ, *GK, *GV, *GR, *BR, *KCMP_P, *VCMPT_P, *KCMP_S, *VCMP_S, *OA, *OB, *MB, *X1B, *HF;
    float *RSTD1, *GATE, *LR, *TMP, *X1, *RSTD2;
    bf16_t *WIN_T, *WBRA_T, *WBRB_T, *WO_T, *WUP_T, *WDN_T;
    float *SUMSQ2, *SUMSQ3;
    unsigned* CTL;
};

__device__ __forceinline__ float xval(const Params& p, int row, int n) { return row < NPT ? p.x_prompt[(size_t)row * DM + n] : p.x_sample[(size_t)(row - NPT) * DM + n]; }

__device__ __forceinline__ void proj_store(const Params& p, int row, int n, float v) {
    if (n < C_KV) p.QN[(size_t)row * 1024 + n] = f2bf(v * 0.125f);
    else if (n < C_G) {
        const int c = n - C_KV; p.KV6[(size_t)row * 1536 + c] = f2bf(v); const int j = c >> 8, cc = c & 255;
        if (row < NPT) { const int b = row >> 11, t = row & 2047;
            if (j < 4) p.out[OFF_PCK + j * SZ_PROW + (size_t)row * 256 + cc] = v;
            else if (t >= 1536) p.out[OFF_PWK + (j - 4) * SZ_PWIN + ((size_t)b * 512 + t - 1536) * 256 + cc] = v; }
        else { const int b = row - NPT;
            if (j < 4) p.out[OFF_SCK + j * SZ_SROW + (size_t)b * 256 + cc] = v;
            else p.out[OFF_SWK + (j - 4) * SZ_SWIN + ((size_t)b * 512 + 511) * 256 + cc] = v; }
    }
    else if (n < C_QL) { const int c = n - C_G; p.GATE[(size_t)row * 48 + c] = sigmoidf_(v + p.b_gate[c]); }
    else if (n < C_KL) p.GQ[(size_t)row * 512 + (n - C_QL)] = f2bf(v * 0.08838834764831845f);
    else if (n < C_VL) p.GK[(size_t)row * 512 + (n - C_KL)] = f2bf(v);
    else if (n < C_RL) p.GV[(size_t)row * 1024 + (n - C_VL)] = f2bf(v);
    else if (n < C_LR) p.GR[(size_t)row * 1024 + (n - C_RL)] = f2bf(siluf_(v));
    else if (n < C_BR) p.LR[(size_t)row * 16 + (n - C_LR)] = v;
    else p.BR[(size_t)row * 4096 + (n - C_BR)] = f2bf(sigmoidf_(v));
}

__global__ void __launch_bounds__(256) k_prep_x(Params p) {
    const int lane = threadIdx.x & 63, row = blockIdx.x * 4 + (threadIdx.x >> 6);
    if (row >= NTOK) return;
    const float* xr = row < NPT ? p.x_prompt + (size_t)row * DM : p.x_sample + (size_t)(row - NPT) * DM;
    float ss = 0.f;
    for (int i = lane; i < DM; i += 64) { const float v = xr[i]; ss += v * v; p.XB[(size_t)row * DM + i] = f2bf(v); }
    ss = wave_sum(ss);
    if (lane == 0) p.RSTD1[row] = rsqrtf(ss * (1.f / DM) + EPS);
}
__global__ void __launch_bounds__(256) k_copy_swin(Params p) {
    const size_t i = (size_t)blockIdx.x * 256 + threadIdx.x;
    if (i >= (size_t)DB * 511 * 256) return;
    const int c = (int)(i & 255); const int r = (int)((i >> 8) % 511); const int b = (int)((i >> 8) / 511);
    p.out[OFF_SWK + ((size_t)b * 512 + r) * 256 + c] = p.cwk[((size_t)b * 512 + r + 1) * 256 + c];
    p.out[OFF_SWK + SZ_SWIN + ((size_t)b * 512 + r) * 256 + c] = p.cwv[((size_t)b * 512 + r + 1) * 256 + c];
}
__global__ void __launch_bounds__(256) k_rms_rows(const float* X, float* rstd, int nrows) {
    const int lane = threadIdx.x & 63, row = blockIdx.x * 4 + (threadIdx.x >> 6);
    if (row >= nrows) return;
    float ss = 0.f;
    for (int i = lane; i < DM; i += 64) { const float v = X[(size_t)row * DM + i]; ss += v * v; }
    ss = wave_sum(ss);
    if (lane == 0) rstd[row] = rsqrtf(ss * (1.f / DM) + EPS);
}
__global__ void __launch_bounds__(256) k_final_norm(Params p) {
    const int lane = threadIdx.x & 63, row = blockIdx.x * 4 + (threadIdx.x >> 6);
    if (row >= NTOK) return;
    float* yr = row < NPT ? p.out + OFF_Y + (size_t)row * DM : p.out + OFF_YS + (size_t)(row - NPT) * DM;
    float ss = 0.f;
    for (int i = lane; i < DM; i += 64) { const float v = yr[i]; ss += v * v; }
    ss = wave_sum(ss);
    const float r = rsqrtf(ss * (1.f / DM) + EPS);
    for (int i = lane; i < DM; i += 64) yr[i] = yr[i] * r * p.norm_f[i];
}

template <class AF, class BF, class EF>
__global__ void __launch_bounds__(256) k_gemm_naive(int m_off, int M, int N, int K, AF af, BF bf, EF ef) {
    __shared__ float As[16][68], Bs[16][68];
    const int tid = threadIdx.x, tx = tid & 15, ty = tid >> 4, m0 = m_off + blockIdx.y * 64, n0 = blockIdx.x * 64;
    float acc[4][4];
#pragma unroll
    for (int i = 0; i < 4; ++i)
#pragma unroll
        for (int j = 0; j < 4; ++j) acc[i][j] = 0.f;
    for (int k0 = 0; k0 < K; k0 += 16) {
#pragma unroll
        for (int i = 0; i < 4; ++i) { const int idx = tid + 256 * i, r = idx >> 4, kk = idx & 15; As[kk][r] = (m0 + r < M) ? af(m0 + r, k0 + kk) : 0.f; }
#pragma unroll
        for (int i = 0; i < 4; ++i) { const int idx = tid + 256 * i, kk = idx >> 6, c = idx & 63; Bs[kk][c] = (n0 + c < N) ? bf(k0 + kk, n0 + c) : 0.f; }
        __syncthreads();
#pragma unroll
        for (int kk = 0; kk < 16; ++kk) {
            float a[4], b[4];
#pragma unroll
            for (int i = 0; i < 4; ++i) { a[i] = As[kk][ty * 4 + i]; b[i] = Bs[kk][tx * 4 + i]; }
#pragma unroll
            for (int i = 0; i < 4; ++i)
#pragma unroll
                for (int j = 0; j < 4; ++j) acc[i][j] += a[i] * b[j];
        }
        __syncthreads();
    }
#pragma unroll
    for (int i = 0; i < 4; ++i)
#pragma unroll
        for (int j = 0; j < 4; ++j) { const int r = m0 + ty * 4 + i, c = n0 + tx * 4 + j; if (r < M && c < N) ef(r, c, acc[i][j]); }
}
struct AF_x_g1 { Params p; __device__ float operator()(int r, int k) const { return xval(p, r, k) * p.norm1_g[k]; } };
struct BF_rowmajor { const float* W; long ld; __device__ float operator()(int k, int n) const { return W[(size_t)k * ld + n]; } };
struct EF_proj { Params p; __device__ void operator()(int r, int n, float acc) const { proj_store(p, r, n, acc * p.RSTD1[r]); } };
struct AF_bf { const bf16_t* A; long ld; __device__ float operator()(int r, int k) const { return bf2f(A[(size_t)r * ld + k]); } };
struct EF_bra { Params p; __device__ void operator()(int r, int n, float acc) const { p.TMP[(size_t)r * DM + n] = acc * bf2f(p.BR[(size_t)r * 4096 + n]); } };
struct EF_brb { Params p; __device__ void operator()(int r, int n, float acc) const { p.MB[(size_t)r * DM + n] = f2bf(p.TMP[(size_t)r * DM + n] + acc * bf2f(p.BR[(size_t)r * 4096 + 2048 + n])); } };
struct EF_wo { Params p; __device__ void operator()(int r, int n, float acc) const { const float x1 = xval(p, r, n) + acc; p.X1[(size_t)r * DM + n] = x1; p.X1B[(size_t)r * DM + n] = f2bf(x1); } };
struct AF_x1_g2 { Params p; __device__ float operator()(int r, int k) const { return bf2f(p.X1B[(size_t)r * DM + k]) * p.norm2_g[k]; } };
struct EF_up { Params p; __device__ void operator()(int r, int n, float acc) const { const float v = fmaxf(acc * p.RSTD2[r], 0.f); p.HF[(size_t)r * DFF + n] = f2bf(v * v); } };
struct EF_down { Params p; __device__ void operator()(int r, int n, float acc) const { const float x2 = p.X1[(size_t)r * DM + n] + acc;
    if (r < NPT) p.out[OFF_Y + (size_t)r * DM + n] = x2; else p.out[OFF_YS + (size_t)(r - NPT) * DM + n] = x2; } };

__global__ void __launch_bounds__(128) k_compress_naive(Params p, int is_s) {
    const int n_cmp = is_s ? 1023 : 127, n_pad = is_s ? 1024 : 128;
    const int kv = blockIdx.y, tid = threadIdx.x;
    const int i = blockIdx.x % n_pad, bg = blockIdx.x / n_pad, b = bg >> 2, g = bg & 3;
    __shared__ float blk[2048]; __shared__ float hid[128];
    if (i >= n_cmp) {
        if (tid < 64) { if (is_s) { (kv ? p.VCMP_S : p.KCMP_S)[((size_t)bg * 1024 + i) * 64 + tid] = 0; }
                        else { if (kv) p.VCMPT_P[((size_t)bg * 64 + tid) * 128 + i] = 0; else p.KCMP_P[((size_t)bg * 128 + i) * 64 + tid] = 0; } }
        return;
    }
    const float* pe = kv ? p.pe_v : p.pe_k; const float* w1 = kv ? p.w1v : p.w1k; const float* w2 = kv ? p.w2v : p.w2k;
    for (int e = tid; e < 2048; e += 128) { const int l = e >> 6, d = e & 63; const int pos = 16 * i + l; float v;
        if (is_s) { const int page = p.page_table[b * NPAGES + (pos >> 7)]; v = (kv ? p.ccv : p.cck)[(((size_t)page * PAGE + (pos & 127)) * 4 + g) * 64 + d]; }
        else v = bf2f(p.KV6[((size_t)b * SEQ + pos) * 1536 + kv * 256 + g * 64 + d]);
        blk[e] = v + pe[e]; }
    __syncthreads();
    float h = 0.f;
    for (int k = 0; k < 2048; ++k) h += blk[k] * w1[(size_t)k * 128 + tid];
    hid[tid] = gelu_tanh(h);
    __syncthreads();
    if (tid < 64) { float o = 0.f; for (int j = 0; j < 128; ++j) o += hid[j] * w2[j * 64 + tid];
        if (is_s) (kv ? p.VCMP_S : p.KCMP_S)[((size_t)bg * 1024 + i) * 64 + tid] = f2bf(o);
        else { if (kv) p.VCMPT_P[((size_t)bg * 64 + tid) * 128 + i] = f2bf(o); else p.KCMP_P[((size_t)bg * 128 + i) * 64 + tid] = f2bf(o); } }
}

struct RowRef { const float* pf; const bf16_t* pb; };
__device__ __forceinline__ float rr_get(const RowRef& r, int d) { return r.pf ? r.pf[d] : bf2f(r.pb[d]); }

template <class KF, class VF>
__device__ __forceinline__ void attend_naive(int nk, KF keyf, VF valf, const float (*q)[64], float (*sc)[1088], float (*oacc)[64], const float* gate3, int gsel, int tid) {
    const int lane = tid & 63, wv = tid >> 6;
    for (int kk = tid; kk < nk; kk += 256) { bool valid; const RowRef r = keyf(kk, valid);
        if (valid) { float d0 = 0.f, d1 = 0.f, d2 = 0.f, d3 = 0.f;
            for (int d = 0; d < 64; ++d) { const float kx = rr_get(r, d); d0 += q[0][d] * kx; d1 += q[1][d] * kx; d2 += q[2][d] * kx; d3 += q[3][d] * kx; }
            sc[0][kk] = d0; sc[1][kk] = d1; sc[2][kk] = d2; sc[3][kk] = d3; }
        else { sc[0][kk] = -INFINITY; sc[1][kk] = -INFINITY; sc[2][kk] = -INFINITY; sc[3][kk] = -INFINITY; } }
    __syncthreads();
    {
        float m = -INFINITY; for (int kk = lane; kk < nk; kk += 64) m = fmaxf(m, sc[wv][kk]);
        m = wave_max(m);
        float s = 0.f;
        for (int kk = lane; kk < nk; kk += 64) { const float x = sc[wv][kk]; const float e = (x == -INFINITY) ? 0.f : __expf(x - m); sc[wv][kk] = e; s += e; }
        s = wave_sum(s);
        const float inv = s > 0.f ? 1.f / s : 0.f;
        for (int kk = lane; kk < nk; kk += 64) sc[wv][kk] *= inv;
    }
    __syncthreads();
    {
        float o = 0.f;
        for (int kk = 0; kk < nk; ++kk) { const float pr = sc[wv][kk]; if (pr != 0.f) o += pr * valf(kk, lane); }
        oacc[wv][lane] += gate3[wv * 3 + gsel] * o;
    }
    __syncthreads();
}

__global__ void __launch_bounds__(256) k_nsa_naive(Params p, int row0) {
    const int row = row0 + blockIdx.x, g = blockIdx.y, tid = threadIdx.x;
    const bool is_s = row >= NPT; const int b = is_s ? row - NPT : row >> 11, t = is_s ? 0 : row & 2047;
    const int start = is_s ? PAST : 0, pos = start + t, rowbase = is_s ? NPT + b : b * SEQ;
    const int n_cmp = is_s ? 1023 : 127, n_slc = is_s ? 257 : 32;
    __shared__ float q[4][64]; __shared__ float sc[4][1088]; __shared__ float oacc[4][64]; __shared__ float gate3[12];
    __shared__ float score[260]; __shared__ int selidx[16];
    { const int hd = tid >> 6, d = tid & 63; q[hd][d] = bf2f(p.QN[(size_t)row * 1024 + (g * 4 + hd) * 64 + d]); oacc[hd][d] = 0.f; }
    if (tid < 12) gate3[tid] = p.GATE[(size_t)row * 48 + g * 12 + tid];
    __syncthreads();
    const int bg = b * 4 + g;
    const bf16_t* kc = is_s ? p.KCMP_S + (size_t)bg * 1024 * 64 : p.KCMP_P + (size_t)bg * 128 * 64;
    const bf16_t* vc_s = p.VCMP_S + (size_t)bg * 1024 * 64; const bf16_t* vc_p = p.VCMPT_P + (size_t)bg * 64 * 128;
    auto kf_c = [&](int kk, bool& valid) { valid = (16 * kk + 31 <= pos); return RowRef{nullptr, kc + (size_t)kk * 64}; };
    auto vf_c = [&](int kk, int d) { return is_s ? bf2f(vc_s[(size_t)kk * 64 + d]) : bf2f(vc_p[(size_t)d * 128 + kk]); };
    attend_naive(n_cmp, kf_c, vf_c, q, sc, oacc, gate3, 0, tid);
    for (int j = tid; j < n_slc; j += 256) { float s = 0.f;
        for (int i = 4 * j - 1; i <= 4 * j + 3; ++i) if (i >= 0 && i < n_cmp) s += (sc[0][i] + sc[1][i]) + (sc[2][i] + sc[3][i]);
        score[j] = (j * 64 <= pos) ? s + ((j == 0 || j == pos / 64) ? 1e4f : 0.f) : -1e30f; }
    __syncthreads();
    for (int j = tid; j < n_slc; j += 256) { const float sj = score[j]; int rank = 0;
        for (int j2 = 0; j2 < n_slc; ++j2) { const float s2 = score[j2]; rank += (s2 > sj || (s2 == sj && j2 < j)) ? 1 : 0; }
        if (rank < 16) selidx[rank] = j; }
    __syncthreads();
    auto row_at = [&](int kp, int which) -> RowRef {
        if (kp < start) {
            if (which < 4) { const int page = p.page_table[b * NPAGES + (kp >> 7)]; const float* c = (which == 2) ? p.csk : p.csv; return RowRef{c + (((size_t)page * PAGE + (kp & 127)) * 4 + g) * 64, nullptr}; }
            const float* c = (which == 4) ? p.cwk : p.cwv; return RowRef{c + (((size_t)b * 512 + (kp - (PAST - 512))) * 4 + g) * 64, nullptr};
        }
        return RowRef{nullptr, p.KV6 + (size_t)(rowbase + kp - start) * 1536 + which * 256 + g * 64};
    };
    auto kf_s = [&](int kk, bool& valid) { const int kp = selidx[kk >> 6] * 64 + (kk & 63); valid = (kp <= pos); return valid ? row_at(kp, 2) : RowRef{nullptr, nullptr}; };
    auto vf_s = [&](int kk, int d) { const int kp = selidx[kk >> 6] * 64 + (kk & 63); return rr_get(row_at(kp, 3), d); };
    attend_naive(1024, kf_s, vf_s, q, sc, oacc, gate3, 1, tid);
    auto kf_w = [&](int kk, bool& valid) { const int kp = pos - 512 + kk; valid = (kp >= 0); return valid ? row_at(kp, 4) : RowRef{nullptr, nullptr}; };
    auto vf_w = [&](int kk, int d) { const int kp = pos - 512 + kk; return rr_get(row_at(kp, 5), d); };
    attend_naive(513, kf_w, vf_w, q, sc, oacc, gate3, 2, tid);
    { const int hd = tid >> 6, d = tid & 63; p.OA[(size_t)row * 1024 + (g * 4 + hd) * 64 + d] = f2bf(oacc[hd][d]); }
}

__global__ void __launch_bounds__(512) k_gla_naive(Params p, int is_s) {
    const int b = blockIdx.x >> 2, h = blockIdx.x & 3, tid = threadIdx.x, e = tid & 255, half = tid >> 8;
    const int T = is_s ? 1 : SEQ, rowbase = is_s ? NPT + b : b * SEQ;
    __shared__ float a_s[128], q_s[128], k_s[128], part[2][256], red[8];
    float S[64];
#pragma unroll
    for (int dd = 0; dd < 64; ++dd) S[dd] = is_s ? p.state[(((size_t)b * 4 + h) * 128 + half * 64 + dd) * 256 + e] : 0.f;
    for (int t = 0; t < T; ++t) {
        const int row = rowbase + t;
        if (tid < 128) { float x = p.b_a[h * 128 + tid];
            for (int r = 0; r < 16; ++r) x += p.LR[(size_t)row * 16 + r] * p.w_a2[r * 512 + h * 128 + tid];
            a_s[tid] = __expf(logsigmoidf_(x) * (1.f / 16.f));
            q_s[tid] = bf2f(p.GQ[(size_t)row * 512 + h * 128 + tid]); k_s[tid] = bf2f(p.GK[(size_t)row * 512 + h * 128 + tid]); }
        const float v = bf2f(p.GV[(size_t)row * 1024 + h * 256 + e]);
        __syncthreads();
        float po = 0.f;
#pragma unroll
        for (int dd = 0; dd < 64; ++dd) { const int d = half * 64 + dd; S[dd] = a_s[d] * S[dd] + k_s[d] * v; po += q_s[d] * S[dd]; }
        part[half][e] = po;
        __syncthreads();
        float o = 0.f;
        if (tid < 256) { o = part[0][e] + part[1][e]; const float ss = wave_sum(o * o); if ((tid & 63) == 0) red[tid >> 6] = ss; }
        __syncthreads();
        if (tid < 256) { const float ss = (red[0] + red[1]) + (red[2] + red[3]); const float r = rsqrtf(ss * (1.f / 256.f) + EPS);
            p.OB[(size_t)row * 1024 + h * 256 + e] = f2bf(o * r * p.gnorm[e] * bf2f(p.GR[(size_t)row * 1024 + h * 256 + e])); }
    }
    float* so = p.out + (is_s ? OFF_SGLA : OFF_PGLA);
#pragma unroll
    for (int dd = 0; dd < 64; ++dd) so[(((size_t)b * 4 + h) * 128 + half * 64 + dd) * 256 + e] = S[dd];
}

#define GAS __attribute__((address_space(1)))
#define LAS __attribute__((address_space(3)))
typedef unsigned v4u __attribute__((ext_vector_type(4)));
typedef unsigned v2u __attribute__((ext_vector_type(2)));
#define LDS_WAIT() asm volatile("s_waitcnt lgkmcnt(0)" ::: "memory")
#define VM_WAIT() asm volatile("s_waitcnt vmcnt(0)" ::: "memory")
__device__ __forceinline__ unsigned pk2(float lo, float hi) { return (unsigned)f2bf(lo) | ((unsigned)f2bf(hi) << 16); }
constexpr int NIN_PAD = 9984;
__host__ __device__ __forceinline__ int in_colmap(int n) {
    if (n < 2560) return n; if (n < 3072) return C_QL + (n - 2560); if (n < 3584) return C_KL + (n - 3072); if (n < 4608) return C_VL + (n - 3584);
    if (n < 5632) return C_RL + (n - 4608); if (n < 9728) return C_BR + (n - 5632); if (n < 9776) return C_G + (n - 9728); if (n < 9792) return C_LR + (n - 9776); return -1;
}
namespace pg8 {
#define PG8_LAS __attribute__((address_space(3)))
typedef unsigned short bf16_t;
typedef short bf16x8 __attribute__((ext_vector_type(8)));
typedef float f32x4 __attribute__((ext_vector_type(4)));
typedef unsigned u32x4 __attribute__((ext_vector_type(4)));
constexpr int BM = 256, BK = 64, HALF = 128, HTB = HALF * BK * 2  , STAGE_BYTES = 8 * HTB, NXCD = 8, WGM = 8;

__host__ __device__ __forceinline__ int lds_byte(int r, int c) { const int st = (r >> 4) * 2 + (c >> 5), rr = r & 15, cc = c & 31, ob = rr * 64 + cc * 2; return st * 1024 + (ob ^ (((ob >> 9) & 1) << 5)); }
__host__ __device__ __forceinline__ void stage_rc(int b, int& R, int& C) { const int st = b / 1024, sb = b % 1024, swz = sb ^ (((sb >> 9) & 1) << 5); R = (st >> 1) * 16 + swz / 64; C = (st & 1) * 32 + (swz % 64) / 2; }
__host__ __device__ __forceinline__ int perm32(int rho) { const int n = rho >> 4, i = rho & 15; return 8 * (i >> 2) + 4 * n + (i & 3); }

struct Unit { int pm, pn; };
struct Gemm { const bf16_t* A; const bf16_t* Bt; int M, N, K; };

struct StaticOrder {
    int nM, nN, nwg, G, c;
    __host__ __device__ void init(int M, int N, int G_, int c_) { nM = M / BM; nN = N / BM; nwg = nM * nN; G = G_; c = c_; }
    __host__ __device__ bool next(int i, Unit& u) const {
        const long L = (long)i * G + c; if (L >= nwg) return false;
        int wgid = (int)L; { const int q = nwg / NXCD, r = nwg % NXCD, xcd = wgid % NXCD, off = wgid / NXCD; wgid = (xcd < r ? xcd * (q + 1) : r * (q + 1) + (xcd - r) * q) + off; }
        const int nig = WGM * nN, gid = wgid / nig, fm = gid * WGM, gsz = (nM - fm) < WGM ? (nM - fm) : WGM;
        u.pm = fm + ((wgid % nig) % gsz); u.pn = (wgid % nig) / gsz; return true;
    }
    __device__ __forceinline__ void a_ready(const Unit&) const {}
    __device__ __forceinline__ void done(const Unit&) const {}
};

template <class Epi, class Sched, bool ALIGN_EPI = false, bool SP2 = false>
__device__ __forceinline__ void gemm_phase(PG8_LAS unsigned char* lds, const Gemm g, const Sched& S, const Epi& E) {
    const int tid = threadIdx.x, wid = __builtin_amdgcn_readfirstlane(tid >> 6), lane = tid & 63, wr = wid >> 2, wc = wid & 3, fr = lane & 15, fq = lane >> 4;
    const int K = g.K, nt = K / BK;
    unsigned voffA[2], voffB[2];
#pragma unroll
    for (int i = 0; i < 2; ++i) { int R, C; stage_rc(tid * 16 + i * 8192, R, C); const int Rb = Epi::PERM ? ((R & ~31) + perm32(R & 31)) : R;
        voffA[i] = (unsigned)(R * K + C) * 2u; voffB[i] = (unsigned)(Rb * K + C) * 2u; }
    const size_t kstep = (size_t)(BK * 2);
    const size_t hstep = (size_t)HALF * K * 2;
    const size_t tstep = 2 * hstep;
    const unsigned ldsw = (unsigned)wid * 1024u;
    const int aoff = lds_byte(wr * 64 + fr, fq * 8), boff = lds_byte(wc * 32 + fr, fq * 8);
#define PG8_SA(b, h) (((b) * 2 + (h)) * HTB)
#define PG8_SB(b, h) ((4 + (b) * 2 + (h)) * HTB)
#define PG8_STAGE(bufoff, gbase, voff) do { _Pragma("unroll") for (int _i = 0; _i < 2; ++_i) \
        __builtin_amdgcn_global_load_lds((const unsigned*)((const char*)(gbase) + (voff)[_i]), (PG8_LAS unsigned*)(lds + (bufoff) + ldsw + _i * 8192), 16, 0, 0); } while (0)
#define PG8_LDA(dst, b, h) do { _Pragma("unroll") for (int m = 0; m < 4; ++m) _Pragma("unroll") for (int k = 0; k < 2; ++k) dst[m][k] = *(const PG8_LAS bf16x8*)(lds + PG8_SA(b, h) + aoff + m * 2048 + k * 1024); } while (0)
#define PG8_LDB(dst, b, h) do { _Pragma("unroll") for (int n = 0; n < 2; ++n) _Pragma("unroll") for (int k = 0; k < 2; ++k) dst[n][k] = *(const PG8_LAS bf16x8*)(lds + PG8_SB(b, h) + boff + n * 2048 + k * 1024); } while (0)
#define PG8_MMA(ai, bj, At, Bt) do { __builtin_amdgcn_s_setprio(1); _Pragma("unroll") for (int m = 0; m < 4; ++m) _Pragma("unroll") for (int n = 0; n < 2; ++n) _Pragma("unroll") for (int k = 0; k < 2; ++k) \
        acc[ai][bj][m][n] = __builtin_amdgcn_mfma_f32_16x16x32_bf16(Bt[n][k], At[m][k], acc[ai][bj][m][n], 0, 0, 0); __builtin_amdgcn_s_setprio(0); } while (0)
#define PG8_WAIT_V(n) asm volatile("s_waitcnt vmcnt(" #n ")" ::: "memory")
#define PG8_WAIT_L(n) asm volatile("s_waitcnt lgkmcnt(" #n ")" ::: "memory")
#define PG8_BAR __builtin_amdgcn_s_barrier()
#define PG8_SCHED __builtin_amdgcn_sched_barrier(0)
    Unit cur, nxt; int ui = 0;
    if (!S.next(0, cur)) return;
    f32x4 acc[2][2][4][2];
#pragma unroll
    for (int a = 0; a < 2; ++a)
#pragma unroll
        for (int b = 0; b < 2; ++b)
#pragma unroll
            for (int m = 0; m < 4; ++m)
#pragma unroll
                for (int n = 0; n < 2; ++n) acc[a][b][m][n] = (f32x4){0.f, 0.f, 0.f, 0.f};
    bf16x8 At[4][2], B0[2][2], B1[2][2];
    const char* cA = (const char*)g.A + (size_t)cur.pm * tstep; const char* cB = (const char*)g.Bt + (size_t)cur.pn * tstep;
    S.a_ready(cur);
    if constexpr (SP2) {
        PG8_STAGE(PG8_SB(0, 0), cB, voffB); PG8_STAGE(PG8_SB(0, 1), cB + hstep, voffB); PG8_STAGE(PG8_SA(0, 0), cA, voffA); PG8_STAGE(PG8_SA(0, 1), cA + hstep, voffA);
        if (wr == 1) PG8_BAR;
        PG8_WAIT_V(2); PG8_BAR;
        PG8_STAGE(PG8_SB(1, 0), cB + kstep, voffB); PG8_STAGE(PG8_SA(1, 0), cA + kstep, voffA); PG8_STAGE(PG8_SB(1, 1), cB + hstep + kstep, voffB);
        PG8_WAIT_V(6); PG8_BAR;
    } else {
        PG8_STAGE(PG8_SB(0, 0), cB, voffB); PG8_STAGE(PG8_SA(0, 0), cA, voffA); PG8_STAGE(PG8_SB(0, 1), cB + hstep, voffB); PG8_STAGE(PG8_SA(0, 1), cA + hstep, voffA);
        if (wr == 1) PG8_BAR;
        PG8_WAIT_V(4); PG8_BAR;
        PG8_STAGE(PG8_SB(1, 0), cB + kstep, voffB); PG8_STAGE(PG8_SA(1, 0), cA + kstep, voffA); PG8_STAGE(PG8_SB(1, 1), cB + hstep + kstep, voffB);
        PG8_WAIT_V(6); PG8_BAR;
    }
    for (;;) {
        const bool has_next = S.next(ui + 1, nxt);
        const char* nA = has_next ? (const char*)g.A + (size_t)nxt.pm * tstep : cA; const char* nB = has_next ? (const char*)g.Bt + (size_t)nxt.pn * tstep : cB;
        for (int t = 0; t < nt; t += 2) {
            const bool last = (t == nt - 2);
            const char* a1 = cA + (size_t)(t + 1) * kstep;
            const char* a2 = last ? nA : cA + (size_t)(t + 2) * kstep; const char* b2 = last ? nB : cB + (size_t)(t + 2) * kstep;
            const char* a3 = a2 + kstep; const char* b3 = b2 + kstep;
            if (last && has_next) S.a_ready(nxt);
            if constexpr (SP2) {
            PG8_LDB(B0, 0, 0); PG8_LDB(B1, 0, 1); PG8_SCHED; PG8_LDA(At, 0, 0); PG8_STAGE(PG8_SA(1, 1), a1 + hstep, voffA);
            PG8_WAIT_V(8); PG8_WAIT_L(0); PG8_BAR; PG8_MMA(0, 0, At, B0); PG8_MMA(0, 1, At, B1); PG8_BAR; PG8_SCHED;
            PG8_LDA(At, 0, 1); PG8_STAGE(PG8_SB(0, 0), b2, voffB); PG8_STAGE(PG8_SB(0, 1), b2 + hstep, voffB); PG8_STAGE(PG8_SA(0, 0), a2, voffA);
            PG8_WAIT_V(8); PG8_WAIT_L(0); PG8_BAR; PG8_MMA(1, 0, At, B0); PG8_MMA(1, 1, At, B1); PG8_BAR; PG8_SCHED;
            PG8_LDB(B0, 1, 0); PG8_LDB(B1, 1, 1); PG8_SCHED; PG8_LDA(At, 1, 0); PG8_STAGE(PG8_SA(0, 1), a2 + hstep, voffA);
            PG8_WAIT_V(8); PG8_WAIT_L(0); PG8_BAR; PG8_MMA(0, 0, At, B0); PG8_MMA(0, 1, At, B1); PG8_BAR; PG8_SCHED;
            PG8_LDA(At, 1, 1); PG8_STAGE(PG8_SB(1, 0), b3, voffB); PG8_STAGE(PG8_SB(1, 1), b3 + hstep, voffB); PG8_STAGE(PG8_SA(1, 0), a3, voffA);
            PG8_WAIT_V(8); PG8_WAIT_L(0); PG8_BAR; PG8_MMA(1, 0, At, B0); PG8_MMA(1, 1, At, B1); PG8_BAR; PG8_SCHED;
            } else {
            PG8_LDB(B0, 0, 0); PG8_SCHED; PG8_LDA(At, 0, 0); PG8_STAGE(PG8_SA(1, 1), a1 + hstep, voffA);
            PG8_WAIT_L(8); PG8_BAR; PG8_WAIT_L(0); PG8_MMA(0, 0, At, B0); PG8_BAR; PG8_SCHED;
            PG8_LDB(B1, 0, 1); PG8_STAGE(PG8_SB(0, 0), b2, voffB);
            PG8_BAR; PG8_WAIT_L(0); PG8_MMA(0, 1, At, B1); PG8_BAR;
            PG8_LDA(At, 0, 1); PG8_STAGE(PG8_SA(0, 0), a2, voffA);
            PG8_BAR; PG8_WAIT_L(0); PG8_MMA(1, 0, At, B0); PG8_BAR; PG8_SCHED;
            PG8_STAGE(PG8_SB(0, 1), b2 + hstep, voffB);
            PG8_WAIT_V(6); PG8_BAR; PG8_MMA(1, 1, At, B1); PG8_BAR;
            PG8_LDB(B0, 1, 0); PG8_SCHED; PG8_LDA(At, 1, 0); PG8_STAGE(PG8_SA(0, 1), a2 + hstep, voffA);
            PG8_WAIT_L(8); PG8_BAR; PG8_WAIT_L(0); PG8_MMA(0, 0, At, B0); PG8_BAR; PG8_SCHED;
            PG8_LDB(B1, 1, 1); PG8_STAGE(PG8_SB(1, 0), b3, voffB);
            PG8_BAR; PG8_WAIT_L(0); PG8_MMA(0, 1, At, B1); PG8_BAR;
            PG8_LDA(At, 1, 1); PG8_STAGE(PG8_SA(1, 0), a3, voffA);
            PG8_BAR; PG8_WAIT_L(0); PG8_MMA(1, 0, At, B0); PG8_BAR; PG8_SCHED;
            PG8_STAGE(PG8_SB(1, 1), b3 + hstep, voffB);
            PG8_WAIT_V(6); PG8_BAR; PG8_MMA(1, 1, At, B1); PG8_BAR;
            }
        }
        if constexpr (ALIGN_EPI) { if (wr == 0) PG8_BAR; }
        if constexpr (!Epi::AFTER_DRAIN) { E(acc, cur, wr, wc, fr, fq); S.done(cur); }
        if (!has_next) break;
#pragma unroll
        for (int a = 0; a < 2; ++a)
#pragma unroll
            for (int b = 0; b < 2; ++b)
#pragma unroll
                for (int m = 0; m < 4; ++m)
#pragma unroll
                    for (int n = 0; n < 2; ++n) acc[a][b][m][n] = (f32x4){0.f, 0.f, 0.f, 0.f};
        cur = nxt; cA = nA; cB = nB; ++ui;
        if constexpr (ALIGN_EPI) { if (wr == 1) PG8_BAR; }
    }
    PG8_WAIT_V(0);
    if constexpr (!ALIGN_EPI) { if (wr == 0) PG8_BAR; }
    PG8_BAR;
    if constexpr (Epi::AFTER_DRAIN) { E.fused(acc, cur, wr, wc, fr, fq, lds, wid, lane); S.done(cur); }
#undef PG8_SA
#undef PG8_SB
#undef PG8_STAGE
#undef PG8_LDA
#undef PG8_LDB
#undef PG8_MMA
#undef PG8_WAIT_V
#undef PG8_WAIT_L
#undef PG8_BAR
#undef PG8_SCHED
}
}
typedef pg8::f32x4 f32x4;
template <class F> struct EpiGen {
    static constexpr bool PERM = false, AFTER_DRAIN = false; F f;
    __device__ __forceinline__ void operator()(const f32x4 (&acc)[2][2][4][2], const pg8::Unit& u, int wr, int wc, int fr, int fq) const {
        const int row0 = u.pm * 256 + wr * 64 + fr, col0 = u.pn * 256 + wc * 32 + 4 * fq;
#pragma unroll
        for (int ai = 0; ai < 2; ++ai)
#pragma unroll
            for (int m = 0; m < 4; ++m) { const int row = row0 + ai * 128 + m * 16; const float ctx = f.row_begin(row); float part = 0.f;
#pragma unroll
                for (int bj = 0; bj < 2; ++bj)
#pragma unroll
                    for (int n = 0; n < 2; ++n) part += f.store4(ctx, row, col0 + bj * 128 + n * 16, acc[ai][bj][m][n]);
                f.row_end(row, part, fq); }
    }
};
template <int ACT  >
__device__ __forceinline__ void store_tile_bf16(const f32x4 (&acc)[2][2][4][2], int row0, int col0, const float* rstd, float scale, bf16_t* dst, int ld) {
#pragma unroll
    for (int ai = 0; ai < 2; ++ai)
#pragma unroll
        for (int m = 0; m < 4; ++m) { const int row = row0 + ai * 128 + m * 16; const float rs = rstd[row] * scale; bf16_t* rp = dst + (size_t)row * ld + col0;
#pragma unroll
            for (int bj = 0; bj < 2; ++bj)
#pragma unroll
                for (int n = 0; n < 2; ++n) { f32x4 v = acc[ai][bj][m][n] * rs;
                    if (ACT == 1) { v[0] = siluf_(v[0]); v[1] = siluf_(v[1]); v[2] = siluf_(v[2]); v[3] = siluf_(v[3]); }
                    if (ACT == 2) { v[0] = sigmoidf_(v[0]); v[1] = sigmoidf_(v[1]); v[2] = sigmoidf_(v[2]); v[3] = sigmoidf_(v[3]); }
                    v2u w; w.x = pk2(v[0], v[1]); w.y = pk2(v[2], v[3]); *(v2u*)(rp + bj * 128 + n * 16) = w; } }
}
struct EpiProj {
    static constexpr bool PERM = false, AFTER_DRAIN = false;
    const float* rstd; const float* b_gate; bf16_t *QN, *KV6, *GQ, *GK, *GV, *GR, *BR; float *GATE, *LR, *out;
    __device__ __forceinline__ void operator()(const f32x4 (&acc)[2][2][4][2], const pg8::Unit& u, int wr, int wc, int fr, int fq) const {
        const int row0 = u.pm * 256 + wr * 64 + fr, cl0 = wc * 32 + 4 * fq, pn = u.pn;
        if (pn < 4) store_tile_bf16<0>(acc, row0, pn * 256 + cl0, rstd, 0.125f, QN, 1024);
        else if (pn < 10) { const int j = pn - 4;
            store_tile_bf16<0>(acc, row0, j * 256 + cl0, rstd, 1.f, KV6, 1536);
#pragma unroll
            for (int ai = 0; ai < 2; ++ai)
#pragma unroll
                for (int m = 0; m < 4; ++m) { const int row = row0 + ai * 128 + m * 16; const float rs = rstd[row]; const int b = row >> 11, t = row & 2047;
                    float* rp = nullptr;
                    if (j < 4) rp = out + OFF_PCK + j * SZ_PROW + (size_t)row * 256 + cl0;
                    else if (t >= 1536) rp = out + OFF_PWK + (j - 4) * SZ_PWIN + ((size_t)b * 512 + (t - 1536)) * 256 + cl0;
                    if (rp) {
#pragma unroll
                        for (int bj = 0; bj < 2; ++bj)
#pragma unroll
                            for (int n = 0; n < 2; ++n) *(f32x4*)(rp + bj * 128 + n * 16) = acc[ai][bj][m][n] * rs; } }
        }
        else if (pn < 12) store_tile_bf16<0>(acc, row0, (pn - 10) * 256 + cl0, rstd, 0.08838834764831845f, GQ, 512);
        else if (pn < 14) store_tile_bf16<0>(acc, row0, (pn - 12) * 256 + cl0, rstd, 1.f, GK, 512);
        else if (pn < 18) store_tile_bf16<0>(acc, row0, (pn - 14) * 256 + cl0, rstd, 1.f, GV, 1024);
        else if (pn < 22) store_tile_bf16<1>(acc, row0, (pn - 18) * 256 + cl0, rstd, 1.f, GR, 1024);
        else if (pn < 38) store_tile_bf16<2>(acc, row0, (pn - 22) * 256 + cl0, rstd, 1.f, BR, 4096);
        else if (wc < 2) {
#pragma unroll
            for (int ai = 0; ai < 2; ++ai)
#pragma unroll
                for (int m = 0; m < 4; ++m) { const int row = row0 + ai * 128 + m * 16; const float rs = rstd[row];
#pragma unroll
                    for (int n = 0; n < 2; ++n) { const int cl = cl0 + n * 16; const f32x4 v = acc[ai][0][m][n] * rs;
                        if (cl < 48) { const f32x4 bg = *(const f32x4*)(b_gate + cl); f32x4 o; o[0] = sigmoidf_(v[0] + bg[0]); o[1] = sigmoidf_(v[1] + bg[1]); o[2] = sigmoidf_(v[2] + bg[2]); o[3] = sigmoidf_(v[3] + bg[3]);
                            *(f32x4*)(GATE + (size_t)row * 48 + cl) = o; }
                        else *(f32x4*)(LR + (size_t)row * 16 + (cl - 48)) = v; } }
        }
    }
};
struct F_bra { const bf16_t* BR; float* TMP;
    __device__ __forceinline__ float row_begin(int) const { return 0.f; }
    __device__ __forceinline__ float store4(float, int row, int col, f32x4 v) const { const v2u b = *(const v2u*)(BR + (size_t)row * 4096 + col);
        f32x4 o; o[0] = v[0] * bf2f((bf16_t)(b.x & 0xffff)); o[1] = v[1] * bf2f((bf16_t)(b.x >> 16)); o[2] = v[2] * bf2f((bf16_t)(b.y & 0xffff)); o[3] = v[3] * bf2f((bf16_t)(b.y >> 16));
        *(f32x4*)(TMP + (size_t)row * DM + col) = o; return 0.f; }
    __device__ __forceinline__ void row_end(int, float, int) const {}
};
struct F_brb { const bf16_t* BR; const float* TMP; bf16_t* MB;
    __device__ __forceinline__ float row_begin(int) const { return 0.f; }
    __device__ __forceinline__ float store4(float, int row, int col, f32x4 v) const { const v2u b = *(const v2u*)(BR + (size_t)row * 4096 + 2048 + col); const f32x4 t = *(const f32x4*)(TMP + (size_t)row * DM + col);
        const float o0 = t[0] + v[0] * bf2f((bf16_t)(b.x & 0xffff)), o1 = t[1] + v[1] * bf2f((bf16_t)(b.x >> 16)), o2 = t[2] + v[2] * bf2f((bf16_t)(b.y & 0xffff)), o3 = t[3] + v[3] * bf2f((bf16_t)(b.y >> 16));
        v2u w; w.x = pk2(o0, o1); w.y = pk2(o2, o3); *(v2u*)(MB + (size_t)row * DM + col) = w; return 0.f; }
    __device__ __forceinline__ void row_end(int, float, int) const {}
};
struct F_wo { const float* x; float* X1; bf16_t* X1B; float* SUMSQ;
    __device__ __forceinline__ float row_begin(int) const { return 0.f; }
    __device__ __forceinline__ float store4(float, int row, int col, f32x4 v) const { const f32x4 xv = *(const f32x4*)(x + (size_t)row * DM + col); const f32x4 x1 = xv + v;
        *(f32x4*)(X1 + (size_t)row * DM + col) = x1; v2u w; w.x = pk2(x1[0], x1[1]); w.y = pk2(x1[2], x1[3]); *(v2u*)(X1B + (size_t)row * DM + col) = w;
        return (x1[0] * x1[0] + x1[1] * x1[1]) + (x1[2] * x1[2] + x1[3] * x1[3]); }
    __device__ __forceinline__ void row_end(int row, float part, int fq) const { part += __shfl_xor(part, 16); part += __shfl_xor(part, 32); if (fq == 0) atomicAdd(SUMSQ + row, part); }
};
struct F_up { const float* SUMSQ; bf16_t* HF;
    __device__ __forceinline__ float row_begin(int row) const { return rsqrtf(SUMSQ[row] * (1.f / DM) + EPS); }
    __device__ __forceinline__ float store4(float rs, int row, int col, f32x4 v) const { float h[4];
#pragma unroll
        for (int i = 0; i < 4; ++i) { const float t = fmaxf(v[i] * rs, 0.f); h[i] = t * t; }
        v2u w; w.x = pk2(h[0], h[1]); w.y = pk2(h[2], h[3]); *(v2u*)(HF + (size_t)row * DFF + col) = w; return 0.f; }
    __device__ __forceinline__ void row_end(int, float, int) const {}
};
struct F_down { const float* X1; float* Y; float* SUMSQ;
    __device__ __forceinline__ float row_begin(int) const { return 0.f; }
    __device__ __forceinline__ float store4(float, int row, int col, f32x4 v) const { const f32x4 x1 = *(const f32x4*)(X1 + (size_t)row * DM + col); const f32x4 x2 = x1 + v;
        *(f32x4*)(Y + (size_t)row * DM + col) = x2; return (x2[0] * x2[0] + x2[1] * x2[1]) + (x2[2] * x2[2] + x2[3] * x2[3]); }
    __device__ __forceinline__ void row_end(int row, float part, int fq) const { part += __shfl_xor(part, 16); part += __shfl_xor(part, 32); if (fq == 0) atomicAdd(SUMSQ + row, part); }
};

template <class CM>
__device__ __forceinline__ void transpose_item(const float* W, int ldw, const float* kscale, bf16_t* WT, int K, int item, int nblk, CM cm, LAS float* scr, int lane) {
    const int kb = item / nblk, nb = item % nblk, k0 = 64 * kb, n0 = 32 * nb;
    const int sc = cm(n0 + (lane & 31));
#pragma unroll 8
    for (int i = 0; i < 32; ++i) { const int kk = 2 * i + (lane >> 5); float v = sc >= 0 ? W[(size_t)(k0 + kk) * ldw + sc] : 0.f; if (kscale) v *= kscale[k0 + kk]; scr[kk * 33 + (lane & 31)] = v; }
    LDS_WAIT(); asm volatile("" ::: "memory");
    const int c = lane & 7;
#pragma unroll
    for (int j = 0; j < 4; ++j) { const int n = (lane >> 3) + 8 * j; const LAS float* s = scr + (8 * c) * 33 + n;
        v4u o; o.x = pk2(s[0 * 33], s[1 * 33]); o.y = pk2(s[2 * 33], s[3 * 33]); o.z = pk2(s[4 * 33], s[5 * 33]); o.w = pk2(s[6 * 33], s[7 * 33]);
        *(v4u*)(WT + (size_t)(n0 + n) * K + k0 + 8 * c) = o; }
    LDS_WAIT(); asm volatile("" ::: "memory");
}
struct CM_id { __device__ __forceinline__ int operator()(int n) const { return n; } };
struct CM_in { __device__ __forceinline__ int operator()(int n) const { return in_colmap(n); } };

__device__ __forceinline__ void ph_prologue(const Params& p, LAS unsigned char* lds, int bid, int G, int tid) {
    const int lane = tid & 63, wave = tid >> 6, gw = bid * 8 + wave, NGW = G * 8;
    LAS float* scr = (LAS float*)(lds + wave * 16384);
    constexpr int I_IN = 32 * (NIN_PAD / 32), I_BR = 16 * 64, I_O = 32 * 64, I_UP = 32 * 256, I_DN = 128 * 64;
    constexpr int TOTAL = I_IN + 2 * I_BR + I_O + I_UP + I_DN;
    for (int it = gw; it < TOTAL; it += NGW) { int r = it;
        if (r < I_IN) { transpose_item(p.w_in, DIN, p.norm1_g, p.WIN_T, DM, r, NIN_PAD / 32, CM_in{}, scr, lane); continue; } r -= I_IN;
        if (r < I_BR) { transpose_item(p.w_br_a, DM, nullptr, p.WBRA_T, 1024, r, 64, CM_id{}, scr, lane); continue; } r -= I_BR;
        if (r < I_BR) { transpose_item(p.w_br_b, DM, nullptr, p.WBRB_T, 1024, r, 64, CM_id{}, scr, lane); continue; } r -= I_BR;
        if (r < I_O) { transpose_item(p.w_o, DM, nullptr, p.WO_T, DM, r, 64, CM_id{}, scr, lane); continue; } r -= I_O;
        if (r < I_UP) { transpose_item(p.w_up, DFF, p.norm2_g, p.WUP_T, DM, r, 256, CM_id{}, scr, lane); continue; } r -= I_UP;
        transpose_item(p.w_down, DM, nullptr, p.WDN_T, DFF, r, 64, CM_id{}, scr, lane);
    }
    for (int row = gw; row < NTOK; row += NGW) {
        const f32x4* xr = (const f32x4*)(row < NPT ? p.x_prompt + (size_t)row * DM : p.x_sample + (size_t)(row - NPT) * DM) + lane;
        f32x4 v[8]; float ss = 0.f;
#pragma unroll
        for (int j = 0; j < 8; ++j) { v[j] = xr[64 * j]; ss += (v[j][0] * v[j][0] + v[j][1] * v[j][1]) + (v[j][2] * v[j][2] + v[j][3] * v[j][3]); }
        ss = wave_sum(ss);
        v2u* o = (v2u*)(p.XB + (size_t)row * DM) + lane;
#pragma unroll
        for (int j = 0; j < 8; ++j) { v2u w; w.x = pk2(v[j][0], v[j][1]); w.y = pk2(v[j][2], v[j][3]); o[64 * j] = w; }
        if (lane == 0) p.RSTD1[row] = rsqrtf(ss * (1.f / DM) + EPS);
    }
    for (int i = bid * 512 + tid; i < NTOK; i += G * 512) { p.SUMSQ2[i] = 0.f; p.SUMSQ3[i] = 0.f; }
    for (int i = bid * 512 + tid; i < DB * 511 * 64; i += G * 512) { const int c4 = i & 63, r = (i >> 6) % 511, b = (i >> 6) / 511;
        const size_t so = ((size_t)b * 512 + r + 1) * 256 + c4 * 4, dofs = ((size_t)b * 512 + r) * 256 + c4 * 4;
        *(f32x4*)(p.out + OFF_SWK + dofs) = *(const f32x4*)(p.cwk + so); *(f32x4*)(p.out + OFF_SWK + SZ_SWIN + dofs) = *(const f32x4*)(p.cwv + so); }
}
__device__ __forceinline__ void ph_final_norm(const Params& p, int bid, int G, int tid) {
    const int lane = tid & 63, wave = tid >> 6, gw = bid * 8 + wave, NGW = G * 8;
    for (int row = gw; row < NTOK; row += NGW) {
        float* yr = row < NPT ? p.out + OFF_Y + (size_t)row * DM : p.out + OFF_YS + (size_t)(row - NPT) * DM;
        const float r = rsqrtf(p.SUMSQ3[row] * (1.f / DM) + EPS);
        f32x4* y4 = (f32x4*)yr + lane; const f32x4* g4 = (const f32x4*)p.norm_f + lane;
#pragma unroll
        for (int j = 0; j < 8; ++j) { f32x4 v = y4[64 * j]; const f32x4 g = g4[64 * j]; v = v * r * g; y4[64 * j] = v; }
    }
}

constexpr int LDS_BYTES = 147456;
constexpr int MISC_OFF = 131072 + 320;
enum Phase { PH_PRO = 0, PH_IN = 1, PH_BRA = 4, PH_BRB = 5, PH_WO = 6, PH_UP = 7, PH_DOWN = 8, PH_NORM = 9, PH_END = 10 };
__global__ void __launch_bounds__(512, 2) mk_fwd(Params p, int ph_lo, int ph_hi) {
    extern __shared__ __attribute__((aligned(16))) unsigned char lds_raw[];
    LAS unsigned char* lds = (LAS unsigned char*)lds_raw;
    const int tid = threadIdx.x, bid = blockIdx.x, G = gridDim.x;
#define IN(k) (ph_lo <= (k) && (k) < ph_hi)
    if (IN(PH_PRO)) ph_prologue(p, lds, bid, G, tid);
    if (IN(PH_IN)) { pg8::Gemm g{p.XB, p.WIN_T, NPT, NIN_PAD, DM}; pg8::StaticOrder S; S.init(NPT, NIN_PAD, G, bid);
        EpiProj E{p.RSTD1, p.b_gate, p.QN, p.KV6, p.GQ, p.GK, p.GV, p.GR, p.BR, p.GATE, p.LR, p.out};
        pg8::gemm_phase<EpiProj, pg8::StaticOrder, true, true>(lds, g, S, E); }
    if (IN(PH_BRA)) { pg8::Gemm g{p.OA, p.WBRA_T, NPT, DM, 1024}; pg8::StaticOrder S; S.init(NPT, DM, G, bid); EpiGen<F_bra> E{{p.BR, p.TMP}};
        pg8::gemm_phase<EpiGen<F_bra>, pg8::StaticOrder, true, true>(lds, g, S, E); }
    if (IN(PH_BRB)) { pg8::Gemm g{p.OB, p.WBRB_T, NPT, DM, 1024}; pg8::StaticOrder S; S.init(NPT, DM, G, bid); EpiGen<F_brb> E{{p.BR, p.TMP, p.MB}};
        pg8::gemm_phase<EpiGen<F_brb>, pg8::StaticOrder, true, true>(lds, g, S, E); }
    if (IN(PH_WO)) { pg8::Gemm g{p.MB, p.WO_T, NPT, DM, DM}; pg8::StaticOrder S; S.init(NPT, DM, G, bid); EpiGen<F_wo> E{{p.x_prompt, p.X1, p.X1B, p.SUMSQ2}};
        pg8::gemm_phase<EpiGen<F_wo>, pg8::StaticOrder, true, true>(lds, g, S, E); }
    if (IN(PH_UP)) { pg8::Gemm g{p.X1B, p.WUP_T, NPT, DFF, DM}; pg8::StaticOrder S; S.init(NPT, DFF, G, bid); EpiGen<F_up> E{{p.SUMSQ2, p.HF}};
        pg8::gemm_phase<EpiGen<F_up>, pg8::StaticOrder, true, true>(lds, g, S, E); }
    if (IN(PH_DOWN)) { pg8::Gemm g{p.HF, p.WDN_T, NPT, DM, DFF}; pg8::StaticOrder S; S.init(NPT, DM, G, bid); EpiGen<F_down> E{{p.X1, p.out + OFF_Y, p.SUMSQ3}};
        pg8::gemm_phase<EpiGen<F_down>, pg8::StaticOrder, true, true>(lds, g, S, E); }
    if (IN(PH_NORM)) ph_final_norm(p, bid, G, tid);
#undef IN
}
__global__ void __launch_bounds__(256) k_sumsq_rows(const float* X, size_t ld, float* ss_out, int nrows) {
    const int lane = threadIdx.x & 63, row = blockIdx.x * 4 + (threadIdx.x >> 6);
    if (row >= nrows) return;
    float ss = 0.f;
    for (int i = lane; i < DM; i += 64) { const float v = X[(size_t)row * ld + i]; ss += v * v; }
    ss = wave_sum(ss);
    if (lane == 0) ss_out[row] = ss;
}
struct EF_up2 { Params p; __device__ void operator()(int r, int n, float acc) const { const float v = fmaxf(acc * rsqrtf(p.SUMSQ2[r] * (1.f / DM) + EPS), 0.f); p.HF[(size_t)r * DFF + n] = f2bf(v * v); } };

static inline size_t align_up(size_t x) { return (x + 255) & ~(size_t)255; }

extern "C" void kernel_launch(void* const* d_in, const int* in_sizes, int n_in, void* d_out, int out_size, void* d_ws, size_t ws_size, hipStream_t stream) {
    if (n_in != 29 || out_size != (int)OUT_TOTAL) { fprintf(stderr, "kernel_launch: unexpected n_in %d / out_size %d\n", n_in, out_size); return; }
    static int grid = 0;
    if (grid == 0) {
        int dev = 0, cus = 0, per_cu = 0;
        if (hipGetDevice(&dev) != hipSuccess || hipDeviceGetAttribute(&cus, hipDeviceAttributeMultiprocessorCount, dev) != hipSuccess) { fprintf(stderr, "kernel_launch: device query failed\n"); grid = -1; return; }
        if (hipFuncSetAttribute((const void*)mk_fwd, hipFuncAttributeMaxDynamicSharedMemorySize, LDS_BYTES) != hipSuccess) { fprintf(stderr, "kernel_launch: hipFuncSetAttribute failed\n"); grid = -1; return; }
        if (hipOccupancyMaxActiveBlocksPerMultiprocessor(&per_cu, (const void*)mk_fwd, 512, LDS_BYTES) != hipSuccess || per_cu < 1) { fprintf(stderr, "kernel_launch: occupancy query says %d\n", per_cu); per_cu = 1; }
        (void)hipGetLastError();
        grid = cus;
    }
    if (grid < 0) return;
    Params p{};
    p.x_prompt = (const float*)d_in[0]; p.x_sample = (const float*)d_in[1]; p.cck = (const float*)d_in[2]; p.ccv = (const float*)d_in[3];
    p.csk = (const float*)d_in[4]; p.csv = (const float*)d_in[5]; p.cwk = (const float*)d_in[6]; p.cwv = (const float*)d_in[7]; p.state = (const float*)d_in[8];
    p.page_table = (const int*)d_in[9]; p.norm1_g = (const float*)d_in[10]; p.w_in = (const float*)d_in[11]; p.b_gate = (const float*)d_in[12];
    p.pe_k = (const float*)d_in[13]; p.pe_v = (const float*)d_in[14]; p.w1k = (const float*)d_in[15]; p.w2k = (const float*)d_in[16]; p.w1v = (const float*)d_in[17]; p.w2v = (const float*)d_in[18];
    p.w_a2 = (const float*)d_in[19]; p.b_a = (const float*)d_in[20]; p.gnorm = (const float*)d_in[21]; p.w_br_a = (const float*)d_in[22]; p.w_br_b = (const float*)d_in[23];
    p.w_o = (const float*)d_in[24]; p.norm2_g = (const float*)d_in[25]; p.w_up = (const float*)d_in[26]; p.w_down = (const float*)d_in[27]; p.norm_f = (const float*)d_in[28];
    p.out = (float*)d_out;
    char* ws = (char*)d_ws; size_t off = 0;
    auto take = [&](size_t bytes) { char* r = ws + off; off = align_up(off + bytes); return r; };
    p.CTL = (unsigned*)take(1 << 20);
    p.XB = (bf16_t*)take((size_t)NTOK * DM * 2); p.RSTD1 = (float*)take(NTOK * 4); p.QN = (bf16_t*)take((size_t)NTOK * 1024 * 2); p.KV6 = (bf16_t*)take((size_t)NTOK * 1536 * 2);
    p.GATE = (float*)take((size_t)NTOK * 48 * 4); p.GQ = (bf16_t*)take((size_t)NTOK * 512 * 2); p.GK = (bf16_t*)take((size_t)NTOK * 512 * 2); p.GV = (bf16_t*)take((size_t)NTOK * 1024 * 2);
    p.GR = (bf16_t*)take((size_t)NTOK * 1024 * 2); p.LR = (float*)take((size_t)NTOK * 16 * 4); p.BR = (bf16_t*)take((size_t)NTOK * 4096 * 2);
    p.KCMP_P = (bf16_t*)take(16 * 128 * 64 * 2); p.VCMPT_P = (bf16_t*)take(16 * 128 * 64 * 2); p.KCMP_S = (bf16_t*)take(32 * 1024 * 64 * 2); p.VCMP_S = (bf16_t*)take(32 * 1024 * 64 * 2);
    p.OA = (bf16_t*)take((size_t)NTOK * 1024 * 2); p.OB = (bf16_t*)take((size_t)NTOK * 1024 * 2); p.TMP = (float*)take((size_t)NTOK * DM * 4); p.MB = (bf16_t*)take((size_t)NTOK * DM * 2);
    p.X1 = (float*)take((size_t)NTOK * DM * 4); p.X1B = (bf16_t*)take((size_t)NTOK * DM * 2); p.RSTD2 = (float*)take(NTOK * 4); p.HF = (bf16_t*)take((size_t)NTOK * DFF * 2);
    p.WIN_T = (bf16_t*)take((size_t)NIN_PAD * DM * 2); p.WBRA_T = (bf16_t*)take((size_t)DM * 1024 * 2); p.WBRB_T = (bf16_t*)take((size_t)DM * 1024 * 2); p.WO_T = (bf16_t*)take((size_t)DM * DM * 2);
    p.WUP_T = (bf16_t*)take((size_t)DFF * DM * 2); p.WDN_T = (bf16_t*)take((size_t)DM * DFF * 2); p.SUMSQ2 = (float*)take(NTOK * 4); p.SUMSQ3 = (float*)take(NTOK * 4);
    if (off > ws_size) { fprintf(stderr, "kernel_launch: workspace too small: need %zu have %zu\n", off, ws_size); return; }
    hipMemsetAsync(p.CTL, 0, 1 << 20, stream);
#define MK(lo, hi) hipLaunchKernelGGL(mk_fwd, dim3(grid), dim3(512), LDS_BYTES, stream, p, (int)(lo), (int)(hi))
    MK(PH_PRO, PH_PRO + 1);
    MK(PH_IN, PH_IN + 1);
    k_gemm_naive<<<dim3(DIN / 64, 1), 256, 0, stream>>>(NPT, NTOK, DIN, DM, AF_x_g1{p}, BF_rowmajor{p.w_in, DIN}, EF_proj{p});
    k_compress_naive<<<dim3(16 * 128, 2), 128, 0, stream>>>(p, 0);
    k_compress_naive<<<dim3(32 * 1024, 2), 128, 0, stream>>>(p, 1);
    k_nsa_naive<<<dim3(NTOK, 4), 256, 0, stream>>>(p, 0);
    k_gla_naive<<<16, 512, 0, stream>>>(p, 0);
    k_gla_naive<<<32, 512, 0, stream>>>(p, 1);
    MK(PH_BRA, PH_BRA + 1);
    k_gemm_naive<<<dim3(DM / 64, 1), 256, 0, stream>>>(NPT, NTOK, DM, 1024, AF_bf{p.OA, 1024}, BF_rowmajor{p.w_br_a, DM}, EF_bra{p});
    MK(PH_BRB, PH_BRB + 1);
    k_gemm_naive<<<dim3(DM / 64, 1), 256, 0, stream>>>(NPT, NTOK, DM, 1024, AF_bf{p.OB, 1024}, BF_rowmajor{p.w_br_b, DM}, EF_brb{p});
    MK(PH_WO, PH_WO + 1);
    k_gemm_naive<<<dim3(DM / 64, 1), 256, 0, stream>>>(NPT, NTOK, DM, DM, AF_bf{p.MB, DM}, BF_rowmajor{p.w_o, DM}, EF_wo{p});
    k_sumsq_rows<<<2, 256, 0, stream>>>(p.X1 + (size_t)NPT * DM, DM, p.SUMSQ2 + NPT, DB);
    MK(PH_UP, PH_UP + 1);
    k_gemm_naive<<<dim3(DFF / 64, 1), 256, 0, stream>>>(NPT, NTOK, DFF, DM, AF_x1_g2{p}, BF_rowmajor{p.w_up, DFF}, EF_up2{p});
    MK(PH_DOWN, PH_DOWN + 1);
    k_gemm_naive<<<dim3(DM / 64, 1), 256, 0, stream>>>(NPT, NTOK, DM, DFF, AF_bf{p.HF, DFF}, BF_rowmajor{p.w_down, DM}, EF_down{p});
    k_sumsq_rows<<<2, 256, 0, stream>>>(p.out + OFF_YS, DM, p.SUMSQ3 + NPT, DB);
    MK(PH_NORM, PH_NORM + 1);
}
```

```cpp
#include <hip/hip_runtime.h>
#include <stdint.h>
#include <cstdio>

typedef unsigned short bf16_t;

constexpr int DM = 2048, NB = 4, SEQ = 2048, NPT = NB * SEQ, DB = 8, NTOK = NPT + DB;
constexpr int PAST = 16384, PAGE = 128, NPAGES = 128;
constexpr int NG = 4, HPG = 4, DH = 64;
constexpr int DIN = 9792, DFF = 8192;
constexpr int C_Q = 0, C_KV = 1024, C_G = 2560, C_QL = 2608, C_KL = 3120, C_VL = 3632, C_RL = 4656, C_LR = 5680, C_BR = 5696;
constexpr float EPS = 1e-6f;
constexpr size_t OFF_Y = 0, OFF_YS = (size_t)NPT * DM, OFF_PCK = OFF_YS + (size_t)DB * DM;
constexpr size_t SZ_PROW = (size_t)NPT * 256;
constexpr size_t OFF_PWK = OFF_PCK + 4 * SZ_PROW, SZ_PWIN = (size_t)NB * 512 * 256;
constexpr size_t OFF_PGLA = OFF_PWK + 2 * SZ_PWIN, SZ_PGLA = (size_t)NB * 4 * 128 * 256;
constexpr size_t OFF_SCK = OFF_PGLA + SZ_PGLA, SZ_SROW = (size_t)DB * 256;
constexpr size_t OFF_SWK = OFF_SCK + 4 * SZ_SROW, SZ_SWIN = (size_t)DB * 512 * 256;
constexpr size_t OFF_SGLA = OFF_SWK + 2 * SZ_SWIN, SZ_SGLA = (size_t)DB * 4 * 128 * 256;
constexpr size_t OUT_TOTAL = OFF_SGLA + SZ_SGLA;
static_assert(OUT_TOTAL == 29908992, "output size");

__device__ __forceinline__ bf16_t f2bf(float f) { unsigned u = __builtin_bit_cast(unsigned, f); return (bf16_t)((u + 0x7fffu + ((u >> 16) & 1u)) >> 16); }
__device__ __forceinline__ float bf2f(bf16_t h) { return __builtin_bit_cast(float, (unsigned)h << 16); }
__device__ __forceinline__ float sigmoidf_(float x) { return 1.f / (1.f + __expf(-x)); }
__device__ __forceinline__ float siluf_(float x) { return x / (1.f + __expf(-x)); }
__device__ __forceinline__ float gelu_tanh(float x) { const float u = 0.7978845608028654f * (x + 0.044715f * x * x * x); return 0.5f * x * (1.f + tanhf(u)); }
__device__ __forceinline__ float logsigmoidf_(float x) { return fminf(x, 0.f) - log1pf(__expf(-fabsf(x))); }
__device__ __forceinline__ float wave_sum(float v) {
#pragma unroll
    for (int o = 1; o < 64; o <<= 1) v += __shfl_xor(v, o);
    return v;
}
__device__ __forceinline__ float wave_max(float v) {
#pragma unroll
    for (int o = 1; o < 64; o <<= 1) v = fmaxf(v, __shfl_xor(v, o));
    return v;
}

struct Params {
    const float *x_prompt, *x_sample, *cck, *ccv, *csk, *csv, *cwk, *cwv, *state;
    const int* page_table;
    const float *norm1_g, *w_in, *b_gate, *pe_k, *pe_v, *w1k, *w2k, *w1v, *w2v, *w_a2, *b_a, *gnorm, *w_br_a, *w_br_b, *w_o, *norm2_g, *w_up, *w_down, *norm_f;
    float* out;
    bf16_t *XB, *QN, *KV6, *GQ, *GK, *GV, *GR, *BR, *KCMP_P, *VCMPT_P, *KCMP_S, *VCMP_S, *OA, *OB, *MB, *X1B, *HF;
    float *RSTD1, *GATE, *LR, *TMP, *X1, *RSTD2;
    bf16_t *WIN_T, *WBRA_T, *WBRB_T, *WO_T, *WUP_T, *WDN_T;
    float *SUMSQ2, *SUMSQ3;
    unsigned* CTL;
};

__device__ __forceinline__ float xval(const Params& p, int row, int n) { return row < NPT ? p.x_prompt[(size_t)row * DM + n] : p.x_sample[(size_t)(row - NPT) * DM + n]; }

__device__ __forceinline__ void proj_store(const Params& p, int row, int n, float v) {
    if (n < C_KV) p.QN[(size_t)row * 1024 + n] = f2bf(v * 0.125f);
    else if (n < C_G) {
        const int c = n - C_KV; p.KV6[(size_t)row * 1536 + c] = f2bf(v); const int j = c >> 8, cc = c & 255;
        if (row < NPT) { const int b = row >> 11, t = row & 2047;
            if (j < 4) p.out[OFF_PCK + j * SZ_PROW + (size_t)row * 256 + cc] = v;
            else if (t >= 1536) p.out[OFF_PWK + (j - 4) * SZ_PWIN + ((size_t)b * 512 + t - 1536) * 256 + cc] = v; }
        else { const int b = row - NPT;
            if (j < 4) p.out[OFF_SCK + j * SZ_SROW + (size_t)b * 256 + cc] = v;
            else p.out[OFF_SWK + (j - 4) * SZ_SWIN + ((size_t)b * 512 + 511) * 256 + cc] = v; }
    }
    else if (n < C_QL) { const int c = n - C_G; p.GATE[(size_t)row * 48 + c] = sigmoidf_(v + p.b_gate[c]); }
    else if (n < C_KL) p.GQ[(size_t)row * 512 + (n - C_QL)] = f2bf(v * 0.08838834764831845f);
    else if (n < C_VL) p.GK[(size_t)row * 512 + (n - C_KL)] = f2bf(v);
    else if (n < C_RL) p.GV[(size_t)row * 1024 + (n - C_VL)] = f2bf(v);
    else if (n < C_LR) p.GR[(size_t)row * 1024 + (n - C_RL)] = f2bf(siluf_(v));
    else if (n < C_BR) p.LR[(size_t)row * 16 + (n - C_LR)] = v;
    else p.BR[(size_t)row * 4096 + (n - C_BR)] = f2bf(sigmoidf_(v));
}

__global__ void __launch_bounds__(256) k_prep_x(Params p) {
    const int lane = threadIdx.x & 63, row = blockIdx.x * 4 + (threadIdx.x >> 6);
    if (row >= NTOK) return;
    const float* xr = row < NPT ? p.x_prompt + (size_t)row * DM : p.x_sample + (size_t)(row - NPT) * DM;
    float ss = 0.f;
    for (int i = lane; i < DM; i += 64) { const float v = xr[i]; ss += v * v; p.XB[(size_t)row * DM + i] = f2bf(v); }
    ss = wave_sum(ss);
    if (lane == 0) p.RSTD1[row] = rsqrtf(ss * (1.f / DM) + EPS);
}
__global__ void __launch_bounds__(256) k_copy_swin(Params p) {
    const size_t i = (size_t)blockIdx.x * 256 + threadIdx.x;
    if (i >= (size_t)DB * 511 * 256) return;
    const int c = (int)(i & 255); const int r = (int)((i >> 8) % 511); const int b = (int)((i >> 8) / 511);
    p.out[OFF_SWK + ((size_t)b * 512 + r) * 256 + c] = p.cwk[((size_t)b * 512 + r + 1) * 256 + c];
    p.out[OFF_SWK + SZ_SWIN + ((size_t)b * 512 + r) * 256 + c] = p.cwv[((size_t)b * 512 + r + 1) * 256 + c];
}
__global__ void __launch_bounds__(256) k_rms_rows(const float* X, float* rstd, int nrows) {
    const int lane = threadIdx.x & 63, row = blockIdx.x * 4 + (threadIdx.x >> 6);
    if (row >= nrows) return;
    float ss = 0.f;
    for (int i = lane; i < DM; i += 64) { const float v = X[(size_t)row * DM + i]; ss += v * v; }
    ss = wave_sum(ss);
    if (lane == 0) rstd[row] = rsqrtf(ss * (1.f / DM) + EPS);
}
__global__ void __launch_bounds__(256) k_final_norm(Params p) {
    const int lane = threadIdx.x & 63, row = blockIdx.x * 4 + (threadIdx.x >> 6);
    if (row >= NTOK) return;
    float* yr = row < NPT ? p.out + OFF_Y + (size_t)row * DM : p.out + OFF_YS + (size_t)(row - NPT) * DM;
    float ss = 0.f;
    for (int i = lane; i < DM; i += 64) { const float v = yr[i]; ss += v * v; }
    ss = wave_sum(ss);
    const float r = rsqrtf(ss * (1.f / DM) + EPS);
    for (int i = lane; i < DM; i += 64) yr[i] = yr[i] * r * p.norm_f[i];
}

template <class AF, class BF, class EF>
__global__ void __launch_bounds__(256) k_gemm_naive(int m_off, int M, int N, int K, AF af, BF bf, EF ef) {
    __shared__ float As[16][68], Bs[16][68];
    const int tid = threadIdx.x, tx = tid & 15, ty = tid >> 4, m0 = m_off + blockIdx.y * 64, n0 = blockIdx.x * 64;
    float acc[4][4];
#pragma unroll
    for (int i = 0; i < 4; ++i)
#pragma unroll
        for (int j = 0; j < 4; ++j) acc[i][j] = 0.f;
    for (int k0 = 0; k0 < K; k0 += 16) {
#pragma unroll
        for (int i = 0; i < 4; ++i) { const int idx = tid + 256 * i, r = idx >> 4, kk = idx & 15; As[kk][r] = (m0 + r < M) ? af(m0 + r, k0 + kk) : 0.f; }
#pragma unroll
        for (int i = 0; i < 4; ++i) { const int idx = tid + 256 * i, kk = idx >> 6, c = idx & 63; Bs[kk][c] = (n0 + c < N) ? bf(k0 + kk, n0 + c) : 0.f; }
        __syncthreads();
#pragma unroll
        for (int kk = 0; kk < 16; ++kk) {
            float a[4], b[4];
#pragma unroll
            for (int i = 0; i < 4; ++i) { a[i] = As[kk][ty * 4 + i]; b[i] = Bs[kk][tx * 4 + i]; }
#pragma unroll
            for (int i = 0; i < 4; ++i)
#pragma unroll
                for (int j = 0; j < 4; ++j) acc[i][j] += a[i] * b[j];
        }
        __syncthreads();
    }
#pragma unroll
    for (int i = 0; i < 4; ++i)
#pragma unroll
        for (int j = 0; j < 4; ++j) { const int r = m0 + ty * 4 + i, c = n0 + tx * 4 + j; if (r < M && c < N) ef(r, c, acc[i][j]); }
}
struct AF_x_g1 { Params p; __device__ float operator()(int r, int k) const { return xval(p, r, k) * p.norm1_g[k]; } };
struct BF_rowmajor { const float* W; long ld; __device__ float operator()(int k, int n) const { return W[(size_t)k * ld + n]; } };
struct EF_proj { Params p; __device__ void operator()(int r, int n, float acc) const { proj_store(p, r, n, acc * p.RSTD1[r]); } };
struct AF_bf { const bf16_t* A; long ld; __device__ float operator()(int r, int k) const { return bf2f(A[(size_t)r * ld + k]); } };
struct EF_bra { Params p; __device__ void operator()(int r, int n, float acc) const { p.TMP[(size_t)r * DM + n] = acc * bf2f(p.BR[(size_t)r * 4096 + n]); } };
struct EF_brb { Params p; __device__ void operator()(int r, int n, float acc) const { p.MB[(size_t)r * DM + n] = f2bf(p.TMP[(size_t)r * DM + n] + acc * bf2f(p.BR[(size_t)r * 4096 + 2048 + n])); } };
struct EF_wo { Params p; __device__ void operator()(int r, int n, float acc) const { const float x1 = xval(p, r, n) + acc; p.X1[(size_t)r * DM + n] = x1; p.X1B[(size_t)r * DM + n] = f2bf(x1); } };
struct AF_x1_g2 { Params p; __device__ float operator()(int r, int k) const { return bf2f(p.X1B[(size_t)r * DM + k]) * p.norm2_g[k]; } };
struct EF_up { Params p; __device__ void operator()(int r, int n, float acc) const { const float v = fmaxf(acc * p.RSTD2[r], 0.f); p.HF[(size_t)r * DFF + n] = f2bf(v * v); } };
struct EF_down { Params p; __device__ void operator()(int r, int n, float acc) const { const float x2 = p.X1[(size_t)r * DM + n] + acc;
    if (r < NPT) p.out[OFF_Y + (size_t)r * DM + n] = x2; else p.out[OFF_YS + (size_t)(r - NPT) * DM + n] = x2; } };

__global__ void __launch_bounds__(128) k_compress_naive(Params p, int is_s) {
    const int n_cmp = is_s ? 1023 : 127, n_pad = is_s ? 1024 : 128;
    const int kv = blockIdx.y, tid = threadIdx.x;
    const int i = blockIdx.x % n_pad, bg = blockIdx.x / n_pad, b = bg >> 2, g = bg & 3;
    __shared__ float blk[2048]; __shared__ float hid[128];
    if (i >= n_cmp) {
        if (tid < 64) { if (is_s) { (kv ? p.VCMP_S : p.KCMP_S)[((size_t)bg * 1024 + i) * 64 + tid] = 0; }
                        else { if (kv) p.VCMPT_P[((size_t)bg * 64 + tid) * 128 + i] = 0; else p.KCMP_P[((size_t)bg * 128 + i) * 64 + tid] = 0; } }
        return;
    }
    const float* pe = kv ? p.pe_v : p.pe_k; const float* w1 = kv ? p.w1v : p.w1k; const float* w2 = kv ? p.w2v : p.w2k;
    for (int e = tid; e < 2048; e += 128) { const int l = e >> 6, d = e & 63; const int pos = 16 * i + l; float v;
        if (is_s) { const int page = p.page_table[b * NPAGES + (pos >> 7)]; v = (kv ? p.ccv : p.cck)[(((size_t)page * PAGE + (pos & 127)) * 4 + g) * 64 + d]; }
        else v = bf2f(p.KV6[((size_t)b * SEQ + pos) * 1536 + kv * 256 + g * 64 + d]);
        blk[e] = v + pe[e]; }
    __syncthreads();
    float h = 0.f;
    for (int k = 0; k < 2048; ++k) h += blk[k] * w1[(size_t)k * 128 + tid];
    hid[tid] = gelu_tanh(h);
    __syncthreads();
    if (tid < 64) { float o = 0.f; for (int j = 0; j < 128; ++j) o += hid[j] * w2[j * 64 + tid];
        if (is_s) (kv ? p.VCMP_S : p.KCMP_S)[((size_t)bg * 1024 + i) * 64 + tid] = f2bf(o);
        else { if (kv) p.VCMPT_P[((size_t)bg * 64 + tid) * 128 + i] = f2bf(o); else p.KCMP_P[((size_t)bg * 128 + i) * 64 + tid] = f2bf(o); } }
}

struct RowRef { const float* pf; const bf16_t* pb; };
__device__ __forceinline__ float rr_get(const RowRef& r, int d) { return r.pf ? r.pf[d] : bf2f(r.pb[d]); }

template <class KF, class VF>
__device__ __forceinline__ void attend_naive(int nk, KF keyf, VF valf, const float (*q)[64], float (*sc)[1088], float (*oacc)[64], const float* gate3, int gsel, int tid) {
    const int lane = tid & 63, wv = tid >> 6;
    for (int kk = tid; kk < nk; kk += 256) { bool valid; const RowRef r = keyf(kk, valid);
        if (valid) { float d0 = 0.f, d1 = 0.f, d2 = 0.f, d3 = 0.f;
            for (int d = 0; d < 64; ++d) { const float kx = rr_get(r, d); d0 += q[0][d] * kx; d1 += q[1][d] * kx; d2 += q[2][d] * kx; d3 += q[3][d] * kx; }
            sc[0][kk] = d0; sc[1][kk] = d1; sc[2][kk] = d2; sc[3][kk] = d3; }
        else { sc[0][kk] = -INFINITY; sc[1][kk] = -INFINITY; sc[2][kk] = -INFINITY; sc[3][kk] = -INFINITY; } }
    __syncthreads();
    {
        float m = -INFINITY; for (int kk = lane; kk < nk; kk += 64) m = fmaxf(m, sc[wv][kk]);
        m = wave_max(m);
        float s = 0.f;
        for (int kk = lane; kk < nk; kk += 64) { const float x = sc[wv][kk]; const float e = (x == -INFINITY) ? 0.f : __expf(x - m); sc[wv][kk] = e; s += e; }
        s = wave_sum(s);
        const float inv = s > 0.f ? 1.f / s : 0.f;
        for (int kk = lane; kk < nk; kk += 64) sc[wv][kk] *= inv;
    }
    __syncthreads();
    {
        float o = 0.f;
        for (int kk = 0; kk < nk; ++kk) { const float pr = sc[wv][kk]; if (pr != 0.f) o += pr * valf(kk, lane); }
        oacc[wv][lane] += gate3[wv * 3 + gsel] * o;
    }
    __syncthreads();
}

__global__ void __launch_bounds__(256) k_nsa_naive(Params p, int row0) {
    const int row = row0 + blockIdx.x, g = blockIdx.y, tid = threadIdx.x;
    const bool is_s = row >= NPT; const int b = is_s ? row - NPT : row >> 11, t = is_s ? 0 : row & 2047;
    const int start = is_s ? PAST : 0, pos = start + t, rowbase = is_s ? NPT + b : b * SEQ;
    const int n_cmp = is_s ? 1023 : 127, n_slc = is_s ? 257 : 32;
    __shared__ float q[4][64]; __shared__ float sc[4][1088]; __shared__ float oacc[4][64]; __shared__ float gate3[12];
    __shared__ float score[260]; __shared__ int selidx[16];
    { const int hd = tid >> 6, d = tid & 63; q[hd][d] = bf2f(p.QN[(size_t)row * 1024 + (g * 4 + hd) * 64 + d]); oacc[hd][d] = 0.f; }
    if (tid < 12) gate3[tid] = p.GATE[(size_t)row * 48 + g * 12 + tid];
    __syncthreads();
    const int bg = b * 4 + g;
    const bf16_t* kc = is_s ? p.KCMP_S + (size_t)bg * 1024 * 64 : p.KCMP_P + (size_t)bg * 128 * 64;
    const bf16_t* vc_s = p.VCMP_S + (size_t)bg * 1024 * 64; const bf16_t* vc_p = p.VCMPT_P + (size_t)bg * 64 * 128;
    auto kf_c = [&](int kk, bool& valid) { valid = (16 * kk + 31 <= pos); return RowRef{nullptr, kc + (size_t)kk * 64}; };
    auto vf_c = [&](int kk, int d) { return is_s ? bf2f(vc_s[(size_t)kk * 64 + d]) : bf2f(vc_p[(size_t)d * 128 + kk]); };
    attend_naive(n_cmp, kf_c, vf_c, q, sc, oacc, gate3, 0, tid);
    for (int j = tid; j < n_slc; j += 256) { float s = 0.f;
        for (int i = 4 * j - 1; i <= 4 * j + 3; ++i) if (i >= 0 && i < n_cmp) s += (sc[0][i] + sc[1][i]) + (sc[2][i] + sc[3][i]);
        score[j] = (j * 64 <= pos) ? s + ((j == 0 || j == pos / 64) ? 1e4f : 0.f) : -1e30f; }
    __syncthreads();
    for (int j = tid; j < n_slc; j += 256) { const float sj = score[j]; int rank = 0;
        for (int j2 = 0; j2 < n_slc; ++j2) { const float s2 = score[j2]; rank += (s2 > sj || (s2 == sj && j2 < j)) ? 1 : 0; }
        if (rank < 16) selidx[rank] = j; }
    __syncthreads();
    auto row_at = [&](int kp, int which) -> RowRef {
        if (kp < start) {
            if (which < 4) { const int page = p.page_table[b * NPAGES + (kp >> 7)]; const float* c = (which == 2) ? p.csk : p.csv; return RowRef{c + (((size_t)page * PAGE + (kp & 127)) * 4 + g) * 64, nullptr}; }
            const float* c = (which == 4) ? p.cwk : p.cwv; return RowRef{c + (((size_t)b * 512 + (kp - (PAST - 512))) * 4 + g) * 64, nullptr};
        }
        return RowRef{nullptr, p.KV6 + (size_t)(rowbase + kp - start) * 1536 + which * 256 + g * 64};
    };
    auto kf_s = [&](int kk, bool& valid) { const int kp = selidx[kk >> 6] * 64 + (kk & 63); valid = (kp <= pos); return valid ? row_at(kp, 2) : RowRef{nullptr, nullptr}; };
    auto vf_s = [&](int kk, int d) { const int kp = selidx[kk >> 6] * 64 + (kk & 63); return rr_get(row_at(kp, 3), d); };
    attend_naive(1024, kf_s, vf_s, q, sc, oacc, gate3, 1, tid);
    auto kf_w = [&](int kk, bool& valid) { const int kp = pos - 512 + kk; valid = (kp >= 0); return valid ? row_at(kp, 4) : RowRef{nullptr, nullptr}; };
    auto vf_w = [&](int kk, int d) { const int kp = pos - 512 + kk; return rr_get(row_at(kp, 5), d); };
    attend_naive(513, kf_w, vf_w, q, sc, oacc, gate3, 2, tid);
    { const int hd = tid >> 6, d = tid & 63; p.OA[(size_t)row * 1024 + (g * 4 + hd) * 64 + d] = f2bf(oacc[hd][d]); }
}

__global__ void __launch_bounds__(512) k_gla_naive(Params p, int is_s) {
    const int b = blockIdx.x >> 2, h = blockIdx.x & 3, tid = threadIdx.x, e = tid & 255, half = tid >> 8;
    const int T = is_s ? 1 : SEQ, rowbase = is_s ? NPT + b : b * SEQ;
    __shared__ float a_s[128], q_s[128], k_s[128], part[2][256], red[8];
    float S[64];
#pragma unroll
    for (int dd = 0; dd < 64; ++dd) S[dd] = is_s ? p.state[(((size_t)b * 4 + h) * 128 + half * 64 + dd) * 256 + e] : 0.f;
    for (int t = 0; t < T; ++t) {
        const int row = rowbase + t;
        if (tid < 128) { float x = p.b_a[h * 128 + tid];
            for (int r = 0; r < 16; ++r) x += p.LR[(size_t)row * 16 + r] * p.w_a2[r * 512 + h * 128 + tid];
            a_s[tid] = __expf(logsigmoidf_(x) * (1.f / 16.f));
            q_s[tid] = bf2f(p.GQ[(size_t)row * 512 + h * 128 + tid]); k_s[tid] = bf2f(p.GK[(size_t)row * 512 + h * 128 + tid]); }
        const float v = bf2f(p.GV[(size_t)row * 1024 + h * 256 + e]);
        __syncthreads();
        float po = 0.f;
#pragma unroll
        for (int dd = 0; dd < 64; ++dd) { const int d = half * 64 + dd; S[dd] = a_s[d] * S[dd] + k_s[d] * v; po += q_s[d] * S[dd]; }
        part[half][e] = po;
        __syncthreads();
        float o = 0.f;
        if (tid < 256) { o = part[0][e] + part[1][e]; const float ss = wave_sum(o * o); if ((tid & 63) == 0) red[tid >> 6] = ss; }
        __syncthreads();
        if (tid < 256) { const float ss = (red[0] + red[1]) + (red[2] + red[3]); const float r = rsqrtf(ss * (1.f / 256.f) + EPS);
            p.OB[(size_t)row * 1024 + h * 256 + e] = f2bf(o * r * p.gnorm[e] * bf2f(p.GR[(size_t)row * 1024 + h * 256 + e])); }
    }
    float* so = p.out + (is_s ? OFF_SGLA : OFF_PGLA);
#pragma unroll
    for (int dd = 0; dd < 64; ++dd) so[(((size_t)b * 4 + h) * 128 + half * 64 + dd) * 256 + e] = S[dd];
}

#define GAS __attribute__((address_space(1)))
#define LAS __attribute__((address_space(3)))
typedef unsigned v4u __attribute__((ext_vector_type(4)));
typedef unsigned v2u __attribute__((ext_vector_type(2)));
#define LDS_WAIT() asm volatile("s_waitcnt lgkmcnt(0)" ::: "memory")
#define VM_WAIT() asm volatile("s_waitcnt vmcnt(0)" ::: "memory")
__device__ __forceinline__ unsigned pk2(float lo, float hi) { return (unsigned)f2bf(lo) | ((unsigned)f2bf(hi) << 16); }
constexpr int NIN_PAD = 9984;
__host__ __device__ __forceinline__ int in_colmap(int n) {
    if (n < 2560) return n; if (n < 3072) return C_QL + (n - 2560); if (n < 3584) return C_KL + (n - 3072); if (n < 4608) return C_VL + (n - 3584);
    if (n < 5632) return C_RL + (n - 4608); if (n < 9728) return C_BR + (n - 5632); if (n < 9776) return C_G + (n - 9728); if (n < 9792) return C_LR + (n - 9776); return -1;
}
namespace pg8 {
#define PG8_LAS __attribute__((address_space(3)))
typedef unsigned short bf16_t;
typedef short bf16x8 __attribute__((ext_vector_type(8)));
typedef float f32x4 __attribute__((ext_vector_type(4)));
typedef unsigned u32x4 __attribute__((ext_vector_type(4)));
constexpr int BM = 256, BK = 64, HALF = 128, HTB = HALF * BK * 2  , STAGE_BYTES = 8 * HTB, NXCD = 8, WGM = 8;

__host__ __device__ __forceinline__ int lds_byte(int r, int c) { const int st = (r >> 4) * 2 + (c >> 5), rr = r & 15, cc = c & 31, ob = rr * 64 + cc * 2; return st * 1024 + (ob ^ (((ob >> 9) & 1) << 5)); }
__host__ __device__ __forceinline__ void stage_rc(int b, int& R, int& C) { const int st = b / 1024, sb = b % 1024, swz = sb ^ (((sb >> 9) & 1) << 5); R = (st >> 1) * 16 + swz / 64; C = (st & 1) * 32 + (swz % 64) / 2; }
__host__ __device__ __forceinline__ int perm32(int rho) { const int n = rho >> 4, i = rho & 15; return 8 * (i >> 2) + 4 * n + (i & 3); }

struct Unit { int pm, pn; };
struct Gemm { const bf16_t* A; const bf16_t* Bt; int M, N, K; };

struct StaticOrder {
    int nM, nN, nwg, G, c;
    __host__ __device__ void init(int M, int N, int G_, int c_) { nM = M / BM; nN = N / BM; nwg = nM * nN; G = G_; c = c_; }
    __host__ __device__ bool next(int i, Unit& u) const {
        const long L = (long)i * G + c; if (L >= nwg) return false;
        int wgid = (int)L; { const int q = nwg / NXCD, r = nwg % NXCD, xcd = wgid % NXCD, off = wgid / NXCD; wgid = (xcd < r ? xcd * (q + 1) : r * (q + 1) + (xcd - r) * q) + off; }
        const int nig = WGM * nN, gid = wgid / nig, fm = gid * WGM, gsz = (nM - fm) < WGM ? (nM - fm) : WGM;
        u.pm = fm + ((wgid % nig) % gsz); u.pn = (wgid % nig) / gsz; return true;
    }
    __device__ __forceinline__ void a_ready(const Unit&) const {}
    __device__ __forceinline__ void done(const Unit&) const {}
};

template <class Epi, class Sched, bool ALIGN_EPI = false, bool SP2 = false>
__device__ __forceinline__ void gemm_phase(PG8_LAS unsigned char* lds, const Gemm g, const Sched& S, const Epi& E) {
    const int tid = threadIdx.x, wid = __builtin_amdgcn_readfirstlane(tid >> 6), lane = tid & 63, wr = wid >> 2, wc = wid & 3, fr = lane & 15, fq = lane >> 4;
    const int K = g.K, nt = K / BK;
    unsigned voffA[2], voffB[2];
#pragma unroll
    for (int i = 0; i < 2; ++i) { int R, C; stage_rc(tid * 16 + i * 8192, R, C); const int Rb = Epi::PERM ? ((R & ~31) + perm32(R & 31)) : R;
        voffA[i] = (unsigned)(R * K + C) * 2u; voffB[i] = (unsigned)(Rb * K + C) * 2u; }
    const size_t kstep = (size_t)(BK * 2);
    const size_t hstep = (size_t)HALF * K * 2;
    const size_t tstep = 2 * hstep;
    const unsigned ldsw = (unsigned)wid * 1024u;
    const int aoff = lds_byte(wr * 64 + fr, fq * 8), boff = lds_byte(wc * 32 + fr, fq * 8);
#define PG8_SA(b, h) (((b) * 2 + (h)) * HTB)
#define PG8_SB(b, h) ((4 + (b) * 2 + (h)) * HTB)
#define PG8_STAGE(bufoff, gbase, voff) do { _Pragma("unroll") for (int _i = 0; _i < 2; ++_i) \
        __builtin_amdgcn_global_load_lds((const unsigned*)((const char*)(gbase) + (voff)[_i]), (PG8_LAS unsigned*)(lds + (bufoff) + ldsw + _i * 8192), 16, 0, 0); } while (0)
#define PG8_LDA(dst, b, h) do { _Pragma("unroll") for (int m = 0; m < 4; ++m) _Pragma("unroll") for (int k = 0; k < 2; ++k) dst[m][k] = *(const PG8_LAS bf16x8*)(lds + PG8_SA(b, h) + aoff + m * 2048 + k * 1024); } while (0)
#define PG8_LDB(dst, b, h) do { _Pragma("unroll") for (int n = 0; n < 2; ++n) _Pragma("unroll") for (int k = 0; k < 2; ++k) dst[n][k] = *(const PG8_LAS bf16x8*)(lds + PG8_SB(b, h) + boff + n * 2048 + k * 1024); } while (0)
#define PG8_MMA(ai, bj, At, Bt) do { __builtin_amdgcn_s_setprio(1); _Pragma("unroll") for (int m = 0; m < 4; ++m) _Pragma("unroll") for (int n = 0; n < 2; ++n) _Pragma("unroll") for (int k = 0; k < 2; ++k) \
        acc[ai][bj][m][n] = __builtin_amdgcn_mfma_f32_16x16x32_bf16(Bt[n][k], At[m][k], acc[ai][bj][m][n], 0, 0, 0); __builtin_amdgcn_s_setprio(0); } while (0)
#define PG8_WAIT_V(n) asm volatile("s_waitcnt vmcnt(" #n ")" ::: "memory")
#define PG8_WAIT_L(n) asm volatile("s_waitcnt lgkmcnt(" #n ")" ::: "memory")
#define PG8_BAR __builtin_amdgcn_s_barrier()
#define PG8_SCHED __builtin_amdgcn_sched_barrier(0)
    Unit cur, nxt; int ui = 0;
    if (!S.next(0, cur)) return;
    f32x4 acc[2][2][4][2];
#pragma unroll
    for (int a = 0; a < 2; ++a)
#pragma unroll
        for (int b = 0; b < 2; ++b)
#pragma unroll
            for (int m = 0; m < 4; ++m)
#pragma unroll
                for (int n = 0; n < 2; ++n) acc[a][b][m][n] = (f32x4){0.f, 0.f, 0.f, 0.f};
    bf16x8 At[4][2], B0[2][2], B1[2][2];
    const char* cA = (const char*)g.A + (size_t)cur.pm * tstep; const char* cB = (const char*)g.Bt + (size_t)cur.pn * tstep;
    S.a_ready(cur);
    if constexpr (SP2) {
        PG8_STAGE(PG8_SB(0, 0), cB, voffB); PG8_STAGE(PG8_SB(0, 1), cB + hstep, voffB); PG8_STAGE(PG8_SA(0, 0), cA, voffA); PG8_STAGE(PG8_SA(0, 1), cA + hstep, voffA);
        if (wr == 1) PG8_BAR;
        PG8_WAIT_V(2); PG8_BAR;
        PG8_STAGE(PG8_SB(1, 0), cB + kstep, voffB); PG8_STAGE(PG8_SA(1, 0), cA + kstep, voffA); PG8_STAGE(PG8_SB(1, 1), cB + hstep + kstep, voffB);
        PG8_WAIT_V(6); PG8_BAR;
    } else {
        PG8_STAGE(PG8_SB(0, 0), cB, voffB); PG8_STAGE(PG8_SA(0, 0), cA, voffA); PG8_STAGE(PG8_SB(0, 1), cB + hstep, voffB); PG8_STAGE(PG8_SA(0, 1), cA + hstep, voffA);
        if (wr == 1) PG8_BAR;
        PG8_WAIT_V(4); PG8_BAR;
        PG8_STAGE(PG8_SB(1, 0), cB + kstep, voffB); PG8_STAGE(PG8_SA(1, 0), cA + kstep, voffA); PG8_STAGE(PG8_SB(1, 1), cB + hstep + kstep, voffB);
        PG8_WAIT_V(6); PG8_BAR;
    }
    for (;;) {
        const bool has_next = S.next(ui + 1, nxt);
        const char* nA = has_next ? (const char*)g.A + (size_t)nxt.pm * tstep : cA; const char* nB = has_next ? (const char*)g.Bt + (size_t)nxt.pn * tstep : cB;
        for (int t = 0; t < nt; t += 2) {
            const bool last = (t == nt - 2);
            const char* a1 = cA + (size_t)(t + 1) * kstep;
            const char* a2 = last ? nA : cA + (size_t)(t + 2) * kstep; const char* b2 = last ? nB : cB + (size_t)(t + 2) * kstep;
            const char* a3 = a2 + kstep; const char* b3 = b2 + kstep;
            if (last && has_next) S.a_ready(nxt);
            if constexpr (SP2) {
            PG8_LDB(B0, 0, 0); PG8_LDB(B1, 0, 1); PG8_SCHED; PG8_LDA(At, 0, 0); PG8_STAGE(PG8_SA(1, 1), a1 + hstep, voffA);
            PG8_WAIT_V(8); PG8_WAIT_L(0); PG8_BAR; PG8_MMA(0, 0, At, B0); PG8_MMA(0, 1, At, B1); PG8_BAR; PG8_SCHED;
            PG8_LDA(At, 0, 1); PG8_STAGE(PG8_SB(0, 0), b2, voffB); PG8_STAGE(PG8_SB(0, 1), b2 + hstep, voffB); PG8_STAGE(PG8_SA(0, 0), a2, voffA);
            PG8_WAIT_V(8); PG8_WAIT_L(0); PG8_BAR; PG8_MMA(1, 0, At, B0); PG8_MMA(1, 1, At, B1); PG8_BAR; PG8_SCHED;
            PG8_LDB(B0, 1, 0); PG8_LDB(B1, 1, 1); PG8_SCHED; PG8_LDA(At, 1, 0); PG8_STAGE(PG8_SA(0, 1), a2 + hstep, voffA);
            PG8_WAIT_V(8); PG8_WAIT_L(0); PG8_BAR; PG8_MMA(0, 0, At, B0); PG8_MMA(0, 1, At, B1); PG8_BAR; PG8_SCHED;
            PG8_LDA(At, 1, 1); PG8_STAGE(PG8_SB(1, 0), b3, voffB); PG8_STAGE(PG8_SB(1, 1), b3 + hstep, voffB); PG8_STAGE(PG8_SA(1, 0), a3, voffA);
            PG8_WAIT_V(8); PG8_WAIT_L(0); PG8_BAR; PG8_MMA(1, 0, At, B0); PG8_MMA(1, 1, At, B1); PG8_BAR; PG8_SCHED;
            } else {
            PG8_LDB(B0, 0, 0); PG8_SCHED; PG8_LDA(At, 0, 0); PG8_STAGE(PG8_SA(1, 1), a1 + hstep, voffA);
            PG8_WAIT_L(8); PG8_BAR; PG8_WAIT_L(0); PG8_MMA(0, 0, At, B0); PG8_BAR; PG8_SCHED;
            PG8_LDB(B1, 0, 1); PG8_STAGE(PG8_SB(0, 0), b2, voffB);
            PG8_BAR; PG8_WAIT_L(0); PG8_MMA(0, 1, At, B1); PG8_BAR;
            PG8_LDA(At, 0, 1); PG8_STAGE(PG8_SA(0, 0), a2, voffA);
            PG8_BAR; PG8_WAIT_L(0); PG8_MMA(1, 0, At, B0); PG8_BAR; PG8_SCHED;
            PG8_STAGE(PG8_SB(0, 1), b2 + hstep, voffB);
            PG8_WAIT_V(6); PG8_BAR; PG8_MMA(1, 1, At, B1); PG8_BAR;
            PG8_LDB(B0, 1, 0); PG8_SCHED; PG8_LDA(At, 1, 0); PG8_STAGE(PG8_SA(0, 1), a2 + hstep, voffA);
            PG8_WAIT_L(8); PG8_BAR; PG8_WAIT_L(0); PG8_MMA(0, 0, At, B0); PG8_BAR; PG8_SCHED;
            PG8_LDB(B1, 1, 1); PG8_STAGE(PG8_SB(1, 0), b3, voffB);
            PG8_BAR; PG8_WAIT_L(0); PG8_MMA(0, 1, At, B1); PG8_BAR;
            PG8_LDA(At, 1, 1); PG8_STAGE(PG8_SA(1, 0), a3, voffA);
            PG8_BAR; PG8_WAIT_L(0); PG8_MMA(1, 0, At, B0); PG8_BAR; PG8_SCHED;
            PG8_STAGE(PG8_SB(1, 1), b3 + hstep, voffB);
            PG8_WAIT_V(6); PG8_BAR; PG8_MMA(1, 1, At, B1); PG8_BAR;
            }
        }
        if constexpr (ALIGN_EPI) { if (wr == 0) PG8_BAR; }
        if constexpr (!Epi::AFTER_DRAIN) { E(acc, cur, wr, wc, fr, fq); S.done(cur); }
        if (!has_next) break;
#pragma unroll
        for (int a = 0; a < 2; ++a)
#pragma unroll
            for (int b = 0; b < 2; ++b)
#pragma unroll
                for (int m = 0; m < 4; ++m)
#pragma unroll
                    for (int n = 0; n < 2; ++n) acc[a][b][m][n] = (f32x4){0.f, 0.f, 0.f, 0.f};
        cur = nxt; cA = nA; cB = nB; ++ui;
        if constexpr (ALIGN_EPI) { if (wr == 1) PG8_BAR; }
    }
    PG8_WAIT_V(0);
    if constexpr (!ALIGN_EPI) { if (wr == 0) PG8_BAR; }
    PG8_BAR;
    if constexpr (Epi::AFTER_DRAIN) { E.fused(acc, cur, wr, wc, fr, fq, lds, wid, lane); S.done(cur); }
#undef PG8_SA
#undef PG8_SB
#undef PG8_STAGE
#undef PG8_LDA
#undef PG8_LDB
#undef PG8_MMA
#undef PG8_WAIT_V
#undef PG8_WAIT_L
#undef PG8_BAR
#undef PG8_SCHED
}
}
typedef pg8::f32x4 f32x4;
template <class F> struct EpiGen {
    static constexpr bool PERM = false, AFTER_DRAIN = false; F f;
    __device__ __forceinline__ void operator()(const f32x4 (&acc)[2][2][4][2], const pg8::Unit& u, int wr, int wc, int fr, int fq) const {
        const int row0 = u.pm * 256 + wr * 64 + fr, col0 = u.pn * 256 + wc * 32 + 4 * fq;
#pragma unroll
        for (int ai = 0; ai < 2; ++ai)
#pragma unroll
            for (int m = 0; m < 4; ++m) { const int row = row0 + ai * 128 + m * 16; const float ctx = f.row_begin(row); float part = 0.f;
#pragma unroll
                for (int bj = 0; bj < 2; ++bj)
#pragma unroll
                    for (int n = 0; n < 2; ++n) part += f.store4(ctx, row, col0 + bj * 128 + n * 16, acc[ai][bj][m][n]);
                f.row_end(row, part, fq, true); }
    }
};
template <int ACT  >
__device__ __forceinline__ void store_tile_bf16(const f32x4 (&acc)[2][2][4][2], int row0, int col0, const float* rstd, float scale, bf16_t* dst, int ld) {
#pragma unroll
    for (int ai = 0; ai < 2; ++ai)
#pragma unroll
        for (int m = 0; m < 4; ++m) { const int row = row0 + ai * 128 + m * 16; const float rs = rstd[row] * scale; bf16_t* rp = dst + (size_t)row * ld + col0;
#pragma unroll
            for (int bj = 0; bj < 2; ++bj)
#pragma unroll
                for (int n = 0; n < 2; ++n) { f32x4 v = acc[ai][bj][m][n] * rs;
                    if (ACT == 1) { v[0] = siluf_(v[0]); v[1] = siluf_(v[1]); v[2] = siluf_(v[2]); v[3] = siluf_(v[3]); }
                    if (ACT == 2) { v[0] = sigmoidf_(v[0]); v[1] = sigmoidf_(v[1]); v[2] = sigmoidf_(v[2]); v[3] = sigmoidf_(v[3]); }
                    v2u w; w.x = pk2(v[0], v[1]); w.y = pk2(v[2], v[3]); *(v2u*)(rp + bj * 128 + n * 16) = w; } }
}
struct EpiProj {
    static constexpr bool PERM = false, AFTER_DRAIN = false;
    const float* rstd; const float* b_gate; bf16_t *QN, *KV6, *GQ, *GK, *GV, *GR, *BR; float *GATE, *LR, *out;
    __device__ __forceinline__ void operator()(const f32x4 (&acc)[2][2][4][2], const pg8::Unit& u, int wr, int wc, int fr, int fq) const {
        const int row0 = u.pm * 256 + wr * 64 + fr, cl0 = wc * 32 + 4 * fq, pn = u.pn;
        if (pn < 4) store_tile_bf16<0>(acc, row0, pn * 256 + cl0, rstd, 0.125f, QN, 1024);
        else if (pn < 10) { const int j = pn - 4;
            store_tile_bf16<0>(acc, row0, j * 256 + cl0, rstd, 1.f, KV6, 1536);
#pragma unroll
            for (int ai = 0; ai < 2; ++ai)
#pragma unroll
                for (int m = 0; m < 4; ++m) { const int row = row0 + ai * 128 + m * 16; const float rs = rstd[row]; const int b = row >> 11, t = row & 2047;
                    float* rp = nullptr;
                    if (j < 4) rp = out + OFF_PCK + j * SZ_PROW + (size_t)row * 256 + cl0;
                    else if (t >= 1536) rp = out + OFF_PWK + (j - 4) * SZ_PWIN + ((size_t)b * 512 + (t - 1536)) * 256 + cl0;
                    if (rp) {
#pragma unroll
                        for (int bj = 0; bj < 2; ++bj)
#pragma unroll
                            for (int n = 0; n < 2; ++n) *(f32x4*)(rp + bj * 128 + n * 16) = acc[ai][bj][m][n] * rs; } }
        }
        else if (pn < 12) store_tile_bf16<0>(acc, row0, (pn - 10) * 256 + cl0, rstd, 0.08838834764831845f, GQ, 512);
        else if (pn < 14) store_tile_bf16<0>(acc, row0, (pn - 12) * 256 + cl0, rstd, 1.f, GK, 512);
        else if (pn < 18) store_tile_bf16<0>(acc, row0, (pn - 14) * 256 + cl0, rstd, 1.f, GV, 1024);
        else if (pn < 22) store_tile_bf16<1>(acc, row0, (pn - 18) * 256 + cl0, rstd, 1.f, GR, 1024);
        else if (pn < 38) store_tile_bf16<2>(acc, row0, (pn - 22) * 256 + cl0, rstd, 1.f, BR, 4096);
        else if (wc < 2) {
#pragma unroll
            for (int ai = 0; ai < 2; ++ai)
#pragma unroll
                for (int m = 0; m < 4; ++m) { const int row = row0 + ai * 128 + m * 16; const float rs = rstd[row];
#pragma unroll
                    for (int n = 0; n < 2; ++n) { const int cl = cl0 + n * 16; const f32x4 v = acc[ai][0][m][n] * rs;
                        if (cl < 48) { const f32x4 bg = *(const f32x4*)(b_gate + cl); f32x4 o; o[0] = sigmoidf_(v[0] + bg[0]); o[1] = sigmoidf_(v[1] + bg[1]); o[2] = sigmoidf_(v[2] + bg[2]); o[3] = sigmoidf_(v[3] + bg[3]);
                            *(f32x4*)(GATE + (size_t)row * 48 + cl) = o; }
                        else *(f32x4*)(LR + (size_t)row * 16 + (cl - 48)) = v; } }
        }
    }
};
struct F_bra { const bf16_t* BR; float* TMP;
    __device__ __forceinline__ float row_begin(int) const { return 0.f; }
    __device__ __forceinline__ float store4(float, int row, int col, f32x4 v) const { const v2u b = *(const v2u*)(BR + (size_t)row * 4096 + col);
        f32x4 o; o[0] = v[0] * bf2f((bf16_t)(b.x & 0xffff)); o[1] = v[1] * bf2f((bf16_t)(b.x >> 16)); o[2] = v[2] * bf2f((bf16_t)(b.y & 0xffff)); o[3] = v[3] * bf2f((bf16_t)(b.y >> 16));
        *(f32x4*)(TMP + (size_t)row * DM + col) = o; return 0.f; }
    __device__ __forceinline__ void row_end(int, float, int, bool) const {}
};
struct F_brb { const bf16_t* BR; const float* TMP; bf16_t* MB;
    __device__ __forceinline__ float row_begin(int) const { return 0.f; }
    __device__ __forceinline__ float store4(float, int row, int col, f32x4 v) const { const v2u b = *(const v2u*)(BR + (size_t)row * 4096 + 2048 + col); const f32x4 t = *(const f32x4*)(TMP + (size_t)row * DM + col);
        const float o0 = t[0] + v[0] * bf2f((bf16_t)(b.x & 0xffff)), o1 = t[1] + v[1] * bf2f((bf16_t)(b.x >> 16)), o2 = t[2] + v[2] * bf2f((bf16_t)(b.y & 0xffff)), o3 = t[3] + v[3] * bf2f((bf16_t)(b.y >> 16));
        v2u w; w.x = pk2(o0, o1); w.y = pk2(o2, o3); *(v2u*)(MB + (size_t)row * DM + col) = w; return 0.f; }
    __device__ __forceinline__ void row_end(int, float, int, bool) const {}
};
struct F_wo { const float* x; float* X1; bf16_t* X1B; float* SUMSQ;
    __device__ __forceinline__ float row_begin(int) const { return 0.f; }
    __device__ __forceinline__ float store4(float, int row, int col, f32x4 v) const { const f32x4 xv = *(const f32x4*)(x + (size_t)row * DM + col); const f32x4 x1 = xv + v;
        *(f32x4*)(X1 + (size_t)row * DM + col) = x1; v2u w; w.x = pk2(x1[0], x1[1]); w.y = pk2(x1[2], x1[3]); *(v2u*)(X1B + (size_t)row * DM + col) = w;
        return (x1[0] * x1[0] + x1[1] * x1[1]) + (x1[2] * x1[2] + x1[3] * x1[3]); }
    __device__ __forceinline__ void row_end(int row, float part, int fq, bool valid) const { part += __shfl_xor(part, 16); part += __shfl_xor(part, 32); if (fq == 0 && valid) atomicAdd(SUMSQ + row, part); }
};
struct F_up { const float* SUMSQ; bf16_t* HF;
    __device__ __forceinline__ float row_begin(int row) const { return rsqrtf(SUMSQ[row] * (1.f / DM) + EPS); }
    __device__ __forceinline__ float store4(float rs, int row, int col, f32x4 v) const { float h[4];
#pragma unroll
        for (int i = 0; i < 4; ++i) { const float t = fmaxf(v[i] * rs, 0.f); h[i] = t * t; }
        v2u w; w.x = pk2(h[0], h[1]); w.y = pk2(h[2], h[3]); *(v2u*)(HF + (size_t)row * DFF + col) = w; return 0.f; }
    __device__ __forceinline__ void row_end(int, float, int, bool) const {}
};
struct F_down { const float* X1; float* Y; float* SUMSQ;
    __device__ __forceinline__ float row_begin(int) const { return 0.f; }
    __device__ __forceinline__ float store4(float, int row, int col, f32x4 v) const { const f32x4 x1 = *(const f32x4*)(X1 + (size_t)row * DM + col); const f32x4 x2 = x1 + v;
        *(f32x4*)(Y + (size_t)row * DM + col) = x2; return (x2[0] * x2[0] + x2[1] * x2[1]) + (x2[2] * x2[2] + x2[3] * x2[3]); }
    __device__ __forceinline__ void row_end(int row, float part, int fq, bool valid) const { part += __shfl_xor(part, 16); part += __shfl_xor(part, 32); if (fq == 0 && valid) atomicAdd(SUMSQ + row, part); }
};

typedef short bf16x8_t __attribute__((ext_vector_type(8)));
template <class F>
__device__ __forceinline__ void skinny_gemm(LAS unsigned char* lds, const bf16_t* A, int lda, const bf16_t* Bt, int N, int K, const F& f, int bid, int G, int tid) {
    const int lane = tid & 63, wave = __builtin_amdgcn_readfirstlane(tid >> 6), j = lane & 15, g = lane >> 4;
    LAS f32x4* red = (LAS f32x4*)lds;
    const int ksl = K >> 3;
    for (int it = bid; it < (N >> 4); it += G) {
        const int n0 = it * 16;
        const bf16_t* bp = Bt + (size_t)(n0 + j) * K + wave * ksl + 8 * g;
        const bf16_t* ap = A + (size_t)(j & 7) * lda + wave * ksl + 8 * g;
        f32x4 acc = {0.f, 0.f, 0.f, 0.f};
#pragma unroll 4
        for (int k = 0; k < ksl; k += 32) {
            const bf16x8_t b = *(const bf16x8_t*)(bp + k); bf16x8_t a = *(const bf16x8_t*)(ap + k);
            if (j >= 8) a = (bf16x8_t){0, 0, 0, 0, 0, 0, 0, 0};
            acc = __builtin_amdgcn_mfma_f32_16x16x32_bf16(b, a, acc, 0, 0, 0);
        }
        red[wave * 64 + lane] = acc;
        __syncthreads();
        if (wave == 0) { f32x4 sacc = red[lane];
#pragma unroll
            for (int w = 1; w < 8; ++w) sacc = sacc + red[w * 64 + lane];
            const int row = NPT + (j & 7); const bool valid = j < 8; const float ctx = f.row_begin(row); float part = 0.f;
            if (valid) part = f.store4(ctx, row, n0 + 4 * g, sacc);
            f.row_end(row, part, g, valid); }
        __syncthreads();
    }
}
struct F_proj_s { const Params& p;
    __device__ __forceinline__ float row_begin(int row) const { return p.RSTD1[row]; }
    __device__ __forceinline__ float store4(float rs, int row, int col, f32x4 v) const { const int n0 = in_colmap(col); if (n0 >= 0) {
#pragma unroll
        for (int i = 0; i < 4; ++i) proj_store(p, row, n0 + i, v[i] * rs); } return 0.f; }
    __device__ __forceinline__ void row_end(int, float, int, bool) const {}
};

template <class CM>
__device__ __forceinline__ void transpose_item(const float* W, int ldw, const float* kscale, bf16_t* WT, int K, int item, int nblk, CM cm, LAS float* scr, int lane) {
    const int kb = item / nblk, nb = item % nblk, k0 = 64 * kb, n0 = 32 * nb;
    const int sc = cm(n0 + (lane & 31));
#pragma unroll 8
    for (int i = 0; i < 32; ++i) { const int kk = 2 * i + (lane >> 5); float v = sc >= 0 ? W[(size_t)(k0 + kk) * ldw + sc] : 0.f; if (kscale) v *= kscale[k0 + kk]; scr[kk * 33 + (lane & 31)] = v; }
    LDS_WAIT(); asm volatile("" ::: "memory");
    const int c = lane & 7;
#pragma unroll
    for (int j = 0; j < 4; ++j) { const int n = (lane >> 3) + 8 * j; const LAS float* s = scr + (8 * c) * 33 + n;
        v4u o; o.x = pk2(s[0 * 33], s[1 * 33]); o.y = pk2(s[2 * 33], s[3 * 33]); o.z = pk2(s[4 * 33], s[5 * 33]); o.w = pk2(s[6 * 33], s[7 * 33]);
        *(v4u*)(WT + (size_t)(n0 + n) * K + k0 + 8 * c) = o; }
    LDS_WAIT(); asm volatile("" ::: "memory");
}
struct CM_id { __device__ __forceinline__ int operator()(int n) const { return n; } };
struct CM_in { __device__ __forceinline__ int operator()(int n) const { return in_colmap(n); } };

__device__ __forceinline__ void ph_prologue(const Params& p, LAS unsigned char* lds, int bid, int G, int tid) {
    const int lane = tid & 63, wave = tid >> 6, gw = bid * 8 + wave, NGW = G * 8;
    LAS float* scr = (LAS float*)(lds + wave * 16384);
    constexpr int I_IN = 32 * (NIN_PAD / 32), I_BR = 16 * 64, I_O = 32 * 64, I_UP = 32 * 256, I_DN = 128 * 64;
    constexpr int TOTAL = I_IN + 2 * I_BR + I_O + I_UP + I_DN;
    for (int it = gw; it < TOTAL; it += NGW) { int r = it;
        if (r < I_IN) { transpose_item(p.w_in, DIN, p.norm1_g, p.WIN_T, DM, r, NIN_PAD / 32, CM_in{}, scr, lane); continue; } r -= I_IN;
        if (r < I_BR) { transpose_item(p.w_br_a, DM, nullptr, p.WBRA_T, 1024, r, 64, CM_id{}, scr, lane); continue; } r -= I_BR;
        if (r < I_BR) { transpose_item(p.w_br_b, DM, nullptr, p.WBRB_T, 1024, r, 64, CM_id{}, scr, lane); continue; } r -= I_BR;
        if (r < I_O) { transpose_item(p.w_o, DM, nullptr, p.WO_T, DM, r, 64, CM_id{}, scr, lane); continue; } r -= I_O;
        if (r < I_UP) { transpose_item(p.w_up, DFF, p.norm2_g, p.WUP_T, DM, r, 256, CM_id{}, scr, lane); continue; } r -= I_UP;
        transpose_item(p.w_down, DM, nullptr, p.WDN_T, DFF, r, 64, CM_id{}, scr, lane);
    }
    for (int row = gw; row < NTOK; row += NGW) {
        const f32x4* xr = (const f32x4*)(row < NPT ? p.x_prompt + (size_t)row * DM : p.x_sample + (size_t)(row - NPT) * DM) + lane;
        f32x4 v[8]; float ss = 0.f;
#pragma unroll
        for (int j = 0; j < 8; ++j) { v[j] = xr[64 * j]; ss += (v[j][0] * v[j][0] + v[j][1] * v[j][1]) + (v[j][2] * v[j][2] + v[j][3] * v[j][3]); }
        ss = wave_sum(ss);
        v2u* o = (v2u*)(p.XB + (size_t)row * DM) + lane;
#pragma unroll
        for (int j = 0; j < 8; ++j) { v2u w; w.x = pk2(v[j][0], v[j][1]); w.y = pk2(v[j][2], v[j][3]); o[64 * j] = w; }
        if (lane == 0) p.RSTD1[row] = rsqrtf(ss * (1.f / DM) + EPS);
    }
    for (int i = bid * 512 + tid; i < NTOK; i += G * 512) { p.SUMSQ2[i] = 0.f; p.SUMSQ3[i] = 0.f; }
    for (int i = bid * 512 + tid; i < DB * 511 * 64; i += G * 512) { const int c4 = i & 63, r = (i >> 6) % 511, b = (i >> 6) / 511;
        const size_t so = ((size_t)b * 512 + r + 1) * 256 + c4 * 4, dofs = ((size_t)b * 512 + r) * 256 + c4 * 4;
        *(f32x4*)(p.out + OFF_SWK + dofs) = *(const f32x4*)(p.cwk + so); *(f32x4*)(p.out + OFF_SWK + SZ_SWIN + dofs) = *(const f32x4*)(p.cwv + so); }
}
__device__ __forceinline__ void ph_final_norm(const Params& p, int bid, int G, int tid) {
    const int lane = tid & 63, wave = tid >> 6, gw = bid * 8 + wave, NGW = G * 8;
    for (int row = gw; row < NTOK; row += NGW) {
        float* yr = row < NPT ? p.out + OFF_Y + (size_t)row * DM : p.out + OFF_YS + (size_t)(row - NPT) * DM;
        const float r = rsqrtf(p.SUMSQ3[row] * (1.f / DM) + EPS);
        f32x4* y4 = (f32x4*)yr + lane; const f32x4* g4 = (const f32x4*)p.norm_f + lane;
#pragma unroll
        for (int j = 0; j < 8; ++j) { f32x4 v = y4[64 * j]; const f32x4 g = g4[64 * j]; v = v * r * g; y4[64 * j] = v; }
    }
}

#define XB_TMO      128
#define XB_XCNT(j)  (256  + 64 * (j))
#define XB_XSUB(j)  (1280 + 64 * (j))
#define XB_XGEN(j)  (2304 + 64 * (j))
#define XB_TOP      3328
#define XB_TOPGEN   3392
#define XCD_BAR_WORDS 3456
#define XB_SPIN_CAP (1u << 22)

__device__ __forceinline__ unsigned xb_ld(unsigned* p)              { return __hip_atomic_load(p, __ATOMIC_RELAXED, __HIP_MEMORY_SCOPE_AGENT); }
__device__ __forceinline__ unsigned xb_add(unsigned* p, unsigned v) { return __hip_atomic_fetch_add(p, v, __ATOMIC_RELAXED, __HIP_MEMORY_SCOPE_AGENT); }
__device__ __forceinline__ unsigned xb_xcc_id() { return (unsigned)__builtin_amdgcn_s_getreg((3 << 11) | 20) & 0xFu; }
#define XB_SPIN(cond, bar) do { unsigned _sp = 0; while (cond) { __builtin_amdgcn_s_sleep(1); \
    if ((++_sp & 255u) == 0u) { if (xb_ld(&(bar)[XB_TMO])) break; if (_sp > XB_SPIN_CAP) { atomicAdd(&(bar)[XB_TMO], 1u); break; } } } } while (0)

struct XcdBarrier {
    unsigned* bar; unsigned x;
    volatile LAS unsigned* st;
};

__device__ __forceinline__ XcdBarrier xcd_barrier_post(unsigned* bar, volatile LAS unsigned* st) {
    XcdBarrier b; b.bar = bar; b.x = xb_xcc_id(); b.st = st;
    if (threadIdx.x == 0) (void)xb_add(&bar[XB_XCNT(b.x)], 1u);
    return b;
}
__device__ __forceinline__ void xcd_barrier_complete(unsigned* bar, unsigned x, unsigned& nloc, unsigned& nx) {
    const unsigned G = gridDim.x * gridDim.y * gridDim.z;
    unsigned sum, cnt, mine, sp = 0u;
    for (;;) {
        sum = 0u; cnt = 0u; mine = 0u;
#pragma unroll
        for (unsigned j = 0; j < 16; ++j) { const unsigned c = xb_ld(&bar[XB_XCNT(j)]); sum += c; cnt += (c > 0u) ? 1u : 0u; mine = (j == x) ? c : mine; }
        if (sum == G) break;
        __builtin_amdgcn_s_sleep(1);
        if ((++sp & 255u) == 0u) { if (xb_ld(&bar[XB_TMO])) break; if (sp > XB_SPIN_CAP) { atomicAdd(&bar[XB_TMO], 1u); break; } }
    }
    nloc = mine > 0u ? mine : 1u; nx = cnt > 0u ? cnt : 1u;
}

__device__ __forceinline__ void xcd_barrier(const XcdBarrier& b) {
    asm volatile("s_waitcnt vmcnt(0)" ::: "memory");
    __syncthreads();
    if (threadIdx.x == 0) {
        unsigned* bar = b.bar;
        __builtin_amdgcn_s_waitcnt(0);
        unsigned nloc = b.st[0], nx = b.st[1];
        if (nloc == 0u) { xcd_barrier_complete(bar, b.x, nloc, nx); b.st[0] = nloc; b.st[1] = nx; }
        const unsigned old = xb_add(&bar[XB_XSUB(b.x)], 1u);
        const unsigned gen = old / nloc;
        if (old + 1u == (gen + 1u) * nloc) {
            __builtin_amdgcn_fence(__ATOMIC_RELEASE, "agent");
            asm volatile("s_waitcnt vmcnt(0)" ::: "memory");
            const unsigned og = xb_add(&bar[XB_TOP], 1u);
            const unsigned tg = og / nx;
            if (og + 1u == (tg + 1u) * nx) xb_add(&bar[XB_TOPGEN], 1u);
            else XB_SPIN(xb_ld(&bar[XB_TOPGEN]) == tg, bar);
            __builtin_amdgcn_fence(__ATOMIC_ACQUIRE, "agent");
            xb_add(&bar[XB_XGEN(b.x)], 1u);
            asm volatile("s_waitcnt vmcnt(0)" ::: "memory");
        } else {
            XB_SPIN(xb_ld(&bar[XB_XGEN(b.x)]) == gen, bar);
            __builtin_amdgcn_fence(__ATOMIC_ACQUIRE, "agent");
            asm volatile("s_waitcnt vmcnt(0)" ::: "memory");
        }
    }
    __syncthreads();
}

constexpr int LDS_BYTES = 147456;
constexpr int LDSCTL_OFF = 131072, MISC_OFF = LDSCTL_OFF + 320;
constexpr int CW_BAR = 4096;
enum Phase { PH_PRO = 0, PH_IN = 1, PH_BRA = 4, PH_BRB = 5, PH_WO = 6, PH_UP = 7, PH_DOWN = 8, PH_NORM = 9, PH_END = 10 };
__global__ void __launch_bounds__(512, 2) mk_fwd(Params p, int ph_lo, int ph_hi, int li) {
    extern __shared__ __attribute__((aligned(16))) unsigned char lds_raw[];
    LAS unsigned char* lds = (LAS unsigned char*)lds_raw;
    const int tid = threadIdx.x, bid = blockIdx.x, G = gridDim.x;
    for (int u = tid; u < (LDS_BYTES - LDSCTL_OFF) / 4; u += 512) ((LAS unsigned*)(lds + LDSCTL_OFF))[u] = 0u;
    __syncthreads();
    XcdBarrier bar; bar.bar = p.CTL + CW_BAR + li * XCD_BAR_WORDS; bar.x = 0; bar.st = nullptr;
    if (ph_hi - ph_lo > 1) bar = xcd_barrier_post(p.CTL + CW_BAR + li * XCD_BAR_WORDS, (volatile LAS unsigned*)(lds + MISC_OFF) + 8);
#define IN(k) (ph_lo <= (k) && (k) < ph_hi)
#define SEAM(k) do { if (ph_lo <= (k) && (k) + 1 < ph_hi) xcd_barrier(bar); } while (0)
    if (IN(PH_PRO)) { ph_prologue(p, lds, bid, G, tid); SEAM(PH_PRO); }
    if (IN(PH_IN)) { { pg8::Gemm g{p.XB, p.WIN_T, NPT, NIN_PAD, DM}; pg8::StaticOrder S; S.init(NPT, NIN_PAD, G, bid);
          EpiProj E{p.RSTD1, p.b_gate, p.QN, p.KV6, p.GQ, p.GK, p.GV, p.GR, p.BR, p.GATE, p.LR, p.out};
          pg8::gemm_phase<EpiProj, pg8::StaticOrder, true, true>(lds, g, S, E); }
        skinny_gemm(lds, p.XB + (size_t)NPT * DM, DM, p.WIN_T, NIN_PAD, DM, F_proj_s{p}, bid, G, tid); SEAM(PH_IN); }
    if (IN(PH_BRA)) { const F_bra f{p.BR, p.TMP};
        { pg8::Gemm g{p.OA, p.WBRA_T, NPT, DM, 1024}; pg8::StaticOrder S; S.init(NPT, DM, G, bid); EpiGen<F_bra> E{f}; pg8::gemm_phase<EpiGen<F_bra>, pg8::StaticOrder, true, true>(lds, g, S, E); }
        skinny_gemm(lds, p.OA + (size_t)NPT * 1024, 1024, p.WBRA_T, DM, 1024, f, bid, G, tid); SEAM(PH_BRA); }
    if (IN(PH_BRB)) { const F_brb f{p.BR, p.TMP, p.MB};
        { pg8::Gemm g{p.OB, p.WBRB_T, NPT, DM, 1024}; pg8::StaticOrder S; S.init(NPT, DM, G, bid); EpiGen<F_brb> E{f}; pg8::gemm_phase<EpiGen<F_brb>, pg8::StaticOrder, true, true>(lds, g, S, E); }
        skinny_gemm(lds, p.OB + (size_t)NPT * 1024, 1024, p.WBRB_T, DM, 1024, f, bid, G, tid); SEAM(PH_BRB); }
    if (IN(PH_WO)) {
        { const F_wo f{p.x_prompt, p.X1, p.X1B, p.SUMSQ2}; pg8::Gemm g{p.MB, p.WO_T, NPT, DM, DM}; pg8::StaticOrder S; S.init(NPT, DM, G, bid); EpiGen<F_wo> E{f}; pg8::gemm_phase<EpiGen<F_wo>, pg8::StaticOrder, true, true>(lds, g, S, E); }
        { const F_wo f{p.x_sample - (size_t)NPT * DM, p.X1, p.X1B, p.SUMSQ2}; skinny_gemm(lds, p.MB + (size_t)NPT * DM, DM, p.WO_T, DM, DM, f, bid, G, tid); } SEAM(PH_WO); }
    if (IN(PH_UP)) { const F_up f{p.SUMSQ2, p.HF};
        { pg8::Gemm g{p.X1B, p.WUP_T, NPT, DFF, DM}; pg8::StaticOrder S; S.init(NPT, DFF, G, bid); EpiGen<F_up> E{f}; pg8::gemm_phase<EpiGen<F_up>, pg8::StaticOrder, true, true>(lds, g, S, E); }
        skinny_gemm(lds, p.X1B + (size_t)NPT * DM, DM, p.WUP_T, DFF, DM, f, bid, G, tid); SEAM(PH_UP); }
    if (IN(PH_DOWN)) {
        { const F_down f{p.X1, p.out + OFF_Y, p.SUMSQ3}; pg8::Gemm g{p.HF, p.WDN_T, NPT, DM, DFF}; pg8::StaticOrder S; S.init(NPT, DM, G, bid); EpiGen<F_down> E{f}; pg8::gemm_phase<EpiGen<F_down>, pg8::StaticOrder, true, true>(lds, g, S, E); }
        { const F_down f{p.X1, p.out + OFF_YS - (size_t)NPT * DM, p.SUMSQ3}; skinny_gemm(lds, p.HF + (size_t)NPT * DFF, DFF, p.WDN_T, DM, DFF, f, bid, G, tid); } SEAM(PH_DOWN); }
    if (IN(PH_NORM)) ph_final_norm(p, bid, G, tid);
#undef IN
#undef SEAM
}
__global__ void __launch_bounds__(256) k_sumsq_rows(const float* X, size_t ld, float* ss_out, int nrows) {
    const int lane = threadIdx.x & 63, row = blockIdx.x * 4 + (threadIdx.x >> 6);
    if (row >= nrows) return;
    float ss = 0.f;
    for (int i = lane; i < DM; i += 64) { const float v = X[(size_t)row * ld + i]; ss += v * v; }
    ss = wave_sum(ss);
    if (lane == 0) ss_out[row] = ss;
}
struct EF_up2 { Params p; __device__ void operator()(int r, int n, float acc) const { const float v = fmaxf(acc * rsqrtf(p.SUMSQ2[r] * (1.f / DM) + EPS), 0.f); p.HF[(size_t)r * DFF + n] = f2bf(v * v); } };

static inline size_t align_up(size_t x) { return (x + 255) & ~(size_t)255; }

extern "C" void kernel_launch(void* const* d_in, const int* in_sizes, int n_in, void* d_out, int out_size, void* d_ws, size_t ws_size, hipStream_t stream) {
    if (n_in != 29 || out_size != (int)OUT_TOTAL) { fprintf(stderr, "kernel_launch: unexpected n_in %d / out_size %d\n", n_in, out_size); return; }
    static int grid = 0;
    if (grid == 0) {
        int dev = 0, cus = 0, per_cu = 0;
        if (hipGetDevice(&dev) != hipSuccess || hipDeviceGetAttribute(&cus, hipDeviceAttributeMultiprocessorCount, dev) != hipSuccess) { fprintf(stderr, "kernel_launch: device query failed\n"); grid = -1; return; }
        if (hipFuncSetAttribute((const void*)mk_fwd, hipFuncAttributeMaxDynamicSharedMemorySize, LDS_BYTES) != hipSuccess) { fprintf(stderr, "kernel_launch: hipFuncSetAttribute failed\n"); grid = -1; return; }
        if (hipOccupancyMaxActiveBlocksPerMultiprocessor(&per_cu, (const void*)mk_fwd, 512, LDS_BYTES) != hipSuccess || per_cu < 1) { fprintf(stderr, "kernel_launch: occupancy query says %d\n", per_cu); per_cu = 1; }
        (void)hipGetLastError();
        grid = cus;
    }
    if (grid < 0) return;
    Params p{};
    p.x_prompt = (const float*)d_in[0]; p.x_sample = (const float*)d_in[1]; p.cck = (const float*)d_in[2]; p.ccv = (const float*)d_in[3];
    p.csk = (const float*)d_in[4]; p.csv = (const float*)d_in[5]; p.cwk = (const float*)d_in[6]; p.cwv = (const float*)d_in[7]; p.state = (const float*)d_in[8];
    p.page_table = (const int*)d_in[9]; p.norm1_g = (const float*)d_in[10]; p.w_in = (const float*)d_in[11]; p.b_gate = (const float*)d_in[12];
    p.pe_k = (const float*)d_in[13]; p.pe_v = (const float*)d_in[14]; p.w1k = (const float*)d_in[15]; p.w2k = (const float*)d_in[16]; p.w1v = (const float*)d_in[17]; p.w2v = (const float*)d_in[18];
    p.w_a2 = (const float*)d_in[19]; p.b_a = (const float*)d_in[20]; p.gnorm = (const float*)d_in[21]; p.w_br_a = (const float*)d_in[22]; p.w_br_b = (const float*)d_in[23];
    p.w_o = (const float*)d_in[24]; p.norm2_g = (const float*)d_in[25]; p.w_up = (const float*)d_in[26]; p.w_down = (const float*)d_in[27]; p.norm_f = (const float*)d_in[28];
    p.out = (float*)d_out;
    char* ws = (char*)d_ws; size_t off = 0;
    auto take = [&](size_t bytes) { char* r = ws + off; off = align_up(off + bytes); return r; };
    p.CTL = (unsigned*)take(1 << 20);
    p.XB = (bf16_t*)take((size_t)NTOK * DM * 2); p.RSTD1 = (float*)take(NTOK * 4); p.QN = (bf16_t*)take((size_t)NTOK * 1024 * 2); p.KV6 = (bf16_t*)take((size_t)NTOK * 1536 * 2);
    p.GATE = (float*)take((size_t)NTOK * 48 * 4); p.GQ = (bf16_t*)take((size_t)NTOK * 512 * 2); p.GK = (bf16_t*)take((size_t)NTOK * 512 * 2); p.GV = (bf16_t*)take((size_t)NTOK * 1024 * 2);
    p.GR = (bf16_t*)take((size_t)NTOK * 1024 * 2); p.LR = (float*)take((size_t)NTOK * 16 * 4); p.BR = (bf16_t*)take((size_t)NTOK * 4096 * 2);
    p.KCMP_P = (bf16_t*)take(16 * 128 * 64 * 2); p.VCMPT_P = (bf16_t*)take(16 * 128 * 64 * 2); p.KCMP_S = (bf16_t*)take(32 * 1024 * 64 * 2); p.VCMP_S = (bf16_t*)take(32 * 1024 * 64 * 2);
    p.OA = (bf16_t*)take((size_t)NTOK * 1024 * 2); p.OB = (bf16_t*)take((size_t)NTOK * 1024 * 2); p.TMP = (float*)take((size_t)NTOK * DM * 4); p.MB = (bf16_t*)take((size_t)NTOK * DM * 2);
    p.X1 = (float*)take((size_t)NTOK * DM * 4); p.X1B = (bf16_t*)take((size_t)NTOK * DM * 2); p.RSTD2 = (float*)take(NTOK * 4); p.HF = (bf16_t*)take((size_t)NTOK * DFF * 2);
    p.WIN_T = (bf16_t*)take((size_t)NIN_PAD * DM * 2); p.WBRA_T = (bf16_t*)take((size_t)DM * 1024 * 2); p.WBRB_T = (bf16_t*)take((size_t)DM * 1024 * 2); p.WO_T = (bf16_t*)take((size_t)DM * DM * 2);
    p.WUP_T = (bf16_t*)take((size_t)DFF * DM * 2); p.WDN_T = (bf16_t*)take((size_t)DM * DFF * 2); p.SUMSQ2 = (float*)take(NTOK * 4); p.SUMSQ3 = (float*)take(NTOK * 4);
    if (off > ws_size) { fprintf(stderr, "kernel_launch: workspace too small: need %zu have %zu\n", off, ws_size); return; }
    hipMemsetAsync(p.CTL, 0, 1 << 20, stream);
#define MK(lo, hi, li) hipLaunchKernelGGL(mk_fwd, dim3(grid), dim3(512), LDS_BYTES, stream, p, (int)(lo), (int)(hi), (int)(li))
    MK(PH_PRO, PH_IN + 1, 0);
    k_compress_naive<<<dim3(16 * 128, 2), 128, 0, stream>>>(p, 0);
    k_compress_naive<<<dim3(32 * 1024, 2), 128, 0, stream>>>(p, 1);
    k_nsa_naive<<<dim3(NTOK, 4), 256, 0, stream>>>(p, 0);
    k_gla_naive<<<16, 512, 0, stream>>>(p, 0);
    k_gla_naive<<<32, 512, 0, stream>>>(p, 1);
    MK(PH_BRA, PH_END, 1);
}
```

```cpp
#include <hip/hip_runtime.h>
#include <stdint.h>
#include <cstdio>

typedef unsigned short bf16_t;

constexpr int DM = 2048, NB = 4, SEQ = 2048, NPT = NB * SEQ, DB = 8, NTOK = NPT + DB;
constexpr int PAST = 16384, PAGE = 128, NPAGES = 128;
constexpr int NG = 4, HPG = 4, DH = 64;
constexpr int DIN = 9792, DFF = 8192;
constexpr int C_Q = 0, C_KV = 1024, C_G = 2560, C_QL = 2608, C_KL = 3120, C_VL = 3632, C_RL = 4656, C_LR = 5680, C_BR = 5696;
constexpr float EPS = 1e-6f;
constexpr size_t OFF_Y = 0, OFF_YS = (size_t)NPT * DM, OFF_PCK = OFF_YS + (size_t)DB * DM;
constexpr size_t SZ_PROW = (size_t)NPT * 256;
constexpr size_t OFF_PWK = OFF_PCK + 4 * SZ_PROW, SZ_PWIN = (size_t)NB * 512 * 256;
constexpr size_t OFF_PGLA = OFF_PWK + 2 * SZ_PWIN, SZ_PGLA = (size_t)NB * 4 * 128 * 256;
constexpr size_t OFF_SCK = OFF_PGLA + SZ_PGLA, SZ_SROW = (size_t)DB * 256;
constexpr size_t OFF_SWK = OFF_SCK + 4 * SZ_SROW, SZ_SWIN = (size_t)DB * 512 * 256;
constexpr size_t OFF_SGLA = OFF_SWK + 2 * SZ_SWIN, SZ_SGLA = (size_t)DB * 4 * 128 * 256;
constexpr size_t OUT_TOTAL = OFF_SGLA + SZ_SGLA;
static_assert(OUT_TOTAL == 29908992, "output size");

__device__ __forceinline__ bf16_t f2bf(float f) { unsigned u = __builtin_bit_cast(unsigned, f); return (bf16_t)((u + 0x7fffu + ((u >> 16) & 1u)) >> 16); }
__device__ __forceinline__ float bf2f(bf16_t h) { return __builtin_bit_cast(float, (unsigned)h << 16); }
__device__ __forceinline__ float sigmoidf_(float x) { return 1.f / (1.f + __expf(-x)); }
__device__ __forceinline__ float siluf_(float x) { return x / (1.f + __expf(-x)); }
__device__ __forceinline__ float gelu_tanh(float x) { const float u = 0.7978845608028654f * (x + 0.044715f * x * x * x); return 0.5f * x * (1.f + tanhf(u)); }
__device__ __forceinline__ float logsigmoidf_(float x) { return fminf(x, 0.f) - log1pf(__expf(-fabsf(x))); }
__device__ __forceinline__ float wave_sum(float v) {
#pragma unroll
    for (int o = 1; o < 64; o <<= 1) v += __shfl_xor(v, o);
    return v;
}
__device__ __forceinline__ float wave_max(float v) {
#pragma unroll
    for (int o = 1; o < 64; o <<= 1) v = fmaxf(v, __shfl_xor(v, o));
    return v;
}

struct Params {
    const float *x_prompt, *x_sample, *cck, *ccv, *csk, *csv, *cwk, *cwv, *state;
    const int* page_table;
    const float *norm1_g, *w_in, *b_gate, *pe_k, *pe_v, *w1k, *w2k, *w1v, *w2v, *w_a2, *b_a, *gnorm, *w_br_a, *w_br_b, *w_o, *norm2_g, *w_up, *w_down, *norm_f;
    float* out;
    bf16_t *XB, *QN, *KV6, *GQ, *GK, *GV, *GR, *BR, *KCMP_P, *VCMPT_P, *KCMP_S, *VCMP_S, *OA, *OB, *MB, *X1B, *HF;
    float *RSTD1, *GATE, *LR, *TMP, *X1, *RSTD2;
    bf16_t *WIN_T, *WBRA_T, *WBRB_T, *WO_T, *WUP_T, *WDN_T;
    float *SUMSQ2, *SUMSQ3;
    unsigned* CTL;
    bf16_t* W1T; float *BIAS1, *AB_S, *AB_P;
};

__device__ __forceinline__ float xval(const Params& p, int row, int n) { return row < NPT ? p.x_prompt[(size_t)row * DM + n] : p.x_sample[(size_t)(row - NPT) * DM + n]; }

__device__ __forceinline__ void proj_store(const Params& p, int row, int n, float v) {
    if (n < C_KV) p.QN[(size_t)row * 1024 + n] = f2bf(v * 0.125f);
    else if (n < C_G) {
        const int c = n - C_KV; p.KV6[(size_t)row * 1536 + c] = f2bf(v); const int j = c >> 8, cc = c & 255;
        if (row < NPT) { const int b = row >> 11, t = row & 2047;
            if (j < 4) p.out[OFF_PCK + j * SZ_PROW + (size_t)row * 256 + cc] = v;
            else if (t >= 1536) p.out[OFF_PWK + (j - 4) * SZ_PWIN + ((size_t)b * 512 + t - 1536) * 256 + cc] = v; }
        else { const int b = row - NPT;
            if (j < 4) p.out[OFF_SCK + j * SZ_SROW + (size_t)b * 256 + cc] = v;
            else p.out[OFF_SWK + (j - 4) * SZ_SWIN + ((size_t)b * 512 + 511) * 256 + cc] = v; }
    }
    else if (n < C_QL) { const int c = n - C_G; p.GATE[(size_t)row * 48 + c] = sigmoidf_(v + p.b_gate[c]); }
    else if (n < C_KL) p.GQ[(size_t)row * 512 + (n - C_QL)] = f2bf(v * 0.08838834764831845f);
    else if (n < C_VL) p.GK[(size_t)row * 512 + (n - C_KL)] = f2bf(v);
    else if (n < C_RL) p.GV[(size_t)row * 1024 + (n - C_VL)] = f2bf(v);
    else if (n < C_LR) p.GR[(size_t)row * 1024 + (n - C_RL)] = f2bf(siluf_(v));
    else if (n < C_BR) p.LR[(size_t)row * 16 + (n - C_LR)] = v;
    else p.BR[(size_t)row * 4096 + (n - C_BR)] = f2bf(sigmoidf_(v));
}

__global__ void __launch_bounds__(256) k_prep_x(Params p) {
    const int lane = threadIdx.x & 63, row = blockIdx.x * 4 + (threadIdx.x >> 6);
    if (row >= NTOK) return;
    const float* xr = row < NPT ? p.x_prompt + (size_t)row * DM : p.x_sample + (size_t)(row - NPT) * DM;
    float ss = 0.f;
    for (int i = lane; i < DM; i += 64) { const float v = xr[i]; ss += v * v; p.XB[(size_t)row * DM + i] = f2bf(v); }
    ss = wave_sum(ss);
    if (lane == 0) p.RSTD1[row] = rsqrtf(ss * (1.f / DM) + EPS);
}
__global__ void __launch_bounds__(256) k_copy_swin(Params p) {
    const size_t i = (size_t)blockIdx.x * 256 + threadIdx.x;
    if (i >= (size_t)DB * 511 * 256) return;
    const int c = (int)(i & 255); const int r = (int)((i >> 8) % 511); const int b = (int)((i >> 8) / 511);
    p.out[OFF_SWK + ((size_t)b * 512 + r) * 256 + c] = p.cwk[((size_t)b * 512 + r + 1) * 256 + c];
    p.out[OFF_SWK + SZ_SWIN + ((size_t)b * 512 + r) * 256 + c] = p.cwv[((size_t)b * 512 + r + 1) * 256 + c];
}
__global__ void __launch_bounds__(256) k_rms_rows(const float* X, float* rstd, int nrows) {
    const int lane = threadIdx.x & 63, row = blockIdx.x * 4 + (threadIdx.x >> 6);
    if (row >= nrows) return;
    float ss = 0.f;
    for (int i = lane; i < DM; i += 64) { const float v = X[(size_t)row * DM + i]; ss += v * v; }
    ss = wave_sum(ss);
    if (lane == 0) rstd[row] = rsqrtf(ss * (1.f / DM) + EPS);
}
__global__ void __launch_bounds__(256) k_final_norm(Params p) {
    const int lane = threadIdx.x & 63, row = blockIdx.x * 4 + (threadIdx.x >> 6);
    if (row >= NTOK) return;
    float* yr = row < NPT ? p.out + OFF_Y + (size_t)row * DM : p.out + OFF_YS + (size_t)(row - NPT) * DM;
    float ss = 0.f;
    for (int i = lane; i < DM; i += 64) { const float v = yr[i]; ss += v * v; }
    ss = wave_sum(ss);
    const float r = rsqrtf(ss * (1.f / DM) + EPS);
    for (int i = lane; i < DM; i += 64) yr[i] = yr[i] * r * p.norm_f[i];
}

template <class AF, class BF, class EF>
__global__ void __launch_bounds__(256) k_gemm_naive(int m_off, int M, int N, int K, AF af, BF bf, EF ef) {
    __shared__ float As[16][68], Bs[16][68];
    const int tid = threadIdx.x, tx = tid & 15, ty = tid >> 4, m0 = m_off + blockIdx.y * 64, n0 = blockIdx.x * 64;
    float acc[4][4];
#pragma unroll
    for (int i = 0; i < 4; ++i)
#pragma unroll
        for (int j = 0; j < 4; ++j) acc[i][j] = 0.f;
    for (int k0 = 0; k0 < K; k0 += 16) {
#pragma unroll
        for (int i = 0; i < 4; ++i) { const int idx = tid + 256 * i, r = idx >> 4, kk = idx & 15; As[kk][r] = (m0 + r < M) ? af(m0 + r, k0 + kk) : 0.f; }
#pragma unroll
        for (int i = 0; i < 4; ++i) { const int idx = tid + 256 * i, kk = idx >> 6, c = idx & 63; Bs[kk][c] = (n0 + c < N) ? bf(k0 + kk, n0 + c) : 0.f; }
        __syncthreads();
#pragma unroll
        for (int kk = 0; kk < 16; ++kk) {
            float a[4], b[4];
#pragma unroll
            for (int i = 0; i < 4; ++i) { a[i] = As[kk][ty * 4 + i]; b[i] = Bs[kk][tx * 4 + i]; }
#pragma unroll
            for (int i = 0; i < 4; ++i)
#pragma unroll
                for (int j = 0; j < 4; ++j) acc[i][j] += a[i] * b[j];
        }
        __syncthreads();
    }
#pragma unroll
    for (int i = 0; i < 4; ++i)
#pragma unroll
        for (int j = 0; j < 4; ++j) { const int r = m0 + ty * 4 + i, c = n0 + tx * 4 + j; if (r < M && c < N) ef(r, c, acc[i][j]); }
}
struct AF_x_g1 { Params p; __device__ float operator()(int r, int k) const { return xval(p, r, k) * p.norm1_g[k]; } };
struct BF_rowmajor { const float* W; long ld; __device__ float operator()(int k, int n) const { return W[(size_t)k * ld + n]; } };
struct EF_proj { Params p; __device__ void operator()(int r, int n, float acc) const { proj_store(p, r, n, acc * p.RSTD1[r]); } };
struct AF_bf { const bf16_t* A; long ld; __device__ float operator()(int r, int k) const { return bf2f(A[(size_t)r * ld + k]); } };
struct EF_bra { Params p; __device__ void operator()(int r, int n, float acc) const { p.TMP[(size_t)r * DM + n] = acc * bf2f(p.BR[(size_t)r * 4096 + n]); } };
struct EF_brb { Params p; __device__ void operator()(int r, int n, float acc) const { p.MB[(size_t)r * DM + n] = f2bf(p.TMP[(size_t)r * DM + n] + acc * bf2f(p.BR[(size_t)r * 4096 + 2048 + n])); } };
struct EF_wo { Params p; __device__ void operator()(int r, int n, float acc) const { const float x1 = xval(p, r, n) + acc; p.X1[(size_t)r * DM + n] = x1; p.X1B[(size_t)r * DM + n] = f2bf(x1); } };
struct AF_x1_g2 { Params p; __device__ float operator()(int r, int k) const { return bf2f(p.X1B[(size_t)r * DM + k]) * p.norm2_g[k]; } };
struct EF_up { Params p; __device__ void operator()(int r, int n, float acc) const { const float v = fmaxf(acc * p.RSTD2[r], 0.f); p.HF[(size_t)r * DFF + n] = f2bf(v * v); } };
struct EF_down { Params p; __device__ void operator()(int r, int n, float acc) const { const float x2 = p.X1[(size_t)r * DM + n] + acc;
    if (r < NPT) p.out[OFF_Y + (size_t)r * DM + n] = x2; else p.out[OFF_YS + (size_t)(r - NPT) * DM + n] = x2; } };

__global__ void __launch_bounds__(128) k_compress_naive(Params p, int is_s) {
    const int n_cmp = is_s ? 1023 : 127, n_pad = is_s ? 1024 : 128;
    const int kv = blockIdx.y, tid = threadIdx.x;
    const int i = blockIdx.x % n_pad, bg = blockIdx.x / n_pad, b = bg >> 2, g = bg & 3;
    __shared__ float blk[2048]; __shared__ float hid[128];
    if (i >= n_cmp) {
        if (tid < 64) { if (is_s) { (kv ? p.VCMP_S : p.KCMP_S)[((size_t)bg * 1024 + i) * 64 + tid] = 0; }
                        else { if (kv) p.VCMPT_P[((size_t)bg * 64 + tid) * 128 + i] = 0; else p.KCMP_P[((size_t)bg * 128 + i) * 64 + tid] = 0; } }
        return;
    }
    const float* pe = kv ? p.pe_v : p.pe_k; const float* w1 = kv ? p.w1v : p.w1k; const float* w2 = kv ? p.w2v : p.w2k;
    for (int e = tid; e < 2048; e += 128) { const int l = e >> 6, d = e & 63; const int pos = 16 * i + l; float v;
        if (is_s) { const int page = p.page_table[b * NPAGES + (pos >> 7)]; v = (kv ? p.ccv : p.cck)[(((size_t)page * PAGE + (pos & 127)) * 4 + g) * 64 + d]; }
        else v = bf2f(p.KV6[((size_t)b * SEQ + pos) * 1536 + kv * 256 + g * 64 + d]);
        blk[e] = v + pe[e]; }
    __syncthreads();
    float h = 0.f;
    for (int k = 0; k < 2048; ++k) h += blk[k] * w1[(size_t)k * 128 + tid];
    hid[tid] = gelu_tanh(h);
    __syncthreads();
    if (tid < 64) { float o = 0.f; for (int j = 0; j < 128; ++j) o += hid[j] * w2[j * 64 + tid];
        if (is_s) (kv ? p.VCMP_S : p.KCMP_S)[((size_t)bg * 1024 + i) * 64 + tid] = f2bf(o);
        else { if (kv) p.VCMPT_P[((size_t)bg * 64 + tid) * 128 + i] = f2bf(o); else p.KCMP_P[((size_t)bg * 128 + i) * 64 + tid] = f2bf(o); } }
}

struct RowRef { const float* pf; const bf16_t* pb; };
__device__ __forceinline__ float rr_get(const RowRef& r, int d) { return r.pf ? r.pf[d] : bf2f(r.pb[d]); }

template <class KF, class VF>
__device__ __forceinline__ void attend_naive(int nk, KF keyf, VF valf, const float (*q)[64], float (*sc)[1088], float (*oacc)[64], const float* gate3, int gsel, int tid) {
    const int lane = tid & 63, wv = tid >> 6;
    for (int kk = tid; kk < nk; kk += 256) { bool valid; const RowRef r = keyf(kk, valid);
        if (valid) { float d0 = 0.f, d1 = 0.f, d2 = 0.f, d3 = 0.f;
            for (int d = 0; d < 64; ++d) { const float kx = rr_get(r, d); d0 += q[0][d] * kx; d1 += q[1][d] * kx; d2 += q[2][d] * kx; d3 += q[3][d] * kx; }
            sc[0][kk] = d0; sc[1][kk] = d1; sc[2][kk] = d2; sc[3][kk] = d3; }
        else { sc[0][kk] = -INFINITY; sc[1][kk] = -INFINITY; sc[2][kk] = -INFINITY; sc[3][kk] = -INFINITY; } }
    __syncthreads();
    {
        float m = -INFINITY; for (int kk = lane; kk < nk; kk += 64) m = fmaxf(m, sc[wv][kk]);
        m = wave_max(m);
        float s = 0.f;
        for (int kk = lane; kk < nk; kk += 64) { const float x = sc[wv][kk]; const float e = (x == -INFINITY) ? 0.f : __expf(x - m); sc[wv][kk] = e; s += e; }
        s = wave_sum(s);
        const float inv = s > 0.f ? 1.f / s : 0.f;
        for (int kk = lane; kk < nk; kk += 64) sc[wv][kk] *= inv;
    }
    __syncthreads();
    {
        float o = 0.f;
        for (int kk = 0; kk < nk; ++kk) { const float pr = sc[wv][kk]; if (pr != 0.f) o += pr * valf(kk, lane); }
        oacc[wv][lane] += gate3[wv * 3 + gsel] * o;
    }
    __syncthreads();
}

__global__ void __launch_bounds__(256) k_nsa_naive(Params p, int row0) {
    const int row = row0 + blockIdx.x, g = blockIdx.y, tid = threadIdx.x;
    const bool is_s = row >= NPT; const int b = is_s ? row - NPT : row >> 11, t = is_s ? 0 : row & 2047;
    const int start = is_s ? PAST : 0, pos = start + t, rowbase = is_s ? NPT + b : b * SEQ;
    const int n_cmp = is_s ? 1023 : 127, n_slc = is_s ? 257 : 32;
    __shared__ float q[4][64]; __shared__ float sc[4][1088]; __shared__ float oacc[4][64]; __shared__ float gate3[12];
    __shared__ float score[260]; __shared__ int selidx[16];
    { const int hd = tid >> 6, d = tid & 63; q[hd][d] = bf2f(p.QN[(size_t)row * 1024 + (g * 4 + hd) * 64 + d]); oacc[hd][d] = 0.f; }
    if (tid < 12) gate3[tid] = p.GATE[(size_t)row * 48 + g * 12 + tid];
    __syncthreads();
    const int bg = b * 4 + g;
    const bf16_t* kc = is_s ? p.KCMP_S + (size_t)bg * 1024 * 64 : p.KCMP_P + (size_t)bg * 128 * 64;
    const bf16_t* vc_s = p.VCMP_S + (size_t)bg * 1024 * 64; const bf16_t* vc_p = p.VCMPT_P + (size_t)bg * 64 * 128;
    auto kf_c = [&](int kk, bool& valid) { valid = (16 * kk + 31 <= pos); return RowRef{nullptr, kc + (size_t)kk * 64}; };
    auto vf_c = [&](int kk, int d) { return is_s ? bf2f(vc_s[(size_t)kk * 64 + d]) : bf2f(vc_p[(size_t)d * 128 + kk]); };
    attend_naive(n_cmp, kf_c, vf_c, q, sc, oacc, gate3, 0, tid);
    for (int j = tid; j < n_slc; j += 256) { float s = 0.f;
        for (int i = 4 * j - 1; i <= 4 * j + 3; ++i) if (i >= 0 && i < n_cmp) s += (sc[0][i] + sc[1][i]) + (sc[2][i] + sc[3][i]);
        score[j] = (j * 64 <= pos) ? s + ((j == 0 || j == pos / 64) ? 1e4f : 0.f) : -1e30f; }
    __syncthreads();
    for (int j = tid; j < n_slc; j += 256) { const float sj = score[j]; int rank = 0;
        for (int j2 = 0; j2 < n_slc; ++j2) { const float s2 = score[j2]; rank += (s2 > sj || (s2 == sj && j2 < j)) ? 1 : 0; }
        if (rank < 16) selidx[rank] = j; }
    __syncthreads();
    auto row_at = [&](int kp, int which) -> RowRef {
        if (kp < start) {
            if (which < 4) { const int page = p.page_table[b * NPAGES + (kp >> 7)]; const float* c = (which == 2) ? p.csk : p.csv; return RowRef{c + (((size_t)page * PAGE + (kp & 127)) * 4 + g) * 64, nullptr}; }
            const float* c = (which == 4) ? p.cwk : p.cwv; return RowRef{c + (((size_t)b * 512 + (kp - (PAST - 512))) * 4 + g) * 64, nullptr};
        }
        return RowRef{nullptr, p.KV6 + (size_t)(rowbase + kp - start) * 1536 + which * 256 + g * 64};
    };
    auto kf_s = [&](int kk, bool& valid) { const int kp = selidx[kk >> 6] * 64 + (kk & 63); valid = (kp <= pos); return valid ? row_at(kp, 2) : RowRef{nullptr, nullptr}; };
    auto vf_s = [&](int kk, int d) { const int kp = selidx[kk >> 6] * 64 + (kk & 63); return rr_get(row_at(kp, 3), d); };
    attend_naive(1024, kf_s, vf_s, q, sc, oacc, gate3, 1, tid);
    auto kf_w = [&](int kk, bool& valid) { const int kp = pos - 512 + kk; valid = (kp >= 0); return valid ? row_at(kp, 4) : RowRef{nullptr, nullptr}; };
    auto vf_w = [&](int kk, int d) { const int kp = pos - 512 + kk; return rr_get(row_at(kp, 5), d); };
    attend_naive(513, kf_w, vf_w, q, sc, oacc, gate3, 2, tid);
    { const int hd = tid >> 6, d = tid & 63; p.OA[(size_t)row * 1024 + (g * 4 + hd) * 64 + d] = f2bf(oacc[hd][d]); }
}

__global__ void __launch_bounds__(512) k_gla_naive(Params p, int is_s) {
    const int b = blockIdx.x >> 2, h = blockIdx.x & 3, tid = threadIdx.x, e = tid & 255, half = tid >> 8;
    const int T = is_s ? 1 : SEQ, rowbase = is_s ? NPT + b : b * SEQ;
    __shared__ float a_s[128], q_s[128], k_s[128], part[2][256], red[8];
    float S[64];
#pragma unroll
    for (int dd = 0; dd < 64; ++dd) S[dd] = is_s ? p.state[(((size_t)b * 4 + h) * 128 + half * 64 + dd) * 256 + e] : 0.f;
    for (int t = 0; t < T; ++t) {
        const int row = rowbase + t;
        if (tid < 128) { float x = p.b_a[h * 128 + tid];
            for (int r = 0; r < 16; ++r) x += p.LR[(size_t)row * 16 + r] * p.w_a2[r * 512 + h * 128 + tid];
            a_s[tid] = __expf(logsigmoidf_(x) * (1.f / 16.f));
            q_s[tid] = bf2f(p.GQ[(size_t)row * 512 + h * 128 + tid]); k_s[tid] = bf2f(p.GK[(size_t)row * 512 + h * 128 + tid]); }
        const float v = bf2f(p.GV[(size_t)row * 1024 + h * 256 + e]);
        __syncthreads();
        float po = 0.f;
#pragma unroll
        for (int dd = 0; dd < 64; ++dd) { const int d = half * 64 + dd; S[dd] = a_s[d] * S[dd] + k_s[d] * v; po += q_s[d] * S[dd]; }
        part[half][e] = po;
        __syncthreads();
        float o = 0.f;
        if (tid < 256) { o = part[0][e] + part[1][e]; const float ss = wave_sum(o * o); if ((tid & 63) == 0) red[tid >> 6] = ss; }
        __syncthreads();
        if (tid < 256) { const float ss = (red[0] + red[1]) + (red[2] + red[3]); const float r = rsqrtf(ss * (1.f / 256.f) + EPS);
            p.OB[(size_t)row * 1024 + h * 256 + e] = f2bf(o * r * p.gnorm[e] * bf2f(p.GR[(size_t)row * 1024 + h * 256 + e])); }
    }
    float* so = p.out + (is_s ? OFF_SGLA : OFF_PGLA);
#pragma unroll
    for (int dd = 0; dd < 64; ++dd) so[(((size_t)b * 4 + h) * 128 + half * 64 + dd) * 256 + e] = S[dd];
}

#define GAS __attribute__((address_space(1)))
#define LAS __attribute__((address_space(3)))
typedef unsigned v4u __attribute__((ext_vector_type(4)));
typedef unsigned v2u __attribute__((ext_vector_type(2)));
#define LDS_WAIT() asm volatile("s_waitcnt lgkmcnt(0)" ::: "memory")
#define VM_WAIT() asm volatile("s_waitcnt vmcnt(0)" ::: "memory")
__device__ __forceinline__ unsigned pk2(float lo, float hi) { return (unsigned)f2bf(lo) | ((unsigned)f2bf(hi) << 16); }
constexpr int NIN_PAD = 9984;
__host__ __device__ __forceinline__ int in_colmap(int n) {
    if (n < 2560) return n; if (n < 3072) return C_QL + (n - 2560); if (n < 3584) return C_KL + (n - 3072); if (n < 4608) return C_VL + (n - 3584);
    if (n < 5632) return C_RL + (n - 4608); if (n < 9728) return C_BR + (n - 5632); if (n < 9776) return C_G + (n - 9728); if (n < 9792) return C_LR + (n - 9776); return -1;
}
namespace pg8 {
#define PG8_LAS __attribute__((address_space(3)))
typedef unsigned short bf16_t;
typedef short bf16x8 __attribute__((ext_vector_type(8)));
typedef float f32x4 __attribute__((ext_vector_type(4)));
typedef unsigned u32x4 __attribute__((ext_vector_type(4)));
constexpr int BM = 256, BK = 64, HALF = 128, HTB = HALF * BK * 2  , STAGE_BYTES = 8 * HTB, NXCD = 8, WGM = 8;

__host__ __device__ __forceinline__ int lds_byte(int r, int c) { const int st = (r >> 4) * 2 + (c >> 5), rr = r & 15, cc = c & 31, ob = rr * 64 + cc * 2; return st * 1024 + (ob ^ (((ob >> 9) & 1) << 5)); }
__host__ __device__ __forceinline__ void stage_rc(int b, int& R, int& C) { const int st = b / 1024, sb = b % 1024, swz = sb ^ (((sb >> 9) & 1) << 5); R = (st >> 1) * 16 + swz / 64; C = (st & 1) * 32 + (swz % 64) / 2; }
__host__ __device__ __forceinline__ int perm32(int rho) { const int n = rho >> 4, i = rho & 15; return 8 * (i >> 2) + 4 * n + (i & 3); }

struct Unit { int pm, pn; };
struct Gemm { const bf16_t* A; const bf16_t* Bt; int M, N, K; };

struct StaticOrder {
    int nM, nN, nwg, G, c;
    __host__ __device__ void init(int M, int N, int G_, int c_) { nM = M / BM; nN = N / BM; nwg = nM * nN; G = G_; c = c_; }
    __host__ __device__ bool next(int i, Unit& u) const {
        const long L = (long)i * G + c; if (L >= nwg) return false;
        int wgid = (int)L; { const int q = nwg / NXCD, r = nwg % NXCD, xcd = wgid % NXCD, off = wgid / NXCD; wgid = (xcd < r ? xcd * (q + 1) : r * (q + 1) + (xcd - r) * q) + off; }
        const int nig = WGM * nN, gid = wgid / nig, fm = gid * WGM, gsz = (nM - fm) < WGM ? (nM - fm) : WGM;
        u.pm = fm + ((wgid % nig) % gsz); u.pn = (wgid % nig) / gsz; return true;
    }
    __device__ __forceinline__ void a_ready(const Unit&) const {}
    __device__ __forceinline__ void done(const Unit&) const {}
};

template <class Epi, class Sched, bool ALIGN_EPI = false, bool SP2 = false>
__device__ __forceinline__ void gemm_phase(PG8_LAS unsigned char* lds, const Gemm g, const Sched& S, const Epi& E) {
    const int tid = threadIdx.x, wid = __builtin_amdgcn_readfirstlane(tid >> 6), lane = tid & 63, wr = wid >> 2, wc = wid & 3, fr = lane & 15, fq = lane >> 4;
    const int K = g.K, nt = K / BK;
    unsigned voffA[2], voffB[2];
#pragma unroll
    for (int i = 0; i < 2; ++i) { int R, C; stage_rc(tid * 16 + i * 8192, R, C); const int Rb = Epi::PERM ? ((R & ~31) + perm32(R & 31)) : R;
        voffA[i] = (unsigned)(R * K + C) * 2u; voffB[i] = (unsigned)(Rb * K + C) * 2u; }
    const size_t kstep = (size_t)(BK * 2);
    const size_t hstep = (size_t)HALF * K * 2;
    const size_t tstep = 2 * hstep;
    const unsigned ldsw = (unsigned)wid * 1024u;
    const int aoff = lds_byte(wr * 64 + fr, fq * 8), boff = lds_byte(wc * 32 + fr, fq * 8);
#define PG8_SA(b, h) (((b) * 2 + (h)) * HTB)
#define PG8_SB(b, h) ((4 + (b) * 2 + (h)) * HTB)
#define PG8_STAGE(bufoff, gbase, voff) do { _Pragma("unroll") for (int _i = 0; _i < 2; ++_i) \
        __builtin_amdgcn_global_load_lds((const unsigned*)((const char*)(gbase) + (voff)[_i]), (PG8_LAS unsigned*)(lds + (bufoff) + ldsw + _i * 8192), 16, 0, 0); } while (0)
#define PG8_LDA(dst, b, h) do { _Pragma("unroll") for (int m = 0; m < 4; ++m) _Pragma("unroll") for (int k = 0; k < 2; ++k) dst[m][k] = *(const PG8_LAS bf16x8*)(lds + PG8_SA(b, h) + aoff + m * 2048 + k * 1024); } while (0)
#define PG8_LDB(dst, b, h) do { _Pragma("unroll") for (int n = 0; n < 2; ++n) _Pragma("unroll") for (int k = 0; k < 2; ++k) dst[n][k] = *(const PG8_LAS bf16x8*)(lds + PG8_SB(b, h) + boff + n * 2048 + k * 1024); } while (0)
#define PG8_MMA(ai, bj, At, Bt) do { __builtin_amdgcn_s_setprio(1); _Pragma("unroll") for (int m = 0; m < 4; ++m) _Pragma("unroll") for (int n = 0; n < 2; ++n) _Pragma("unroll") for (int k = 0; k < 2; ++k) \
        acc[ai][bj][m][n] = __builtin_amdgcn_mfma_f32_16x16x32_bf16(Bt[n][k], At[m][k], acc[ai][bj][m][n], 0, 0, 0); __builtin_amdgcn_s_setprio(0); } while (0)
#define PG8_WAIT_V(n) asm volatile("s_waitcnt vmcnt(" #n ")" ::: "memory")
#define PG8_WAIT_L(n) asm volatile("s_waitcnt lgkmcnt(" #n ")" ::: "memory")
#define PG8_BAR __builtin_amdgcn_s_barrier()
#define PG8_SCHED __builtin_amdgcn_sched_barrier(0)
    Unit cur, nxt; int ui = 0;
    if (!S.next(0, cur)) return;
    f32x4 acc[2][2][4][2];
#pragma unroll
    for (int a = 0; a < 2; ++a)
#pragma unroll
        for (int b = 0; b < 2; ++b)
#pragma unroll
            for (int m = 0; m < 4; ++m)
#pragma unroll
                for (int n = 0; n < 2; ++n) acc[a][b][m][n] = (f32x4){0.f, 0.f, 0.f, 0.f};
    bf16x8 At[4][2], B0[2][2], B1[2][2];
    const char* cA = (const char*)g.A + (size_t)cur.pm * tstep; const char* cB = (const char*)g.Bt + (size_t)cur.pn * tstep;
    S.a_ready(cur);
    if constexpr (SP2) {
        PG8_STAGE(PG8_SB(0, 0), cB, voffB); PG8_STAGE(PG8_SB(0, 1), cB + hstep, voffB); PG8_STAGE(PG8_SA(0, 0), cA, voffA); PG8_STAGE(PG8_SA(0, 1), cA + hstep, voffA);
        if (wr == 1) PG8_BAR;
        PG8_WAIT_V(2); PG8_BAR;
        PG8_STAGE(PG8_SB(1, 0), cB + kstep, voffB); PG8_STAGE(PG8_SA(1, 0), cA + kstep, voffA); PG8_STAGE(PG8_SB(1, 1), cB + hstep + kstep, voffB);
        PG8_WAIT_V(6); PG8_BAR;
    } else {
        PG8_STAGE(PG8_SB(0, 0), cB, voffB); PG8_STAGE(PG8_SA(0, 0), cA, voffA); PG8_STAGE(PG8_SB(0, 1), cB + hstep, voffB); PG8_STAGE(PG8_SA(0, 1), cA + hstep, voffA);
        if (wr == 1) PG8_BAR;
        PG8_WAIT_V(4); PG8_BAR;
        PG8_STAGE(PG8_SB(1, 0), cB + kstep, voffB); PG8_STAGE(PG8_SA(1, 0), cA + kstep, voffA); PG8_STAGE(PG8_SB(1, 1), cB + hstep + kstep, voffB);
        PG8_WAIT_V(6); PG8_BAR;
    }
    for (;;) {
        const bool has_next = S.next(ui + 1, nxt);
        const char* nA = has_next ? (const char*)g.A + (size_t)nxt.pm * tstep : cA; const char* nB = has_next ? (const char*)g.Bt + (size_t)nxt.pn * tstep : cB;
        for (int t = 0; t < nt; t += 2) {
            const bool last = (t == nt - 2);
            const char* a1 = cA + (size_t)(t + 1) * kstep;
            const char* a2 = last ? nA : cA + (size_t)(t + 2) * kstep; const char* b2 = last ? nB : cB + (size_t)(t + 2) * kstep;
            const char* a3 = a2 + kstep; const char* b3 = b2 + kstep;
            if (last && has_next) S.a_ready(nxt);
            if constexpr (SP2) {
            PG8_LDB(B0, 0, 0); PG8_LDB(B1, 0, 1); PG8_SCHED; PG8_LDA(At, 0, 0); PG8_STAGE(PG8_SA(1, 1), a1 + hstep, voffA);
            PG8_WAIT_V(8); PG8_WAIT_L(0); PG8_BAR; PG8_MMA(0, 0, At, B0); PG8_MMA(0, 1, At, B1); PG8_BAR; PG8_SCHED;
            PG8_LDA(At, 0, 1); PG8_STAGE(PG8_SB(0, 0), b2, voffB); PG8_STAGE(PG8_SB(0, 1), b2 + hstep, voffB); PG8_STAGE(PG8_SA(0, 0), a2, voffA);
            PG8_WAIT_V(8); PG8_WAIT_L(0); PG8_BAR; PG8_MMA(1, 0, At, B0); PG8_MMA(1, 1, At, B1); PG8_BAR; PG8_SCHED;
            PG8_LDB(B0, 1, 0); PG8_LDB(B1, 1, 1); PG8_SCHED; PG8_LDA(At, 1, 0); PG8_STAGE(PG8_SA(0, 1), a2 + hstep, voffA);
            PG8_WAIT_V(8); PG8_WAIT_L(0); PG8_BAR; PG8_MMA(0, 0, At, B0); PG8_MMA(0, 1, At, B1); PG8_BAR; PG8_SCHED;
            PG8_LDA(At, 1, 1); PG8_STAGE(PG8_SB(1, 0), b3, voffB); PG8_STAGE(PG8_SB(1, 1), b3 + hstep, voffB); PG8_STAGE(PG8_SA(1, 0), a3, voffA);
            PG8_WAIT_V(8); PG8_WAIT_L(0); PG8_BAR; PG8_MMA(1, 0, At, B0); PG8_MMA(1, 1, At, B1); PG8_BAR; PG8_SCHED;
            } else {
            PG8_LDB(B0, 0, 0); PG8_SCHED; PG8_LDA(At, 0, 0); PG8_STAGE(PG8_SA(1, 1), a1 + hstep, voffA);
            PG8_WAIT_L(8); PG8_BAR; PG8_WAIT_L(0); PG8_MMA(0, 0, At, B0); PG8_BAR; PG8_SCHED;
            PG8_LDB(B1, 0, 1); PG8_STAGE(PG8_SB(0, 0), b2, voffB);
            PG8_BAR; PG8_WAIT_L(0); PG8_MMA(0, 1, At, B1); PG8_BAR;
            PG8_LDA(At, 0, 1); PG8_STAGE(PG8_SA(0, 0), a2, voffA);
            PG8_BAR; PG8_WAIT_L(0); PG8_MMA(1, 0, At, B0); PG8_BAR; PG8_SCHED;
            PG8_STAGE(PG8_SB(0, 1), b2 + hstep, voffB);
            PG8_WAIT_V(6); PG8_BAR; PG8_MMA(1, 1, At, B1); PG8_BAR;
            PG8_LDB(B0, 1, 0); PG8_SCHED; PG8_LDA(At, 1, 0); PG8_STAGE(PG8_SA(0, 1), a2 + hstep, voffA);
            PG8_WAIT_L(8); PG8_BAR; PG8_WAIT_L(0); PG8_MMA(0, 0, At, B0); PG8_BAR; PG8_SCHED;
            PG8_LDB(B1, 1, 1); PG8_STAGE(PG8_SB(1, 0), b3, voffB);
            PG8_BAR; PG8_WAIT_L(0); PG8_MMA(0, 1, At, B1); PG8_BAR;
            PG8_LDA(At, 1, 1); PG8_STAGE(PG8_SA(1, 0), a3, voffA);
            PG8_BAR; PG8_WAIT_L(0); PG8_MMA(1, 0, At, B0); PG8_BAR; PG8_SCHED;
            PG8_STAGE(PG8_SB(1, 1), b3 + hstep, voffB);
            PG8_WAIT_V(6); PG8_BAR; PG8_MMA(1, 1, At, B1); PG8_BAR;
            }
        }
        if constexpr (ALIGN_EPI) { if (wr == 0) PG8_BAR; }
        if constexpr (!Epi::AFTER_DRAIN) { E(acc, cur, wr, wc, fr, fq); S.done(cur); }
        if (!has_next) break;
#pragma unroll
        for (int a = 0; a < 2; ++a)
#pragma unroll
            for (int b = 0; b < 2; ++b)
#pragma unroll
                for (int m = 0; m < 4; ++m)
#pragma unroll
                    for (int n = 0; n < 2; ++n) acc[a][b][m][n] = (f32x4){0.f, 0.f, 0.f, 0.f};
        cur = nxt; cA = nA; cB = nB; ++ui;
        if constexpr (ALIGN_EPI) { if (wr == 1) PG8_BAR; }
    }
    PG8_WAIT_V(0);
    if constexpr (!ALIGN_EPI) { if (wr == 0) PG8_BAR; }
    PG8_BAR;
    if constexpr (Epi::AFTER_DRAIN) { E.fused(acc, cur, wr, wc, fr, fq, lds, wid, lane); S.done(cur); }
#undef PG8_SA
#undef PG8_SB
#undef PG8_STAGE
#undef PG8_LDA
#undef PG8_LDB
#undef PG8_MMA
#undef PG8_WAIT_V
#undef PG8_WAIT_L
#undef PG8_BAR
#undef PG8_SCHED
}
}
typedef pg8::f32x4 f32x4;
template <class F> struct EpiGen {
    static constexpr bool PERM = false, AFTER_DRAIN = false; F f;
    __device__ __forceinline__ void operator()(const f32x4 (&acc)[2][2][4][2], const pg8::Unit& u, int wr, int wc, int fr, int fq) const {
        const int row0 = u.pm * 256 + wr * 64 + fr, col0 = u.pn * 256 + wc * 32 + 4 * fq;
#pragma unroll
        for (int ai = 0; ai < 2; ++ai)
#pragma unroll
            for (int m = 0; m < 4; ++m) { const int row = row0 + ai * 128 + m * 16; const float ctx = f.row_begin(row); float part = 0.f;
#pragma unroll
                for (int bj = 0; bj < 2; ++bj)
#pragma unroll
                    for (int n = 0; n < 2; ++n) part += f.store4(ctx, row, col0 + bj * 128 + n * 16, acc[ai][bj][m][n]);
                f.row_end(row, part, fq, true); }
    }
};
template <int ACT  >
__device__ __forceinline__ void store_tile_bf16(const f32x4 (&acc)[2][2][4][2], int row0, int col0, const float* rstd, float scale, bf16_t* dst, int ld) {
#pragma unroll
    for (int ai = 0; ai < 2; ++ai)
#pragma unroll
        for (int m = 0; m < 4; ++m) { const int row = row0 + ai * 128 + m * 16; const float rs = rstd[row] * scale; bf16_t* rp = dst + (size_t)row * ld + col0;
#pragma unroll
            for (int bj = 0; bj < 2; ++bj)
#pragma unroll
                for (int n = 0; n < 2; ++n) { f32x4 v = acc[ai][bj][m][n] * rs;
                    if (ACT == 1) { v[0] = siluf_(v[0]); v[1] = siluf_(v[1]); v[2] = siluf_(v[2]); v[3] = siluf_(v[3]); }
                    if (ACT == 2) { v[0] = sigmoidf_(v[0]); v[1] = sigmoidf_(v[1]); v[2] = sigmoidf_(v[2]); v[3] = sigmoidf_(v[3]); }
                    v2u w; w.x = pk2(v[0], v[1]); w.y = pk2(v[2], v[3]); *(v2u*)(rp + bj * 128 + n * 16) = w; } }
}
struct EpiProj {
    static constexpr bool PERM = false, AFTER_DRAIN = false;
    const float* rstd; const float* b_gate; bf16_t *QN, *KV6, *GQ, *GK, *GV, *GR, *BR; float *GATE, *LR, *out;
    __device__ __forceinline__ void operator()(const f32x4 (&acc)[2][2][4][2], const pg8::Unit& u, int wr, int wc, int fr, int fq) const {
        const int row0 = u.pm * 256 + wr * 64 + fr, cl0 = wc * 32 + 4 * fq, pn = u.pn;
        if (pn < 4) store_tile_bf16<0>(acc, row0, pn * 256 + cl0, rstd, 0.125f, QN, 1024);
        else if (pn < 10) { const int j = pn - 4;
            store_tile_bf16<0>(acc, row0, j * 256 + cl0, rstd, 1.f, KV6, 1536);
#pragma unroll
            for (int ai = 0; ai < 2; ++ai)
#pragma unroll
                for (int m = 0; m < 4; ++m) { const int row = row0 + ai * 128 + m * 16; const float rs = rstd[row]; const int b = row >> 11, t = row & 2047;
                    float* rp = nullptr;
                    if (j < 4) rp = out + OFF_PCK + j * SZ_PROW + (size_t)row * 256 + cl0;
                    else if (t >= 1536) rp = out + OFF_PWK + (j - 4) * SZ_PWIN + ((size_t)b * 512 + (t - 1536)) * 256 + cl0;
                    if (rp) {
#pragma unroll
                        for (int bj = 0; bj < 2; ++bj)
#pragma unroll
                            for (int n = 0; n < 2; ++n) *(f32x4*)(rp + bj * 128 + n * 16) = acc[ai][bj][m][n] * rs; } }
        }
        else if (pn < 12) store_tile_bf16<0>(acc, row0, (pn - 10) * 256 + cl0, rstd, 0.08838834764831845f, GQ, 512);
        else if (pn < 14) store_tile_bf16<0>(acc, row0, (pn - 12) * 256 + cl0, rstd, 1.f, GK, 512);
        else if (pn < 18) store_tile_bf16<0>(acc, row0, (pn - 14) * 256 + cl0, rstd, 1.f, GV, 1024);
        else if (pn < 22) store_tile_bf16<1>(acc, row0, (pn - 18) * 256 + cl0, rstd, 1.f, GR, 1024);
        else if (pn < 38) store_tile_bf16<2>(acc, row0, (pn - 22) * 256 + cl0, rstd, 1.f, BR, 4096);
        else if (wc < 2) {
#pragma unroll
            for (int ai = 0; ai < 2; ++ai)
#pragma unroll
                for (int m = 0; m < 4; ++m) { const int row = row0 + ai * 128 + m * 16; const float rs = rstd[row];
#pragma unroll
                    for (int n = 0; n < 2; ++n) { const int cl = cl0 + n * 16; const f32x4 v = acc[ai][0][m][n] * rs;
                        if (cl < 48) { const f32x4 bg = *(const f32x4*)(b_gate + cl); f32x4 o; o[0] = sigmoidf_(v[0] + bg[0]); o[1] = sigmoidf_(v[1] + bg[1]); o[2] = sigmoidf_(v[2] + bg[2]); o[3] = sigmoidf_(v[3] + bg[3]);
                            *(f32x4*)(GATE + (size_t)row * 48 + cl) = o; }
                        else *(f32x4*)(LR + (size_t)row * 16 + (cl - 48)) = v; } }
        }
    }
};
struct F_bra { const bf16_t* BR; float* TMP;
    __device__ __forceinline__ float row_begin(int) const { return 0.f; }
    __device__ __forceinline__ float store4(float, int row, int col, f32x4 v) const { const v2u b = *(const v2u*)(BR + (size_t)row * 4096 + col);
        f32x4 o; o[0] = v[0] * bf2f((bf16_t)(b.x & 0xffff)); o[1] = v[1] * bf2f((bf16_t)(b.x >> 16)); o[2] = v[2] * bf2f((bf16_t)(b.y & 0xffff)); o[3] = v[3] * bf2f((bf16_t)(b.y >> 16));
        *(f32x4*)(TMP + (size_t)row * DM + col) = o; return 0.f; }
    __device__ __forceinline__ void row_end(int, float, int, bool) const {}
};
struct F_brb { const bf16_t* BR; const float* TMP; bf16_t* MB;
    __device__ __forceinline__ float row_begin(int) const { return 0.f; }
    __device__ __forceinline__ float store4(float, int row, int col, f32x4 v) const { const v2u b = *(const v2u*)(BR + (size_t)row * 4096 + 2048 + col); const f32x4 t = *(const f32x4*)(TMP + (size_t)row * DM + col);
        const float o0 = t[0] + v[0] * bf2f((bf16_t)(b.x & 0xffff)), o1 = t[1] + v[1] * bf2f((bf16_t)(b.x >> 16)), o2 = t[2] + v[2] * bf2f((bf16_t)(b.y & 0xffff)), o3 = t[3] + v[3] * bf2f((bf16_t)(b.y >> 16));
        v2u w; w.x = pk2(o0, o1); w.y = pk2(o2, o3); *(v2u*)(MB + (size_t)row * DM + col) = w; return 0.f; }
    __device__ __forceinline__ void row_end(int, float, int, bool) const {}
};
struct F_wo { const float* x; float* X1; bf16_t* X1B; float* SUMSQ;
    __device__ __forceinline__ float row_begin(int) const { return 0.f; }
    __device__ __forceinline__ float store4(float, int row, int col, f32x4 v) const { const f32x4 xv = *(const f32x4*)(x + (size_t)row * DM + col); const f32x4 x1 = xv + v;
        *(f32x4*)(X1 + (size_t)row * DM + col) = x1; v2u w; w.x = pk2(x1[0], x1[1]); w.y = pk2(x1[2], x1[3]); *(v2u*)(X1B + (size_t)row * DM + col) = w;
        return (x1[0] * x1[0] + x1[1] * x1[1]) + (x1[2] * x1[2] + x1[3] * x1[3]); }
    __device__ __forceinline__ void row_end(int row, float part, int fq, bool valid) const { part += __shfl_xor(part, 16); part += __shfl_xor(part, 32); if (fq == 0 && valid) atomicAdd(SUMSQ + row, part); }
};
struct F_up { const float* SUMSQ; bf16_t* HF;
    __device__ __forceinline__ float row_begin(int row) const { return rsqrtf(SUMSQ[row] * (1.f / DM) + EPS); }
    __device__ __forceinline__ float store4(float rs, int row, int col, f32x4 v) const { float h[4];
#pragma unroll
        for (int i = 0; i < 4; ++i) { const float t = fmaxf(v[i] * rs, 0.f); h[i] = t * t; }
        v2u w; w.x = pk2(h[0], h[1]); w.y = pk2(h[2], h[3]); *(v2u*)(HF + (size_t)row * DFF + col) = w; return 0.f; }
    __device__ __forceinline__ void row_end(int, float, int, bool) const {}
};
struct F_down { const float* X1; float* Y; float* SUMSQ;
    __device__ __forceinline__ float row_begin(int) const { return 0.f; }
    __device__ __forceinline__ float store4(float, int row, int col, f32x4 v) const { const f32x4 x1 = *(const f32x4*)(X1 + (size_t)row * DM + col); const f32x4 x2 = x1 + v;
        *(f32x4*)(Y + (size_t)row * DM + col) = x2; return (x2[0] * x2[0] + x2[1] * x2[1]) + (x2[2] * x2[2] + x2[3] * x2[3]); }
    __device__ __forceinline__ void row_end(int row, float part, int fq, bool valid) const { part += __shfl_xor(part, 16); part += __shfl_xor(part, 32); if (fq == 0 && valid) atomicAdd(SUMSQ + row, part); }
};

typedef short bf16x8_t __attribute__((ext_vector_type(8)));
template <class F>
__device__ __forceinline__ void skinny_gemm(LAS unsigned char* lds, const bf16_t* A, int lda, const bf16_t* Bt, int N, int K, const F& f, int bid, int G, int tid) {
    const int lane = tid & 63, wave = __builtin_amdgcn_readfirstlane(tid >> 6), j = lane & 15, g = lane >> 4;
    LAS f32x4* red = (LAS f32x4*)lds;
    const int ksl = K >> 3;
    for (int it = bid; it < (N >> 4); it += G) {
        const int n0 = it * 16;
        const bf16_t* bp = Bt + (size_t)(n0 + j) * K + wave * ksl + 8 * g;
        const bf16_t* ap = A + (size_t)(j & 7) * lda + wave * ksl + 8 * g;
        f32x4 acc = {0.f, 0.f, 0.f, 0.f};
#pragma unroll 4
        for (int k = 0; k < ksl; k += 32) {
            const bf16x8_t b = *(const bf16x8_t*)(bp + k); bf16x8_t a = *(const bf16x8_t*)(ap + k);
            if (j >= 8) a = (bf16x8_t){0, 0, 0, 0, 0, 0, 0, 0};
            acc = __builtin_amdgcn_mfma_f32_16x16x32_bf16(b, a, acc, 0, 0, 0);
        }
        red[wave * 64 + lane] = acc;
        __syncthreads();
        if (wave == 0) { f32x4 sacc = red[lane];
#pragma unroll
            for (int w = 1; w < 8; ++w) sacc = sacc + red[w * 64 + lane];
            const int row = NPT + (j & 7); const bool valid = j < 8; const float ctx = f.row_begin(row); float part = 0.f;
            if (valid) part = f.store4(ctx, row, n0 + 4 * g, sacc);
            f.row_end(row, part, g, valid); }
        __syncthreads();
    }
}
struct F_proj_s { const Params& p;
    __device__ __forceinline__ float row_begin(int row) const { return p.RSTD1[row]; }
    __device__ __forceinline__ float store4(float rs, int row, int col, f32x4 v) const { const int n0 = in_colmap(col); if (n0 >= 0) {
#pragma unroll
        for (int i = 0; i < 4; ++i) proj_store(p, row, n0 + i, v[i] * rs); } return 0.f; }
    __device__ __forceinline__ void row_end(int, float, int, bool) const {}
};

template <class CM>
__device__ __forceinline__ void transpose_item(const float* W, int ldw, const float* kscale, bf16_t* WT, int K, int item, int nblk, CM cm, LAS float* scr, int lane) {
    const int kb = item / nblk, nb = item % nblk, k0 = 64 * kb, n0 = 32 * nb;
    const int sc = cm(n0 + (lane & 31));
#pragma unroll 8
    for (int i = 0; i < 32; ++i) { const int kk = 2 * i + (lane >> 5); float v = sc >= 0 ? W[(size_t)(k0 + kk) * ldw + sc] : 0.f; if (kscale) v *= kscale[k0 + kk]; scr[kk * 33 + (lane & 31)] = v; }
    LDS_WAIT(); asm volatile("" ::: "memory");
    const int c = lane & 7;
#pragma unroll
    for (int j = 0; j < 4; ++j) { const int n = (lane >> 3) + 8 * j; const LAS float* s = scr + (8 * c) * 33 + n;
        v4u o; o.x = pk2(s[0 * 33], s[1 * 33]); o.y = pk2(s[2 * 33], s[3 * 33]); o.z = pk2(s[4 * 33], s[5 * 33]); o.w = pk2(s[6 * 33], s[7 * 33]);
        *(v4u*)(WT + (size_t)(n0 + n) * K + k0 + 8 * c) = o; }
    LDS_WAIT(); asm volatile("" ::: "memory");
}
struct CM_id { __device__ __forceinline__ int operator()(int n) const { return n; } };
struct CM_in { __device__ __forceinline__ int operator()(int n) const { return in_colmap(n); } };

__device__ __forceinline__ void ph_prologue(const Params& p, LAS unsigned char* lds, int bid, int G, int tid) {
    const int lane = tid & 63, wave = tid >> 6, gw = bid * 8 + wave, NGW = G * 8;
    LAS float* scr = (LAS float*)(lds + wave * 16384);
    constexpr int I_IN = 32 * (NIN_PAD / 32), I_BR = 16 * 64, I_O = 32 * 64, I_UP = 32 * 256, I_DN = 128 * 64;
    constexpr int TOTAL = I_IN + 2 * I_BR + I_O + I_UP + I_DN;
    for (int it = gw; it < TOTAL; it += NGW) { int r = it;
        if (r < I_IN) { transpose_item(p.w_in, DIN, p.norm1_g, p.WIN_T, DM, r, NIN_PAD / 32, CM_in{}, scr, lane); continue; } r -= I_IN;
        if (r < I_BR) { transpose_item(p.w_br_a, DM, nullptr, p.WBRA_T, 1024, r, 64, CM_id{}, scr, lane); continue; } r -= I_BR;
        if (r < I_BR) { transpose_item(p.w_br_b, DM, nullptr, p.WBRB_T, 1024, r, 64, CM_id{}, scr, lane); continue; } r -= I_BR;
        if (r < I_O) { transpose_item(p.w_o, DM, nullptr, p.WO_T, DM, r, 64, CM_id{}, scr, lane); continue; } r -= I_O;
        if (r < I_UP) { transpose_item(p.w_up, DFF, p.norm2_g, p.WUP_T, DM, r, 256, CM_id{}, scr, lane); continue; } r -= I_UP;
        transpose_item(p.w_down, DM, nullptr, p.WDN_T, DFF, r, 64, CM_id{}, scr, lane);
    }
    for (int row = gw; row < NTOK; row += NGW) {
        const f32x4* xr = (const f32x4*)(row < NPT ? p.x_prompt + (size_t)row * DM : p.x_sample + (size_t)(row - NPT) * DM) + lane;
        f32x4 v[8]; float ss = 0.f;
#pragma unroll
        for (int j = 0; j < 8; ++j) { v[j] = xr[64 * j]; ss += (v[j][0] * v[j][0] + v[j][1] * v[j][1]) + (v[j][2] * v[j][2] + v[j][3] * v[j][3]); }
        ss = wave_sum(ss);
        v2u* o = (v2u*)(p.XB + (size_t)row * DM) + lane;
#pragma unroll
        for (int j = 0; j < 8; ++j) { v2u w; w.x = pk2(v[j][0], v[j][1]); w.y = pk2(v[j][2], v[j][3]); o[64 * j] = w; }
        if (lane == 0) p.RSTD1[row] = rsqrtf(ss * (1.f / DM) + EPS);
    }
    for (int i = bid * 512 + tid; i < DB * 511 * 64; i += G * 512) { const int c4 = i & 63, r = (i >> 6) % 511, b = (i >> 6) / 511;
        const size_t so = ((size_t)b * 512 + r + 1) * 256 + c4 * 4, dofs = ((size_t)b * 512 + r) * 256 + c4 * 4;
        *(f32x4*)(p.out + OFF_SWK + dofs) = *(const f32x4*)(p.cwk + so); *(f32x4*)(p.out + OFF_SWK + SZ_SWIN + dofs) = *(const f32x4*)(p.cwv + so); }
}
__device__ __forceinline__ void ph_final_norm(const Params& p, int bid, int G, int tid) {
    const int lane = tid & 63, wave = tid >> 6, gw = bid * 8 + wave, NGW = G * 8;
    for (int row = gw; row < NTOK; row += NGW) {
        float* yr = row < NPT ? p.out + OFF_Y + (size_t)row * DM : p.out + OFF_YS + (size_t)(row - NPT) * DM;
        const float r = rsqrtf(p.SUMSQ3[row] * (1.f / DM) + EPS);
        f32x4* y4 = (f32x4*)yr + lane; const f32x4* g4 = (const f32x4*)p.norm_f + lane;
#pragma unroll
        for (int j = 0; j < 8; ++j) { f32x4 v = y4[64 * j]; const f32x4 g = g4[64 * j]; v = v * r * g; y4[64 * j] = v; }
    }
}

__device__ __forceinline__ unsigned pk2t(float lo, float hi) { return pk2(lo, hi); }
template <bool IS_S>
__device__ __forceinline__ void cmp_gemm_tile(const Params& p, LAS unsigned char* lds, int tile, int tid) {
    const int lane = tid & 63, wave = __builtin_amdgcn_readfirstlane(tid >> 6), wm = wave >> 2, wn = wave & 3, fr = lane & 15, fg = lane >> 4;
    int kv, b, ct = 0, g = 0;
    if (IS_S) { ct = tile & 31; b = (tile >> 5) & 7; kv = tile >> 8; } else { g = tile & 3; b = (tile >> 2) & 3; kv = tile >> 4; }
    const bf16_t* W = p.W1T + (size_t)kv * 256 * 1024;
    const float* asf[4]; const bf16_t* asb[4];
#pragma unroll
    for (int q = 0; q < 4; ++q) { const int i = q * 32 + (tid >> 4), d4 = (tid & 15) * 4;
        if (IS_S) { const int cl = i >> 2, gg = i & 3, c = 32 * ct + cl; const int page = p.page_table[b * NPAGES + (c >> 3)];
            asf[q] = (kv ? p.ccv : p.cck) + (((size_t)page * PAGE + (c & 7) * 16) * 4 + gg) * 64 + d4; asb[q] = nullptr; }
        else { asb[q] = p.KV6 + ((size_t)(b * SEQ + 16 * i)) * 1536 + kv * 256 + g * 64 + d4; asf[q] = nullptr; } }
    const bf16_t* bsrc = W + (size_t)(tid >> 3) * 1024 + (tid & 7) * 8;
    f32x4 ra[4]; v2u rab[4]; v4u rb[4];
    auto load_regs = [&](int r) {
#pragma unroll
        for (int q = 0; q < 4; ++q) { if (IS_S) ra[q] = *(const f32x4*)(asf[q] + (size_t)r * 256); else rab[q] = *(const v2u*)(asb[q] + (size_t)r * 1536);
            rb[q] = *(const v4u*)(bsrc + (size_t)q * 64 * 1024 + r * 64); } };
    auto write_lds = [&](int s) { LAS unsigned char* ab = lds + s * 55296; LAS unsigned char* bb = ab + 18432;
#pragma unroll
        for (int q = 0; q < 4; ++q) { const int i = q * 32 + (tid >> 4), d4 = (tid & 15) * 4; v2u w;
            if (IS_S) { w.x = pk2(ra[q][0], ra[q][1]); w.y = pk2(ra[q][2], ra[q][3]); } else w = rab[q];
            *(LAS v2u*)(ab + i * 144 + d4 * 2) = w;
            *(LAS v4u*)(bb + (q * 64 + (tid >> 3)) * 144 + (tid & 7) * 16) = rb[q]; } };
    f32x4 acc[4][4];
#pragma unroll
    for (int mi = 0; mi < 4; ++mi)
#pragma unroll
        for (int ni = 0; ni < 4; ++ni) acc[mi][ni] = (f32x4){0.f, 0.f, 0.f, 0.f};
    load_regs(0); write_lds(0); __syncthreads();
    for (int r = 0; r < 16; ++r) {
        if (r + 1 < 16) load_regs(r + 1);
        const LAS unsigned char* ab = lds + (r & 1) * 55296; const LAS unsigned char* bb = ab + 18432;
#pragma unroll
        for (int ks = 0; ks < 2; ++ks) { bf16x8_t af[4], bfr[4];
#pragma unroll
            for (int mi = 0; mi < 4; ++mi) af[mi] = *(const LAS bf16x8_t*)(ab + (64 * wm + 16 * mi + fr) * 144 + (32 * ks + 8 * fg) * 2);
#pragma unroll
            for (int ni = 0; ni < 4; ++ni) bfr[ni] = *(const LAS bf16x8_t*)(bb + (64 * wn + 16 * ni + fr) * 144 + (32 * ks + 8 * fg) * 2);
#pragma unroll
            for (int mi = 0; mi < 4; ++mi)
#pragma unroll
                for (int ni = 0; ni < 4; ++ni) acc[mi][ni] = __builtin_amdgcn_mfma_f32_16x16x32_bf16(bfr[ni], af[mi], acc[mi][ni], 0, 0, 0); }
        if (r + 1 < 16) write_lds((r + 1) & 1);
        __syncthreads();
    }
    float* AB = IS_S ? p.AB_S + (size_t)kv * 32768 * 256 : p.AB_P + (size_t)kv * 2048 * 256;
#pragma unroll
    for (int mi = 0; mi < 4; ++mi) { const int i = 64 * wm + 16 * mi + fr; size_t R;
        if (IS_S) R = (size_t)(b * 4 + (i & 3)) * 1024 + 32 * ct + (i >> 2); else R = (size_t)(b * 4 + g) * 128 + i;
#pragma unroll
        for (int ni = 0; ni < 4; ++ni) *(f32x4*)(AB + R * 256 + 64 * wn + 16 * ni + 4 * fg) = acc[mi][ni]; }
}
template <bool IS_S>
__device__ __forceinline__ void cmp_part2(const Params& p, LAS unsigned char* lds, int kv, int bg, int i0, int tid) {
    constexpr int n_cmp = IS_S ? 1023 : 127, nrs = IS_S ? 1024 : 128;
    const int lane = tid & 63, wave = __builtin_amdgcn_readfirstlane(tid >> 6), fr = lane & 15, fg = lane >> 4;
    const float* AB = (IS_S ? p.AB_S + (size_t)kv * 32768 * 256 : p.AB_P + (size_t)kv * 2048 * 256) + (size_t)bg * nrs * 256;
    LAS unsigned char* H = lds; LAS unsigned char* W2T = lds + 128 * 272;
    const float* w2 = kv ? p.w2v : p.w2k; const float* bias = p.BIAS1 + kv * 128;
    for (int idx = tid; idx < 128 * 32; idx += 512) { const int row = idx >> 5, j4 = (idx & 31) * 4, i = i0 + row; v2u w; w.x = 0u; w.y = 0u;
        if (i < n_cmp) { const f32x4 a = *(const f32x4*)(AB + (size_t)i * 256 + j4), bq = *(const f32x4*)(AB + (size_t)(i + 1) * 256 + 128 + j4), bi = *(const f32x4*)(bias + j4);
            const f32x4 h = a + bq + bi; w.x = pk2(gelu_tanh(h[0]), gelu_tanh(h[1])); w.y = pk2(gelu_tanh(h[2]), gelu_tanh(h[3])); }
        *(LAS v2u*)(H + row * 272 + j4 * 2) = w; }
    for (int idx = tid; idx < 8192; idx += 512) { const int j = idx >> 6, d = idx & 63; *(LAS bf16_t*)(W2T + d * 272 + j * 2) = f2bf(w2[idx]); }
    __syncthreads();
    f32x4 acc[4];
#pragma unroll
    for (int ni = 0; ni < 4; ++ni) acc[ni] = (f32x4){0.f, 0.f, 0.f, 0.f};
#pragma unroll
    for (int ks = 0; ks < 4; ++ks) { const bf16x8_t hb = *(const LAS bf16x8_t*)(H + (16 * wave + fr) * 272 + (32 * ks + 8 * fg) * 2);
#pragma unroll
        for (int ni = 0; ni < 4; ++ni) { const bf16x8_t wa = *(const LAS bf16x8_t*)(W2T + (16 * ni + fr) * 272 + (32 * ks + 8 * fg) * 2);
            acc[ni] = __builtin_amdgcn_mfma_f32_16x16x32_bf16(wa, hb, acc[ni], 0, 0, 0); } }
    const int i = i0 + 16 * wave + fr;
    if (i < nrs) {
#pragma unroll
        for (int ni = 0; ni < 4; ++ni) { const int d = 16 * ni + 4 * fg;
            if (IS_S) { v2u w; w.x = pk2(acc[ni][0], acc[ni][1]); w.y = pk2(acc[ni][2], acc[ni][3]); *(v2u*)((kv ? p.VCMP_S : p.KCMP_S) + ((size_t)bg * 1024 + i) * 64 + d) = w; }
            else if (kv == 0) { v2u w; w.x = pk2(acc[ni][0], acc[ni][1]); w.y = pk2(acc[ni][2], acc[ni][3]); *(v2u*)(p.KCMP_P + ((size_t)bg * 128 + i) * 64 + d) = w; }
            else {
#pragma unroll
                for (int r = 0; r < 4; ++r) p.VCMPT_P[((size_t)bg * 64 + d + r) * 128 + i] = f2bf(acc[ni][r]); } } }
    __syncthreads();
}
__device__ __forceinline__ void ph_pro0(const Params& p, LAS unsigned char* lds, int bid, int G, int tid) {
    const int lane = tid & 63, wave = tid >> 6, gw = bid * 8 + wave, NGW = G * 8;
    LAS float* scr = (LAS float*)(lds + wave * 16384);
    for (int it = gw; it < 4 * 64; it += NGW) { const int q = it >> 6, r = it & 63, kv = q >> 1, half = q & 1;
        transpose_item((kv ? p.w1v : p.w1k) + (size_t)half * 1024 * 128, 128, nullptr, p.W1T + ((size_t)kv * 256 + half * 128) * 1024, 1024, r, 4, CM_id{}, scr, lane); }
    for (int i = bid * 512 + tid; i < NTOK; i += G * 512) { p.SUMSQ2[i] = 0.f; p.SUMSQ3[i] = 0.f; }
    __syncthreads();
    for (int it = bid; it < 4; it += G) { const int kv = it >> 1, jh = it & 1, j = jh * 64 + (tid & 63), ks = tid >> 6;
        const float* pe = kv ? p.pe_v : p.pe_k; const float* w1 = kv ? p.w1v : p.w1k; float s = 0.f;
        for (int k = ks * 256; k < ks * 256 + 256; ++k) s += pe[k] * w1[(size_t)k * 128 + j];
        LAS float* red = (LAS float*)lds; red[tid] = s; __syncthreads();
        if (tid < 64) { float t = 0.f; for (int w = 0; w < 8; ++w) t += red[w * 64 + tid]; p.BIAS1[kv * 128 + j] = t; }
        __syncthreads(); }
}

#define XB_TMO      128
#define XB_XCNT(j)  (256  + 64 * (j))
#define XB_XSUB(j)  (1280 + 64 * (j))
#define XB_XGEN(j)  (2304 + 64 * (j))
#define XB_TOP      3328
#define XB_TOPGEN   3392
#define XCD_BAR_WORDS 3456
#define XB_SPIN_CAP (1u << 22)

__device__ __forceinline__ unsigned xb_ld(unsigned* p)              { return __hip_atomic_load(p, __ATOMIC_RELAXED, __HIP_MEMORY_SCOPE_AGENT); }
__device__ __forceinline__ unsigned xb_add(unsigned* p, unsigned v) { return __hip_atomic_fetch_add(p, v, __ATOMIC_RELAXED, __HIP_MEMORY_SCOPE_AGENT); }
__device__ __forceinline__ unsigned xb_xcc_id() { return (unsigned)__builtin_amdgcn_s_getreg((3 << 11) | 20) & 0xFu; }
#define XB_SPIN(cond, bar) do { unsigned _sp = 0; while (cond) { __builtin_amdgcn_s_sleep(1); \
    if ((++_sp & 255u) == 0u) { if (xb_ld(&(bar)[XB_TMO])) break; if (_sp > XB_SPIN_CAP) { atomicAdd(&(bar)[XB_TMO], 1u); break; } } } } while (0)

struct XcdBarrier {
    unsigned* bar; unsigned x;
    volatile LAS unsigned* st;
};

__device__ __forceinline__ XcdBarrier xcd_barrier_post(unsigned* bar, volatile LAS unsigned* st) {
    XcdBarrier b; b.bar = bar; b.x = xb_xcc_id(); b.st = st;
    if (threadIdx.x == 0) (void)xb_add(&bar[XB_XCNT(b.x)], 1u);
    return b;
}
__device__ __forceinline__ void xcd_barrier_complete(unsigned* bar, unsigned x, unsigned& nloc, unsigned& nx) {
    const unsigned G = gridDim.x * gridDim.y * gridDim.z;
    unsigned sum, cnt, mine, sp = 0u;
    for (;;) {
        sum = 0u; cnt = 0u; mine = 0u;
#pragma unroll
        for (unsigned j = 0; j < 16; ++j) { const unsigned c = xb_ld(&bar[XB_XCNT(j)]); sum += c; cnt += (c > 0u) ? 1u : 0u; mine = (j == x) ? c : mine; }
        if (sum == G) break;
        __builtin_amdgcn_s_sleep(1);
        if ((++sp & 255u) == 0u) { if (xb_ld(&bar[XB_TMO])) break; if (sp > XB_SPIN_CAP) { atomicAdd(&bar[XB_TMO], 1u); break; } }
    }
    nloc = mine > 0u ? mine : 1u; nx = cnt > 0u ? cnt : 1u;
}

__device__ __forceinline__ void xcd_barrier(const XcdBarrier& b) {
    asm volatile("s_waitcnt vmcnt(0)" ::: "memory");
    __syncthreads();
    if (threadIdx.x == 0) {
        unsigned* bar = b.bar;
        __builtin_amdgcn_s_waitcnt(0);
        unsigned nloc = b.st[0], nx = b.st[1];
        if (nloc == 0u) { xcd_barrier_complete(bar, b.x, nloc, nx); b.st[0] = nloc; b.st[1] = nx; }
        const unsigned old = xb_add(&bar[XB_XSUB(b.x)], 1u);
        const unsigned gen = old / nloc;
        if (old + 1u == (gen + 1u) * nloc) {
            __builtin_amdgcn_fence(__ATOMIC_RELEASE, "agent");
            asm volatile("s_waitcnt vmcnt(0)" ::: "memory");
            const unsigned og = xb_add(&bar[XB_TOP], 1u);
            const unsigned tg = og / nx;
            if (og + 1u == (tg + 1u) * nx) xb_add(&bar[XB_TOPGEN], 1u);
            else XB_SPIN(xb_ld(&bar[XB_TOPGEN]) == tg, bar);
            __builtin_amdgcn_fence(__ATOMIC_ACQUIRE, "agent");
            xb_add(&bar[XB_XGEN(b.x)], 1u);
            asm volatile("s_waitcnt vmcnt(0)" ::: "memory");
        } else {
            XB_SPIN(xb_ld(&bar[XB_XGEN(b.x)]) == gen, bar);
            __builtin_amdgcn_fence(__ATOMIC_ACQUIRE, "agent");
            asm volatile("s_waitcnt vmcnt(0)" ::: "memory");
        }
    }
    __syncthreads();
}

constexpr int LDS_BYTES = 147456;
constexpr int LDSCTL_OFF = 131072, MISC_OFF = LDSCTL_OFF + 320;
constexpr int CW_BAR = 4096;
enum Phase { PH_PRO0 = 0, PH_PRO = 1, PH_IN = 2, PH_MID = 3, PH_ATT = 4, PH_BRA = 5, PH_BRB = 6, PH_WO = 7, PH_UP = 8, PH_DOWN = 9, PH_NORM = 10, PH_END = 11 };
__global__ void __launch_bounds__(512, 2) mk_fwd(Params p, int ph_lo, int ph_hi, int li) {
    extern __shared__ __attribute__((aligned(16))) unsigned char lds_raw[];
    LAS unsigned char* lds = (LAS unsigned char*)lds_raw;
    const int tid = threadIdx.x, bid = blockIdx.x, G = gridDim.x;
    for (int u = tid; u < (LDS_BYTES - LDSCTL_OFF) / 4; u += 512) ((LAS unsigned*)(lds + LDSCTL_OFF))[u] = 0u;
    __syncthreads();
    XcdBarrier bar; bar.bar = p.CTL + CW_BAR + li * XCD_BAR_WORDS; bar.x = 0; bar.st = nullptr;
    if (ph_hi - ph_lo > 1) bar = xcd_barrier_post(p.CTL + CW_BAR + li * XCD_BAR_WORDS, (volatile LAS unsigned*)(lds + MISC_OFF) + 8);
#define IN(k) (ph_lo <= (k) && (k) < ph_hi)
#define SEAM(k) do { if (ph_lo <= (k) && (k) + 1 < ph_hi) xcd_barrier(bar); } while (0)
    if (IN(PH_PRO0)) { ph_pro0(p, lds, bid, G, tid); SEAM(PH_PRO0); }
    if (IN(PH_PRO)) { for (int t = bid; t < 512; t += G) cmp_gemm_tile<true>(p, lds, t, tid);
        __syncthreads(); ph_prologue(p, lds, bid, G, tid); SEAM(PH_PRO); }
    if (IN(PH_IN)) { { pg8::Gemm g{p.XB, p.WIN_T, NPT, NIN_PAD, DM}; pg8::StaticOrder S; S.init(NPT, NIN_PAD, G, bid);
          EpiProj E{p.RSTD1, p.b_gate, p.QN, p.KV6, p.GQ, p.GK, p.GV, p.GR, p.BR, p.GATE, p.LR, p.out};
          pg8::gemm_phase<EpiProj, pg8::StaticOrder, true, true>(lds, g, S, E); }
        skinny_gemm(lds, p.XB + (size_t)NPT * DM, DM, p.WIN_T, NIN_PAD, DM, F_proj_s{p}, bid, G, tid); SEAM(PH_IN); }
    if (IN(PH_MID)) {
        for (int t = bid; t < 32; t += G) { cmp_gemm_tile<false>(p, lds, t, tid); __builtin_amdgcn_fence(__ATOMIC_RELEASE, "workgroup"); VM_WAIT(); __syncthreads(); cmp_part2<false>(p, lds, t >> 4, t & 15, 0, tid); }
        for (int it = bid; it < 512; it += G) cmp_part2<true>(p, lds, it >> 8, (it >> 3) & 31, (it & 7) * 128, tid);
        SEAM(PH_MID); }
    if (IN(PH_BRA)) { const F_bra f{p.BR, p.TMP};
        { pg8::Gemm g{p.OA, p.WBRA_T, NPT, DM, 1024}; pg8::StaticOrder S; S.init(NPT, DM, G, bid); EpiGen<F_bra> E{f}; pg8::gemm_phase<EpiGen<F_bra>, pg8::StaticOrder, true, true>(lds, g, S, E); }
        skinny_gemm(lds, p.OA + (size_t)NPT * 1024, 1024, p.WBRA_T, DM, 1024, f, bid, G, tid); SEAM(PH_BRA); }
    if (IN(PH_BRB)) { const F_brb f{p.BR, p.TMP, p.MB};
        { pg8::Gemm g{p.OB, p.WBRB_T, NPT, DM, 1024}; pg8::StaticOrder S; S.init(NPT, DM, G, bid); EpiGen<F_brb> E{f}; pg8::gemm_phase<EpiGen<F_brb>, pg8::StaticOrder, true, true>(lds, g, S, E); }
        skinny_gemm(lds, p.OB + (size_t)NPT * 1024, 1024, p.WBRB_T, DM, 1024, f, bid, G, tid); SEAM(PH_BRB); }
    if (IN(PH_WO)) {
        { const F_wo f{p.x_prompt, p.X1, p.X1B, p.SUMSQ2}; pg8::Gemm g{p.MB, p.WO_T, NPT, DM, DM}; pg8::StaticOrder S; S.init(NPT, DM, G, bid); EpiGen<F_wo> E{f}; pg8::gemm_phase<EpiGen<F_wo>, pg8::StaticOrder, true, true>(lds, g, S, E); }
        { const F_wo f{p.x_sample - (size_t)NPT * DM, p.X1, p.X1B, p.SUMSQ2}; skinny_gemm(lds, p.MB + (size_t)NPT * DM, DM, p.WO_T, DM, DM, f, bid, G, tid); } SEAM(PH_WO); }
    if (IN(PH_UP)) { const F_up f{p.SUMSQ2, p.HF};
        { pg8::Gemm g{p.X1B, p.WUP_T, NPT, DFF, DM}; pg8::StaticOrder S; S.init(NPT, DFF, G, bid); EpiGen<F_up> E{f}; pg8::gemm_phase<EpiGen<F_up>, pg8::StaticOrder, true, true>(lds, g, S, E); }
        skinny_gemm(lds, p.X1B + (size_t)NPT * DM, DM, p.WUP_T, DFF, DM, f, bid, G, tid); SEAM(PH_UP); }
    if (IN(PH_DOWN)) {
        { const F_down f{p.X1, p.out + OFF_Y, p.SUMSQ3}; pg8::Gemm g{p.HF, p.WDN_T, NPT, DM, DFF}; pg8::StaticOrder S; S.init(NPT, DM, G, bid); EpiGen<F_down> E{f}; pg8::gemm_phase<EpiGen<F_down>, pg8::StaticOrder, true, true>(lds, g, S, E); }
        { const F_down f{p.X1, p.out + OFF_YS - (size_t)NPT * DM, p.SUMSQ3}; skinny_gemm(lds, p.HF + (size_t)NPT * DFF, DFF, p.WDN_T, DM, DFF, f, bid, G, tid); } SEAM(PH_DOWN); }
    if (IN(PH_NORM)) ph_final_norm(p, bid, G, tid);
#undef IN
#undef SEAM
}
__global__ void __launch_bounds__(256) k_sumsq_rows(const float* X, size_t ld, float* ss_out, int nrows) {
    const int lane = threadIdx.x & 63, row = blockIdx.x * 4 + (threadIdx.x >> 6);
    if (row >= nrows) return;
    float ss = 0.f;
    for (int i = lane; i < DM; i += 64) { const float v = X[(size_t)row * ld + i]; ss += v * v; }
    ss = wave_sum(ss);
    if (lane == 0) ss_out[row] = ss;
}
struct EF_up2 { Params p; __device__ void operator()(int r, int n, float acc) const { const float v = fmaxf(acc * rsqrtf(p.SUMSQ2[r] * (1.f / DM) + EPS), 0.f); p.HF[(size_t)r * DFF + n] = f2bf(v * v); } };

static inline size_t align_up(size_t x) { return (x + 255) & ~(size_t)255; }

extern "C" void kernel_launch(void* const* d_in, const int* in_sizes, int n_in, void* d_out, int out_size, void* d_ws, size_t ws_size, hipStream_t stream) {
    if (n_in != 29 || out_size != (int)OUT_TOTAL) { fprintf(stderr, "kernel_launch: unexpected n_in %d / out_size %d\n", n_in, out_size); return; }
    static int grid = 0;
    if (grid == 0) {
        int dev = 0, cus = 0, per_cu = 0;
        if (hipGetDevice(&dev) != hipSuccess || hipDeviceGetAttribute(&cus, hipDeviceAttributeMultiprocessorCount, dev) != hipSuccess) { fprintf(stderr, "kernel_launch: device query failed\n"); grid = -1; return; }
        if (hipFuncSetAttribute((const void*)mk_fwd, hipFuncAttributeMaxDynamicSharedMemorySize, LDS_BYTES) != hipSuccess) { fprintf(stderr, "kernel_launch: hipFuncSetAttribute failed\n"); grid = -1; return; }
        if (hipOccupancyMaxActiveBlocksPerMultiprocessor(&per_cu, (const void*)mk_fwd, 512, LDS_BYTES) != hipSuccess || per_cu < 1) { fprintf(stderr, "kernel_launch: occupancy query says %d\n", per_cu); per_cu = 1; }
        (void)hipGetLastError();
        grid = cus;
    }
    if (grid < 0) return;
    Params p{};
    p.x_prompt = (const float*)d_in[0]; p.x_sample = (const float*)d_in[1]; p.cck = (const float*)d_in[2]; p.ccv = (const float*)d_in[3];
    p.csk = (const float*)d_in[4]; p.csv = (const float*)d_in[5]; p.cwk = (const float*)d_in[6]; p.cwv = (const float*)d_in[7]; p.state = (const float*)d_in[8];
    p.page_table = (const int*)d_in[9]; p.norm1_g = (const float*)d_in[10]; p.w_in = (const float*)d_in[11]; p.b_gate = (const float*)d_in[12];
    p.pe_k = (const float*)d_in[13]; p.pe_v = (const float*)d_in[14]; p.w1k = (const float*)d_in[15]; p.w2k = (const float*)d_in[16]; p.w1v = (const float*)d_in[17]; p.w2v = (const float*)d_in[18];
    p.w_a2 = (const float*)d_in[19]; p.b_a = (const float*)d_in[20]; p.gnorm = (const float*)d_in[21]; p.w_br_a = (const float*)d_in[22]; p.w_br_b = (const float*)d_in[23];
    p.w_o = (const float*)d_in[24]; p.norm2_g = (const float*)d_in[25]; p.w_up = (const float*)d_in[26]; p.w_down = (const float*)d_in[27]; p.norm_f = (const float*)d_in[28];
    p.out = (float*)d_out;
    char* ws = (char*)d_ws; size_t off = 0;
    auto take = [&](size_t bytes) { char* r = ws + off; off = align_up(off + bytes); return r; };
    p.CTL = (unsigned*)take(1 << 20);
    p.XB = (bf16_t*)take((size_t)NTOK * DM * 2); p.RSTD1 = (float*)take(NTOK * 4); p.QN = (bf16_t*)take((size_t)NTOK * 1024 * 2); p.KV6 = (bf16_t*)take((size_t)NTOK * 1536 * 2);
    p.GATE = (float*)take((size_t)NTOK * 48 * 4); p.GQ = (bf16_t*)take((size_t)NTOK * 512 * 2); p.GK = (bf16_t*)take((size_t)NTOK * 512 * 2); p.GV = (bf16_t*)take((size_t)NTOK * 1024 * 2);
    p.GR = (bf16_t*)take((size_t)NTOK * 1024 * 2); p.LR = (float*)take((size_t)NTOK * 16 * 4); p.BR = (bf16_t*)take((size_t)NTOK * 4096 * 2);
    p.KCMP_P = (bf16_t*)take(16 * 128 * 64 * 2); p.VCMPT_P = (bf16_t*)take(16 * 128 * 64 * 2); p.KCMP_S = (bf16_t*)take(32 * 1024 * 64 * 2); p.VCMP_S = (bf16_t*)take(32 * 1024 * 64 * 2);
    p.OA = (bf16_t*)take((size_t)NTOK * 1024 * 2); p.OB = (bf16_t*)take((size_t)NTOK * 1024 * 2); p.TMP = (float*)take((size_t)NTOK * DM * 4); p.MB = (bf16_t*)take((size_t)NTOK * DM * 2);
    p.X1 = (float*)take((size_t)NTOK * DM * 4); p.X1B = (bf16_t*)take((size_t)NTOK * DM * 2); p.RSTD2 = (float*)take(NTOK * 4); p.HF = (bf16_t*)take((size_t)NTOK * DFF * 2);
    p.WIN_T = (bf16_t*)take((size_t)NIN_PAD * DM * 2); p.WBRA_T = (bf16_t*)take((size_t)DM * 1024 * 2); p.WBRB_T = (bf16_t*)take((size_t)DM * 1024 * 2); p.WO_T = (bf16_t*)take((size_t)DM * DM * 2);
    p.WUP_T = (bf16_t*)take((size_t)DFF * DM * 2); p.WDN_T = (bf16_t*)take((size_t)DM * DFF * 2); p.SUMSQ2 = (float*)take(NTOK * 4); p.SUMSQ3 = (float*)take(NTOK * 4);
    p.W1T = (bf16_t*)take(2 * 256 * 1024 * 2); p.BIAS1 = (float*)take(256 * 4); p.AB_S = (float*)take((size_t)2 * 32768 * 256 * 4); p.AB_P = (float*)take((size_t)2 * 2048 * 256 * 4);
    if (off > ws_size) { fprintf(stderr, "kernel_launch: workspace too small: need %zu have %zu\n", off, ws_size); return; }
    hipMemsetAsync(p.CTL, 0, 1 << 20, stream);
#define MK(lo, hi, li) hipLaunchKernelGGL(mk_fwd, dim3(grid), dim3(512), LDS_BYTES, stream, p, (int)(lo), (int)(hi), (int)(li))
    MK(PH_PRO0, PH_IN + 1, 0);
    MK(PH_MID, PH_MID + 1, 1);
    k_nsa_naive<<<dim3(NTOK, 4), 256, 0, stream>>>(p, 0);
    k_gla_naive<<<16, 512, 0, stream>>>(p, 0);
    k_gla_naive<<<32, 512, 0, stream>>>(p, 1);
    MK(PH_BRA, PH_END, 2);
}
```

```cpp
#include <hip/hip_runtime.h>
#include <stdint.h>
#include <cstdio>

typedef unsigned short bf16_t;

constexpr int DM = 2048, NB = 4, SEQ = 2048, NPT = NB * SEQ, DB = 8, NTOK = NPT + DB;
constexpr int PAST = 16384, PAGE = 128, NPAGES = 128;
constexpr int NG = 4, HPG = 4, DH = 64;
constexpr int DIN = 9792, DFF = 8192;
constexpr int C_Q = 0, C_KV = 1024, C_G = 2560, C_QL = 2608, C_KL = 3120, C_VL = 3632, C_RL = 4656, C_LR = 5680, C_BR = 5696;
constexpr float EPS = 1e-6f;
constexpr size_t OFF_Y = 0, OFF_YS = (size_t)NPT * DM, OFF_PCK = OFF_YS + (size_t)DB * DM;
constexpr size_t SZ_PROW = (size_t)NPT * 256;
constexpr size_t OFF_PWK = OFF_PCK + 4 * SZ_PROW, SZ_PWIN = (size_t)NB * 512 * 256;
constexpr size_t OFF_PGLA = OFF_PWK + 2 * SZ_PWIN, SZ_PGLA = (size_t)NB * 4 * 128 * 256;
constexpr size_t OFF_SCK = OFF_PGLA + SZ_PGLA, SZ_SROW = (size_t)DB * 256;
constexpr size_t OFF_SWK = OFF_SCK + 4 * SZ_SROW, SZ_SWIN = (size_t)DB * 512 * 256;
constexpr size_t OFF_SGLA = OFF_SWK + 2 * SZ_SWIN, SZ_SGLA = (size_t)DB * 4 * 128 * 256;
constexpr size_t OUT_TOTAL = OFF_SGLA + SZ_SGLA;
static_assert(OUT_TOTAL == 29908992, "output size");

__device__ __forceinline__ bf16_t f2bf(float f) { unsigned u = __builtin_bit_cast(unsigned, f); return (bf16_t)((u + 0x7fffu + ((u >> 16) & 1u)) >> 16); }
__device__ __forceinline__ float bf2f(bf16_t h) { return __builtin_bit_cast(float, (unsigned)h << 16); }
__device__ __forceinline__ float sigmoidf_(float x) { return 1.f / (1.f + __expf(-x)); }
__device__ __forceinline__ float siluf_(float x) { return x / (1.f + __expf(-x)); }
__device__ __forceinline__ float gelu_tanh(float x) { const float u = 0.7978845608028654f * (x + 0.044715f * x * x * x); return 0.5f * x * (1.f + tanhf(u)); }
__device__ __forceinline__ float logsigmoidf_(float x) { return fminf(x, 0.f) - log1pf(__expf(-fabsf(x))); }
__device__ __forceinline__ float wave_sum(float v) {
#pragma unroll
    for (int o = 1; o < 64; o <<= 1) v += __shfl_xor(v, o);
    return v;
}
__device__ __forceinline__ float wave_max(float v) {
#pragma unroll
    for (int o = 1; o < 64; o <<= 1) v = fmaxf(v, __shfl_xor(v, o));
    return v;
}

struct Params {
    const float *x_prompt, *x_sample, *cck, *ccv, *csk, *csv, *cwk, *cwv, *state;
    const int* page_table;
    const float *norm1_g, *w_in, *b_gate, *pe_k, *pe_v, *w1k, *w2k, *w1v, *w2v, *w_a2, *b_a, *gnorm, *w_br_a, *w_br_b, *w_o, *norm2_g, *w_up, *w_down, *norm_f;
    float* out;
    bf16_t *XB, *QN, *KV6, *GQ, *GK, *GV, *GR, *BR, *KCMP_P, *VCMPT_P, *KCMP_S, *VCMP_S, *OA, *OB, *MB, *X1B, *HF;
    float *RSTD1, *GATE, *LR, *TMP, *X1, *RSTD2;
    bf16_t *WIN_T, *WBRA_T, *WBRB_T, *WO_T, *WUP_T, *WDN_T;
    float *SUMSQ2, *SUMSQ3;
    unsigned* CTL;
    bf16_t* W1T; float *BIAS1, *AB_S, *AB_P;
    float *UT, *DEC; bf16_t* SNT;
};

__device__ __forceinline__ float xval(const Params& p, int row, int n) { return row < NPT ? p.x_prompt[(size_t)row * DM + n] : p.x_sample[(size_t)(row - NPT) * DM + n]; }

__device__ __forceinline__ void proj_store(const Params& p, int row, int n, float v) {
    if (n < C_KV) p.QN[(size_t)row * 1024 + n] = f2bf(v * 0.125f);
    else if (n < C_G) {
        const int c = n - C_KV; p.KV6[(size_t)row * 1536 + c] = f2bf(v); const int j = c >> 8, cc = c & 255;
        if (row < NPT) { const int b = row >> 11, t = row & 2047;
            if (j < 4) p.out[OFF_PCK + j * SZ_PROW + (size_t)row * 256 + cc] = v;
            else if (t >= 1536) p.out[OFF_PWK + (j - 4) * SZ_PWIN + ((size_t)b * 512 + t - 1536) * 256 + cc] = v; }
        else { const int b = row - NPT;
            if (j < 4) p.out[OFF_SCK + j * SZ_SROW + (size_t)b * 256 + cc] = v;
            else p.out[OFF_SWK + (j - 4) * SZ_SWIN + ((size_t)b * 512 + 511) * 256 + cc] = v; }
    }
    else if (n < C_QL) { const int c = n - C_G; p.GATE[(size_t)row * 48 + c] = sigmoidf_(v + p.b_gate[c]); }
    else if (n < C_KL) p.GQ[(size_t)row * 512 + (n - C_QL)] = f2bf(v * 0.08838834764831845f);
    else if (n < C_VL) p.GK[(size_t)row * 512 + (n - C_KL)] = f2bf(v);
    else if (n < C_RL) p.GV[(size_t)row * 1024 + (n - C_VL)] = f2bf(v);
    else if (n < C_LR) p.GR[(size_t)row * 1024 + (n - C_RL)] = f2bf(siluf_(v));
    else if (n < C_BR) p.LR[(size_t)row * 16 + (n - C_LR)] = v;
    else p.BR[(size_t)row * 4096 + (n - C_BR)] = f2bf(sigmoidf_(v));
}

__global__ void __launch_bounds__(256) k_prep_x(Params p) {
    const int lane = threadIdx.x & 63, row = blockIdx.x * 4 + (threadIdx.x >> 6);
    if (row >= NTOK) return;
    const float* xr = row < NPT ? p.x_prompt + (size_t)row * DM : p.x_sample + (size_t)(row - NPT) * DM;
    float ss = 0.f;
    for (int i = lane; i < DM; i += 64) { const float v = xr[i]; ss += v * v; p.XB[(size_t)row * DM + i] = f2bf(v); }
    ss = wave_sum(ss);
    if (lane == 0) p.RSTD1[row] = rsqrtf(ss * (1.f / DM) + EPS);
}
__global__ void __launch_bounds__(256) k_copy_swin(Params p) {
    const size_t i = (size_t)blockIdx.x * 256 + threadIdx.x;
    if (i >= (size_t)DB * 511 * 256) return;
    const int c = (int)(i & 255); const int r = (int)((i >> 8) % 511); const int b = (int)((i >> 8) / 511);
    p.out[OFF_SWK + ((size_t)b * 512 + r) * 256 + c] = p.cwk[((size_t)b * 512 + r + 1) * 256 + c];
    p.out[OFF_SWK + SZ_SWIN + ((size_t)b * 512 + r) * 256 + c] = p.cwv[((size_t)b * 512 + r + 1) * 256 + c];
}
__global__ void __launch_bounds__(256) k_rms_rows(const float* X, float* rstd, int nrows) {
    const int lane = threadIdx.x & 63, row = blockIdx.x * 4 + (threadIdx.x >> 6);
    if (row >= nrows) return;
    float ss = 0.f;
    for (int i = lane; i < DM; i += 64) { const float v = X[(size_t)row * DM + i]; ss += v * v; }
    ss = wave_sum(ss);
    if (lane == 0) rstd[row] = rsqrtf(ss * (1.f / DM) + EPS);
}
__global__ void __launch_bounds__(256) k_final_norm(Params p) {
    const int lane = threadIdx.x & 63, row = blockIdx.x * 4 + (threadIdx.x >> 6);
    if (row >= NTOK) return;
    float* yr = row < NPT ? p.out + OFF_Y + (size_t)row * DM : p.out + OFF_YS + (size_t)(row - NPT) * DM;
    float ss = 0.f;
    for (int i = lane; i < DM; i += 64) { const float v = yr[i]; ss += v * v; }
    ss = wave_sum(ss);
    const float r = rsqrtf(ss * (1.f / DM) + EPS);
    for (int i = lane; i < DM; i += 64) yr[i] = yr[i] * r * p.norm_f[i];
}

template <class AF, class BF, class EF>
__global__ void __launch_bounds__(256) k_gemm_naive(int m_off, int M, int N, int K, AF af, BF bf, EF ef) {
    __shared__ float As[16][68], Bs[16][68];
    const int tid = threadIdx.x, tx = tid & 15, ty = tid >> 4, m0 = m_off + blockIdx.y * 64, n0 = blockIdx.x * 64;
    float acc[4][4];
#pragma unroll
    for (int i = 0; i < 4; ++i)
#pragma unroll
        for (int j = 0; j < 4; ++j) acc[i][j] = 0.f;
    for (int k0 = 0; k0 < K; k0 += 16) {
#pragma unroll
        for (int i = 0; i < 4; ++i) { const int idx = tid + 256 * i, r = idx >> 4, kk = idx & 15; As[kk][r] = (m0 + r < M) ? af(m0 + r, k0 + kk) : 0.f; }
#pragma unroll
        for (int i = 0; i < 4; ++i) { const int idx = tid + 256 * i, kk = idx >> 6, c = idx & 63; Bs[kk][c] = (n0 + c < N) ? bf(k0 + kk, n0 + c) : 0.f; }
        __syncthreads();
#pragma unroll
        for (int kk = 0; kk < 16; ++kk) {
            float a[4], b[4];
#pragma unroll
            for (int i = 0; i < 4; ++i) { a[i] = As[kk][ty * 4 + i]; b[i] = Bs[kk][tx * 4 + i]; }
#pragma unroll
            for (int i = 0; i < 4; ++i)
#pragma unroll
                for (int j = 0; j < 4; ++j) acc[i][j] += a[i] * b[j];
        }
        __syncthreads();
    }
#pragma unroll
    for (int i = 0; i < 4; ++i)
#pragma unroll
        for (int j = 0; j < 4; ++j) { const int r = m0 + ty * 4 + i, c = n0 + tx * 4 + j; if (r < M && c < N) ef(r, c, acc[i][j]); }
}
struct AF_x_g1 { Params p; __device__ float operator()(int r, int k) const { return xval(p, r, k) * p.norm1_g[k]; } };
struct BF_rowmajor { const float* W; long ld; __device__ float operator()(int k, int n) const { return W[(size_t)k * ld + n]; } };
struct EF_proj { Params p; __device__ void operator()(int r, int n, float acc) const { proj_store(p, r, n, acc * p.RSTD1[r]); } };
struct AF_bf { const bf16_t* A; long ld; __device__ float operator()(int r, int k) const { return bf2f(A[(size_t)r * ld + k]); } };
struct EF_bra { Params p; __device__ void operator()(int r, int n, float acc) const { p.TMP[(size_t)r * DM + n] = acc * bf2f(p.BR[(size_t)r * 4096 + n]); } };
struct EF_brb { Params p; __device__ void operator()(int r, int n, float acc) const { p.MB[(size_t)r * DM + n] = f2bf(p.TMP[(size_t)r * DM + n] + acc * bf2f(p.BR[(size_t)r * 4096 + 2048 + n])); } };
struct EF_wo { Params p; __device__ void operator()(int r, int n, float acc) const { const float x1 = xval(p, r, n) + acc; p.X1[(size_t)r * DM + n] = x1; p.X1B[(size_t)r * DM + n] = f2bf(x1); } };
struct AF_x1_g2 { Params p; __device__ float operator()(int r, int k) const { return bf2f(p.X1B[(size_t)r * DM + k]) * p.norm2_g[k]; } };
struct EF_up { Params p; __device__ void operator()(int r, int n, float acc) const { const float v = fmaxf(acc * p.RSTD2[r], 0.f); p.HF[(size_t)r * DFF + n] = f2bf(v * v); } };
struct EF_down { Params p; __device__ void operator()(int r, int n, float acc) const { const float x2 = p.X1[(size_t)r * DM + n] + acc;
    if (r < NPT) p.out[OFF_Y + (size_t)r * DM + n] = x2; else p.out[OFF_YS + (size_t)(r - NPT) * DM + n] = x2; } };

__global__ void __launch_bounds__(128) k_compress_naive(Params p, int is_s) {
    const int n_cmp = is_s ? 1023 : 127, n_pad = is_s ? 1024 : 128;
    const int kv = blockIdx.y, tid = threadIdx.x;
    const int i = blockIdx.x % n_pad, bg = blockIdx.x / n_pad, b = bg >> 2, g = bg & 3;
    __shared__ float blk[2048]; __shared__ float hid[128];
    if (i >= n_cmp) {
        if (tid < 64) { if (is_s) { (kv ? p.VCMP_S : p.KCMP_S)[((size_t)bg * 1024 + i) * 64 + tid] = 0; }
                        else { if (kv) p.VCMPT_P[((size_t)bg * 64 + tid) * 128 + i] = 0; else p.KCMP_P[((size_t)bg * 128 + i) * 64 + tid] = 0; } }
        return;
    }
    const float* pe = kv ? p.pe_v : p.pe_k; const float* w1 = kv ? p.w1v : p.w1k; const float* w2 = kv ? p.w2v : p.w2k;
    for (int e = tid; e < 2048; e += 128) { const int l = e >> 6, d = e & 63; const int pos = 16 * i + l; float v;
        if (is_s) { const int page = p.page_table[b * NPAGES + (pos >> 7)]; v = (kv ? p.ccv : p.cck)[(((size_t)page * PAGE + (pos & 127)) * 4 + g) * 64 + d]; }
        else v = bf2f(p.KV6[((size_t)b * SEQ + pos) * 1536 + kv * 256 + g * 64 + d]);
        blk[e] = v + pe[e]; }
    __syncthreads();
    float h = 0.f;
    for (int k = 0; k < 2048; ++k) h += blk[k] * w1[(size_t)k * 128 + tid];
    hid[tid] = gelu_tanh(h);
    __syncthreads();
    if (tid < 64) { float o = 0.f; for (int j = 0; j < 128; ++j) o += hid[j] * w2[j * 64 + tid];
        if (is_s) (kv ? p.VCMP_S : p.KCMP_S)[((size_t)bg * 1024 + i) * 64 + tid] = f2bf(o);
        else { if (kv) p.VCMPT_P[((size_t)bg * 64 + tid) * 128 + i] = f2bf(o); else p.KCMP_P[((size_t)bg * 128 + i) * 64 + tid] = f2bf(o); } }
}

struct RowRef { const float* pf; const bf16_t* pb; };
__device__ __forceinline__ float rr_get(const RowRef& r, int d) { return r.pf ? r.pf[d] : bf2f(r.pb[d]); }

template <class KF, class VF>
__device__ __forceinline__ void attend_naive(int nk, KF keyf, VF valf, const float (*q)[64], float (*sc)[1088], float (*oacc)[64], const float* gate3, int gsel, int tid) {
    const int lane = tid & 63, wv = tid >> 6;
    for (int kk = tid; kk < nk; kk += 256) { bool valid; const RowRef r = keyf(kk, valid);
        if (valid) { float d0 = 0.f, d1 = 0.f, d2 = 0.f, d3 = 0.f;
            for (int d = 0; d < 64; ++d) { const float kx = rr_get(r, d); d0 += q[0][d] * kx; d1 += q[1][d] * kx; d2 += q[2][d] * kx; d3 += q[3][d] * kx; }
            sc[0][kk] = d0; sc[1][kk] = d1; sc[2][kk] = d2; sc[3][kk] = d3; }
        else { sc[0][kk] = -INFINITY; sc[1][kk] = -INFINITY; sc[2][kk] = -INFINITY; sc[3][kk] = -INFINITY; } }
    __syncthreads();
    {
        float m = -INFINITY; for (int kk = lane; kk < nk; kk += 64) m = fmaxf(m, sc[wv][kk]);
        m = wave_max(m);
        float s = 0.f;
        for (int kk = lane; kk < nk; kk += 64) { const float x = sc[wv][kk]; const float e = (x == -INFINITY) ? 0.f : __expf(x - m); sc[wv][kk] = e; s += e; }
        s = wave_sum(s);
        const float inv = s > 0.f ? 1.f / s : 0.f;
        for (int kk = lane; kk < nk; kk += 64) sc[wv][kk] *= inv;
    }
    __syncthreads();
    {
        float o = 0.f;
        for (int kk = 0; kk < nk; ++kk) { const float pr = sc[wv][kk]; if (pr != 0.f) o += pr * valf(kk, lane); }
        oacc[wv][lane] += gate3[wv * 3 + gsel] * o;
    }
    __syncthreads();
}

__global__ void __launch_bounds__(256) k_nsa_naive(Params p, int row0) {
    const int row = row0 + blockIdx.x, g = blockIdx.y, tid = threadIdx.x;
    const bool is_s = row >= NPT; const int b = is_s ? row - NPT : row >> 11, t = is_s ? 0 : row & 2047;
    const int start = is_s ? PAST : 0, pos = start + t, rowbase = is_s ? NPT + b : b * SEQ;
    const int n_cmp = is_s ? 1023 : 127, n_slc = is_s ? 257 : 32;
    __shared__ float q[4][64]; __shared__ float sc[4][1088]; __shared__ float oacc[4][64]; __shared__ float gate3[12];
    __shared__ float score[260]; __shared__ int selidx[16];
    { const int hd = tid >> 6, d = tid & 63; q[hd][d] = bf2f(p.QN[(size_t)row * 1024 + (g * 4 + hd) * 64 + d]); oacc[hd][d] = 0.f; }
    if (tid < 12) gate3[tid] = p.GATE[(size_t)row * 48 + g * 12 + tid];
    __syncthreads();
    const int bg = b * 4 + g;
    const bf16_t* kc = is_s ? p.KCMP_S + (size_t)bg * 1024 * 64 : p.KCMP_P + (size_t)bg * 128 * 64;
    const bf16_t* vc_s = p.VCMP_S + (size_t)bg * 1024 * 64; const bf16_t* vc_p = p.VCMPT_P + (size_t)bg * 64 * 128;
    auto kf_c = [&](int kk, bool& valid) { valid = (16 * kk + 31 <= pos); return RowRef{nullptr, kc + (size_t)kk * 64}; };
    auto vf_c = [&](int kk, int d) { return is_s ? bf2f(vc_s[(size_t)kk * 64 + d]) : bf2f(vc_p[(size_t)d * 128 + kk]); };
    attend_naive(n_cmp, kf_c, vf_c, q, sc, oacc, gate3, 0, tid);
    for (int j = tid; j < n_slc; j += 256) { float s = 0.f;
        for (int i = 4 * j - 1; i <= 4 * j + 3; ++i) if (i >= 0 && i < n_cmp) s += (sc[0][i] + sc[1][i]) + (sc[2][i] + sc[3][i]);
        score[j] = (j * 64 <= pos) ? s + ((j == 0 || j == pos / 64) ? 1e4f : 0.f) : -1e30f; }
    __syncthreads();
    for (int j = tid; j < n_slc; j += 256) { const float sj = score[j]; int rank = 0;
        for (int j2 = 0; j2 < n_slc; ++j2) { const float s2 = score[j2]; rank += (s2 > sj || (s2 == sj && j2 < j)) ? 1 : 0; }
        if (rank < 16) selidx[rank] = j; }
    __syncthreads();
    auto row_at = [&](int kp, int which) -> RowRef {
        if (kp < start) {
            if (which < 4) { const int page = p.page_table[b * NPAGES + (kp >> 7)]; const float* c = (which == 2) ? p.csk : p.csv; return RowRef{c + (((size_t)page * PAGE + (kp & 127)) * 4 + g) * 64, nullptr}; }
            const float* c = (which == 4) ? p.cwk : p.cwv; return RowRef{c + (((size_t)b * 512 + (kp - (PAST - 512))) * 4 + g) * 64, nullptr};
        }
        return RowRef{nullptr, p.KV6 + (size_t)(rowbase + kp - start) * 1536 + which * 256 + g * 64};
    };
    auto kf_s = [&](int kk, bool& valid) { const int kp = selidx[kk >> 6] * 64 + (kk & 63); valid = (kp <= pos); return valid ? row_at(kp, 2) : RowRef{nullptr, nullptr}; };
    auto vf_s = [&](int kk, int d) { const int kp = selidx[kk >> 6] * 64 + (kk & 63); return rr_get(row_at(kp, 3), d); };
    attend_naive(1024, kf_s, vf_s, q, sc, oacc, gate3, 1, tid);
    auto kf_w = [&](int kk, bool& valid) { const int kp = pos - 512 + kk; valid = (kp >= 0); return valid ? row_at(kp, 4) : RowRef{nullptr, nullptr}; };
    auto vf_w = [&](int kk, int d) { const int kp = pos - 512 + kk; return rr_get(row_at(kp, 5), d); };
    attend_naive(513, kf_w, vf_w, q, sc, oacc, gate3, 2, tid);
    { const int hd = tid >> 6, d = tid & 63; p.OA[(size_t)row * 1024 + (g * 4 + hd) * 64 + d] = f2bf(oacc[hd][d]); }
}

__global__ void __launch_bounds__(512) k_gla_naive(Params p, int is_s) {
    const int b = blockIdx.x >> 2, h = blockIdx.x & 3, tid = threadIdx.x, e = tid & 255, half = tid >> 8;
    const int T = is_s ? 1 : SEQ, rowbase = is_s ? NPT + b : b * SEQ;
    __shared__ float a_s[128], q_s[128], k_s[128], part[2][256], red[8];
    float S[64];
#pragma unroll
    for (int dd = 0; dd < 64; ++dd) S[dd] = is_s ? p.state[(((size_t)b * 4 + h) * 128 + half * 64 + dd) * 256 + e] : 0.f;
    for (int t = 0; t < T; ++t) {
        const int row = rowbase + t;
        if (tid < 128) { float x = p.b_a[h * 128 + tid];
            for (int r = 0; r < 16; ++r) x += p.LR[(size_t)row * 16 + r] * p.w_a2[r * 512 + h * 128 + tid];
            a_s[tid] = __expf(logsigmoidf_(x) * (1.f / 16.f));
            q_s[tid] = bf2f(p.GQ[(size_t)row * 512 + h * 128 + tid]); k_s[tid] = bf2f(p.GK[(size_t)row * 512 + h * 128 + tid]); }
        const float v = bf2f(p.GV[(size_t)row * 1024 + h * 256 + e]);
        __syncthreads();
        float po = 0.f;
#pragma unroll
        for (int dd = 0; dd < 64; ++dd) { const int d = half * 64 + dd; S[dd] = a_s[d] * S[dd] + k_s[d] * v; po += q_s[d] * S[dd]; }
        part[half][e] = po;
        __syncthreads();
        float o = 0.f;
        if (tid < 256) { o = part[0][e] + part[1][e]; const float ss = wave_sum(o * o); if ((tid & 63) == 0) red[tid >> 6] = ss; }
        __syncthreads();
        if (tid < 256) { const float ss = (red[0] + red[1]) + (red[2] + red[3]); const float r = rsqrtf(ss * (1.f / 256.f) + EPS);
            p.OB[(size_t)row * 1024 + h * 256 + e] = f2bf(o * r * p.gnorm[e] * bf2f(p.GR[(size_t)row * 1024 + h * 256 + e])); }
    }
    float* so = p.out + (is_s ? OFF_SGLA : OFF_PGLA);
#pragma unroll
    for (int dd = 0; dd < 64; ++dd) so[(((size_t)b * 4 + h) * 128 + half * 64 + dd) * 256 + e] = S[dd];
}

#define GAS __attribute__((address_space(1)))
#define LAS __attribute__((address_space(3)))
typedef unsigned v4u __attribute__((ext_vector_type(4)));
typedef unsigned v2u __attribute__((ext_vector_type(2)));
#define LDS_WAIT() asm volatile("s_waitcnt lgkmcnt(0)" ::: "memory")
#define VM_WAIT() asm volatile("s_waitcnt vmcnt(0)" ::: "memory")
__device__ __forceinline__ unsigned pk2(float lo, float hi) { return (unsigned)f2bf(lo) | ((unsigned)f2bf(hi) << 16); }
constexpr int NIN_PAD = 9984;
__host__ __device__ __forceinline__ int in_colmap(int n) {
    if (n < 2560) return n; if (n < 3072) return C_QL + (n - 2560); if (n < 3584) return C_KL + (n - 3072); if (n < 4608) return C_VL + (n - 3584);
    if (n < 5632) return C_RL + (n - 4608); if (n < 9728) return C_BR + (n - 5632); if (n < 9776) return C_G + (n - 9728); if (n < 9792) return C_LR + (n - 9776); return -1;
}
namespace pg8 {
#define PG8_LAS __attribute__((address_space(3)))
typedef unsigned short bf16_t;
typedef short bf16x8 __attribute__((ext_vector_type(8)));
typedef float f32x4 __attribute__((ext_vector_type(4)));
typedef unsigned u32x4 __attribute__((ext_vector_type(4)));
constexpr int BM = 256, BK = 64, HALF = 128, HTB = HALF * BK * 2  , STAGE_BYTES = 8 * HTB, NXCD = 8, WGM = 8;

__host__ __device__ __forceinline__ int lds_byte(int r, int c) { const int st = (r >> 4) * 2 + (c >> 5), rr = r & 15, cc = c & 31, ob = rr * 64 + cc * 2; return st * 1024 + (ob ^ (((ob >> 9) & 1) << 5)); }
__host__ __device__ __forceinline__ void stage_rc(int b, int& R, int& C) { const int st = b / 1024, sb = b % 1024, swz = sb ^ (((sb >> 9) & 1) << 5); R = (st >> 1) * 16 + swz / 64; C = (st & 1) * 32 + (swz % 64) / 2; }
__host__ __device__ __forceinline__ int perm32(int rho) { const int n = rho >> 4, i = rho & 15; return 8 * (i >> 2) + 4 * n + (i & 3); }

struct Unit { int pm, pn; };
struct Gemm { const bf16_t* A; const bf16_t* Bt; int M, N, K; };

struct StaticOrder {
    int nM, nN, nwg, G, c;
    __host__ __device__ void init(int M, int N, int G_, int c_) { nM = M / BM; nN = N / BM; nwg = nM * nN; G = G_; c = c_; }
    __host__ __device__ bool next(int i, Unit& u) const {
        const long L = (long)i * G + c; if (L >= nwg) return false;
        int wgid = (int)L; { const int q = nwg / NXCD, r = nwg % NXCD, xcd = wgid % NXCD, off = wgid / NXCD; wgid = (xcd < r ? xcd * (q + 1) : r * (q + 1) + (xcd - r) * q) + off; }
        const int nig = WGM * nN, gid = wgid / nig, fm = gid * WGM, gsz = (nM - fm) < WGM ? (nM - fm) : WGM;
        u.pm = fm + ((wgid % nig) % gsz); u.pn = (wgid % nig) / gsz; return true;
    }
    __device__ __forceinline__ void a_ready(const Unit&) const {}
    __device__ __forceinline__ void done(const Unit&) const {}
};

template <class Epi, class Sched, bool ALIGN_EPI = false, bool SP2 = false>
__device__ __forceinline__ void gemm_phase(PG8_LAS unsigned char* lds, const Gemm g, const Sched& S, const Epi& E) {
    const int tid = threadIdx.x, wid = __builtin_amdgcn_readfirstlane(tid >> 6), lane = tid & 63, wr = wid >> 2, wc = wid & 3, fr = lane & 15, fq = lane >> 4;
    const int K = g.K, nt = K / BK;
    unsigned voffA[2], voffB[2];
#pragma unroll
    for (int i = 0; i < 2; ++i) { int R, C; stage_rc(tid * 16 + i * 8192, R, C); const int Rb = Epi::PERM ? ((R & ~31) + perm32(R & 31)) : R;
        voffA[i] = (unsigned)(R * K + C) * 2u; voffB[i] = (unsigned)(Rb * K + C) * 2u; }
    const size_t kstep = (size_t)(BK * 2);
    const size_t hstep = (size_t)HALF * K * 2;
    const size_t tstep = 2 * hstep;
    const unsigned ldsw = (unsigned)wid * 1024u;
    const int aoff = lds_byte(wr * 64 + fr, fq * 8), boff = lds_byte(wc * 32 + fr, fq * 8);
#define PG8_SA(b, h) (((b) * 2 + (h)) * HTB)
#define PG8_SB(b, h) ((4 + (b) * 2 + (h)) * HTB)
#define PG8_STAGE(bufoff, gbase, voff) do { _Pragma("unroll") for (int _i = 0; _i < 2; ++_i) \
        __builtin_amdgcn_global_load_lds((const unsigned*)((const char*)(gbase) + (voff)[_i]), (PG8_LAS unsigned*)(lds + (bufoff) + ldsw + _i * 8192), 16, 0, 0); } while (0)
#define PG8_LDA(dst, b, h) do { _Pragma("unroll") for (int m = 0; m < 4; ++m) _Pragma("unroll") for (int k = 0; k < 2; ++k) dst[m][k] = *(const PG8_LAS bf16x8*)(lds + PG8_SA(b, h) + aoff + m * 2048 + k * 1024); } while (0)
#define PG8_LDB(dst, b, h) do { _Pragma("unroll") for (int n = 0; n < 2; ++n) _Pragma("unroll") for (int k = 0; k < 2; ++k) dst[n][k] = *(const PG8_LAS bf16x8*)(lds + PG8_SB(b, h) + boff + n * 2048 + k * 1024); } while (0)
#define PG8_MMA(ai, bj, At, Bt) do { __builtin_amdgcn_s_setprio(1); _Pragma("unroll") for (int m = 0; m < 4; ++m) _Pragma("unroll") for (int n = 0; n < 2; ++n) _Pragma("unroll") for (int k = 0; k < 2; ++k) \
        acc[ai][bj][m][n] = __builtin_amdgcn_mfma_f32_16x16x32_bf16(Bt[n][k], At[m][k], acc[ai][bj][m][n], 0, 0, 0); __builtin_amdgcn_s_setprio(0); } while (0)
#define PG8_WAIT_V(n) asm volatile("s_waitcnt vmcnt(" #n ")" ::: "memory")
#define PG8_WAIT_L(n) asm volatile("s_waitcnt lgkmcnt(" #n ")" ::: "memory")
#define PG8_BAR __builtin_amdgcn_s_barrier()
#define PG8_SCHED __builtin_amdgcn_sched_barrier(0)
    Unit cur, nxt; int ui = 0;
    if (!S.next(0, cur)) return;
    f32x4 acc[2][2][4][2];
#pragma unroll
    for (int a = 0; a < 2; ++a)
#pragma unroll
        for (int b = 0; b < 2; ++b)
#pragma unroll
            for (int m = 0; m < 4; ++m)
#pragma unroll
                for (int n = 0; n < 2; ++n) acc[a][b][m][n] = (f32x4){0.f, 0.f, 0.f, 0.f};
    bf16x8 At[4][2], B0[2][2], B1[2][2];
    const char* cA = (const char*)g.A + (size_t)cur.pm * tstep; const char* cB = (const char*)g.Bt + (size_t)cur.pn * tstep;
    S.a_ready(cur);
    if constexpr (SP2) {
        PG8_STAGE(PG8_SB(0, 0), cB, voffB); PG8_STAGE(PG8_SB(0, 1), cB + hstep, voffB); PG8_STAGE(PG8_SA(0, 0), cA, voffA); PG8_STAGE(PG8_SA(0, 1), cA + hstep, voffA);
        if (wr == 1) PG8_BAR;
        PG8_WAIT_V(2); PG8_BAR;
        PG8_STAGE(PG8_SB(1, 0), cB + kstep, voffB); PG8_STAGE(PG8_SA(1, 0), cA + kstep, voffA); PG8_STAGE(PG8_SB(1, 1), cB + hstep + kstep, voffB);
        PG8_WAIT_V(6); PG8_BAR;
    } else {
        PG8_STAGE(PG8_SB(0, 0), cB, voffB); PG8_STAGE(PG8_SA(0, 0), cA, voffA); PG8_STAGE(PG8_SB(0, 1), cB + hstep, voffB); PG8_STAGE(PG8_SA(0, 1), cA + hstep, voffA);
        if (wr == 1) PG8_BAR;
        PG8_WAIT_V(4); PG8_BAR;
        PG8_STAGE(PG8_SB(1, 0), cB + kstep, voffB); PG8_STAGE(PG8_SA(1, 0), cA + kstep, voffA); PG8_STAGE(PG8_SB(1, 1), cB + hstep + kstep, voffB);
        PG8_WAIT_V(6); PG8_BAR;
    }
    for (;;) {
        const bool has_next = S.next(ui + 1, nxt);
        const char* nA = has_next ? (const char*)g.A + (size_t)nxt.pm * tstep : cA; const char* nB = has_next ? (const char*)g.Bt + (size_t)nxt.pn * tstep : cB;
        for (int t = 0; t < nt; t += 2) {
            const bool last = (t == nt - 2);
            const char* a1 = cA + (size_t)(t + 1) * kstep;
            const char* a2 = last ? nA : cA + (size_t)(t + 2) * kstep; const char* b2 = last ? nB : cB + (size_t)(t + 2) * kstep;
            const char* a3 = a2 + kstep; const char* b3 = b2 + kstep;
            if (last && has_next) S.a_ready(nxt);
            if constexpr (SP2) {
            PG8_LDB(B0, 0, 0); PG8_LDB(B1, 0, 1); PG8_SCHED; PG8_LDA(At, 0, 0); PG8_STAGE(PG8_SA(1, 1), a1 + hstep, voffA);
            PG8_WAIT_V(8); PG8_WAIT_L(0); PG8_BAR; PG8_MMA(0, 0, At, B0); PG8_MMA(0, 1, At, B1); PG8_BAR; PG8_SCHED;
            PG8_LDA(At, 0, 1); PG8_STAGE(PG8_SB(0, 0), b2, voffB); PG8_STAGE(PG8_SB(0, 1), b2 + hstep, voffB); PG8_STAGE(PG8_SA(0, 0), a2, voffA);
            PG8_WAIT_V(8); PG8_WAIT_L(0); PG8_BAR; PG8_MMA(1, 0, At, B0); PG8_MMA(1, 1, At, B1); PG8_BAR; PG8_SCHED;
            PG8_LDB(B0, 1, 0); PG8_LDB(B1, 1, 1); PG8_SCHED; PG8_LDA(At, 1, 0); PG8_STAGE(PG8_SA(0, 1), a2 + hstep, voffA);
            PG8_WAIT_V(8); PG8_WAIT_L(0); PG8_BAR; PG8_MMA(0, 0, At, B0); PG8_MMA(0, 1, At, B1); PG8_BAR; PG8_SCHED;
            PG8_LDA(At, 1, 1); PG8_STAGE(PG8_SB(1, 0), b3, voffB); PG8_STAGE(PG8_SB(1, 1), b3 + hstep, voffB); PG8_STAGE(PG8_SA(1, 0), a3, voffA);
            PG8_WAIT_V(8); PG8_WAIT_L(0); PG8_BAR; PG8_MMA(1, 0, At, B0); PG8_MMA(1, 1, At, B1); PG8_BAR; PG8_SCHED;
            } else {
            PG8_LDB(B0, 0, 0); PG8_SCHED; PG8_LDA(At, 0, 0); PG8_STAGE(PG8_SA(1, 1), a1 + hstep, voffA);
            PG8_WAIT_L(8); PG8_BAR; PG8_WAIT_L(0); PG8_MMA(0, 0, At, B0); PG8_BAR; PG8_SCHED;
            PG8_LDB(B1, 0, 1); PG8_STAGE(PG8_SB(0, 0), b2, voffB);
            PG8_BAR; PG8_WAIT_L(0); PG8_MMA(0, 1, At, B1); PG8_BAR;
            PG8_LDA(At, 0, 1); PG8_STAGE(PG8_SA(0, 0), a2, voffA);
            PG8_BAR; PG8_WAIT_L(0); PG8_MMA(1, 0, At, B0); PG8_BAR; PG8_SCHED;
            PG8_STAGE(PG8_SB(0, 1), b2 + hstep, voffB);
            PG8_WAIT_V(6); PG8_BAR; PG8_MMA(1, 1, At, B1); PG8_BAR;
            PG8_LDB(B0, 1, 0); PG8_SCHED; PG8_LDA(At, 1, 0); PG8_STAGE(PG8_SA(0, 1), a2 + hstep, voffA);
            PG8_WAIT_L(8); PG8_BAR; PG8_WAIT_L(0); PG8_MMA(0, 0, At, B0); PG8_BAR; PG8_SCHED;
            PG8_LDB(B1, 1, 1); PG8_STAGE(PG8_SB(1, 0), b3, voffB);
            PG8_BAR; PG8_WAIT_L(0); PG8_MMA(0, 1, At, B1); PG8_BAR;
            PG8_LDA(At, 1, 1); PG8_STAGE(PG8_SA(1, 0), a3, voffA);
            PG8_BAR; PG8_WAIT_L(0); PG8_MMA(1, 0, At, B0); PG8_BAR; PG8_SCHED;
            PG8_STAGE(PG8_SB(1, 1), b3 + hstep, voffB);
            PG8_WAIT_V(6); PG8_BAR; PG8_MMA(1, 1, At, B1); PG8_BAR;
            }
        }
        if constexpr (ALIGN_EPI) { if (wr == 0) PG8_BAR; }
        if constexpr (!Epi::AFTER_DRAIN) { E(acc, cur, wr, wc, fr, fq); S.done(cur); }
        if (!has_next) break;
#pragma unroll
        for (int a = 0; a < 2; ++a)
#pragma unroll
            for (int b = 0; b < 2; ++b)
#pragma unroll
                for (int m = 0; m < 4; ++m)
#pragma unroll
                    for (int n = 0; n < 2; ++n) acc[a][b][m][n] = (f32x4){0.f, 0.f, 0.f, 0.f};
        cur = nxt; cA = nA; cB = nB; ++ui;
        if constexpr (ALIGN_EPI) { if (wr == 1) PG8_BAR; }
    }
    PG8_WAIT_V(0);
    if constexpr (!ALIGN_EPI) { if (wr == 0) PG8_BAR; }
    PG8_BAR;
    if constexpr (Epi::AFTER_DRAIN) { E.fused(acc, cur, wr, wc, fr, fq, lds, wid, lane); S.done(cur); }
#undef PG8_SA
#undef PG8_SB
#undef PG8_STAGE
#undef PG8_LDA
#undef PG8_LDB
#undef PG8_MMA
#undef PG8_WAIT_V
#undef PG8_WAIT_L
#undef PG8_BAR
#undef PG8_SCHED
}
}
typedef pg8::f32x4 f32x4;
template <class F> struct EpiGen {
    static constexpr bool PERM = false, AFTER_DRAIN = false; F f;
    __device__ __forceinline__ void operator()(const f32x4 (&acc)[2][2][4][2], const pg8::Unit& u, int wr, int wc, int fr, int fq) const {
        const int row0 = u.pm * 256 + wr * 64 + fr, col0 = u.pn * 256 + wc * 32 + 4 * fq;
#pragma unroll
        for (int ai = 0; ai < 2; ++ai)
#pragma unroll
            for (int m = 0; m < 4; ++m) { const int row = row0 + ai * 128 + m * 16; const float ctx = f.row_begin(row); float part = 0.f;
#pragma unroll
                for (int bj = 0; bj < 2; ++bj)
#pragma unroll
                    for (int n = 0; n < 2; ++n) part += f.store4(ctx, row, col0 + bj * 128 + n * 16, acc[ai][bj][m][n]);
                f.row_end(row, part, fq, true); }
    }
};
template <int ACT  >
__device__ __forceinline__ void store_tile_bf16(const f32x4 (&acc)[2][2][4][2], int row0, int col0, const float* rstd, float scale, bf16_t* dst, int ld) {
#pragma unroll
    for (int ai = 0; ai < 2; ++ai)
#pragma unroll
        for (int m = 0; m < 4; ++m) { const int row = row0 + ai * 128 + m * 16; const float rs = rstd[row] * scale; bf16_t* rp = dst + (size_t)row * ld + col0;
#pragma unroll
            for (int bj = 0; bj < 2; ++bj)
#pragma unroll
                for (int n = 0; n < 2; ++n) { f32x4 v = acc[ai][bj][m][n] * rs;
                    if (ACT == 1) { v[0] = siluf_(v[0]); v[1] = siluf_(v[1]); v[2] = siluf_(v[2]); v[3] = siluf_(v[3]); }
                    if (ACT == 2) { v[0] = sigmoidf_(v[0]); v[1] = sigmoidf_(v[1]); v[2] = sigmoidf_(v[2]); v[3] = sigmoidf_(v[3]); }
                    v2u w; w.x = pk2(v[0], v[1]); w.y = pk2(v[2], v[3]); *(v2u*)(rp + bj * 128 + n * 16) = w; } }
}
struct EpiProj {
    static constexpr bool PERM = false, AFTER_DRAIN = false;
    const float* rstd; const float* b_gate; bf16_t *QN, *KV6, *GQ, *GK, *GV, *GR, *BR; float *GATE, *LR, *out;
    __device__ __forceinline__ void operator()(const f32x4 (&acc)[2][2][4][2], const pg8::Unit& u, int wr, int wc, int fr, int fq) const {
        const int row0 = u.pm * 256 + wr * 64 + fr, cl0 = wc * 32 + 4 * fq, pn = u.pn;
        if (pn < 4) store_tile_bf16<0>(acc, row0, pn * 256 + cl0, rstd, 0.125f, QN, 1024);
        else if (pn < 10) { const int j = pn - 4;
            store_tile_bf16<0>(acc, row0, j * 256 + cl0, rstd, 1.f, KV6, 1536);
#pragma unroll
            for (int ai = 0; ai < 2; ++ai)
#pragma unroll
                for (int m = 0; m < 4; ++m) { const int row = row0 + ai * 128 + m * 16; const float rs = rstd[row]; const int b = row >> 11, t = row & 2047;
                    float* rp = nullptr;
                    if (j < 4) rp = out + OFF_PCK + j * SZ_PROW + (size_t)row * 256 + cl0;
                    else if (t >= 1536) rp = out + OFF_PWK + (j - 4) * SZ_PWIN + ((size_t)b * 512 + (t - 1536)) * 256 + cl0;
                    if (rp) {
#pragma unroll
                        for (int bj = 0; bj < 2; ++bj)
#pragma unroll
                            for (int n = 0; n < 2; ++n) *(f32x4*)(rp + bj * 128 + n * 16) = acc[ai][bj][m][n] * rs; } }
        }
        else if (pn < 12) store_tile_bf16<0>(acc, row0, (pn - 10) * 256 + cl0, rstd, 0.08838834764831845f, GQ, 512);
        else if (pn < 14) store_tile_bf16<0>(acc, row0, (pn - 12) * 256 + cl0, rstd, 1.f, GK, 512);
        else if (pn < 18) store_tile_bf16<0>(acc, row0, (pn - 14) * 256 + cl0, rstd, 1.f, GV, 1024);
        else if (pn < 22) store_tile_bf16<1>(acc, row0, (pn - 18) * 256 + cl0, rstd, 1.f, GR, 1024);
        else if (pn < 38) store_tile_bf16<2>(acc, row0, (pn - 22) * 256 + cl0, rstd, 1.f, BR, 4096);
        else if (wc < 2) {
#pragma unroll
            for (int ai = 0; ai < 2; ++ai)
#pragma unroll
                for (int m = 0; m < 4; ++m) { const int row = row0 + ai * 128 + m * 16; const float rs = rstd[row];
#pragma unroll
                    for (int n = 0; n < 2; ++n) { const int cl = cl0 + n * 16; const f32x4 v = acc[ai][0][m][n] * rs;
                        if (cl < 48) { const f32x4 bg = *(const f32x4*)(b_gate + cl); f32x4 o; o[0] = sigmoidf_(v[0] + bg[0]); o[1] = sigmoidf_(v[1] + bg[1]); o[2] = sigmoidf_(v[2] + bg[2]); o[3] = sigmoidf_(v[3] + bg[3]);
                            *(f32x4*)(GATE + (size_t)row * 48 + cl) = o; }
                        else *(f32x4*)(LR + (size_t)row * 16 + (cl - 48)) = v; } }
        }
    }
};
struct F_bra { const bf16_t* BR; float* TMP;
    __device__ __forceinline__ float row_begin(int) const { return 0.f; }
    __device__ __forceinline__ float store4(float, int row, int col, f32x4 v) const { const v2u b = *(const v2u*)(BR + (size_t)row * 4096 + col);
        f32x4 o; o[0] = v[0] * bf2f((bf16_t)(b.x & 0xffff)); o[1] = v[1] * bf2f((bf16_t)(b.x >> 16)); o[2] = v[2] * bf2f((bf16_t)(b.y & 0xffff)); o[3] = v[3] * bf2f((bf16_t)(b.y >> 16));
        *(f32x4*)(TMP + (size_t)row * DM + col) = o; return 0.f; }
    __device__ __forceinline__ void row_end(int, float, int, bool) const {}
};
struct F_brb { const bf16_t* BR; const float* TMP; bf16_t* MB;
    __device__ __forceinline__ float row_begin(int) const { return 0.f; }
    __device__ __forceinline__ float store4(float, int row, int col, f32x4 v) const { const v2u b = *(const v2u*)(BR + (size_t)row * 4096 + 2048 + col); const f32x4 t = *(const f32x4*)(TMP + (size_t)row * DM + col);
        const float o0 = t[0] + v[0] * bf2f((bf16_t)(b.x & 0xffff)), o1 = t[1] + v[1] * bf2f((bf16_t)(b.x >> 16)), o2 = t[2] + v[2] * bf2f((bf16_t)(b.y & 0xffff)), o3 = t[3] + v[3] * bf2f((bf16_t)(b.y >> 16));
        v2u w; w.x = pk2(o0, o1); w.y = pk2(o2, o3); *(v2u*)(MB + (size_t)row * DM + col) = w; return 0.f; }
    __device__ __forceinline__ void row_end(int, float, int, bool) const {}
};
struct F_wo { const float* x; float* X1; bf16_t* X1B; float* SUMSQ;
    __device__ __forceinline__ float row_begin(int) const { return 0.f; }
    __device__ __forceinline__ float store4(float, int row, int col, f32x4 v) const { const f32x4 xv = *(const f32x4*)(x + (size_t)row * DM + col); const f32x4 x1 = xv + v;
        *(f32x4*)(X1 + (size_t)row * DM + col) = x1; v2u w; w.x = pk2(x1[0], x1[1]); w.y = pk2(x1[2], x1[3]); *(v2u*)(X1B + (size_t)row * DM + col) = w;
        return (x1[0] * x1[0] + x1[1] * x1[1]) + (x1[2] * x1[2] + x1[3] * x1[3]); }
    __device__ __forceinline__ void row_end(int row, float part, int fq, bool valid) const { part += __shfl_xor(part, 16); part += __shfl_xor(part, 32); if (fq == 0 && valid) atomicAdd(SUMSQ + row, part); }
};
struct F_up { const float* SUMSQ; bf16_t* HF;
    __device__ __forceinline__ float row_begin(int row) const { return rsqrtf(SUMSQ[row] * (1.f / DM) + EPS); }
    __device__ __forceinline__ float store4(float rs, int row, int col, f32x4 v) const { float h[4];
#pragma unroll
        for (int i = 0; i < 4; ++i) { const float t = fmaxf(v[i] * rs, 0.f); h[i] = t * t; }
        v2u w; w.x = pk2(h[0], h[1]); w.y = pk2(h[2], h[3]); *(v2u*)(HF + (size_t)row * DFF + col) = w; return 0.f; }
    __device__ __forceinline__ void row_end(int, float, int, bool) const {}
};
struct F_down { const float* X1; float* Y; float* SUMSQ;
    __device__ __forceinline__ float row_begin(int) const { return 0.f; }
    __device__ __forceinline__ float store4(float, int row, int col, f32x4 v) const { const f32x4 x1 = *(const f32x4*)(X1 + (size_t)row * DM + col); const f32x4 x2 = x1 + v;
        *(f32x4*)(Y + (size_t)row * DM + col) = x2; return (x2[0] * x2[0] + x2[1] * x2[1]) + (x2[2] * x2[2] + x2[3] * x2[3]); }
    __device__ __forceinline__ void row_end(int row, float part, int fq, bool valid) const { part += __shfl_xor(part, 16); part += __shfl_xor(part, 32); if (fq == 0 && valid) atomicAdd(SUMSQ + row, part); }
};

typedef short bf16x8_t __attribute__((ext_vector_type(8)));
template <class F>
__device__ __forceinline__ void skinny_gemm(LAS unsigned char* lds, const bf16_t* A, int lda, const bf16_t* Bt, int N, int K, const F& f, int bid, int G, int tid) {
    const int lane = tid & 63, wave = __builtin_amdgcn_readfirstlane(tid >> 6), j = lane & 15, g = lane >> 4;
    LAS f32x4* red = (LAS f32x4*)lds;
    const int ksl = K >> 3;
    for (int it = bid; it < (N >> 4); it += G) {
        const int n0 = it * 16;
        const bf16_t* bp = Bt + (size_t)(n0 + j) * K + wave * ksl + 8 * g;
        const bf16_t* ap = A + (size_t)(j & 7) * lda + wave * ksl + 8 * g;
        f32x4 acc = {0.f, 0.f, 0.f, 0.f};
#pragma unroll 4
        for (int k = 0; k < ksl; k += 32) {
            const bf16x8_t b = *(const bf16x8_t*)(bp + k); bf16x8_t a = *(const bf16x8_t*)(ap + k);
            if (j >= 8) a = (bf16x8_t){0, 0, 0, 0, 0, 0, 0, 0};
            acc = __builtin_amdgcn_mfma_f32_16x16x32_bf16(b, a, acc, 0, 0, 0);
        }
        red[wave * 64 + lane] = acc;
        __syncthreads();
        if (wave == 0) { f32x4 sacc = red[lane];
#pragma unroll
            for (int w = 1; w < 8; ++w) sacc = sacc + red[w * 64 + lane];
            const int row = NPT + (j & 7); const bool valid = j < 8; const float ctx = f.row_begin(row); float part = 0.f;
            if (valid) part = f.store4(ctx, row, n0 + 4 * g, sacc);
            f.row_end(row, part, g, valid); }
        __syncthreads();
    }
}
struct F_proj_s { const Params& p;
    __device__ __forceinline__ float row_begin(int row) const { return p.RSTD1[row]; }
    __device__ __forceinline__ float store4(float rs, int row, int col, f32x4 v) const { const int n0 = in_colmap(col); if (n0 >= 0) {
#pragma unroll
        for (int i = 0; i < 4; ++i) proj_store(p, row, n0 + i, v[i] * rs); } return 0.f; }
    __device__ __forceinline__ void row_end(int, float, int, bool) const {}
};

template <class CM>
__device__ __forceinline__ void transpose_item(const float* W, int ldw, const float* kscale, bf16_t* WT, int K, int item, int nblk, CM cm, LAS float* scr, int lane) {
    const int kb = item / nblk, nb = item % nblk, k0 = 64 * kb, n0 = 32 * nb;
    const int sc = cm(n0 + (lane & 31));
#pragma unroll 8
    for (int i = 0; i < 32; ++i) { const int kk = 2 * i + (lane >> 5); float v = sc >= 0 ? W[(size_t)(k0 + kk) * ldw + sc] : 0.f; if (kscale) v *= kscale[k0 + kk]; scr[kk * 33 + (lane & 31)] = v; }
    LDS_WAIT(); asm volatile("" ::: "memory");
    const int c = lane & 7;
#pragma unroll
    for (int j = 0; j < 4; ++j) { const int n = (lane >> 3) + 8 * j; const LAS float* s = scr + (8 * c) * 33 + n;
        v4u o; o.x = pk2(s[0 * 33], s[1 * 33]); o.y = pk2(s[2 * 33], s[3 * 33]); o.z = pk2(s[4 * 33], s[5 * 33]); o.w = pk2(s[6 * 33], s[7 * 33]);
        *(v4u*)(WT + (size_t)(n0 + n) * K + k0 + 8 * c) = o; }
    LDS_WAIT(); asm volatile("" ::: "memory");
}
struct CM_id { __device__ __forceinline__ int operator()(int n) const { return n; } };
struct CM_in { __device__ __forceinline__ int operator()(int n) const { return in_colmap(n); } };

__device__ __forceinline__ void ph_prologue(const Params& p, LAS unsigned char* lds, int bid, int G, int tid) {
    const int lane = tid & 63, wave = tid >> 6, gw = bid * 8 + wave, NGW = G * 8;
    LAS float* scr = (LAS float*)(lds + wave * 16384);
    constexpr int I_IN = 32 * (NIN_PAD / 32), I_BR = 16 * 64, I_O = 32 * 64, I_UP = 32 * 256, I_DN = 128 * 64;
    constexpr int TOTAL = I_IN + 2 * I_BR + I_O + I_UP + I_DN;
    for (int it = gw; it < TOTAL; it += NGW) { int r = it;
        if (r < I_IN) { transpose_item(p.w_in, DIN, p.norm1_g, p.WIN_T, DM, r, NIN_PAD / 32, CM_in{}, scr, lane); continue; } r -= I_IN;
        if (r < I_BR) { transpose_item(p.w_br_a, DM, nullptr, p.WBRA_T, 1024, r, 64, CM_id{}, scr, lane); continue; } r -= I_BR;
        if (r < I_BR) { transpose_item(p.w_br_b, DM, nullptr, p.WBRB_T, 1024, r, 64, CM_id{}, scr, lane); continue; } r -= I_BR;
        if (r < I_O) { transpose_item(p.w_o, DM, nullptr, p.WO_T, DM, r, 64, CM_id{}, scr, lane); continue; } r -= I_O;
        if (r < I_UP) { transpose_item(p.w_up, DFF, p.norm2_g, p.WUP_T, DM, r, 256, CM_id{}, scr, lane); continue; } r -= I_UP;
        transpose_item(p.w_down, DM, nullptr, p.WDN_T, DFF, r, 64, CM_id{}, scr, lane);
    }
    for (int row = gw; row < NTOK; row += NGW) {
        const f32x4* xr = (const f32x4*)(row < NPT ? p.x_prompt + (size_t)row * DM : p.x_sample + (size_t)(row - NPT) * DM) + lane;
        f32x4 v[8]; float ss = 0.f;
#pragma unroll
        for (int j = 0; j < 8; ++j) { v[j] = xr[64 * j]; ss += (v[j][0] * v[j][0] + v[j][1] * v[j][1]) + (v[j][2] * v[j][2] + v[j][3] * v[j][3]); }
        ss = wave_sum(ss);
        v2u* o = (v2u*)(p.XB + (size_t)row * DM) + lane;
#pragma unroll
        for (int j = 0; j < 8; ++j) { v2u w; w.x = pk2(v[j][0], v[j][1]); w.y = pk2(v[j][2], v[j][3]); o[64 * j] = w; }
        if (lane == 0) p.RSTD1[row] = rsqrtf(ss * (1.f / DM) + EPS);
    }
    for (int i = bid * 512 + tid; i < DB * 511 * 64; i += G * 512) { const int c4 = i & 63, r = (i >> 6) % 511, b = (i >> 6) / 511;
        const size_t so = ((size_t)b * 512 + r + 1) * 256 + c4 * 4, dofs = ((size_t)b * 512 + r) * 256 + c4 * 4;
        *(f32x4*)(p.out + OFF_SWK + dofs) = *(const f32x4*)(p.cwk + so); *(f32x4*)(p.out + OFF_SWK + SZ_SWIN + dofs) = *(const f32x4*)(p.cwv + so); }
}
__device__ __forceinline__ void ph_final_norm(const Params& p, int bid, int G, int tid) {
    const int lane = tid & 63, wave = tid >> 6, gw = bid * 8 + wave, NGW = G * 8;
    for (int row = gw; row < NTOK; row += NGW) {
        float* yr = row < NPT ? p.out + OFF_Y + (size_t)row * DM : p.out + OFF_YS + (size_t)(row - NPT) * DM;
        const float r = rsqrtf(p.SUMSQ3[row] * (1.f / DM) + EPS);
        f32x4* y4 = (f32x4*)yr + lane; const f32x4* g4 = (const f32x4*)p.norm_f + lane;
#pragma unroll
        for (int j = 0; j < 8; ++j) { f32x4 v = y4[64 * j]; const f32x4 g = g4[64 * j]; v = v * r * g; y4[64 * j] = v; }
    }
}

__device__ __forceinline__ unsigned pk2t(float lo, float hi) { return pk2(lo, hi); }
template <bool IS_S>
__device__ __forceinline__ void cmp_gemm_tile(const Params& p, LAS unsigned char* lds, int tile, int tid) {
    const int lane = tid & 63, wave = __builtin_amdgcn_readfirstlane(tid >> 6), wm = wave >> 2, wn = wave & 3, fr = lane & 15, fg = lane >> 4;
    int kv, b, ct = 0, g = 0;
    if (IS_S) { ct = tile & 31; b = (tile >> 5) & 7; kv = tile >> 8; } else { g = tile & 3; b = (tile >> 2) & 3; kv = tile >> 4; }
    const bf16_t* W = p.W1T + (size_t)kv * 256 * 1024;
    const float* asf[4]; const bf16_t* asb[4];
#pragma unroll
    for (int q = 0; q < 4; ++q) { const int i = q * 32 + (tid >> 4), d4 = (tid & 15) * 4;
        if (IS_S) { const int cl = i >> 2, gg = i & 3, c = 32 * ct + cl; const int page = p.page_table[b * NPAGES + (c >> 3)];
            asf[q] = (kv ? p.ccv : p.cck) + (((size_t)page * PAGE + (c & 7) * 16) * 4 + gg) * 64 + d4; asb[q] = nullptr; }
        else { asb[q] = p.KV6 + ((size_t)(b * SEQ + 16 * i)) * 1536 + kv * 256 + g * 64 + d4; asf[q] = nullptr; } }
    const bf16_t* bsrc = W + (size_t)(tid >> 3) * 1024 + (tid & 7) * 8;
    f32x4 ra[4]; v2u rab[4]; v4u rb[4];
    auto load_regs = [&](int r) {
#pragma unroll
        for (int q = 0; q < 4; ++q) { if (IS_S) ra[q] = *(const f32x4*)(asf[q] + (size_t)r * 256); else rab[q] = *(const v2u*)(asb[q] + (size_t)r * 1536);
            rb[q] = *(const v4u*)(bsrc + (size_t)q * 64 * 1024 + r * 64); } };
    auto write_lds = [&](int s) { LAS unsigned char* ab = lds + s * 55296; LAS unsigned char* bb = ab + 18432;
#pragma unroll
        for (int q = 0; q < 4; ++q) { const int i = q * 32 + (tid >> 4), d4 = (tid & 15) * 4; v2u w;
            if (IS_S) { w.x = pk2(ra[q][0], ra[q][1]); w.y = pk2(ra[q][2], ra[q][3]); } else w = rab[q];
            *(LAS v2u*)(ab + i * 144 + d4 * 2) = w;
            *(LAS v4u*)(bb + (q * 64 + (tid >> 3)) * 144 + (tid & 7) * 16) = rb[q]; } };
    f32x4 acc[4][4];
#pragma unroll
    for (int mi = 0; mi < 4; ++mi)
#pragma unroll
        for (int ni = 0; ni < 4; ++ni) acc[mi][ni] = (f32x4){0.f, 0.f, 0.f, 0.f};
    load_regs(0); write_lds(0); __syncthreads();
    for (int r = 0; r < 16; ++r) {
        if (r + 1 < 16) load_regs(r + 1);
        const LAS unsigned char* ab = lds + (r & 1) * 55296; const LAS unsigned char* bb = ab + 18432;
#pragma unroll
        for (int ks = 0; ks < 2; ++ks) { bf16x8_t af[4], bfr[4];
#pragma unroll
            for (int mi = 0; mi < 4; ++mi) af[mi] = *(const LAS bf16x8_t*)(ab + (64 * wm + 16 * mi + fr) * 144 + (32 * ks + 8 * fg) * 2);
#pragma unroll
            for (int ni = 0; ni < 4; ++ni) bfr[ni] = *(const LAS bf16x8_t*)(bb + (64 * wn + 16 * ni + fr) * 144 + (32 * ks + 8 * fg) * 2);
#pragma unroll
            for (int mi = 0; mi < 4; ++mi)
#pragma unroll
                for (int ni = 0; ni < 4; ++ni) acc[mi][ni] = __builtin_amdgcn_mfma_f32_16x16x32_bf16(bfr[ni], af[mi], acc[mi][ni], 0, 0, 0); }
        if (r + 1 < 16) write_lds((r + 1) & 1);
        __syncthreads();
    }
    float* AB = IS_S ? p.AB_S + (size_t)kv * 32768 * 256 : p.AB_P + (size_t)kv * 2048 * 256;
#pragma unroll
    for (int mi = 0; mi < 4; ++mi) { const int i = 64 * wm + 16 * mi + fr; size_t R;
        if (IS_S) R = (size_t)(b * 4 + (i & 3)) * 1024 + 32 * ct + (i >> 2); else R = (size_t)(b * 4 + g) * 128 + i;
#pragma unroll
        for (int ni = 0; ni < 4; ++ni) *(f32x4*)(AB + R * 256 + 64 * wn + 16 * ni + 4 * fg) = acc[mi][ni]; }
}
template <bool IS_S>
__device__ __forceinline__ void cmp_part2(const Params& p, LAS unsigned char* lds, int kv, int bg, int i0, int tid) {
    constexpr int n_cmp = IS_S ? 1023 : 127, nrs = IS_S ? 1024 : 128;
    const int lane = tid & 63, wave = __builtin_amdgcn_readfirstlane(tid >> 6), fr = lane & 15, fg = lane >> 4;
    const float* AB = (IS_S ? p.AB_S + (size_t)kv * 32768 * 256 : p.AB_P + (size_t)kv * 2048 * 256) + (size_t)bg * nrs * 256;
    LAS unsigned char* H = lds; LAS unsigned char* W2T = lds + 128 * 272;
    const float* w2 = kv ? p.w2v : p.w2k; const float* bias = p.BIAS1 + kv * 128;
    for (int idx = tid; idx < 128 * 32; idx += 512) { const int row = idx >> 5, j4 = (idx & 31) * 4, i = i0 + row; v2u w; w.x = 0u; w.y = 0u;
        if (i < n_cmp) { const f32x4 a = *(const f32x4*)(AB + (size_t)i * 256 + j4), bq = *(const f32x4*)(AB + (size_t)(i + 1) * 256 + 128 + j4), bi = *(const f32x4*)(bias + j4);
            const f32x4 h = a + bq + bi; w.x = pk2(gelu_tanh(h[0]), gelu_tanh(h[1])); w.y = pk2(gelu_tanh(h[2]), gelu_tanh(h[3])); }
        *(LAS v2u*)(H + row * 272 + j4 * 2) = w; }
    for (int idx = tid; idx < 8192; idx += 512) { const int j = idx >> 6, d = idx & 63; *(LAS bf16_t*)(W2T + d * 272 + j * 2) = f2bf(w2[idx]); }
    __syncthreads();
    f32x4 acc[4];
#pragma unroll
    for (int ni = 0; ni < 4; ++ni) acc[ni] = (f32x4){0.f, 0.f, 0.f, 0.f};
#pragma unroll
    for (int ks = 0; ks < 4; ++ks) { const bf16x8_t hb = *(const LAS bf16x8_t*)(H + (16 * wave + fr) * 272 + (32 * ks + 8 * fg) * 2);
#pragma unroll
        for (int ni = 0; ni < 4; ++ni) { const bf16x8_t wa = *(const LAS bf16x8_t*)(W2T + (16 * ni + fr) * 272 + (32 * ks + 8 * fg) * 2);
            acc[ni] = __builtin_amdgcn_mfma_f32_16x16x32_bf16(wa, hb, acc[ni], 0, 0, 0); } }
    const int i = i0 + 16 * wave + fr;
    if (i < nrs) {
#pragma unroll
        for (int ni = 0; ni < 4; ++ni) { const int d = 16 * ni + 4 * fg;
            if (IS_S) { v2u w; w.x = pk2(acc[ni][0], acc[ni][1]); w.y = pk2(acc[ni][2], acc[ni][3]); *(v2u*)((kv ? p.VCMP_S : p.KCMP_S) + ((size_t)bg * 1024 + i) * 64 + d) = w; }
            else if (kv == 0) { v2u w; w.x = pk2(acc[ni][0], acc[ni][1]); w.y = pk2(acc[ni][2], acc[ni][3]); *(v2u*)(p.KCMP_P + ((size_t)bg * 128 + i) * 64 + d) = w; }
            else {
#pragma unroll
                for (int r = 0; r < 4; ++r) p.VCMPT_P[((size_t)bg * 64 + d + r) * 128 + i] = f2bf(acc[ni][r]); } } }
    __syncthreads();
}
__device__ __forceinline__ void ph_pro0(const Params& p, LAS unsigned char* lds, int bid, int G, int tid) {
    const int lane = tid & 63, wave = tid >> 6, gw = bid * 8 + wave, NGW = G * 8;
    LAS float* scr = (LAS float*)(lds + wave * 16384);
    for (int it = gw; it < 4 * 64; it += NGW) { const int q = it >> 6, r = it & 63, kv = q >> 1, half = q & 1;
        transpose_item((kv ? p.w1v : p.w1k) + (size_t)half * 1024 * 128, 128, nullptr, p.W1T + ((size_t)kv * 256 + half * 128) * 1024, 1024, r, 4, CM_id{}, scr, lane); }
    for (int i = bid * 512 + tid; i < NTOK; i += G * 512) { p.SUMSQ2[i] = 0.f; p.SUMSQ3[i] = 0.f; }
    __syncthreads();
    for (int it = bid; it < 4; it += G) { const int kv = it >> 1, jh = it & 1, j = jh * 64 + (tid & 63), ks = tid >> 6;
        const float* pe = kv ? p.pe_v : p.pe_k; const float* w1 = kv ? p.w1v : p.w1k; float s = 0.f;
        for (int k = ks * 256; k < ks * 256 + 256; ++k) s += pe[k] * w1[(size_t)k * 128 + j];
        LAS float* red = (LAS float*)lds; red[tid] = s; __syncthreads();
        if (tid < 64) { float t = 0.f; for (int w = 0; w < 8; ++w) t += red[w * 64 + tid]; p.BIAS1[kv * 128 + j] = t; }
        __syncthreads(); }
}

constexpr int GL_BC = 0, GL_SEG = 32768, GL_QT = 34816, GL_KT = GL_QT + 64 * 272, GL_AM = GL_KT + 64 * 272, GL_VT = GL_AM + 64 * 144, GL_SSQ = GL_VT + 256 * 144, GL_END = GL_SSQ + 2048;
static_assert(GL_END <= 131072, "gla lds");
__device__ __forceinline__ void gla_gates(const Params& p, LAS unsigned char* lds, int row0, int h, int tid) {
    LAS float* BC = (LAS float*)(lds + GL_BC); LAS float* SEG = (LAS float*)(lds + GL_SEG);
    const int d = tid & 127, cq = tid >> 7;
    float wa[16];
#pragma unroll
    for (int r = 0; r < 16; ++r) wa[r] = p.w_a2[r * 512 + h * 128 + d];
    const float ba = p.b_a[h * 128 + d];
    float run = 0.f;
    for (int cc = 0; cc < 16; ++cc) { const int c = cq * 16 + cc; const f32x4* lr = (const f32x4*)(p.LR + (size_t)(row0 + c) * 16);
        const f32x4 l0 = lr[0], l1 = lr[1], l2 = lr[2], l3 = lr[3];
        float x = ba + (l0[0] * wa[0] + l0[1] * wa[1] + l0[2] * wa[2] + l0[3] * wa[3]) + (l1[0] * wa[4] + l1[1] * wa[5] + l1[2] * wa[6] + l1[3] * wa[7])
                     + (l2[0] * wa[8] + l2[1] * wa[9] + l2[2] * wa[10] + l2[3] * wa[11]) + (l3[0] * wa[12] + l3[1] * wa[13] + l3[2] * wa[14] + l3[3] * wa[15]);
        run += logsigmoidf_(x) * (1.f / 16.f); BC[c * 128 + d] = run; }
    SEG[cq * 128 + d] = run;
    __syncthreads();
    float pre = 0.f;
    for (int q = 0; q < cq; ++q) pre += SEG[q * 128 + d];
    if (cq > 0) for (int cc = 0; cc < 16; ++cc) BC[(cq * 16 + cc) * 128 + d] += pre;
    __syncthreads();
}
__device__ __forceinline__ void gla_load_vt(const Params& p, LAS unsigned char* lds, int row0, int h, int tid) {
    LAS bf16_t* VT = (LAS bf16_t*)(lds + GL_VT);
    const int e8 = (tid & 31) * 8;
#pragma unroll
    for (int q = 0; q < 4; ++q) { const int c = (tid >> 5) + 16 * q; const v4u v = *(const v4u*)(p.GV + (size_t)(row0 + c) * 1024 + h * 256 + e8);
        VT[(e8 + 0) * 72 + c] = (bf16_t)(v.x & 0xffff); VT[(e8 + 1) * 72 + c] = (bf16_t)(v.x >> 16); VT[(e8 + 2) * 72 + c] = (bf16_t)(v.y & 0xffff); VT[(e8 + 3) * 72 + c] = (bf16_t)(v.y >> 16);
        VT[(e8 + 4) * 72 + c] = (bf16_t)(v.z & 0xffff); VT[(e8 + 5) * 72 + c] = (bf16_t)(v.z >> 16); VT[(e8 + 6) * 72 + c] = (bf16_t)(v.w & 0xffff); VT[(e8 + 7) * 72 + c] = (bf16_t)(v.w >> 16); }
}
__device__ __forceinline__ void gla_pass_a(const Params& p, LAS unsigned char* lds, int item, int tid) {
    const int bh = item >> 5, n = item & 31, b = bh >> 2, h = bh & 3, row0 = b * SEQ + n * 64;
    const int lane = tid & 63, wave = __builtin_amdgcn_readfirstlane(tid >> 6), fr = lane & 15, fg = lane >> 4;
    gla_gates(p, lds, row0, h, tid);
    const LAS float* BC = (const LAS float*)(lds + GL_BC);
    LAS bf16_t* KST = (LAS bf16_t*)(lds + GL_QT);
    gla_load_vt(p, lds, row0, h, tid);
    { const int d8 = (tid & 15) * 8;
#pragma unroll
      for (int q = 0; q < 2; ++q) { const int c = (tid >> 4) + 32 * q; const v4u kk = *(const v4u*)(p.GK + (size_t)(row0 + c) * 512 + h * 128 + d8);
          const unsigned wv[4] = {kk.x, kk.y, kk.z, kk.w};
#pragma unroll
          for (int i = 0; i < 8; ++i) { const int d = d8 + i; const float kx = bf2f((bf16_t)((wv[i >> 1] >> ((i & 1) * 16)) & 0xffff));
              KST[d * 72 + c] = f2bf(kx * __expf(BC[63 * 128 + d] - BC[c * 128 + d])); } } }
    if (tid < 128) p.DEC[((size_t)bh * 32 + n) * 128 + tid] = __expf(BC[63 * 128 + tid]);
    __syncthreads();
    const LAS unsigned char* VTb = lds + GL_VT; const LAS unsigned char* KSb = lds + GL_QT;
    f32x4 acc[8][2];
#pragma unroll
    for (int mb = 0; mb < 8; ++mb) { acc[mb][0] = (f32x4){0.f, 0.f, 0.f, 0.f}; acc[mb][1] = (f32x4){0.f, 0.f, 0.f, 0.f}; }
#pragma unroll
    for (int ks = 0; ks < 2; ++ks) { bf16x8_t vb[2];
#pragma unroll
        for (int nb = 0; nb < 2; ++nb) vb[nb] = *(const LAS bf16x8_t*)(VTb + (32 * wave + 16 * nb + fr) * 144 + (32 * ks + 8 * fg) * 2);
#pragma unroll
        for (int mb = 0; mb < 8; ++mb) { const bf16x8_t ka = *(const LAS bf16x8_t*)(KSb + (16 * mb + fr) * 144 + (32 * ks + 8 * fg) * 2);
            acc[mb][0] = __builtin_amdgcn_mfma_f32_16x16x32_bf16(ka, vb[0], acc[mb][0], 0, 0, 0); acc[mb][1] = __builtin_amdgcn_mfma_f32_16x16x32_bf16(ka, vb[1], acc[mb][1], 0, 0, 0); } }
    float* U = p.UT + ((size_t)bh * 32 + n) * 256 * 128;
#pragma unroll
    for (int nb = 0; nb < 2; ++nb) { const int e = 32 * wave + 16 * nb + fr;
#pragma unroll
        for (int mb = 0; mb < 8; ++mb) *(f32x4*)(U + (size_t)e * 128 + 16 * mb + 4 * fg) = acc[mb][nb]; }
    __syncthreads();
}
__device__ __forceinline__ void gla_pass_b(const Params& p, int bid, int G, int tid) {
    for (int idx = bid * 512 + tid; idx < 16 * 256 * 32; idx += G * 512) { const int d4 = (idx & 31) * 4, e = (idx >> 5) & 255, bh = idx >> 13;
        f32x4 S = {0.f, 0.f, 0.f, 0.f};
        const float* U = p.UT + (size_t)bh * 32 * 256 * 128 + (size_t)e * 128 + d4; const float* D = p.DEC + (size_t)bh * 32 * 128 + d4;
        bf16_t* SN = p.SNT + (size_t)bh * 32 * 256 * 128 + (size_t)e * 128 + d4;
#pragma unroll 8
        for (int n = 0; n < 32; ++n) { const f32x4 u = *(const f32x4*)(U + (size_t)n * 256 * 128); const f32x4 dc = *(const f32x4*)(D + n * 128);
            v2u w; w.x = pk2(S[0], S[1]); w.y = pk2(S[2], S[3]); *(v2u*)(SN + (size_t)n * 256 * 128) = w;
            S = dc * S + u; }
        float* so = p.out + OFF_PGLA + ((size_t)bh * 128 + d4) * 256 + e;
        so[0] = S[0]; so[256] = S[1]; so[512] = S[2]; so[768] = S[3]; }
}
__device__ __forceinline__ void gla_pass_c(const Params& p, LAS unsigned char* lds, int item, int tid) {
    const int bh = item >> 5, n = item & 31, b = bh >> 2, h = bh & 3, row0 = b * SEQ + n * 64;
    const int lane = tid & 63, wave = __builtin_amdgcn_readfirstlane(tid >> 6), fr = lane & 15, fg = lane >> 4;
    gla_gates(p, lds, row0, h, tid);
    const LAS float* BC = (const LAS float*)(lds + GL_BC);
    LAS unsigned char* QTb = lds + GL_QT; LAS unsigned char* KTb = lds + GL_KT; LAS unsigned char* AMb = lds + GL_AM; const LAS unsigned char* VTb = lds + GL_VT;
    gla_load_vt(p, lds, row0, h, tid);
    { const int d8 = (tid & 15) * 8;
#pragma unroll
      for (int q = 0; q < 2; ++q) { const int c = (tid >> 4) + 32 * q; const v4u qq = *(const v4u*)(p.GQ + (size_t)(row0 + c) * 512 + h * 128 + d8), kk = *(const v4u*)(p.GK + (size_t)(row0 + c) * 512 + h * 128 + d8);
          const unsigned qv[4] = {qq.x, qq.y, qq.z, qq.w}, kw[4] = {kk.x, kk.y, kk.z, kk.w}; unsigned qo[4], ko[4];
#pragma unroll
          for (int i = 0; i < 4; ++i) { const float b0 = BC[c * 128 + d8 + 2 * i], b1 = BC[c * 128 + d8 + 2 * i + 1]; const float e0 = __expf(b0), e1 = __expf(b1);
              qo[i] = pk2(bf2f((bf16_t)(qv[i] & 0xffff)) * e0, bf2f((bf16_t)(qv[i] >> 16)) * e1);
              ko[i] = pk2(bf2f((bf16_t)(kw[i] & 0xffff)) / e0, bf2f((bf16_t)(kw[i] >> 16)) / e1); }
          *(LAS v4u*)(QTb + c * 272 + d8 * 2) = (v4u){qo[0], qo[1], qo[2], qo[3]}; *(LAS v4u*)(KTb + c * 272 + d8 * 2) = (v4u){ko[0], ko[1], ko[2], ko[3]}; } }
    __syncthreads();
    { const int sb = wave >> 1;
#pragma unroll
      for (int u = 0; u < 2; ++u) { const int cb = 2 * (wave & 1) + u; f32x4 a = {0.f, 0.f, 0.f, 0.f};
          if (sb <= cb) {
#pragma unroll
              for (int ks = 0; ks < 4; ++ks) { const bf16x8_t ka = *(const LAS bf16x8_t*)(KTb + (16 * sb + fr) * 272 + (32 * ks + 8 * fg) * 2); const bf16x8_t qb = *(const LAS bf16x8_t*)(QTb + (16 * cb + fr) * 272 + (32 * ks + 8 * fg) * 2);
                  a = __builtin_amdgcn_mfma_f32_16x16x32_bf16(ka, qb, a, 0, 0, 0); } }
          const int c = 16 * cb + fr, s0 = 16 * sb + 4 * fg;
          v2u w; w.x = pk2(s0 <= c ? a[0] : 0.f, s0 + 1 <= c ? a[1] : 0.f); w.y = pk2(s0 + 2 <= c ? a[2] : 0.f, s0 + 3 <= c ? a[3] : 0.f);
          *(LAS v2u*)(AMb + c * 144 + s0 * 2) = w; } }
    __syncthreads();
    f32x4 acc[2][4];
#pragma unroll
    for (int eb = 0; eb < 2; ++eb)
#pragma unroll
        for (int cb = 0; cb < 4; ++cb) acc[eb][cb] = (f32x4){0.f, 0.f, 0.f, 0.f};
    const bf16_t* SN = p.SNT + ((size_t)bh * 32 + n) * 256 * 128;
#pragma unroll
    for (int ks = 0; ks < 4; ++ks) { bf16x8_t sa[2], qb[4];
#pragma unroll
        for (int eb = 0; eb < 2; ++eb) sa[eb] = *(const bf16x8_t*)(SN + (size_t)(32 * wave + 16 * eb + fr) * 128 + 32 * ks + 8 * fg);
#pragma unroll
        for (int cb = 0; cb < 4; ++cb) qb[cb] = *(const LAS bf16x8_t*)(QTb + (16 * cb + fr) * 272 + (32 * ks + 8 * fg) * 2);
#pragma unroll
        for (int eb = 0; eb < 2; ++eb)
#pragma unroll
            for (int cb = 0; cb < 4; ++cb) acc[eb][cb] = __builtin_amdgcn_mfma_f32_16x16x32_bf16(sa[eb], qb[cb], acc[eb][cb], 0, 0, 0); }
#pragma unroll
    for (int ks = 0; ks < 2; ++ks) { bf16x8_t va[2], ab[4];
#pragma unroll
        for (int eb = 0; eb < 2; ++eb) va[eb] = *(const LAS bf16x8_t*)(VTb + (32 * wave + 16 * eb + fr) * 144 + (32 * ks + 8 * fg) * 2);
#pragma unroll
        for (int cb = 0; cb < 4; ++cb) ab[cb] = *(const LAS bf16x8_t*)(AMb + (16 * cb + fr) * 144 + (32 * ks + 8 * fg) * 2);
#pragma unroll
        for (int eb = 0; eb < 2; ++eb)
#pragma unroll
            for (int cb = 0; cb < 4; ++cb) acc[eb][cb] = __builtin_amdgcn_mfma_f32_16x16x32_bf16(va[eb], ab[cb], acc[eb][cb], 0, 0, 0); }
    LAS float* SSQ = (LAS float*)(lds + GL_SSQ);
#pragma unroll
    for (int cb = 0; cb < 4; ++cb) { float s = 0.f;
#pragma unroll
        for (int eb = 0; eb < 2; ++eb) s += (acc[eb][cb][0] * acc[eb][cb][0] + acc[eb][cb][1] * acc[eb][cb][1]) + (acc[eb][cb][2] * acc[eb][cb][2] + acc[eb][cb][3] * acc[eb][cb][3]);
        s += __shfl_xor(s, 16); s += __shfl_xor(s, 32);
        if (fg == 0) SSQ[wave * 64 + 16 * cb + fr] = s; }
    __syncthreads();
#pragma unroll
    for (int cb = 0; cb < 4; ++cb) { const int c = 16 * cb + fr; float s = 0.f;
#pragma unroll
        for (int w = 0; w < 8; ++w) s += SSQ[w * 64 + c];
        const float rs = rsqrtf(s * (1.f / 256.f) + EPS);
#pragma unroll
        for (int eb = 0; eb < 2; ++eb) { const int e = 32 * wave + 16 * eb + 4 * fg; const f32x4 gn = *(const f32x4*)(p.gnorm + e);
            const v2u rr = *(const v2u*)(p.GR + (size_t)(row0 + c) * 1024 + h * 256 + e);
            const float o0 = acc[eb][cb][0] * rs * gn[0] * bf2f((bf16_t)(rr.x & 0xffff)), o1 = acc[eb][cb][1] * rs * gn[1] * bf2f((bf16_t)(rr.x >> 16));
            const float o2 = acc[eb][cb][2] * rs * gn[2] * bf2f((bf16_t)(rr.y & 0xffff)), o3 = acc[eb][cb][3] * rs * gn[3] * bf2f((bf16_t)(rr.y >> 16));
            v2u w; w.x = pk2(o0, o1); w.y = pk2(o2, o3); *(v2u*)(p.OB + (size_t)(row0 + c) * 1024 + h * 256 + e) = w; } }
    __syncthreads();
}
__device__ __forceinline__ void gla_sample_item(const Params& p, LAS unsigned char* lds, int item, int tid) {
    const int b = item >> 2, h = item & 3, e = tid & 255, half = tid >> 8, row = NPT + b;
    LAS float* a_s = (LAS float*)lds; LAS float* q_s = a_s + 128; LAS float* k_s = q_s + 128; LAS float* part = k_s + 128; LAS float* red = part + 512;
    if (tid < 128) { float x = p.b_a[h * 128 + tid];
        for (int r = 0; r < 16; ++r) x += p.LR[(size_t)row * 16 + r] * p.w_a2[r * 512 + h * 128 + tid];
        a_s[tid] = __expf(logsigmoidf_(x) * (1.f / 16.f)); q_s[tid] = bf2f(p.GQ[(size_t)row * 512 + h * 128 + tid]); k_s[tid] = bf2f(p.GK[(size_t)row * 512 + h * 128 + tid]); }
    const float v = bf2f(p.GV[(size_t)row * 1024 + h * 256 + e]);
    __syncthreads();
    float po = 0.f; const float* s0 = p.state + (((size_t)b * 4 + h) * 128 + half * 64) * 256 + e; float* so = p.out + OFF_SGLA + (((size_t)b * 4 + h) * 128 + half * 64) * 256 + e;
#pragma unroll 8
    for (int dd = 0; dd < 64; ++dd) { const int d = half * 64 + dd; const float s = a_s[d] * s0[(size_t)dd * 256] + k_s[d] * v; so[(size_t)dd * 256] = s; po += q_s[d] * s; }
    part[half * 256 + e] = po;
    __syncthreads();
    float o = 0.f;
    if (tid < 256) { o = part[e] + part[256 + e]; const float ss = wave_sum(o * o); if ((tid & 63) == 0) red[tid >> 6] = ss; }
    __syncthreads();
    if (tid < 256) { const float ss = (red[0] + red[1]) + (red[2] + red[3]); const float r = rsqrtf(ss * (1.f / 256.f) + EPS);
        p.OB[(size_t)row * 1024 + h * 256 + e] = f2bf(o * r * p.gnorm[e] * bf2f(p.GR[(size_t)row * 1024 + h * 256 + e])); }
    __syncthreads();
}

#define XB_TMO      128
#define XB_XCNT(j)  (256  + 64 * (j))
#define XB_XSUB(j)  (1280 + 64 * (j))
#define XB_XGEN(j)  (2304 + 64 * (j))
#define XB_TOP      3328
#define XB_TOPGEN   3392
#define XCD_BAR_WORDS 3456
#define XB_SPIN_CAP (1u << 22)

__device__ __forceinline__ unsigned xb_ld(unsigned* p)              { return __hip_atomic_load(p, __ATOMIC_RELAXED, __HIP_MEMORY_SCOPE_AGENT); }
__device__ __forceinline__ unsigned xb_add(unsigned* p, unsigned v) { return __hip_atomic_fetch_add(p, v, __ATOMIC_RELAXED, __HIP_MEMORY_SCOPE_AGENT); }
__device__ __forceinline__ unsigned xb_xcc_id() { return (unsigned)__builtin_amdgcn_s_getreg((3 << 11) | 20) & 0xFu; }
#define XB_SPIN(cond, bar) do { unsigned _sp = 0; while (cond) { __builtin_amdgcn_s_sleep(1); \
    if ((++_sp & 255u) == 0u) { if (xb_ld(&(bar)[XB_TMO])) break; if (_sp > XB_SPIN_CAP) { atomicAdd(&(bar)[XB_TMO], 1u); break; } } } } while (0)

struct XcdBarrier {
    unsigned* bar; unsigned x;
    volatile LAS unsigned* st;
};

__device__ __forceinline__ XcdBarrier xcd_barrier_post(unsigned* bar, volatile LAS unsigned* st) {
    XcdBarrier b; b.bar = bar; b.x = xb_xcc_id(); b.st = st;
    if (threadIdx.x == 0) (void)xb_add(&bar[XB_XCNT(b.x)], 1u);
    return b;
}
__device__ __forceinline__ void xcd_barrier_complete(unsigned* bar, unsigned x, unsigned& nloc, unsigned& nx) {
    const unsigned G = gridDim.x * gridDim.y * gridDim.z;
    unsigned sum, cnt, mine, sp = 0u;
    for (;;) {
        sum = 0u; cnt = 0u; mine = 0u;
#pragma unroll
        for (unsigned j = 0; j < 16; ++j) { const unsigned c = xb_ld(&bar[XB_XCNT(j)]); sum += c; cnt += (c > 0u) ? 1u : 0u; mine = (j == x) ? c : mine; }
        if (sum == G) break;
        __builtin_amdgcn_s_sleep(1);
        if ((++sp & 255u) == 0u) { if (xb_ld(&bar[XB_TMO])) break; if (sp > XB_SPIN_CAP) { atomicAdd(&bar[XB_TMO], 1u); break; } }
    }
    nloc = mine > 0u ? mine : 1u; nx = cnt > 0u ? cnt : 1u;
}

__device__ __forceinline__ void xcd_barrier(const XcdBarrier& b) {
    asm volatile("s_waitcnt vmcnt(0)" ::: "memory");
    __syncthreads();
    if (threadIdx.x == 0) {
        unsigned* bar = b.bar;
        __builtin_amdgcn_s_waitcnt(0);
        unsigned nloc = b.st[0], nx = b.st[1];
        if (nloc == 0u) { xcd_barrier_complete(bar, b.x, nloc, nx); b.st[0] = nloc; b.st[1] = nx; }
        const unsigned old = xb_add(&bar[XB_XSUB(b.x)], 1u);
        const unsigned gen = old / nloc;
        if (old + 1u == (gen + 1u) * nloc) {
            __builtin_amdgcn_fence(__ATOMIC_RELEASE, "agent");
            asm volatile("s_waitcnt vmcnt(0)" ::: "memory");
            const unsigned og = xb_add(&bar[XB_TOP], 1u);
            const unsigned tg = og / nx;
            if (og + 1u == (tg + 1u) * nx) xb_add(&bar[XB_TOPGEN], 1u);
            else XB_SPIN(xb_ld(&bar[XB_TOPGEN]) == tg, bar);
            __builtin_amdgcn_fence(__ATOMIC_ACQUIRE, "agent");
            xb_add(&bar[XB_XGEN(b.x)], 1u);
            asm volatile("s_waitcnt vmcnt(0)" ::: "memory");
        } else {
            XB_SPIN(xb_ld(&bar[XB_XGEN(b.x)]) == gen, bar);
            __builtin_amdgcn_fence(__ATOMIC_ACQUIRE, "agent");
            asm volatile("s_waitcnt vmcnt(0)" ::: "memory");
        }
    }
    __syncthreads();
}

constexpr int LDS_BYTES = 147456;
constexpr int LDSCTL_OFF = 131072, MISC_OFF = LDSCTL_OFF + 320;
constexpr int CW_BAR = 4096;
enum Phase { PH_PRO0 = 0, PH_PRO = 1, PH_IN = 2, PH_MID = 3, PH_ATT = 4, PH_BRA = 5, PH_BRB = 6, PH_WO = 7, PH_UP = 8, PH_DOWN = 9, PH_NORM = 10, PH_END = 11 };
__global__ void __launch_bounds__(512, 2) mk_fwd(Params p, int ph_lo, int ph_hi, int li) {
    extern __shared__ __attribute__((aligned(16))) unsigned char lds_raw[];
    LAS unsigned char* lds = (LAS unsigned char*)lds_raw;
    const int tid = threadIdx.x, bid = blockIdx.x, G = gridDim.x;
    for (int u = tid; u < (LDS_BYTES - LDSCTL_OFF) / 4; u += 512) ((LAS unsigned*)(lds + LDSCTL_OFF))[u] = 0u;
    __syncthreads();
    XcdBarrier bar; bar.bar = p.CTL + CW_BAR + li * XCD_BAR_WORDS; bar.x = 0; bar.st = nullptr;
    if (ph_hi - ph_lo > 1) bar = xcd_barrier_post(p.CTL + CW_BAR + li * XCD_BAR_WORDS, (volatile LAS unsigned*)(lds + MISC_OFF) + 8);
#define IN(k) (ph_lo <= (k) && (k) < ph_hi)
#define SEAM(k) do { if (ph_lo <= (k) && (k) + 1 < ph_hi) xcd_barrier(bar); } while (0)
    if (IN(PH_PRO0)) { ph_pro0(p, lds, bid, G, tid); SEAM(PH_PRO0); }
    if (IN(PH_PRO)) { for (int t = bid; t < 512; t += G) cmp_gemm_tile<true>(p, lds, t, tid);
        __syncthreads(); ph_prologue(p, lds, bid, G, tid); SEAM(PH_PRO); }
    if (IN(PH_IN)) { { pg8::Gemm g{p.XB, p.WIN_T, NPT, NIN_PAD, DM}; pg8::StaticOrder S; S.init(NPT, NIN_PAD, G, bid);
          EpiProj E{p.RSTD1, p.b_gate, p.QN, p.KV6, p.GQ, p.GK, p.GV, p.GR, p.BR, p.GATE, p.LR, p.out};
          pg8::gemm_phase<EpiProj, pg8::StaticOrder, true, true>(lds, g, S, E); }
        skinny_gemm(lds, p.XB + (size_t)NPT * DM, DM, p.WIN_T, NIN_PAD, DM, F_proj_s{p}, bid, G, tid); SEAM(PH_IN); }
    if (IN(PH_MID)) {
        for (int t = bid; t < 32; t += G) { cmp_gemm_tile<false>(p, lds, t, tid); __builtin_amdgcn_fence(__ATOMIC_RELEASE, "workgroup"); VM_WAIT(); __syncthreads(); cmp_part2<false>(p, lds, t >> 4, t & 15, 0, tid); }
        for (int it = bid; it < 512; it += G) cmp_part2<true>(p, lds, it >> 8, (it >> 3) & 31, (it & 7) * 128, tid);
        for (int it = bid; it < 512; it += G) gla_pass_a(p, lds, it, tid);
        for (int it = bid; it < 32; it += G) gla_sample_item(p, lds, it, tid);
        SEAM(PH_MID); }
    if (IN(PH_ATT)) { gla_pass_b(p, bid, G, tid); SEAM(PH_ATT); }
    if (IN(PH_BRA)) { for (int it = bid; it < 512; it += G) gla_pass_c(p, lds, it, tid);
        const F_bra f{p.BR, p.TMP};
        { pg8::Gemm g{p.OA, p.WBRA_T, NPT, DM, 1024}; pg8::StaticOrder S; S.init(NPT, DM, G, bid); EpiGen<F_bra> E{f}; pg8::gemm_phase<EpiGen<F_bra>, pg8::StaticOrder, true, true>(lds, g, S, E); }
        skinny_gemm(lds, p.OA + (size_t)NPT * 1024, 1024, p.WBRA_T, DM, 1024, f, bid, G, tid); SEAM(PH_BRA); }
    if (IN(PH_BRB)) { const F_brb f{p.BR, p.TMP, p.MB};
        { pg8::Gemm g{p.OB, p.WBRB_T, NPT, DM, 1024}; pg8::StaticOrder S; S.init(NPT, DM, G, bid); EpiGen<F_brb> E{f}; pg8::gemm_phase<EpiGen<F_brb>, pg8::StaticOrder, true, true>(lds, g, S, E); }
        skinny_gemm(lds, p.OB + (size_t)NPT * 1024, 1024, p.WBRB_T, DM, 1024, f, bid, G, tid); SEAM(PH_BRB); }
    if (IN(PH_WO)) {
        { const F_wo f{p.x_prompt, p.X1, p.X1B, p.SUMSQ2}; pg8::Gemm g{p.MB, p.WO_T, NPT, DM, DM}; pg8::StaticOrder S; S.init(NPT, DM, G, bid); EpiGen<F_wo> E{f}; pg8::gemm_phase<EpiGen<F_wo>, pg8::StaticOrder, true, true>(lds, g, S, E); }
        { const F_wo f{p.x_sample - (size_t)NPT * DM, p.X1, p.X1B, p.SUMSQ2}; skinny_gemm(lds, p.MB + (size_t)NPT * DM, DM, p.WO_T, DM, DM, f, bid, G, tid); } SEAM(PH_WO); }
    if (IN(PH_UP)) { const F_up f{p.SUMSQ2, p.HF};
        { pg8::Gemm g{p.X1B, p.WUP_T, NPT, DFF, DM}; pg8::StaticOrder S; S.init(NPT, DFF, G, bid); EpiGen<F_up> E{f}; pg8::gemm_phase<EpiGen<F_up>, pg8::StaticOrder, true, true>(lds, g, S, E); }
        skinny_gemm(lds, p.X1B + (size_t)NPT * DM, DM, p.WUP_T, DFF, DM, f, bid, G, tid); SEAM(PH_UP); }
    if (IN(PH_DOWN)) {
        { const F_down f{p.X1, p.out + OFF_Y, p.SUMSQ3}; pg8::Gemm g{p.HF, p.WDN_T, NPT, DM, DFF}; pg8::StaticOrder S; S.init(NPT, DM, G, bid); EpiGen<F_down> E{f}; pg8::gemm_phase<EpiGen<F_down>, pg8::StaticOrder, true, true>(lds, g, S, E); }
        { const F_down f{p.X1, p.out + OFF_YS - (size_t)NPT * DM, p.SUMSQ3}; skinny_gemm(lds, p.HF + (size_t)NPT * DFF, DFF, p.WDN_T, DM, DFF, f, bid, G, tid); } SEAM(PH_DOWN); }
    if (IN(PH_NORM)) ph_final_norm(p, bid, G, tid);
#undef IN
#undef SEAM
}
__global__ void __launch_bounds__(256) k_sumsq_rows(const float* X, size_t ld, float* ss_out, int nrows) {
    const int lane = threadIdx.x & 63, row = blockIdx.x * 4 + (threadIdx.x >> 6);
    if (row >= nrows) return;
    float ss = 0.f;
    for (int i = lane; i < DM; i += 64) { const float v = X[(size_t)row * ld + i]; ss += v * v; }
    ss = wave_sum(ss);
    if (lane == 0) ss_out[row] = ss;
}
struct EF_up2 { Params p; __device__ void operator()(int r, int n, float acc) const { const float v = fmaxf(acc * rsqrtf(p.SUMSQ2[r] * (1.f / DM) + EPS), 0.f); p.HF[(size_t)r * DFF + n] = f2bf(v * v); } };

static inline size_t align_up(size_t x) { return (x + 255) & ~(size_t)255; }

extern "C" void kernel_launch(void* const* d_in, const int* in_sizes, int n_in, void* d_out, int out_size, void* d_ws, size_t ws_size, hipStream_t stream) {
    if (n_in != 29 || out_size != (int)OUT_TOTAL) { fprintf(stderr, "kernel_launch: unexpected n_in %d / out_size %d\n", n_in, out_size); return; }
    static int grid = 0;
    if (grid == 0) {
        int dev = 0, cus = 0, per_cu = 0;
        if (hipGetDevice(&dev) != hipSuccess || hipDeviceGetAttribute(&cus, hipDeviceAttributeMultiprocessorCount, dev) != hipSuccess) { fprintf(stderr, "kernel_launch: device query failed\n"); grid = -1; return; }
        if (hipFuncSetAttribute((const void*)mk_fwd, hipFuncAttributeMaxDynamicSharedMemorySize, LDS_BYTES) != hipSuccess) { fprintf(stderr, "kernel_launch: hipFuncSetAttribute failed\n"); grid = -1; return; }
        if (hipOccupancyMaxActiveBlocksPerMultiprocessor(&per_cu, (const void*)mk_fwd, 512, LDS_BYTES) != hipSuccess || per_cu < 1) { fprintf(stderr, "kernel_launch: occupancy query says %d\n", per_cu); per_cu = 1; }
        (void)hipGetLastError();
        grid = cus;
    }
    if (grid < 0) return;
    Params p{};
    p.x_prompt = (const float*)d_in[0]; p.x_sample = (const float*)d_in[1]; p.cck = (const float*)d_in[2]; p.ccv = (const float*)d_in[3];
    p.csk = (const float*)d_in[4]; p.csv = (const float*)d_in[5]; p.cwk = (const float*)d_in[6]; p.cwv = (const float*)d_in[7]; p.state = (const float*)d_in[8];
    p.page_table = (const int*)d_in[9]; p.norm1_g = (const float*)d_in[10]; p.w_in = (const float*)d_in[11]; p.b_gate = (const float*)d_in[12];
    p.pe_k = (const float*)d_in[13]; p.pe_v = (const float*)d_in[14]; p.w1k = (const float*)d_in[15]; p.w2k = (const float*)d_in[16]; p.w1v = (const float*)d_in[17]; p.w2v = (const float*)d_in[18];
    p.w_a2 = (const float*)d_in[19]; p.b_a = (const float*)d_in[20]; p.gnorm = (const float*)d_in[21]; p.w_br_a = (const float*)d_in[22]; p.w_br_b = (const float*)d_in[23];
    p.w_o = (const float*)d_in[24]; p.norm2_g = (const float*)d_in[25]; p.w_up = (const float*)d_in[26]; p.w_down = (const float*)d_in[27]; p.norm_f = (const float*)d_in[28];
    p.out = (float*)d_out;
    char* ws = (char*)d_ws; size_t off = 0;
    auto take = [&](size_t bytes) { char* r = ws + off; off = align_up(off + bytes); return r; };
    p.CTL = (unsigned*)take(1 << 20);
    p.XB = (bf16_t*)take((size_t)NTOK * DM * 2); p.RSTD1 = (float*)take(NTOK * 4); p.QN = (bf16_t*)take((size_t)NTOK * 1024 * 2); p.KV6 = (bf16_t*)take((size_t)NTOK * 1536 * 2);
    p.GATE = (float*)take((size_t)NTOK * 48 * 4); p.GQ = (bf16_t*)take((size_t)NTOK * 512 * 2); p.GK = (bf16_t*)take((size_t)NTOK * 512 * 2); p.GV = (bf16_t*)take((size_t)NTOK * 1024 * 2);
    p.GR = (bf16_t*)take((size_t)NTOK * 1024 * 2); p.LR = (float*)take((size_t)NTOK * 16 * 4); p.BR = (bf16_t*)take((size_t)NTOK * 4096 * 2);
    p.KCMP_P = (bf16_t*)take(16 * 128 * 64 * 2); p.VCMPT_P = (bf16_t*)take(16 * 128 * 64 * 2); p.KCMP_S = (bf16_t*)take(32 * 1024 * 64 * 2); p.VCMP_S = (bf16_t*)take(32 * 1024 * 64 * 2);
    p.OA = (bf16_t*)take((size_t)NTOK * 1024 * 2); p.OB = (bf16_t*)take((size_t)NTOK * 1024 * 2); p.TMP = (float*)take((size_t)NTOK * DM * 4); p.MB = (bf16_t*)take((size_t)NTOK * DM * 2);
    p.X1 = (float*)take((size_t)NTOK * DM * 4); p.X1B = (bf16_t*)take((size_t)NTOK * DM * 2); p.RSTD2 = (float*)take(NTOK * 4); p.HF = (bf16_t*)take((size_t)NTOK * DFF * 2);
    p.WIN_T = (bf16_t*)take((size_t)NIN_PAD * DM * 2); p.WBRA_T = (bf16_t*)take((size_t)DM * 1024 * 2); p.WBRB_T = (bf16_t*)take((size_t)DM * 1024 * 2); p.WO_T = (bf16_t*)take((size_t)DM * DM * 2);
    p.WUP_T = (bf16_t*)take((size_t)DFF * DM * 2); p.WDN_T = (bf16_t*)take((size_t)DM * DFF * 2); p.SUMSQ2 = (float*)take(NTOK * 4); p.SUMSQ3 = (float*)take(NTOK * 4);
    p.W1T = (bf16_t*)take(2 * 256 * 1024 * 2); p.BIAS1 = (float*)take(256 * 4); p.AB_S = (float*)take((size_t)2 * 32768 * 256 * 4); p.AB_P = (float*)take((size_t)2 * 2048 * 256 * 4);
    p.UT = (float*)take((size_t)512 * 256 * 128 * 4); p.DEC = (float*)take(512 * 128 * 4); p.SNT = (bf16_t*)take((size_t)512 * 256 * 128 * 2);
    if (off > ws_size) { fprintf(stderr, "kernel_launch: workspace too small: need %zu have %zu\n", off, ws_size); return; }
    hipMemsetAsync(p.CTL, 0, 1 << 20, stream);
#define MK(lo, hi, li) hipLaunchKernelGGL(mk_fwd, dim3(grid), dim3(512), LDS_BYTES, stream, p, (int)(lo), (int)(hi), (int)(li))
    MK(PH_PRO0, PH_MID + 1, 0);
    k_nsa_naive<<<dim3(NTOK, 4), 256, 0, stream>>>(p, 0);
    MK(PH_ATT, PH_END, 1);
}
```

```cpp
#include <hip/hip_runtime.h>
#include <stdint.h>
#include <cstdio>

typedef unsigned short bf16_t;

constexpr int DM = 2048, NB = 4, SEQ = 2048, NPT = NB * SEQ, DB = 8, NTOK = NPT + DB;
constexpr int PAST = 16384, PAGE = 128, NPAGES = 128;
constexpr int NG = 4, HPG = 4, DH = 64;
constexpr int DIN = 9792, DFF = 8192;
constexpr int C_Q = 0, C_KV = 1024, C_G = 2560, C_QL = 2608, C_KL = 3120, C_VL = 3632, C_RL = 4656, C_LR = 5680, C_BR = 5696;
constexpr float EPS = 1e-6f;
constexpr size_t OFF_Y = 0, OFF_YS = (size_t)NPT * DM, OFF_PCK = OFF_YS + (size_t)DB * DM;
constexpr size_t SZ_PROW = (size_t)NPT * 256;
constexpr size_t OFF_PWK = OFF_PCK + 4 * SZ_PROW, SZ_PWIN = (size_t)NB * 512 * 256;
constexpr size_t OFF_PGLA = OFF_PWK + 2 * SZ_PWIN, SZ_PGLA = (size_t)NB * 4 * 128 * 256;
constexpr size_t OFF_SCK = OFF_PGLA + SZ_PGLA, SZ_SROW = (size_t)DB * 256;
constexpr size_t OFF_SWK = OFF_SCK + 4 * SZ_SROW, SZ_SWIN = (size_t)DB * 512 * 256;
constexpr size_t OFF_SGLA = OFF_SWK + 2 * SZ_SWIN, SZ_SGLA = (size_t)DB * 4 * 128 * 256;
constexpr size_t OUT_TOTAL = OFF_SGLA + SZ_SGLA;
static_assert(OUT_TOTAL == 29908992, "output size");

__device__ __forceinline__ bf16_t f2bf(float f) { unsigned u = __builtin_bit_cast(unsigned, f); return (bf16_t)((u + 0x7fffu + ((u >> 16) & 1u)) >> 16); }
__device__ __forceinline__ float bf2f(bf16_t h) { return __builtin_bit_cast(float, (unsigned)h << 16); }
__device__ __forceinline__ float sigmoidf_(float x) { return 1.f / (1.f + __expf(-x)); }
__device__ __forceinline__ float siluf_(float x) { return x / (1.f + __expf(-x)); }
__device__ __forceinline__ float gelu_tanh(float x) { const float u = 0.7978845608028654f * (x + 0.044715f * x * x * x); return 0.5f * x * (1.f + tanhf(u)); }
__device__ __forceinline__ float logsigmoidf_(float x) { return fminf(x, 0.f) - log1pf(__expf(-fabsf(x))); }
__device__ __forceinline__ float wave_sum(float v) {
#pragma unroll
    for (int o = 1; o < 64; o <<= 1) v += __shfl_xor(v, o);
    return v;
}
__device__ __forceinline__ float wave_max(float v) {
#pragma unroll
    for (int o = 1; o < 64; o <<= 1) v = fmaxf(v, __shfl_xor(v, o));
    return v;
}

struct Params {
    const float *x_prompt, *x_sample, *cck, *ccv, *csk, *csv, *cwk, *cwv, *state;
    const int* page_table;
    const float *norm1_g, *w_in, *b_gate, *pe_k, *pe_v, *w1k, *w2k, *w1v, *w2v, *w_a2, *b_a, *gnorm, *w_br_a, *w_br_b, *w_o, *norm2_g, *w_up, *w_down, *norm_f;
    float* out;
    bf16_t *XB, *QN, *KV6, *GQ, *GK, *GV, *GR, *BR, *KCMP_P, *VCMPT_P, *KCMP_S, *VCMP_S, *OA, *OB, *MB, *X1B, *HF;
    float *RSTD1, *GATE, *LR, *TMP, *X1, *RSTD2;
    bf16_t *WIN_T, *WBRA_T, *WBRB_T, *WO_T, *WUP_T, *WDN_T;
    float *SUMSQ2, *SUMSQ3;
    unsigned* CTL;
    bf16_t* W1T; float *BIAS1, *AB_S, *AB_P;
    float *UT, *DEC; bf16_t* SNT;
    bf16_t *VTS, *VTW;
};

__device__ __forceinline__ float xval(const Params& p, int row, int n) { return row < NPT ? p.x_prompt[(size_t)row * DM + n] : p.x_sample[(size_t)(row - NPT) * DM + n]; }

__device__ __forceinline__ void proj_store(const Params& p, int row, int n, float v) {
    if (n < C_KV) p.QN[(size_t)row * 1024 + n] = f2bf(v * 0.125f);
    else if (n < C_G) {
        const int c = n - C_KV; p.KV6[(size_t)row * 1536 + c] = f2bf(v); const int j = c >> 8, cc = c & 255;
        if (row < NPT) { const int b = row >> 11, t = row & 2047;
            if (j < 4) p.out[OFF_PCK + j * SZ_PROW + (size_t)row * 256 + cc] = v;
            else if (t >= 1536) p.out[OFF_PWK + (j - 4) * SZ_PWIN + ((size_t)b * 512 + t - 1536) * 256 + cc] = v; }
        else { const int b = row - NPT;
            if (j < 4) p.out[OFF_SCK + j * SZ_SROW + (size_t)b * 256 + cc] = v;
            else p.out[OFF_SWK + (j - 4) * SZ_SWIN + ((size_t)b * 512 + 511) * 256 + cc] = v; }
    }
    else if (n < C_QL) { const int c = n - C_G; p.GATE[(size_t)row * 48 + c] = sigmoidf_(v + p.b_gate[c]); }
    else if (n < C_KL) p.GQ[(size_t)row * 512 + (n - C_QL)] = f2bf(v * 0.08838834764831845f);
    else if (n < C_VL) p.GK[(size_t)row * 512 + (n - C_KL)] = f2bf(v);
    else if (n < C_RL) p.GV[(size_t)row * 1024 + (n - C_VL)] = f2bf(v);
    else if (n < C_LR) p.GR[(size_t)row * 1024 + (n - C_RL)] = f2bf(siluf_(v));
    else if (n < C_BR) p.LR[(size_t)row * 16 + (n - C_LR)] = v;
    else p.BR[(size_t)row * 4096 + (n - C_BR)] = f2bf(sigmoidf_(v));
}

__global__ void __launch_bounds__(256) k_prep_x(Params p) {
    const int lane = threadIdx.x & 63, row = blockIdx.x * 4 + (threadIdx.x >> 6);
    if (row >= NTOK) return;
    const float* xr = row < NPT ? p.x_prompt + (size_t)row * DM : p.x_sample + (size_t)(row - NPT) * DM;
    float ss = 0.f;
    for (int i = lane; i < DM; i += 64) { const float v = xr[i]; ss += v * v; p.XB[(size_t)row * DM + i] = f2bf(v); }
    ss = wave_sum(ss);
    if (lane == 0) p.RSTD1[row] = rsqrtf(ss * (1.f / DM) + EPS);
}
__global__ void __launch_bounds__(256) k_copy_swin(Params p) {
    const size_t i = (size_t)blockIdx.x * 256 + threadIdx.x;
    if (i >= (size_t)DB * 511 * 256) return;
    const int c = (int)(i & 255); const int r = (int)((i >> 8) % 511); const int b = (int)((i >> 8) / 511);
    p.out[OFF_SWK + ((size_t)b * 512 + r) * 256 + c] = p.cwk[((size_t)b * 512 + r + 1) * 256 + c];
    p.out[OFF_SWK + SZ_SWIN + ((size_t)b * 512 + r) * 256 + c] = p.cwv[((size_t)b * 512 + r + 1) * 256 + c];
}
__global__ void __launch_bounds__(256) k_rms_rows(const float* X, float* rstd, int nrows) {
    const int lane = threadIdx.x & 63, row = blockIdx.x * 4 + (threadIdx.x >> 6);
    if (row >= nrows) return;
    float ss = 0.f;
    for (int i = lane; i < DM; i += 64) { const float v = X[(size_t)row * DM + i]; ss += v * v; }
    ss = wave_sum(ss);
    if (lane == 0) rstd[row] = rsqrtf(ss * (1.f / DM) + EPS);
}
__global__ void __launch_bounds__(256) k_final_norm(Params p) {
    const int lane = threadIdx.x & 63, row = blockIdx.x * 4 + (threadIdx.x >> 6);
    if (row >= NTOK) return;
    float* yr = row < NPT ? p.out + OFF_Y + (size_t)row * DM : p.out + OFF_YS + (size_t)(row - NPT) * DM;
    float ss = 0.f;
    for (int i = lane; i < DM; i += 64) { const float v = yr[i]; ss += v * v; }
    ss = wave_sum(ss);
    const float r = rsqrtf(ss * (1.f / DM) + EPS);
    for (int i = lane; i < DM; i += 64) yr[i] = yr[i] * r * p.norm_f[i];
}

template <class AF, class BF, class EF>
__global__ void __launch_bounds__(256) k_gemm_naive(int m_off, int M, int N, int K, AF af, BF bf, EF ef) {
    __shared__ float As[16][68], Bs[16][68];
    const int tid = threadIdx.x, tx = tid & 15, ty = tid >> 4, m0 = m_off + blockIdx.y * 64, n0 = blockIdx.x * 64;
    float acc[4][4];
#pragma unroll
    for (int i = 0; i < 4; ++i)
#pragma unroll
        for (int j = 0; j < 4; ++j) acc[i][j] = 0.f;
    for (int k0 = 0; k0 < K; k0 += 16) {
#pragma unroll
        for (int i = 0; i < 4; ++i) { const int idx = tid + 256 * i, r = idx >> 4, kk = idx & 15; As[kk][r] = (m0 + r < M) ? af(m0 + r, k0 + kk) : 0.f; }
#pragma unroll
        for (int i = 0; i < 4; ++i) { const int idx = tid + 256 * i, kk = idx >> 6, c = idx & 63; Bs[kk][c] = (n0 + c < N) ? bf(k0 + kk, n0 + c) : 0.f; }
        __syncthreads();
#pragma unroll
        for (int kk = 0; kk < 16; ++kk) {
            float a[4], b[4];
#pragma unroll
            for (int i = 0; i < 4; ++i) { a[i] = As[kk][ty * 4 + i]; b[i] = Bs[kk][tx * 4 + i]; }
#pragma unroll
            for (int i = 0; i < 4; ++i)
#pragma unroll
                for (int j = 0; j < 4; ++j) acc[i][j] += a[i] * b[j];
        }
        __syncthreads();
    }
#pragma unroll
    for (int i = 0; i < 4; ++i)
#pragma unroll
        for (int j = 0; j < 4; ++j) { const int r = m0 + ty * 4 + i, c = n0 + tx * 4 + j; if (r < M && c < N) ef(r, c, acc[i][j]); }
}
struct AF_x_g1 { Params p; __device__ float operator()(int r, int k) const { return xval(p, r, k) * p.norm1_g[k]; } };
struct BF_rowmajor { const float* W; long ld; __device__ float operator()(int k, int n) const { return W[(size_t)k * ld + n]; } };
struct EF_proj { Params p; __device__ void operator()(int r, int n, float acc) const { proj_store(p, r, n, acc * p.RSTD1[r]); } };
struct AF_bf { const bf16_t* A; long ld; __device__ float operator()(int r, int k) const { return bf2f(A[(size_t)r * ld + k]); } };
struct EF_bra { Params p; __device__ void operator()(int r, int n, float acc) const { p.TMP[(size_t)r * DM + n] = acc * bf2f(p.BR[(size_t)r * 4096 + n]); } };
struct EF_brb { Params p; __device__ void operator()(int r, int n, float acc) const { p.MB[(size_t)r * DM + n] = f2bf(p.TMP[(size_t)r * DM + n] + acc * bf2f(p.BR[(size_t)r * 4096 + 2048 + n])); } };
struct EF_wo { Params p; __device__ void operator()(int r, int n, float acc) const { const float x1 = xval(p, r, n) + acc; p.X1[(size_t)r * DM + n] = x1; p.X1B[(size_t)r * DM + n] = f2bf(x1); } };
struct AF_x1_g2 { Params p; __device__ float operator()(int r, int k) const { return bf2f(p.X1B[(size_t)r * DM + k]) * p.norm2_g[k]; } };
struct EF_up { Params p; __device__ void operator()(int r, int n, float acc) const { const float v = fmaxf(acc * p.RSTD2[r], 0.f); p.HF[(size_t)r * DFF + n] = f2bf(v * v); } };
struct EF_down { Params p; __device__ void operator()(int r, int n, float acc) const { const float x2 = p.X1[(size_t)r * DM + n] + acc;
    if (r < NPT) p.out[OFF_Y + (size_t)r * DM + n] = x2; else p.out[OFF_YS + (size_t)(r - NPT) * DM + n] = x2; } };

__global__ void __launch_bounds__(128) k_compress_naive(Params p, int is_s) {
    const int n_cmp = is_s ? 1023 : 127, n_pad = is_s ? 1024 : 128;
    const int kv = blockIdx.y, tid = threadIdx.x;
    const int i = blockIdx.x % n_pad, bg = blockIdx.x / n_pad, b = bg >> 2, g = bg & 3;
    __shared__ float blk[2048]; __shared__ float hid[128];
    if (i >= n_cmp) {
        if (tid < 64) { if (is_s) { (kv ? p.VCMP_S : p.KCMP_S)[((size_t)bg * 1024 + i) * 64 + tid] = 0; }
                        else { if (kv) p.VCMPT_P[((size_t)bg * 64 + tid) * 128 + i] = 0; else p.KCMP_P[((size_t)bg * 128 + i) * 64 + tid] = 0; } }
        return;
    }
    const float* pe = kv ? p.pe_v : p.pe_k; const float* w1 = kv ? p.w1v : p.w1k; const float* w2 = kv ? p.w2v : p.w2k;
    for (int e = tid; e < 2048; e += 128) { const int l = e >> 6, d = e & 63; const int pos = 16 * i + l; float v;
        if (is_s) { const int page = p.page_table[b * NPAGES + (pos >> 7)]; v = (kv ? p.ccv : p.cck)[(((size_t)page * PAGE + (pos & 127)) * 4 + g) * 64 + d]; }
        else v = bf2f(p.KV6[((size_t)b * SEQ + pos) * 1536 + kv * 256 + g * 64 + d]);
        blk[e] = v + pe[e]; }
    __syncthreads();
    float h = 0.f;
    for (int k = 0; k < 2048; ++k) h += blk[k] * w1[(size_t)k * 128 + tid];
    hid[tid] = gelu_tanh(h);
    __syncthreads();
    if (tid < 64) { float o = 0.f; for (int j = 0; j < 128; ++j) o += hid[j] * w2[j * 64 + tid];
        if (is_s) (kv ? p.VCMP_S : p.KCMP_S)[((size_t)bg * 1024 + i) * 64 + tid] = f2bf(o);
        else { if (kv) p.VCMPT_P[((size_t)bg * 64 + tid) * 128 + i] = f2bf(o); else p.KCMP_P[((size_t)bg * 128 + i) * 64 + tid] = f2bf(o); } }
}

struct RowRef { const float* pf; const bf16_t* pb; };
__device__ __forceinline__ float rr_get(const RowRef& r, int d) { return r.pf ? r.pf[d] : bf2f(r.pb[d]); }

template <class KF, class VF>
__device__ __forceinline__ void attend_naive(int nk, KF keyf, VF valf, const float (*q)[64], float (*sc)[1088], float (*oacc)[64], const float* gate3, int gsel, int tid) {
    const int lane = tid & 63, wv = tid >> 6;
    for (int kk = tid; kk < nk; kk += 256) { bool valid; const RowRef r = keyf(kk, valid);
        if (valid) { float d0 = 0.f, d1 = 0.f, d2 = 0.f, d3 = 0.f;
            for (int d = 0; d < 64; ++d) { const float kx = rr_get(r, d); d0 += q[0][d] * kx; d1 += q[1][d] * kx; d2 += q[2][d] * kx; d3 += q[3][d] * kx; }
            sc[0][kk] = d0; sc[1][kk] = d1; sc[2][kk] = d2; sc[3][kk] = d3; }
        else { sc[0][kk] = -INFINITY; sc[1][kk] = -INFINITY; sc[2][kk] = -INFINITY; sc[3][kk] = -INFINITY; } }
    __syncthreads();
    {
        float m = -INFINITY; for (int kk = lane; kk < nk; kk += 64) m = fmaxf(m, sc[wv][kk]);
        m = wave_max(m);
        float s = 0.f;
        for (int kk = lane; kk < nk; kk += 64) { const float x = sc[wv][kk]; const float e = (x == -INFINITY) ? 0.f : __expf(x - m); sc[wv][kk] = e; s += e; }
        s = wave_sum(s);
        const float inv = s > 0.f ? 1.f / s : 0.f;
        for (int kk = lane; kk < nk; kk += 64) sc[wv][kk] *= inv;
    }
    __syncthreads();
    {
        float o = 0.f;
        for (int kk = 0; kk < nk; ++kk) { const float pr = sc[wv][kk]; if (pr != 0.f) o += pr * valf(kk, lane); }
        oacc[wv][lane] += gate3[wv * 3 + gsel] * o;
    }
    __syncthreads();
}

__device__ __forceinline__ void nsa_naive_body(const Params& p, int row, int g, int tid, float (*q)[64], float (*sc)[1088], float (*oacc)[64], float* gate3, float* score, int* selidx) {
    const bool is_s = row >= NPT; const int b = is_s ? row - NPT : row >> 11, t = is_s ? 0 : row & 2047;
    const int start = is_s ? PAST : 0, pos = start + t, rowbase = is_s ? NPT + b : b * SEQ;
    const int n_cmp = is_s ? 1023 : 127, n_slc = is_s ? 257 : 32;
    { const int hd = tid >> 6, d = tid & 63; q[hd][d] = bf2f(p.QN[(size_t)row * 1024 + (g * 4 + hd) * 64 + d]); oacc[hd][d] = 0.f; }
    if (tid < 12) gate3[tid] = p.GATE[(size_t)row * 48 + g * 12 + tid];
    __syncthreads();
    const int bg = b * 4 + g;
    const bf16_t* kc = is_s ? p.KCMP_S + (size_t)bg * 1024 * 64 : p.KCMP_P + (size_t)bg * 128 * 64;
    const bf16_t* vc_s = p.VCMP_S + (size_t)bg * 1024 * 64; const bf16_t* vc_p = p.VCMPT_P + (size_t)bg * 64 * 128;
    auto kf_c = [&](int kk, bool& valid) { valid = (16 * kk + 31 <= pos); return RowRef{nullptr, kc + (size_t)kk * 64}; };
    auto vf_c = [&](int kk, int d) { return is_s ? bf2f(vc_s[(size_t)kk * 64 + d]) : bf2f(vc_p[(size_t)d * 128 + kk]); };
    attend_naive(n_cmp, kf_c, vf_c, q, sc, oacc, gate3, 0, tid);
    for (int j = tid; j < n_slc; j += 256) { float s = 0.f;
        for (int i = 4 * j - 1; i <= 4 * j + 3; ++i) if (i >= 0 && i < n_cmp) s += (sc[0][i] + sc[1][i]) + (sc[2][i] + sc[3][i]);
        score[j] = (j * 64 <= pos) ? s + ((j == 0 || j == pos / 64) ? 1e4f : 0.f) : -1e30f; }
    __syncthreads();
    for (int j = tid; j < n_slc; j += 256) { const float sj = score[j]; int rank = 0;
        for (int j2 = 0; j2 < n_slc; ++j2) { const float s2 = score[j2]; rank += (s2 > sj || (s2 == sj && j2 < j)) ? 1 : 0; }
        if (rank < 16) selidx[rank] = j; }
    __syncthreads();
    auto row_at = [&](int kp, int which) -> RowRef {
        if (kp < start) {
            if (which < 4) { const int page = p.page_table[b * NPAGES + (kp >> 7)]; const float* c = (which == 2) ? p.csk : p.csv; return RowRef{c + (((size_t)page * PAGE + (kp & 127)) * 4 + g) * 64, nullptr}; }
            const float* c = (which == 4) ? p.cwk : p.cwv; return RowRef{c + (((size_t)b * 512 + (kp - (PAST - 512))) * 4 + g) * 64, nullptr};
        }
        return RowRef{nullptr, p.KV6 + (size_t)(rowbase + kp - start) * 1536 + which * 256 + g * 64};
    };
    auto kf_s = [&](int kk, bool& valid) { const int kp = selidx[kk >> 6] * 64 + (kk & 63); valid = (kp <= pos); return valid ? row_at(kp, 2) : RowRef{nullptr, nullptr}; };
    auto vf_s = [&](int kk, int d) { const int kp = selidx[kk >> 6] * 64 + (kk & 63); return rr_get(row_at(kp, 3), d); };
    attend_naive(1024, kf_s, vf_s, q, sc, oacc, gate3, 1, tid);
    auto kf_w = [&](int kk, bool& valid) { const int kp = pos - 512 + kk; valid = (kp >= 0); return valid ? row_at(kp, 4) : RowRef{nullptr, nullptr}; };
    auto vf_w = [&](int kk, int d) { const int kp = pos - 512 + kk; return rr_get(row_at(kp, 5), d); };
    attend_naive(513, kf_w, vf_w, q, sc, oacc, gate3, 2, tid);
    { const int hd = tid >> 6, d = tid & 63; p.OA[(size_t)row * 1024 + (g * 4 + hd) * 64 + d] = f2bf(oacc[hd][d]); }
}
__global__ void __launch_bounds__(256) k_nsa_naive(Params p, int row0) {
    __shared__ float q[4][64]; __shared__ float sc[4][1088]; __shared__ float oacc[4][64]; __shared__ float gate3[12];
    __shared__ float score[260]; __shared__ int selidx[16];
    nsa_naive_body(p, row0 + blockIdx.x, blockIdx.y, threadIdx.x, q, sc, oacc, gate3, score, selidx);
}

__global__ void __launch_bounds__(512) k_gla_naive(Params p, int is_s) {
    const int b = blockIdx.x >> 2, h = blockIdx.x & 3, tid = threadIdx.x, e = tid & 255, half = tid >> 8;
    const int T = is_s ? 1 : SEQ, rowbase = is_s ? NPT + b : b * SEQ;
    __shared__ float a_s[128], q_s[128], k_s[128], part[2][256], red[8];
    float S[64];
#pragma unroll
    for (int dd = 0; dd < 64; ++dd) S[dd] = is_s ? p.state[(((size_t)b * 4 + h) * 128 + half * 64 + dd) * 256 + e] : 0.f;
    for (int t = 0; t < T; ++t) {
        const int row = rowbase + t;
        if (tid < 128) { float x = p.b_a[h * 128 + tid];
            for (int r = 0; r < 16; ++r) x += p.LR[(size_t)row * 16 + r] * p.w_a2[r * 512 + h * 128 + tid];
            a_s[tid] = __expf(logsigmoidf_(x) * (1.f / 16.f));
            q_s[tid] = bf2f(p.GQ[(size_t)row * 512 + h * 128 + tid]); k_s[tid] = bf2f(p.GK[(size_t)row * 512 + h * 128 + tid]); }
        const float v = bf2f(p.GV[(size_t)row * 1024 + h * 256 + e]);
        __syncthreads();
        float po = 0.f;
#pragma unroll
        for (int dd = 0; dd < 64; ++dd) { const int d = half * 64 + dd; S[dd] = a_s[d] * S[dd] + k_s[d] * v; po += q_s[d] * S[dd]; }
        part[half][e] = po;
        __syncthreads();
        float o = 0.f;
        if (tid < 256) { o = part[0][e] + part[1][e]; const float ss = wave_sum(o * o); if ((tid & 63) == 0) red[tid >> 6] = ss; }
        __syncthreads();
        if (tid < 256) { const float ss = (red[0] + red[1]) + (red[2] + red[3]); const float r = rsqrtf(ss * (1.f / 256.f) + EPS);
            p.OB[(size_t)row * 1024 + h * 256 + e] = f2bf(o * r * p.gnorm[e] * bf2f(p.GR[(size_t)row * 1024 + h * 256 + e])); }
    }
    float* so = p.out + (is_s ? OFF_SGLA : OFF_PGLA);
#pragma unroll
    for (int dd = 0; dd < 64; ++dd) so[(((size_t)b * 4 + h) * 128 + half * 64 + dd) * 256 + e] = S[dd];
}

#define GAS __attribute__((address_space(1)))
#define LAS __attribute__((address_space(3)))
typedef unsigned v4u __attribute__((ext_vector_type(4)));
typedef unsigned v2u __attribute__((ext_vector_type(2)));
#define LDS_WAIT() asm volatile("s_waitcnt lgkmcnt(0)" ::: "memory")
#define VM_WAIT() asm volatile("s_waitcnt vmcnt(0)" ::: "memory")
__device__ __forceinline__ unsigned pk2(float lo, float hi) { return (unsigned)f2bf(lo) | ((unsigned)f2bf(hi) << 16); }
constexpr int NIN_PAD = 9984;
__host__ __device__ __forceinline__ int in_colmap(int n) {
    if (n < 2560) return n; if (n < 3072) return C_QL + (n - 2560); if (n < 3584) return C_KL + (n - 3072); if (n < 4608) return C_VL + (n - 3584);
    if (n < 5632) return C_RL + (n - 4608); if (n < 9728) return C_BR + (n - 5632); if (n < 9776) return C_G + (n - 9728); if (n < 9792) return C_LR + (n - 9776); return -1;
}
namespace pg8 {
#define PG8_LAS __attribute__((address_space(3)))
typedef unsigned short bf16_t;
typedef short bf16x8 __attribute__((ext_vector_type(8)));
typedef float f32x4 __attribute__((ext_vector_type(4)));
typedef unsigned u32x4 __attribute__((ext_vector_type(4)));
constexpr int BM = 256, BK = 64, HALF = 128, HTB = HALF * BK * 2  , STAGE_BYTES = 8 * HTB, NXCD = 8, WGM = 8;

__host__ __device__ __forceinline__ int lds_byte(int r, int c) { const int st = (r >> 4) * 2 + (c >> 5), rr = r & 15, cc = c & 31, ob = rr * 64 + cc * 2; return st * 1024 + (ob ^ (((ob >> 9) & 1) << 5)); }
__host__ __device__ __forceinline__ void stage_rc(int b, int& R, int& C) { const int st = b / 1024, sb = b % 1024, swz = sb ^ (((sb >> 9) & 1) << 5); R = (st >> 1) * 16 + swz / 64; C = (st & 1) * 32 + (swz % 64) / 2; }
__host__ __device__ __forceinline__ int perm32(int rho) { const int n = rho >> 4, i = rho & 15; return 8 * (i >> 2) + 4 * n + (i & 3); }

struct Unit { int pm, pn; };
struct Gemm { const bf16_t* A; const bf16_t* Bt; int M, N, K; };

struct StaticOrder {
    int nM, nN, nwg, G, c;
    __host__ __device__ void init(int M, int N, int G_, int c_) { nM = M / BM; nN = N / BM; nwg = nM * nN; G = G_; c = c_; }
    __host__ __device__ bool next(int i, Unit& u) const {
        const long L = (long)i * G + c; if (L >= nwg) return false;
        int wgid = (int)L; { const int q = nwg / NXCD, r = nwg % NXCD, xcd = wgid % NXCD, off = wgid / NXCD; wgid = (xcd < r ? xcd * (q + 1) : r * (q + 1) + (xcd - r) * q) + off; }
        const int nig = WGM * nN, gid = wgid / nig, fm = gid * WGM, gsz = (nM - fm) < WGM ? (nM - fm) : WGM;
        u.pm = fm + ((wgid % nig) % gsz); u.pn = (wgid % nig) / gsz; return true;
    }
    __device__ __forceinline__ void a_ready(const Unit&) const {}
    __device__ __forceinline__ void done(const Unit&) const {}
};

template <class Epi, class Sched, bool ALIGN_EPI = false, bool SP2 = false>
__device__ __forceinline__ void gemm_phase(PG8_LAS unsigned char* lds, const Gemm g, const Sched& S, const Epi& E) {
    const int tid = threadIdx.x, wid = __builtin_amdgcn_readfirstlane(tid >> 6), lane = tid & 63, wr = wid >> 2, wc = wid & 3, fr = lane & 15, fq = lane >> 4;
    const int K = g.K, nt = K / BK;
    unsigned voffA[2], voffB[2];
#pragma unroll
    for (int i = 0; i < 2; ++i) { int R, C; stage_rc(tid * 16 + i * 8192, R, C); const int Rb = Epi::PERM ? ((R & ~31) + perm32(R & 31)) : R;
        voffA[i] = (unsigned)(R * K + C) * 2u; voffB[i] = (unsigned)(Rb * K + C) * 2u; }
    const size_t kstep = (size_t)(BK * 2);
    const size_t hstep = (size_t)HALF * K * 2;
    const size_t tstep = 2 * hstep;
    const unsigned ldsw = (unsigned)wid * 1024u;
    const int aoff = lds_byte(wr * 64 + fr, fq * 8), boff = lds_byte(wc * 32 + fr, fq * 8);
#define PG8_SA(b, h) (((b) * 2 + (h)) * HTB)
#define PG8_SB(b, h) ((4 + (b) * 2 + (h)) * HTB)
#define PG8_STAGE(bufoff, gbase, voff) do { _Pragma("unroll") for (int _i = 0; _i < 2; ++_i) \
        __builtin_amdgcn_global_load_lds((const unsigned*)((const char*)(gbase) + (voff)[_i]), (PG8_LAS unsigned*)(lds + (bufoff) + ldsw + _i * 8192), 16, 0, 0); } while (0)
#define PG8_LDA(dst, b, h) do { _Pragma("unroll") for (int m = 0; m < 4; ++m) _Pragma("unroll") for (int k = 0; k < 2; ++k) dst[m][k] = *(const PG8_LAS bf16x8*)(lds + PG8_SA(b, h) + aoff + m * 2048 + k * 1024); } while (0)
#define PG8_LDB(dst, b, h) do { _Pragma("unroll") for (int n = 0; n < 2; ++n) _Pragma("unroll") for (int k = 0; k < 2; ++k) dst[n][k] = *(const PG8_LAS bf16x8*)(lds + PG8_SB(b, h) + boff + n * 2048 + k * 1024); } while (0)
#define PG8_MMA(ai, bj, At, Bt) do { __builtin_amdgcn_s_setprio(1); _Pragma("unroll") for (int m = 0; m < 4; ++m) _Pragma("unroll") for (int n = 0; n < 2; ++n) _Pragma("unroll") for (int k = 0; k < 2; ++k) \
        acc[ai][bj][m][n] = __builtin_amdgcn_mfma_f32_16x16x32_bf16(Bt[n][k], At[m][k], acc[ai][bj][m][n], 0, 0, 0); __builtin_amdgcn_s_setprio(0); } while (0)
#define PG8_WAIT_V(n) asm volatile("s_waitcnt vmcnt(" #n ")" ::: "memory")
#define PG8_WAIT_L(n) asm volatile("s_waitcnt lgkmcnt(" #n ")" ::: "memory")
#define PG8_BAR __builtin_amdgcn_s_barrier()
#define PG8_SCHED __builtin_amdgcn_sched_barrier(0)
    Unit cur, nxt; int ui = 0;
    if (!S.next(0, cur)) return;
    f32x4 acc[2][2][4][2];
#pragma unroll
    for (int a = 0; a < 2; ++a)
#pragma unroll
        for (int b = 0; b < 2; ++b)
#pragma unroll
            for (int m = 0; m < 4; ++m)
#pragma unroll
                for (int n = 0; n < 2; ++n) acc[a][b][m][n] = (f32x4){0.f, 0.f, 0.f, 0.f};
    bf16x8 At[4][2], B0[2][2], B1[2][2];
    const char* cA = (const char*)g.A + (size_t)cur.pm * tstep; const char* cB = (const char*)g.Bt + (size_t)cur.pn * tstep;
    S.a_ready(cur);
    if constexpr (SP2) {
        PG8_STAGE(PG8_SB(0, 0), cB, voffB); PG8_STAGE(PG8_SB(0, 1), cB + hstep, voffB); PG8_STAGE(PG8_SA(0, 0), cA, voffA); PG8_STAGE(PG8_SA(0, 1), cA + hstep, voffA);
        if (wr == 1) PG8_BAR;
        PG8_WAIT_V(2); PG8_BAR;
        PG8_STAGE(PG8_SB(1, 0), cB + kstep, voffB); PG8_STAGE(PG8_SA(1, 0), cA + kstep, voffA); PG8_STAGE(PG8_SB(1, 1), cB + hstep + kstep, voffB);
        PG8_WAIT_V(6); PG8_BAR;
    } else {
        PG8_STAGE(PG8_SB(0, 0), cB, voffB); PG8_STAGE(PG8_SA(0, 0), cA, voffA); PG8_STAGE(PG8_SB(0, 1), cB + hstep, voffB); PG8_STAGE(PG8_SA(0, 1), cA + hstep, voffA);
        if (wr == 1) PG8_BAR;
        PG8_WAIT_V(4); PG8_BAR;
        PG8_STAGE(PG8_SB(1, 0), cB + kstep, voffB); PG8_STAGE(PG8_SA(1, 0), cA + kstep, voffA); PG8_STAGE(PG8_SB(1, 1), cB + hstep + kstep, voffB);
        PG8_WAIT_V(6); PG8_BAR;
    }
    for (;;) {
        const bool has_next = S.next(ui + 1, nxt);
        const char* nA = has_next ? (const char*)g.A + (size_t)nxt.pm * tstep : cA; const char* nB = has_next ? (const char*)g.Bt + (size_t)nxt.pn * tstep : cB;
        for (int t = 0; t < nt; t += 2) {
            const bool last = (t == nt - 2);
            const char* a1 = cA + (size_t)(t + 1) * kstep;
            const char* a2 = last ? nA : cA + (size_t)(t + 2) * kstep; const char* b2 = last ? nB : cB + (size_t)(t + 2) * kstep;
            const char* a3 = a2 + kstep; const char* b3 = b2 + kstep;
            if (last && has_next) S.a_ready(nxt);
            if constexpr (SP2) {
            PG8_LDB(B0, 0, 0); PG8_LDB(B1, 0, 1); PG8_SCHED; PG8_LDA(At, 0, 0); PG8_STAGE(PG8_SA(1, 1), a1 + hstep, voffA);
            PG8_WAIT_V(8); PG8_WAIT_L(0); PG8_BAR; PG8_MMA(0, 0, At, B0); PG8_MMA(0, 1, At, B1); PG8_BAR; PG8_SCHED;
            PG8_LDA(At, 0, 1); PG8_STAGE(PG8_SB(0, 0), b2, voffB); PG8_STAGE(PG8_SB(0, 1), b2 + hstep, voffB); PG8_STAGE(PG8_SA(0, 0), a2, voffA);
            PG8_WAIT_V(8); PG8_WAIT_L(0); PG8_BAR; PG8_MMA(1, 0, At, B0); PG8_MMA(1, 1, At, B1); PG8_BAR; PG8_SCHED;
            PG8_LDB(B0, 1, 0); PG8_LDB(B1, 1, 1); PG8_SCHED; PG8_LDA(At, 1, 0); PG8_STAGE(PG8_SA(0, 1), a2 + hstep, voffA);
            PG8_WAIT_V(8); PG8_WAIT_L(0); PG8_BAR; PG8_MMA(0, 0, At, B0); PG8_MMA(0, 1, At, B1); PG8_BAR; PG8_SCHED;
            PG8_LDA(At, 1, 1); PG8_STAGE(PG8_SB(1, 0), b3, voffB); PG8_STAGE(PG8_SB(1, 1), b3 + hstep, voffB); PG8_STAGE(PG8_SA(1, 0), a3, voffA);
            PG8_WAIT_V(8); PG8_WAIT_L(0); PG8_BAR; PG8_MMA(1, 0, At, B0); PG8_MMA(1, 1, At, B1); PG8_BAR; PG8_SCHED;
            } else {
            PG8_LDB(B0, 0, 0); PG8_SCHED; PG8_LDA(At, 0, 0); PG8_STAGE(PG8_SA(1, 1), a1 + hstep, voffA);
            PG8_WAIT_L(8); PG8_BAR; PG8_WAIT_L(0); PG8_MMA(0, 0, At, B0); PG8_BAR; PG8_SCHED;
            PG8_LDB(B1, 0, 1); PG8_STAGE(PG8_SB(0, 0), b2, voffB);
            PG8_BAR; PG8_WAIT_L(0); PG8_MMA(0, 1, At, B1); PG8_BAR;
            PG8_LDA(At, 0, 1); PG8_STAGE(PG8_SA(0, 0), a2, voffA);
            PG8_BAR; PG8_WAIT_L(0); PG8_MMA(1, 0, At, B0); PG8_BAR; PG8_SCHED;
            PG8_STAGE(PG8_SB(0, 1), b2 + hstep, voffB);
            PG8_WAIT_V(6); PG8_BAR; PG8_MMA(1, 1, At, B1); PG8_BAR;
            PG8_LDB(B0, 1, 0); PG8_SCHED; PG8_LDA(At, 1, 0); PG8_STAGE(PG8_SA(0, 1), a2 + hstep, voffA);
            PG8_WAIT_L(8); PG8_BAR; PG8_WAIT_L(0); PG8_MMA(0, 0, At, B0); PG8_BAR; PG8_SCHED;
            PG8_LDB(B1, 1, 1); PG8_STAGE(PG8_SB(1, 0), b3, voffB);
            PG8_BAR; PG8_WAIT_L(0); PG8_MMA(0, 1, At, B1); PG8_BAR;
            PG8_LDA(At, 1, 1); PG8_STAGE(PG8_SA(1, 0), a3, voffA);
            PG8_BAR; PG8_WAIT_L(0); PG8_MMA(1, 0, At, B0); PG8_BAR; PG8_SCHED;
            PG8_STAGE(PG8_SB(1, 1), b3 + hstep, voffB);
            PG8_WAIT_V(6); PG8_BAR; PG8_MMA(1, 1, At, B1); PG8_BAR;
            }
        }
        if constexpr (ALIGN_EPI) { if (wr == 0) PG8_BAR; }
        if constexpr (!Epi::AFTER_DRAIN) { E(acc, cur, wr, wc, fr, fq); S.done(cur); }
        if (!has_next) break;
#pragma unroll
        for (int a = 0; a < 2; ++a)
#pragma unroll
            for (int b = 0; b < 2; ++b)
#pragma unroll
                for (int m = 0; m < 4; ++m)
#pragma unroll
                    for (int n = 0; n < 2; ++n) acc[a][b][m][n] = (f32x4){0.f, 0.f, 0.f, 0.f};
        cur = nxt; cA = nA; cB = nB; ++ui;
        if constexpr (ALIGN_EPI) { if (wr == 1) PG8_BAR; }
    }
    PG8_WAIT_V(0);
    if constexpr (!ALIGN_EPI) { if (wr == 0) PG8_BAR; }
    PG8_BAR;
    if constexpr (Epi::AFTER_DRAIN) { E.fused(acc, cur, wr, wc, fr, fq, lds, wid, lane); S.done(cur); }
#undef PG8_SA
#undef PG8_SB
#undef PG8_STAGE
#undef PG8_LDA
#undef PG8_LDB
#undef PG8_MMA
#undef PG8_WAIT_V
#undef PG8_WAIT_L
#undef PG8_BAR
#undef PG8_SCHED
}
}
typedef pg8::f32x4 f32x4;
template <class F> struct EpiGen {
    static constexpr bool PERM = false, AFTER_DRAIN = false; F f;
    __device__ __forceinline__ void operator()(const f32x4 (&acc)[2][2][4][2], const pg8::Unit& u, int wr, int wc, int fr, int fq) const {
        const int row0 = u.pm * 256 + wr * 64 + fr, col0 = u.pn * 256 + wc * 32 + 4 * fq;
#pragma unroll
        for (int ai = 0; ai < 2; ++ai)
#pragma unroll
            for (int m = 0; m < 4; ++m) { const int row = row0 + ai * 128 + m * 16; const float ctx = f.row_begin(row); float part = 0.f;
#pragma unroll
                for (int bj = 0; bj < 2; ++bj)
#pragma unroll
                    for (int n = 0; n < 2; ++n) part += f.store4(ctx, row, col0 + bj * 128 + n * 16, acc[ai][bj][m][n]);
                f.row_end(row, part, fq, true); }
    }
};
template <int ACT  >
__device__ __forceinline__ void store_tile_bf16(const f32x4 (&acc)[2][2][4][2], int row0, int col0, const float* rstd, float scale, bf16_t* dst, int ld) {
#pragma unroll
    for (int ai = 0; ai < 2; ++ai)
#pragma unroll
        for (int m = 0; m < 4; ++m) { const int row = row0 + ai * 128 + m * 16; const float rs = rstd[row] * scale; bf16_t* rp = dst + (size_t)row * ld + col0;
#pragma unroll
            for (int bj = 0; bj < 2; ++bj)
#pragma unroll
                for (int n = 0; n < 2; ++n) { f32x4 v = acc[ai][bj][m][n] * rs;
                    if (ACT == 1) { v[0] = siluf_(v[0]); v[1] = siluf_(v[1]); v[2] = siluf_(v[2]); v[3] = siluf_(v[3]); }
                    if (ACT == 2) { v[0] = sigmoidf_(v[0]); v[1] = sigmoidf_(v[1]); v[2] = sigmoidf_(v[2]); v[3] = sigmoidf_(v[3]); }
                    v2u w; w.x = pk2(v[0], v[1]); w.y = pk2(v[2], v[3]); *(v2u*)(rp + bj * 128 + n * 16) = w; } }
}
struct EpiProj {
    static constexpr bool PERM = false, AFTER_DRAIN = false;
    const float* rstd; const float* b_gate; bf16_t *QN, *KV6, *GQ, *GK, *GV, *GR, *BR; float *GATE, *LR, *out;
    __device__ __forceinline__ void operator()(const f32x4 (&acc)[2][2][4][2], const pg8::Unit& u, int wr, int wc, int fr, int fq) const {
        const int row0 = u.pm * 256 + wr * 64 + fr, cl0 = wc * 32 + 4 * fq, pn = u.pn;
        if (pn < 4) store_tile_bf16<0>(acc, row0, pn * 256 + cl0, rstd, 0.125f, QN, 1024);
        else if (pn < 10) { const int j = pn - 4;
            store_tile_bf16<0>(acc, row0, j * 256 + cl0, rstd, 1.f, KV6, 1536);
#pragma unroll
            for (int ai = 0; ai < 2; ++ai)
#pragma unroll
                for (int m = 0; m < 4; ++m) { const int row = row0 + ai * 128 + m * 16; const float rs = rstd[row]; const int b = row >> 11, t = row & 2047;
                    float* rp = nullptr;
                    if (j < 4) rp = out + OFF_PCK + j * SZ_PROW + (size_t)row * 256 + cl0;
                    else if (t >= 1536) rp = out + OFF_PWK + (j - 4) * SZ_PWIN + ((size_t)b * 512 + (t - 1536)) * 256 + cl0;
                    if (rp) {
#pragma unroll
                        for (int bj = 0; bj < 2; ++bj)
#pragma unroll
                            for (int n = 0; n < 2; ++n) *(f32x4*)(rp + bj * 128 + n * 16) = acc[ai][bj][m][n] * rs; } }
        }
        else if (pn < 12) store_tile_bf16<0>(acc, row0, (pn - 10) * 256 + cl0, rstd, 0.08838834764831845f, GQ, 512);
        else if (pn < 14) store_tile_bf16<0>(acc, row0, (pn - 12) * 256 + cl0, rstd, 1.f, GK, 512);
        else if (pn < 18) store_tile_bf16<0>(acc, row0, (pn - 14) * 256 + cl0, rstd, 1.f, GV, 1024);
        else if (pn < 22) store_tile_bf16<1>(acc, row0, (pn - 18) * 256 + cl0, rstd, 1.f, GR, 1024);
        else if (pn < 38) store_tile_bf16<2>(acc, row0, (pn - 22) * 256 + cl0, rstd, 1.f, BR, 4096);
        else if (wc < 2) {
#pragma unroll
            for (int ai = 0; ai < 2; ++ai)
#pragma unroll
                for (int m = 0; m < 4; ++m) { const int row = row0 + ai * 128 + m * 16; const float rs = rstd[row];
#pragma unroll
                    for (int n = 0; n < 2; ++n) { const int cl = cl0 + n * 16; const f32x4 v = acc[ai][0][m][n] * rs;
                        if (cl < 48) { const f32x4 bg = *(const f32x4*)(b_gate + cl); f32x4 o; o[0] = sigmoidf_(v[0] + bg[0]); o[1] = sigmoidf_(v[1] + bg[1]); o[2] = sigmoidf_(v[2] + bg[2]); o[3] = sigmoidf_(v[3] + bg[3]);
                            *(f32x4*)(GATE + (size_t)row * 48 + cl) = o; }
                        else *(f32x4*)(LR + (size_t)row * 16 + (cl - 48)) = v; } }
        }
    }
};
struct F_bra { const bf16_t* BR; float* TMP;
    __device__ __forceinline__ float row_begin(int) const { return 0.f; }
    __device__ __forceinline__ float store4(float, int row, int col, f32x4 v) const { const v2u b = *(const v2u*)(BR + (size_t)row * 4096 + col);
        f32x4 o; o[0] = v[0] * bf2f((bf16_t)(b.x & 0xffff)); o[1] = v[1] * bf2f((bf16_t)(b.x >> 16)); o[2] = v[2] * bf2f((bf16_t)(b.y & 0xffff)); o[3] = v[3] * bf2f((bf16_t)(b.y >> 16));
        *(f32x4*)(TMP + (size_t)row * DM + col) = o; return 0.f; }
    __device__ __forceinline__ void row_end(int, float, int, bool) const {}
};
struct F_brb { const bf16_t* BR; const float* TMP; bf16_t* MB;
    __device__ __forceinline__ float row_begin(int) const { return 0.f; }
    __device__ __forceinline__ float store4(float, int row, int col, f32x4 v) const { const v2u b = *(const v2u*)(BR + (size_t)row * 4096 + 2048 + col); const f32x4 t = *(const f32x4*)(TMP + (size_t)row * DM + col);
        const float o0 = t[0] + v[0] * bf2f((bf16_t)(b.x & 0xffff)), o1 = t[1] + v[1] * bf2f((bf16_t)(b.x >> 16)), o2 = t[2] + v[2] * bf2f((bf16_t)(b.y & 0xffff)), o3 = t[3] + v[3] * bf2f((bf16_t)(b.y >> 16));
        v2u w; w.x = pk2(o0, o1); w.y = pk2(o2, o3); *(v2u*)(MB + (size_t)row * DM + col) = w; return 0.f; }
    __device__ __forceinline__ void row_end(int, float, int, bool) const {}
};
struct F_wo { const float* x; float* X1; bf16_t* X1B; float* SUMSQ;
    __device__ __forceinline__ float row_begin(int) const { return 0.f; }
    __device__ __forceinline__ float store4(float, int row, int col, f32x4 v) const { const f32x4 xv = *(const f32x4*)(x + (size_t)row * DM + col); const f32x4 x1 = xv + v;
        *(f32x4*)(X1 + (size_t)row * DM + col) = x1; v2u w; w.x = pk2(x1[0], x1[1]); w.y = pk2(x1[2], x1[3]); *(v2u*)(X1B + (size_t)row * DM + col) = w;
        return (x1[0] * x1[0] + x1[1] * x1[1]) + (x1[2] * x1[2] + x1[3] * x1[3]); }
    __device__ __forceinline__ void row_end(int row, float part, int fq, bool valid) const { part += __shfl_xor(part, 16); part += __shfl_xor(part, 32); if (fq == 0 && valid) atomicAdd(SUMSQ + row, part); }
};
struct F_up { const float* SUMSQ; bf16_t* HF;
    __device__ __forceinline__ float row_begin(int row) const { return rsqrtf(SUMSQ[row] * (1.f / DM) + EPS); }
    __device__ __forceinline__ float store4(float rs, int row, int col, f32x4 v) const { float h[4];
#pragma unroll
        for (int i = 0; i < 4; ++i) { const float t = fmaxf(v[i] * rs, 0.f); h[i] = t * t; }
        v2u w; w.x = pk2(h[0], h[1]); w.y = pk2(h[2], h[3]); *(v2u*)(HF + (size_t)row * DFF + col) = w; return 0.f; }
    __device__ __forceinline__ void row_end(int, float, int, bool) const {}
};
struct F_down { const float* X1; float* Y; float* SUMSQ;
    __device__ __forceinline__ float row_begin(int) const { return 0.f; }
    __device__ __forceinline__ float store4(float, int row, int col, f32x4 v) const { const f32x4 x1 = *(const f32x4*)(X1 + (size_t)row * DM + col); const f32x4 x2 = x1 + v;
        *(f32x4*)(Y + (size_t)row * DM + col) = x2; return (x2[0] * x2[0] + x2[1] * x2[1]) + (x2[2] * x2[2] + x2[3] * x2[3]); }
    __device__ __forceinline__ void row_end(int row, float part, int fq, bool valid) const { part += __shfl_xor(part, 16); part += __shfl_xor(part, 32); if (fq == 0 && valid) atomicAdd(SUMSQ + row, part); }
};

typedef short bf16x8_t __attribute__((ext_vector_type(8)));
template <class F>
__device__ __forceinline__ void skinny_gemm(LAS unsigned char* lds, const bf16_t* A, int lda, const bf16_t* Bt, int N, int K, const F& f, int bid, int G, int tid) {
    const int lane = tid & 63, wave = __builtin_amdgcn_readfirstlane(tid >> 6), j = lane & 15, g = lane >> 4;
    LAS f32x4* red = (LAS f32x4*)lds;
    const int ksl = K >> 3;
    for (int it = bid; it < (N >> 4); it += G) {
        const int n0 = it * 16;
        const bf16_t* bp = Bt + (size_t)(n0 + j) * K + wave * ksl + 8 * g;
        const bf16_t* ap = A + (size_t)(j & 7) * lda + wave * ksl + 8 * g;
        f32x4 acc = {0.f, 0.f, 0.f, 0.f};
#pragma unroll 4
        for (int k = 0; k < ksl; k += 32) {
            const bf16x8_t b = *(const bf16x8_t*)(bp + k); bf16x8_t a = *(const bf16x8_t*)(ap + k);
            if (j >= 8) a = (bf16x8_t){0, 0, 0, 0, 0, 0, 0, 0};
            acc = __builtin_amdgcn_mfma_f32_16x16x32_bf16(b, a, acc, 0, 0, 0);
        }
        red[wave * 64 + lane] = acc;
        __syncthreads();
        if (wave == 0) { f32x4 sacc = red[lane];
#pragma unroll
            for (int w = 1; w < 8; ++w) sacc = sacc + red[w * 64 + lane];
            const int row = NPT + (j & 7); const bool valid = j < 8; const float ctx = f.row_begin(row); float part = 0.f;
            if (valid) part = f.store4(ctx, row, n0 + 4 * g, sacc);
            f.row_end(row, part, g, valid); }
        __syncthreads();
    }
}
struct F_proj_s { const Params& p;
    __device__ __forceinline__ float row_begin(int row) const { return p.RSTD1[row]; }
    __device__ __forceinline__ float store4(float rs, int row, int col, f32x4 v) const { const int n0 = in_colmap(col); if (n0 >= 0) {
#pragma unroll
        for (int i = 0; i < 4; ++i) proj_store(p, row, n0 + i, v[i] * rs); } return 0.f; }
    __device__ __forceinline__ void row_end(int, float, int, bool) const {}
};

template <class CM>
__device__ __forceinline__ void transpose_item(const float* W, int ldw, const float* kscale, bf16_t* WT, int K, int item, int nblk, CM cm, LAS float* scr, int lane) {
    const int kb = item / nblk, nb = item % nblk, k0 = 64 * kb, n0 = 32 * nb;
    const int sc = cm(n0 + (lane & 31));
#pragma unroll 8
    for (int i = 0; i < 32; ++i) { const int kk = 2 * i + (lane >> 5); float v = sc >= 0 ? W[(size_t)(k0 + kk) * ldw + sc] : 0.f; if (kscale) v *= kscale[k0 + kk]; scr[kk * 33 + (lane & 31)] = v; }
    LDS_WAIT(); asm volatile("" ::: "memory");
    const int c = lane & 7;
#pragma unroll
    for (int j = 0; j < 4; ++j) { const int n = (lane >> 3) + 8 * j; const LAS float* s = scr + (8 * c) * 33 + n;
        v4u o; o.x = pk2(s[0 * 33], s[1 * 33]); o.y = pk2(s[2 * 33], s[3 * 33]); o.z = pk2(s[4 * 33], s[5 * 33]); o.w = pk2(s[6 * 33], s[7 * 33]);
        *(v4u*)(WT + (size_t)(n0 + n) * K + k0 + 8 * c) = o; }
    LDS_WAIT(); asm volatile("" ::: "memory");
}
struct CM_id { __device__ __forceinline__ int operator()(int n) const { return n; } };
struct CM_in { __device__ __forceinline__ int operator()(int n) const { return in_colmap(n); } };

__device__ __forceinline__ void ph_prologue(const Params& p, LAS unsigned char* lds, int bid, int G, int tid) {
    const int lane = tid & 63, wave = tid >> 6, gw = bid * 8 + wave, NGW = G * 8;
    LAS float* scr = (LAS float*)(lds + wave * 16384);
    constexpr int I_IN = 32 * (NIN_PAD / 32), I_BR = 16 * 64, I_O = 32 * 64, I_UP = 32 * 256, I_DN = 128 * 64;
    constexpr int TOTAL = I_IN + 2 * I_BR + I_O + I_UP + I_DN;
    for (int it = gw; it < TOTAL; it += NGW) { int r = it;
        if (r < I_IN) { transpose_item(p.w_in, DIN, p.norm1_g, p.WIN_T, DM, r, NIN_PAD / 32, CM_in{}, scr, lane); continue; } r -= I_IN;
        if (r < I_BR) { transpose_item(p.w_br_a, DM, nullptr, p.WBRA_T, 1024, r, 64, CM_id{}, scr, lane); continue; } r -= I_BR;
        if (r < I_BR) { transpose_item(p.w_br_b, DM, nullptr, p.WBRB_T, 1024, r, 64, CM_id{}, scr, lane); continue; } r -= I_BR;
        if (r < I_O) { transpose_item(p.w_o, DM, nullptr, p.WO_T, DM, r, 64, CM_id{}, scr, lane); continue; } r -= I_O;
        if (r < I_UP) { transpose_item(p.w_up, DFF, p.norm2_g, p.WUP_T, DM, r, 256, CM_id{}, scr, lane); continue; } r -= I_UP;
        transpose_item(p.w_down, DM, nullptr, p.WDN_T, DFF, r, 64, CM_id{}, scr, lane);
    }
    for (int row = gw; row < NTOK; row += NGW) {
        const f32x4* xr = (const f32x4*)(row < NPT ? p.x_prompt + (size_t)row * DM : p.x_sample + (size_t)(row - NPT) * DM) + lane;
        f32x4 v[8]; float ss = 0.f;
#pragma unroll
        for (int j = 0; j < 8; ++j) { v[j] = xr[64 * j]; ss += (v[j][0] * v[j][0] + v[j][1] * v[j][1]) + (v[j][2] * v[j][2] + v[j][3] * v[j][3]); }
        ss = wave_sum(ss);
        v2u* o = (v2u*)(p.XB + (size_t)row * DM) + lane;
#pragma unroll
        for (int j = 0; j < 8; ++j) { v2u w; w.x = pk2(v[j][0], v[j][1]); w.y = pk2(v[j][2], v[j][3]); o[64 * j] = w; }
        if (lane == 0) p.RSTD1[row] = rsqrtf(ss * (1.f / DM) + EPS);
    }
    for (int i = bid * 512 + tid; i < DB * 511 * 64; i += G * 512) { const int c4 = i & 63, r = (i >> 6) % 511, b = (i >> 6) / 511;
        const size_t so = ((size_t)b * 512 + r + 1) * 256 + c4 * 4, dofs = ((size_t)b * 512 + r) * 256 + c4 * 4;
        *(f32x4*)(p.out + OFF_SWK + dofs) = *(const f32x4*)(p.cwk + so); *(f32x4*)(p.out + OFF_SWK + SZ_SWIN + dofs) = *(const f32x4*)(p.cwv + so); }
}
__device__ __forceinline__ void ph_final_norm(const Params& p, int bid, int G, int tid) {
    const int lane = tid & 63, wave = tid >> 6, gw = bid * 8 + wave, NGW = G * 8;
    for (int row = gw; row < NTOK; row += NGW) {
        float* yr = row < NPT ? p.out + OFF_Y + (size_t)row * DM : p.out + OFF_YS + (size_t)(row - NPT) * DM;
        const float r = rsqrtf(p.SUMSQ3[row] * (1.f / DM) + EPS);
        f32x4* y4 = (f32x4*)yr + lane; const f32x4* g4 = (const f32x4*)p.norm_f + lane;
#pragma unroll
        for (int j = 0; j < 8; ++j) { f32x4 v = y4[64 * j]; const f32x4 g = g4[64 * j]; v = v * r * g; y4[64 * j] = v; }
    }
}

__device__ __forceinline__ unsigned pk2t(float lo, float hi) { return pk2(lo, hi); }
template <bool IS_S>
__device__ __forceinline__ void cmp_gemm_tile(const Params& p, LAS unsigned char* lds, int tile, int tid) {
    const int lane = tid & 63, wave = __builtin_amdgcn_readfirstlane(tid >> 6), wm = wave >> 2, wn = wave & 3, fr = lane & 15, fg = lane >> 4;
    int kv, b, ct = 0, g = 0;
    if (IS_S) { ct = tile & 31; b = (tile >> 5) & 7; kv = tile >> 8; } else { g = tile & 3; b = (tile >> 2) & 3; kv = tile >> 4; }
    const bf16_t* W = p.W1T + (size_t)kv * 256 * 1024;
    const float* asf[4]; const bf16_t* asb[4];
#pragma unroll
    for (int q = 0; q < 4; ++q) { const int i = q * 32 + (tid >> 4), d4 = (tid & 15) * 4;
        if (IS_S) { const int cl = i >> 2, gg = i & 3, c = 32 * ct + cl; const int page = p.page_table[b * NPAGES + (c >> 3)];
            asf[q] = (kv ? p.ccv : p.cck) + (((size_t)page * PAGE + (c & 7) * 16) * 4 + gg) * 64 + d4; asb[q] = nullptr; }
        else { asb[q] = p.KV6 + ((size_t)(b * SEQ + 16 * i)) * 1536 + kv * 256 + g * 64 + d4; asf[q] = nullptr; } }
    const bf16_t* bsrc = W + (size_t)(tid >> 3) * 1024 + (tid & 7) * 8;
    f32x4 ra[4]; v2u rab[4]; v4u rb[4];
    auto load_regs = [&](int r) {
#pragma unroll
        for (int q = 0; q < 4; ++q) { if (IS_S) ra[q] = *(const f32x4*)(asf[q] + (size_t)r * 256); else rab[q] = *(const v2u*)(asb[q] + (size_t)r * 1536);
            rb[q] = *(const v4u*)(bsrc + (size_t)q * 64 * 1024 + r * 64); } };
    auto write_lds = [&](int s) { LAS unsigned char* ab = lds + s * 55296; LAS unsigned char* bb = ab + 18432;
#pragma unroll
        for (int q = 0; q < 4; ++q) { const int i = q * 32 + (tid >> 4), d4 = (tid & 15) * 4; v2u w;
            if (IS_S) { w.x = pk2(ra[q][0], ra[q][1]); w.y = pk2(ra[q][2], ra[q][3]); } else w = rab[q];
            *(LAS v2u*)(ab + i * 144 + d4 * 2) = w;
            *(LAS v4u*)(bb + (q * 64 + (tid >> 3)) * 144 + (tid & 7) * 16) = rb[q]; } };
    f32x4 acc[4][4];
#pragma unroll
    for (int mi = 0; mi < 4; ++mi)
#pragma unroll
        for (int ni = 0; ni < 4; ++ni) acc[mi][ni] = (f32x4){0.f, 0.f, 0.f, 0.f};
    load_regs(0); write_lds(0); __syncthreads();
    for (int r = 0; r < 16; ++r) {
        if (r + 1 < 16) load_regs(r + 1);
        const LAS unsigned char* ab = lds + (r & 1) * 55296; const LAS unsigned char* bb = ab + 18432;
#pragma unroll
        for (int ks = 0; ks < 2; ++ks) { bf16x8_t af[4], bfr[4];
#pragma unroll
            for (int mi = 0; mi < 4; ++mi) af[mi] = *(const LAS bf16x8_t*)(ab + (64 * wm + 16 * mi + fr) * 144 + (32 * ks + 8 * fg) * 2);
#pragma unroll
            for (int ni = 0; ni < 4; ++ni) bfr[ni] = *(const LAS bf16x8_t*)(bb + (64 * wn + 16 * ni + fr) * 144 + (32 * ks + 8 * fg) * 2);
#pragma unroll
            for (int mi = 0; mi < 4; ++mi)
#pragma unroll
                for (int ni = 0; ni < 4; ++ni) acc[mi][ni] = __builtin_amdgcn_mfma_f32_16x16x32_bf16(bfr[ni], af[mi], acc[mi][ni], 0, 0, 0); }
        if (r + 1 < 16) write_lds((r + 1) & 1);
        __syncthreads();
    }
    float* AB = IS_S ? p.AB_S + (size_t)kv * 32768 * 256 : p.AB_P + (size_t)kv * 2048 * 256;
#pragma unroll
    for (int mi = 0; mi < 4; ++mi) { const int i = 64 * wm + 16 * mi + fr; size_t R;
        if (IS_S) R = (size_t)(b * 4 + (i & 3)) * 1024 + 32 * ct + (i >> 2); else R = (size_t)(b * 4 + g) * 128 + i;
#pragma unroll
        for (int ni = 0; ni < 4; ++ni) *(f32x4*)(AB + R * 256 + 64 * wn + 16 * ni + 4 * fg) = acc[mi][ni]; }
}
template <bool IS_S>
__device__ __forceinline__ void cmp_part2(const Params& p, LAS unsigned char* lds, int kv, int bg, int i0, int tid) {
    constexpr int n_cmp = IS_S ? 1023 : 127, nrs = IS_S ? 1024 : 128;
    const int lane = tid & 63, wave = __builtin_amdgcn_readfirstlane(tid >> 6), fr = lane & 15, fg = lane >> 4;
    const float* AB = (IS_S ? p.AB_S + (size_t)kv * 32768 * 256 : p.AB_P + (size_t)kv * 2048 * 256) + (size_t)bg * nrs * 256;
    LAS unsigned char* H = lds; LAS unsigned char* W2T = lds + 128 * 272;
    const float* w2 = kv ? p.w2v : p.w2k; const float* bias = p.BIAS1 + kv * 128;
    for (int idx = tid; idx < 128 * 32; idx += 512) { const int row = idx >> 5, j4 = (idx & 31) * 4, i = i0 + row; v2u w; w.x = 0u; w.y = 0u;
        if (i < n_cmp) { const f32x4 a = *(const f32x4*)(AB + (size_t)i * 256 + j4), bq = *(const f32x4*)(AB + (size_t)(i + 1) * 256 + 128 + j4), bi = *(const f32x4*)(bias + j4);
            const f32x4 h = a + bq + bi; w.x = pk2(gelu_tanh(h[0]), gelu_tanh(h[1])); w.y = pk2(gelu_tanh(h[2]), gelu_tanh(h[3])); }
        *(LAS v2u*)(H + row * 272 + j4 * 2) = w; }
    for (int idx = tid; idx < 8192; idx += 512) { const int j = idx >> 6, d = idx & 63; *(LAS bf16_t*)(W2T + d * 272 + j * 2) = f2bf(w2[idx]); }
    __syncthreads();
    f32x4 acc[4];
#pragma unroll
    for (int ni = 0; ni < 4; ++ni) acc[ni] = (f32x4){0.f, 0.f, 0.f, 0.f};
#pragma unroll
    for (int ks = 0; ks < 4; ++ks) { const bf16x8_t hb = *(const LAS bf16x8_t*)(H + (16 * wave + fr) * 272 + (32 * ks + 8 * fg) * 2);
#pragma unroll
        for (int ni = 0; ni < 4; ++ni) { const bf16x8_t wa = *(const LAS bf16x8_t*)(W2T + (16 * ni + fr) * 272 + (32 * ks + 8 * fg) * 2);
            acc[ni] = __builtin_amdgcn_mfma_f32_16x16x32_bf16(wa, hb, acc[ni], 0, 0, 0); } }
    const int i = i0 + 16 * wave + fr;
    if (i < nrs) {
#pragma unroll
        for (int ni = 0; ni < 4; ++ni) { const int d = 16 * ni + 4 * fg;
            if (IS_S) { v2u w; w.x = pk2(acc[ni][0], acc[ni][1]); w.y = pk2(acc[ni][2], acc[ni][3]); *(v2u*)((kv ? p.VCMP_S : p.KCMP_S) + ((size_t)bg * 1024 + i) * 64 + d) = w; }
            else if (kv == 0) { v2u w; w.x = pk2(acc[ni][0], acc[ni][1]); w.y = pk2(acc[ni][2], acc[ni][3]); *(v2u*)(p.KCMP_P + ((size_t)bg * 128 + i) * 64 + d) = w; }
            else {
#pragma unroll
                for (int r = 0; r < 4; ++r) p.VCMPT_P[((size_t)bg * 64 + d + r) * 128 + i] = f2bf(acc[ni][r]); } } }
    __syncthreads();
}
__device__ __forceinline__ void ph_pro0(const Params& p, LAS unsigned char* lds, int bid, int G, int tid) {
    const int lane = tid & 63, wave = tid >> 6, gw = bid * 8 + wave, NGW = G * 8;
    LAS float* scr = (LAS float*)(lds + wave * 16384);
    for (int it = gw; it < 4 * 64; it += NGW) { const int q = it >> 6, r = it & 63, kv = q >> 1, half = q & 1;
        transpose_item((kv ? p.w1v : p.w1k) + (size_t)half * 1024 * 128, 128, nullptr, p.W1T + ((size_t)kv * 256 + half * 128) * 1024, 1024, r, 4, CM_id{}, scr, lane); }
    for (int i = bid * 512 + tid; i < NTOK; i += G * 512) { p.SUMSQ2[i] = 0.f; p.SUMSQ3[i] = 0.f; }
    __syncthreads();
    for (int it = bid; it < 4; it += G) { const int kv = it >> 1, jh = it & 1, j = jh * 64 + (tid & 63), ks = tid >> 6;
        const float* pe = kv ? p.pe_v : p.pe_k; const float* w1 = kv ? p.w1v : p.w1k; float s = 0.f;
        for (int k = ks * 256; k < ks * 256 + 256; ++k) s += pe[k] * w1[(size_t)k * 128 + j];
        LAS float* red = (LAS float*)lds; red[tid] = s; __syncthreads();
        if (tid < 64) { float t = 0.f; for (int w = 0; w < 8; ++w) t += red[w * 64 + tid]; p.BIAS1[kv * 128 + j] = t; }
        __syncthreads(); }
}

constexpr int GL_BC = 0, GL_SEG = 32768, GL_QT = 34816, GL_KT = GL_QT + 64 * 272, GL_AM = GL_KT + 64 * 272, GL_VT = GL_AM + 64 * 144, GL_SSQ = GL_VT + 256 * 144, GL_END = GL_SSQ + 2048;
static_assert(GL_END <= 131072, "gla lds");
__device__ __forceinline__ void gla_gates(const Params& p, LAS unsigned char* lds, int row0, int h, int tid) {
    LAS float* BC = (LAS float*)(lds + GL_BC); LAS float* SEG = (LAS float*)(lds + GL_SEG);
    const int d = tid & 127, cq = tid >> 7;
    float wa[16];
#pragma unroll
    for (int r = 0; r < 16; ++r) wa[r] = p.w_a2[r * 512 + h * 128 + d];
    const float ba = p.b_a[h * 128 + d];
    float run = 0.f;
    for (int cc = 0; cc < 16; ++cc) { const int c = cq * 16 + cc; const f32x4* lr = (const f32x4*)(p.LR + (size_t)(row0 + c) * 16);
        const f32x4 l0 = lr[0], l1 = lr[1], l2 = lr[2], l3 = lr[3];
        float x = ba + (l0[0] * wa[0] + l0[1] * wa[1] + l0[2] * wa[2] + l0[3] * wa[3]) + (l1[0] * wa[4] + l1[1] * wa[5] + l1[2] * wa[6] + l1[3] * wa[7])
                     + (l2[0] * wa[8] + l2[1] * wa[9] + l2[2] * wa[10] + l2[3] * wa[11]) + (l3[0] * wa[12] + l3[1] * wa[13] + l3[2] * wa[14] + l3[3] * wa[15]);
        run += logsigmoidf_(x) * (1.f / 16.f); BC[c * 128 + d] = run; }
    SEG[cq * 128 + d] = run;
    __syncthreads();
    float pre = 0.f;
    for (int q = 0; q < cq; ++q) pre += SEG[q * 128 + d];
    if (cq > 0) for (int cc = 0; cc < 16; ++cc) BC[(cq * 16 + cc) * 128 + d] += pre;
    __syncthreads();
}
__device__ __forceinline__ void gla_load_vt(const Params& p, LAS unsigned char* lds, int row0, int h, int tid) {
    LAS bf16_t* VT = (LAS bf16_t*)(lds + GL_VT);
    const int e8 = (tid & 31) * 8;
#pragma unroll
    for (int q = 0; q < 4; ++q) { const int c = (tid >> 5) + 16 * q; const v4u v = *(const v4u*)(p.GV + (size_t)(row0 + c) * 1024 + h * 256 + e8);
        VT[(e8 + 0) * 72 + c] = (bf16_t)(v.x & 0xffff); VT[(e8 + 1) * 72 + c] = (bf16_t)(v.x >> 16); VT[(e8 + 2) * 72 + c] = (bf16_t)(v.y & 0xffff); VT[(e8 + 3) * 72 + c] = (bf16_t)(v.y >> 16);
        VT[(e8 + 4) * 72 + c] = (bf16_t)(v.z & 0xffff); VT[(e8 + 5) * 72 + c] = (bf16_t)(v.z >> 16); VT[(e8 + 6) * 72 + c] = (bf16_t)(v.w & 0xffff); VT[(e8 + 7) * 72 + c] = (bf16_t)(v.w >> 16); }
}
__device__ __forceinline__ void gla_pass_a(const Params& p, LAS unsigned char* lds, int item, int tid) {
    const int bh = item >> 5, n = item & 31, b = bh >> 2, h = bh & 3, row0 = b * SEQ + n * 64;
    const int lane = tid & 63, wave = __builtin_amdgcn_readfirstlane(tid >> 6), fr = lane & 15, fg = lane >> 4;
    gla_gates(p, lds, row0, h, tid);
    const LAS float* BC = (const LAS float*)(lds + GL_BC);
    LAS bf16_t* KST = (LAS bf16_t*)(lds + GL_QT);
    gla_load_vt(p, lds, row0, h, tid);
    { const int d8 = (tid & 15) * 8;
#pragma unroll
      for (int q = 0; q < 2; ++q) { const int c = (tid >> 4) + 32 * q; const v4u kk = *(const v4u*)(p.GK + (size_t)(row0 + c) * 512 + h * 128 + d8);
          const unsigned wv[4] = {kk.x, kk.y, kk.z, kk.w};
#pragma unroll
          for (int i = 0; i < 8; ++i) { const int d = d8 + i; const float kx = bf2f((bf16_t)((wv[i >> 1] >> ((i & 1) * 16)) & 0xffff));
              KST[d * 72 + c] = f2bf(kx * __expf(BC[63 * 128 + d] - BC[c * 128 + d])); } } }
    if (tid < 128) p.DEC[((size_t)bh * 32 + n) * 128 + tid] = __expf(BC[63 * 128 + tid]);
    __syncthreads();
    const LAS unsigned char* VTb = lds + GL_VT; const LAS unsigned char* KSb = lds + GL_QT;
    f32x4 acc[8][2];
#pragma unroll
    for (int mb = 0; mb < 8; ++mb) { acc[mb][0] = (f32x4){0.f, 0.f, 0.f, 0.f}; acc[mb][1] = (f32x4){0.f, 0.f, 0.f, 0.f}; }
#pragma unroll
    for (int ks = 0; ks < 2; ++ks) { bf16x8_t vb[2];
#pragma unroll
        for (int nb = 0; nb < 2; ++nb) vb[nb] = *(const LAS bf16x8_t*)(VTb + (32 * wave + 16 * nb + fr) * 144 + (32 * ks + 8 * fg) * 2);
#pragma unroll
        for (int mb = 0; mb < 8; ++mb) { const bf16x8_t ka = *(const LAS bf16x8_t*)(KSb + (16 * mb + fr) * 144 + (32 * ks + 8 * fg) * 2);
            acc[mb][0] = __builtin_amdgcn_mfma_f32_16x16x32_bf16(ka, vb[0], acc[mb][0], 0, 0, 0); acc[mb][1] = __builtin_amdgcn_mfma_f32_16x16x32_bf16(ka, vb[1], acc[mb][1], 0, 0, 0); } }
    float* U = p.UT + ((size_t)bh * 32 + n) * 256 * 128;
#pragma unroll
    for (int nb = 0; nb < 2; ++nb) { const int e = 32 * wave + 16 * nb + fr;
#pragma unroll
        for (int mb = 0; mb < 8; ++mb) *(f32x4*)(U + (size_t)e * 128 + 16 * mb + 4 * fg) = acc[mb][nb]; }
    __syncthreads();
}
__device__ __forceinline__ void gla_pass_b(const Params& p, int bid, int G, int tid) {
    for (int idx = bid * 512 + tid; idx < 16 * 256 * 32; idx += G * 512) { const int d4 = (idx & 31) * 4, e = (idx >> 5) & 255, bh = idx >> 13;
        f32x4 S = {0.f, 0.f, 0.f, 0.f};
        const float* U = p.UT + (size_t)bh * 32 * 256 * 128 + (size_t)e * 128 + d4; const float* D = p.DEC + (size_t)bh * 32 * 128 + d4;
        bf16_t* SN = p.SNT + (size_t)bh * 32 * 256 * 128 + (size_t)e * 128 + d4;
#pragma unroll 8
        for (int n = 0; n < 32; ++n) { const f32x4 u = *(const f32x4*)(U + (size_t)n * 256 * 128); const f32x4 dc = *(const f32x4*)(D + n * 128);
            v2u w; w.x = pk2(S[0], S[1]); w.y = pk2(S[2], S[3]); *(v2u*)(SN + (size_t)n * 256 * 128) = w;
            S = dc * S + u; }
        float* so = p.out + OFF_PGLA + ((size_t)bh * 128 + d4) * 256 + e;
        so[0] = S[0]; so[256] = S[1]; so[512] = S[2]; so[768] = S[3]; }
}
__device__ __forceinline__ void gla_pass_c(const Params& p, LAS unsigned char* lds, int item, int tid) {
    const int bh = item >> 5, n = item & 31, b = bh >> 2, h = bh & 3, row0 = b * SEQ + n * 64;
    const int lane = tid & 63, wave = __builtin_amdgcn_readfirstlane(tid >> 6), fr = lane & 15, fg = lane >> 4;
    gla_gates(p, lds, row0, h, tid);
    const LAS float* BC = (const LAS float*)(lds + GL_BC);
    LAS unsigned char* QTb = lds + GL_QT; LAS unsigned char* KTb = lds + GL_KT; LAS unsigned char* AMb = lds + GL_AM; const LAS unsigned char* VTb = lds + GL_VT;
    gla_load_vt(p, lds, row0, h, tid);
    { const int d8 = (tid & 15) * 8;
#pragma unroll
      for (int q = 0; q < 2; ++q) { const int c = (tid >> 4) + 32 * q; const v4u qq = *(const v4u*)(p.GQ + (size_t)(row0 + c) * 512 + h * 128 + d8), kk = *(const v4u*)(p.GK + (size_t)(row0 + c) * 512 + h * 128 + d8);
          const unsigned qv[4] = {qq.x, qq.y, qq.z, qq.w}, kw[4] = {kk.x, kk.y, kk.z, kk.w}; unsigned qo[4], ko[4];
#pragma unroll
          for (int i = 0; i < 4; ++i) { const float b0 = BC[c * 128 + d8 + 2 * i], b1 = BC[c * 128 + d8 + 2 * i + 1]; const float e0 = __expf(b0), e1 = __expf(b1);
              qo[i] = pk2(bf2f((bf16_t)(qv[i] & 0xffff)) * e0, bf2f((bf16_t)(qv[i] >> 16)) * e1);
              ko[i] = pk2(bf2f((bf16_t)(kw[i] & 0xffff)) / e0, bf2f((bf16_t)(kw[i] >> 16)) / e1); }
          *(LAS v4u*)(QTb + c * 272 + d8 * 2) = (v4u){qo[0], qo[1], qo[2], qo[3]}; *(LAS v4u*)(KTb + c * 272 + d8 * 2) = (v4u){ko[0], ko[1], ko[2], ko[3]}; } }
    __syncthreads();
    { const int sb = wave >> 1;
#pragma unroll
      for (int u = 0; u < 2; ++u) { const int cb = 2 * (wave & 1) + u; f32x4 a = {0.f, 0.f, 0.f, 0.f};
          if (sb <= cb) {
#pragma unroll
              for (int ks = 0; ks < 4; ++ks) { const bf16x8_t ka = *(const LAS bf16x8_t*)(KTb + (16 * sb + fr) * 272 + (32 * ks + 8 * fg) * 2); const bf16x8_t qb = *(const LAS bf16x8_t*)(QTb + (16 * cb + fr) * 272 + (32 * ks + 8 * fg) * 2);
                  a = __builtin_amdgcn_mfma_f32_16x16x32_bf16(ka, qb, a, 0, 0, 0); } }
          const int c = 16 * cb + fr, s0 = 16 * sb + 4 * fg;
          v2u w; w.x = pk2(s0 <= c ? a[0] : 0.f, s0 + 1 <= c ? a[1] : 0.f); w.y = pk2(s0 + 2 <= c ? a[2] : 0.f, s0 + 3 <= c ? a[3] : 0.f);
          *(LAS v2u*)(AMb + c * 144 + s0 * 2) = w; } }
    __syncthreads();
    f32x4 acc[2][4];
#pragma unroll
    for (int eb = 0; eb < 2; ++eb)
#pragma unroll
        for (int cb = 0; cb < 4; ++cb) acc[eb][cb] = (f32x4){0.f, 0.f, 0.f, 0.f};
    const bf16_t* SN = p.SNT + ((size_t)bh * 32 + n) * 256 * 128;
#pragma unroll
    for (int ks = 0; ks < 4; ++ks) { bf16x8_t sa[2], qb[4];
#pragma unroll
        for (int eb = 0; eb < 2; ++eb) sa[eb] = *(const bf16x8_t*)(SN + (size_t)(32 * wave + 16 * eb + fr) * 128 + 32 * ks + 8 * fg);
#pragma unroll
        for (int cb = 0; cb < 4; ++cb) qb[cb] = *(const LAS bf16x8_t*)(QTb + (16 * cb + fr) * 272 + (32 * ks + 8 * fg) * 2);
#pragma unroll
        for (int eb = 0; eb < 2; ++eb)
#pragma unroll
            for (int cb = 0; cb < 4; ++cb) acc[eb][cb] = __builtin_amdgcn_mfma_f32_16x16x32_bf16(sa[eb], qb[cb], acc[eb][cb], 0, 0, 0); }
#pragma unroll
    for (int ks = 0; ks < 2; ++ks) { bf16x8_t va[2], ab[4];
#pragma unroll
        for (int eb = 0; eb < 2; ++eb) va[eb] = *(const LAS bf16x8_t*)(VTb + (32 * wave + 16 * eb + fr) * 144 + (32 * ks + 8 * fg) * 2);
#pragma unroll
        for (int cb = 0; cb < 4; ++cb) ab[cb] = *(const LAS bf16x8_t*)(AMb + (16 * cb + fr) * 144 + (32 * ks + 8 * fg) * 2);
#pragma unroll
        for (int eb = 0; eb < 2; ++eb)
#pragma unroll
            for (int cb = 0; cb < 4; ++cb) acc[eb][cb] = __builtin_amdgcn_mfma_f32_16x16x32_bf16(va[eb], ab[cb], acc[eb][cb], 0, 0, 0); }
    LAS float* SSQ = (LAS float*)(lds + GL_SSQ);
#pragma unroll
    for (int cb = 0; cb < 4; ++cb) { float s = 0.f;
#pragma unroll
        for (int eb = 0; eb < 2; ++eb) s += (acc[eb][cb][0] * acc[eb][cb][0] + acc[eb][cb][1] * acc[eb][cb][1]) + (acc[eb][cb][2] * acc[eb][cb][2] + acc[eb][cb][3] * acc[eb][cb][3]);
        s += __shfl_xor(s, 16); s += __shfl_xor(s, 32);
        if (fg == 0) SSQ[wave * 64 + 16 * cb + fr] = s; }
    __syncthreads();
#pragma unroll
    for (int cb = 0; cb < 4; ++cb) { const int c = 16 * cb + fr; float s = 0.f;
#pragma unroll
        for (int w = 0; w < 8; ++w) s += SSQ[w * 64 + c];
        const float rs = rsqrtf(s * (1.f / 256.f) + EPS);
#pragma unroll
        for (int eb = 0; eb < 2; ++eb) { const int e = 32 * wave + 16 * eb + 4 * fg; const f32x4 gn = *(const f32x4*)(p.gnorm + e);
            const v2u rr = *(const v2u*)(p.GR + (size_t)(row0 + c) * 1024 + h * 256 + e);
            const float o0 = acc[eb][cb][0] * rs * gn[0] * bf2f((bf16_t)(rr.x & 0xffff)), o1 = acc[eb][cb][1] * rs * gn[1] * bf2f((bf16_t)(rr.x >> 16));
            const float o2 = acc[eb][cb][2] * rs * gn[2] * bf2f((bf16_t)(rr.y & 0xffff)), o3 = acc[eb][cb][3] * rs * gn[3] * bf2f((bf16_t)(rr.y >> 16));
            v2u w; w.x = pk2(o0, o1); w.y = pk2(o2, o3); *(v2u*)(p.OB + (size_t)(row0 + c) * 1024 + h * 256 + e) = w; } }
    __syncthreads();
}
__device__ __forceinline__ void gla_sample_item(const Params& p, LAS unsigned char* lds, int item, int tid) {
    const int b = item >> 2, h = item & 3, e = tid & 255, half = tid >> 8, row = NPT + b;
    LAS float* a_s = (LAS float*)lds; LAS float* q_s = a_s + 128; LAS float* k_s = q_s + 128; LAS float* part = k_s + 128; LAS float* red = part + 512;
    if (tid < 128) { float x = p.b_a[h * 128 + tid];
        for (int r = 0; r < 16; ++r) x += p.LR[(size_t)row * 16 + r] * p.w_a2[r * 512 + h * 128 + tid];
        a_s[tid] = __expf(logsigmoidf_(x) * (1.f / 16.f)); q_s[tid] = bf2f(p.GQ[(size_t)row * 512 + h * 128 + tid]); k_s[tid] = bf2f(p.GK[(size_t)row * 512 + h * 128 + tid]); }
    const float v = bf2f(p.GV[(size_t)row * 1024 + h * 256 + e]);
    __syncthreads();
    float po = 0.f; const float* s0 = p.state + (((size_t)b * 4 + h) * 128 + half * 64) * 256 + e; float* so = p.out + OFF_SGLA + (((size_t)b * 4 + h) * 128 + half * 64) * 256 + e;
#pragma unroll 8
    for (int dd = 0; dd < 64; ++dd) { const int d = half * 64 + dd; const float s = a_s[d] * s0[(size_t)dd * 256] + k_s[d] * v; so[(size_t)dd * 256] = s; po += q_s[d] * s; }
    part[half * 256 + e] = po;
    __syncthreads();
    float o = 0.f;
    if (tid < 256) { o = part[e] + part[256 + e]; const float ss = wave_sum(o * o); if ((tid & 63) == 0) red[tid >> 6] = ss; }
    __syncthreads();
    if (tid < 256) { const float ss = (red[0] + red[1]) + (red[2] + red[3]); const float r = rsqrtf(ss * (1.f / 256.f) + EPS);
        p.OB[(size_t)row * 1024 + h * 256 + e] = f2bf(o * r * p.gnorm[e] * bf2f(p.GR[(size_t)row * 1024 + h * 256 + e])); }
    __syncthreads();
}

typedef float f32x16 __attribute__((ext_vector_type(16)));
typedef float f32x2_t __attribute__((ext_vector_type(2)));
typedef __bf16 bf16x2_t __attribute__((ext_vector_type(2)));
__device__ __forceinline__ unsigned cvtpk(float lo, float hi) { f32x2_t v = {lo, hi}; bf16x2_t b = __builtin_convertvector(v, bf16x2_t); return __builtin_bit_cast(unsigned, b); }
constexpr int NS_STAGE = 17920, NS_KOFF = 0, NS_VOFF = 9216, NS_PCS = 35840, NS_SC = NS_PCS + 32768, NS_OUT = NS_PCS  , NS_SEL = NS_OUT + 256 * 272, NS_END = NS_SEL + 256;
static_assert(NS_END <= 131072, "nsa lds");
constexpr float LOG2E = 1.4426950408889634f, NEGBIG = -1e30f;
__device__ __forceinline__ int crow(int r, int hh) { return (r & 3) + 8 * (r >> 2) + 4 * hh; }

__device__ __forceinline__ void nsa_vt_tile(const Params& p, LAS unsigned char* scr  , int item, int lane) {
    const int tt = item & 31, bg = (item >> 5) & 15, which = item >> 9, b = bg >> 2, g = bg & 3;
    const bf16_t* src = p.KV6 + (size_t)(b * SEQ + tt * 64) * 1536 + (which ? 5 : 3) * 256 + g * 64;
    LAS bf16_t* TT = (LAS bf16_t*)scr;
    const int ch = lane & 7, r0 = lane >> 3;
#pragma unroll
    for (int q = 0; q < 8; ++q) { const int c = r0 + 8 * q; const v4u v = *(const v4u*)(src + (size_t)c * 1536 + ch * 8); const unsigned wv[4] = {v.x, v.y, v.z, v.w};
#pragma unroll
        for (int i = 0; i < 8; ++i) TT[(ch * 8 + i) * 72 + c] = (bf16_t)((wv[i >> 1] >> ((i & 1) * 16)) & 0xffff); }
    LDS_WAIT(); asm volatile("" ::: "memory");
    bf16_t* dst = (which ? p.VTW : p.VTS) + (size_t)bg * 64 * SEQ + tt * 64;
#pragma unroll
    for (int q = 0; q < 8; ++q) { const int d = r0 + 8 * q; const v4u v = *(const LAS v4u*)((LAS unsigned char*)scr + d * 144 + ch * 16); *(v4u*)(dst + (size_t)d * SEQ + ch * 8) = v; }
    LDS_WAIT(); asm volatile("" ::: "memory");
}

struct NsaState { float m, l; f32x16 o0, o1; };
template <int MODE  >
__device__ __forceinline__ void nsa_tile(const LAS unsigned char* st, const bf16x8_t (&q)[4], NsaState& s, int lo, int hi, int r32, int hh, LAS float* pcs = nullptr, int kbase = 0) {
    f32x16 s0 = {}, s1 = {};
    const LAS unsigned char* kb = st + NS_KOFF + r32 * 144 + hh * 16;
#pragma unroll
    for (int ks = 0; ks < 4; ++ks) { const bf16x8_t a0 = *(const LAS bf16x8_t*)(kb + ks * 32), a1 = *(const LAS bf16x8_t*)(kb + 32 * 144 + ks * 32);
        s0 = __builtin_amdgcn_mfma_f32_32x32x16_bf16(a0, q[ks], s0, 0, 0, 0); s1 = __builtin_amdgcn_mfma_f32_32x32x16_bf16(a1, q[ks], s1, 0, 0, 0); }
    const bool nomask = __all(lo <= 0 && hi >= 63);
    float tmax = NEGBIG;
    if (nomask) {
#pragma unroll
        for (int r = 0; r < 16; ++r) tmax = fmaxf(tmax, fmaxf(s0[r], s1[r]));
    } else {
#pragma unroll
        for (int r = 0; r < 16; ++r) { const int k0 = crow(r, hh), k1 = k0 + 32; if (!(k0 >= lo && k0 <= hi)) s0[r] = NEGBIG; if (!(k1 >= lo && k1 <= hi)) s1[r] = NEGBIG; tmax = fmaxf(tmax, fmaxf(s0[r], s1[r])); }
    }
    __builtin_amdgcn_sched_barrier(0);
    if (MODE == 2) {
        const float mL = s.m * LOG2E, inv = s.l;
#pragma unroll
        for (int r = 0; r < 16; ++r) { float p0 = __builtin_amdgcn_exp2f(s0[r] * LOG2E - mL) * inv, p1 = __builtin_amdgcn_exp2f(s1[r] * LOG2E - mL) * inv;
            if (!nomask) { if (s0[r] == NEGBIG) p0 = 0.f; if (s1[r] == NEGBIG) p1 = 0.f; }
            s0[r] = p0; s1[r] = p1; }
        if (pcs) {
#pragma unroll
            for (int r = 0; r < 16; ++r) { float v0 = s0[r], v1 = s1[r]; v0 += __shfl_xor(v0, 8); v1 += __shfl_xor(v1, 8); v0 += __shfl_xor(v0, 16); v1 += __shfl_xor(v1, 16);
                if ((r32 >> 3) == 0) { pcs[kbase + crow(r, hh)] = v0; pcs[kbase + 32 + crow(r, hh)] = v1; } } }
    } else {
        tmax = fmaxf(tmax, __shfl_xor(tmax, 32));
        const float mn = fmaxf(s.m, tmax), alpha = __builtin_amdgcn_exp2f((s.m - mn) * LOG2E), mL = mn * LOG2E;
        s.m = mn;
        float ps = 0.f;
#pragma unroll
        for (int r = 0; r < 16; ++r) { float p0 = __builtin_amdgcn_exp2f(s0[r] * LOG2E - mL), p1 = __builtin_amdgcn_exp2f(s1[r] * LOG2E - mL);
            if (!nomask) { if (s0[r] == NEGBIG) p0 = 0.f; if (s1[r] == NEGBIG) p1 = 0.f; }
            s0[r] = p0; s1[r] = p1; ps += p0 + p1; }
        s.l = s.l * alpha + ps;
        if (MODE == 1) return;
#pragma unroll
        for (int r = 0; r < 16; ++r) { s.o0[r] *= alpha; s.o1[r] *= alpha; }
    }
    __builtin_amdgcn_sched_barrier(0);
    const LAS unsigned char* vb = st + NS_VOFF + r32 * 136 + hh * 8;
#pragma unroll
    for (int blk = 0; blk < 2; ++blk)
#pragma unroll
        for (int sp = 0; sp < 2; ++sp) { const f32x16& pp = blk ? s1 : s0; const int rb = 8 * sp;
            v4u pw; pw.x = cvtpk(pp[rb + 0], pp[rb + 1]); pw.y = cvtpk(pp[rb + 2], pp[rb + 3]); pw.z = cvtpk(pp[rb + 4], pp[rb + 5]); pw.w = cvtpk(pp[rb + 6], pp[rb + 7]);
            const bf16x8_t pf = __builtin_bit_cast(bf16x8_t, pw);
            const int ko = (32 * blk + 16 * sp) * 2;
            const v2u a0l = *(const LAS v2u*)(vb + ko), a0h = *(const LAS v2u*)(vb + ko + 16), a1l = *(const LAS v2u*)(vb + 32 * 136 + ko), a1h = *(const LAS v2u*)(vb + 32 * 136 + ko + 16);
            const bf16x8_t v0 = __builtin_bit_cast(bf16x8_t, (v4u){a0l.x, a0l.y, a0h.x, a0h.y}), v1 = __builtin_bit_cast(bf16x8_t, (v4u){a1l.x, a1l.y, a1h.x, a1h.y});
            s.o0 = __builtin_amdgcn_mfma_f32_32x32x16_bf16(v0, pf, s.o0, 0, 0, 0); s.o1 = __builtin_amdgcn_mfma_f32_32x32x16_bf16(v1, pf, s.o1, 0, 0, 0); }
}
template <bool FIRST>
__device__ __forceinline__ void nsa_finish(NsaState& s, float gate, LAS float* outp) {
    const float lt = s.l + __shfl_xor(s.l, 32); const float sc = lt > 0.f ? gate / lt : 0.f;
#pragma unroll
    for (int k = 0; k < 4; ++k) { f32x4 a = {s.o0[4 * k], s.o0[4 * k + 1], s.o0[4 * k + 2], s.o0[4 * k + 3]}, c = {s.o1[4 * k], s.o1[4 * k + 1], s.o1[4 * k + 2], s.o1[4 * k + 3]};
        a = a * sc; c = c * sc;
        if (!FIRST) { a = a + *(const LAS f32x4*)(outp + 8 * k); c = c + *(const LAS f32x4*)(outp + 32 + 8 * k); }
        *(LAS f32x4*)(outp + 8 * k) = a; *(LAS f32x4*)(outp + 32 + 8 * k) = c; }
    s.m = NEGBIG; s.l = 0.f; s.o0 = (f32x16){}; s.o1 = (f32x16){};
}

__device__ __forceinline__ void nsa_prompt_item(const Params& p, LAS unsigned char* lds, int bg, int qi, int tid) {
    const int lane = tid & 63, wave = __builtin_amdgcn_readfirstlane(tid >> 6), r32 = lane & 31, hh = lane >> 5;
    const int b = bg >> 2, g = bg & 3, tl = 8 * wave + (r32 & 7), hd = r32 >> 3, t = 64 * qi + tl, row = b * SEQ + t;
    const int srow = tid >> 3, sch = tid & 7;
    v4u rk, rv;
    auto issue = [&](const bf16_t* kbase, size_t kstride, const bf16_t* vbase, size_t vstride) { rk = *(const v4u*)(kbase + (size_t)srow * kstride + sch * 8); rv = *(const v4u*)(vbase + (size_t)srow * vstride + sch * 8); };
    auto commit = [&](int s) { LAS unsigned char* st = lds + s * NS_STAGE; *(LAS v4u*)(st + NS_KOFF + srow * 144 + sch * 16) = rk;
        *(LAS v2u*)(st + NS_VOFF + srow * 136 + sch * 16) = (v2u){rv.x, rv.y}; *(LAS v2u*)(st + NS_VOFF + srow * 136 + sch * 16 + 8) = (v2u){rv.z, rv.w}; };
    bf16x8_t q[4];
    { const bf16_t* qp = p.QN + (size_t)row * 1024 + (g * 4 + hd) * 64 + 8 * hh;
#pragma unroll
      for (int ks = 0; ks < 4; ++ks) q[ks] = *(const bf16x8_t*)(qp + 16 * ks); }
    const float g0 = p.GATE[(size_t)row * 48 + (g * 4 + hd) * 3 + 0], g1 = p.GATE[(size_t)row * 48 + (g * 4 + hd) * 3 + 1], g2 = p.GATE[(size_t)row * 48 + (g * 4 + hd) * 3 + 2];
    LAS float* outp = (LAS float*)(lds + NS_OUT) + (wave * 32 + r32) * 68 + 4 * hh;
    NsaState s; s.m = NEGBIG; s.l = 0.f; s.o0 = (f32x16){}; s.o1 = (f32x16){};
    const bf16_t* kc = p.KCMP_P + (size_t)bg * 128 * 64; const bf16_t* vct = p.VCMPT_P + (size_t)bg * 64 * 128;
    issue(kc, 64, vct, 128); commit(0); issue(kc + 64 * 64, 64, vct + 64, 128); commit(1);
    __syncthreads();
    const int limc = (t >= 31) ? ((t - 31) >> 4) : -1;
    {
        nsa_tile<1>(lds, q, s, 0, limc, r32, hh); nsa_tile<1>(lds + NS_STAGE, q, s, 0, limc - 64, r32, hh);
        const float lt = s.l + __shfl_xor(s.l, 32); s.l = lt > 0.f ? 1.f / lt : 0.f;
        LAS float* PCS = (LAS float*)(lds + NS_PCS) + tl * 128;
        nsa_tile<2>(lds, q, s, 0, limc, r32, hh, qi >= 16 ? PCS : nullptr, 0); nsa_tile<2>(lds + NS_STAGE, q, s, 0, limc - 64, r32, hh, qi >= 16 ? PCS : nullptr, 64);
        __syncthreads();
    }
    if (qi >= 16) {
        const LAS float* PCS = (const LAS float*)(lds + NS_PCS);
        LAS float* SCR = (LAS float*)(lds + NS_SC); LAS unsigned* SEL = (LAS unsigned*)(lds + NS_SEL);
        { const int tk = tid >> 3, jq = tid & 7;
#pragma unroll
          for (int u = 0; u < 4; ++u) { const int j = jq * 4 + u; float sm = 0.f;
#pragma unroll
              for (int o = 0; o < 5; ++o) { const int ki = 4 * j - 1 + o; if (ki >= 0 && ki < 127) sm += PCS[tk * 128 + ki]; }
              SCR[tk * 32 + j] = (j <= qi) ? sm + ((j == 0 || j == qi) ? 1e4f : 0.f) : NEGBIG; }
        }
        __syncthreads();
        { const int tk = tid >> 3, jq = tid & 7; unsigned bits = 0u;
#pragma unroll
          for (int u = 0; u < 4; ++u) { const int j = jq * 4 + u; const float sj = SCR[tk * 32 + j]; int rank = 0;
              for (int j2 = 0; j2 < 32; ++j2) { const float s2 = SCR[tk * 32 + j2]; rank += (s2 > sj || (s2 == sj && j2 < j)) ? 1 : 0; }
              if (rank < 16) bits |= 1u << j; }
          bits |= __shfl_xor(bits, 1); bits |= __shfl_xor(bits, 2); bits |= __shfl_xor(bits, 4);
          if (jq == 0) SEL[tk] = bits; }
        __syncthreads();
    }
    s.l = 0.5f; nsa_finish<true>(s, g0, outp);
    const unsigned selmask = (qi < 16) ? 0xffffffffu : ((LAS unsigned*)(lds + NS_SEL))[tl];
    const int wlo = qi > 8 ? qi - 8 : 0, nslc = qi + 1, nsteps = nslc + (qi - wlo + 1);
    const bf16_t* ksl = p.KV6 + (size_t)(b * SEQ) * 1536 + 2 * 256 + g * 64; const bf16_t* kwn = ksl + 2 * 256;
    const bf16_t* vsl = p.VTS + (size_t)bg * 64 * SEQ; const bf16_t* vwn = p.VTW + (size_t)bg * 64 * SEQ;
    auto issue_step = [&](int u) { if (u < nslc) issue(ksl + (size_t)(64 * u) * 1536, 1536, vsl + 64 * u, SEQ); else { const int j = wlo + (u - nslc); issue(kwn + (size_t)(64 * j) * 1536, 1536, vwn + 64 * j, SEQ); } };
    issue_step(0); commit(0); __syncthreads();
    for (int u = 0; u < nsteps; ++u) {
        if (u + 1 < nsteps) issue_step(u + 1);
        int lo = 0, hi = 63;
        if (u < nslc) { const int j = u; if (!((selmask >> j) & 1u)) hi = -1; else if (j == qi) hi = tl; }
        else { const int j = wlo + (u - nslc); if (j == qi) hi = tl; if (j == qi - 8) lo = tl; }
        if (u == nslc) nsa_finish<false>(s, g1, outp);
        nsa_tile<0>(lds + (u & 1) * NS_STAGE, q, s, lo, hi, r32, hh);
        if (u + 1 < nsteps) commit((u + 1) & 1);
        __syncthreads();
    }
    { const float lt = s.l + __shfl_xor(s.l, 32); const float sc = lt > 0.f ? g2 / lt : 0.f;
      bf16_t* op = p.OA + (size_t)row * 1024 + (g * 4 + hd) * 64 + 4 * hh;
#pragma unroll
      for (int k = 0; k < 4; ++k) { const f32x4 a = *(const LAS f32x4*)(outp + 8 * k), c = *(const LAS f32x4*)(outp + 32 + 8 * k);
          v2u w; w.x = cvtpk(a[0] + s.o0[4 * k] * sc, a[1] + s.o0[4 * k + 1] * sc); w.y = cvtpk(a[2] + s.o0[4 * k + 2] * sc, a[3] + s.o0[4 * k + 3] * sc); *(v2u*)(op + 8 * k) = w;
          v2u w1; w1.x = cvtpk(c[0] + s.o1[4 * k] * sc, c[1] + s.o1[4 * k + 1] * sc); w1.y = cvtpk(c[2] + s.o1[4 * k + 2] * sc, c[3] + s.o1[4 * k + 3] * sc); *(v2u*)(op + 32 + 8 * k) = w1; } }
}

__device__ __forceinline__ void nsa_sample_pair(const Params& p, LAS unsigned char* lds, int pair, int tid) {
    const int vb = tid >> 8, item = pair * 2 + vb, row = NPT + (item >> 2), g = item & 3;
    float* base = (float*)(LAS float*)(lds + vb * 32768);
    float (*q)[64] = (float (*)[64])base; float (*sc)[1088] = (float (*)[1088])(base + 256); float (*oacc)[64] = (float (*)[64])(base + 256 + 4352);
    float* gate3 = base + 256 + 4352 + 256; float* score = gate3 + 16; int* selidx = (int*)(score + 272);
    nsa_naive_body(p, row, g, tid & 255, q, sc, oacc, gate3, score, selidx);
}

#define XB_TMO      128
#define XB_XCNT(j)  (256  + 64 * (j))
#define XB_XSUB(j)  (1280 + 64 * (j))
#define XB_XGEN(j)  (2304 + 64 * (j))
#define XB_TOP      3328
#define XB_TOPGEN   3392
#define XCD_BAR_WORDS 3456
#define XB_SPIN_CAP (1u << 22)

__device__ __forceinline__ unsigned xb_ld(unsigned* p)              { return __hip_atomic_load(p, __ATOMIC_RELAXED, __HIP_MEMORY_SCOPE_AGENT); }
__device__ __forceinline__ unsigned xb_add(unsigned* p, unsigned v) { return __hip_atomic_fetch_add(p, v, __ATOMIC_RELAXED, __HIP_MEMORY_SCOPE_AGENT); }
__device__ __forceinline__ unsigned xb_xcc_id() { return (unsigned)__builtin_amdgcn_s_getreg((3 << 11) | 20) & 0xFu; }
#define XB_SPIN(cond, bar) do { unsigned _sp = 0; while (cond) { __builtin_amdgcn_s_sleep(1); \
    if ((++_sp & 255u) == 0u) { if (xb_ld(&(bar)[XB_TMO])) break; if (_sp > XB_SPIN_CAP) { atomicAdd(&(bar)[XB_TMO], 1u); break; } } } } while (0)

struct XcdBarrier {
    unsigned* bar; unsigned x;
    volatile LAS unsigned* st;
};

__device__ __forceinline__ XcdBarrier xcd_barrier_post(unsigned* bar, volatile LAS unsigned* st) {
    XcdBarrier b; b.bar = bar; b.x = xb_xcc_id(); b.st = st;
    if (threadIdx.x == 0) (void)xb_add(&bar[XB_XCNT(b.x)], 1u);
    return b;
}
__device__ __forceinline__ void xcd_barrier_complete(unsigned* bar, unsigned x, unsigned& nloc, unsigned& nx) {
    const unsigned G = gridDim.x * gridDim.y * gridDim.z;
    unsigned sum, cnt, mine, sp = 0u;
    for (;;) {
        sum = 0u; cnt = 0u; mine = 0u;
#pragma unroll
        for (unsigned j = 0; j < 16; ++j) { const unsigned c = xb_ld(&bar[XB_XCNT(j)]); sum += c; cnt += (c > 0u) ? 1u : 0u; mine = (j == x) ? c : mine; }
        if (sum == G) break;
        __builtin_amdgcn_s_sleep(1);
        if ((++sp & 255u) == 0u) { if (xb_ld(&bar[XB_TMO])) break; if (sp > XB_SPIN_CAP) { atomicAdd(&bar[XB_TMO], 1u); break; } }
    }
    nloc = mine > 0u ? mine : 1u; nx = cnt > 0u ? cnt : 1u;
}

__device__ __forceinline__ void xcd_barrier(const XcdBarrier& b) {
    asm volatile("s_waitcnt vmcnt(0)" ::: "memory");
    __syncthreads();
    if (threadIdx.x == 0) {
        unsigned* bar = b.bar;
        __builtin_amdgcn_s_waitcnt(0);
        unsigned nloc = b.st[0], nx = b.st[1];
        if (nloc == 0u) { xcd_barrier_complete(bar, b.x, nloc, nx); b.st[0] = nloc; b.st[1] = nx; }
        const unsigned old = xb_add(&bar[XB_XSUB(b.x)], 1u);
        const unsigned gen = old / nloc;
        if (old + 1u == (gen + 1u) * nloc) {
            __builtin_amdgcn_fence(__ATOMIC_RELEASE, "agent");
            asm volatile("s_waitcnt vmcnt(0)" ::: "memory");
            const unsigned og = xb_add(&bar[XB_TOP], 1u);
            const unsigned tg = og / nx;
            if (og + 1u == (tg + 1u) * nx) xb_add(&bar[XB_TOPGEN], 1u);
            else XB_SPIN(xb_ld(&bar[XB_TOPGEN]) == tg, bar);
            __builtin_amdgcn_fence(__ATOMIC_ACQUIRE, "agent");
            xb_add(&bar[XB_XGEN(b.x)], 1u);
            asm volatile("s_waitcnt vmcnt(0)" ::: "memory");
        } else {
            XB_SPIN(xb_ld(&bar[XB_XGEN(b.x)]) == gen, bar);
            __builtin_amdgcn_fence(__ATOMIC_ACQUIRE, "agent");
            asm volatile("s_waitcnt vmcnt(0)" ::: "memory");
        }
    }
    __syncthreads();
}

constexpr int LDS_BYTES = 147456;
constexpr int LDSCTL_OFF = 131072, MISC_OFF = LDSCTL_OFF + 320;
constexpr int CW_BAR = 4096;
enum Phase { PH_PRO0 = 0, PH_PRO = 1, PH_IN = 2, PH_MID = 3, PH_ATT = 4, PH_BRA = 5, PH_BRB = 6, PH_WO = 7, PH_UP = 8, PH_DOWN = 9, PH_NORM = 10, PH_END = 11 };
__global__ void __launch_bounds__(512, 2) mk_fwd(Params p, int ph_lo, int ph_hi, int li) {
    extern __shared__ __attribute__((aligned(16))) unsigned char lds_raw[];
    LAS unsigned char* lds = (LAS unsigned char*)lds_raw;
    const int tid = threadIdx.x, bid = blockIdx.x, G = gridDim.x;
    for (int u = tid; u < (LDS_BYTES - LDSCTL_OFF) / 4; u += 512) ((LAS unsigned*)(lds + LDSCTL_OFF))[u] = 0u;
    __syncthreads();
    XcdBarrier bar; bar.bar = p.CTL + CW_BAR + li * XCD_BAR_WORDS; bar.x = 0; bar.st = nullptr;
    if (ph_hi - ph_lo > 1) bar = xcd_barrier_post(p.CTL + CW_BAR + li * XCD_BAR_WORDS, (volatile LAS unsigned*)(lds + MISC_OFF) + 8);
#define IN(k) (ph_lo <= (k) && (k) < ph_hi)
#define SEAM(k) do { if (ph_lo <= (k) && (k) + 1 < ph_hi) xcd_barrier(bar); } while (0)
    if (IN(PH_PRO0)) { ph_pro0(p, lds, bid, G, tid); SEAM(PH_PRO0); }
    if (IN(PH_PRO)) { for (int t = bid; t < 512; t += G) cmp_gemm_tile<true>(p, lds, t, tid);
        __syncthreads(); ph_prologue(p, lds, bid, G, tid); SEAM(PH_PRO); }
    if (IN(PH_IN)) { { pg8::Gemm g{p.XB, p.WIN_T, NPT, NIN_PAD, DM}; pg8::StaticOrder S; S.init(NPT, NIN_PAD, G, bid);
          EpiProj E{p.RSTD1, p.b_gate, p.QN, p.KV6, p.GQ, p.GK, p.GV, p.GR, p.BR, p.GATE, p.LR, p.out};
          pg8::gemm_phase<EpiProj, pg8::StaticOrder, true, true>(lds, g, S, E); }
        skinny_gemm(lds, p.XB + (size_t)NPT * DM, DM, p.WIN_T, NIN_PAD, DM, F_proj_s{p}, bid, G, tid); SEAM(PH_IN); }
    if (IN(PH_MID)) {
        for (int t = bid; t < 32; t += G) { cmp_gemm_tile<false>(p, lds, t, tid); __builtin_amdgcn_fence(__ATOMIC_RELEASE, "workgroup"); VM_WAIT(); __syncthreads(); cmp_part2<false>(p, lds, t >> 4, t & 15, 0, tid); }
        for (int it = bid; it < 512; it += G) cmp_part2<true>(p, lds, it >> 8, (it >> 3) & 31, (it & 7) * 128, tid);
        for (int it = bid; it < 512; it += G) gla_pass_a(p, lds, it, tid);
        for (int it = bid; it < 32; it += G) gla_sample_item(p, lds, it, tid);
        { const int wave = tid >> 6; for (int it = bid * 8 + wave; it < 1024; it += G * 8) nsa_vt_tile(p, lds + wave * 16384, it, tid & 63); }
        SEAM(PH_MID); }
    if (IN(PH_ATT)) {
        for (int it = bid; it < 256; it += G) { const int bg = it & 15, sq = it >> 4;
#pragma unroll 1
            for (int k = 0; k < 2; ++k) { nsa_prompt_item(p, lds, bg, k ? sq : 31 - sq, tid); __syncthreads(); } }
        gla_pass_b(p, bid, G, tid);
        for (int pr = bid; pr < 16; pr += G) nsa_sample_pair(p, lds, pr, tid);
        SEAM(PH_ATT); }
    if (IN(PH_BRA)) { for (int it = bid; it < 512; it += G) gla_pass_c(p, lds, it, tid);
        const F_bra f{p.BR, p.TMP};
        { pg8::Gemm g{p.OA, p.WBRA_T, NPT, DM, 1024}; pg8::StaticOrder S; S.init(NPT, DM, G, bid); EpiGen<F_bra> E{f}; pg8::gemm_phase<EpiGen<F_bra>, pg8::StaticOrder, true, true>(lds, g, S, E); }
        skinny_gemm(lds, p.OA + (size_t)NPT * 1024, 1024, p.WBRA_T, DM, 1024, f, bid, G, tid); SEAM(PH_BRA); }
    if (IN(PH_BRB)) { const F_brb f{p.BR, p.TMP, p.MB};
        { pg8::Gemm g{p.OB, p.WBRB_T, NPT, DM, 1024}; pg8::StaticOrder S; S.init(NPT, DM, G, bid); EpiGen<F_brb> E{f}; pg8::gemm_phase<EpiGen<F_brb>, pg8::StaticOrder, true, true>(lds, g, S, E); }
        skinny_gemm(lds, p.OB + (size_t)NPT * 1024, 1024, p.WBRB_T, DM, 1024, f, bid, G, tid); SEAM(PH_BRB); }
    if (IN(PH_WO)) {
        { const F_wo f{p.x_prompt, p.X1, p.X1B, p.SUMSQ2}; pg8::Gemm g{p.MB, p.WO_T, NPT, DM, DM}; pg8::StaticOrder S; S.init(NPT, DM, G, bid); EpiGen<F_wo> E{f}; pg8::gemm_phase<EpiGen<F_wo>, pg8::StaticOrder, true, true>(lds, g, S, E); }
        { const F_wo f{p.x_sample - (size_t)NPT * DM, p.X1, p.X1B, p.SUMSQ2}; skinny_gemm(lds, p.MB + (size_t)NPT * DM, DM, p.WO_T, DM, DM, f, bid, G, tid); } SEAM(PH_WO); }
    if (IN(PH_UP)) { const F_up f{p.SUMSQ2, p.HF};
        { pg8::Gemm g{p.X1B, p.WUP_T, NPT, DFF, DM}; pg8::StaticOrder S; S.init(NPT, DFF, G, bid); EpiGen<F_up> E{f}; pg8::gemm_phase<EpiGen<F_up>, pg8::StaticOrder, true, true>(lds, g, S, E); }
        skinny_gemm(lds, p.X1B + (size_t)NPT * DM, DM, p.WUP_T, DFF, DM, f, bid, G, tid); SEAM(PH_UP); }
    if (IN(PH_DOWN)) {
        { const F_down f{p.X1, p.out + OFF_Y, p.SUMSQ3}; pg8::Gemm g{p.HF, p.WDN_T, NPT, DM, DFF}; pg8::StaticOrder S; S.init(NPT, DM, G, bid); EpiGen<F_down> E{f}; pg8::gemm_phase<EpiGen<F_down>, pg8::StaticOrder, true, true>(lds, g, S, E); }
        { const F_down f{p.X1, p.out + OFF_YS - (size_t)NPT * DM, p.SUMSQ3}; skinny_gemm(lds, p.HF + (size_t)NPT * DFF, DFF, p.WDN_T, DM, DFF, f, bid, G, tid); } SEAM(PH_DOWN); }
    if (IN(PH_NORM)) ph_final_norm(p, bid, G, tid);
#undef IN
#undef SEAM
}
__global__ void __launch_bounds__(256) k_sumsq_rows(const float* X, size_t ld, float* ss_out, int nrows) {
    const int lane = threadIdx.x & 63, row = blockIdx.x * 4 + (threadIdx.x >> 6);
    if (row >= nrows) return;
    float ss = 0.f;
    for (int i = lane; i < DM; i += 64) { const float v = X[(size_t)row * ld + i]; ss += v * v; }
    ss = wave_sum(ss);
    if (lane == 0) ss_out[row] = ss;
}
struct EF_up2 { Params p; __device__ void operator()(int r, int n, float acc) const { const float v = fmaxf(acc * rsqrtf(p.SUMSQ2[r] * (1.f / DM) + EPS), 0.f); p.HF[(size_t)r * DFF + n] = f2bf(v * v); } };

static inline size_t align_up(size_t x) { return (x + 255) & ~(size_t)255; }

extern "C" void kernel_launch(void* const* d_in, const int* in_sizes, int n_in, void* d_out, int out_size, void* d_ws, size_t ws_size, hipStream_t stream) {
    if (n_in != 29 || out_size != (int)OUT_TOTAL) { fprintf(stderr, "kernel_launch: unexpected n_in %d / out_size %d\n", n_in, out_size); return; }
    static int grid = 0;
    if (grid == 0) {
        int dev = 0, cus = 0, per_cu = 0;
        if (hipGetDevice(&dev) != hipSuccess || hipDeviceGetAttribute(&cus, hipDeviceAttributeMultiprocessorCount, dev) != hipSuccess) { fprintf(stderr, "kernel_launch: device query failed\n"); grid = -1; return; }
        if (hipFuncSetAttribute((const void*)mk_fwd, hipFuncAttributeMaxDynamicSharedMemorySize, LDS_BYTES) != hipSuccess) { fprintf(stderr, "kernel_launch: hipFuncSetAttribute failed\n"); grid = -1; return; }
        if (hipOccupancyMaxActiveBlocksPerMultiprocessor(&per_cu, (const void*)mk_fwd, 512, LDS_BYTES) != hipSuccess || per_cu < 1) { fprintf(stderr, "kernel_launch: occupancy query says %d\n", per_cu); per_cu = 1; }
        (void)hipGetLastError();
        grid = cus;
    }
    if (grid < 0) return;
    Params p{};
    p.x_prompt = (const float*)d_in[0]; p.x_sample = (const float*)d_in[1]; p.cck = (const float*)d_in[2]; p.ccv = (const float*)d_in[3];
    p.csk = (const float*)d_in[4]; p.csv = (const float*)d_in[5]; p.cwk = (const float*)d_in[6]; p.cwv = (const float*)d_in[7]; p.state = (const float*)d_in[8];
    p.page_table = (const int*)d_in[9]; p.norm1_g = (const float*)d_in[10]; p.w_in = (const float*)d_in[11]; p.b_gate = (const float*)d_in[12];
    p.pe_k = (const float*)d_in[13]; p.pe_v = (const float*)d_in[14]; p.w1k = (const float*)d_in[15]; p.w2k = (const float*)d_in[16]; p.w1v = (const float*)d_in[17]; p.w2v = (const float*)d_in[18];
    p.w_a2 = (const float*)d_in[19]; p.b_a = (const float*)d_in[20]; p.gnorm = (const float*)d_in[21]; p.w_br_a = (const float*)d_in[22]; p.w_br_b = (const float*)d_in[23];
    p.w_o = (const float*)d_in[24]; p.norm2_g = (const float*)d_in[25]; p.w_up = (const float*)d_in[26]; p.w_down = (const float*)d_in[27]; p.norm_f = (const float*)d_in[28];
    p.out = (float*)d_out;
    char* ws = (char*)d_ws; size_t off = 0;
    auto take = [&](size_t bytes) { char* r = ws + off; off = align_up(off + bytes); return r; };
    p.CTL = (unsigned*)take(1 << 20);
    p.XB = (bf16_t*)take((size_t)NTOK * DM * 2); p.RSTD1 = (float*)take(NTOK * 4); p.QN = (bf16_t*)take((size_t)NTOK * 1024 * 2); p.KV6 = (bf16_t*)take((size_t)NTOK * 1536 * 2);
    p.GATE = (float*)take((size_t)NTOK * 48 * 4); p.GQ = (bf16_t*)take((size_t)NTOK * 512 * 2); p.GK = (bf16_t*)take((size_t)NTOK * 512 * 2); p.GV = (bf16_t*)take((size_t)NTOK * 1024 * 2);
    p.GR = (bf16_t*)take((size_t)NTOK * 1024 * 2); p.LR = (float*)take((size_t)NTOK * 16 * 4); p.BR = (bf16_t*)take((size_t)NTOK * 4096 * 2);
    p.KCMP_P = (bf16_t*)take(16 * 128 * 64 * 2); p.VCMPT_P = (bf16_t*)take(16 * 128 * 64 * 2); p.KCMP_S = (bf16_t*)take(32 * 1024 * 64 * 2); p.VCMP_S = (bf16_t*)take(32 * 1024 * 64 * 2);
    p.OA = (bf16_t*)take((size_t)NTOK * 1024 * 2); p.OB = (bf16_t*)take((size_t)NTOK * 1024 * 2); p.TMP = (float*)take((size_t)NTOK * DM * 4); p.MB = (bf16_t*)take((size_t)NTOK * DM * 2);
    p.X1 = (float*)take((size_t)NTOK * DM * 4); p.X1B = (bf16_t*)take((size_t)NTOK * DM * 2); p.RSTD2 = (float*)take(NTOK * 4); p.HF = (bf16_t*)take((size_t)NTOK * DFF * 2);
    p.WIN_T = (bf16_t*)take((size_t)NIN_PAD * DM * 2); p.WBRA_T = (bf16_t*)take((size_t)DM * 1024 * 2); p.WBRB_T = (bf16_t*)take((size_t)DM * 1024 * 2); p.WO_T = (bf16_t*)take((size_t)DM * DM * 2);
    p.WUP_T = (bf16_t*)take((size_t)DFF * DM * 2); p.WDN_T = (bf16_t*)take((size_t)DM * DFF * 2); p.SUMSQ2 = (float*)take(NTOK * 4); p.SUMSQ3 = (float*)take(NTOK * 4);
    p.W1T = (bf16_t*)take(2 * 256 * 1024 * 2); p.BIAS1 = (float*)take(256 * 4); p.AB_S = (float*)take((size_t)2 * 32768 * 256 * 4); p.AB_P = (float*)take((size_t)2 * 2048 * 256 * 4);
    p.UT = (float*)take((size_t)512 * 256 * 128 * 4); p.DEC = (float*)take(512 * 128 * 4); p.SNT = (bf16_t*)take((size_t)512 * 256 * 128 * 2);
    p.VTS = (bf16_t*)take((size_t)16 * 64 * SEQ * 2); p.VTW = (bf16_t*)take((size_t)16 * 64 * SEQ * 2);
    if (off > ws_size) { fprintf(stderr, "kernel_launch: workspace too small: need %zu have %zu\n", off, ws_size); return; }
    hipMemsetAsync(p.CTL, 0, 1 << 20, stream);
#define MK(lo, hi, li) hipLaunchKernelGGL(mk_fwd, dim3(grid), dim3(512), LDS_BYTES, stream, p, (int)(lo), (int)(hi), (int)(li))
    MK(PH_PRO0, PH_END, 0);
}
```

```cpp
#include <hip/hip_runtime.h>
#include <stdint.h>
#include <cstdio>

typedef unsigned short bf16_t;

constexpr int DM = 2048, NB = 4, SEQ = 2048, NPT = NB * SEQ, DB = 8, NTOK = NPT + DB;
constexpr int PAST = 16384, PAGE = 128, NPAGES = 128;
constexpr int NG = 4, HPG = 4, DH = 64;
constexpr int DIN = 9792, DFF = 8192;
constexpr int C_Q = 0, C_KV = 1024, C_G = 2560, C_QL = 2608, C_KL = 3120, C_VL = 3632, C_RL = 4656, C_LR = 5680, C_BR = 5696;
constexpr float EPS = 1e-6f;
constexpr size_t OFF_Y = 0, OFF_YS = (size_t)NPT * DM, OFF_PCK = OFF_YS + (size_t)DB * DM;
constexpr size_t SZ_PROW = (size_t)NPT * 256;
constexpr size_t OFF_PWK = OFF_PCK + 4 * SZ_PROW, SZ_PWIN = (size_t)NB * 512 * 256;
constexpr size_t OFF_PGLA = OFF_PWK + 2 * SZ_PWIN, SZ_PGLA = (size_t)NB * 4 * 128 * 256;
constexpr size_t OFF_SCK = OFF_PGLA + SZ_PGLA, SZ_SROW = (size_t)DB * 256;
constexpr size_t OFF_SWK = OFF_SCK + 4 * SZ_SROW, SZ_SWIN = (size_t)DB * 512 * 256;
constexpr size_t OFF_SGLA = OFF_SWK + 2 * SZ_SWIN, SZ_SGLA = (size_t)DB * 4 * 128 * 256;
constexpr size_t OUT_TOTAL = OFF_SGLA + SZ_SGLA;
static_assert(OUT_TOTAL == 29908992, "output size");

__device__ __forceinline__ bf16_t f2bf(float f) { unsigned u = __builtin_bit_cast(unsigned, f); return (bf16_t)((u + 0x7fffu + ((u >> 16) & 1u)) >> 16); }
__device__ __forceinline__ float bf2f(bf16_t h) { return __builtin_bit_cast(float, (unsigned)h << 16); }
__device__ __forceinline__ float sigmoidf_(float x) { return 1.f / (1.f + __expf(-x)); }
__device__ __forceinline__ float siluf_(float x) { return x / (1.f + __expf(-x)); }
__device__ __forceinline__ float gelu_tanh(float x) { const float u = 0.7978845608028654f * (x + 0.044715f * x * x * x); return 0.5f * x * (1.f + tanhf(u)); }
__device__ __forceinline__ float logsigmoidf_(float x) { return fminf(x, 0.f) - log1pf(__expf(-fabsf(x))); }
__device__ __forceinline__ float wave_sum(float v) {
#pragma unroll
    for (int o = 1; o < 64; o <<= 1) v += __shfl_xor(v, o);
    return v;
}
__device__ __forceinline__ float wave_max(float v) {
#pragma unroll
    for (int o = 1; o < 64; o <<= 1) v = fmaxf(v, __shfl_xor(v, o));
    return v;
}

struct Params {
    const float *x_prompt, *x_sample, *cck, *ccv, *csk, *csv, *cwk, *cwv, *state;
    const int* page_table;
    const float *norm1_g, *w_in, *b_gate, *pe_k, *pe_v, *w1k, *w2k, *w1v, *w2v, *w_a2, *b_a, *gnorm, *w_br_a, *w_br_b, *w_o, *norm2_g, *w_up, *w_down, *norm_f;
    float* out;
    bf16_t *XB, *QN, *KV6, *GQ, *GK, *GV, *GR, *BR, *KCMP_P, *VCMPT_P, *KCMP_S, *VCMP_S, *OA, *OB, *MB, *X1B, *HF;
    float *RSTD1, *GATE, *LR, *TMP, *X1, *RSTD2;
    bf16_t *WIN_T, *WBRA_T, *WBRB_T, *WO_T, *WUP_T, *WDN_T;
    float *SUMSQ2, *SUMSQ3;
    unsigned* CTL;
    bf16_t* W1T; float *BIAS1, *AB_S, *AB_P;
    float *UT, *DEC; bf16_t* SNT;
    bf16_t *VTS, *VTW;
};

__device__ __forceinline__ float xval(const Params& p, int row, int n) { return row < NPT ? p.x_prompt[(size_t)row * DM + n] : p.x_sample[(size_t)(row - NPT) * DM + n]; }

__device__ __forceinline__ void proj_store(const Params& p, int row, int n, float v) {
    if (n < C_KV) p.QN[(size_t)row * 1024 + n] = f2bf(v * 0.125f);
    else if (n < C_G) {
        const int c = n - C_KV; p.KV6[(size_t)row * 1536 + c] = f2bf(v); const int j = c >> 8, cc = c & 255;
        if (row < NPT) { const int b = row >> 11, t = row & 2047;
            if (j < 4) p.out[OFF_PCK + j * SZ_PROW + (size_t)row * 256 + cc] = v;
            else if (t >= 1536) p.out[OFF_PWK + (j - 4) * SZ_PWIN + ((size_t)b * 512 + t - 1536) * 256 + cc] = v; }
        else { const int b = row - NPT;
            if (j < 4) p.out[OFF_SCK + j * SZ_SROW + (size_t)b * 256 + cc] = v;
            else p.out[OFF_SWK + (j - 4) * SZ_SWIN + ((size_t)b * 512 + 511) * 256 + cc] = v; }
    }
    else if (n < C_QL) { const int c = n - C_G; p.GATE[(size_t)row * 48 + c] = sigmoidf_(v + p.b_gate[c]); }
    else if (n < C_KL) p.GQ[(size_t)row * 512 + (n - C_QL)] = f2bf(v * 0.08838834764831845f);
    else if (n < C_VL) p.GK[(size_t)row * 512 + (n - C_KL)] = f2bf(v);
    else if (n < C_RL) p.GV[(size_t)row * 1024 + (n - C_VL)] = f2bf(v);
    else if (n < C_LR) p.GR[(size_t)row * 1024 + (n - C_RL)] = f2bf(siluf_(v));
    else if (n < C_BR) p.LR[(size_t)row * 16 + (n - C_LR)] = v;
    else p.BR[(size_t)row * 4096 + (n - C_BR)] = f2bf(sigmoidf_(v));
}

__global__ void __launch_bounds__(256) k_prep_x(Params p) {
    const int lane = threadIdx.x & 63, row = blockIdx.x * 4 + (threadIdx.x >> 6);
    if (row >= NTOK) return;
    const float* xr = row < NPT ? p.x_prompt + (size_t)row * DM : p.x_sample + (size_t)(row - NPT) * DM;
    float ss = 0.f;
    for (int i = lane; i < DM; i += 64) { const float v = xr[i]; ss += v * v; p.XB[(size_t)row * DM + i] = f2bf(v); }
    ss = wave_sum(ss);
    if (lane == 0) p.RSTD1[row] = rsqrtf(ss * (1.f / DM) + EPS);
}
__global__ void __launch_bounds__(256) k_copy_swin(Params p) {
    const size_t i = (size_t)blockIdx.x * 256 + threadIdx.x;
    if (i >= (size_t)DB * 511 * 256) return;
    const int c = (int)(i & 255); const int r = (int)((i >> 8) % 511); const int b = (int)((i >> 8) / 511);
    p.out[OFF_SWK + ((size_t)b * 512 + r) * 256 + c] = p.cwk[((size_t)b * 512 + r + 1) * 256 + c];
    p.out[OFF_SWK + SZ_SWIN + ((size_t)b * 512 + r) * 256 + c] = p.cwv[((size_t)b * 512 + r + 1) * 256 + c];
}
__global__ void __launch_bounds__(256) k_rms_rows(const float* X, float* rstd, int nrows) {
    const int lane = threadIdx.x & 63, row = blockIdx.x * 4 + (threadIdx.x >> 6);
    if (row >= nrows) return;
    float ss = 0.f;
    for (int i = lane; i < DM; i += 64) { const float v = X[(size_t)row * DM + i]; ss += v * v; }
    ss = wave_sum(ss);
    if (lane == 0) rstd[row] = rsqrtf(ss * (1.f / DM) + EPS);
}
__global__ void __launch_bounds__(256) k_final_norm(Params p) {
    const int lane = threadIdx.x & 63, row = blockIdx.x * 4 + (threadIdx.x >> 6);
    if (row >= NTOK) return;
    float* yr = row < NPT ? p.out + OFF_Y + (size_t)row * DM : p.out + OFF_YS + (size_t)(row - NPT) * DM;
    float ss = 0.f;
    for (int i = lane; i < DM; i += 64) { const float v = yr[i]; ss += v * v; }
    ss = wave_sum(ss);
    const float r = rsqrtf(ss * (1.f / DM) + EPS);
    for (int i = lane; i < DM; i += 64) yr[i] = yr[i] * r * p.norm_f[i];
}

template <class AF, class BF, class EF>
__global__ void __launch_bounds__(256) k_gemm_naive(int m_off, int M, int N, int K, AF af, BF bf, EF ef) {
    __shared__ float As[16][68], Bs[16][68];
    const int tid = threadIdx.x, tx = tid & 15, ty = tid >> 4, m0 = m_off + blockIdx.y * 64, n0 = blockIdx.x * 64;
    float acc[4][4];
#pragma unroll
    for (int i = 0; i < 4; ++i)
#pragma unroll
        for (int j = 0; j < 4; ++j) acc[i][j] = 0.f;
    for (int k0 = 0; k0 < K; k0 += 16) {
#pragma unroll
        for (int i = 0; i < 4; ++i) { const int idx = tid + 256 * i, r = idx >> 4, kk = idx & 15; As[kk][r] = (m0 + r < M) ? af(m0 + r, k0 + kk) : 0.f; }
#pragma unroll
        for (int i = 0; i < 4; ++i) { const int idx = tid + 256 * i, kk = idx >> 6, c = idx & 63; Bs[kk][c] = (n0 + c < N) ? bf(k0 + kk, n0 + c) : 0.f; }
        __syncthreads();
#pragma unroll
        for (int kk = 0; kk < 16; ++kk) {
            float a[4], b[4];
#pragma unroll
            for (int i = 0; i < 4; ++i) { a[i] = As[kk][ty * 4 + i]; b[i] = Bs[kk][tx * 4 + i]; }
#pragma unroll
            for (int i = 0; i < 4; ++i)
#pragma unroll
                for (int j = 0; j < 4; ++j) acc[i][j] += a[i] * b[j];
        }
        __syncthreads();
    }
#pragma unroll
    for (int i = 0; i < 4; ++i)
#pragma unroll
        for (int j = 0; j < 4; ++j) { const int r = m0 + ty * 4 + i, c = n0 + tx * 4 + j; if (r < M && c < N) ef(r, c, acc[i][j]); }
}
struct AF_x_g1 { Params p; __device__ float operator()(int r, int k) const { return xval(p, r, k) * p.norm1_g[k]; } };
struct BF_rowmajor { const float* W; long ld; __device__ float operator()(int k, int n) const { return W[(size_t)k * ld + n]; } };
struct EF_proj { Params p; __device__ void operator()(int r, int n, float acc) const { proj_store(p, r, n, acc * p.RSTD1[r]); } };
struct AF_bf { const bf16_t* A; long ld; __device__ float operator()(int r, int k) const { return bf2f(A[(size_t)r * ld + k]); } };
struct EF_bra { Params p; __device__ void operator()(int r, int n, float acc) const { p.TMP[(size_t)r * DM + n] = acc * bf2f(p.BR[(size_t)r * 4096 + n]); } };
struct EF_brb { Params p; __device__ void operator()(int r, int n, float acc) const { p.MB[(size_t)r * DM + n] = f2bf(p.TMP[(size_t)r * DM + n] + acc * bf2f(p.BR[(size_t)r * 4096 + 2048 + n])); } };
struct EF_wo { Params p; __device__ void operator()(int r, int n, float acc) const { const float x1 = xval(p, r, n) + acc; p.X1[(size_t)r * DM + n] = x1; p.X1B[(size_t)r * DM + n] = f2bf(x1); } };
struct AF_x1_g2 { Params p; __device__ float operator()(int r, int k) const { return bf2f(p.X1B[(size_t)r * DM + k]) * p.norm2_g[k]; } };
struct EF_up { Params p; __device__ void operator()(int r, int n, float acc) const { const float v = fmaxf(acc * p.RSTD2[r], 0.f); p.HF[(size_t)r * DFF + n] = f2bf(v * v); } };
struct EF_down { Params p; __device__ void operator()(int r, int n, float acc) const { const float x2 = p.X1[(size_t)r * DM + n] + acc;
    if (r < NPT) p.out[OFF_Y + (size_t)r * DM + n] = x2; else p.out[OFF_YS + (size_t)(r - NPT) * DM + n] = x2; } };

__global__ void __launch_bounds__(128) k_compress_naive(Params p, int is_s) {
    const int n_cmp = is_s ? 1023 : 127, n_pad = is_s ? 1024 : 128;
    const int kv = blockIdx.y, tid = threadIdx.x;
    const int i = blockIdx.x % n_pad, bg = blockIdx.x / n_pad, b = bg >> 2, g = bg & 3;
    __shared__ float blk[2048]; __shared__ float hid[128];
    if (i >= n_cmp) {
        if (tid < 64) { if (is_s) { (kv ? p.VCMP_S : p.KCMP_S)[((size_t)bg * 1024 + i) * 64 + tid] = 0; }
                        else { if (kv) p.VCMPT_P[((size_t)bg * 64 + tid) * 128 + i] = 0; else p.KCMP_P[((size_t)bg * 128 + i) * 64 + tid] = 0; } }
        return;
    }
    const float* pe = kv ? p.pe_v : p.pe_k; const float* w1 = kv ? p.w1v : p.w1k; const float* w2 = kv ? p.w2v : p.w2k;
    for (int e = tid; e < 2048; e += 128) { const int l = e >> 6, d = e & 63; const int pos = 16 * i + l; float v;
        if (is_s) { const int page = p.page_table[b * NPAGES + (pos >> 7)]; v = (kv ? p.ccv : p.cck)[(((size_t)page * PAGE + (pos & 127)) * 4 + g) * 64 + d]; }
        else v = bf2f(p.KV6[((size_t)b * SEQ + pos) * 1536 + kv * 256 + g * 64 + d]);
        blk[e] = v + pe[e]; }
    __syncthreads();
    float h = 0.f;
    for (int k = 0; k < 2048; ++k) h += blk[k] * w1[(size_t)k * 128 + tid];
    hid[tid] = gelu_tanh(h);
    __syncthreads();
    if (tid < 64) { float o = 0.f; for (int j = 0; j < 128; ++j) o += hid[j] * w2[j * 64 + tid];
        if (is_s) (kv ? p.VCMP_S : p.KCMP_S)[((size_t)bg * 1024 + i) * 64 + tid] = f2bf(o);
        else { if (kv) p.VCMPT_P[((size_t)bg * 64 + tid) * 128 + i] = f2bf(o); else p.KCMP_P[((size_t)bg * 128 + i) * 64 + tid] = f2bf(o); } }
}

struct RowRef { const float* pf; const bf16_t* pb; };
__device__ __forceinline__ float rr_get(const RowRef& r, int d) { return r.pf ? r.pf[d] : bf2f(r.pb[d]); }

template <class KF, class VF>
__device__ __forceinline__ void attend_naive(int nk, KF keyf, VF valf, const float (*q)[64], float (*sc)[1088], float (*oacc)[64], const float* gate3, int gsel, int tid) {
    const int lane = tid & 63, wv = tid >> 6;
    for (int kk = tid; kk < nk; kk += 256) { bool valid; const RowRef r = keyf(kk, valid);
        if (valid) { float d0 = 0.f, d1 = 0.f, d2 = 0.f, d3 = 0.f;
            for (int d = 0; d < 64; ++d) { const float kx = rr_get(r, d); d0 += q[0][d] * kx; d1 += q[1][d] * kx; d2 += q[2][d] * kx; d3 += q[3][d] * kx; }
            sc[0][kk] = d0; sc[1][kk] = d1; sc[2][kk] = d2; sc[3][kk] = d3; }
        else { sc[0][kk] = -INFINITY; sc[1][kk] = -INFINITY; sc[2][kk] = -INFINITY; sc[3][kk] = -INFINITY; } }
    __syncthreads();
    {
        float m = -INFINITY; for (int kk = lane; kk < nk; kk += 64) m = fmaxf(m, sc[wv][kk]);
        m = wave_max(m);
        float s = 0.f;
        for (int kk = lane; kk < nk; kk += 64) { const float x = sc[wv][kk]; const float e = (x == -INFINITY) ? 0.f : __expf(x - m); sc[wv][kk] = e; s += e; }
        s = wave_sum(s);
        const float inv = s > 0.f ? 1.f / s : 0.f;
        for (int kk = lane; kk < nk; kk += 64) sc[wv][kk] *= inv;
    }
    __syncthreads();
    {
        float o = 0.f;
        for (int kk = 0; kk < nk; ++kk) { const float pr = sc[wv][kk]; if (pr != 0.f) o += pr * valf(kk, lane); }
        oacc[wv][lane] += gate3[wv * 3 + gsel] * o;
    }
    __syncthreads();
}

__device__ __forceinline__ void nsa_naive_body(const Params& p, int row, int g, int tid, float (*q)[64], float (*sc)[1088], float (*oacc)[64], float* gate3, float* score, int* selidx) {
    const bool is_s = row >= NPT; const int b = is_s ? row - NPT : row >> 11, t = is_s ? 0 : row & 2047;
    const int start = is_s ? PAST : 0, pos = start + t, rowbase = is_s ? NPT + b : b * SEQ;
    const int n_cmp = is_s ? 1023 : 127, n_slc = is_s ? 257 : 32;
    { const int hd = tid >> 6, d = tid & 63; q[hd][d] = bf2f(p.QN[(size_t)row * 1024 + (g * 4 + hd) * 64 + d]); oacc[hd][d] = 0.f; }
    if (tid < 12) gate3[tid] = p.GATE[(size_t)row * 48 + g * 12 + tid];
    __syncthreads();
    const int bg = b * 4 + g;
    const bf16_t* kc = is_s ? p.KCMP_S + (size_t)bg * 1024 * 64 : p.KCMP_P + (size_t)bg * 128 * 64;
    const bf16_t* vc_s = p.VCMP_S + (size_t)bg * 1024 * 64; const bf16_t* vc_p = p.VCMPT_P + (size_t)bg * 64 * 128;
    auto kf_c = [&](int kk, bool& valid) { valid = (16 * kk + 31 <= pos); return RowRef{nullptr, kc + (size_t)kk * 64}; };
    auto vf_c = [&](int kk, int d) { return is_s ? bf2f(vc_s[(size_t)kk * 64 + d]) : bf2f(vc_p[(size_t)d * 128 + kk]); };
    attend_naive(n_cmp, kf_c, vf_c, q, sc, oacc, gate3, 0, tid);
    for (int j = tid; j < n_slc; j += 256) { float s = 0.f;
        for (int i = 4 * j - 1; i <= 4 * j + 3; ++i) if (i >= 0 && i < n_cmp) s += (sc[0][i] + sc[1][i]) + (sc[2][i] + sc[3][i]);
        score[j] = (j * 64 <= pos) ? s + ((j == 0 || j == pos / 64) ? 1e4f : 0.f) : -1e30f; }
    __syncthreads();
    for (int j = tid; j < n_slc; j += 256) { const float sj = score[j]; int rank = 0;
        for (int j2 = 0; j2 < n_slc; ++j2) { const float s2 = score[j2]; rank += (s2 > sj || (s2 == sj && j2 < j)) ? 1 : 0; }
        if (rank < 16) selidx[rank] = j; }
    __syncthreads();
    auto row_at = [&](int kp, int which) -> RowRef {
        if (kp < start) {
            if (which < 4) { const int page = p.page_table[b * NPAGES + (kp >> 7)]; const float* c = (which == 2) ? p.csk : p.csv; return RowRef{c + (((size_t)page * PAGE + (kp & 127)) * 4 + g) * 64, nullptr}; }
            const float* c = (which == 4) ? p.cwk : p.cwv; return RowRef{c + (((size_t)b * 512 + (kp - (PAST - 512))) * 4 + g) * 64, nullptr};
        }
        return RowRef{nullptr, p.KV6 + (size_t)(rowbase + kp - start) * 1536 + which * 256 + g * 64};
    };
    auto kf_s = [&](int kk, bool& valid) { const int kp = selidx[kk >> 6] * 64 + (kk & 63); valid = (kp <= pos); return valid ? row_at(kp, 2) : RowRef{nullptr, nullptr}; };
    auto vf_s = [&](int kk, int d) { const int kp = selidx[kk >> 6] * 64 + (kk & 63); return rr_get(row_at(kp, 3), d); };
    attend_naive(1024, kf_s, vf_s, q, sc, oacc, gate3, 1, tid);
    auto kf_w = [&](int kk, bool& valid) { const int kp = pos - 512 + kk; valid = (kp >= 0); return valid ? row_at(kp, 4) : RowRef{nullptr, nullptr}; };
    auto vf_w = [&](int kk, int d) { const int kp = pos - 512 + kk; return rr_get(row_at(kp, 5), d); };
    attend_naive(513, kf_w, vf_w, q, sc, oacc, gate3, 2, tid);
    { const int hd = tid >> 6, d = tid & 63; p.OA[(size_t)row * 1024 + (g * 4 + hd) * 64 + d] = f2bf(oacc[hd][d]); }
}
__global__ void __launch_bounds__(256) k_nsa_naive(Params p, int row0) {
    __shared__ float q[4][64]; __shared__ float sc[4][1088]; __shared__ float oacc[4][64]; __shared__ float gate3[12];
    __shared__ float score[260]; __shared__ int selidx[16];
    nsa_naive_body(p, row0 + blockIdx.x, blockIdx.y, threadIdx.x, q, sc, oacc, gate3, score, selidx);
}

__global__ void __launch_bounds__(512) k_gla_naive(Params p, int is_s) {
    const int b = blockIdx.x >> 2, h = blockIdx.x & 3, tid = threadIdx.x, e = tid & 255, half = tid >> 8;
    const int T = is_s ? 1 : SEQ, rowbase = is_s ? NPT + b : b * SEQ;
    __shared__ float a_s[128], q_s[128], k_s[128], part[2][256], red[8];
    float S[64];
#pragma unroll
    for (int dd = 0; dd < 64; ++dd) S[dd] = is_s ? p.state[(((size_t)b * 4 + h) * 128 + half * 64 + dd) * 256 + e] : 0.f;
    for (int t = 0; t < T; ++t) {
        const int row = rowbase + t;
        if (tid < 128) { float x = p.b_a[h * 128 + tid];
            for (int r = 0; r < 16; ++r) x += p.LR[(size_t)row * 16 + r] * p.w_a2[r * 512 + h * 128 + tid];
            a_s[tid] = __expf(logsigmoidf_(x) * (1.f / 16.f));
            q_s[tid] = bf2f(p.GQ[(size_t)row * 512 + h * 128 + tid]); k_s[tid] = bf2f(p.GK[(size_t)row * 512 + h * 128 + tid]); }
        const float v = bf2f(p.GV[(size_t)row * 1024 + h * 256 + e]);
        __syncthreads();
        float po = 0.f;
#pragma unroll
        for (int dd = 0; dd < 64; ++dd) { const int d = half * 64 + dd; S[dd] = a_s[d] * S[dd] + k_s[d] * v; po += q_s[d] * S[dd]; }
        part[half][e] = po;
        __syncthreads();
        float o = 0.f;
        if (tid < 256) { o = part[0][e] + part[1][e]; const float ss = wave_sum(o * o); if ((tid & 63) == 0) red[tid >> 6] = ss; }
        __syncthreads();
        if (tid < 256) { const float ss = (red[0] + red[1]) + (red[2] + red[3]); const float r = rsqrtf(ss * (1.f / 256.f) + EPS);
            p.OB[(size_t)row * 1024 + h * 256 + e] = f2bf(o * r * p.gnorm[e] * bf2f(p.GR[(size_t)row * 1024 + h * 256 + e])); }
    }
    float* so = p.out + (is_s ? OFF_SGLA : OFF_PGLA);
#pragma unroll
    for (int dd = 0; dd < 64; ++dd) so[(((size_t)b * 4 + h) * 128 + half * 64 + dd) * 256 + e] = S[dd];
}

#define GAS __attribute__((address_space(1)))
#define LAS __attribute__((address_space(3)))
typedef unsigned v4u __attribute__((ext_vector_type(4)));
typedef unsigned v2u __attribute__((ext_vector_type(2)));
#define LDS_WAIT() asm volatile("s_waitcnt lgkmcnt(0)" ::: "memory")
#define VM_WAIT() asm volatile("s_waitcnt vmcnt(0)" ::: "memory")
__device__ __forceinline__ unsigned pk2(float lo, float hi) { return (unsigned)f2bf(lo) | ((unsigned)f2bf(hi) << 16); }
constexpr int NIN_PAD = 9984;
__host__ __device__ __forceinline__ int in_colmap(int n) {
    if (n < 2560) return n; if (n < 3072) return C_QL + (n - 2560); if (n < 3584) return C_KL + (n - 3072); if (n < 4608) return C_VL + (n - 3584);
    if (n < 5632) return C_RL + (n - 4608); if (n < 9728) return C_BR + (n - 5632); if (n < 9776) return C_G + (n - 9728); if (n < 9792) return C_LR + (n - 9776); return -1;
}
namespace pg8 {
#define PG8_LAS __attribute__((address_space(3)))
typedef unsigned short bf16_t;
typedef short bf16x8 __attribute__((ext_vector_type(8)));
typedef float f32x4 __attribute__((ext_vector_type(4)));
typedef unsigned u32x4 __attribute__((ext_vector_type(4)));
constexpr int BM = 256, BK = 64, HALF = 128, HTB = HALF * BK * 2  , STAGE_BYTES = 8 * HTB, NXCD = 8, WGM = 8;

__host__ __device__ __forceinline__ int lds_byte(int r, int c) { const int st = (r >> 4) * 2 + (c >> 5), rr = r & 15, cc = c & 31, ob = rr * 64 + cc * 2; return st * 1024 + (ob ^ (((ob >> 9) & 1) << 5)); }
__host__ __device__ __forceinline__ void stage_rc(int b, int& R, int& C) { const int st = b / 1024, sb = b % 1024, swz = sb ^ (((sb >> 9) & 1) << 5); R = (st >> 1) * 16 + swz / 64; C = (st & 1) * 32 + (swz % 64) / 2; }
__host__ __device__ __forceinline__ int perm32(int rho) { const int n = rho >> 4, i = rho & 15; return 8 * (i >> 2) + 4 * n + (i & 3); }

struct Unit { int pm, pn; };
struct Gemm { const bf16_t* A; const bf16_t* Bt; int M, N, K; };

struct StaticOrder {
    int nM, nN, nwg, G, c;
    __host__ __device__ void init(int M, int N, int G_, int c_) { nM = M / BM; nN = N / BM; nwg = nM * nN; G = G_; c = c_; }
    __host__ __device__ bool next(int i, Unit& u) const {
        const long L = (long)i * G + c; if (L >= nwg) return false;
        int wgid = (int)L; { const int q = nwg / NXCD, r = nwg % NXCD, xcd = wgid % NXCD, off = wgid / NXCD; wgid = (xcd < r ? xcd * (q + 1) : r * (q + 1) + (xcd - r) * q) + off; }
        const int nig = WGM * nN, gid = wgid / nig, fm = gid * WGM, gsz = (nM - fm) < WGM ? (nM - fm) : WGM;
        u.pm = fm + ((wgid % nig) % gsz); u.pn = (wgid % nig) / gsz; return true;
    }
    __device__ __forceinline__ void a_ready(const Unit&) const {}
    __device__ __forceinline__ void done(const Unit&) const {}
};

template <class Epi, class Sched, bool ALIGN_EPI = false, bool SP2 = false>
__device__ __forceinline__ void gemm_phase(PG8_LAS unsigned char* lds, const Gemm g, const Sched& S, const Epi& E) {
    const int tid = threadIdx.x, wid = __builtin_amdgcn_readfirstlane(tid >> 6), lane = tid & 63, wr = wid >> 2, wc = wid & 3, fr = lane & 15, fq = lane >> 4;
    const int K = g.K, nt = K / BK;
    unsigned voffA[2], voffB[2];
#pragma unroll
    for (int i = 0; i < 2; ++i) { int R, C; stage_rc(tid * 16 + i * 8192, R, C); const int Rb = Epi::PERM ? ((R & ~31) + perm32(R & 31)) : R;
        voffA[i] = (unsigned)(R * K + C) * 2u; voffB[i] = (unsigned)(Rb * K + C) * 2u; }
    const size_t kstep = (size_t)(BK * 2);
    const size_t hstep = (size_t)HALF * K * 2;
    const size_t tstep = 2 * hstep;
    const unsigned ldsw = (unsigned)wid * 1024u;
    const int aoff = lds_byte(wr * 64 + fr, fq * 8), boff = lds_byte(wc * 32 + fr, fq * 8);
#define PG8_SA(b, h) (((b) * 2 + (h)) * HTB)
#define PG8_SB(b, h) ((4 + (b) * 2 + (h)) * HTB)
#define PG8_STAGE(bufoff, gbase, voff) do { _Pragma("unroll") for (int _i = 0; _i < 2; ++_i) \
        __builtin_amdgcn_global_load_lds((const unsigned*)((const char*)(gbase) + (voff)[_i]), (PG8_LAS unsigned*)(lds + (bufoff) + ldsw + _i * 8192), 16, 0, 0); } while (0)
#define PG8_LDA(dst, b, h) do { _Pragma("unroll") for (int m = 0; m < 4; ++m) _Pragma("unroll") for (int k = 0; k < 2; ++k) dst[m][k] = *(const PG8_LAS bf16x8*)(lds + PG8_SA(b, h) + aoff + m * 2048 + k * 1024); } while (0)
#define PG8_LDB(dst, b, h) do { _Pragma("unroll") for (int n = 0; n < 2; ++n) _Pragma("unroll") for (int k = 0; k < 2; ++k) dst[n][k] = *(const PG8_LAS bf16x8*)(lds + PG8_SB(b, h) + boff + n * 2048 + k * 1024); } while (0)
#define PG8_MMA(ai, bj, At, Bt) do { __builtin_amdgcn_s_setprio(1); _Pragma("unroll") for (int m = 0; m < 4; ++m) _Pragma("unroll") for (int n = 0; n < 2; ++n) _Pragma("unroll") for (int k = 0; k < 2; ++k) \
        acc[ai][bj][m][n] = __builtin_amdgcn_mfma_f32_16x16x32_bf16(Bt[n][k], At[m][k], acc[ai][bj][m][n], 0, 0, 0); __builtin_amdgcn_s_setprio(0); } while (0)
#define PG8_WAIT_V(n) asm volatile("s_waitcnt vmcnt(" #n ")" ::: "memory")
#define PG8_WAIT_L(n) asm volatile("s_waitcnt lgkmcnt(" #n ")" ::: "memory")
#define PG8_BAR __builtin_amdgcn_s_barrier()
#define PG8_SCHED __builtin_amdgcn_sched_barrier(0)
    Unit cur, nxt; int ui = 0;
    if (!S.next(0, cur)) return;
    f32x4 acc[2][2][4][2];
#pragma unroll
    for (int a = 0; a < 2; ++a)
#pragma unroll
        for (int b = 0; b < 2; ++b)
#pragma unroll
            for (int m = 0; m < 4; ++m)
#pragma unroll
                for (int n = 0; n < 2; ++n) acc[a][b][m][n] = (f32x4){0.f, 0.f, 0.f, 0.f};
    bf16x8 At[4][2], B0[2][2], B1[2][2];
    const char* cA = (const char*)g.A + (size_t)cur.pm * tstep; const char* cB = (const char*)g.Bt + (size_t)cur.pn * tstep;
    S.a_ready(cur);
    if constexpr (SP2) {
        PG8_STAGE(PG8_SB(0, 0), cB, voffB); PG8_STAGE(PG8_SB(0, 1), cB + hstep, voffB); PG8_STAGE(PG8_SA(0, 0), cA, voffA); PG8_STAGE(PG8_SA(0, 1), cA + hstep, voffA);
        if (wr == 1) PG8_BAR;
        PG8_WAIT_V(2); PG8_BAR;
        PG8_STAGE(PG8_SB(1, 0), cB + kstep, voffB); PG8_STAGE(PG8_SA(1, 0), cA + kstep, voffA); PG8_STAGE(PG8_SB(1, 1), cB + hstep + kstep, voffB);
        PG8_WAIT_V(6); PG8_BAR;
    } else {
        PG8_STAGE(PG8_SB(0, 0), cB, voffB); PG8_STAGE(PG8_SA(0, 0), cA, voffA); PG8_STAGE(PG8_SB(0, 1), cB + hstep, voffB); PG8_STAGE(PG8_SA(0, 1), cA + hstep, voffA);
        if (wr == 1) PG8_BAR;
        PG8_WAIT_V(4); PG8_BAR;
        PG8_STAGE(PG8_SB(1, 0), cB + kstep, voffB); PG8_STAGE(PG8_SA(1, 0), cA + kstep, voffA); PG8_STAGE(PG8_SB(1, 1), cB + hstep + kstep, voffB);
        PG8_WAIT_V(6); PG8_BAR;
    }
    for (;;) {
        const bool has_next = S.next(ui + 1, nxt);
        const char* nA = has_next ? (const char*)g.A + (size_t)nxt.pm * tstep : cA; const char* nB = has_next ? (const char*)g.Bt + (size_t)nxt.pn * tstep : cB;
        for (int t = 0; t < nt; t += 2) {
            const bool last = (t == nt - 2);
            const char* a1 = cA + (size_t)(t + 1) * kstep;
            const char* a2 = last ? nA : cA + (size_t)(t + 2) * kstep; const char* b2 = last ? nB : cB + (size_t)(t + 2) * kstep;
            const char* a3 = a2 + kstep; const char* b3 = b2 + kstep;
            if (last && has_next) S.a_ready(nxt);
            if constexpr (SP2) {
            PG8_LDB(B0, 0, 0); PG8_LDB(B1, 0, 1); PG8_SCHED; PG8_LDA(At, 0, 0); PG8_STAGE(PG8_SA(1, 1), a1 + hstep, voffA);
            PG8_WAIT_V(8); PG8_WAIT_L(0); PG8_BAR; PG8_MMA(0, 0, At, B0); PG8_MMA(0, 1, At, B1); PG8_BAR; PG8_SCHED;
            PG8_LDA(At, 0, 1); PG8_STAGE(PG8_SB(0, 0), b2, voffB); PG8_STAGE(PG8_SB(0, 1), b2 + hstep, voffB); PG8_STAGE(PG8_SA(0, 0), a2, voffA);
            PG8_WAIT_V(8); PG8_WAIT_L(0); PG8_BAR; PG8_MMA(1, 0, At, B0); PG8_MMA(1, 1, At, B1); PG8_BAR; PG8_SCHED;
            PG8_LDB(B0, 1, 0); PG8_LDB(B1, 1, 1); PG8_SCHED; PG8_LDA(At, 1, 0); PG8_STAGE(PG8_SA(0, 1), a2 + hstep, voffA);
            PG8_WAIT_V(8); PG8_WAIT_L(0); PG8_BAR; PG8_MMA(0, 0, At, B0); PG8_MMA(0, 1, At, B1); PG8_BAR; PG8_SCHED;
            PG8_LDA(At, 1, 1); PG8_STAGE(PG8_SB(1, 0), b3, voffB); PG8_STAGE(PG8_SB(1, 1), b3 + hstep, voffB); PG8_STAGE(PG8_SA(1, 0), a3, voffA);
            PG8_WAIT_V(8); PG8_WAIT_L(0); PG8_BAR; PG8_MMA(1, 0, At, B0); PG8_MMA(1, 1, At, B1); PG8_BAR; PG8_SCHED;
            } else {
            PG8_LDB(B0, 0, 0); PG8_SCHED; PG8_LDA(At, 0, 0); PG8_STAGE(PG8_SA(1, 1), a1 + hstep, voffA);
            PG8_WAIT_L(8); PG8_BAR; PG8_WAIT_L(0); PG8_MMA(0, 0, At, B0); PG8_BAR; PG8_SCHED;
            PG8_LDB(B1, 0, 1); PG8_STAGE(PG8_SB(0, 0), b2, voffB);
            PG8_BAR; PG8_WAIT_L(0); PG8_MMA(0, 1, At, B1); PG8_BAR;
            PG8_LDA(At, 0, 1); PG8_STAGE(PG8_SA(0, 0), a2, voffA);
            PG8_BAR; PG8_WAIT_L(0); PG8_MMA(1, 0, At, B0); PG8_BAR; PG8_SCHED;
            PG8_STAGE(PG8_SB(0, 1), b2 + hstep, voffB);
            PG8_WAIT_V(6); PG8_BAR; PG8_MMA(1, 1, At, B1); PG8_BAR;
            PG8_LDB(B0, 1, 0); PG8_SCHED; PG8_LDA(At, 1, 0); PG8_STAGE(PG8_SA(0, 1), a2 + hstep, voffA);
            PG8_WAIT_L(8); PG8_BAR; PG8_WAIT_L(0); PG8_MMA(0, 0, At, B0); PG8_BAR; PG8_SCHED;
            PG8_LDB(B1, 1, 1); PG8_STAGE(PG8_SB(1, 0), b3, voffB);
            PG8_BAR; PG8_WAIT_L(0); PG8_MMA(0, 1, At, B1); PG8_BAR;
            PG8_LDA(At, 1, 1); PG8_STAGE(PG8_SA(1, 0), a3, voffA);
            PG8_BAR; PG8_WAIT_L(0); PG8_MMA(1, 0, At, B0); PG8_BAR; PG8_SCHED;
            PG8_STAGE(PG8_SB(1, 1), b3 + hstep, voffB);
            PG8_WAIT_V(6); PG8_BAR; PG8_MMA(1, 1, At, B1); PG8_BAR;
            }
        }
        if constexpr (ALIGN_EPI) { if (wr == 0) PG8_BAR; }
        if constexpr (!Epi::AFTER_DRAIN) { E(acc, cur, wr, wc, fr, fq); S.done(cur); }
        if (!has_next) break;
#pragma unroll
        for (int a = 0; a < 2; ++a)
#pragma unroll
            for (int b = 0; b < 2; ++b)
#pragma unroll
                for (int m = 0; m < 4; ++m)
#pragma unroll
                    for (int n = 0; n < 2; ++n) acc[a][b][m][n] = (f32x4){0.f, 0.f, 0.f, 0.f};
        cur = nxt; cA = nA; cB = nB; ++ui;
        if constexpr (ALIGN_EPI) { if (wr == 1) PG8_BAR; }
    }
    PG8_WAIT_V(0);
    if constexpr (!ALIGN_EPI) { if (wr == 0) PG8_BAR; }
    PG8_BAR;
    if constexpr (Epi::AFTER_DRAIN) { E.fused(acc, cur, wr, wc, fr, fq, lds, wid, lane); S.done(cur); }
#undef PG8_SA
#undef PG8_SB
#undef PG8_STAGE
#undef PG8_LDA
#undef PG8_LDB
#undef PG8_MMA
#undef PG8_WAIT_V
#undef PG8_WAIT_L
#undef PG8_BAR
#undef PG8_SCHED
}
}
typedef pg8::f32x4 f32x4;
template <class F> struct EpiGen {
    static constexpr bool PERM = false, AFTER_DRAIN = false; F f;
    __device__ __forceinline__ void operator()(const f32x4 (&acc)[2][2][4][2], const pg8::Unit& u, int wr, int wc, int fr, int fq) const {
        const int row0 = u.pm * 256 + wr * 64 + fr, col0 = u.pn * 256 + wc * 32 + 4 * fq;
#pragma unroll
        for (int ai = 0; ai < 2; ++ai)
#pragma unroll
            for (int m = 0; m < 4; ++m) { const int row = row0 + ai * 128 + m * 16; const float ctx = f.row_begin(row); float part = 0.f;
#pragma unroll
                for (int bj = 0; bj < 2; ++bj)
#pragma unroll
                    for (int n = 0; n < 2; ++n) part += f.store4(ctx, row, col0 + bj * 128 + n * 16, acc[ai][bj][m][n]);
                f.row_end(row, part, fq, true); }
    }
};
template <int ACT  >
__device__ __forceinline__ void store_tile_bf16(const f32x4 (&acc)[2][2][4][2], int row0, int col0, const float* rstd, float scale, bf16_t* dst, int ld) {
#pragma unroll
    for (int ai = 0; ai < 2; ++ai)
#pragma unroll
        for (int m = 0; m < 4; ++m) { const int row = row0 + ai * 128 + m * 16; const float rs = rstd[row] * scale; bf16_t* rp = dst + (size_t)row * ld + col0;
#pragma unroll
            for (int bj = 0; bj < 2; ++bj)
#pragma unroll
                for (int n = 0; n < 2; ++n) { f32x4 v = acc[ai][bj][m][n] * rs;
                    if (ACT == 1) { v[0] = siluf_(v[0]); v[1] = siluf_(v[1]); v[2] = siluf_(v[2]); v[3] = siluf_(v[3]); }
                    if (ACT == 2) { v[0] = sigmoidf_(v[0]); v[1] = sigmoidf_(v[1]); v[2] = sigmoidf_(v[2]); v[3] = sigmoidf_(v[3]); }
                    v2u w; w.x = pk2(v[0], v[1]); w.y = pk2(v[2], v[3]); *(v2u*)(rp + bj * 128 + n * 16) = w; } }
}
struct EpiProj {
    static constexpr bool PERM = false, AFTER_DRAIN = false;
    const float* rstd; const float* b_gate; bf16_t *QN, *KV6, *GQ, *GK, *GV, *GR, *BR; float *GATE, *LR, *out;
    __device__ __forceinline__ void operator()(const f32x4 (&acc)[2][2][4][2], const pg8::Unit& u, int wr, int wc, int fr, int fq) const {
        const int row0 = u.pm * 256 + wr * 64 + fr, cl0 = wc * 32 + 4 * fq, pn = u.pn;
        if (pn < 4) store_tile_bf16<0>(acc, row0, pn * 256 + cl0, rstd, 0.125f, QN, 1024);
        else if (pn < 10) { const int j = pn - 4;
            store_tile_bf16<0>(acc, row0, j * 256 + cl0, rstd, 1.f, KV6, 1536);
#pragma unroll
            for (int ai = 0; ai < 2; ++ai)
#pragma unroll
                for (int m = 0; m < 4; ++m) { const int row = row0 + ai * 128 + m * 16; const float rs = rstd[row]; const int b = row >> 11, t = row & 2047;
                    float* rp = nullptr;
                    if (j < 4) rp = out + OFF_PCK + j * SZ_PROW + (size_t)row * 256 + cl0;
                    else if (t >= 1536) rp = out + OFF_PWK + (j - 4) * SZ_PWIN + ((size_t)b * 512 + (t - 1536)) * 256 + cl0;
                    if (rp) {
#pragma unroll
                        for (int bj = 0; bj < 2; ++bj)
#pragma unroll
                            for (int n = 0; n < 2; ++n) *(f32x4*)(rp + bj * 128 + n * 16) = acc[ai][bj][m][n] * rs; } }
        }
        else if (pn < 12) store_tile_bf16<0>(acc, row0, (pn - 10) * 256 + cl0, rstd, 0.08838834764831845f, GQ, 512);
        else if (pn < 14) store_tile_bf16<0>(acc, row0, (pn - 12) * 256 + cl0, rstd, 1.f, GK, 512);
        else if (pn < 18) store_tile_bf16<0>(acc, row0, (pn - 14) * 256 + cl0, rstd, 1.f, GV, 1024);
        else if (pn < 22) store_tile_bf16<1>(acc, row0, (pn - 18) * 256 + cl0, rstd, 1.f, GR, 1024);
        else if (pn < 38) store_tile_bf16<2>(acc, row0, (pn - 22) * 256 + cl0, rstd, 1.f, BR, 4096);
        else if (wc < 2) {
#pragma unroll
            for (int ai = 0; ai < 2; ++ai)
#pragma unroll
                for (int m = 0; m < 4; ++m) { const int row = row0 + ai * 128 + m * 16; const float rs = rstd[row];
#pragma unroll
                    for (int n = 0; n < 2; ++n) { const int cl = cl0 + n * 16; const f32x4 v = acc[ai][0][m][n] * rs;
                        if (cl < 48) { const f32x4 bg = *(const f32x4*)(b_gate + cl); f32x4 o; o[0] = sigmoidf_(v[0] + bg[0]); o[1] = sigmoidf_(v[1] + bg[1]); o[2] = sigmoidf_(v[2] + bg[2]); o[3] = sigmoidf_(v[3] + bg[3]);
                            *(f32x4*)(GATE + (size_t)row * 48 + cl) = o; }
                        else *(f32x4*)(LR + (size_t)row * 16 + (cl - 48)) = v; } }
        }
    }
};
struct F_bra { const bf16_t* BR; float* TMP;
    __device__ __forceinline__ float row_begin(int) const { return 0.f; }
    __device__ __forceinline__ float store4(float, int row, int col, f32x4 v) const { const v2u b = *(const v2u*)(BR + (size_t)row * 4096 + col);
        f32x4 o; o[0] = v[0] * bf2f((bf16_t)(b.x & 0xffff)); o[1] = v[1] * bf2f((bf16_t)(b.x >> 16)); o[2] = v[2] * bf2f((bf16_t)(b.y & 0xffff)); o[3] = v[3] * bf2f((bf16_t)(b.y >> 16));
        *(f32x4*)(TMP + (size_t)row * DM + col) = o; return 0.f; }
    __device__ __forceinline__ void row_end(int, float, int, bool) const {}
};
struct F_brb { const bf16_t* BR; const float* TMP; bf16_t* MB;
    __device__ __forceinline__ float row_begin(int) const { return 0.f; }
    __device__ __forceinline__ float store4(float, int row, int col, f32x4 v) const { const v2u b = *(const v2u*)(BR + (size_t)row * 4096 + 2048 + col); const f32x4 t = *(const f32x4*)(TMP + (size_t)row * DM + col);
        const float o0 = t[0] + v[0] * bf2f((bf16_t)(b.x & 0xffff)), o1 = t[1] + v[1] * bf2f((bf16_t)(b.x >> 16)), o2 = t[2] + v[2] * bf2f((bf16_t)(b.y & 0xffff)), o3 = t[3] + v[3] * bf2f((bf16_t)(b.y >> 16));
        v2u w; w.x = pk2(o0, o1); w.y = pk2(o2, o3); *(v2u*)(MB + (size_t)row * DM + col) = w; return 0.f; }
    __device__ __forceinline__ void row_end(int, float, int, bool) const {}
};
struct F_wo { const float* x; float* X1; bf16_t* X1B; float* SUMSQ;
    __device__ __forceinline__ float row_begin(int) const { return 0.f; }
    __device__ __forceinline__ float store4(float, int row, int col, f32x4 v) const { const f32x4 xv = *(const f32x4*)(x + (size_t)row * DM + col); const f32x4 x1 = xv + v;
        *(f32x4*)(X1 + (size_t)row * DM + col) = x1; v2u w; w.x = pk2(x1[0], x1[1]); w.y = pk2(x1[2], x1[3]); *(v2u*)(X1B + (size_t)row * DM + col) = w;
        return (x1[0] * x1[0] + x1[1] * x1[1]) + (x1[2] * x1[2] + x1[3] * x1[3]); }
    __device__ __forceinline__ void row_end(int row, float part, int fq, bool valid) const { part += __shfl_xor(part, 16); part += __shfl_xor(part, 32); if (fq == 0 && valid) atomicAdd(SUMSQ + row, part); }
};
struct F_up { const float* SUMSQ; bf16_t* HF;
    __device__ __forceinline__ float row_begin(int row) const { return rsqrtf(SUMSQ[row] * (1.f / DM) + EPS); }
    __device__ __forceinline__ float store4(float rs, int row, int col, f32x4 v) const { float h[4];
#pragma unroll
        for (int i = 0; i < 4; ++i) { const float t = fmaxf(v[i] * rs, 0.f); h[i] = t * t; }
        v2u w; w.x = pk2(h[0], h[1]); w.y = pk2(h[2], h[3]); *(v2u*)(HF + (size_t)row * DFF + col) = w; return 0.f; }
    __device__ __forceinline__ void row_end(int, float, int, bool) const {}
};
struct F_down { const float* X1; float* Y; float* SUMSQ;
    __device__ __forceinline__ float row_begin(int) const { return 0.f; }
    __device__ __forceinline__ float store4(float, int row, int col, f32x4 v) const { const f32x4 x1 = *(const f32x4*)(X1 + (size_t)row * DM + col); const f32x4 x2 = x1 + v;
        *(f32x4*)(Y + (size_t)row * DM + col) = x2; return (x2[0] * x2[0] + x2[1] * x2[1]) + (x2[2] * x2[2] + x2[3] * x2[3]); }
    __device__ __forceinline__ void row_end(int row, float part, int fq, bool valid) const { part += __shfl_xor(part, 16); part += __shfl_xor(part, 32); if (fq == 0 && valid) atomicAdd(SUMSQ + row, part); }
};

typedef short bf16x8_t __attribute__((ext_vector_type(8)));
template <class F>
__device__ __forceinline__ void skinny_gemm(LAS unsigned char* lds, const bf16_t* A, int lda, const bf16_t* Bt, int N, int K, const F& f, int bid, int G, int tid) {
    const int lane = tid & 63, wave = __builtin_amdgcn_readfirstlane(tid >> 6), j = lane & 15, g = lane >> 4;
    LAS f32x4* red = (LAS f32x4*)lds;
    const int ksl = K >> 3;
    for (int it = bid; it < (N >> 4); it += G) {
        const int n0 = it * 16;
        const bf16_t* bp = Bt + (size_t)(n0 + j) * K + wave * ksl + 8 * g;
        const bf16_t* ap = A + (size_t)(j & 7) * lda + wave * ksl + 8 * g;
        f32x4 acc = {0.f, 0.f, 0.f, 0.f};
#pragma unroll 4
        for (int k = 0; k < ksl; k += 32) {
            const bf16x8_t b = *(const bf16x8_t*)(bp + k); bf16x8_t a = *(const bf16x8_t*)(ap + k);
            if (j >= 8) a = (bf16x8_t){0, 0, 0, 0, 0, 0, 0, 0};
            acc = __builtin_amdgcn_mfma_f32_16x16x32_bf16(b, a, acc, 0, 0, 0);
        }
        red[wave * 64 + lane] = acc;
        __syncthreads();
        if (wave == 0) { f32x4 sacc = red[lane];
#pragma unroll
            for (int w = 1; w < 8; ++w) sacc = sacc + red[w * 64 + lane];
            const int row = NPT + (j & 7); const bool valid = j < 8; const float ctx = f.row_begin(row); float part = 0.f;
            if (valid) part = f.store4(ctx, row, n0 + 4 * g, sacc);
            f.row_end(row, part, g, valid); }
        __syncthreads();
    }
}
struct F_proj_s { const Params& p;
    __device__ __forceinline__ float row_begin(int row) const { return p.RSTD1[row]; }
    __device__ __forceinline__ float store4(float rs, int row, int col, f32x4 v) const { const int n0 = in_colmap(col); if (n0 >= 0) {
#pragma unroll
        for (int i = 0; i < 4; ++i) proj_store(p, row, n0 + i, v[i] * rs); } return 0.f; }
    __device__ __forceinline__ void row_end(int, float, int, bool) const {}
};

template <class CM>
__device__ __forceinline__ void transpose_item(const float* W, int ldw, const float* kscale, bf16_t* WT, int K, int item, int nblk, CM cm, LAS float* scr, int lane) {
    const int kb = item / nblk, nb = item % nblk, k0 = 64 * kb, n0 = 32 * nb;
    const int sc = cm(n0 + (lane & 31));
#pragma unroll 8
    for (int i = 0; i < 32; ++i) { const int kk = 2 * i + (lane >> 5); float v = sc >= 0 ? W[(size_t)(k0 + kk) * ldw + sc] : 0.f; if (kscale) v *= kscale[k0 + kk]; scr[kk * 33 + (lane & 31)] = v; }
    LDS_WAIT(); asm volatile("" ::: "memory");
    const int c = lane & 7;
#pragma unroll
    for (int j = 0; j < 4; ++j) { const int n = (lane >> 3) + 8 * j; const LAS float* s = scr + (8 * c) * 33 + n;
        v4u o; o.x = pk2(s[0 * 33], s[1 * 33]); o.y = pk2(s[2 * 33], s[3 * 33]); o.z = pk2(s[4 * 33], s[5 * 33]); o.w = pk2(s[6 * 33], s[7 * 33]);
        *(v4u*)(WT + (size_t)(n0 + n) * K + k0 + 8 * c) = o; }
    LDS_WAIT(); asm volatile("" ::: "memory");
}
struct CM_id { __device__ __forceinline__ int operator()(int n) const { return n; } };
struct CM_in { __device__ __forceinline__ int operator()(int n) const { return in_colmap(n); } };

__device__ __forceinline__ void ph_prologue(const Params& p, LAS unsigned char* lds, int bid, int G, int tid) {
    const int lane = tid & 63, wave = tid >> 6, gw = bid * 8 + wave, NGW = G * 8;
    LAS float* scr = (LAS float*)(lds + wave * 16384);
    constexpr int I_IN = 32 * (NIN_PAD / 32), I_BR = 16 * 64, I_O = 32 * 64, I_UP = 32 * 256, I_DN = 128 * 64;
    constexpr int TOTAL = I_IN + 2 * I_BR + I_O + I_UP + I_DN;
    for (int it = gw; it < TOTAL; it += NGW) { int r = it;
        if (r < I_IN) { transpose_item(p.w_in, DIN, p.norm1_g, p.WIN_T, DM, r, NIN_PAD / 32, CM_in{}, scr, lane); continue; } r -= I_IN;
        if (r < I_BR) { transpose_item(p.w_br_a, DM, nullptr, p.WBRA_T, 1024, r, 64, CM_id{}, scr, lane); continue; } r -= I_BR;
        if (r < I_BR) { transpose_item(p.w_br_b, DM, nullptr, p.WBRB_T, 1024, r, 64, CM_id{}, scr, lane); continue; } r -= I_BR;
        if (r < I_O) { transpose_item(p.w_o, DM, nullptr, p.WO_T, DM, r, 64, CM_id{}, scr, lane); continue; } r -= I_O;
        if (r < I_UP) { transpose_item(p.w_up, DFF, p.norm2_g, p.WUP_T, DM, r, 256, CM_id{}, scr, lane); continue; } r -= I_UP;
        transpose_item(p.w_down, DM, nullptr, p.WDN_T, DFF, r, 64, CM_id{}, scr, lane);
    }
    for (int row = gw; row < NTOK; row += NGW) {
        const f32x4* xr = (const f32x4*)(row < NPT ? p.x_prompt + (size_t)row * DM : p.x_sample + (size_t)(row - NPT) * DM) + lane;
        f32x4 v[8]; float ss = 0.f;
#pragma unroll
        for (int j = 0; j < 8; ++j) { v[j] = xr[64 * j]; ss += (v[j][0] * v[j][0] + v[j][1] * v[j][1]) + (v[j][2] * v[j][2] + v[j][3] * v[j][3]); }
        ss = wave_sum(ss);
        v2u* o = (v2u*)(p.XB + (size_t)row * DM) + lane;
#pragma unroll
        for (int j = 0; j < 8; ++j) { v2u w; w.x = pk2(v[j][0], v[j][1]); w.y = pk2(v[j][2], v[j][3]); o[64 * j] = w; }
        if (lane == 0) p.RSTD1[row] = rsqrtf(ss * (1.f / DM) + EPS);
    }
    for (int i = bid * 512 + tid; i < DB * 511 * 64; i += G * 512) { const int c4 = i & 63, r = (i >> 6) % 511, b = (i >> 6) / 511;
        const size_t so = ((size_t)b * 512 + r + 1) * 256 + c4 * 4, dofs = ((size_t)b * 512 + r) * 256 + c4 * 4;
        *(f32x4*)(p.out + OFF_SWK + dofs) = *(const f32x4*)(p.cwk + so); *(f32x4*)(p.out + OFF_SWK + SZ_SWIN + dofs) = *(const f32x4*)(p.cwv + so); }
}
__device__ __forceinline__ void ph_final_norm(const Params& p, int bid, int G, int tid) {
    const int lane = tid & 63, wave = tid >> 6, gw = bid * 8 + wave, NGW = G * 8;
    for (int row = gw; row < NTOK; row += NGW) {
        float* yr = row < NPT ? p.out + OFF_Y + (size_t)row * DM : p.out + OFF_YS + (size_t)(row - NPT) * DM;
        const float r = rsqrtf(p.SUMSQ3[row] * (1.f / DM) + EPS);
        f32x4* y4 = (f32x4*)yr + lane; const f32x4* g4 = (const f32x4*)p.norm_f + lane;
#pragma unroll
        for (int j = 0; j < 8; ++j) { f32x4 v = y4[64 * j]; const f32x4 g = g4[64 * j]; v = v * r * g; y4[64 * j] = v; }
    }
}

__device__ __forceinline__ unsigned pk2t(float lo, float hi) { return pk2(lo, hi); }
template <bool IS_S>
__device__ __forceinline__ void cmp_gemm_tile(const Params& p, LAS unsigned char* lds, int tile, int tid) {
    const int lane = tid & 63, wave = __builtin_amdgcn_readfirstlane(tid >> 6), wm = wave >> 2, wn = wave & 3, fr = lane & 15, fg = lane >> 4;
    int kv, b, ct = 0, g = 0;
    if (IS_S) { ct = tile & 31; b = (tile >> 5) & 7; kv = tile >> 8; } else { g = tile & 3; b = (tile >> 2) & 3; kv = tile >> 4; }
    const bf16_t* W = p.W1T + (size_t)kv * 256 * 1024;
    const float* asf[4]; const bf16_t* asb[4];
#pragma unroll
    for (int q = 0; q < 4; ++q) { const int i = q * 32 + (tid >> 4), d4 = (tid & 15) * 4;
        if (IS_S) { const int cl = i >> 2, gg = i & 3, c = 32 * ct + cl; const int page = p.page_table[b * NPAGES + (c >> 3)];
            asf[q] = (kv ? p.ccv : p.cck) + (((size_t)page * PAGE + (c & 7) * 16) * 4 + gg) * 64 + d4; asb[q] = nullptr; }
        else { asb[q] = p.KV6 + ((size_t)(b * SEQ + 16 * i)) * 1536 + kv * 256 + g * 64 + d4; asf[q] = nullptr; } }
    const bf16_t* bsrc = W + (size_t)(tid >> 3) * 1024 + (tid & 7) * 8;
    f32x4 ra[4]; v2u rab[4]; v4u rb[4];
    auto load_regs = [&](int r) {
#pragma unroll
        for (int q = 0; q < 4; ++q) { if (IS_S) ra[q] = *(const f32x4*)(asf[q] + (size_t)r * 256); else rab[q] = *(const v2u*)(asb[q] + (size_t)r * 1536);
            rb[q] = *(const v4u*)(bsrc + (size_t)q * 64 * 1024 + r * 64); } };
    auto write_lds = [&](int s) { LAS unsigned char* ab = lds + s * 55296; LAS unsigned char* bb = ab + 18432;
#pragma unroll
        for (int q = 0; q < 4; ++q) { const int i = q * 32 + (tid >> 4), d4 = (tid & 15) * 4; v2u w;
            if (IS_S) { w.x = pk2(ra[q][0], ra[q][1]); w.y = pk2(ra[q][2], ra[q][3]); } else w = rab[q];
            *(LAS v2u*)(ab + i * 144 + d4 * 2) = w;
            *(LAS v4u*)(bb + (q * 64 + (tid >> 3)) * 144 + (tid & 7) * 16) = rb[q]; } };
    f32x4 acc[4][4];
#pragma unroll
    for (int mi = 0; mi < 4; ++mi)
#pragma unroll
        for (int ni = 0; ni < 4; ++ni) acc[mi][ni] = (f32x4){0.f, 0.f, 0.f, 0.f};
    load_regs(0); write_lds(0); __syncthreads();
    for (int r = 0; r < 16; ++r) {
        if (r + 1 < 16) load_regs(r + 1);
        const LAS unsigned char* ab = lds + (r & 1) * 55296; const LAS unsigned char* bb = ab + 18432;
#pragma unroll
        for (int ks = 0; ks < 2; ++ks) { bf16x8_t af[4], bfr[4];
#pragma unroll
            for (int mi = 0; mi < 4; ++mi) af[mi] = *(const LAS bf16x8_t*)(ab + (64 * wm + 16 * mi + fr) * 144 + (32 * ks + 8 * fg) * 2);
#pragma unroll
            for (int ni = 0; ni < 4; ++ni) bfr[ni] = *(const LAS bf16x8_t*)(bb + (64 * wn + 16 * ni + fr) * 144 + (32 * ks + 8 * fg) * 2);
#pragma unroll
            for (int mi = 0; mi < 4; ++mi)
#pragma unroll
                for (int ni = 0; ni < 4; ++ni) acc[mi][ni] = __builtin_amdgcn_mfma_f32_16x16x32_bf16(bfr[ni], af[mi], acc[mi][ni], 0, 0, 0); }
        if (r + 1 < 16) write_lds((r + 1) & 1);
        __syncthreads();
    }
    float* AB = IS_S ? p.AB_S + (size_t)kv * 32768 * 256 : p.AB_P + (size_t)kv * 2048 * 256;
#pragma unroll
    for (int mi = 0; mi < 4; ++mi) { const int i = 64 * wm + 16 * mi + fr; size_t R;
        if (IS_S) R = (size_t)(b * 4 + (i & 3)) * 1024 + 32 * ct + (i >> 2); else R = (size_t)(b * 4 + g) * 128 + i;
#pragma unroll
        for (int ni = 0; ni < 4; ++ni) *(f32x4*)(AB + R * 256 + 64 * wn + 16 * ni + 4 * fg) = acc[mi][ni]; }
}
template <bool IS_S>
__device__ __forceinline__ void cmp_part2(const Params& p, LAS unsigned char* lds, int kv, int bg, int i0, int tid) {
    constexpr int n_cmp = IS_S ? 1023 : 127, nrs = IS_S ? 1024 : 128;
    const int lane = tid & 63, wave = __builtin_amdgcn_readfirstlane(tid >> 6), fr = lane & 15, fg = lane >> 4;
    const float* AB = (IS_S ? p.AB_S + (size_t)kv * 32768 * 256 : p.AB_P + (size_t)kv * 2048 * 256) + (size_t)bg * nrs * 256;
    LAS unsigned char* H = lds; LAS unsigned char* W2T = lds + 128 * 272;
    const float* w2 = kv ? p.w2v : p.w2k; const float* bias = p.BIAS1 + kv * 128;
    for (int idx = tid; idx < 128 * 32; idx += 512) { const int row = idx >> 5, j4 = (idx & 31) * 4, i = i0 + row; v2u w; w.x = 0u; w.y = 0u;
        if (i < n_cmp) { const f32x4 a = *(const f32x4*)(AB + (size_t)i * 256 + j4), bq = *(const f32x4*)(AB + (size_t)(i + 1) * 256 + 128 + j4), bi = *(const f32x4*)(bias + j4);
            const f32x4 h = a + bq + bi; w.x = pk2(gelu_tanh(h[0]), gelu_tanh(h[1])); w.y = pk2(gelu_tanh(h[2]), gelu_tanh(h[3])); }
        *(LAS v2u*)(H + row * 272 + j4 * 2) = w; }
    for (int idx = tid; idx < 8192; idx += 512) { const int j = idx >> 6, d = idx & 63; *(LAS bf16_t*)(W2T + d * 272 + j * 2) = f2bf(w2[idx]); }
    __syncthreads();
    f32x4 acc[4];
#pragma unroll
    for (int ni = 0; ni < 4; ++ni) acc[ni] = (f32x4){0.f, 0.f, 0.f, 0.f};
#pragma unroll
    for (int ks = 0; ks < 4; ++ks) { const bf16x8_t hb = *(const LAS bf16x8_t*)(H + (16 * wave + fr) * 272 + (32 * ks + 8 * fg) * 2);
#pragma unroll
        for (int ni = 0; ni < 4; ++ni) { const bf16x8_t wa = *(const LAS bf16x8_t*)(W2T + (16 * ni + fr) * 272 + (32 * ks + 8 * fg) * 2);
            acc[ni] = __builtin_amdgcn_mfma_f32_16x16x32_bf16(wa, hb, acc[ni], 0, 0, 0); } }
    const int i = i0 + 16 * wave + fr;
    if (i < nrs) {
#pragma unroll
        for (int ni = 0; ni < 4; ++ni) { const int d = 16 * ni + 4 * fg;
            if (IS_S) { v2u w; w.x = pk2(acc[ni][0], acc[ni][1]); w.y = pk2(acc[ni][2], acc[ni][3]); *(v2u*)((kv ? p.VCMP_S : p.KCMP_S) + ((size_t)bg * 1024 + i) * 64 + d) = w; }
            else if (kv == 0) { v2u w; w.x = pk2(acc[ni][0], acc[ni][1]); w.y = pk2(acc[ni][2], acc[ni][3]); *(v2u*)(p.KCMP_P + ((size_t)bg * 128 + i) * 64 + d) = w; }
            else {
#pragma unroll
                for (int r = 0; r < 4; ++r) p.VCMPT_P[((size_t)bg * 64 + d + r) * 128 + i] = f2bf(acc[ni][r]); } } }
    __syncthreads();
}
__device__ __forceinline__ void ph_pro0(const Params& p, LAS unsigned char* lds, int bid, int G, int tid) {
    const int lane = tid & 63, wave = tid >> 6, gw = bid * 8 + wave, NGW = G * 8;
    LAS float* scr = (LAS float*)(lds + wave * 16384);
    for (int it = gw; it < 4 * 64; it += NGW) { const int q = it >> 6, r = it & 63, kv = q >> 1, half = q & 1;
        transpose_item((kv ? p.w1v : p.w1k) + (size_t)half * 1024 * 128, 128, nullptr, p.W1T + ((size_t)kv * 256 + half * 128) * 1024, 1024, r, 4, CM_id{}, scr, lane); }
    for (int i = bid * 512 + tid; i < NTOK; i += G * 512) { p.SUMSQ2[i] = 0.f; p.SUMSQ3[i] = 0.f; }
    __syncthreads();
    for (int it = bid; it < 4; it += G) { const int kv = it >> 1, jh = it & 1, j = jh * 64 + (tid & 63), ks = tid >> 6;
        const float* pe = kv ? p.pe_v : p.pe_k; const float* w1 = kv ? p.w1v : p.w1k; float s = 0.f;
        for (int k = ks * 256; k < ks * 256 + 256; ++k) s += pe[k] * w1[(size_t)k * 128 + j];
        LAS float* red = (LAS float*)lds; red[tid] = s; __syncthreads();
        if (tid < 64) { float t = 0.f; for (int w = 0; w < 8; ++w) t += red[w * 64 + tid]; p.BIAS1[kv * 128 + j] = t; }
        __syncthreads(); }
}

constexpr int GL_BC = 0, GL_SEG = 32768, GL_QT = 34816, GL_KT = GL_QT + 64 * 272, GL_AM = GL_KT + 64 * 272, GL_VT = GL_AM + 64 * 144, GL_SSQ = GL_VT + 256 * 144, GL_END = GL_SSQ + 2048;
static_assert(GL_END <= 131072, "gla lds");
__device__ __forceinline__ void gla_gates(const Params& p, LAS unsigned char* lds, int row0, int h, int tid) {
    LAS float* BC = (LAS float*)(lds + GL_BC); LAS float* SEG = (LAS float*)(lds + GL_SEG);
    const int d = tid & 127, cq = tid >> 7;
    float wa[16];
#pragma unroll
    for (int r = 0; r < 16; ++r) wa[r] = p.w_a2[r * 512 + h * 128 + d];
    const float ba = p.b_a[h * 128 + d];
    float run = 0.f;
    for (int cc = 0; cc < 16; ++cc) { const int c = cq * 16 + cc; const f32x4* lr = (const f32x4*)(p.LR + (size_t)(row0 + c) * 16);
        const f32x4 l0 = lr[0], l1 = lr[1], l2 = lr[2], l3 = lr[3];
        float x = ba + (l0[0] * wa[0] + l0[1] * wa[1] + l0[2] * wa[2] + l0[3] * wa[3]) + (l1[0] * wa[4] + l1[1] * wa[5] + l1[2] * wa[6] + l1[3] * wa[7])
                     + (l2[0] * wa[8] + l2[1] * wa[9] + l2[2] * wa[10] + l2[3] * wa[11]) + (l3[0] * wa[12] + l3[1] * wa[13] + l3[2] * wa[14] + l3[3] * wa[15]);
        run += logsigmoidf_(x) * (1.f / 16.f); BC[c * 128 + d] = run; }
    SEG[cq * 128 + d] = run;
    __syncthreads();
    float pre = 0.f;
    for (int q = 0; q < cq; ++q) pre += SEG[q * 128 + d];
    if (cq > 0) for (int cc = 0; cc < 16; ++cc) BC[(cq * 16 + cc) * 128 + d] += pre;
    __syncthreads();
}
__device__ __forceinline__ void gla_load_vt(const Params& p, LAS unsigned char* lds, int row0, int h, int tid) {
    LAS bf16_t* VT = (LAS bf16_t*)(lds + GL_VT);
    const int e8 = (tid & 31) * 8;
#pragma unroll
    for (int q = 0; q < 4; ++q) { const int c = (tid >> 5) + 16 * q; const v4u v = *(const v4u*)(p.GV + (size_t)(row0 + c) * 1024 + h * 256 + e8);
        VT[(e8 + 0) * 72 + c] = (bf16_t)(v.x & 0xffff); VT[(e8 + 1) * 72 + c] = (bf16_t)(v.x >> 16); VT[(e8 + 2) * 72 + c] = (bf16_t)(v.y & 0xffff); VT[(e8 + 3) * 72 + c] = (bf16_t)(v.y >> 16);
        VT[(e8 + 4) * 72 + c] = (bf16_t)(v.z & 0xffff); VT[(e8 + 5) * 72 + c] = (bf16_t)(v.z >> 16); VT[(e8 + 6) * 72 + c] = (bf16_t)(v.w & 0xffff); VT[(e8 + 7) * 72 + c] = (bf16_t)(v.w >> 16); }
}
__device__ __forceinline__ void gla_pass_a(const Params& p, LAS unsigned char* lds, int item, int tid) {
    const int bh = item >> 5, n = item & 31, b = bh >> 2, h = bh & 3, row0 = b * SEQ + n * 64;
    const int lane = tid & 63, wave = __builtin_amdgcn_readfirstlane(tid >> 6), fr = lane & 15, fg = lane >> 4;
    gla_gates(p, lds, row0, h, tid);
    const LAS float* BC = (const LAS float*)(lds + GL_BC);
    LAS bf16_t* KST = (LAS bf16_t*)(lds + GL_QT);
    gla_load_vt(p, lds, row0, h, tid);
    { const int d8 = (tid & 15) * 8;
#pragma unroll
      for (int q = 0; q < 2; ++q) { const int c = (tid >> 4) + 32 * q; const v4u kk = *(const v4u*)(p.GK + (size_t)(row0 + c) * 512 + h * 128 + d8);
          const unsigned wv[4] = {kk.x, kk.y, kk.z, kk.w};
#pragma unroll
          for (int i = 0; i < 8; ++i) { const int d = d8 + i; const float kx = bf2f((bf16_t)((wv[i >> 1] >> ((i & 1) * 16)) & 0xffff));
              KST[d * 72 + c] = f2bf(kx * __expf(BC[63 * 128 + d] - BC[c * 128 + d])); } } }
    if (tid < 128) p.DEC[((size_t)bh * 32 + n) * 128 + tid] = __expf(BC[63 * 128 + tid]);
    __syncthreads();
    const LAS unsigned char* VTb = lds + GL_VT; const LAS unsigned char* KSb = lds + GL_QT;
    f32x4 acc[8][2];
#pragma unroll
    for (int mb = 0; mb < 8; ++mb) { acc[mb][0] = (f32x4){0.f, 0.f, 0.f, 0.f}; acc[mb][1] = (f32x4){0.f, 0.f, 0.f, 0.f}; }
#pragma unroll
    for (int ks = 0; ks < 2; ++ks) { bf16x8_t vb[2];
#pragma unroll
        for (int nb = 0; nb < 2; ++nb) vb[nb] = *(const LAS bf16x8_t*)(VTb + (32 * wave + 16 * nb + fr) * 144 + (32 * ks + 8 * fg) * 2);
#pragma unroll
        for (int mb = 0; mb < 8; ++mb) { const bf16x8_t ka = *(const LAS bf16x8_t*)(KSb + (16 * mb + fr) * 144 + (32 * ks + 8 * fg) * 2);
            acc[mb][0] = __builtin_amdgcn_mfma_f32_16x16x32_bf16(ka, vb[0], acc[mb][0], 0, 0, 0); acc[mb][1] = __builtin_amdgcn_mfma_f32_16x16x32_bf16(ka, vb[1], acc[mb][1], 0, 0, 0); } }
    float* U = p.UT + ((size_t)bh * 32 + n) * 256 * 128;
#pragma unroll
    for (int nb = 0; nb < 2; ++nb) { const int e = 32 * wave + 16 * nb + fr;
#pragma unroll
        for (int mb = 0; mb < 8; ++mb) *(f32x4*)(U + (size_t)e * 128 + 16 * mb + 4 * fg) = acc[mb][nb]; }
    __syncthreads();
}
__device__ __forceinline__ void gla_pass_b(const Params& p, int bid, int G, int tid) {
    for (int idx = bid * 512 + tid; idx < 16 * 256 * 32; idx += G * 512) { const int d4 = (idx & 31) * 4, e = (idx >> 5) & 255, bh = idx >> 13;
        f32x4 S = {0.f, 0.f, 0.f, 0.f};
        const float* U = p.UT + (size_t)bh * 32 * 256 * 128 + (size_t)e * 128 + d4; const float* D = p.DEC + (size_t)bh * 32 * 128 + d4;
        bf16_t* SN = p.SNT + (size_t)bh * 32 * 256 * 128 + (size_t)e * 128 + d4;
#pragma unroll 8
        for (int n = 0; n < 32; ++n) { const f32x4 u = *(const f32x4*)(U + (size_t)n * 256 * 128); const f32x4 dc = *(const f32x4*)(D + n * 128);
            v2u w; w.x = pk2(S[0], S[1]); w.y = pk2(S[2], S[3]); *(v2u*)(SN + (size_t)n * 256 * 128) = w;
            S = dc * S + u; }
        float* so = p.out + OFF_PGLA + ((size_t)bh * 128 + d4) * 256 + e;
        so[0] = S[0]; so[256] = S[1]; so[512] = S[2]; so[768] = S[3]; }
}
__device__ __forceinline__ void gla_pass_c(const Params& p, LAS unsigned char* lds, int item, int tid) {
    const int bh = item >> 5, n = item & 31, b = bh >> 2, h = bh & 3, row0 = b * SEQ + n * 64;
    const int lane = tid & 63, wave = __builtin_amdgcn_readfirstlane(tid >> 6), fr = lane & 15, fg = lane >> 4;
    gla_gates(p, lds, row0, h, tid);
    const LAS float* BC = (const LAS float*)(lds + GL_BC);
    LAS unsigned char* QTb = lds + GL_QT; LAS unsigned char* KTb = lds + GL_KT; LAS unsigned char* AMb = lds + GL_AM; const LAS unsigned char* VTb = lds + GL_VT;
    gla_load_vt(p, lds, row0, h, tid);
    { const int d8 = (tid & 15) * 8;
#pragma unroll
      for (int q = 0; q < 2; ++q) { const int c = (tid >> 4) + 32 * q; const v4u qq = *(const v4u*)(p.GQ + (size_t)(row0 + c) * 512 + h * 128 + d8), kk = *(const v4u*)(p.GK + (size_t)(row0 + c) * 512 + h * 128 + d8);
          const unsigned qv[4] = {qq.x, qq.y, qq.z, qq.w}, kw[4] = {kk.x, kk.y, kk.z, kk.w}; unsigned qo[4], ko[4];
#pragma unroll
          for (int i = 0; i < 4; ++i) { const float b0 = BC[c * 128 + d8 + 2 * i], b1 = BC[c * 128 + d8 + 2 * i + 1]; const float e0 = __expf(b0), e1 = __expf(b1);
              qo[i] = pk2(bf2f((bf16_t)(qv[i] & 0xffff)) * e0, bf2f((bf16_t)(qv[i] >> 16)) * e1);
              ko[i] = pk2(bf2f((bf16_t)(kw[i] & 0xffff)) / e0, bf2f((bf16_t)(kw[i] >> 16)) / e1); }
          *(LAS v4u*)(QTb + c * 272 + d8 * 2) = (v4u){qo[0], qo[1], qo[2], qo[3]}; *(LAS v4u*)(KTb + c * 272 + d8 * 2) = (v4u){ko[0], ko[1], ko[2], ko[3]}; } }
    __syncthreads();
    { const int sb = wave >> 1;
#pragma unroll
      for (int u = 0; u < 2; ++u) { const int cb = 2 * (wave & 1) + u; f32x4 a = {0.f, 0.f, 0.f, 0.f};
          if (sb <= cb) {
#pragma unroll
              for (int ks = 0; ks < 4; ++ks) { const bf16x8_t ka = *(const LAS bf16x8_t*)(KTb + (16 * sb + fr) * 272 + (32 * ks + 8 * fg) * 2); const bf16x8_t qb = *(const LAS bf16x8_t*)(QTb + (16 * cb + fr) * 272 + (32 * ks + 8 * fg) * 2);
                  a = __builtin_amdgcn_mfma_f32_16x16x32_bf16(ka, qb, a, 0, 0, 0); } }
          const int c = 16 * cb + fr, s0 = 16 * sb + 4 * fg;
          v2u w; w.x = pk2(s0 <= c ? a[0] : 0.f, s0 + 1 <= c ? a[1] : 0.f); w.y = pk2(s0 + 2 <= c ? a[2] : 0.f, s0 + 3 <= c ? a[3] : 0.f);
          *(LAS v2u*)(AMb + c * 144 + s0 * 2) = w; } }
    __syncthreads();
    f32x4 acc[2][4];
#pragma unroll
    for (int eb = 0; eb < 2; ++eb)
#pragma unroll
        for (int cb = 0; cb < 4; ++cb) acc[eb][cb] = (f32x4){0.f, 0.f, 0.f, 0.f};
    const bf16_t* SN = p.SNT + ((size_t)bh * 32 + n) * 256 * 128;
#pragma unroll
    for (int ks = 0; ks < 4; ++ks) { bf16x8_t sa[2], qb[4];
#pragma unroll
        for (int eb = 0; eb < 2; ++eb) sa[eb] = *(const bf16x8_t*)(SN + (size_t)(32 * wave + 16 * eb + fr) * 128 + 32 * ks + 8 * fg);
#pragma unroll
        for (int cb = 0; cb < 4; ++cb) qb[cb] = *(const LAS bf16x8_t*)(QTb + (16 * cb + fr) * 272 + (32 * ks + 8 * fg) * 2);
#pragma unroll
        for (int eb = 0; eb < 2; ++eb)
#pragma unroll
            for (int cb = 0; cb < 4; ++cb) acc[eb][cb] = __builtin_amdgcn_mfma_f32_16x16x32_bf16(sa[eb], qb[cb], acc[eb][cb], 0, 0, 0); }
#pragma unroll
    for (int ks = 0; ks < 2; ++ks) { bf16x8_t va[2], ab[4];
#pragma unroll
        for (int eb = 0; eb < 2; ++eb) va[eb] = *(const LAS bf16x8_t*)(VTb + (32 * wave + 16 * eb + fr) * 144 + (32 * ks + 8 * fg) * 2);
#pragma unroll
        for (int cb = 0; cb < 4; ++cb) ab[cb] = *(const LAS bf16x8_t*)(AMb + (16 * cb + fr) * 144 + (32 * ks + 8 * fg) * 2);
#pragma unroll
        for (int eb = 0; eb < 2; ++eb)
#pragma unroll
            for (int cb = 0; cb < 4; ++cb) acc[eb][cb] = __builtin_amdgcn_mfma_f32_16x16x32_bf16(va[eb], ab[cb], acc[eb][cb], 0, 0, 0); }
    LAS float* SSQ = (LAS float*)(lds + GL_SSQ);
#pragma unroll
    for (int cb = 0; cb < 4; ++cb) { float s = 0.f;
#pragma unroll
        for (int eb = 0; eb < 2; ++eb) s += (acc[eb][cb][0] * acc[eb][cb][0] + acc[eb][cb][1] * acc[eb][cb][1]) + (acc[eb][cb][2] * acc[eb][cb][2] + acc[eb][cb][3] * acc[eb][cb][3]);
        s += __shfl_xor(s, 16); s += __shfl_xor(s, 32);
        if (fg == 0) SSQ[wave * 64 + 16 * cb + fr] = s; }
    __syncthreads();
#pragma unroll
    for (int cb = 0; cb < 4; ++cb) { const int c = 16 * cb + fr; float s = 0.f;
#pragma unroll
        for (int w = 0; w < 8; ++w) s += SSQ[w * 64 + c];
        const float rs = rsqrtf(s * (1.f / 256.f) + EPS);
#pragma unroll
        for (int eb = 0; eb < 2; ++eb) { const int e = 32 * wave + 16 * eb + 4 * fg; const f32x4 gn = *(const f32x4*)(p.gnorm + e);
            const v2u rr = *(const v2u*)(p.GR + (size_t)(row0 + c) * 1024 + h * 256 + e);
            const float o0 = acc[eb][cb][0] * rs * gn[0] * bf2f((bf16_t)(rr.x & 0xffff)), o1 = acc[eb][cb][1] * rs * gn[1] * bf2f((bf16_t)(rr.x >> 16));
            const float o2 = acc[eb][cb][2] * rs * gn[2] * bf2f((bf16_t)(rr.y & 0xffff)), o3 = acc[eb][cb][3] * rs * gn[3] * bf2f((bf16_t)(rr.y >> 16));
            v2u w; w.x = pk2(o0, o1); w.y = pk2(o2, o3); *(v2u*)(p.OB + (size_t)(row0 + c) * 1024 + h * 256 + e) = w; } }
    __syncthreads();
}
__device__ __forceinline__ void gla_sample_item(const Params& p, LAS unsigned char* lds, int item, int tid) {
    const int b = item >> 2, h = item & 3, e = tid & 255, half = tid >> 8, row = NPT + b;
    LAS float* a_s = (LAS float*)lds; LAS float* q_s = a_s + 128; LAS float* k_s = q_s + 128; LAS float* part = k_s + 128; LAS float* red = part + 512;
    if (tid < 128) { float x = p.b_a[h * 128 + tid];
        for (int r = 0; r < 16; ++r) x += p.LR[(size_t)row * 16 + r] * p.w_a2[r * 512 + h * 128 + tid];
        a_s[tid] = __expf(logsigmoidf_(x) * (1.f / 16.f)); q_s[tid] = bf2f(p.GQ[(size_t)row * 512 + h * 128 + tid]); k_s[tid] = bf2f(p.GK[(size_t)row * 512 + h * 128 + tid]); }
    const float v = bf2f(p.GV[(size_t)row * 1024 + h * 256 + e]);
    __syncthreads();
    float po = 0.f; const float* s0 = p.state + (((size_t)b * 4 + h) * 128 + half * 64) * 256 + e; float* so = p.out + OFF_SGLA + (((size_t)b * 4 + h) * 128 + half * 64) * 256 + e;
#pragma unroll 8
    for (int dd = 0; dd < 64; ++dd) { const int d = half * 64 + dd; const float s = a_s[d] * s0[(size_t)dd * 256] + k_s[d] * v; so[(size_t)dd * 256] = s; po += q_s[d] * s; }
    part[half * 256 + e] = po;
    __syncthreads();
    float o = 0.f;
    if (tid < 256) { o = part[e] + part[256 + e]; const float ss = wave_sum(o * o); if ((tid & 63) == 0) red[tid >> 6] = ss; }
    __syncthreads();
    if (tid < 256) { const float ss = (red[0] + red[1]) + (red[2] + red[3]); const float r = rsqrtf(ss * (1.f / 256.f) + EPS);
        p.OB[(size_t)row * 1024 + h * 256 + e] = f2bf(o * r * p.gnorm[e] * bf2f(p.GR[(size_t)row * 1024 + h * 256 + e])); }
    __syncthreads();
}

typedef float f32x16 __attribute__((ext_vector_type(16)));
typedef float f32x2_t __attribute__((ext_vector_type(2)));
typedef __bf16 bf16x2_t __attribute__((ext_vector_type(2)));
__device__ __forceinline__ unsigned cvtpk(float lo, float hi) { f32x2_t v = {lo, hi}; bf16x2_t b = __builtin_convertvector(v, bf16x2_t); return __builtin_bit_cast(unsigned, b); }
constexpr int NS_STAGE = 17920, NS_KOFF = 0, NS_VOFF = 9216, NS_PCS = 35840, NS_SC = NS_PCS + 32768, NS_OUT = NS_PCS  , NS_SEL = NS_OUT + 256 * 272, NS_END = NS_SEL + 256;
static_assert(NS_END <= 131072, "nsa lds");
constexpr float LOG2E = 1.4426950408889634f, NEGBIG = -1e30f;
__device__ __forceinline__ int crow(int r, int hh) { return (r & 3) + 8 * (r >> 2) + 4 * hh; }

__device__ __forceinline__ void nsa_vt_tile(const Params& p, LAS unsigned char* scr  , int item, int lane) {
    const int tt = item & 31, bg = (item >> 5) & 15, which = item >> 9, b = bg >> 2, g = bg & 3;
    const bf16_t* src = p.KV6 + (size_t)(b * SEQ + tt * 64) * 1536 + (which ? 5 : 3) * 256 + g * 64;
    LAS bf16_t* TT = (LAS bf16_t*)scr;
    const int ch = lane & 7, r0 = lane >> 3;
#pragma unroll
    for (int q = 0; q < 8; ++q) { const int c = r0 + 8 * q; const v4u v = *(const v4u*)(src + (size_t)c * 1536 + ch * 8); const unsigned wv[4] = {v.x, v.y, v.z, v.w};
#pragma unroll
        for (int i = 0; i < 8; ++i) TT[(ch * 8 + i) * 72 + c] = (bf16_t)((wv[i >> 1] >> ((i & 1) * 16)) & 0xffff); }
    LDS_WAIT(); asm volatile("" ::: "memory");
    bf16_t* dst = (which ? p.VTW : p.VTS) + (size_t)bg * 64 * SEQ + tt * 64;
#pragma unroll
    for (int q = 0; q < 8; ++q) { const int d = r0 + 8 * q; const v4u v = *(const LAS v4u*)((LAS unsigned char*)scr + d * 144 + ch * 16); *(v4u*)(dst + (size_t)d * SEQ + ch * 8) = v; }
    LDS_WAIT(); asm volatile("" ::: "memory");
}

struct NsaState { float m, l; f32x16 o0, o1; };
template <int MODE  >
__device__ __forceinline__ void nsa_tile(const LAS unsigned char* st, const bf16x8_t (&q)[4], NsaState& s, int lo, int hi, int r32, int hh, LAS float* pcs = nullptr, int kbase = 0) {
    f32x16 s0 = {}, s1 = {};
    const LAS unsigned char* kb = st + NS_KOFF + r32 * 144 + hh * 16;
#pragma unroll
    for (int ks = 0; ks < 4; ++ks) { const bf16x8_t a0 = *(const LAS bf16x8_t*)(kb + ks * 32), a1 = *(const LAS bf16x8_t*)(kb + 32 * 144 + ks * 32);
        s0 = __builtin_amdgcn_mfma_f32_32x32x16_bf16(a0, q[ks], s0, 0, 0, 0); s1 = __builtin_amdgcn_mfma_f32_32x32x16_bf16(a1, q[ks], s1, 0, 0, 0); }
    const bool nomask = __all(lo <= 0 && hi >= 63);
    float tmax = NEGBIG;
    if (nomask) {
#pragma unroll
        for (int r = 0; r < 16; ++r) tmax = fmaxf(tmax, fmaxf(s0[r], s1[r]));
    } else {
#pragma unroll
        for (int r = 0; r < 16; ++r) { const int k0 = crow(r, hh), k1 = k0 + 32; if (!(k0 >= lo && k0 <= hi)) s0[r] = NEGBIG; if (!(k1 >= lo && k1 <= hi)) s1[r] = NEGBIG; tmax = fmaxf(tmax, fmaxf(s0[r], s1[r])); }
    }
    __builtin_amdgcn_sched_barrier(0);
    if (MODE == 2) {
        const float mL = s.m * LOG2E, inv = s.l;
#pragma unroll
        for (int r = 0; r < 16; ++r) { float p0 = __builtin_amdgcn_exp2f(s0[r] * LOG2E - mL) * inv, p1 = __builtin_amdgcn_exp2f(s1[r] * LOG2E - mL) * inv;
            if (!nomask) { if (s0[r] == NEGBIG) p0 = 0.f; if (s1[r] == NEGBIG) p1 = 0.f; }
            s0[r] = p0; s1[r] = p1; }
        if (pcs) {
#pragma unroll
            for (int r = 0; r < 16; ++r) { float v0 = s0[r], v1 = s1[r]; v0 += __shfl_xor(v0, 8); v1 += __shfl_xor(v1, 8); v0 += __shfl_xor(v0, 16); v1 += __shfl_xor(v1, 16);
                if ((r32 >> 3) == 0) { pcs[kbase + crow(r, hh)] = v0; pcs[kbase + 32 + crow(r, hh)] = v1; } } }
    } else {
        tmax = fmaxf(tmax, __shfl_xor(tmax, 32));
        const float mn = fmaxf(s.m, tmax), alpha = __builtin_amdgcn_exp2f((s.m - mn) * LOG2E), mL = mn * LOG2E;
        s.m = mn;
        float ps = 0.f;
#pragma unroll
        for (int r = 0; r < 16; ++r) { float p0 = __builtin_amdgcn_exp2f(s0[r] * LOG2E - mL), p1 = __builtin_amdgcn_exp2f(s1[r] * LOG2E - mL);
            if (!nomask) { if (s0[r] == NEGBIG) p0 = 0.f; if (s1[r] == NEGBIG) p1 = 0.f; }
            s0[r] = p0; s1[r] = p1; ps += p0 + p1; }
        s.l = s.l * alpha + ps;
        if (MODE == 1) return;
#pragma unroll
        for (int r = 0; r < 16; ++r) { s.o0[r] *= alpha; s.o1[r] *= alpha; }
    }
    __builtin_amdgcn_sched_barrier(0);
    const LAS unsigned char* vb = st + NS_VOFF + r32 * 136 + hh * 8;
#pragma unroll
    for (int blk = 0; blk < 2; ++blk)
#pragma unroll
        for (int sp = 0; sp < 2; ++sp) { const f32x16& pp = blk ? s1 : s0; const int rb = 8 * sp;
            v4u pw; pw.x = cvtpk(pp[rb + 0], pp[rb + 1]); pw.y = cvtpk(pp[rb + 2], pp[rb + 3]); pw.z = cvtpk(pp[rb + 4], pp[rb + 5]); pw.w = cvtpk(pp[rb + 6], pp[rb + 7]);
            const bf16x8_t pf = __builtin_bit_cast(bf16x8_t, pw);
            const int ko = (32 * blk + 16 * sp) * 2;
            const v2u a0l = *(const LAS v2u*)(vb + ko), a0h = *(const LAS v2u*)(vb + ko + 16), a1l = *(const LAS v2u*)(vb + 32 * 136 + ko), a1h = *(const LAS v2u*)(vb + 32 * 136 + ko + 16);
            const bf16x8_t v0 = __builtin_bit_cast(bf16x8_t, (v4u){a0l.x, a0l.y, a0h.x, a0h.y}), v1 = __builtin_bit_cast(bf16x8_t, (v4u){a1l.x, a1l.y, a1h.x, a1h.y});
            s.o0 = __builtin_amdgcn_mfma_f32_32x32x16_bf16(v0, pf, s.o0, 0, 0, 0); s.o1 = __builtin_amdgcn_mfma_f32_32x32x16_bf16(v1, pf, s.o1, 0, 0, 0); }
}
template <bool FIRST>
__device__ __forceinline__ void nsa_finish(NsaState& s, float gate, LAS float* outp) {
    const float lt = s.l + __shfl_xor(s.l, 32); const float sc = lt > 0.f ? gate / lt : 0.f;
#pragma unroll
    for (int k = 0; k < 4; ++k) { f32x4 a = {s.o0[4 * k], s.o0[4 * k + 1], s.o0[4 * k + 2], s.o0[4 * k + 3]}, c = {s.o1[4 * k], s.o1[4 * k + 1], s.o1[4 * k + 2], s.o1[4 * k + 3]};
        a = a * sc; c = c * sc;
        if (!FIRST) { a = a + *(const LAS f32x4*)(outp + 8 * k); c = c + *(const LAS f32x4*)(outp + 32 + 8 * k); }
        *(LAS f32x4*)(outp + 8 * k) = a; *(LAS f32x4*)(outp + 32 + 8 * k) = c; }
    s.m = NEGBIG; s.l = 0.f; s.o0 = (f32x16){}; s.o1 = (f32x16){};
}

__device__ __forceinline__ void nsa_prompt_item(const Params& p, LAS unsigned char* lds, int bg, int qi, int tid) {
    const int lane = tid & 63, wave = __builtin_amdgcn_readfirstlane(tid >> 6), r32 = lane & 31, hh = lane >> 5;
    const int b = bg >> 2, g = bg & 3, tl = 8 * wave + (r32 & 7), hd = r32 >> 3, t = 64 * qi + tl, row = b * SEQ + t;
    const int srow = tid >> 3, sch = tid & 7;
    v4u rk, rv;
    auto issue = [&](const bf16_t* kbase, size_t kstride, const bf16_t* vbase, size_t vstride) { rk = *(const v4u*)(kbase + (size_t)srow * kstride + sch * 8); rv = *(const v4u*)(vbase + (size_t)srow * vstride + sch * 8); };
    auto commit = [&](int s) { LAS unsigned char* st = lds + s * NS_STAGE; *(LAS v4u*)(st + NS_KOFF + srow * 144 + sch * 16) = rk;
        *(LAS v2u*)(st + NS_VOFF + srow * 136 + sch * 16) = (v2u){rv.x, rv.y}; *(LAS v2u*)(st + NS_VOFF + srow * 136 + sch * 16 + 8) = (v2u){rv.z, rv.w}; };
    bf16x8_t q[4];
    { const bf16_t* qp = p.QN + (size_t)row * 1024 + (g * 4 + hd) * 64 + 8 * hh;
#pragma unroll
      for (int ks = 0; ks < 4; ++ks) q[ks] = *(const bf16x8_t*)(qp + 16 * ks); }
    const float g0 = p.GATE[(size_t)row * 48 + (g * 4 + hd) * 3 + 0], g1 = p.GATE[(size_t)row * 48 + (g * 4 + hd) * 3 + 1], g2 = p.GATE[(size_t)row * 48 + (g * 4 + hd) * 3 + 2];
    LAS float* outp = (LAS float*)(lds + NS_OUT) + (wave * 32 + r32) * 68 + 4 * hh;
    NsaState s; s.m = NEGBIG; s.l = 0.f; s.o0 = (f32x16){}; s.o1 = (f32x16){};
    const bf16_t* kc = p.KCMP_P + (size_t)bg * 128 * 64; const bf16_t* vct = p.VCMPT_P + (size_t)bg * 64 * 128;
    issue(kc, 64, vct, 128); commit(0); issue(kc + 64 * 64, 64, vct + 64, 128); commit(1);
    __syncthreads();
    const int limc = (t >= 31) ? ((t - 31) >> 4) : -1;
    {
        nsa_tile<1>(lds, q, s, 0, limc, r32, hh); nsa_tile<1>(lds + NS_STAGE, q, s, 0, limc - 64, r32, hh);
        const float lt = s.l + __shfl_xor(s.l, 32); s.l = lt > 0.f ? 1.f / lt : 0.f;
        LAS float* PCS = (LAS float*)(lds + NS_PCS) + tl * 128;
        nsa_tile<2>(lds, q, s, 0, limc, r32, hh, qi >= 16 ? PCS : nullptr, 0); nsa_tile<2>(lds + NS_STAGE, q, s, 0, limc - 64, r32, hh, qi >= 16 ? PCS : nullptr, 64);
        __syncthreads();
    }
    if (qi >= 16) {
        const LAS float* PCS = (const LAS float*)(lds + NS_PCS);
        LAS float* SCR = (LAS float*)(lds + NS_SC); LAS unsigned* SEL = (LAS unsigned*)(lds + NS_SEL);
        { const int tk = tid >> 3, jq = tid & 7;
#pragma unroll
          for (int u = 0; u < 4; ++u) { const int j = jq * 4 + u; float sm = 0.f;
#pragma unroll
              for (int o = 0; o < 5; ++o) { const int ki = 4 * j - 1 + o; if (ki >= 0 && ki < 127) sm += PCS[tk * 128 + ki]; }
              SCR[tk * 32 + j] = (j <= qi) ? sm + ((j == 0 || j == qi) ? 1e4f : 0.f) : NEGBIG; }
        }
        __syncthreads();
        { const int tk = tid >> 3, jq = tid & 7; unsigned bits = 0u;
#pragma unroll
          for (int u = 0; u < 4; ++u) { const int j = jq * 4 + u; const float sj = SCR[tk * 32 + j]; int rank = 0;
              for (int j2 = 0; j2 < 32; ++j2) { const float s2 = SCR[tk * 32 + j2]; rank += (s2 > sj || (s2 == sj && j2 < j)) ? 1 : 0; }
              if (rank < 16) bits |= 1u << j; }
          bits |= __shfl_xor(bits, 1); bits |= __shfl_xor(bits, 2); bits |= __shfl_xor(bits, 4);
          if (jq == 0) SEL[tk] = bits; }
        __syncthreads();
    }
    s.l = 0.5f; nsa_finish<true>(s, g0, outp);
    const unsigned selmask = (qi < 16) ? 0xffffffffu : ((LAS unsigned*)(lds + NS_SEL))[tl];
    const int wlo = qi > 8 ? qi - 8 : 0, nslc = qi + 1, nsteps = nslc + (qi - wlo + 1);
    const bf16_t* ksl = p.KV6 + (size_t)(b * SEQ) * 1536 + 2 * 256 + g * 64; const bf16_t* kwn = ksl + 2 * 256;
    const bf16_t* vsl = p.VTS + (size_t)bg * 64 * SEQ; const bf16_t* vwn = p.VTW + (size_t)bg * 64 * SEQ;
    auto issue_step = [&](int u) { if (u < nslc) issue(ksl + (size_t)(64 * u) * 1536, 1536, vsl + 64 * u, SEQ); else { const int j = wlo + (u - nslc); issue(kwn + (size_t)(64 * j) * 1536, 1536, vwn + 64 * j, SEQ); } };
    issue_step(0); commit(0); __syncthreads();
    for (int u = 0; u < nsteps; ++u) {
        if (u + 1 < nsteps) issue_step(u + 1);
        int lo = 0, hi = 63;
        if (u < nslc) { const int j = u; if (!((selmask >> j) & 1u)) hi = -1; else if (j == qi) hi = tl; }
        else { const int j = wlo + (u - nslc); if (j == qi) hi = tl; if (j == qi - 8) lo = tl; }
        if (u == nslc) nsa_finish<false>(s, g1, outp);
        nsa_tile<0>(lds + (u & 1) * NS_STAGE, q, s, lo, hi, r32, hh);
        if (u + 1 < nsteps) commit((u + 1) & 1);
        __syncthreads();
    }
    { const float lt = s.l + __shfl_xor(s.l, 32); const float sc = lt > 0.f ? g2 / lt : 0.f;
      bf16_t* op = p.OA + (size_t)row * 1024 + (g * 4 + hd) * 64 + 4 * hh;
#pragma unroll
      for (int k = 0; k < 4; ++k) { const f32x4 a = *(const LAS f32x4*)(outp + 8 * k), c = *(const LAS f32x4*)(outp + 32 + 8 * k);
          v2u w; w.x = cvtpk(a[0] + s.o0[4 * k] * sc, a[1] + s.o0[4 * k + 1] * sc); w.y = cvtpk(a[2] + s.o0[4 * k + 2] * sc, a[3] + s.o0[4 * k + 3] * sc); *(v2u*)(op + 8 * k) = w;
          v2u w1; w1.x = cvtpk(c[0] + s.o1[4 * k] * sc, c[1] + s.o1[4 * k + 1] * sc); w1.y = cvtpk(c[2] + s.o1[4 * k + 2] * sc, c[3] + s.o1[4 * k + 3] * sc); *(v2u*)(op + 32 + 8 * k) = w1; } }
}

constexpr int SS_Q = 0, SS_SC = 256, SS_PART = SS_SC + 4 * 1088, SS_REDM = SS_PART + 2048, SS_REDS = SS_REDM + 8, SS_GATE = SS_REDS + 8, SS_SCORE = SS_GATE + 16, SS_SEL = SS_SCORE + 272, SS_OACC = SS_SEL + 16, SS_END = SS_OACC + 256;
__device__ __forceinline__ void dot4h(const LAS float* q, int c4, const f32x4 kx, float (&acc)[4]) {
#pragma unroll
    for (int hd = 0; hd < 4; ++hd) { const f32x4 qv = *(const LAS f32x4*)(q + hd * 64 + c4); acc[hd] += (qv[0] * kx[0] + qv[1] * kx[1]) + (qv[2] * kx[2] + qv[3] * kx[3]); }
}
template <class KF, class VF>
__device__ __forceinline__ void nsa_s_branch(LAS float* L, int nk, KF keyf, VF valf, int gsel, int tid) {
    const int lane = tid & 63, wave = tid >> 6;
    LAS float* q = L + SS_Q; LAS float* sc = L + SS_SC; LAS float* part = L + SS_PART; LAS float* redm = L + SS_REDM; LAS float* reds = L + SS_REDS;
    for (int kk = tid; kk < nk; kk += 512) { bool valid; const RowRef r = keyf(kk, valid); float acc[4] = {0.f, 0.f, 0.f, 0.f};
        if (valid) {
            if (r.pf) {
#pragma unroll 4
                for (int c = 0; c < 16; ++c) dot4h(q, 4 * c, *(const f32x4*)(r.pf + 4 * c), acc);
            } else {
#pragma unroll 2
                for (int c = 0; c < 8; ++c) { const v4u w = *(const v4u*)(r.pb + 8 * c);
                    dot4h(q, 8 * c, (f32x4){bf2f((bf16_t)(w.x & 0xffff)), bf2f((bf16_t)(w.x >> 16)), bf2f((bf16_t)(w.y & 0xffff)), bf2f((bf16_t)(w.y >> 16))}, acc);
                    dot4h(q, 8 * c + 4, (f32x4){bf2f((bf16_t)(w.z & 0xffff)), bf2f((bf16_t)(w.z >> 16)), bf2f((bf16_t)(w.w & 0xffff)), bf2f((bf16_t)(w.w >> 16))}, acc); }
            }
        } else { acc[0] = -INFINITY; acc[1] = -INFINITY; acc[2] = -INFINITY; acc[3] = -INFINITY; }
        sc[kk] = acc[0]; sc[1088 + kk] = acc[1]; sc[2 * 1088 + kk] = acc[2]; sc[3 * 1088 + kk] = acc[3]; }
    __syncthreads();
    { const int hd = wave & 3, half = wave >> 2; LAS float* sh = sc + hd * 1088;
      float m = -INFINITY; for (int kk = half * 64 + lane; kk < nk; kk += 128) m = fmaxf(m, sh[kk]);
      m = wave_max(m); if (lane == 0) redm[wave] = m;
      __syncthreads();
      m = fmaxf(redm[hd], redm[hd + 4]); float sm = 0.f;
      for (int kk = half * 64 + lane; kk < nk; kk += 128) { const float x = sh[kk]; const float e = (x == -INFINITY) ? 0.f : __expf(x - m); sh[kk] = e; sm += e; }
      sm = wave_sum(sm); if (lane == 0) reds[wave] = sm;
      __syncthreads();
      const float tot = reds[hd] + reds[hd + 4]; const float inv = tot > 0.f ? 1.f / tot : 0.f;
      for (int kk = half * 64 + lane; kk < nk; kk += 128) sh[kk] *= inv; }
    __syncthreads();
    { const int chunk = (nk + 7) >> 3, k0 = wave * chunk, k1 = (k0 + chunk < nk) ? k0 + chunk : nk; float o0 = 0.f, o1 = 0.f, o2 = 0.f, o3 = 0.f;
#pragma unroll 8
      for (int kk = k0; kk < k1; ++kk) { const float v = valf(kk, lane); o0 += sc[kk] * v; o1 += sc[1088 + kk] * v; o2 += sc[2 * 1088 + kk] * v; o3 += sc[3 * 1088 + kk] * v; }
      part[(wave * 4 + 0) * 64 + lane] = o0; part[(wave * 4 + 1) * 64 + lane] = o1; part[(wave * 4 + 2) * 64 + lane] = o2; part[(wave * 4 + 3) * 64 + lane] = o3; }
    __syncthreads();
    if (tid < 256) { float o = 0.f;
#pragma unroll
        for (int w = 0; w < 8; ++w) o += part[w * 256 + tid];
        L[SS_OACC + tid] += L[SS_GATE + (tid >> 6) * 3 + gsel] * o; }
    __syncthreads();
}
__device__ __forceinline__ void nsa_sample_item(const Params& p, LAS unsigned char* lds, int item, int tid) {
    const int b = item >> 2, g = item & 3, bg = item, row = NPT + b;
    constexpr int pos = PAST, n_cmp = 1023, n_slc = 257;
    LAS float* L = (LAS float*)lds; LAS float* sc = L + SS_SC; LAS float* score = L + SS_SCORE; LAS int* selidx = (LAS int*)(L + SS_SEL);
    if (tid < 256) { L[SS_Q + tid] = bf2f(p.QN[(size_t)row * 1024 + g * 256 + tid]); L[SS_OACC + tid] = 0.f; }
    if (tid < 12) L[SS_GATE + tid] = p.GATE[(size_t)row * 48 + g * 12 + tid];
    __syncthreads();
    const bf16_t* kc = p.KCMP_S + (size_t)bg * 1024 * 64; const bf16_t* vc = p.VCMP_S + (size_t)bg * 1024 * 64;
    nsa_s_branch(L, n_cmp, [&](int kk, bool& valid) { valid = true; return RowRef{nullptr, kc + (size_t)kk * 64}; }, [&](int kk, int d) { return bf2f(vc[(size_t)kk * 64 + d]); }, 0, tid);
    for (int j = tid; j < n_slc; j += 512) { float s = 0.f;
        for (int i = 4 * j - 1; i <= 4 * j + 3; ++i) if (i >= 0 && i < n_cmp) s += (sc[i] + sc[1088 + i]) + (sc[2 * 1088 + i] + sc[3 * 1088 + i]);
        score[j] = s + ((j == 0 || j == pos / 64) ? 1e4f : 0.f); }
    __syncthreads();
    for (int j = tid; j < n_slc; j += 512) { const float sj = score[j]; int rank = 0;
        for (int j2 = 0; j2 < n_slc; ++j2) { const float s2 = score[j2]; rank += (s2 > sj || (s2 == sj && j2 < j)) ? 1 : 0; }
        if (rank < 16) selidx[rank] = j; }
    __syncthreads();
    const bf16_t* newrow = p.KV6 + (size_t)row * 1536 + g * 64;
    auto past_slc = [&](int kp, const float* cache) { const int page = p.page_table[b * NPAGES + (kp >> 7)]; return cache + (((size_t)page * PAGE + (kp & 127)) * 4 + g) * 64; };
    nsa_s_branch(L, 1024,
        [&](int kk, bool& valid) { const int kp = selidx[kk >> 6] * 64 + (kk & 63); valid = kp <= pos; return (kp < pos) ? RowRef{past_slc(kp, p.csk), nullptr} : RowRef{nullptr, newrow + 2 * 256}; },
        [&](int kk, int d) { int kp = selidx[kk >> 6] * 64 + (kk & 63); kp = kp < pos ? kp : pos; return (kp < pos) ? past_slc(kp, p.csv)[d] : bf2f(newrow[3 * 256 + d]); }, 1, tid);
    nsa_s_branch(L, 513,
        [&](int kk, bool& valid) { valid = true; return (kk < 512) ? RowRef{p.cwk + (((size_t)b * 512 + kk) * 4 + g) * 64, nullptr} : RowRef{nullptr, newrow + 4 * 256}; },
        [&](int kk, int d) { return (kk < 512) ? p.cwv[(((size_t)b * 512 + kk) * 4 + g) * 64 + d] : bf2f(newrow[5 * 256 + d]); }, 2, tid);
    if (tid < 256) p.OA[(size_t)row * 1024 + g * 256 + tid] = f2bf(L[SS_OACC + tid]);
    __syncthreads();
}

#define XB_TMO      128
#define XB_XCNT(j)  (256  + 64 * (j))
#define XB_XSUB(j)  (1280 + 64 * (j))
#define XB_XGEN(j)  (2304 + 64 * (j))
#define XB_TOP      3328
#define XB_TOPGEN   3392
#define XCD_BAR_WORDS 3456
#define XB_SPIN_CAP (1u << 22)

__device__ __forceinline__ unsigned xb_ld(unsigned* p)              { return __hip_atomic_load(p, __ATOMIC_RELAXED, __HIP_MEMORY_SCOPE_AGENT); }
__device__ __forceinline__ unsigned xb_add(unsigned* p, unsigned v) { return __hip_atomic_fetch_add(p, v, __ATOMIC_RELAXED, __HIP_MEMORY_SCOPE_AGENT); }
__device__ __forceinline__ unsigned xb_xcc_id() { return (unsigned)__builtin_amdgcn_s_getreg((3 << 11) | 20) & 0xFu; }
#define XB_SPIN(cond, bar) do { unsigned _sp = 0; while (cond) { __builtin_amdgcn_s_sleep(1); \
    if ((++_sp & 255u) == 0u) { if (xb_ld(&(bar)[XB_TMO])) break; if (_sp > XB_SPIN_CAP) { atomicAdd(&(bar)[XB_TMO], 1u); break; } } } } while (0)

struct XcdBarrier {
    unsigned* bar; unsigned x;
    volatile LAS unsigned* st;
};

__device__ __forceinline__ XcdBarrier xcd_barrier_post(unsigned* bar, volatile LAS unsigned* st) {
    XcdBarrier b; b.bar = bar; b.x = xb_xcc_id(); b.st = st;
    if (threadIdx.x == 0) (void)xb_add(&bar[XB_XCNT(b.x)], 1u);
    return b;
}
__device__ __forceinline__ void xcd_barrier_complete(unsigned* bar, unsigned x, unsigned& nloc, unsigned& nx) {
    const unsigned G = gridDim.x * gridDim.y * gridDim.z;
    unsigned sum, cnt, mine, sp = 0u;
    for (;;) {
        sum = 0u; cnt = 0u; mine = 0u;
#pragma unroll
        for (unsigned j = 0; j < 16; ++j) { const unsigned c = xb_ld(&bar[XB_XCNT(j)]); sum += c; cnt += (c > 0u) ? 1u : 0u; mine = (j == x) ? c : mine; }
        if (sum == G) break;
        __builtin_amdgcn_s_sleep(1);
        if ((++sp & 255u) == 0u) { if (xb_ld(&bar[XB_TMO])) break; if (sp > XB_SPIN_CAP) { atomicAdd(&bar[XB_TMO], 1u); break; } }
    }
    nloc = mine > 0u ? mine : 1u; nx = cnt > 0u ? cnt : 1u;
}

__device__ __forceinline__ void xcd_barrier(const XcdBarrier& b) {
    asm volatile("s_waitcnt vmcnt(0)" ::: "memory");
    __syncthreads();
    if (threadIdx.x == 0) {
        unsigned* bar = b.bar;
        __builtin_amdgcn_s_waitcnt(0);
        unsigned nloc = b.st[0], nx = b.st[1];
        if (nloc == 0u) { xcd_barrier_complete(bar, b.x, nloc, nx); b.st[0] = nloc; b.st[1] = nx; }
        const unsigned old = xb_add(&bar[XB_XSUB(b.x)], 1u);
        const unsigned gen = old / nloc;
        if (old + 1u == (gen + 1u) * nloc) {
            __builtin_amdgcn_fence(__ATOMIC_RELEASE, "agent");
            asm volatile("s_waitcnt vmcnt(0)" ::: "memory");
            const unsigned og = xb_add(&bar[XB_TOP], 1u);
            const unsigned tg = og / nx;
            if (og + 1u == (tg + 1u) * nx) xb_add(&bar[XB_TOPGEN], 1u);
            else XB_SPIN(xb_ld(&bar[XB_TOPGEN]) == tg, bar);
            __builtin_amdgcn_fence(__ATOMIC_ACQUIRE, "agent");
            xb_add(&bar[XB_XGEN(b.x)], 1u);
            asm volatile("s_waitcnt vmcnt(0)" ::: "memory");
        } else {
            XB_SPIN(xb_ld(&bar[XB_XGEN(b.x)]) == gen, bar);
            __builtin_amdgcn_fence(__ATOMIC_ACQUIRE, "agent");
            asm volatile("s_waitcnt vmcnt(0)" ::: "memory");
        }
    }
    __syncthreads();
}

constexpr int LDS_BYTES = 147456;
constexpr int LDSCTL_OFF = 131072, MISC_OFF = LDSCTL_OFF + 320;
constexpr int CW_BAR = 4096;
enum Phase { PH_PRO0 = 0, PH_PRO = 1, PH_IN = 2, PH_MID = 3, PH_ATT = 4, PH_BRA = 5, PH_BRB = 6, PH_WO = 7, PH_UP = 8, PH_DOWN = 9, PH_NORM = 10, PH_END = 11 };
__global__ void __launch_bounds__(512, 2) mk_fwd(Params p, int ph_lo, int ph_hi, int li) {
    extern __shared__ __attribute__((aligned(16))) unsigned char lds_raw[];
    LAS unsigned char* lds = (LAS unsigned char*)lds_raw;
    const int tid = threadIdx.x, bid = blockIdx.x, G = gridDim.x;
    for (int u = tid; u < (LDS_BYTES - LDSCTL_OFF) / 4; u += 512) ((LAS unsigned*)(lds + LDSCTL_OFF))[u] = 0u;
    __syncthreads();
    XcdBarrier bar; bar.bar = p.CTL + CW_BAR + li * XCD_BAR_WORDS; bar.x = 0; bar.st = nullptr;
    if (ph_hi - ph_lo > 1) bar = xcd_barrier_post(p.CTL + CW_BAR + li * XCD_BAR_WORDS, (volatile LAS unsigned*)(lds + MISC_OFF) + 8);
#define IN(k) (ph_lo <= (k) && (k) < ph_hi)
#define SEAM(k) do { if (ph_lo <= (k) && (k) + 1 < ph_hi) xcd_barrier(bar); } while (0)
    if (IN(PH_PRO0)) { ph_pro0(p, lds, bid, G, tid); SEAM(PH_PRO0); }
    if (IN(PH_PRO)) { for (int t = bid; t < 512; t += G) cmp_gemm_tile<true>(p, lds, t, tid);
        __syncthreads(); ph_prologue(p, lds, bid, G, tid); SEAM(PH_PRO); }
    if (IN(PH_IN)) { { pg8::Gemm g{p.XB, p.WIN_T, NPT, NIN_PAD, DM}; pg8::StaticOrder S; S.init(NPT, NIN_PAD, G, bid);
          EpiProj E{p.RSTD1, p.b_gate, p.QN, p.KV6, p.GQ, p.GK, p.GV, p.GR, p.BR, p.GATE, p.LR, p.out};
          pg8::gemm_phase<EpiProj, pg8::StaticOrder, true, true>(lds, g, S, E); }
        skinny_gemm(lds, p.XB + (size_t)NPT * DM, DM, p.WIN_T, NIN_PAD, DM, F_proj_s{p}, bid, G, tid);
        for (int it = bid; it < 512; it += G) cmp_part2<true>(p, lds, it >> 8, (it >> 3) & 31, (it & 7) * 128, tid);
        SEAM(PH_IN); }
    if (IN(PH_MID)) {
        for (int t = bid; t < 32; t += G) { cmp_gemm_tile<false>(p, lds, t, tid); __builtin_amdgcn_fence(__ATOMIC_RELEASE, "workgroup"); VM_WAIT(); __syncthreads(); cmp_part2<false>(p, lds, t >> 4, t & 15, 0, tid); }
        for (int it = G - 1 - bid; it < 32; it += G) nsa_sample_item(p, lds, it, tid);
        for (int it = bid; it < 512; it += G) gla_pass_a(p, lds, it, tid);
        for (int it = bid; it < 32; it += G) gla_sample_item(p, lds, it, tid);
        { const int wave = tid >> 6; for (int it = bid * 8 + wave; it < 1024; it += G * 8) nsa_vt_tile(p, lds + wave * 16384, it, tid & 63); }
        SEAM(PH_MID); }
    if (IN(PH_ATT)) {
        for (int it = bid; it < 256; it += G) { const int bg = it & 15, sq = it >> 4;
#pragma unroll 1
            for (int k = 0; k < 2; ++k) { nsa_prompt_item(p, lds, bg, k ? sq : 31 - sq, tid); __syncthreads(); } }
        gla_pass_b(p, bid, G, tid);
        SEAM(PH_ATT); }
    if (IN(PH_BRA)) { for (int it = bid; it < 512; it += G) gla_pass_c(p, lds, it, tid);
        const F_bra f{p.BR, p.TMP};
        { pg8::Gemm g{p.OA, p.WBRA_T, NPT, DM, 1024}; pg8::StaticOrder S; S.init(NPT, DM, G, bid); EpiGen<F_bra> E{f}; pg8::gemm_phase<EpiGen<F_bra>, pg8::StaticOrder, true, true>(lds, g, S, E); }
        skinny_gemm(lds, p.OA + (size_t)NPT * 1024, 1024, p.WBRA_T, DM, 1024, f, bid, G, tid); SEAM(PH_BRA); }
    if (IN(PH_BRB)) { const F_brb f{p.BR, p.TMP, p.MB};
        { pg8::Gemm g{p.OB, p.WBRB_T, NPT, DM, 1024}; pg8::StaticOrder S; S.init(NPT, DM, G, bid); EpiGen<F_brb> E{f}; pg8::gemm_phase<EpiGen<F_brb>, pg8::StaticOrder, true, true>(lds, g, S, E); }
        skinny_gemm(lds, p.OB + (size_t)NPT * 1024, 1024, p.WBRB_T, DM, 1024, f, bid, G, tid); SEAM(PH_BRB); }
    if (IN(PH_WO)) {
        { const F_wo f{p.x_prompt, p.X1, p.X1B, p.SUMSQ2}; pg8::Gemm g{p.MB, p.WO_T, NPT, DM, DM}; pg8::StaticOrder S; S.init(NPT, DM, G, bid); EpiGen<F_wo> E{f}; pg8::gemm_phase<EpiGen<F_wo>, pg8::StaticOrder, true, true>(lds, g, S, E); }
        { const F_wo f{p.x_sample - (size_t)NPT * DM, p.X1, p.X1B, p.SUMSQ2}; skinny_gemm(lds, p.MB + (size_t)NPT * DM, DM, p.WO_T, DM, DM, f, bid, G, tid); } SEAM(PH_WO); }
    if (IN(PH_UP)) { const F_up f{p.SUMSQ2, p.HF};
        { pg8::Gemm g{p.X1B, p.WUP_T, NPT, DFF, DM}; pg8::StaticOrder S; S.init(NPT, DFF, G, bid); EpiGen<F_up> E{f}; pg8::gemm_phase<EpiGen<F_up>, pg8::StaticOrder, true, true>(lds, g, S, E); }
        skinny_gemm(lds, p.X1B + (size_t)NPT * DM, DM, p.WUP_T, DFF, DM, f, bid, G, tid); SEAM(PH_UP); }
    if (IN(PH_DOWN)) {
        { const F_down f{p.X1, p.out + OFF_Y, p.SUMSQ3}; pg8::Gemm g{p.HF, p.WDN_T, NPT, DM, DFF}; pg8::StaticOrder S; S.init(NPT, DM, G, bid); EpiGen<F_down> E{f}; pg8::gemm_phase<EpiGen<F_down>, pg8::StaticOrder, true, true>(lds, g, S, E); }
        { const F_down f{p.X1, p.out + OFF_YS - (size_t)NPT * DM, p.SUMSQ3}; skinny_gemm(lds, p.HF + (size_t)NPT * DFF, DFF, p.WDN_T, DM, DFF, f, bid, G, tid); } SEAM(PH_DOWN); }
    if (IN(PH_NORM)) ph_final_norm(p, bid, G, tid);
#undef IN
#undef SEAM
}
__global__ void __launch_bounds__(256) k_sumsq_rows(const float* X, size_t ld, float* ss_out, int nrows) {
    const int lane = threadIdx.x & 63, row = blockIdx.x * 4 + (threadIdx.x >> 6);
    if (row >= nrows) return;
    float ss = 0.f;
    for (int i = lane; i < DM; i += 64) { const float v = X[(size_t)row * ld + i]; ss += v * v; }
    ss = wave_sum(ss);
    if (lane == 0) ss_out[row] = ss;
}
struct EF_up2 { Params p; __device__ void operator()(int r, int n, float acc) const { const float v = fmaxf(acc * rsqrtf(p.SUMSQ2[r] * (1.f / DM) + EPS), 0.f); p.HF[(size_t)r * DFF + n] = f2bf(v * v); } };

static inline size_t align_up(size_t x) { return (x + 255) & ~(size_t)255; }

extern "C" void kernel_launch(void* const* d_in, const int* in_sizes, int n_in, void* d_out, int out_size, void* d_ws, size_t ws_size, hipStream_t stream) {
    if (n_in != 29 || out_size != (int)OUT_TOTAL) { fprintf(stderr, "kernel_launch: unexpected n_in %d / out_size %d\n", n_in, out_size); return; }
    static int grid = 0;
    if (grid == 0) {
        int dev = 0, cus = 0, per_cu = 0;
        if (hipGetDevice(&dev) != hipSuccess || hipDeviceGetAttribute(&cus, hipDeviceAttributeMultiprocessorCount, dev) != hipSuccess) { fprintf(stderr, "kernel_launch: device query failed\n"); grid = -1; return; }
        if (hipFuncSetAttribute((const void*)mk_fwd, hipFuncAttributeMaxDynamicSharedMemorySize, LDS_BYTES) != hipSuccess) { fprintf(stderr, "kernel_launch: hipFuncSetAttribute failed\n"); grid = -1; return; }
        if (hipOccupancyMaxActiveBlocksPerMultiprocessor(&per_cu, (const void*)mk_fwd, 512, LDS_BYTES) != hipSuccess || per_cu < 1) { fprintf(stderr, "kernel_launch: occupancy query says %d\n", per_cu); per_cu = 1; }
        (void)hipGetLastError();
        grid = cus;
    }
    if (grid < 0) return;
    Params p{};
    p.x_prompt = (const float*)d_in[0]; p.x_sample = (const float*)d_in[1]; p.cck = (const float*)d_in[2]; p.ccv = (const float*)d_in[3];
    p.csk = (const float*)d_in[4]; p.csv = (const float*)d_in[5]; p.cwk = (const float*)d_in[6]; p.cwv = (const float*)d_in[7]; p.state = (const float*)d_in[8];
    p.page_table = (const int*)d_in[9]; p.norm1_g = (const float*)d_in[10]; p.w_in = (const float*)d_in[11]; p.b_gate = (const float*)d_in[12];
    p.pe_k = (const float*)d_in[13]; p.pe_v = (const float*)d_in[14]; p.w1k = (const float*)d_in[15]; p.w2k = (const float*)d_in[16]; p.w1v = (const float*)d_in[17]; p.w2v = (const float*)d_in[18];
    p.w_a2 = (const float*)d_in[19]; p.b_a = (const float*)d_in[20]; p.gnorm = (const float*)d_in[21]; p.w_br_a = (const float*)d_in[22]; p.w_br_b = (const float*)d_in[23];
    p.w_o = (const float*)d_in[24]; p.norm2_g = (const float*)d_in[25]; p.w_up = (const float*)d_in[26]; p.w_down = (const float*)d_in[27]; p.norm_f = (const float*)d_in[28];
    p.out = (float*)d_out;
    char* ws = (char*)d_ws; size_t off = 0;
    auto take = [&](size_t bytes) { char* r = ws + off; off = align_up(off + bytes); return r; };
    p.CTL = (unsigned*)take(1 << 20);
    p.XB = (bf16_t*)take((size_t)NTOK * DM * 2); p.RSTD1 = (float*)take(NTOK * 4); p.QN = (bf16_t*)take((size_t)NTOK * 1024 * 2); p.KV6 = (bf16_t*)take((size_t)NTOK * 1536 * 2);
    p.GATE = (float*)take((size_t)NTOK * 48 * 4); p.GQ = (bf16_t*)take((size_t)NTOK * 512 * 2); p.GK = (bf16_t*)take((size_t)NTOK * 512 * 2); p.GV = (bf16_t*)take((size_t)NTOK * 1024 * 2);
    p.GR = (bf16_t*)take((size_t)NTOK * 1024 * 2); p.LR = (float*)take((size_t)NTOK * 16 * 4); p.BR = (bf16_t*)take((size_t)NTOK * 4096 * 2);
    p.KCMP_P = (bf16_t*)take(16 * 128 * 64 * 2); p.VCMPT_P = (bf16_t*)take(16 * 128 * 64 * 2); p.KCMP_S = (bf16_t*)take(32 * 1024 * 64 * 2); p.VCMP_S = (bf16_t*)take(32 * 1024 * 64 * 2);
    p.OA = (bf16_t*)take((size_t)NTOK * 1024 * 2); p.OB = (bf16_t*)take((size_t)NTOK * 1024 * 2); p.TMP = (float*)take((size_t)NTOK * DM * 4); p.MB = (bf16_t*)take((size_t)NTOK * DM * 2);
    p.X1 = (float*)take((size_t)NTOK * DM * 4); p.X1B = (bf16_t*)take((size_t)NTOK * DM * 2); p.RSTD2 = (float*)take(NTOK * 4); p.HF = (bf16_t*)take((size_t)NTOK * DFF * 2);
    p.WIN_T = (bf16_t*)take((size_t)NIN_PAD * DM * 2); p.WBRA_T = (bf16_t*)take((size_t)DM * 1024 * 2); p.WBRB_T = (bf16_t*)take((size_t)DM * 1024 * 2); p.WO_T = (bf16_t*)take((size_t)DM * DM * 2);
    p.WUP_T = (bf16_t*)take((size_t)DFF * DM * 2); p.WDN_T = (bf16_t*)take((size_t)DM * DFF * 2); p.SUMSQ2 = (float*)take(NTOK * 4); p.SUMSQ3 = (float*)take(NTOK * 4);
    p.W1T = (bf16_t*)take(2 * 256 * 1024 * 2); p.BIAS1 = (float*)take(256 * 4); p.AB_S = (float*)take((size_t)2 * 32768 * 256 * 4); p.AB_P = (float*)take((size_t)2 * 2048 * 256 * 4);
    p.UT = (float*)take((size_t)512 * 256 * 128 * 4); p.DEC = (float*)take(512 * 128 * 4); p.SNT = (bf16_t*)take((size_t)512 * 256 * 128 * 2);
    p.VTS = (bf16_t*)take((size_t)16 * 64 * SEQ * 2); p.VTW = (bf16_t*)take((size_t)16 * 64 * SEQ * 2);
    if (off > ws_size) { fprintf(stderr, "kernel_launch: workspace too small: need %zu have %zu\n", off, ws_size); return; }
    hipMemsetAsync(p.CTL, 0, 1 << 20, stream);
#define MK(lo, hi, li) hipLaunchKernelGGL(mk_fwd, dim3(grid), dim3(512), LDS_BYTES, stream, p, (int)(lo), (int)(hi), (int)(li))
    MK(PH_PRO0, PH_END, 0);
}
```

```cpp
#include <hip/hip_runtime.h>
#include <stdint.h>
#include <cstdio>

typedef unsigned short bf16_t;

constexpr int DM = 2048, NB = 4, SEQ = 2048, NPT = NB * SEQ, DB = 8, NTOK = NPT + DB;
constexpr int PAST = 16384, PAGE = 128, NPAGES = 128;
constexpr int NG = 4, HPG = 4, DH = 64;
constexpr int DIN = 9792, DFF = 8192;
constexpr int C_Q = 0, C_KV = 1024, C_G = 2560, C_QL = 2608, C_KL = 3120, C_VL = 3632, C_RL = 4656, C_LR = 5680, C_BR = 5696;
constexpr float EPS = 1e-6f;
constexpr size_t OFF_Y = 0, OFF_YS = (size_t)NPT * DM, OFF_PCK = OFF_YS + (size_t)DB * DM;
constexpr size_t SZ_PROW = (size_t)NPT * 256;
constexpr size_t OFF_PWK = OFF_PCK + 4 * SZ_PROW, SZ_PWIN = (size_t)NB * 512 * 256;
constexpr size_t OFF_PGLA = OFF_PWK + 2 * SZ_PWIN, SZ_PGLA = (size_t)NB * 4 * 128 * 256;
constexpr size_t OFF_SCK = OFF_PGLA + SZ_PGLA, SZ_SROW = (size_t)DB * 256;
constexpr size_t OFF_SWK = OFF_SCK + 4 * SZ_SROW, SZ_SWIN = (size_t)DB * 512 * 256;
constexpr size_t OFF_SGLA = OFF_SWK + 2 * SZ_SWIN, SZ_SGLA = (size_t)DB * 4 * 128 * 256;
constexpr size_t OUT_TOTAL = OFF_SGLA + SZ_SGLA;
static_assert(OUT_TOTAL == 29908992, "output size");

__device__ __forceinline__ bf16_t f2bf(float f) { unsigned u = __builtin_bit_cast(unsigned, f); return (bf16_t)((u + 0x7fffu + ((u >> 16) & 1u)) >> 16); }
__device__ __forceinline__ float bf2f(bf16_t h) { return __builtin_bit_cast(float, (unsigned)h << 16); }
__device__ __forceinline__ float sigmoidf_(float x) { return 1.f / (1.f + __expf(-x)); }
__device__ __forceinline__ float siluf_(float x) { return x / (1.f + __expf(-x)); }
__device__ __forceinline__ float gelu_tanh(float x) { const float u = 0.7978845608028654f * (x + 0.044715f * x * x * x); return 0.5f * x * (1.f + tanhf(u)); }
__device__ __forceinline__ float logsigmoidf_(float x) { return fminf(x, 0.f) - log1pf(__expf(-fabsf(x))); }
__device__ __forceinline__ float wave_sum(float v) {
#pragma unroll
    for (int o = 1; o < 64; o <<= 1) v += __shfl_xor(v, o);
    return v;
}
__device__ __forceinline__ float wave_max(float v) {
#pragma unroll
    for (int o = 1; o < 64; o <<= 1) v = fmaxf(v, __shfl_xor(v, o));
    return v;
}

struct Params {
    const float *x_prompt, *x_sample, *cck, *ccv, *csk, *csv, *cwk, *cwv, *state;
    const int* page_table;
    const float *norm1_g, *w_in, *b_gate, *pe_k, *pe_v, *w1k, *w2k, *w1v, *w2v, *w_a2, *b_a, *gnorm, *w_br_a, *w_br_b, *w_o, *norm2_g, *w_up, *w_down, *norm_f;
    float* out;
    bf16_t *XB, *QN, *KV6, *GQ, *GK, *GV, *GR, *BR, *KCMP_P, *VCMPT_P, *KCMP_S, *VCMP_S, *OA, *OB, *MB, *X1B, *HF;
    float *RSTD1, *GATE, *LR, *TMP, *X1, *RSTD2;
    bf16_t *WIN_T, *WBRA_T, *WBRB_T, *WO_T, *WUP_T, *WDN_T;
    float *SUMSQ2, *SUMSQ3;
    unsigned* CTL;
    bf16_t *W1T, *W2TG; float *BIAS1, *AB_S, *AB_P;
    float *UT, *DEC, *BCG; bf16_t* SNT;
    bf16_t *VTS, *VTW;
};

__device__ __forceinline__ float xval(const Params& p, int row, int n) { return row < NPT ? p.x_prompt[(size_t)row * DM + n] : p.x_sample[(size_t)(row - NPT) * DM + n]; }

__device__ __forceinline__ void proj_store(const Params& p, int row, int n, float v) {
    if (n < C_KV) p.QN[(size_t)row * 1024 + n] = f2bf(v * 0.125f);
    else if (n < C_G) {
        const int c = n - C_KV; p.KV6[(size_t)row * 1536 + c] = f2bf(v); const int j = c >> 8, cc = c & 255;
        if (row < NPT) { const int b = row >> 11, t = row & 2047;
            if (j < 4) p.out[OFF_PCK + j * SZ_PROW + (size_t)row * 256 + cc] = v;
            else if (t >= 1536) p.out[OFF_PWK + (j - 4) * SZ_PWIN + ((size_t)b * 512 + t - 1536) * 256 + cc] = v; }
        else { const int b = row - NPT;
            if (j < 4) p.out[OFF_SCK + j * SZ_SROW + (size_t)b * 256 + cc] = v;
            else p.out[OFF_SWK + (j - 4) * SZ_SWIN + ((size_t)b * 512 + 511) * 256 + cc] = v; }
    }
    else if (n < C_QL) { const int c = n - C_G; p.GATE[(size_t)row * 48 + c] = sigmoidf_(v + p.b_gate[c]); }
    else if (n < C_KL) p.GQ[(size_t)row * 512 + (n - C_QL)] = f2bf(v * 0.08838834764831845f);
    else if (n < C_VL) p.GK[(size_t)row * 512 + (n - C_KL)] = f2bf(v);
    else if (n < C_RL) p.GV[(size_t)row * 1024 + (n - C_VL)] = f2bf(v);
    else if (n < C_LR) p.GR[(size_t)row * 1024 + (n - C_RL)] = f2bf(siluf_(v));
    else if (n < C_BR) p.LR[(size_t)row * 16 + (n - C_LR)] = v;
    else p.BR[(size_t)row * 4096 + (n - C_BR)] = f2bf(sigmoidf_(v));
}

__global__ void __launch_bounds__(256) k_prep_x(Params p) {
    const int lane = threadIdx.x & 63, row = blockIdx.x * 4 + (threadIdx.x >> 6);
    if (row >= NTOK) return;
    const float* xr = row < NPT ? p.x_prompt + (size_t)row * DM : p.x_sample + (size_t)(row - NPT) * DM;
    float ss = 0.f;
    for (int i = lane; i < DM; i += 64) { const float v = xr[i]; ss += v * v; p.XB[(size_t)row * DM + i] = f2bf(v); }
    ss = wave_sum(ss);
    if (lane == 0) p.RSTD1[row] = rsqrtf(ss * (1.f / DM) + EPS);
}
__global__ void __launch_bounds__(256) k_copy_swin(Params p) {
    const size_t i = (size_t)blockIdx.x * 256 + threadIdx.x;
    if (i >= (size_t)DB * 511 * 256) return;
    const int c = (int)(i & 255); const int r = (int)((i >> 8) % 511); const int b = (int)((i >> 8) / 511);
    p.out[OFF_SWK + ((size_t)b * 512 + r) * 256 + c] = p.cwk[((size_t)b * 512 + r + 1) * 256 + c];
    p.out[OFF_SWK + SZ_SWIN + ((size_t)b * 512 + r) * 256 + c] = p.cwv[((size_t)b * 512 + r + 1) * 256 + c];
}
__global__ void __launch_bounds__(256) k_rms_rows(const float* X, float* rstd, int nrows) {
    const int lane = threadIdx.x & 63, row = blockIdx.x * 4 + (threadIdx.x >> 6);
    if (row >= nrows) return;
    float ss = 0.f;
    for (int i = lane; i < DM; i += 64) { const float v = X[(size_t)row * DM + i]; ss += v * v; }
    ss = wave_sum(ss);
    if (lane == 0) rstd[row] = rsqrtf(ss * (1.f / DM) + EPS);
}
__global__ void __launch_bounds__(256) k_final_norm(Params p) {
    const int lane = threadIdx.x & 63, row = blockIdx.x * 4 + (threadIdx.x >> 6);
    if (row >= NTOK) return;
    float* yr = row < NPT ? p.out + OFF_Y + (size_t)row * DM : p.out + OFF_YS + (size_t)(row - NPT) * DM;
    float ss = 0.f;
    for (int i = lane; i < DM; i += 64) { const float v = yr[i]; ss += v * v; }
    ss = wave_sum(ss);
    const float r = rsqrtf(ss * (1.f / DM) + EPS);
    for (int i = lane; i < DM; i += 64) yr[i] = yr[i] * r * p.norm_f[i];
}

template <class AF, class BF, class EF>
__global__ void __launch_bounds__(256) k_gemm_naive(int m_off, int M, int N, int K, AF af, BF bf, EF ef) {
    __shared__ float As[16][68], Bs[16][68];
    const int tid = threadIdx.x, tx = tid & 15, ty = tid >> 4, m0 = m_off + blockIdx.y * 64, n0 = blockIdx.x * 64;
    float acc[4][4];
#pragma unroll
    for (int i = 0; i < 4; ++i)
#pragma unroll
        for (int j = 0; j < 4; ++j) acc[i][j] = 0.f;
    for (int k0 = 0; k0 < K; k0 += 16) {
#pragma unroll
        for (int i = 0; i < 4; ++i) { const int idx = tid + 256 * i, r = idx >> 4, kk = idx & 15; As[kk][r] = (m0 + r < M) ? af(m0 + r, k0 + kk) : 0.f; }
#pragma unroll
        for (int i = 0; i < 4; ++i) { const int idx = tid + 256 * i, kk = idx >> 6, c = idx & 63; Bs[kk][c] = (n0 + c < N) ? bf(k0 + kk, n0 + c) : 0.f; }
        __syncthreads();
#pragma unroll
        for (int kk = 0; kk < 16; ++kk) {
            float a[4], b[4];
#pragma unroll
            for (int i = 0; i < 4; ++i) { a[i] = As[kk][ty * 4 + i]; b[i] = Bs[kk][tx * 4 + i]; }
#pragma unroll
            for (int i = 0; i < 4; ++i)
#pragma unroll
                for (int j = 0; j < 4; ++j) acc[i][j] += a[i] * b[j];
        }
        __syncthreads();
    }
#pragma unroll
    for (int i = 0; i < 4; ++i)
#pragma unroll
        for (int j = 0; j < 4; ++j) { const int r = m0 + ty * 4 + i, c = n0 + tx * 4 + j; if (r < M && c < N) ef(r, c, acc[i][j]); }
}
struct AF_x_g1 { Params p; __device__ float operator()(int r, int k) const { return xval(p, r, k) * p.norm1_g[k]; } };
struct BF_rowmajor { const float* W; long ld; __device__ float operator()(int k, int n) const { return W[(size_t)k * ld + n]; } };
struct EF_proj { Params p; __device__ void operator()(int r, int n, float acc) const { proj_store(p, r, n, acc * p.RSTD1[r]); } };
struct AF_bf { const bf16_t* A; long ld; __device__ float operator()(int r, int k) const { return bf2f(A[(size_t)r * ld + k]); } };
struct EF_bra { Params p; __device__ void operator()(int r, int n, float acc) const { p.TMP[(size_t)r * DM + n] = acc * bf2f(p.BR[(size_t)r * 4096 + n]); } };
struct EF_brb { Params p; __device__ void operator()(int r, int n, float acc) const { p.MB[(size_t)r * DM + n] = f2bf(p.TMP[(size_t)r * DM + n] + acc * bf2f(p.BR[(size_t)r * 4096 + 2048 + n])); } };
struct EF_wo { Params p; __device__ void operator()(int r, int n, float acc) const { const float x1 = xval(p, r, n) + acc; p.X1[(size_t)r * DM + n] = x1; p.X1B[(size_t)r * DM + n] = f2bf(x1); } };
struct AF_x1_g2 { Params p; __device__ float operator()(int r, int k) const { return bf2f(p.X1B[(size_t)r * DM + k]) * p.norm2_g[k]; } };
struct EF_up { Params p; __device__ void operator()(int r, int n, float acc) const { const float v = fmaxf(acc * p.RSTD2[r], 0.f); p.HF[(size_t)r * DFF + n] = f2bf(v * v); } };
struct EF_down { Params p; __device__ void operator()(int r, int n, float acc) const { const float x2 = p.X1[(size_t)r * DM + n] + acc;
    if (r < NPT) p.out[OFF_Y + (size_t)r * DM + n] = x2; else p.out[OFF_YS + (size_t)(r - NPT) * DM + n] = x2; } };

__global__ void __launch_bounds__(128) k_compress_naive(Params p, int is_s) {
    const int n_cmp = is_s ? 1023 : 127, n_pad = is_s ? 1024 : 128;
    const int kv = blockIdx.y, tid = threadIdx.x;
    const int i = blockIdx.x % n_pad, bg = blockIdx.x / n_pad, b = bg >> 2, g = bg & 3;
    __shared__ float blk[2048]; __shared__ float hid[128];
    if (i >= n_cmp) {
        if (tid < 64) { if (is_s) { (kv ? p.VCMP_S : p.KCMP_S)[((size_t)bg * 1024 + i) * 64 + tid] = 0; }
                        else { if (kv) p.VCMPT_P[((size_t)bg * 64 + tid) * 128 + i] = 0; else p.KCMP_P[((size_t)bg * 128 + i) * 64 + tid] = 0; } }
        return;
    }
    const float* pe = kv ? p.pe_v : p.pe_k; const float* w1 = kv ? p.w1v : p.w1k; const float* w2 = kv ? p.w2v : p.w2k;
    for (int e = tid; e < 2048; e += 128) { const int l = e >> 6, d = e & 63; const int pos = 16 * i + l; float v;
        if (is_s) { const int page = p.page_table[b * NPAGES + (pos >> 7)]; v = (kv ? p.ccv : p.cck)[(((size_t)page * PAGE + (pos & 127)) * 4 + g) * 64 + d]; }
        else v = bf2f(p.KV6[((size_t)b * SEQ + pos) * 1536 + kv * 256 + g * 64 + d]);
        blk[e] = v + pe[e]; }
    __syncthreads();
    float h = 0.f;
    for (int k = 0; k < 2048; ++k) h += blk[k] * w1[(size_t)k * 128 + tid];
    hid[tid] = gelu_tanh(h);
    __syncthreads();
    if (tid < 64) { float o = 0.f; for (int j = 0; j < 128; ++j) o += hid[j] * w2[j * 64 + tid];
        if (is_s) (kv ? p.VCMP_S : p.KCMP_S)[((size_t)bg * 1024 + i) * 64 + tid] = f2bf(o);
        else { if (kv) p.VCMPT_P[((size_t)bg * 64 + tid) * 128 + i] = f2bf(o); else p.KCMP_P[((size_t)bg * 128 + i) * 64 + tid] = f2bf(o); } }
}

struct RowRef { const float* pf; const bf16_t* pb; };
__device__ __forceinline__ float rr_get(const RowRef& r, int d) { return r.pf ? r.pf[d] : bf2f(r.pb[d]); }

template <class KF, class VF>
__device__ __forceinline__ void attend_naive(int nk, KF keyf, VF valf, const float (*q)[64], float (*sc)[1088], float (*oacc)[64], const float* gate3, int gsel, int tid) {
    const int lane = tid & 63, wv = tid >> 6;
    for (int kk = tid; kk < nk; kk += 256) { bool valid; const RowRef r = keyf(kk, valid);
        if (valid) { float d0 = 0.f, d1 = 0.f, d2 = 0.f, d3 = 0.f;
            for (int d = 0; d < 64; ++d) { const float kx = rr_get(r, d); d0 += q[0][d] * kx; d1 += q[1][d] * kx; d2 += q[2][d] * kx; d3 += q[3][d] * kx; }
            sc[0][kk] = d0; sc[1][kk] = d1; sc[2][kk] = d2; sc[3][kk] = d3; }
        else { sc[0][kk] = -INFINITY; sc[1][kk] = -INFINITY; sc[2][kk] = -INFINITY; sc[3][kk] = -INFINITY; } }
    __syncthreads();
    {
        float m = -INFINITY; for (int kk = lane; kk < nk; kk += 64) m = fmaxf(m, sc[wv][kk]);
        m = wave_max(m);
        float s = 0.f;
        for (int kk = lane; kk < nk; kk += 64) { const float x = sc[wv][kk]; const float e = (x == -INFINITY) ? 0.f : __expf(x - m); sc[wv][kk] = e; s += e; }
        s = wave_sum(s);
        const float inv = s > 0.f ? 1.f / s : 0.f;
        for (int kk = lane; kk < nk; kk += 64) sc[wv][kk] *= inv;
    }
    __syncthreads();
    {
        float o = 0.f;
        for (int kk = 0; kk < nk; ++kk) { const float pr = sc[wv][kk]; if (pr != 0.f) o += pr * valf(kk, lane); }
        oacc[wv][lane] += gate3[wv * 3 + gsel] * o;
    }
    __syncthreads();
}

__device__ __forceinline__ void nsa_naive_body(const Params& p, int row, int g, int tid, float (*q)[64], float (*sc)[1088], float (*oacc)[64], float* gate3, float* score, int* selidx) {
    const bool is_s = row >= NPT; const int b = is_s ? row - NPT : row >> 11, t = is_s ? 0 : row & 2047;
    const int start = is_s ? PAST : 0, pos = start + t, rowbase = is_s ? NPT + b : b * SEQ;
    const int n_cmp = is_s ? 1023 : 127, n_slc = is_s ? 257 : 32;
    { const int hd = tid >> 6, d = tid & 63; q[hd][d] = bf2f(p.QN[(size_t)row * 1024 + (g * 4 + hd) * 64 + d]); oacc[hd][d] = 0.f; }
    if (tid < 12) gate3[tid] = p.GATE[(size_t)row * 48 + g * 12 + tid];
    __syncthreads();
    const int bg = b * 4 + g;
    const bf16_t* kc = is_s ? p.KCMP_S + (size_t)bg * 1024 * 64 : p.KCMP_P + (size_t)bg * 128 * 64;
    const bf16_t* vc_s = p.VCMP_S + (size_t)bg * 1024 * 64; const bf16_t* vc_p = p.VCMPT_P + (size_t)bg * 64 * 128;
    auto kf_c = [&](int kk, bool& valid) { valid = (16 * kk + 31 <= pos); return RowRef{nullptr, kc + (size_t)kk * 64}; };
    auto vf_c = [&](int kk, int d) { return is_s ? bf2f(vc_s[(size_t)kk * 64 + d]) : bf2f(vc_p[(size_t)d * 128 + kk]); };
    attend_naive(n_cmp, kf_c, vf_c, q, sc, oacc, gate3, 0, tid);
    for (int j = tid; j < n_slc; j += 256) { float s = 0.f;
        for (int i = 4 * j - 1; i <= 4 * j + 3; ++i) if (i >= 0 && i < n_cmp) s += (sc[0][i] + sc[1][i]) + (sc[2][i] + sc[3][i]);
        score[j] = (j * 64 <= pos) ? s + ((j == 0 || j == pos / 64) ? 1e4f : 0.f) : -1e30f; }
    __syncthreads();
    for (int j = tid; j < n_slc; j += 256) { const float sj = score[j]; int rank = 0;
        for (int j2 = 0; j2 < n_slc; ++j2) { const float s2 = score[j2]; rank += (s2 > sj || (s2 == sj && j2 < j)) ? 1 : 0; }
        if (rank < 16) selidx[rank] = j; }
    __syncthreads();
    auto row_at = [&](int kp, int which) -> RowRef {
        if (kp < start) {
            if (which < 4) { const int page = p.page_table[b * NPAGES + (kp >> 7)]; const float* c = (which == 2) ? p.csk : p.csv; return RowRef{c + (((size_t)page * PAGE + (kp & 127)) * 4 + g) * 64, nullptr}; }
            const float* c = (which == 4) ? p.cwk : p.cwv; return RowRef{c + (((size_t)b * 512 + (kp - (PAST - 512))) * 4 + g) * 64, nullptr};
        }
        return RowRef{nullptr, p.KV6 + (size_t)(rowbase + kp - start) * 1536 + which * 256 + g * 64};
    };
    auto kf_s = [&](int kk, bool& valid) { const int kp = selidx[kk >> 6] * 64 + (kk & 63); valid = (kp <= pos); return valid ? row_at(kp, 2) : RowRef{nullptr, nullptr}; };
    auto vf_s = [&](int kk, int d) { const int kp = selidx[kk >> 6] * 64 + (kk & 63); return rr_get(row_at(kp, 3), d); };
    attend_naive(1024, kf_s, vf_s, q, sc, oacc, gate3, 1, tid);
    auto kf_w = [&](int kk, bool& valid) { const int kp = pos - 512 + kk; valid = (kp >= 0); return valid ? row_at(kp, 4) : RowRef{nullptr, nullptr}; };
    auto vf_w = [&](int kk, int d) { const int kp = pos - 512 + kk; return rr_get(row_at(kp, 5), d); };
    attend_naive(513, kf_w, vf_w, q, sc, oacc, gate3, 2, tid);
    { const int hd = tid >> 6, d = tid & 63; p.OA[(size_t)row * 1024 + (g * 4 + hd) * 64 + d] = f2bf(oacc[hd][d]); }
}
__global__ void __launch_bounds__(256) k_nsa_naive(Params p, int row0) {
    __shared__ float q[4][64]; __shared__ float sc[4][1088]; __shared__ float oacc[4][64]; __shared__ float gate3[12];
    __shared__ float score[260]; __shared__ int selidx[16];
    nsa_naive_body(p, row0 + blockIdx.x, blockIdx.y, threadIdx.x, q, sc, oacc, gate3, score, selidx);
}

__global__ void __launch_bounds__(512) k_gla_naive(Params p, int is_s) {
    const int b = blockIdx.x >> 2, h = blockIdx.x & 3, tid = threadIdx.x, e = tid & 255, half = tid >> 8;
    const int T = is_s ? 1 : SEQ, rowbase = is_s ? NPT + b : b * SEQ;
    __shared__ float a_s[128], q_s[128], k_s[128], part[2][256], red[8];
    float S[64];
#pragma unroll
    for (int dd = 0; dd < 64; ++dd) S[dd] = is_s ? p.state[(((size_t)b * 4 + h) * 128 + half * 64 + dd) * 256 + e] : 0.f;
    for (int t = 0; t < T; ++t) {
        const int row = rowbase + t;
        if (tid < 128) { float x = p.b_a[h * 128 + tid];
            for (int r = 0; r < 16; ++r) x += p.LR[(size_t)row * 16 + r] * p.w_a2[r * 512 + h * 128 + tid];
            a_s[tid] = __expf(logsigmoidf_(x) * (1.f / 16.f));
            q_s[tid] = bf2f(p.GQ[(size_t)row * 512 + h * 128 + tid]); k_s[tid] = bf2f(p.GK[(size_t)row * 512 + h * 128 + tid]); }
        const float v = bf2f(p.GV[(size_t)row * 1024 + h * 256 + e]);
        __syncthreads();
        float po = 0.f;
#pragma unroll
        for (int dd = 0; dd < 64; ++dd) { const int d = half * 64 + dd; S[dd] = a_s[d] * S[dd] + k_s[d] * v; po += q_s[d] * S[dd]; }
        part[half][e] = po;
        __syncthreads();
        float o = 0.f;
        if (tid < 256) { o = part[0][e] + part[1][e]; const float ss = wave_sum(o * o); if ((tid & 63) == 0) red[tid >> 6] = ss; }
        __syncthreads();
        if (tid < 256) { const float ss = (red[0] + red[1]) + (red[2] + red[3]); const float r = rsqrtf(ss * (1.f / 256.f) + EPS);
            p.OB[(size_t)row * 1024 + h * 256 + e] = f2bf(o * r * p.gnorm[e] * bf2f(p.GR[(size_t)row * 1024 + h * 256 + e])); }
    }
    float* so = p.out + (is_s ? OFF_SGLA : OFF_PGLA);
#pragma unroll
    for (int dd = 0; dd < 64; ++dd) so[(((size_t)b * 4 + h) * 128 + half * 64 + dd) * 256 + e] = S[dd];
}

#define REP_MASK 0
#define PROBE_PHASE -1
#define PROBE_A -1
#define PROBE_B -1
#define PROBE_BID 0
#define LATE_PRO 9600
#define GAS __attribute__((address_space(1)))
#define LAS __attribute__((address_space(3)))
typedef unsigned v4u __attribute__((ext_vector_type(4)));
typedef unsigned v2u __attribute__((ext_vector_type(2)));
#define LDS_WAIT() asm volatile("s_waitcnt lgkmcnt(0)" ::: "memory")
#define VM_WAIT() asm volatile("s_waitcnt vmcnt(0)" ::: "memory")
#define LDS_BARRIER() do { asm volatile("s_waitcnt lgkmcnt(0)" ::: "memory"); __builtin_amdgcn_s_barrier(); asm volatile("" ::: "memory"); } while (0)
typedef float f32x2_t __attribute__((ext_vector_type(2)));
typedef __bf16 bf16x2_t __attribute__((ext_vector_type(2)));
__device__ __forceinline__ unsigned cvtpk(float lo, float hi) { f32x2_t v = {lo, hi}; bf16x2_t b = __builtin_convertvector(v, bf16x2_t); return __builtin_bit_cast(unsigned, b); }
__device__ __forceinline__ unsigned pk2(float lo, float hi) { return cvtpk(lo, hi); }
__device__ __forceinline__ float sigmoid_fast(float x) { return __builtin_amdgcn_rcpf(1.f + __expf(-x)); }
__device__ __forceinline__ float silu_fast(float x) { return x * __builtin_amdgcn_rcpf(1.f + __expf(-x)); }
__device__ __forceinline__ float gelu_fast(float x) { return x * __builtin_amdgcn_rcpf(1.f + __expf(-1.5957691216057308f * (x + 0.044715f * x * x * x))); }
constexpr int NIN_PAD = 9984;
__host__ __device__ __forceinline__ int in_colmap(int n) {
    if (n < 2560) return n; if (n < 3072) return C_QL + (n - 2560); if (n < 3584) return C_KL + (n - 3072); if (n < 4608) return C_VL + (n - 3584);
    if (n < 5632) return C_RL + (n - 4608); if (n < 9728) return C_BR + (n - 5632); if (n < 9776) return C_G + (n - 9728); if (n < 9792) return C_LR + (n - 9776); return -1;
}
namespace pg8 {
#define PG8_LAS __attribute__((address_space(3)))
typedef unsigned short bf16_t;
typedef short bf16x8 __attribute__((ext_vector_type(8)));
typedef float f32x4 __attribute__((ext_vector_type(4)));
typedef unsigned u32x4 __attribute__((ext_vector_type(4)));
constexpr int BM = 256, BK = 64, HALF = 128, HTB = HALF * BK * 2  , STAGE_BYTES = 8 * HTB, NXCD = 8, WGM = 8;

__host__ __device__ __forceinline__ int lds_byte(int r, int c) { const int st = (r >> 4) * 2 + (c >> 5), rr = r & 15, cc = c & 31, ob = rr * 64 + cc * 2; return st * 1024 + (ob ^ (((ob >> 9) & 1) << 5)); }
__host__ __device__ __forceinline__ void stage_rc(int b, int& R, int& C) { const int st = b / 1024, sb = b % 1024, swz = sb ^ (((sb >> 9) & 1) << 5); R = (st >> 1) * 16 + swz / 64; C = (st & 1) * 32 + (swz % 64) / 2; }
__host__ __device__ __forceinline__ int perm32(int rho) { const int n = rho >> 4, i = rho & 15; return 8 * (i >> 2) + 4 * n + (i & 3); }

struct Unit { int pm, pn; };
struct Gemm { const bf16_t* A; const bf16_t* Bt; int M, N, K; };

struct StaticOrder {
    int nM, nN, nwg, G, c;
    __host__ __device__ void init(int M, int N, int G_, int c_) { nM = M / BM; nN = N / BM; nwg = nM * nN; G = G_; c = c_; }
    __host__ __device__ bool next(int i, Unit& u) const {
        const long L = (long)i * G + c; if (L >= nwg) return false;
        int wgid = (int)L; { const int q = nwg / NXCD, r = nwg % NXCD, xcd = wgid % NXCD, off = wgid / NXCD; wgid = (xcd < r ? xcd * (q + 1) : r * (q + 1) + (xcd - r) * q) + off; }
        const int nig = WGM * nN, gid = wgid / nig, fm = gid * WGM, gsz = (nM - fm) < WGM ? (nM - fm) : WGM;
        u.pm = fm + ((wgid % nig) % gsz); u.pn = (wgid % nig) / gsz; return true;
    }
    __device__ __forceinline__ void a_ready(const Unit&) const {}
    __device__ __forceinline__ void done(const Unit&) const {}
};

template <class Epi, class Sched, bool ALIGN_EPI = false, bool SP2 = false>
__device__ __forceinline__ void gemm_phase(PG8_LAS unsigned char* lds, const Gemm g, const Sched& S, const Epi& E) {
    const int tid = threadIdx.x, wid = __builtin_amdgcn_readfirstlane(tid >> 6), lane = tid & 63, wr = wid >> 2, wc = wid & 3, fr = lane & 15, fq = lane >> 4;
    const int K = g.K, nt = K / BK;
    unsigned voffA[2], voffB[2];
#pragma unroll
    for (int i = 0; i < 2; ++i) { int R, C; stage_rc(tid * 16 + i * 8192, R, C); const int Rb = Epi::PERM ? ((R & ~31) + perm32(R & 31)) : R;
        voffA[i] = (unsigned)(R * K + C) * 2u; voffB[i] = (unsigned)(Rb * K + C) * 2u; }
    const size_t kstep = (size_t)(BK * 2);
    const size_t hstep = (size_t)HALF * K * 2;
    const size_t tstep = 2 * hstep;
    const unsigned ldsw = (unsigned)wid * 1024u;
    const int aoff = lds_byte(wr * 64 + fr, fq * 8), boff = lds_byte(wc * 32 + fr, fq * 8);
#define PG8_SA(b, h) (((b) * 2 + (h)) * HTB)
#define PG8_SB(b, h) ((4 + (b) * 2 + (h)) * HTB)
#define PG8_STAGE(bufoff, gbase, voff) do { _Pragma("unroll") for (int _i = 0; _i < 2; ++_i) \
        __builtin_amdgcn_global_load_lds((const unsigned*)((const char*)(gbase) + (voff)[_i]), (PG8_LAS unsigned*)(lds + (bufoff) + ldsw + _i * 8192), 16, 0, 0); } while (0)
#define PG8_LDA(dst, b, h) do { _Pragma("unroll") for (int m = 0; m < 4; ++m) _Pragma("unroll") for (int k = 0; k < 2; ++k) dst[m][k] = *(const PG8_LAS bf16x8*)(lds + PG8_SA(b, h) + aoff + m * 2048 + k * 1024); } while (0)
#define PG8_LDB(dst, b, h) do { _Pragma("unroll") for (int n = 0; n < 2; ++n) _Pragma("unroll") for (int k = 0; k < 2; ++k) dst[n][k] = *(const PG8_LAS bf16x8*)(lds + PG8_SB(b, h) + boff + n * 2048 + k * 1024); } while (0)
#define PG8_MMA(ai, bj, At, Bt) do { __builtin_amdgcn_s_setprio(1); _Pragma("unroll") for (int m = 0; m < 4; ++m) _Pragma("unroll") for (int n = 0; n < 2; ++n) _Pragma("unroll") for (int k = 0; k < 2; ++k) \
        acc[ai][bj][m][n] = __builtin_amdgcn_mfma_f32_16x16x32_bf16(Bt[n][k], At[m][k], acc[ai][bj][m][n], 0, 0, 0); __builtin_amdgcn_s_setprio(0); } while (0)
#define PG8_WAIT_V(n) asm volatile("s_waitcnt vmcnt(" #n ")" ::: "memory")
#define PG8_WAIT_L(n) asm volatile("s_waitcnt lgkmcnt(" #n ")" ::: "memory")
#define PG8_BAR __builtin_amdgcn_s_barrier()
#define PG8_SCHED __builtin_amdgcn_sched_barrier(0)
    Unit cur, nxt; int ui = 0;
    if (!S.next(0, cur)) return;
    if (PROBE_A >= 0 && threadIdx.x == 0) *(PG8_LAS unsigned long long*)(lds + 135168 + 8 * 0) = __builtin_amdgcn_s_memrealtime();
    f32x4 acc[2][2][4][2];
#pragma unroll
    for (int a = 0; a < 2; ++a)
#pragma unroll
        for (int b = 0; b < 2; ++b)
#pragma unroll
            for (int m = 0; m < 4; ++m)
#pragma unroll
                for (int n = 0; n < 2; ++n) acc[a][b][m][n] = (f32x4){0.f, 0.f, 0.f, 0.f};
    bf16x8 At[4][2], B0[2][2], B1[2][2];
    const char* cA = (const char*)g.A + (size_t)cur.pm * tstep; const char* cB = (const char*)g.Bt + (size_t)cur.pn * tstep;
    S.a_ready(cur);
    if constexpr (SP2) {
        PG8_STAGE(PG8_SB(0, 0), cB, voffB); PG8_STAGE(PG8_SB(0, 1), cB + hstep, voffB); PG8_STAGE(PG8_SA(0, 0), cA, voffA); PG8_STAGE(PG8_SA(0, 1), cA + hstep, voffA);
        if (wr == 1) PG8_BAR;
        PG8_WAIT_V(2); PG8_BAR;
        PG8_STAGE(PG8_SB(1, 0), cB + kstep, voffB); PG8_STAGE(PG8_SA(1, 0), cA + kstep, voffA); PG8_STAGE(PG8_SB(1, 1), cB + hstep + kstep, voffB);
        PG8_WAIT_V(6); PG8_BAR;
    } else {
        PG8_STAGE(PG8_SB(0, 0), cB, voffB); PG8_STAGE(PG8_SA(0, 0), cA, voffA); PG8_STAGE(PG8_SB(0, 1), cB + hstep, voffB); PG8_STAGE(PG8_SA(0, 1), cA + hstep, voffA);
        if (wr == 1) PG8_BAR;
        PG8_WAIT_V(4); PG8_BAR;
        PG8_STAGE(PG8_SB(1, 0), cB + kstep, voffB); PG8_STAGE(PG8_SA(1, 0), cA + kstep, voffA); PG8_STAGE(PG8_SB(1, 1), cB + hstep + kstep, voffB);
        PG8_WAIT_V(6); PG8_BAR;
    }
    for (;;) {
        const bool has_next = S.next(ui + 1, nxt);
        const char* nA = has_next ? (const char*)g.A + (size_t)nxt.pm * tstep : cA; const char* nB = has_next ? (const char*)g.Bt + (size_t)nxt.pn * tstep : cB;
        for (int t = 0; t < nt; t += 2) {
            const bool last = (t == nt - 2);
            const char* a1 = cA + (size_t)(t + 1) * kstep;
            const char* a2 = last ? nA : cA + (size_t)(t + 2) * kstep; const char* b2 = last ? nB : cB + (size_t)(t + 2) * kstep;
            const char* a3 = a2 + kstep; const char* b3 = b2 + kstep;
            if (last && has_next) S.a_ready(nxt);
            if constexpr (SP2) {
            PG8_LDB(B0, 0, 0); PG8_LDB(B1, 0, 1); PG8_SCHED; PG8_LDA(At, 0, 0); PG8_STAGE(PG8_SA(1, 1), a1 + hstep, voffA);
            PG8_WAIT_V(8); PG8_WAIT_L(0); PG8_BAR; PG8_MMA(0, 0, At, B0); PG8_MMA(0, 1, At, B1); PG8_BAR; PG8_SCHED;
            PG8_LDA(At, 0, 1); PG8_STAGE(PG8_SB(0, 0), b2, voffB); PG8_STAGE(PG8_SB(0, 1), b2 + hstep, voffB); PG8_STAGE(PG8_SA(0, 0), a2, voffA);
            PG8_WAIT_V(8); PG8_WAIT_L(0); PG8_BAR; PG8_MMA(1, 0, At, B0); PG8_MMA(1, 1, At, B1); PG8_BAR; PG8_SCHED;
            PG8_LDB(B0, 1, 0); PG8_LDB(B1, 1, 1); PG8_SCHED; PG8_LDA(At, 1, 0); PG8_STAGE(PG8_SA(0, 1), a2 + hstep, voffA);
            PG8_WAIT_V(8); PG8_WAIT_L(0); PG8_BAR; PG8_MMA(0, 0, At, B0); PG8_MMA(0, 1, At, B1); PG8_BAR; PG8_SCHED;
            PG8_LDA(At, 1, 1); PG8_STAGE(PG8_SB(1, 0), b3, voffB); PG8_STAGE(PG8_SB(1, 1), b3 + hstep, voffB); PG8_STAGE(PG8_SA(1, 0), a3, voffA);
            PG8_WAIT_V(8); PG8_WAIT_L(0); PG8_BAR; PG8_MMA(1, 0, At, B0); PG8_MMA(1, 1, At, B1); PG8_BAR; PG8_SCHED;
            } else {
            PG8_LDB(B0, 0, 0); PG8_SCHED; PG8_LDA(At, 0, 0); PG8_STAGE(PG8_SA(1, 1), a1 + hstep, voffA);
            PG8_WAIT_L(8); PG8_BAR; PG8_WAIT_L(0); PG8_MMA(0, 0, At, B0); PG8_BAR; PG8_SCHED;
            PG8_LDB(B1, 0, 1); PG8_STAGE(PG8_SB(0, 0), b2, voffB);
            PG8_BAR; PG8_WAIT_L(0); PG8_MMA(0, 1, At, B1); PG8_BAR;
            PG8_LDA(At, 0, 1); PG8_STAGE(PG8_SA(0, 0), a2, voffA);
            PG8_BAR; PG8_WAIT_L(0); PG8_MMA(1, 0, At, B0); PG8_BAR; PG8_SCHED;
            PG8_STAGE(PG8_SB(0, 1), b2 + hstep, voffB);
            PG8_WAIT_V(6); PG8_BAR; PG8_MMA(1, 1, At, B1); PG8_BAR;
            PG8_LDB(B0, 1, 0); PG8_SCHED; PG8_LDA(At, 1, 0); PG8_STAGE(PG8_SA(0, 1), a2 + hstep, voffA);
            PG8_WAIT_L(8); PG8_BAR; PG8_WAIT_L(0); PG8_MMA(0, 0, At, B0); PG8_BAR; PG8_SCHED;
            PG8_LDB(B1, 1, 1); PG8_STAGE(PG8_SB(1, 0), b3, voffB);
            PG8_BAR; PG8_WAIT_L(0); PG8_MMA(0, 1, At, B1); PG8_BAR;
            PG8_LDA(At, 1, 1); PG8_STAGE(PG8_SA(1, 0), a3, voffA);
            PG8_BAR; PG8_WAIT_L(0); PG8_MMA(1, 0, At, B0); PG8_BAR; PG8_SCHED;
            PG8_STAGE(PG8_SB(1, 1), b3 + hstep, voffB);
            PG8_WAIT_V(6); PG8_BAR; PG8_MMA(1, 1, At, B1); PG8_BAR;
            }
        }
        if (PROBE_A >= 0 && threadIdx.x == 0) *(PG8_LAS unsigned long long*)(lds + 135168 + 8 * 1) = __builtin_amdgcn_s_memrealtime();
        if constexpr (ALIGN_EPI) { if (wr == 0) PG8_BAR; }
        if (PROBE_A >= 0 && threadIdx.x == 0) *(PG8_LAS unsigned long long*)(lds + 135168 + 8 * 2) = __builtin_amdgcn_s_memrealtime();
        if constexpr (!Epi::AFTER_DRAIN) { E(acc, cur, wr, wc, fr, fq); S.done(cur); }   if (PROBE_A >= 0 && threadIdx.x == 0) *(PG8_LAS unsigned long long*)(lds + 135168 + 8 * 3) = __builtin_amdgcn_s_memrealtime();
        if (!has_next) break;
#pragma unroll
        for (int a = 0; a < 2; ++a)
#pragma unroll
            for (int b = 0; b < 2; ++b)
#pragma unroll
                for (int m = 0; m < 4; ++m)
#pragma unroll
                    for (int n = 0; n < 2; ++n) acc[a][b][m][n] = (f32x4){0.f, 0.f, 0.f, 0.f};
        cur = nxt; cA = nA; cB = nB; ++ui;
        if constexpr (ALIGN_EPI) { if (wr == 1) PG8_BAR; }
    }
    PG8_WAIT_V(0);
    if constexpr (!ALIGN_EPI) { if (wr == 0) PG8_BAR; }
    PG8_BAR;
    if constexpr (Epi::AFTER_DRAIN) { E.fused(acc, cur, wr, wc, fr, fq, lds, wid, lane); S.done(cur); }
#undef PG8_SA
#undef PG8_SB
#undef PG8_STAGE
#undef PG8_LDA
#undef PG8_LDB
#undef PG8_MMA
#undef PG8_WAIT_V
#undef PG8_WAIT_L
#undef PG8_BAR
#undef PG8_SCHED
}
}
#define SSTAMP(i) do { if (PROBE_A >= 0 && (int)blockIdx.x == PROBE_BID && tid == 0) { ((unsigned long long*)(p.CTL + 2048))[i] = __builtin_amdgcn_s_memrealtime(); } } while (0)
typedef pg8::f32x4 f32x4;
struct NoIn {};
template <class F> struct EpiGen {
    static constexpr bool PERM = true, AFTER_DRAIN = false; F f;
    __device__ __forceinline__ void operator()(const f32x4 (&acc)[2][2][4][2], const pg8::Unit& u, int wr, int wc, int fr, int fq) const {
        const int row0 = u.pm * 256 + wr * 64 + fr, col0 = u.pn * 256 + wc * 32 + 8 * fq;
        float ctx[8];
#pragma unroll
        for (int r = 0; r < 8; ++r) ctx[r] = f.row_begin(row0 + (r >> 2) * 128 + (r & 3) * 16);
        typename F::In8 cur[2], nxt[2];
#pragma unroll
        for (int g = 0; g < 2; ++g) cur[g] = f.load8(row0, col0 + g * 128);
#pragma unroll
        for (int r = 0; r < 8; ++r) { const int row = row0 + (r >> 2) * 128 + (r & 3) * 16;
            if (r < 7) { const int rn = row0 + ((r + 1) >> 2) * 128 + ((r + 1) & 3) * 16;
#pragma unroll
                for (int g = 0; g < 2; ++g) nxt[g] = f.load8(rn, col0 + g * 128); }
            float part = 0.f;
#pragma unroll
            for (int g = 0; g < 2; ++g) part += f.store8(ctx[r], row, col0 + g * 128, acc[r >> 2][g][r & 3][0], acc[r >> 2][g][r & 3][1], cur[g]);
            f.row_end(row, part, fq, true);
#pragma unroll
            for (int g = 0; g < 2; ++g) cur[g] = nxt[g]; }
    }
};
__device__ __forceinline__ f32x4 bf4lo(v4u w) { return (f32x4){bf2f((bf16_t)(w.x & 0xffff)), bf2f((bf16_t)(w.x >> 16)), bf2f((bf16_t)(w.y & 0xffff)), bf2f((bf16_t)(w.y >> 16))}; }
__device__ __forceinline__ f32x4 bf4hi(v4u w) { return (f32x4){bf2f((bf16_t)(w.z & 0xffff)), bf2f((bf16_t)(w.z >> 16)), bf2f((bf16_t)(w.w & 0xffff)), bf2f((bf16_t)(w.w >> 16))}; }
__device__ __forceinline__ v4u pk8(f32x4 a, f32x4 c) { v4u w; w.x = pk2(a[0], a[1]); w.y = pk2(a[2], a[3]); w.z = pk2(c[0], c[1]); w.w = pk2(c[2], c[3]); return w; }
template <int ACT  >
__device__ __forceinline__ void store_tile_bf16(const f32x4 (&acc)[2][2][4][2], int row0, int col0, const float (&rsv)[8], float scale, bf16_t* dst, int ld) {
#pragma unroll
    for (int ai = 0; ai < 2; ++ai)
#pragma unroll
        for (int m = 0; m < 4; ++m) { const int row = row0 + ai * 128 + m * 16; const float rs = rsv[ai * 4 + m] * scale; bf16_t* rp = dst + (size_t)row * ld + col0;
#pragma unroll
            for (int bj = 0; bj < 2; ++bj) { f32x4 v = acc[ai][bj][m][0] * rs, w = acc[ai][bj][m][1] * rs;
                if (ACT == 1) { v[0] = silu_fast(v[0]); v[1] = silu_fast(v[1]); v[2] = silu_fast(v[2]); v[3] = silu_fast(v[3]); w[0] = silu_fast(w[0]); w[1] = silu_fast(w[1]); w[2] = silu_fast(w[2]); w[3] = silu_fast(w[3]); }
                if (ACT == 2) { v[0] = sigmoid_fast(v[0]); v[1] = sigmoid_fast(v[1]); v[2] = sigmoid_fast(v[2]); v[3] = sigmoid_fast(v[3]); w[0] = sigmoid_fast(w[0]); w[1] = sigmoid_fast(w[1]); w[2] = sigmoid_fast(w[2]); w[3] = sigmoid_fast(w[3]); }
                *(v4u*)(rp + bj * 128) = pk8(v, w); } }
}
struct EpiProj {
    static constexpr bool PERM = true, AFTER_DRAIN = false;
    const float* rstd; const float* b_gate; bf16_t *QN, *KV6, *GQ, *GK, *GV, *GR, *BR; float *GATE, *LR, *out;
    __device__ __forceinline__ void operator()(const f32x4 (&acc)[2][2][4][2], const pg8::Unit& u, int wr, int wc, int fr, int fq) const {
        const int row0 = u.pm * 256 + wr * 64 + fr, cl0 = wc * 32 + 8 * fq, pn = u.pn;
        float rsv[8];
#pragma unroll
        for (int r = 0; r < 8; ++r) rsv[r] = rstd[row0 + (r >> 2) * 128 + (r & 3) * 16];
        if (pn < 4) store_tile_bf16<0>(acc, row0, pn * 256 + cl0, rsv, 0.125f, QN, 1024);
        else if (pn < 10) { const int j = pn - 4;
            store_tile_bf16<0>(acc, row0, j * 256 + cl0, rsv, 1.f, KV6, 1536);
#pragma unroll
            for (int ai = 0; ai < 2; ++ai)
#pragma unroll
                for (int m = 0; m < 4; ++m) { const int row = row0 + ai * 128 + m * 16; const float rs = rsv[ai * 4 + m]; const int b = row >> 11, t = row & 2047;
                    float* rp = nullptr;
                    if (j < 4) rp = out + OFF_PCK + j * SZ_PROW + (size_t)row * 256 + cl0;
                    else if (t >= 1536) rp = out + OFF_PWK + (j - 4) * SZ_PWIN + ((size_t)b * 512 + (t - 1536)) * 256 + cl0;
                    if (rp) {
#pragma unroll
                        for (int bj = 0; bj < 2; ++bj)
#pragma unroll
                            for (int n = 0; n < 2; ++n) *(f32x4*)(rp + bj * 128 + n * 4) = acc[ai][bj][m][n] * rs; } }
        }
        else if (pn < 12) store_tile_bf16<0>(acc, row0, (pn - 10) * 256 + cl0, rsv, 0.08838834764831845f, GQ, 512);
        else if (pn < 14) store_tile_bf16<0>(acc, row0, (pn - 12) * 256 + cl0, rsv, 1.f, GK, 512);
        else if (pn < 18) store_tile_bf16<0>(acc, row0, (pn - 14) * 256 + cl0, rsv, 1.f, GV, 1024);
        else if (pn < 22) store_tile_bf16<1>(acc, row0, (pn - 18) * 256 + cl0, rsv, 1.f, GR, 1024);
        else if (pn < 38) store_tile_bf16<2>(acc, row0, (pn - 22) * 256 + cl0, rsv, 1.f, BR, 4096);
        else if (wc < 2) {
#pragma unroll
            for (int ai = 0; ai < 2; ++ai)
#pragma unroll
                for (int m = 0; m < 4; ++m) { const int row = row0 + ai * 128 + m * 16; const float rs = rsv[ai * 4 + m];
#pragma unroll
                    for (int n = 0; n < 2; ++n) { const int cl = cl0 + n * 4; const f32x4 v = acc[ai][0][m][n] * rs;
                        if (cl < 48) { const f32x4 bg = *(const f32x4*)(b_gate + cl); f32x4 o; o[0] = sigmoid_fast(v[0] + bg[0]); o[1] = sigmoid_fast(v[1] + bg[1]); o[2] = sigmoid_fast(v[2] + bg[2]); o[3] = sigmoid_fast(v[3] + bg[3]);
                            *(f32x4*)(GATE + (size_t)row * 48 + cl) = o; }
                        else *(f32x4*)(LR + (size_t)row * 16 + (cl - 48)) = v; } }
        }
    }
};
struct F_bra { const bf16_t* BR; bf16_t* TMPB; typedef v2u In;
    typedef v4u In8;
    __device__ __forceinline__ In8 load8(int row, int col) const { return *(const v4u*)(BR + (size_t)row * 4096 + col); }
    __device__ __forceinline__ float store8(float, int row, int col, f32x4 v, f32x4 w, const In8& g) const { *(v4u*)(TMPB + (size_t)row * DM + col) = pk8(v * bf4lo(g), w * bf4hi(g)); return 0.f; }
    __device__ __forceinline__ float row_begin(int) const { return 0.f; }
    __device__ __forceinline__ In load4(int row, int col) const { return *(const v2u*)(BR + (size_t)row * 4096 + col); }
    __device__ __forceinline__ float store4(float, int row, int col, f32x4 v, const In& b) const {
        v2u w; w.x = pk2(v[0] * bf2f((bf16_t)(b.x & 0xffff)), v[1] * bf2f((bf16_t)(b.x >> 16))); w.y = pk2(v[2] * bf2f((bf16_t)(b.y & 0xffff)), v[3] * bf2f((bf16_t)(b.y >> 16)));
        *(v2u*)(TMPB + (size_t)row * DM + col) = w; return 0.f; }
    __device__ __forceinline__ void row_end(int, float, int, bool) const {}
};
struct F_brb { const bf16_t* BR; const bf16_t* TMPB; bf16_t* MB; struct In { v2u b; v2u t; };
    struct In8 { v4u b; v4u t; };
    __device__ __forceinline__ In8 load8(int row, int col) const { In8 i; i.b = *(const v4u*)(BR + (size_t)row * 4096 + 2048 + col); i.t = *(const v4u*)(TMPB + (size_t)row * DM + col); return i; }
    __device__ __forceinline__ float store8(float, int row, int col, f32x4 v, f32x4 w, const In8& i) const { *(v4u*)(MB + (size_t)row * DM + col) = pk8(bf4lo(i.t) + v * bf4lo(i.b), bf4hi(i.t) + w * bf4hi(i.b)); return 0.f; }
    __device__ __forceinline__ float row_begin(int) const { return 0.f; }
    __device__ __forceinline__ In load4(int row, int col) const { In i; i.b = *(const v2u*)(BR + (size_t)row * 4096 + 2048 + col); i.t = *(const v2u*)(TMPB + (size_t)row * DM + col); return i; }
    __device__ __forceinline__ float store4(float, int row, int col, f32x4 v, const In& i) const { const v2u b = i.b, t = i.t;
        const float o0 = bf2f((bf16_t)(t.x & 0xffff)) + v[0] * bf2f((bf16_t)(b.x & 0xffff)), o1 = bf2f((bf16_t)(t.x >> 16)) + v[1] * bf2f((bf16_t)(b.x >> 16));
        const float o2 = bf2f((bf16_t)(t.y & 0xffff)) + v[2] * bf2f((bf16_t)(b.y & 0xffff)), o3 = bf2f((bf16_t)(t.y >> 16)) + v[3] * bf2f((bf16_t)(b.y >> 16));
        v2u w; w.x = pk2(o0, o1); w.y = pk2(o2, o3); *(v2u*)(MB + (size_t)row * DM + col) = w; return 0.f; }
    __device__ __forceinline__ void row_end(int, float, int, bool) const {}
};
struct F_wo { const float* x; bf16_t* X1B; float* SUMSQ; typedef f32x4 In;
    struct In8 { f32x4 a, c; };
    __device__ __forceinline__ In8 load8(int row, int col) const { In8 i; i.a = *(const f32x4*)(x + (size_t)row * DM + col); i.c = *(const f32x4*)(x + (size_t)row * DM + col + 4); return i; }
    __device__ __forceinline__ float store8(float, int row, int col, f32x4 v, f32x4 w, const In8& i) const { const f32x4 a = i.a + v, c = i.c + w; *(v4u*)(X1B + (size_t)row * DM + col) = pk8(a, c);
        return ((a[0] * a[0] + a[1] * a[1]) + (a[2] * a[2] + a[3] * a[3])) + ((c[0] * c[0] + c[1] * c[1]) + (c[2] * c[2] + c[3] * c[3])); }
    __device__ __forceinline__ float row_begin(int) const { return 0.f; }
    __device__ __forceinline__ In load4(int row, int col) const { return *(const f32x4*)(x + (size_t)row * DM + col); }
    __device__ __forceinline__ float store4(float, int row, int col, f32x4 v, const In& xv) const { const f32x4 x1 = xv + v;
        v2u w; w.x = pk2(x1[0], x1[1]); w.y = pk2(x1[2], x1[3]); *(v2u*)(X1B + (size_t)row * DM + col) = w;
        return (x1[0] * x1[0] + x1[1] * x1[1]) + (x1[2] * x1[2] + x1[3] * x1[3]); }
    __device__ __forceinline__ void row_end(int row, float part, int fq, bool valid) const { part += __shfl_xor(part, 16); part += __shfl_xor(part, 32); if (fq == 0 && valid) atomicAdd(SUMSQ + row, part); }
};
struct F_up { const float* SUMSQ; bf16_t* HF; typedef NoIn In;
    typedef NoIn In8;
    __device__ __forceinline__ In8 load8(int, int) const { return NoIn{}; }
    __device__ __forceinline__ float store8(float rs, int row, int col, f32x4 v, f32x4 w, const In8&) const { f32x4 a, c;
#pragma unroll
        for (int i = 0; i < 4; ++i) { const float t = fmaxf(v[i] * rs, 0.f), s = fmaxf(w[i] * rs, 0.f); a[i] = t * t; c[i] = s * s; }
        *(v4u*)(HF + (size_t)row * DFF + col) = pk8(a, c); return 0.f; }
    __device__ __forceinline__ float row_begin(int row) const { return rsqrtf(SUMSQ[row] * (1.f / DM) + EPS); }
    __device__ __forceinline__ In load4(int, int) const { return NoIn{}; }
    __device__ __forceinline__ float store4(float rs, int row, int col, f32x4 v, const In&) const { float h[4];
#pragma unroll
        for (int i = 0; i < 4; ++i) { const float t = fmaxf(v[i] * rs, 0.f); h[i] = t * t; }
        v2u w; w.x = pk2(h[0], h[1]); w.y = pk2(h[2], h[3]); *(v2u*)(HF + (size_t)row * DFF + col) = w; return 0.f; }
    __device__ __forceinline__ void row_end(int, float, int, bool) const {}
};
struct F_down { const bf16_t* X1B; bf16_t* YB; float* SUMSQ; typedef v2u In;
    typedef v4u In8;
    __device__ __forceinline__ In8 load8(int row, int col) const { return *(const v4u*)(X1B + (size_t)row * DM + col); }
    __device__ __forceinline__ float store8(float, int row, int col, f32x4 v, f32x4 w, const In8& t) const { const f32x4 a = bf4lo(t) + v, c = bf4hi(t) + w; *(v4u*)(YB + (size_t)row * DM + col) = pk8(a, c);
        return ((a[0] * a[0] + a[1] * a[1]) + (a[2] * a[2] + a[3] * a[3])) + ((c[0] * c[0] + c[1] * c[1]) + (c[2] * c[2] + c[3] * c[3])); }
    __device__ __forceinline__ float row_begin(int) const { return 0.f; }
    __device__ __forceinline__ In load4(int row, int col) const { return *(const v2u*)(X1B + (size_t)row * DM + col); }
    __device__ __forceinline__ float store4(float, int row, int col, f32x4 v, const In& t) const {
        const float a0 = bf2f((bf16_t)(t.x & 0xffff)) + v[0], a1 = bf2f((bf16_t)(t.x >> 16)) + v[1], a2 = bf2f((bf16_t)(t.y & 0xffff)) + v[2], a3 = bf2f((bf16_t)(t.y >> 16)) + v[3];
        v2u w; w.x = pk2(a0, a1); w.y = pk2(a2, a3); *(v2u*)(YB + (size_t)row * DM + col) = w; return (a0 * a0 + a1 * a1) + (a2 * a2 + a3 * a3); }
    __device__ __forceinline__ void row_end(int row, float part, int fq, bool valid) const { part += __shfl_xor(part, 16); part += __shfl_xor(part, 32); if (fq == 0 && valid) atomicAdd(SUMSQ + row, part); }
};

struct EpiDownNorm {
    static constexpr bool PERM = true, AFTER_DRAIN = true;
    const bf16_t* X1B; float* SUMSQ; float* Y; const float* norm_f; unsigned* pcnt;
    __device__ __forceinline__ void fused(f32x4 (&acc)[2][2][4][2], const pg8::Unit& u, int wr, int wc, int fr, int fq, PG8_LAS unsigned char* lds, int wid, int lane) const {
        const int row0 = u.pm * 256 + wr * 64 + fr, col0 = u.pn * 256 + wc * 32 + 8 * fq;
        v4u cur[2], nxt[2];
#pragma unroll
        for (int g = 0; g < 2; ++g) cur[g] = *(const v4u*)(X1B + (size_t)row0 * DM + col0 + g * 128);
#pragma unroll
        for (int r = 0; r < 8; ++r) { const int row = row0 + (r >> 2) * 128 + (r & 3) * 16;
            if (r < 7) { const int rn = row0 + ((r + 1) >> 2) * 128 + ((r + 1) & 3) * 16;
#pragma unroll
                for (int g = 0; g < 2; ++g) nxt[g] = *(const v4u*)(X1B + (size_t)rn * DM + col0 + g * 128); }
            float part = 0.f;
#pragma unroll
            for (int g = 0; g < 2; ++g) { f32x4& a = acc[r >> 2][g][r & 3][0]; f32x4& c = acc[r >> 2][g][r & 3][1]; a = a + bf4lo(cur[g]); c = c + bf4hi(cur[g]);
                part += ((a[0] * a[0] + a[1] * a[1]) + (a[2] * a[2] + a[3] * a[3])) + ((c[0] * c[0] + c[1] * c[1]) + (c[2] * c[2] + c[3] * c[3])); }
            part += __shfl_xor(part, 16); part += __shfl_xor(part, 32); if (fq == 0) atomicAdd(SUMSQ + row, part);
#pragma unroll
            for (int g = 0; g < 2; ++g) cur[g] = nxt[g]; }
        asm volatile("s_waitcnt vmcnt(0)" ::: "memory"); __syncthreads();
        if (threadIdx.x == 0) { __builtin_amdgcn_fence(__ATOMIC_RELEASE, "agent"); asm volatile("s_waitcnt vmcnt(0)" ::: "memory");
            __hip_atomic_fetch_add(pcnt + 64 * u.pm, 1u, __ATOMIC_RELAXED, __HIP_MEMORY_SCOPE_AGENT);
            unsigned sp = 0; while (__hip_atomic_load(pcnt + 64 * u.pm, __ATOMIC_RELAXED, __HIP_MEMORY_SCOPE_AGENT) < 8u) { __builtin_amdgcn_s_sleep(1); if (++sp > (1u << 22)) break; }
            __builtin_amdgcn_fence(__ATOMIC_ACQUIRE, "agent"); asm volatile("s_waitcnt vmcnt(0)" ::: "memory"); }
        __syncthreads();
#pragma unroll
        for (int r = 0; r < 8; ++r) { const int row = row0 + (r >> 2) * 128 + (r & 3) * 16;
            const float rs = rsqrtf(__hip_atomic_load(SUMSQ + row, __ATOMIC_RELAXED, __HIP_MEMORY_SCOPE_AGENT) * (1.f / DM) + EPS);
#pragma unroll
            for (int g = 0; g < 2; ++g) { const int col = col0 + g * 128; const f32x4 g0 = *(const f32x4*)(norm_f + col), g1 = *(const f32x4*)(norm_f + col + 4);
                *(f32x4*)(Y + (size_t)row * DM + col) = acc[r >> 2][g][r & 3][0] * rs * g0; *(f32x4*)(Y + (size_t)row * DM + col + 4) = acc[r >> 2][g][r & 3][1] * rs * g1; } }
    }
    __device__ __forceinline__ void operator()(const f32x4 (&)[2][2][4][2], const pg8::Unit&, int, int, int, int) const {}
};

typedef short bf16x8_t __attribute__((ext_vector_type(8)));
template <class F>
__device__ __forceinline__ void skinny_gemm(LAS unsigned char* lds, const bf16_t* A, int lda, const bf16_t* Bt, int N, int K, const F& f, int bid, int G, int tid) {
    const int lane = tid & 63, wave = __builtin_amdgcn_readfirstlane(tid >> 6), j = lane & 15, g = lane >> 4;
    LAS f32x4* red = (LAS f32x4*)lds;
    const int ksl = K >> 3;
    for (int it = bid; it < (N >> 4); it += G) {
        const int n0 = it * 16;
        const bf16_t* bp = Bt + (size_t)(n0 + j) * K + wave * ksl + 8 * g;
        const bf16_t* ap = A + (size_t)(j & 7) * lda + wave * ksl + 8 * g;
        f32x4 acc = {0.f, 0.f, 0.f, 0.f};
#pragma unroll 4
        for (int k = 0; k < ksl; k += 32) {
            const bf16x8_t b = *(const bf16x8_t*)(bp + k); bf16x8_t a = *(const bf16x8_t*)(ap + k);
            if (j >= 8) a = (bf16x8_t){0, 0, 0, 0, 0, 0, 0, 0};
            acc = __builtin_amdgcn_mfma_f32_16x16x32_bf16(b, a, acc, 0, 0, 0);
        }
        red[wave * 64 + lane] = acc;
        __syncthreads();
        if (wave == 0) { f32x4 sacc = red[lane];
#pragma unroll
            for (int w = 1; w < 8; ++w) sacc = sacc + red[w * 64 + lane];
            const int row = NPT + (j & 7); const bool valid = j < 8; const float ctx = f.row_begin(row); float part = 0.f;
            const typename F::In in = f.load4(row, n0 + 4 * g);
            if (valid) part = f.store4(ctx, row, n0 + 4 * g, sacc, in);
            f.row_end(row, part, g, valid); }
        __syncthreads();
    }
}
struct F_proj_s { const Params& p; typedef NoIn In;
    __device__ __forceinline__ float row_begin(int row) const { return p.RSTD1[row]; }
    __device__ __forceinline__ In load4(int, int) const { return NoIn{}; }
    __device__ __forceinline__ float store4(float rs, int row, int col, f32x4 v, const In&) const { const int n0 = in_colmap(col); if (n0 >= 0) {
#pragma unroll
        for (int i = 0; i < 4; ++i) proj_store(p, row, n0 + i, v[i] * rs); } return 0.f; }
    __device__ __forceinline__ void row_end(int, float, int, bool) const {}
};

struct TrRegs { f32x4 v[8]; };
template <class CM>
__device__ __forceinline__ TrRegs transpose_load(const float* W, int ldw, const float* kscale, int item, int nblk, CM cm, int lane) {
    const int kb = item / nblk, nb = item % nblk, k0 = 64 * kb, n0 = 32 * nb;
    const int n4 = (lane & 7) * 4, kr = lane >> 3;
    const int sc = cm(n0 + n4);
    TrRegs t;
#pragma unroll
    for (int i = 0; i < 8; ++i) t.v[i] = sc >= 0 ? *(const f32x4*)(W + (size_t)(k0 + 8 * i + kr) * ldw + sc) : (f32x4){0.f, 0.f, 0.f, 0.f};
    if (kscale) {
#pragma unroll
        for (int i = 0; i < 8; ++i) t.v[i] = t.v[i] * kscale[k0 + 8 * i + kr]; }
    return t;
}
__device__ __forceinline__ void transpose_store(const TrRegs& t, bf16_t* WT, int K, int item, int nblk, LAS float* scr, int lane) {
    const int kb = item / nblk, nb = item % nblk, k0 = 64 * kb, n0 = 32 * nb;
    const int n4 = (lane & 7) * 4, kr = lane >> 3;
#pragma unroll
    for (int i = 0; i < 8; ++i) { LAS float* d = scr + (8 * i + kr) * 33 + n4; d[0] = t.v[i][0]; d[1] = t.v[i][1]; d[2] = t.v[i][2]; d[3] = t.v[i][3]; }
    LDS_WAIT(); asm volatile("" ::: "memory");
    const int c = lane & 7;
#pragma unroll
    for (int j = 0; j < 4; ++j) { const int n = (lane >> 3) + 8 * j; const LAS float* s = scr + (8 * c) * 33 + n;
        v4u o; o.x = pk2(s[0 * 33], s[1 * 33]); o.y = pk2(s[2 * 33], s[3 * 33]); o.z = pk2(s[4 * 33], s[5 * 33]); o.w = pk2(s[6 * 33], s[7 * 33]);
        *(v4u*)(WT + (size_t)(n0 + n) * K + k0 + 8 * c) = o; }
    LDS_WAIT(); asm volatile("" ::: "memory");
}
template <class CM>
__device__ __forceinline__ void transpose_item(const float* W, int ldw, const float* kscale, bf16_t* WT, int K, int item, int nblk, CM cm, LAS float* scr, int lane) {
    const TrRegs t = transpose_load(W, ldw, kscale, item, nblk, cm, lane); transpose_store(t, WT, K, item, nblk, scr, lane);
}
struct CM_id { __device__ __forceinline__ int operator()(int n) const { return n; } };
struct CM_in { __device__ __forceinline__ int operator()(int n) const { return in_colmap(n); } };

__device__ __forceinline__ void ph_prologue(const Params& p, LAS unsigned char* lds, int bid, int G, int tid, int parts  ) {
    const int lane = tid & 63, wave = tid >> 6, gw = bid * 8 + wave, NGW = G * 8;
    LAS float* scr = (LAS float*)(lds + wave * 16384);
    constexpr int I_IN = 32 * (NIN_PAD / 32);
    if ((parts & 1) && gw < I_IN) { TrRegs cur = transpose_load(p.w_in, DIN, p.norm1_g, gw, NIN_PAD / 32, CM_in{}, lane);
        for (int it = gw; it < I_IN; it += NGW) { const int nx = it + NGW; TrRegs nxt = cur; if (nx < I_IN) nxt = transpose_load(p.w_in, DIN, p.norm1_g, nx, NIN_PAD / 32, CM_in{}, lane);
            transpose_store(cur, p.WIN_T, DM, it, NIN_PAD / 32, scr, lane); cur = nxt; } }
    if (!(parts & 2)) return;
    for (int row = gw; row < NTOK; row += NGW) {
        const f32x4* xr = (const f32x4*)(row < NPT ? p.x_prompt + (size_t)row * DM : p.x_sample + (size_t)(row - NPT) * DM) + 2 * lane;
        f32x4 v[8]; float ss = 0.f;
#pragma unroll
        for (int j = 0; j < 4; ++j) { v[2 * j] = xr[128 * j]; v[2 * j + 1] = xr[128 * j + 1]; }
#pragma unroll
        for (int j = 0; j < 8; ++j) ss += (v[j][0] * v[j][0] + v[j][1] * v[j][1]) + (v[j][2] * v[j][2] + v[j][3] * v[j][3]);
        ss = wave_sum(ss);
        v4u* o = (v4u*)(p.XB + (size_t)row * DM) + lane;
#pragma unroll
        for (int j = 0; j < 4; ++j) o[64 * j] = pk8(v[2 * j], v[2 * j + 1]);
        if (lane == 0) p.RSTD1[row] = rsqrtf(ss * (1.f / DM) + EPS);
    }
    for (int i = bid * 512 + tid; i < DB * 511 * 64; i += G * 512) { const int c4 = i & 63, r = (i >> 6) % 511, b = (i >> 6) / 511;
        const size_t so = ((size_t)b * 512 + r + 1) * 256 + c4 * 4, dofs = ((size_t)b * 512 + r) * 256 + c4 * 4;
        *(f32x4*)(p.out + OFF_SWK + dofs) = *(const f32x4*)(p.cwk + so); *(f32x4*)(p.out + OFF_SWK + SZ_SWIN + dofs) = *(const f32x4*)(p.cwv + so); }
}
__device__ __forceinline__ void ph_late_weights(const Params& p, LAS unsigned char* lds, int gw, int ngw, int tid, int it0 = 0, int it1 = 1 << 30) {
    const int lane = tid & 63, wave = tid >> 6;
    LAS float* scr = (LAS float*)(lds + wave * 16384);
    constexpr int I_BR = 16 * 64, I_O = 32 * 64, I_UP = 32 * 256, I_DN = 128 * 64, TOTAL = 2 * I_BR + I_O + I_UP + I_DN;
    struct Desc { const float* W; const float* ks; bf16_t* WT; int ldw, K, r, nblk; };
    auto desc = [&](int it) { Desc d; int r = it;
        if (r < I_BR) { d = Desc{p.w_br_a, nullptr, p.WBRA_T, DM, 1024, r, 64}; return d; } r -= I_BR;
        if (r < I_BR) { d = Desc{p.w_br_b, nullptr, p.WBRB_T, DM, 1024, r, 64}; return d; } r -= I_BR;
        if (r < I_O) { d = Desc{p.w_o, nullptr, p.WO_T, DM, DM, r, 64}; return d; } r -= I_O;
        if (r < I_UP) { d = Desc{p.w_up, p.norm2_g, p.WUP_T, DFF, DM, r, 256}; return d; } r -= I_UP;
        d = Desc{p.w_down, nullptr, p.WDN_T, DM, DFF, r, 64}; return d; };
    const int iend = it1 < TOTAL ? it1 : TOTAL;
    if (it0 + gw < iend) { Desc dc = desc(it0 + gw); TrRegs cur = transpose_load(dc.W, dc.ldw, dc.ks, dc.r, dc.nblk, CM_id{}, lane);
        for (int it = it0 + gw; it < iend; it += ngw) { const int nx = it + ngw; Desc dn = dc; TrRegs nxt = cur;
            if (nx < iend) { dn = desc(nx); nxt = transpose_load(dn.W, dn.ldw, dn.ks, dn.r, dn.nblk, CM_id{}, lane); }
            transpose_store(cur, dc.WT, dc.K, dc.r, dc.nblk, scr, lane); cur = nxt; dc = dn; } }
}
__device__ __forceinline__ void ph_final_norm(const Params& p, int bid, int G, int tid, int rbeg = 0) {
    const int lane = tid & 63, wave = tid >> 6, gw = rbeg + bid * 8 + wave, NGW = G * 8;
    const bf16_t* YB = (const bf16_t*)p.X1;
    for (int row = gw; row < NTOK; row += NGW) {
        float* yr = row < NPT ? p.out + OFF_Y + (size_t)row * DM : p.out + OFF_YS + (size_t)(row - NPT) * DM;
        const float r = rsqrtf(p.SUMSQ3[row] * (1.f / DM) + EPS);
        const v4u* s8 = (const v4u*)(YB + (size_t)row * DM) + lane; f32x4* y4 = (f32x4*)yr + 2 * lane; const f32x4* g4 = (const f32x4*)p.norm_f + 2 * lane;
        v4u t[4];
#pragma unroll
        for (int j = 0; j < 4; ++j) t[j] = s8[64 * j];
#pragma unroll
        for (int j = 0; j < 4; ++j) { y4[128 * j] = bf4lo(t[j]) * r * g4[128 * j]; y4[128 * j + 1] = bf4hi(t[j]) * r * g4[128 * j + 1]; }
    }
}

__device__ __forceinline__ unsigned pk2t(float lo, float hi) { return pk2(lo, hi); }
template <bool IS_S>
__device__ __forceinline__ void cmp_gemm_tile(const Params& p, LAS unsigned char* lds, int tile, int tid) {
    const int lane = tid & 63, wave = __builtin_amdgcn_readfirstlane(tid >> 6), wm = wave >> 2, wn = wave & 3, fr = lane & 15, fg = lane >> 4;
    int kv, b, ct = 0, g = 0;
    if (IS_S) { ct = tile % 33; b = (tile / 33) & 7; kv = tile / 264; } else { g = tile & 3; b = (tile >> 2) & 3; kv = tile >> 4; }
    const int c0 = IS_S ? 31 * ct : 0;
    const bf16_t* W = p.W1T + (size_t)kv * 256 * 1024;
    const float* abasef = kv ? p.ccv : p.cck; const bf16_t* abaseb = p.KV6;
    unsigned aof[4];
#pragma unroll
    for (int q = 0; q < 4; ++q) { const int i = q * 32 + (tid >> 4), d4 = (tid & 15) * 4;
        if (IS_S) { const int cl = i >> 2, gg = i & 3, c = c0 + cl; const int page = p.page_table[b * NPAGES + (c >> 3)];
            aof[q] = (unsigned)((((size_t)page * PAGE + (c & 7) * 16) * 4 + gg) * 64 + d4); }
        else aof[q] = (unsigned)(((size_t)(b * SEQ + 16 * i)) * 1536 + kv * 256 + g * 64 + d4); }
    const unsigned bof = (unsigned)((tid >> 3) * 1024 + (tid & 7) * 8);
    f32x4 ra0[4], ra1[4], ra2[4]; v2u rab0[4], rab1[4], rab2[4]; v4u rb0[4];
#define CMP_LOADA(S, r) do { _Pragma("unroll") for (int q = 0; q < 4; ++q) { if (IS_S) ra##S[q] = __builtin_nontemporal_load((const f32x4*)(abasef + aof[q] + (unsigned)(r) * 256u)); else rab##S[q] = *(const v2u*)(abaseb + aof[q] + (unsigned)(r) * 1536u); } } while (0)
#define CMP_LOADB(T, r) do { _Pragma("unroll") for (int q = 0; q < 4; ++q) rb##T[q] = *(const v4u*)(W + bof + (unsigned)(q * 64 * 1024 + (r) * 64)); } while (0)
#define CMP_WRITE(S, T, s) do { LAS unsigned char* ab_ = lds + (s) * 55296; LAS unsigned char* bb_ = ab_ + 18432; \
        _Pragma("unroll") for (int q = 0; q < 4; ++q) { const int i_ = q * 32 + (tid >> 4), d4_ = (tid & 15) * 4; v2u w_; \
            if (IS_S) { w_.x = pk2(ra##S[q][0], ra##S[q][1]); w_.y = pk2(ra##S[q][2], ra##S[q][3]); } else w_ = rab##S[q]; \
            *(LAS v2u*)(ab_ + i_ * 144 + d4_ * 2) = w_; *(LAS v4u*)(bb_ + (q * 64 + (tid >> 3)) * 144 + (tid & 7) * 16) = rb##T[q]; } } while (0)
#define CMP_COMPUTE(s) do { const LAS unsigned char* ab_ = lds + (s) * 55296; const LAS unsigned char* bb_ = ab_ + 18432; \
        _Pragma("unroll") for (int ks = 0; ks < 2; ++ks) { bf16x8_t bfr[4]; \
            _Pragma("unroll") for (int ni = 0; ni < 4; ++ni) bfr[ni] = *(const LAS bf16x8_t*)(bb_ + (64 * wn + 16 * ni + fr) * 144 + (32 * ks + 8 * fg) * 2); \
            _Pragma("unroll") for (int mi = 0; mi < 4; ++mi) { const bf16x8_t af = *(const LAS bf16x8_t*)(ab_ + (64 * wm + 16 * mi + fr) * 144 + (32 * ks + 8 * fg) * 2); \
                _Pragma("unroll") for (int ni = 0; ni < 4; ++ni) acc[mi][ni] = __builtin_amdgcn_mfma_f32_16x16x32_bf16(bfr[ni], af, acc[mi][ni], 0, 0, 0); } } } while (0)
#define CMP_STEP(r, AF, AW, BC, BW) do { if ((r) < 16) { if ((r) + 3 < 16) CMP_LOADA(AF, (r) + 3); if ((r) + 1 < 16) CMP_LOADB(0, (r) + 1); CMP_COMPUTE(BC); if ((r) + 1 < 16) CMP_WRITE(AW, 0, BW); LDS_BARRIER(); } } while (0)
    f32x4 acc[4][4];
#pragma unroll
    for (int mi = 0; mi < 4; ++mi)
#pragma unroll
        for (int ni = 0; ni < 4; ++ni) acc[mi][ni] = (f32x4){0.f, 0.f, 0.f, 0.f};
    CMP_LOADA(0, 0); CMP_LOADB(0, 0); CMP_LOADA(1, 1); CMP_LOADA(2, 2); CMP_WRITE(0, 0, 0); LDS_BARRIER();
#pragma unroll 1
    for (int r = 0; r < 16; r += 6) {
        CMP_STEP(r, 0, 1, 0, 1); CMP_STEP(r + 1, 1, 2, 1, 0); CMP_STEP(r + 2, 2, 0, 0, 1);
        CMP_STEP(r + 3, 0, 1, 1, 0); CMP_STEP(r + 4, 1, 2, 0, 1); CMP_STEP(r + 5, 2, 0, 1, 0);
    }
#undef CMP_LOADA
#undef CMP_LOADB
#undef CMP_STEP
#undef CMP_WRITE
#undef CMP_COMPUTE
    if (!IS_S) {
        float* AB = p.AB_P + (size_t)kv * 2048 * 256;
#pragma unroll
        for (int mi = 0; mi < 4; ++mi) { const int i = 64 * wm + 16 * mi + fr; const size_t R = (size_t)(b * 4 + g) * 128 + i;
#pragma unroll
            for (int ni = 0; ni < 4; ++ni) *(f32x4*)(AB + R * 256 + 64 * wn + 16 * ni + 4 * fg) = acc[mi][ni]; }
    } else {
        LAS float* BH = (LAS float*)lds;
        LAS unsigned char* H = lds + 67584; LAS unsigned char* W2T = lds + 67584 + 34816;
        const float* bias = p.BIAS1 + kv * 128;
        if (wn >= 2) {
#pragma unroll
            for (int mi = 0; mi < 4; ++mi) { const int i = 64 * wm + 16 * mi + fr;
#pragma unroll
                for (int ni = 0; ni < 4; ++ni) *(LAS f32x4*)(BH + i * 132 + 64 * (wn - 2) + 16 * ni + 4 * fg) = acc[mi][ni]; } }
#pragma unroll
        for (int k = 0; k < 2; ++k) { const int idx8 = tid * 8 + 4096 * k, d = idx8 >> 7, j = idx8 & 127; *(LAS v4u*)(W2T + d * 272 + j * 2) = *(const v4u*)(p.W2TG + kv * 8192 + idx8); }
        __syncthreads();
        if (wn < 2) {
#pragma unroll
            for (int mi = 0; mi < 4; ++mi) { const int i = 64 * wm + 16 * mi + fr;
#pragma unroll
                for (int ni = 0; ni < 4; ++ni) { const int j = 64 * wn + 16 * ni + 4 * fg; v2u w; w.x = 0u; w.y = 0u;
                    if (i < 124) { const f32x4 bq = *(const LAS f32x4*)(BH + (i + 4) * 132 + j), bi = *(const f32x4*)(bias + j); const f32x4 hv = acc[mi][ni] + bq + bi;
                        w.x = pk2(gelu_fast(hv[0]), gelu_fast(hv[1])); w.y = pk2(gelu_fast(hv[2]), gelu_fast(hv[3])); }
                    *(LAS v2u*)(H + i * 272 + j * 2) = w; } } }
        __syncthreads();
        f32x4 a2[4];
#pragma unroll
        for (int ni = 0; ni < 4; ++ni) a2[ni] = (f32x4){0.f, 0.f, 0.f, 0.f};
#pragma unroll
        for (int ks = 0; ks < 4; ++ks) { const bf16x8_t hb = *(const LAS bf16x8_t*)(H + (16 * wave + fr) * 272 + (32 * ks + 8 * fg) * 2);
#pragma unroll
            for (int ni = 0; ni < 4; ++ni) { const bf16x8_t wa = *(const LAS bf16x8_t*)(W2T + (16 * ni + fr) * 272 + (32 * ks + 8 * fg) * 2);
                a2[ni] = __builtin_amdgcn_mfma_f32_16x16x32_bf16(wa, hb, a2[ni], 0, 0, 0); } }
        { const int i = 16 * wave + fr, cl = i >> 2, gg = i & 3;
          if (cl < 31 || ct == 32) { bf16_t* dst = (kv ? p.VCMP_S : p.KCMP_S) + ((size_t)(b * 4 + gg) * 1024 + c0 + cl) * 64;
#pragma unroll
              for (int ni = 0; ni < 4; ++ni) { v2u w; w.x = pk2(a2[ni][0], a2[ni][1]); w.y = pk2(a2[ni][2], a2[ni][3]); *(v2u*)(dst + 16 * ni + 4 * fg) = w; } } }
        __syncthreads();
    }
}
template <bool IS_S>
__device__ __forceinline__ void cmp_part2(const Params& p, LAS unsigned char* lds, int kv, int bg, int i0, int tid) {
    constexpr int n_cmp = IS_S ? 1023 : 127, nrs = IS_S ? 1024 : 128;
    const int lane = tid & 63, wave = __builtin_amdgcn_readfirstlane(tid >> 6), fr = lane & 15, fg = lane >> 4;
    const float* AB = (IS_S ? p.AB_S + (size_t)kv * 32768 * 256 : p.AB_P + (size_t)kv * 2048 * 256) + (size_t)bg * nrs * 256;
    LAS unsigned char* H = lds; LAS unsigned char* W2T = lds + 128 * 272;
    const float* w2 = kv ? p.w2v : p.w2k; const float* bias = p.BIAS1 + kv * 128;
    for (int idx = tid; idx < 128 * 32; idx += 512) { const int row = idx >> 5, j4 = (idx & 31) * 4, i = i0 + row; v2u w; w.x = 0u; w.y = 0u;
        if (i < n_cmp) { const f32x4 a = *(const f32x4*)(AB + (size_t)i * 256 + j4), bq = *(const f32x4*)(AB + (size_t)(i + 1) * 256 + 128 + j4), bi = *(const f32x4*)(bias + j4);
            const f32x4 h = a + bq + bi; w.x = pk2(gelu_fast(h[0]), gelu_fast(h[1])); w.y = pk2(gelu_fast(h[2]), gelu_fast(h[3])); }
        *(LAS v2u*)(H + row * 272 + j4 * 2) = w; }
    for (int idx = tid; idx < 8192; idx += 512) { const int j = idx >> 6, d = idx & 63; *(LAS bf16_t*)(W2T + d * 272 + j * 2) = f2bf(w2[idx]); }
    __syncthreads();
    f32x4 acc[4];
#pragma unroll
    for (int ni = 0; ni < 4; ++ni) acc[ni] = (f32x4){0.f, 0.f, 0.f, 0.f};
#pragma unroll
    for (int ks = 0; ks < 4; ++ks) { const bf16x8_t hb = *(const LAS bf16x8_t*)(H + (16 * wave + fr) * 272 + (32 * ks + 8 * fg) * 2);
#pragma unroll
        for (int ni = 0; ni < 4; ++ni) { const bf16x8_t wa = *(const LAS bf16x8_t*)(W2T + (16 * ni + fr) * 272 + (32 * ks + 8 * fg) * 2);
            acc[ni] = __builtin_amdgcn_mfma_f32_16x16x32_bf16(wa, hb, acc[ni], 0, 0, 0); } }
    const int i = i0 + 16 * wave + fr;
    if (i < nrs) {
#pragma unroll
        for (int ni = 0; ni < 4; ++ni) { const int d = 16 * ni + 4 * fg;
            if (IS_S) { v2u w; w.x = pk2(acc[ni][0], acc[ni][1]); w.y = pk2(acc[ni][2], acc[ni][3]); *(v2u*)((kv ? p.VCMP_S : p.KCMP_S) + ((size_t)bg * 1024 + i) * 64 + d) = w; }
            else if (kv == 0) { v2u w; w.x = pk2(acc[ni][0], acc[ni][1]); w.y = pk2(acc[ni][2], acc[ni][3]); *(v2u*)(p.KCMP_P + ((size_t)bg * 128 + i) * 64 + d) = w; }
            else {
#pragma unroll
                for (int r = 0; r < 4; ++r) p.VCMPT_P[((size_t)bg * 64 + d + r) * 128 + i] = f2bf(acc[ni][r]); } } }
    __syncthreads();
}
__device__ __forceinline__ void ph_pro0(const Params& p, LAS unsigned char* lds, int bid, int G, int tid) {
    const int lane = tid & 63, wave = tid >> 6, gw = bid * 8 + wave, NGW = G * 8;
    LAS float* scr = (LAS float*)(lds + wave * 16384);
    for (int it = gw; it < 4 * 64; it += NGW) { const int q = it >> 6, r = it & 63, kv = q >> 1, half = q & 1;
        transpose_item((kv ? p.w1v : p.w1k) + (size_t)half * 1024 * 128, 128, nullptr, p.W1T + ((size_t)kv * 256 + half * 128) * 1024, 1024, r, 4, CM_id{}, scr, lane); }
    for (int i = bid * 512 + tid; i < NTOK; i += G * 512) { p.SUMSQ2[i] = 0.f; p.SUMSQ3[i] = 0.f; }
    for (int idx = bid * 512 + tid; idx < 2 * 8192; idx += G * 512) { const int kv = idx >> 13, r = idx & 8191, j = r & 127, d = r >> 7; p.W2TG[idx] = f2bf((kv ? p.w2v : p.w2k)[j * 64 + d]); }
    __syncthreads();
    for (int it = bid; it < 4; it += G) { const int kv = it >> 1, jh = it & 1, j = jh * 64 + (tid & 63), ks = tid >> 6;
        const float* pe = kv ? p.pe_v : p.pe_k; const float* w1 = kv ? p.w1v : p.w1k; float s = 0.f;
#pragma unroll 1
        for (int k0 = ks * 256; k0 < ks * 256 + 256; k0 += 32) { float pv[32], wv[32];
#pragma unroll
            for (int u = 0; u < 32; ++u) { pv[u] = pe[k0 + u]; wv[u] = w1[(size_t)(k0 + u) * 128 + j]; }
#pragma unroll
            for (int u = 0; u < 32; ++u) s += pv[u] * wv[u]; }
        LAS float* red = (LAS float*)lds; red[tid] = s; __syncthreads();
        if (tid < 64) { float t = 0.f; for (int w = 0; w < 8; ++w) t += red[w * 64 + tid]; p.BIAS1[kv * 128 + j] = t; }
        __syncthreads(); }
}

constexpr int GL_BC = 0, GL_SEG = 32768, GL_QT = 34816, GL_KT = GL_QT + 64 * 272, GL_AM = GL_KT + 64 * 272, GL_VT = GL_AM + 64 * 144, GL_SSQ = GL_VT + 256 * 144, GL_END = GL_SSQ + 2048;
static_assert(GL_END <= 131072, "gla lds");
struct GateRegs { f32x4 lr[8]; float wv[8]; float ba; };
__device__ __forceinline__ GateRegs gla_gates_issue(const Params& p, int row0, int h, int tid) {
    const int lane = tid & 63, wave = tid >> 6, fr = lane & 15, fg = lane >> 4, d = 16 * wave + fr; GateRegs g;
#pragma unroll
    for (int j = 0; j < 8; ++j) { g.wv[j] = 0.f; g.lr[j] = (f32x4){0.f, 0.f, 0.f, 0.f}; }
    if (fg < 2) {
#pragma unroll
        for (int j = 0; j < 8; ++j) g.wv[j] = p.w_a2[(8 * fg + j) * 512 + h * 128 + d];
#pragma unroll
        for (int cb = 0; cb < 4; ++cb) { const f32x4* lr = (const f32x4*)(p.LR + (size_t)(row0 + 16 * cb + fr) * 16 + 8 * fg); g.lr[2 * cb] = lr[0]; g.lr[2 * cb + 1] = lr[1]; } }
    g.ba = p.b_a[h * 128 + d];
    return g;
}
__device__ __forceinline__ void gla_gates(const GateRegs& gr, LAS unsigned char* lds, int tid) {
    LAS float* BC = (LAS float*)(lds + GL_BC);
    const int lane = tid & 63, wave = tid >> 6, fr = lane & 15, fg = lane >> 4, d = 16 * wave + fr;
    const bf16x8_t wb = __builtin_bit_cast(bf16x8_t, pk8((f32x4){gr.wv[0], gr.wv[1], gr.wv[2], gr.wv[3]}, (f32x4){gr.wv[4], gr.wv[5], gr.wv[6], gr.wv[7]}));
    const float ba = gr.ba;
    float run = 0.f;
#pragma unroll
    for (int cb = 0; cb < 4; ++cb) { const bf16x8_t la = __builtin_bit_cast(bf16x8_t, pk8(gr.lr[2 * cb], gr.lr[2 * cb + 1]));
        f32x4 x = __builtin_amdgcn_mfma_f32_16x16x32_bf16(la, wb, (f32x4){0.f, 0.f, 0.f, 0.f}, 0, 0, 0);
        float g4[4];
#pragma unroll
        for (int r = 0; r < 4; ++r) { const float xv = x[r] + ba; g4[r] = (fminf(xv, 0.f) - __logf(1.f + __expf(-fabsf(xv)))) * (1.f / 16.f); }
        g4[1] += g4[0]; g4[2] += g4[1]; g4[3] += g4[2];
        const float t0 = __shfl(g4[3], fr), t1 = __shfl(g4[3], fr + 16), t2 = __shfl(g4[3], fr + 32), t3 = __shfl(g4[3], fr + 48);
        const float off = run + (fg > 0 ? t0 : 0.f) + (fg > 1 ? t1 : 0.f) + (fg > 2 ? t2 : 0.f);
#pragma unroll
        for (int r = 0; r < 4; ++r) BC[(16 * cb + 4 * fg + r) * 128 + d] = off + g4[r];
        run += (t0 + t1) + (t2 + t3); }
    LDS_BARRIER();
}
struct GlaVRegs { v4u v[4]; };
__device__ __forceinline__ GlaVRegs gla_vt_issue(const Params& p, int row0, int h, int tid) {
    const int c = tid & 63, e0 = (tid >> 6) * 32; const bf16_t* src = p.GV + (size_t)(row0 + c) * 1024 + h * 256 + e0; GlaVRegs r;
#pragma unroll
    for (int q = 0; q < 4; ++q) r.v[q] = *(const v4u*)(src + 8 * q);
    return r;
}
__device__ __forceinline__ void gla_vt_commit(const GlaVRegs& r, LAS unsigned char* lds, int tid) {
    LAS bf16_t* VT = (LAS bf16_t*)(lds + GL_VT); const int c = tid & 63, e0 = (tid >> 6) * 32;
#pragma unroll
    for (int q = 0; q < 4; ++q) { const unsigned wv[4] = {r.v[q].x, r.v[q].y, r.v[q].z, r.v[q].w};
#pragma unroll
        for (int i = 0; i < 8; ++i) VT[(e0 + 8 * q + i) * 72 + c] = (bf16_t)((wv[i >> 1] >> ((i & 1) * 16)) & 0xffff); }
}
struct GlaAIn { GateRegs g; GlaVRegs v; v4u k[2]; };
__device__ __forceinline__ GlaAIn gla_a_issue(const Params& p, int item, int tid) {
    const int bh = item >> 5, n = item & 31, b = bh >> 2, h = bh & 3, row0 = b * SEQ + n * 64; GlaAIn in;
    in.g = gla_gates_issue(p, row0, h, tid); in.v = gla_vt_issue(p, row0, h, tid);
    { const int c = tid & 63, d0 = (tid >> 6) * 16;
#pragma unroll
      for (int q = 0; q < 2; ++q) in.k[q] = *(const v4u*)(p.GK + (size_t)(row0 + c) * 512 + h * 128 + d0 + 8 * q); }
    return in;
}
__device__ __forceinline__ void gla_pass_a(const Params& p, LAS unsigned char* lds, int item, int tid, const GlaAIn& in) {
    const int bh = item >> 5, n = item & 31, b = bh >> 2, h = bh & 3, row0 = b * SEQ + n * 64;
    const int lane = tid & 63, wave = __builtin_amdgcn_readfirstlane(tid >> 6), fr = lane & 15, fg = lane >> 4;
    SSTAMP(80);
    const GlaVRegs& vr = in.v; const v4u (&kreg)[2] = in.k;
    gla_gates(in.g, lds, tid); SSTAMP(81);
    { const LAS f32x4* bs = (const LAS f32x4*)(lds + GL_BC); f32x4* bg = (f32x4*)(p.BCG + (size_t)item * 8192);
#pragma unroll
      for (int k = 0; k < 4; ++k) bg[tid + 512 * k] = bs[tid + 512 * k]; }
    const LAS float* BC = (const LAS float*)(lds + GL_BC);
    LAS bf16_t* KST = (LAS bf16_t*)(lds + GL_QT);
    gla_vt_commit(vr, lds, tid);
    { const int c = tid & 63, d0 = (tid >> 6) * 16;
#pragma unroll
      for (int q = 0; q < 2; ++q) { const v4u kk = kreg[q];
          const unsigned wv[4] = {kk.x, kk.y, kk.z, kk.w};
#pragma unroll
          for (int i = 0; i < 8; ++i) { const int d = d0 + 8 * q + i; const float kx = bf2f((bf16_t)((wv[i >> 1] >> ((i & 1) * 16)) & 0xffff));
              KST[d * 72 + c] = f2bf(kx * __expf(BC[63 * 128 + d] - BC[c * 128 + d])); } } }
    if (tid < 128) p.DEC[((size_t)bh * 32 + n) * 128 + tid] = __expf(BC[63 * 128 + tid]);
    LDS_BARRIER(); SSTAMP(82);
    const LAS unsigned char* VTb = lds + GL_VT; const LAS unsigned char* KSb = lds + GL_QT;
    f32x4 acc[8][2];
#pragma unroll
    for (int mb = 0; mb < 8; ++mb) { acc[mb][0] = (f32x4){0.f, 0.f, 0.f, 0.f}; acc[mb][1] = (f32x4){0.f, 0.f, 0.f, 0.f}; }
#pragma unroll
    for (int ks = 0; ks < 2; ++ks) { bf16x8_t vb[2];
#pragma unroll
        for (int nb = 0; nb < 2; ++nb) vb[nb] = *(const LAS bf16x8_t*)(VTb + (32 * wave + 16 * nb + fr) * 144 + (32 * ks + 8 * fg) * 2);
#pragma unroll
        for (int mb = 0; mb < 8; ++mb) { const bf16x8_t ka = *(const LAS bf16x8_t*)(KSb + (16 * mb + fr) * 144 + (32 * ks + 8 * fg) * 2);
            acc[mb][0] = __builtin_amdgcn_mfma_f32_16x16x32_bf16(ka, vb[0], acc[mb][0], 0, 0, 0); acc[mb][1] = __builtin_amdgcn_mfma_f32_16x16x32_bf16(ka, vb[1], acc[mb][1], 0, 0, 0); } }
    SSTAMP(83);
    bf16_t* U = (bf16_t*)p.UT + ((size_t)bh * 32 + n) * 256 * 128;
#pragma unroll
    for (int nb = 0; nb < 2; ++nb) { const int e = 32 * wave + 16 * nb + fr;
#pragma unroll
        for (int mb = 0; mb < 8; ++mb) { v2u w; w.x = pk2(acc[mb][nb][0], acc[mb][nb][1]); w.y = pk2(acc[mb][nb][2], acc[mb][nb][3]); *(v2u*)(U + (size_t)e * 128 + 16 * mb + 4 * fg) = w; } }
    LDS_BARRIER(); SSTAMP(84);
}
__device__ __forceinline__ void gla_pass_b(const Params& p, int bid, int G, int tid) {
    for (int idx = bid * 512 + tid; idx < 16 * 256 * 16; idx += G * 512) { const int d8 = (idx & 15) * 8, e = (idx >> 4) & 255, bh = idx >> 12;
        f32x4 S0 = {0.f, 0.f, 0.f, 0.f}, S1 = {0.f, 0.f, 0.f, 0.f};
        const bf16_t* U = (const bf16_t*)p.UT + (size_t)bh * 32 * 256 * 128 + (size_t)e * 128 + d8; const float* D = p.DEC + (size_t)bh * 32 * 128 + d8;
        bf16_t* SN = p.SNT + (size_t)bh * 32 * 256 * 128 + (size_t)e * 128 + d8;
#pragma unroll 8
        for (int n = 0; n < 32; ++n) { const v4u ub = *(const v4u*)(U + (size_t)n * 256 * 128); const f32x4 d0 = *(const f32x4*)(D + n * 128), d1 = *(const f32x4*)(D + n * 128 + 4);
            *(v4u*)(SN + (size_t)n * 256 * 128) = pk8(S0, S1);
            S0 = d0 * S0 + bf4lo(ub); S1 = d1 * S1 + bf4hi(ub); }
        float* so = p.out + OFF_PGLA + ((size_t)bh * 128 + d8) * 256 + e;
#pragma unroll
        for (int i = 0; i < 4; ++i) { so[(size_t)i * 256] = S0[i]; so[(size_t)(4 + i) * 256] = S1[i]; } }
}
__device__ __forceinline__ void gla_pass_c(const Params& p, LAS unsigned char* lds, int item, int tid) {
    const int bh = item >> 5, n = item & 31, b = bh >> 2, h = bh & 3, row0 = b * SEQ + n * 64;
    const int lane = tid & 63, wave = __builtin_amdgcn_readfirstlane(tid >> 6), fr = lane & 15, fg = lane >> 4;
    bf16x8_t sa[4][2];
    { const bf16_t* SN = p.SNT + ((size_t)bh * 32 + n) * 256 * 128;
#pragma unroll
      for (int ks = 0; ks < 4; ++ks)
#pragma unroll
          for (int eb = 0; eb < 2; ++eb) sa[ks][eb] = *(const bf16x8_t*)(SN + (size_t)(32 * wave + 16 * eb + fr) * 128 + 32 * ks + 8 * fg); }
    const GlaVRegs vr = gla_vt_issue(p, row0, h, tid);
    v4u qreg[2], kreg[2];
    { const int d8 = (tid & 15) * 8;
#pragma unroll
      for (int q = 0; q < 2; ++q) { const int c = (tid >> 4) + 32 * q; qreg[q] = *(const v4u*)(p.GQ + (size_t)(row0 + c) * 512 + h * 128 + d8); kreg[q] = *(const v4u*)(p.GK + (size_t)(row0 + c) * 512 + h * 128 + d8); } }
    { LAS f32x4* bs = (LAS f32x4*)(lds + GL_BC); const f32x4* bg = (const f32x4*)(p.BCG + (size_t)item * 8192);
      f32x4 t4[4];
#pragma unroll
      for (int k = 0; k < 4; ++k) t4[k] = bg[tid + 512 * k];
#pragma unroll
      for (int k = 0; k < 4; ++k) bs[tid + 512 * k] = t4[k]; }
    LDS_BARRIER();
    const LAS float* BC = (const LAS float*)(lds + GL_BC);
    LAS unsigned char* QTb = lds + GL_QT; LAS unsigned char* KTb = lds + GL_KT; LAS unsigned char* AMb = lds + GL_AM; const LAS unsigned char* VTb = lds + GL_VT;
    gla_vt_commit(vr, lds, tid);
    { const int d8 = (tid & 15) * 8;
#pragma unroll
      for (int q = 0; q < 2; ++q) { const int c = (tid >> 4) + 32 * q; const v4u qq = qreg[q], kk = kreg[q];
          const unsigned qv[4] = {qq.x, qq.y, qq.z, qq.w}, kw[4] = {kk.x, kk.y, kk.z, kk.w}; unsigned qo[4], ko[4];
#pragma unroll
          for (int i = 0; i < 4; ++i) { const float b0 = BC[c * 128 + d8 + 2 * i], b1 = BC[c * 128 + d8 + 2 * i + 1]; const float e0 = __expf(b0), e1 = __expf(b1), i0 = __expf(-b0), i1 = __expf(-b1);
              qo[i] = pk2(bf2f((bf16_t)(qv[i] & 0xffff)) * e0, bf2f((bf16_t)(qv[i] >> 16)) * e1);
              ko[i] = pk2(bf2f((bf16_t)(kw[i] & 0xffff)) * i0, bf2f((bf16_t)(kw[i] >> 16)) * i1); }
          *(LAS v4u*)(QTb + c * 272 + d8 * 2) = (v4u){qo[0], qo[1], qo[2], qo[3]}; *(LAS v4u*)(KTb + c * 272 + d8 * 2) = (v4u){ko[0], ko[1], ko[2], ko[3]}; } }
    LDS_BARRIER();
    { const int sb = wave >> 1;
#pragma unroll
      for (int u = 0; u < 2; ++u) { const int cb = 2 * (wave & 1) + u; f32x4 a = {0.f, 0.f, 0.f, 0.f};
          if (sb <= cb) {
#pragma unroll
              for (int ks = 0; ks < 4; ++ks) { const bf16x8_t ka = *(const LAS bf16x8_t*)(KTb + (16 * sb + fr) * 272 + (32 * ks + 8 * fg) * 2); const bf16x8_t qb = *(const LAS bf16x8_t*)(QTb + (16 * cb + fr) * 272 + (32 * ks + 8 * fg) * 2);
                  a = __builtin_amdgcn_mfma_f32_16x16x32_bf16(ka, qb, a, 0, 0, 0); } }
          const int c = 16 * cb + fr, s0 = 16 * sb + 4 * fg;
          v2u w; w.x = pk2(s0 <= c ? a[0] : 0.f, s0 + 1 <= c ? a[1] : 0.f); w.y = pk2(s0 + 2 <= c ? a[2] : 0.f, s0 + 3 <= c ? a[3] : 0.f);
          *(LAS v2u*)(AMb + c * 144 + s0 * 2) = w; } }
    LDS_BARRIER();
    f32x4 acc[2][4];
#pragma unroll
    for (int eb = 0; eb < 2; ++eb)
#pragma unroll
        for (int cb = 0; cb < 4; ++cb) acc[eb][cb] = (f32x4){0.f, 0.f, 0.f, 0.f};
#pragma unroll
    for (int ks = 0; ks < 4; ++ks) { bf16x8_t qb[4];
#pragma unroll
        for (int cb = 0; cb < 4; ++cb) qb[cb] = *(const LAS bf16x8_t*)(QTb + (16 * cb + fr) * 272 + (32 * ks + 8 * fg) * 2);
#pragma unroll
        for (int eb = 0; eb < 2; ++eb)
#pragma unroll
            for (int cb = 0; cb < 4; ++cb) acc[eb][cb] = __builtin_amdgcn_mfma_f32_16x16x32_bf16(sa[ks][eb], qb[cb], acc[eb][cb], 0, 0, 0); }
#pragma unroll
    for (int ks = 0; ks < 2; ++ks) { bf16x8_t va[2], ab[4];
#pragma unroll
        for (int eb = 0; eb < 2; ++eb) va[eb] = *(const LAS bf16x8_t*)(VTb + (32 * wave + 16 * eb + fr) * 144 + (32 * ks + 8 * fg) * 2);
#pragma unroll
        for (int cb = 0; cb < 4; ++cb) ab[cb] = *(const LAS bf16x8_t*)(AMb + (16 * cb + fr) * 144 + (32 * ks + 8 * fg) * 2);
#pragma unroll
        for (int eb = 0; eb < 2; ++eb)
#pragma unroll
            for (int cb = 0; cb < 4; ++cb) acc[eb][cb] = __builtin_amdgcn_mfma_f32_16x16x32_bf16(va[eb], ab[cb], acc[eb][cb], 0, 0, 0); }
    LAS float* SSQ = (LAS float*)(lds + GL_SSQ);
#pragma unroll
    for (int cb = 0; cb < 4; ++cb) { float s = 0.f;
#pragma unroll
        for (int eb = 0; eb < 2; ++eb) s += (acc[eb][cb][0] * acc[eb][cb][0] + acc[eb][cb][1] * acc[eb][cb][1]) + (acc[eb][cb][2] * acc[eb][cb][2] + acc[eb][cb][3] * acc[eb][cb][3]);
        s += __shfl_xor(s, 16); s += __shfl_xor(s, 32);
        if (fg == 0) SSQ[wave * 64 + 16 * cb + fr] = s; }
    LDS_BARRIER();
#pragma unroll
    for (int cb = 0; cb < 4; ++cb) { const int c = 16 * cb + fr; float s = 0.f;
#pragma unroll
        for (int w = 0; w < 8; ++w) s += SSQ[w * 64 + c];
        const float rs = rsqrtf(s * (1.f / 256.f) + EPS);
#pragma unroll
        for (int eb = 0; eb < 2; ++eb) { const int e = 32 * wave + 16 * eb + 4 * fg; const f32x4 gn = *(const f32x4*)(p.gnorm + e);
            const v2u rr = *(const v2u*)(p.GR + (size_t)(row0 + c) * 1024 + h * 256 + e);
            const float o0 = acc[eb][cb][0] * rs * gn[0] * bf2f((bf16_t)(rr.x & 0xffff)), o1 = acc[eb][cb][1] * rs * gn[1] * bf2f((bf16_t)(rr.x >> 16));
            const float o2 = acc[eb][cb][2] * rs * gn[2] * bf2f((bf16_t)(rr.y & 0xffff)), o3 = acc[eb][cb][3] * rs * gn[3] * bf2f((bf16_t)(rr.y >> 16));
            v2u w; w.x = pk2(o0, o1); w.y = pk2(o2, o3); *(v2u*)(p.OB + (size_t)(row0 + c) * 1024 + h * 256 + e) = w; } }
    LDS_BARRIER();
}
__device__ __forceinline__ void gla_sample_item(const Params& p, LAS unsigned char* lds, int item, int tid) {
    const int b = item >> 2, h = item & 3, e = tid & 255, half = tid >> 8, row = NPT + b;
    LAS float* a_s = (LAS float*)lds; LAS float* q_s = a_s + 128; LAS float* k_s = q_s + 128; LAS float* part = k_s + 128; LAS float* red = part + 512;
    if (tid < 128) { float x = p.b_a[h * 128 + tid];
        for (int r = 0; r < 16; ++r) x += p.LR[(size_t)row * 16 + r] * p.w_a2[r * 512 + h * 128 + tid];
        a_s[tid] = __expf(logsigmoidf_(x) * (1.f / 16.f)); q_s[tid] = bf2f(p.GQ[(size_t)row * 512 + h * 128 + tid]); k_s[tid] = bf2f(p.GK[(size_t)row * 512 + h * 128 + tid]); }
    const float v = bf2f(p.GV[(size_t)row * 1024 + h * 256 + e]);
    __syncthreads();
    float po = 0.f; const float* s0 = p.state + (((size_t)b * 4 + h) * 128 + half * 64) * 256 + e; float* so = p.out + OFF_SGLA + (((size_t)b * 4 + h) * 128 + half * 64) * 256 + e;
#pragma unroll 1
    for (int d0 = 0; d0 < 64; d0 += 32) { float sv[32];
#pragma unroll
        for (int dd = 0; dd < 32; ++dd) sv[dd] = s0[(size_t)(d0 + dd) * 256];
#pragma unroll
        for (int dd = 0; dd < 32; ++dd) { const int d = half * 64 + d0 + dd; const float s = a_s[d] * sv[dd] + k_s[d] * v; so[(size_t)(d0 + dd) * 256] = s; po += q_s[d] * s; } }
    part[half * 256 + e] = po;
    __syncthreads();
    float o = 0.f;
    if (tid < 256) { o = part[e] + part[256 + e]; const float ss = wave_sum(o * o); if ((tid & 63) == 0) red[tid >> 6] = ss; }
    __syncthreads();
    if (tid < 256) { const float ss = (red[0] + red[1]) + (red[2] + red[3]); const float r = rsqrtf(ss * (1.f / 256.f) + EPS);
        p.OB[(size_t)row * 1024 + h * 256 + e] = f2bf(o * r * p.gnorm[e] * bf2f(p.GR[(size_t)row * 1024 + h * 256 + e])); }
    __syncthreads();
}

typedef float f32x16 __attribute__((ext_vector_type(16)));
constexpr int NS_STAGE = 17920, NS_KOFF = 0, NS_VOFF = 9216, NS_PCS = 35840, NS_SC = NS_PCS + 32768, NS_OUT = NS_PCS  , NS_SEL = NS_OUT + 256 * 272, NS_END = NS_SEL + 256;
static_assert(NS_END <= 131072, "nsa lds");
constexpr float LOG2E = 1.4426950408889634f, NEGBIG = -1e30f;
__device__ __forceinline__ int crow(int r, int hh) { return (r & 3) + 8 * (r >> 2) + 4 * hh; }

__device__ __forceinline__ void nsa_vt_tile(const Params& p, LAS unsigned char* scr  , int item, int lane) {
    const int tt = item & 31, bg = (item >> 5) & 15, which = item >> 9, b = bg >> 2, g = bg & 3;
    const bf16_t* src = p.KV6 + (size_t)(b * SEQ + tt * 64) * 1536 + (which ? 5 : 3) * 256 + g * 64;
    LAS bf16_t* TT = (LAS bf16_t*)scr;
    const int ch = lane & 7, r0 = lane >> 3;
#pragma unroll
    for (int q = 0; q < 8; ++q) { const v4u v = *(const v4u*)(src + (size_t)lane * 1536 + q * 8); const unsigned wv[4] = {v.x, v.y, v.z, v.w};
#pragma unroll
        for (int i = 0; i < 8; ++i) TT[(q * 8 + i) * 72 + lane] = (bf16_t)((wv[i >> 1] >> ((i & 1) * 16)) & 0xffff); }
    LDS_WAIT(); asm volatile("" ::: "memory");
    bf16_t* dst = (which ? p.VTW : p.VTS) + (size_t)bg * 64 * SEQ + tt * 64;
#pragma unroll
    for (int q = 0; q < 8; ++q) { const int d = r0 + 8 * q; const v4u v = *(const LAS v4u*)((LAS unsigned char*)scr + d * 144 + ch * 16); *(v4u*)(dst + (size_t)d * SEQ + ch * 8) = v; }
    LDS_WAIT(); asm volatile("" ::: "memory");
}

__device__ __forceinline__ float max3f(float a, float b, float c) { float r; asm("v_max3_f32 %0, %1, %2, %3" : "=v"(r) : "v"(a), "v"(b), "v"(c)); return r; }
struct NsaState { float m, l; f32x16 o0, o1; };
template <int MODE  >
__device__ __forceinline__ void nsa_tile(const LAS unsigned char* st, const bf16x8_t (&q)[4], NsaState& s, int lo, int hi, int r32, int hh, LAS float* pcs = nullptr, int kbase = 0) {
    f32x16 s0 = {}, s1 = {};
    const LAS unsigned char* kb = st + NS_KOFF + r32 * 144 + hh * 16;
#pragma unroll
    for (int ks = 0; ks < 4; ++ks) { const bf16x8_t a0 = *(const LAS bf16x8_t*)(kb + ks * 32), a1 = *(const LAS bf16x8_t*)(kb + 32 * 144 + ks * 32);
        s0 = __builtin_amdgcn_mfma_f32_32x32x16_bf16(a0, q[ks], s0, 0, 0, 0); s1 = __builtin_amdgcn_mfma_f32_32x32x16_bf16(a1, q[ks], s1, 0, 0, 0); }
    asm volatile("s_nop 15\n\ts_nop 7" : "+v"(s0), "+v"(s1));
    const bool full = lo <= 0 && hi >= 63, on = hi >= 0;
    const bool nomask = __all(full), laneonly = !nomask && __all(full || !on);
    if (!nomask && !laneonly) {
#pragma unroll
        for (int r = 0; r < 16; ++r) { const int k0 = crow(r, hh), k1 = k0 + 32; s0[r] = (k0 >= lo && k0 <= hi) ? s0[r] : -INFINITY; s1[r] = (k1 >= lo && k1 <= hi) ? s1[r] : -INFINITY; }
    }
    const bool off = laneonly && !on;
    float tmax;
    { float a = max3f(s0[0], s0[1], s1[0]), c = max3f(s0[2], s0[3], s1[1]); a = max3f(a, s1[2], s1[3]);
#pragma unroll
      for (int r = 4; r < 16; r += 4) { a = max3f(a, s0[r], s0[r + 1]); c = max3f(c, s0[r + 2], s0[r + 3]); a = max3f(a, s1[r], s1[r + 1]); c = max3f(c, s1[r + 2], s1[r + 3]); }
      tmax = off ? NEGBIG : max3f(a, c, NEGBIG); }
    if (MODE == 2) {
        const float mL = off ? INFINITY : s.m * LOG2E, inv = s.l;
#pragma unroll
        for (int r = 0; r < 16; ++r) { s0[r] = __builtin_amdgcn_exp2f(s0[r] * LOG2E - mL) * inv; s1[r] = __builtin_amdgcn_exp2f(s1[r] * LOG2E - mL) * inv; }
        if (pcs) {
#pragma unroll
            for (int r = 0; r < 16; ++r) { float v0 = s0[r], v1 = s1[r]; v0 += __shfl_xor(v0, 8); v1 += __shfl_xor(v1, 8); v0 += __shfl_xor(v0, 16); v1 += __shfl_xor(v1, 16);
                pcs[kbase + crow(r, hh)] = v0; pcs[kbase + 32 + crow(r, hh)] = v1; } }
    } else {
        tmax = max3f(tmax, __shfl_xor(tmax, 32), s.m);
        const float mn = tmax, alpha = __builtin_amdgcn_exp2f((s.m - mn) * LOG2E), mL = off ? INFINITY : mn * LOG2E;
        s.m = mn;
        float ps = 0.f;
#pragma unroll
        for (int r = 0; r < 16; ++r) { const float p0 = __builtin_amdgcn_exp2f(s0[r] * LOG2E - mL), p1 = __builtin_amdgcn_exp2f(s1[r] * LOG2E - mL); s0[r] = p0; s1[r] = p1; ps += p0 + p1; }
        s.l = s.l * alpha + ps;
        if (MODE == 1) return;
        if (!__all(alpha == 1.f)) {
#pragma unroll
            for (int r = 0; r < 16; ++r) { s.o0[r] *= alpha; s.o1[r] *= alpha; } }
    }
    const LAS unsigned char* vb = st + NS_VOFF + r32 * 136 + hh * 8;
#pragma unroll
    for (int blk = 0; blk < 2; ++blk)
#pragma unroll
        for (int sp = 0; sp < 2; ++sp) { const f32x16& pp = blk ? s1 : s0; const int rb = 8 * sp;
            v4u pw; pw.x = cvtpk(pp[rb + 0], pp[rb + 1]); pw.y = cvtpk(pp[rb + 2], pp[rb + 3]); pw.z = cvtpk(pp[rb + 4], pp[rb + 5]); pw.w = cvtpk(pp[rb + 6], pp[rb + 7]);
            const bf16x8_t pf = __builtin_bit_cast(bf16x8_t, pw);
            const int ko = (32 * blk + 16 * sp) * 2;
            const v2u a0l = *(const LAS v2u*)(vb + ko), a0h = *(const LAS v2u*)(vb + ko + 16), a1l = *(const LAS v2u*)(vb + 32 * 136 + ko), a1h = *(const LAS v2u*)(vb + 32 * 136 + ko + 16);
            const bf16x8_t v0 = __builtin_bit_cast(bf16x8_t, (v4u){a0l.x, a0l.y, a0h.x, a0h.y}), v1 = __builtin_bit_cast(bf16x8_t, (v4u){a1l.x, a1l.y, a1h.x, a1h.y});
            s.o0 = __builtin_amdgcn_mfma_f32_32x32x16_bf16(v0, pf, s.o0, 0, 0, 0); s.o1 = __builtin_amdgcn_mfma_f32_32x32x16_bf16(v1, pf, s.o1, 0, 0, 0); }
}
template <bool FIRST>
__device__ __forceinline__ void nsa_finish(NsaState& s, float gate, LAS float* outp) {
    const float lt = s.l + __shfl_xor(s.l, 32); const float sc = lt > 0.f ? gate / lt : 0.f;
#pragma unroll
    for (int k = 0; k < 4; ++k) { f32x4 a = {s.o0[4 * k], s.o0[4 * k + 1], s.o0[4 * k + 2], s.o0[4 * k + 3]}, c = {s.o1[4 * k], s.o1[4 * k + 1], s.o1[4 * k + 2], s.o1[4 * k + 3]};
        a = a * sc; c = c * sc;
        if (!FIRST) { a = a + *(const LAS f32x4*)(outp + 8 * k); c = c + *(const LAS f32x4*)(outp + 32 + 8 * k); }
        *(LAS f32x4*)(outp + 8 * k) = a; *(LAS f32x4*)(outp + 32 + 8 * k) = c; }
    s.m = NEGBIG; s.l = 0.f; s.o0 = (f32x16){}; s.o1 = (f32x16){};
}

__device__ __forceinline__ void nsa_prompt_item(const Params& p, LAS unsigned char* lds, int bg, int qi, int tid) {
    const int lane = tid & 63, wave = __builtin_amdgcn_readfirstlane(tid >> 6), r32 = lane & 31, hh = lane >> 5;
    const int b = bg >> 2, g = bg & 3, tl = 8 * wave + (r32 & 7), hd = r32 >> 3, t = 64 * qi + tl, row = b * SEQ + t;
    const int srow = tid >> 3, sch = tid & 7;
    v4u rk, rv;
    auto issue = [&](const bf16_t* kbase, size_t kstride, const bf16_t* vbase, size_t vstride) { rk = *(const v4u*)(kbase + (size_t)srow * kstride + sch * 8); rv = *(const v4u*)(vbase + (size_t)srow * vstride + sch * 8); };
    auto commit = [&](int s) { LAS unsigned char* st = lds + s * NS_STAGE; *(LAS v4u*)(st + NS_KOFF + srow * 144 + sch * 16) = rk;
        *(LAS v2u*)(st + NS_VOFF + srow * 136 + sch * 16) = (v2u){rv.x, rv.y}; *(LAS v2u*)(st + NS_VOFF + srow * 136 + sch * 16 + 8) = (v2u){rv.z, rv.w}; };
    bf16x8_t q[4];
    { const bf16_t* qp = p.QN + (size_t)row * 1024 + (g * 4 + hd) * 64 + 8 * hh;
#pragma unroll
      for (int ks = 0; ks < 4; ++ks) q[ks] = *(const bf16x8_t*)(qp + 16 * ks); }
    const float g0 = p.GATE[(size_t)row * 48 + (g * 4 + hd) * 3 + 0], g1 = p.GATE[(size_t)row * 48 + (g * 4 + hd) * 3 + 1], g2 = p.GATE[(size_t)row * 48 + (g * 4 + hd) * 3 + 2];
    LAS float* outp = (LAS float*)(lds + NS_OUT) + (wave * 32 + r32) * 68 + 4 * hh;
    NsaState s; s.m = NEGBIG; s.l = 0.f; s.o0 = (f32x16){}; s.o1 = (f32x16){};
    const bf16_t* kc = p.KCMP_P + (size_t)bg * 128 * 64; const bf16_t* vct = p.VCMPT_P + (size_t)bg * 64 * 128;
    issue(kc, 64, vct, 128); commit(0); issue(kc + 64 * 64, 64, vct + 64, 128); commit(1);
    __syncthreads();
    const int limc = (t >= 31) ? ((t - 31) >> 4) : -1;
    {
        nsa_tile<1>(lds, q, s, 0, limc, r32, hh); if (qi >= 16) nsa_tile<1>(lds + NS_STAGE, q, s, 0, limc - 64, r32, hh);
        const float lt = s.l + __shfl_xor(s.l, 32); s.l = lt > 0.f ? 1.f / lt : 0.f;
        LAS float* PCS = (hd == 0) ? (LAS float*)(lds + NS_PCS) + tl * 128 : (LAS float*)(lds + NS_SC);
        nsa_tile<2>(lds, q, s, 0, limc, r32, hh, qi >= 16 ? PCS : nullptr, 0); if (qi >= 16) nsa_tile<2>(lds + NS_STAGE, q, s, 0, limc - 64, r32, hh, PCS, 64);
        __syncthreads();
    }
    if (qi >= 16) {
        const LAS float* PCS = (const LAS float*)(lds + NS_PCS);
        LAS float* SCR = (LAS float*)(lds + NS_SC); LAS unsigned* SEL = (LAS unsigned*)(lds + NS_SEL);
        { const int tk = tid >> 3, jq = tid & 7;
#pragma unroll
          for (int u = 0; u < 4; ++u) { const int j = jq * 4 + u; float sm = 0.f;
#pragma unroll
              for (int o = 0; o < 5; ++o) { const int ki = 4 * j - 1 + o; if (ki >= 0 && ki < 127) sm += PCS[tk * 128 + ki]; }
              SCR[tk * 32 + j] = (j <= qi) ? sm + ((j == 0 || j == qi) ? 1e4f : 0.f) : NEGBIG; }
        }
        __syncthreads();
        { const int tk = tid >> 3, jq = tid & 7; unsigned bits = 0u;
#pragma unroll
          for (int u = 0; u < 4; ++u) { const int j = jq * 4 + u; const float sj = SCR[tk * 32 + j]; int rank = 0;
              for (int j2 = 0; j2 < 32; ++j2) { const float s2 = SCR[tk * 32 + j2]; rank += (s2 > sj || (s2 == sj && j2 < j)) ? 1 : 0; }
              if (rank < 16) bits |= 1u << j; }
          bits |= __shfl_xor(bits, 1); bits |= __shfl_xor(bits, 2); bits |= __shfl_xor(bits, 4);
          if (jq == 0) SEL[tk] = bits; }
        __syncthreads();
    }
    s.l = 0.5f; nsa_finish<true>(s, g0, outp);
    const unsigned selmask = (qi < 16) ? 0xffffffffu : ((LAS unsigned*)(lds + NS_SEL))[tl];
    const int wlo = qi > 8 ? qi - 8 : 0, nslc = qi + 1, nsteps = nslc + (qi - wlo + 1);
    const bf16_t* ksl = p.KV6 + (size_t)(b * SEQ) * 1536 + 2 * 256 + g * 64; const bf16_t* kwn = ksl + 2 * 256;
    const bf16_t* vsl = p.VTS + (size_t)bg * 64 * SEQ; const bf16_t* vwn = p.VTW + (size_t)bg * 64 * SEQ;
    v4u rkB, rvB;
#define NSA_ISSUE(RK, RV, u) do { const int u_ = (u); const bf16_t* kb_; const bf16_t* vb_; \
        if (u_ < nslc) { kb_ = ksl + (size_t)(64 * u_) * 1536; vb_ = vsl + 64 * u_; } else { const int j_ = wlo + (u_ - nslc); kb_ = kwn + (size_t)(64 * j_) * 1536; vb_ = vwn + 64 * j_; } \
        RK = *(const v4u*)(kb_ + (size_t)srow * 1536 + sch * 8); RV = *(const v4u*)(vb_ + (size_t)srow * SEQ + sch * 8); } while (0)
#define NSA_COMMIT(RK, RV, s_) do { LAS unsigned char* st_ = lds + (s_) * NS_STAGE; *(LAS v4u*)(st_ + NS_KOFF + srow * 144 + sch * 16) = RK; \
        *(LAS v2u*)(st_ + NS_VOFF + srow * 136 + sch * 16) = (v2u){RV.x, RV.y}; *(LAS v2u*)(st_ + NS_VOFF + srow * 136 + sch * 16 + 8) = (v2u){RV.z, RV.w}; } while (0)
#define NSA_STEP(u) do { const int u__ = (u); int lo = 0, hi = 63; \
        if (u__ < nslc) { if (!((selmask >> u__) & 1u)) hi = -1; else if (u__ == qi) hi = tl; } \
        else { const int j_ = wlo + (u__ - nslc); if (j_ == qi) hi = tl; if (j_ == qi - 8) lo = tl; } \
        if (u__ == nslc) nsa_finish<false>(s, g1, outp); \
        nsa_tile<0>(lds + (u__ & 1) * NS_STAGE, q, s, lo, hi, r32, hh); } while (0)
    NSA_ISSUE(rk, rv, 0); NSA_COMMIT(rk, rv, 0);
    if (nsteps > 1) NSA_ISSUE(rk, rv, 1);
    __syncthreads();
    for (int u = 0; u < nsteps; u += 2) {
        if (u + 2 < nsteps) NSA_ISSUE(rkB, rvB, u + 2);
        NSA_STEP(u);
        if (u + 1 < nsteps) NSA_COMMIT(rk, rv, 1);
        LDS_BARRIER();
        if (u + 1 < nsteps) {
            if (u + 3 < nsteps) NSA_ISSUE(rk, rv, u + 3);
            NSA_STEP(u + 1);
            if (u + 2 < nsteps) NSA_COMMIT(rkB, rvB, 0);
            LDS_BARRIER();
        }
    }
#undef NSA_ISSUE
#undef NSA_COMMIT
#undef NSA_STEP
    { const float lt = s.l + __shfl_xor(s.l, 32); const float sc = lt > 0.f ? g2 / lt : 0.f;
      bf16_t* op = p.OA + (size_t)row * 1024 + (g * 4 + hd) * 64 + 4 * hh;
#pragma unroll
      for (int k = 0; k < 4; ++k) { const f32x4 a = *(const LAS f32x4*)(outp + 8 * k), c = *(const LAS f32x4*)(outp + 32 + 8 * k);
          v2u w; w.x = cvtpk(a[0] + s.o0[4 * k] * sc, a[1] + s.o0[4 * k + 1] * sc); w.y = cvtpk(a[2] + s.o0[4 * k + 2] * sc, a[3] + s.o0[4 * k + 3] * sc); *(v2u*)(op + 8 * k) = w;
          v2u w1; w1.x = cvtpk(c[0] + s.o1[4 * k] * sc, c[1] + s.o1[4 * k + 1] * sc); w1.y = cvtpk(c[2] + s.o1[4 * k + 2] * sc, c[3] + s.o1[4 * k + 3] * sc); *(v2u*)(op + 32 + 8 * k) = w1; } }
}

constexpr int SS_Q = 0, SS_SC = 256, SS_PART = SS_SC + 4 * 1088, SS_REDM = SS_PART + 2048, SS_REDS = SS_REDM + 8, SS_GATE = SS_REDS + 8, SS_SCORE = SS_GATE + 16, SS_SEL = SS_SCORE + 272, SS_SELO = SS_SEL + 16, SS_OACC = SS_SELO + 16, SS_END = SS_OACC + 256;
__device__ __forceinline__ f32x4 ld4_bf(const bf16_t* ptr) { const v2u w = *(const v2u*)ptr; return (f32x4){bf2f((bf16_t)(w.x & 0xffff)), bf2f((bf16_t)(w.x >> 16)), bf2f((bf16_t)(w.y & 0xffff)), bf2f((bf16_t)(w.y >> 16))}; }
template <int N> __device__ __forceinline__ float dpp_ror(float v) { return __builtin_bit_cast(float, __builtin_amdgcn_update_dpp(0, __builtin_bit_cast(int, v), 0x120 + N, 0xf, 0xf, false)); }
__device__ __forceinline__ float row16_sum(float t) { t += dpp_ror<8>(t); t += dpp_ror<4>(t); t += dpp_ror<2>(t); t += dpp_ror<1>(t); return t; }
template <class KF, class VF>
__device__ __forceinline__ void nsa_s_branch(LAS float* L, int nk, KF keyf, VF valf, int gsel, int tid) {
    const int lane = tid & 63, wave = tid >> 6, d4 = (lane & 15) * 4, ksub = lane >> 4;
    LAS float* q = L + SS_Q; LAS float* sc = L + SS_SC; LAS float* part = L + SS_PART; LAS float* redm = L + SS_REDM; LAS float* reds = L + SS_REDS;
    f32x4 qv[4];
#pragma unroll
    for (int hd = 0; hd < 4; ++hd) qv[hd] = *(const LAS f32x4*)(q + hd * 64 + d4);
    for (int base = wave * 4; base < nk; base += 256) {
        f32x4 kx[8]; bool vld[8];
#pragma unroll
        for (int u = 0; u < 8; ++u) { int kk = base + 32 * u + ksub; kk = kk < nk ? kk : nk - 1; kx[u] = keyf(kk, d4, vld[u]); }
#pragma unroll
        for (int u = 0; u < 8; ++u) { const int kk = base + 32 * u + ksub; float pd[4];
#pragma unroll
            for (int hd = 0; hd < 4; ++hd) pd[hd] = row16_sum((qv[hd][0] * kx[u][0] + qv[hd][1] * kx[u][1]) + (qv[hd][2] * kx[u][2] + qv[hd][3] * kx[u][3]));
            if (kk < nk && (lane & 15) == 0) {
#pragma unroll
                for (int hd = 0; hd < 4; ++hd) sc[hd * 1088 + kk] = vld[u] ? pd[hd] : -INFINITY; } } }
    __syncthreads();
    { const int hd = wave & 3, half = wave >> 2; LAS float* sh = sc + hd * 1088;
      float m = -INFINITY; for (int kk = half * 64 + lane; kk < nk; kk += 128) m = fmaxf(m, sh[kk]);
      m = wave_max(m); if (lane == 0) redm[wave] = m;
      __syncthreads();
      m = fmaxf(redm[hd], redm[hd + 4]); float sm = 0.f;
      for (int kk = half * 64 + lane; kk < nk; kk += 128) { const float x = sh[kk]; const float e = (x == -INFINITY) ? 0.f : __expf(x - m); sh[kk] = e; sm += e; }
      sm = wave_sum(sm); if (lane == 0) reds[wave] = sm;
      __syncthreads();
      const float tot = reds[hd] + reds[hd + 4]; const float inv = tot > 0.f ? 1.f / tot : 0.f;
      for (int kk = half * 64 + lane; kk < nk; kk += 128) sh[kk] *= inv; }
    __syncthreads();
    { f32x4 o[4];
#pragma unroll
      for (int hd = 0; hd < 4; ++hd) o[hd] = (f32x4){0.f, 0.f, 0.f, 0.f};
      for (int base = wave * 4; base < nk; base += 256) { f32x4 vv[8];
#pragma unroll
          for (int u = 0; u < 8; ++u) { int kk = base + 32 * u + ksub; kk = kk < nk ? kk : nk - 1; vv[u] = valf(kk, d4); }
#pragma unroll
          for (int u = 0; u < 8; ++u) { const int kk = base + 32 * u + ksub; const bool inr = kk < nk; const int kc2 = inr ? kk : nk - 1;
#pragma unroll
              for (int hd = 0; hd < 4; ++hd) { const float pr = inr ? sc[hd * 1088 + kc2] : 0.f; o[hd] = o[hd] + vv[u] * pr; } } }
#pragma unroll
      for (int hd = 0; hd < 4; ++hd)
#pragma unroll
          for (int e = 0; e < 4; ++e) { float t = o[hd][e]; t += __shfl_xor(t, 16); t += __shfl_xor(t, 32); o[hd][e] = t; }
      if (ksub == 0) {
#pragma unroll
          for (int hd = 0; hd < 4; ++hd) *(LAS f32x4*)(part + (wave * 4 + hd) * 64 + d4) = o[hd]; } }
    __syncthreads();
    if (tid < 256) { float o = 0.f;
#pragma unroll
        for (int w = 0; w < 8; ++w) o += part[w * 256 + tid];
        L[SS_OACC + tid] += L[SS_GATE + (tid >> 6) * 3 + gsel] * o; }
    __syncthreads();
}
__device__ __forceinline__ void nsa_sample_item(const Params& p, LAS unsigned char* lds, int item, int tid) {
    const int b = item >> 2, g = item & 3, bg = item, row = NPT + b;
    constexpr int pos = PAST, n_cmp = 1023, n_slc = 257;
    LAS float* L = (LAS float*)lds; LAS float* sc = L + SS_SC; LAS float* score = L + SS_SCORE; LAS int* selidx = (LAS int*)(L + SS_SEL); LAS unsigned* selofs = (LAS unsigned*)(L + SS_SELO);
    if (tid < 256) { L[SS_Q + tid] = bf2f(p.QN[(size_t)row * 1024 + g * 256 + tid]); L[SS_OACC + tid] = 0.f; }
    if (tid < 12) L[SS_GATE + tid] = p.GATE[(size_t)row * 48 + g * 12 + tid];
    __syncthreads();
    SSTAMP(40);
    const bf16_t* kc = p.KCMP_S + (size_t)bg * 1024 * 64; const bf16_t* vc = p.VCMP_S + (size_t)bg * 1024 * 64;
    nsa_s_branch(L, n_cmp, [&](int kk, int d4, bool& valid) { valid = true; return ld4_bf(kc + (size_t)kk * 64 + d4); }, [&](int kk, int d4) { return ld4_bf(vc + (size_t)kk * 64 + d4); }, 0, tid);
    SSTAMP(41);
    for (int j = tid; j < n_slc; j += 512) { float s = 0.f;
        for (int i = 4 * j - 1; i <= 4 * j + 3; ++i) if (i >= 0 && i < n_cmp) s += (sc[i] + sc[1088 + i]) + (sc[2 * 1088 + i] + sc[3 * 1088 + i]);
        score[j] = s + ((j == 0 || j == pos / 64) ? 1e4f : 0.f); }
    __syncthreads();
    { const int j = tid >> 1, half = tid & 1, jb = half ? 129 : 0, je = half ? 257 : 129; const float sj = score[j]; int cnt = 0;
#pragma unroll 8
      for (int j2 = jb; j2 < je; ++j2) { const float s2 = score[j2]; cnt += (s2 > sj || (s2 == sj && j2 < j)) ? 1 : 0; }
      cnt += __shfl_xor(cnt, 1);
      if (half == 0 && cnt < 16) { selidx[cnt] = j; selofs[cnt] = (unsigned)((((size_t)p.page_table[b * NPAGES + (j >> 1)] * PAGE + (j & 1) * 64) * 4 + g) * 64); }
      if (tid == 0) { selidx[1] = 256; selofs[1] = 0xffffffffu; } }
    __syncthreads();
    SSTAMP(42);
    const bf16_t* newrow = p.KV6 + (size_t)row * 1536 + g * 64;
    nsa_s_branch(L, 1024,
        [&](int kk, int d4, bool& valid) { const unsigned so = selofs[kk >> 6]; const int r = kk & 63;
            if (so != 0xffffffffu) { valid = true; return *(const f32x4*)(p.csk + so + (size_t)r * 256 + d4); } valid = (r == 0); return ld4_bf(newrow + 2 * 256 + d4); },
        [&](int kk, int d4) { const unsigned so = selofs[kk >> 6]; const int r = kk & 63;
            if (so != 0xffffffffu) return *(const f32x4*)(p.csv + so + (size_t)r * 256 + d4); return ld4_bf(newrow + 3 * 256 + d4); }, 1, tid);
    SSTAMP(43);
    nsa_s_branch(L, 513,
        [&](int kk, int d4, bool& valid) { valid = true; if (kk < 512) return *(const f32x4*)(p.cwk + (((size_t)b * 512 + kk) * 4 + g) * 64 + d4); return ld4_bf(newrow + 4 * 256 + d4); },
        [&](int kk, int d4) { if (kk < 512) return *(const f32x4*)(p.cwv + (((size_t)b * 512 + kk) * 4 + g) * 64 + d4); return ld4_bf(newrow + 5 * 256 + d4); }, 2, tid);
    SSTAMP(44);
    if (tid < 256) p.OA[(size_t)row * 1024 + g * 256 + tid] = f2bf(L[SS_OACC + tid]);
    __syncthreads();
}

#define XB_TMO      128
#define XB_XCNT(j)  (256  + 64 * (j))
#define XB_XSUB(j)  (1280 + 64 * (j))
#define XB_XGEN(j)  (2304 + 64 * (j))
#define XB_TOP      3328
#define XB_TOPGEN   3392
#define XCD_BAR_WORDS 3456
#define XB_SPIN_CAP (1u << 22)

__device__ __forceinline__ unsigned xb_ld(unsigned* p)              { return __hip_atomic_load(p, __ATOMIC_RELAXED, __HIP_MEMORY_SCOPE_AGENT); }
__device__ __forceinline__ unsigned xb_add(unsigned* p, unsigned v) { return __hip_atomic_fetch_add(p, v, __ATOMIC_RELAXED, __HIP_MEMORY_SCOPE_AGENT); }
__device__ __forceinline__ unsigned xb_xcc_id() { return (unsigned)__builtin_amdgcn_s_getreg((3 << 11) | 20) & 0xFu; }
#define XB_SPIN(cond, bar) do { unsigned _sp = 0; while (cond) { __builtin_amdgcn_s_sleep(1); \
    if ((++_sp & 255u) == 0u) { if (xb_ld(&(bar)[XB_TMO])) break; if (_sp > XB_SPIN_CAP) { atomicAdd(&(bar)[XB_TMO], 1u); break; } } } } while (0)

struct XcdBarrier {
    unsigned* bar; unsigned x;
    volatile LAS unsigned* st;
};

__device__ __forceinline__ XcdBarrier xcd_barrier_post(unsigned* bar, volatile LAS unsigned* st) {
    XcdBarrier b; b.bar = bar; b.x = xb_xcc_id(); b.st = st;
    if (threadIdx.x == 0) (void)xb_add(&bar[XB_XCNT(b.x)], 1u);
    return b;
}
__device__ __forceinline__ void xcd_barrier_complete(unsigned* bar, unsigned x, unsigned& nloc, unsigned& nx) {
    const unsigned G = gridDim.x * gridDim.y * gridDim.z;
    unsigned sum, cnt, mine, sp = 0u;
    for (;;) {
        sum = 0u; cnt = 0u; mine = 0u;
#pragma unroll
        for (unsigned j = 0; j < 16; ++j) { const unsigned c = xb_ld(&bar[XB_XCNT(j)]); sum += c; cnt += (c > 0u) ? 1u : 0u; mine = (j == x) ? c : mine; }
        if (sum == G) break;
        __builtin_amdgcn_s_sleep(1);
        if ((++sp & 255u) == 0u) { if (xb_ld(&bar[XB_TMO])) break; if (sp > XB_SPIN_CAP) { atomicAdd(&bar[XB_TMO], 1u); break; } }
    }
    nloc = mine > 0u ? mine : 1u; nx = cnt > 0u ? cnt : 1u;
}

__device__ __forceinline__ void xcd_barrier(const XcdBarrier& b) {
    asm volatile("s_waitcnt vmcnt(0)" ::: "memory");
    __syncthreads();
    if (threadIdx.x == 0) {
        unsigned* bar = b.bar;
        __builtin_amdgcn_s_waitcnt(0);
        unsigned nloc = b.st[0], nx = b.st[1];
        if (nloc == 0u) { xcd_barrier_complete(bar, b.x, nloc, nx); b.st[0] = nloc; b.st[1] = nx; }
        const unsigned old = xb_add(&bar[XB_XSUB(b.x)], 1u);
        const unsigned gen = old / nloc;
        if (old + 1u == (gen + 1u) * nloc) {
            __builtin_amdgcn_fence(__ATOMIC_RELEASE, "agent");
            asm volatile("s_waitcnt vmcnt(0)" ::: "memory");
            const unsigned og = xb_add(&bar[XB_TOP], 1u);
            const unsigned tg = og / nx;
            if (og + 1u == (tg + 1u) * nx) xb_add(&bar[XB_TOPGEN], 1u);
            else XB_SPIN(xb_ld(&bar[XB_TOPGEN]) == tg, bar);
            __builtin_amdgcn_fence(__ATOMIC_ACQUIRE, "agent");
            xb_add(&bar[XB_XGEN(b.x)], 1u);
            asm volatile("s_waitcnt vmcnt(0)" ::: "memory");
        } else {
            XB_SPIN(xb_ld(&bar[XB_XGEN(b.x)]) == gen, bar);
            __builtin_amdgcn_fence(__ATOMIC_ACQUIRE, "agent");
            asm volatile("s_waitcnt vmcnt(0)" ::: "memory");
        }
    }
    __syncthreads();
}

constexpr int LDS_BYTES = 147456;
constexpr int LDSCTL_OFF = 131072, MISC_OFF = LDSCTL_OFF + 320;
constexpr int CW_BAR = 4096;
enum Phase { PH_PRO0 = 0, PH_PRO = 1, PH_IN = 2, PH_MID = 3, PH_ATT = 4, PH_BRA = 5, PH_BRB = 6, PH_WO = 7, PH_UP = 8, PH_DOWN = 9, PH_NORM = 10, PH_END = 11 };
__global__ void __launch_bounds__(512, 2) mk_fwd(Params p, int ph_lo, int ph_hi, int li) {
    extern __shared__ __attribute__((aligned(16))) unsigned char lds_raw[];
    LAS unsigned char* lds = (LAS unsigned char*)lds_raw;
    const int tid = threadIdx.x, bid = blockIdx.x, G = gridDim.x;
    for (int u = tid; u < (LDS_BYTES - LDSCTL_OFF) / 4; u += 512) ((LAS unsigned*)(lds + LDSCTL_OFF))[u] = 0u;
    __syncthreads();
    XcdBarrier bar; bar.bar = p.CTL + CW_BAR + li * XCD_BAR_WORDS; bar.x = 0; bar.st = nullptr;
    if (ph_hi - ph_lo > 1) bar = xcd_barrier_post(p.CTL + CW_BAR + li * XCD_BAR_WORDS, (volatile LAS unsigned*)(lds + MISC_OFF) + 8);
    if (PROBE_PHASE >= 0 && bid == 0 && tid == 0) ((LAS unsigned long long*)(lds + LDSCTL_OFF + 512))[0] = __builtin_amdgcn_s_memrealtime();
#define IN(k) (ph_lo <= (k) && (k) < ph_hi)
#define STAMP(i) do { if (PROBE_A >= 0 && bid == PROBE_BID && tid == 0) { ((unsigned long long*)(p.CTL + 2048))[i] = __builtin_amdgcn_s_memrealtime(); } } while (0)
#define SEAM(k) do { if (ph_lo <= (k) && (k) + 1 < ph_hi) xcd_barrier(bar); if (PROBE_PHASE >= 0 && bid == 0 && tid == 0) ((LAS unsigned long long*)(lds + LDSCTL_OFF + 512))[(k) + 1] = __builtin_amdgcn_s_memrealtime(); } while (0)
#define REP(k) _Pragma("unroll 1") for (int rep_ = 0; rep_ < 1 + ((REP_MASK >> (k)) & 1); ++rep_)
    if (IN(PH_PRO)) { if (PROBE_PHASE >= 0 && bid == 0 && tid == 0) ((LAS unsigned long long*)(lds + LDSCTL_OFF + 512))[PH_PRO] = __builtin_amdgcn_s_memrealtime();
      REP(PH_PRO) {
        STAMP(10); ph_pro0(p, lds, bid, G, tid);
        VM_WAIT(); __syncthreads(); STAMP(11);
        if (tid == 0) { __builtin_amdgcn_fence(__ATOMIC_RELEASE, "agent"); VM_WAIT(); __hip_atomic_fetch_add(p.CTL + 1088, 1u, __ATOMIC_RELAXED, __HIP_MEMORY_SCOPE_AGENT); }
        if (G > 32) { if (bid < G - 16) ph_prologue(p, lds, bid, G - 16, tid, 2); } else ph_prologue(p, lds, bid, G, tid, 2);
        __syncthreads(); STAMP(12);
        if (tid == 0) { unsigned sp = 0; while (__hip_atomic_load(p.CTL + 1088, __ATOMIC_RELAXED, __HIP_MEMORY_SCOPE_AGENT) < (unsigned)G * (1 + rep_)) { __builtin_amdgcn_s_sleep(2); if (++sp > (1u << 22)) break; }
            __builtin_amdgcn_fence(__ATOMIC_ACQUIRE, "agent"); VM_WAIT(); }
        __syncthreads(); STAMP(13);
        { const int lim = (G > 32) ? 512 : 528, extra = (G > 32 && bid >= G - 16) ? 512 + (bid - (G - 16)) : -1;
          int t = bid; bool fin = false;
#pragma unroll 1
          while (!fin) { int tt = t; if (t >= lim) { if (extra < 0) break; tt = extra; fin = true; } cmp_gemm_tile<true>(p, lds, tt, tid); t += G; } }
        __syncthreads(); STAMP(14); if (G > 32) { if (bid >= 4 && bid < G - 16) ph_prologue(p, lds, bid - 4, G - 20, tid, 1); } else ph_prologue(p, lds, bid, G, tid, 1);
        if (G > 32 && bid < G - 16) ph_late_weights(p, lds, bid * 8 + (tid >> 6), (G - 16) * 8, tid, 0, LATE_PRO);
        __syncthreads(); STAMP(15); } SEAM(PH_PRO); STAMP(16); }
    if (IN(PH_IN)) { REP(PH_IN) {
        STAMP(30); skinny_gemm(lds, p.XB + (size_t)NPT * DM, DM, p.WIN_T, NIN_PAD, DM, F_proj_s{p}, bid, G, tid);
        VM_WAIT(); __syncthreads();
        if (tid == 0) { __builtin_amdgcn_fence(__ATOMIC_RELEASE, "agent"); VM_WAIT(); __hip_atomic_fetch_add(p.CTL + 1024, 1u, __ATOMIC_RELAXED, __HIP_MEMORY_SCOPE_AGENT); }
        { pg8::Gemm g{p.XB, p.WIN_T, NPT, NIN_PAD, DM}; pg8::StaticOrder S; S.init(NPT, NIN_PAD, G, bid);
          EpiProj E{p.RSTD1, p.b_gate, p.QN, p.KV6, p.GQ, p.GK, p.GV, p.GR, p.BR, p.GATE, p.LR, p.out};
          pg8::gemm_phase<EpiProj, pg8::StaticOrder, true, true>(lds, g, S, E); } STAMP(31);
        for (int it = G - 1 - bid; it < 32; it += G) {
            if (tid == 0) { unsigned sp = 0; while (__hip_atomic_load(p.CTL + 1024, __ATOMIC_RELAXED, __HIP_MEMORY_SCOPE_AGENT) < (unsigned)G * (1 + rep_)) { __builtin_amdgcn_s_sleep(2); if (++sp > (1u << 22)) break; }
                __builtin_amdgcn_fence(__ATOMIC_ACQUIRE, "agent"); VM_WAIT(); }
            __syncthreads();
            nsa_sample_item(p, lds, it, tid); }
        STAMP(32); }
        SEAM(PH_IN); STAMP(33); }
    if (IN(PH_MID)) { REP(PH_MID) { STAMP(20);
        for (int t = bid; t < 32; t += G) { cmp_gemm_tile<false>(p, lds, t, tid); __builtin_amdgcn_fence(__ATOMIC_RELEASE, "workgroup"); VM_WAIT(); __syncthreads(); cmp_part2<false>(p, lds, t >> 4, t & 15, 0, tid); }
        STAMP(21);
        const int gsplit = (G * 20) / 32;
        const int lw0 = (G > 32) ? LATE_PRO : 0;
        { int ga0 = bid, gas = G; if (G >= 128) { ga0 = (bid >= 32 && bid < gsplit) ? bid - 32 : 512; gas = gsplit - 32; }
          if (ga0 < 512) { GlaAIn cur = gla_a_issue(p, ga0, tid);
#pragma unroll 1
              for (int it = ga0; it < 512; it += gas) { const GlaAIn nxt = gla_a_issue(p, (it + gas < 512) ? it + gas : it, tid); gla_pass_a(p, lds, it, tid, cur); cur = nxt; } } }
        STAMP(23);
        for (int it = G - 1 - bid; it < 32; it += G) gla_sample_item(p, lds, it, tid); STAMP(24);
        { const int wave = tid >> 6; const int vb = (G == 256) ? bid - 128 : bid, vs = (G == 256) ? 128 * 8 : G * 8;
          if (vb >= 0) for (int it = vb * 8 + wave; it < 1024; it += vs) nsa_vt_tile(p, lds + wave * 16384, it, tid & 63); } __syncthreads(); STAMP(25);
        if (G >= 128) { int lg = bid * 8 + (tid >> 6), ln = 32 * 8, l0 = lw0, l1 = lw0;
            if (bid >= gsplit) { lg = (bid - gsplit) * 8 + (tid >> 6); ln = (G - gsplit) * 8; l0 = lw0 + 640; l1 = 1 << 30; } else if (bid >= 32) { lg = (bid - 32) * 8 + (tid >> 6); ln = (gsplit - 32) * 8; l0 = lw0; l1 = lw0 + 640; }
            ph_late_weights(p, lds, lg, ln, tid, l0, l1); }
        else ph_late_weights(p, lds, bid * 8 + (tid >> 6), G * 8, tid, lw0);
        __syncthreads(); STAMP(26); }
        SEAM(PH_MID); }
    if (IN(PH_ATT)) { REP(PH_ATT) {
        gla_pass_b(p, bid, G, tid);
        VM_WAIT(); __syncthreads();
        if (tid == 0) { __builtin_amdgcn_fence(__ATOMIC_RELEASE, "agent"); VM_WAIT(); __hip_atomic_fetch_add(p.CTL + 1152, 1u, __ATOMIC_RELAXED, __HIP_MEMORY_SCOPE_AGENT); }
        STAMP(53);
        for (int it = bid; it < 256; it += G) { const int bg = it & 15, sq = it >> 4;
#pragma unroll 1
            for (int k = 0; k < 2; ++k) { STAMP(50 + k); nsa_prompt_item(p, lds, bg, k ? sq : 31 - sq, tid); __syncthreads(); } }
        STAMP(52);
        if (tid == 0) { unsigned sp = 0; while (__hip_atomic_load(p.CTL + 1152, __ATOMIC_RELAXED, __HIP_MEMORY_SCOPE_AGENT) < (unsigned)G * (1 + rep_)) { __builtin_amdgcn_s_sleep(2); if (++sp > (1u << 22)) break; }
            __builtin_amdgcn_fence(__ATOMIC_ACQUIRE, "agent"); VM_WAIT(); }
        __syncthreads();
        { volatile LAS int* slot = (volatile LAS int*)(lds + LDSCTL_OFF + 2048);
          int it = bid; STAMP(30);
#pragma unroll 1
          while (it < 512) { int nxt = 0; if (tid == 0) nxt = G + (int)__hip_atomic_fetch_add(p.CTL + 1344, 1u, __ATOMIC_RELAXED, __HIP_MEMORY_SCOPE_AGENT);
              gla_pass_c(p, lds, it, tid);
              if (tid == 0) *slot = nxt;
              __syncthreads(); it = __builtin_amdgcn_readfirstlane(*slot); }
          STAMP(31); } __syncthreads(); }
        SEAM(PH_ATT); }
    if (IN(PH_BRA)) { if (PROBE_PHASE >= 0 && bid == 0 && tid == 0) ((LAS unsigned long long*)(lds + LDSCTL_OFF + 512))[PH_BRB] = __builtin_amdgcn_s_memrealtime();
      REP(PH_BRA) {
        { const F_bra f{p.BR, (bf16_t*)p.TMP};
          { pg8::Gemm g{p.OA, p.WBRA_T, NPT, DM, 1024}; pg8::StaticOrder S; S.init(NPT, DM, G, bid); EpiGen<F_bra> E{f}; pg8::gemm_phase<EpiGen<F_bra>, pg8::StaticOrder, true, true>(lds, g, S, E); }
          skinny_gemm(lds, p.OA + (size_t)NPT * 1024, 1024, p.WBRA_T, DM, 1024, f, bid, G, tid); }
        { const F_brb f{p.BR, (const bf16_t*)p.TMP, p.MB};
          { pg8::Gemm g{p.OB, p.WBRB_T, NPT, DM, 1024}; pg8::StaticOrder S; S.init(NPT, DM, G, bid); EpiGen<F_brb> E{f}; pg8::gemm_phase<EpiGen<F_brb>, pg8::StaticOrder, true, true>(lds, g, S, E); }
          skinny_gemm(lds, p.OB + (size_t)NPT * 1024, 1024, p.WBRB_T, DM, 1024, f, bid, G, tid); } }
        SEAM(PH_BRB); }
    if (IN(PH_WO)) { STAMP(60);
        { const F_wo f{p.x_prompt, p.X1B, p.SUMSQ2}; pg8::Gemm g{p.MB, p.WO_T, NPT, DM, DM}; pg8::StaticOrder S; S.init(NPT, DM, G, bid); EpiGen<F_wo> E{f}; pg8::gemm_phase<EpiGen<F_wo>, pg8::StaticOrder, true, true>(lds, g, S, E); } STAMP(61);
        if (PROBE_A >= 0 && bid == PROBE_BID && tid == 0) { for (int i = 0; i < 4; ++i) ((unsigned long long*)(p.CTL + 2048))[70 + i] = ((LAS unsigned long long*)(lds + 135168))[i]; }
        { const F_wo f{p.x_sample - (size_t)NPT * DM, p.X1B, p.SUMSQ2}; skinny_gemm(lds, p.MB + (size_t)NPT * DM, DM, p.WO_T, DM, DM, f, bid, G, tid); } STAMP(62); SEAM(PH_WO); STAMP(63); }
    if (IN(PH_UP)) { REP(PH_UP) { const F_up f{p.SUMSQ2, p.HF};
        { pg8::Gemm g{p.X1B, p.WUP_T, NPT, DFF, DM}; pg8::StaticOrder S; S.init(NPT, DFF, G, bid); EpiGen<F_up> E{f}; pg8::gemm_phase<EpiGen<F_up>, pg8::StaticOrder, true, true>(lds, g, S, E); }
        skinny_gemm(lds, p.X1B + (size_t)NPT * DM, DM, p.WUP_T, DFF, DM, f, bid, G, tid); } SEAM(PH_UP); }
    const bool fusedn = (G == 256) && PROBE_A < 0 && PROBE_PHASE < 0;
    if (IN(PH_DOWN)) {
        { const F_down f{p.X1B, (bf16_t*)p.X1, p.SUMSQ3}; skinny_gemm(lds, p.HF + (size_t)NPT * DFF, DFF, p.WDN_T, DM, DFF, f, bid, G, tid); }
        if (fusedn) {
            volatile LAS unsigned* lastf = (volatile LAS unsigned*)(lds + LDSCTL_OFF + 64);
            VM_WAIT(); __syncthreads();
            if (tid == 0) { __builtin_amdgcn_fence(__ATOMIC_RELEASE, "agent"); VM_WAIT(); const unsigned old = __hip_atomic_fetch_add(p.CTL + 1280, 1u, __ATOMIC_RELAXED, __HIP_MEMORY_SCOPE_AGENT);
                const unsigned last = (old == (unsigned)G - 1u) ? 1u : 0u; if (last) { __builtin_amdgcn_fence(__ATOMIC_ACQUIRE, "agent"); VM_WAIT(); } lastf[0] = last; }
            __syncthreads();
            if (lastf[0]) ph_final_norm(p, 0, 1, tid, NPT);
            __syncthreads();
            pg8::Gemm g{p.HF, p.WDN_T, NPT, DM, DFF}; pg8::StaticOrder S; S.init(NPT, DM, G, bid); EpiDownNorm E{p.X1B, p.SUMSQ3, p.out + OFF_Y, p.norm_f, p.CTL + 8192};
            pg8::gemm_phase<EpiDownNorm, pg8::StaticOrder, false, true>(lds, g, S, E);
        } else {
            { const F_down f{p.X1B, (bf16_t*)p.X1, p.SUMSQ3}; pg8::Gemm g{p.HF, p.WDN_T, NPT, DM, DFF}; pg8::StaticOrder S; S.init(NPT, DM, G, bid); EpiGen<F_down> E{f}; pg8::gemm_phase<EpiGen<F_down>, pg8::StaticOrder, true, true>(lds, g, S, E); }
            SEAM(PH_DOWN); } }
    if (IN(PH_NORM) && !fusedn) { ph_final_norm(p, bid, G, tid);
        if (PROBE_A >= 0 && bid == 0) { const unsigned long long* tg = (const unsigned long long*)(p.CTL + 2048); const float X = (float)(tg[PROBE_B] - tg[PROBE_A]) * 1e-7f, f = 1.f + sqrtf(X);
            for (int i = tid; i < 2048; i += 512) p.out[OFF_SCK + i] *= f; }
        if (PROBE_PHASE >= 0 && bid == 0) { __syncthreads(); const LAS unsigned long long* ts = (const LAS unsigned long long*)(lds + LDSCTL_OFF + 512);
            const float X = (float)(ts[PROBE_PHASE + 1] - ts[PROBE_PHASE]) * 1e-7f, f = 1.f + sqrtf(X);
            for (int i = tid; i < 2048; i += 512) p.out[OFF_SCK + i] *= f; } }
#undef IN
#undef SEAM
#undef REP
}
__global__ void __launch_bounds__(256) k_sumsq_rows(const float* X, size_t ld, float* ss_out, int nrows) {
    const int lane = threadIdx.x & 63, row = blockIdx.x * 4 + (threadIdx.x >> 6);
    if (row >= nrows) return;
    float ss = 0.f;
    for (int i = lane; i < DM; i += 64) { const float v = X[(size_t)row * ld + i]; ss += v * v; }
    ss = wave_sum(ss);
    if (lane == 0) ss_out[row] = ss;
}
struct EF_up2 { Params p; __device__ void operator()(int r, int n, float acc) const { const float v = fmaxf(acc * rsqrtf(p.SUMSQ2[r] * (1.f / DM) + EPS), 0.f); p.HF[(size_t)r * DFF + n] = f2bf(v * v); } };

static inline size_t align_up(size_t x) { return (x + 255) & ~(size_t)255; }

extern "C" void kernel_launch(void* const* d_in, const int* in_sizes, int n_in, void* d_out, int out_size, void* d_ws, size_t ws_size, hipStream_t stream) {
    if (n_in != 29 || out_size != (int)OUT_TOTAL) { fprintf(stderr, "kernel_launch: unexpected n_in %d / out_size %d\n", n_in, out_size); return; }
    static int grid = 0;
    if (grid == 0) {
        int dev = 0, cus = 0, per_cu = 0;
        if (hipGetDevice(&dev) != hipSuccess || hipDeviceGetAttribute(&cus, hipDeviceAttributeMultiprocessorCount, dev) != hipSuccess) { fprintf(stderr, "kernel_launch: device query failed\n"); grid = -1; return; }
        if (hipFuncSetAttribute((const void*)mk_fwd, hipFuncAttributeMaxDynamicSharedMemorySize, LDS_BYTES) != hipSuccess) { fprintf(stderr, "kernel_launch: hipFuncSetAttribute failed\n"); grid = -1; return; }
        if (hipOccupancyMaxActiveBlocksPerMultiprocessor(&per_cu, (const void*)mk_fwd, 512, LDS_BYTES) != hipSuccess || per_cu < 1) { fprintf(stderr, "kernel_launch: occupancy query says %d\n", per_cu); per_cu = 1; }
        (void)hipGetLastError();
        grid = cus;
    }
    if (grid < 0) return;
    Params p{};
    p.x_prompt = (const float*)d_in[0]; p.x_sample = (const float*)d_in[1]; p.cck = (const float*)d_in[2]; p.ccv = (const float*)d_in[3];
    p.csk = (const float*)d_in[4]; p.csv = (const float*)d_in[5]; p.cwk = (const float*)d_in[6]; p.cwv = (const float*)d_in[7]; p.state = (const float*)d_in[8];
    p.page_table = (const int*)d_in[9]; p.norm1_g = (const float*)d_in[10]; p.w_in = (const float*)d_in[11]; p.b_gate = (const float*)d_in[12];
    p.pe_k = (const float*)d_in[13]; p.pe_v = (const float*)d_in[14]; p.w1k = (const float*)d_in[15]; p.w2k = (const float*)d_in[16]; p.w1v = (const float*)d_in[17]; p.w2v = (const float*)d_in[18];
    p.w_a2 = (const float*)d_in[19]; p.b_a = (const float*)d_in[20]; p.gnorm = (const float*)d_in[21]; p.w_br_a = (const float*)d_in[22]; p.w_br_b = (const float*)d_in[23];
    p.w_o = (const float*)d_in[24]; p.norm2_g = (const float*)d_in[25]; p.w_up = (const float*)d_in[26]; p.w_down = (const float*)d_in[27]; p.norm_f = (const float*)d_in[28];
    p.out = (float*)d_out;
    char* ws = (char*)d_ws; size_t off = 0;
    auto take = [&](size_t bytes) { char* r = ws + off; off = align_up(off + bytes); return r; };
    p.CTL = (unsigned*)take(1 << 20);
    p.XB = (bf16_t*)take((size_t)NTOK * DM * 2); p.RSTD1 = (float*)take(NTOK * 4); p.QN = (bf16_t*)take((size_t)NTOK * 1024 * 2); p.KV6 = (bf16_t*)take((size_t)NTOK * 1536 * 2);
    p.GATE = (float*)take((size_t)NTOK * 48 * 4); p.GQ = (bf16_t*)take((size_t)NTOK * 512 * 2); p.GK = (bf16_t*)take((size_t)NTOK * 512 * 2); p.GV = (bf16_t*)take((size_t)NTOK * 1024 * 2);
    p.GR = (bf16_t*)take((size_t)NTOK * 1024 * 2); p.LR = (float*)take((size_t)NTOK * 16 * 4); p.BR = (bf16_t*)take((size_t)NTOK * 4096 * 2);
    p.KCMP_P = (bf16_t*)take(16 * 128 * 64 * 2); p.VCMPT_P = (bf16_t*)take(16 * 128 * 64 * 2); p.KCMP_S = (bf16_t*)take(32 * 1024 * 64 * 2); p.VCMP_S = (bf16_t*)take(32 * 1024 * 64 * 2);
    p.OA = (bf16_t*)take((size_t)NTOK * 1024 * 2); p.OB = (bf16_t*)take((size_t)NTOK * 1024 * 2); p.TMP = (float*)take((size_t)NTOK * DM * 4); p.MB = (bf16_t*)take((size_t)NTOK * DM * 2);
    p.X1 = (float*)take((size_t)NTOK * DM * 4); p.X1B = (bf16_t*)take((size_t)NTOK * DM * 2); p.RSTD2 = (float*)take(NTOK * 4); p.HF = (bf16_t*)take((size_t)NTOK * DFF * 2);
    p.WIN_T = (bf16_t*)take((size_t)NIN_PAD * DM * 2); p.WBRA_T = (bf16_t*)take((size_t)DM * 1024 * 2); p.WBRB_T = (bf16_t*)take((size_t)DM * 1024 * 2); p.WO_T = (bf16_t*)take((size_t)DM * DM * 2);
    p.WUP_T = (bf16_t*)take((size_t)DFF * DM * 2); p.WDN_T = (bf16_t*)take((size_t)DM * DFF * 2); p.SUMSQ2 = (float*)take(NTOK * 4); p.SUMSQ3 = (float*)take(NTOK * 4);
    p.W1T = (bf16_t*)take(2 * 256 * 1024 * 2); p.W2TG = (bf16_t*)take(2 * 8192 * 2); p.BIAS1 = (float*)take(256 * 4); p.AB_S = (float*)take((size_t)2 * 32768 * 256 * 4); p.AB_P = (float*)take((size_t)2 * 2048 * 256 * 4);
    p.UT = (float*)take((size_t)512 * 256 * 128 * 2); p.BCG = (float*)take((size_t)512 * 8192 * 4); p.DEC = (float*)take(512 * 128 * 4); p.SNT = (bf16_t*)take((size_t)512 * 256 * 128 * 2);
    p.VTS = (bf16_t*)take((size_t)16 * 64 * SEQ * 2); p.VTW = (bf16_t*)take((size_t)16 * 64 * SEQ * 2);
    if (off > ws_size) { fprintf(stderr, "kernel_launch: workspace too small: need %zu have %zu\n", off, ws_size); return; }
    hipMemsetAsync(p.CTL, 0, 1 << 20, stream);
#define MK(lo, hi, li) hipLaunchKernelGGL(mk_fwd, dim3(grid), dim3(512), LDS_BYTES, stream, p, (int)(lo), (int)(hi), (int)(li))
    MK(PH_PRO0, PH_END, 0);
}
```

```cpp
#include <hip/hip_runtime.h>
#include <stdint.h>
#include <cstdio>

typedef unsigned short bf16_t;

constexpr int DM = 2048, NB = 4, SEQ = 2048, NPT = NB * SEQ, DB = 8, NTOK = NPT + DB;
constexpr int PAST = 16384, PAGE = 128, NPAGES = 128;
constexpr int NG = 4, HPG = 4, DH = 64;
constexpr int DIN = 9792, DFF = 8192;
constexpr int C_Q = 0, C_KV = 1024, C_G = 2560, C_QL = 2608, C_KL = 3120, C_VL = 3632, C_RL = 4656, C_LR = 5680, C_BR = 5696;
constexpr float EPS = 1e-6f;
constexpr size_t OFF_Y = 0, OFF_YS = (size_t)NPT * DM, OFF_PCK = OFF_YS + (size_t)DB * DM;
constexpr size_t SZ_PROW = (size_t)NPT * 256;
constexpr size_t OFF_PWK = OFF_PCK + 4 * SZ_PROW, SZ_PWIN = (size_t)NB * 512 * 256;
constexpr size_t OFF_PGLA = OFF_PWK + 2 * SZ_PWIN, SZ_PGLA = (size_t)NB * 4 * 128 * 256;
constexpr size_t OFF_SCK = OFF_PGLA + SZ_PGLA, SZ_SROW = (size_t)DB * 256;
constexpr size_t OFF_SWK = OFF_SCK + 4 * SZ_SROW, SZ_SWIN = (size_t)DB * 512 * 256;
constexpr size_t OFF_SGLA = OFF_SWK + 2 * SZ_SWIN, SZ_SGLA = (size_t)DB * 4 * 128 * 256;
constexpr size_t OUT_TOTAL = OFF_SGLA + SZ_SGLA;
static_assert(OUT_TOTAL == 29908992, "output size");

__device__ __forceinline__ bf16_t f2bf(float f) { unsigned u = __builtin_bit_cast(unsigned, f); return (bf16_t)((u + 0x7fffu + ((u >> 16) & 1u)) >> 16); }
__device__ __forceinline__ float bf2f(bf16_t h) { return __builtin_bit_cast(float, (unsigned)h << 16); }
__device__ __forceinline__ float sigmoidf_(float x) { return 1.f / (1.f + __expf(-x)); }
__device__ __forceinline__ float siluf_(float x) { return x / (1.f + __expf(-x)); }
__device__ __forceinline__ float gelu_tanh(float x) { const float u = 0.7978845608028654f * (x + 0.044715f * x * x * x); return 0.5f * x * (1.f + tanhf(u)); }
__device__ __forceinline__ float logsigmoidf_(float x) { return fminf(x, 0.f) - log1pf(__expf(-fabsf(x))); }
__device__ __forceinline__ float wave_sum(float v) {
#pragma unroll
    for (int o = 1; o < 64; o <<= 1) v += __shfl_xor(v, o);
    return v;
}
__device__ __forceinline__ float wave_max(float v) {
#pragma unroll
    for (int o = 1; o < 64; o <<= 1) v = fmaxf(v, __shfl_xor(v, o));
    return v;
}

struct Params {
    const float *x_prompt, *x_sample, *cck, *ccv, *csk, *csv, *cwk, *cwv, *state;
    const int* page_table;
    const float *norm1_g, *w_in, *b_gate, *pe_k, *pe_v, *w1k, *w2k, *w1v, *w2v, *w_a2, *b_a, *gnorm, *w_br_a, *w_br_b, *w_o, *norm2_g, *w_up, *w_down, *norm_f;
    float* out;
    bf16_t *XB, *QN, *KV6, *GQ, *GK, *GV, *GR, *BR, *KCMP_P, *VCMPT_P, *KCMP_S, *VCMP_S, *OA, *OB, *MB, *X1B, *HF;
    float *RSTD1, *GATE, *LR, *TMP, *X1, *RSTD2;
    bf16_t *WIN_T, *WBRA_T, *WBRB_T, *WO_T, *WUP_T, *WDN_T;
    float *SUMSQ2, *SUMSQ3;
    unsigned* CTL;
    bf16_t *W1T, *W2TG; float *BIAS1, *AB_S, *AB_P;
    float *UT, *DEC, *BCG; bf16_t* SNT;
    bf16_t *VTS, *VTW;
};

__device__ __forceinline__ float xval(const Params& p, int row, int n) { return row < NPT ? p.x_prompt[(size_t)row * DM + n] : p.x_sample[(size_t)(row - NPT) * DM + n]; }

__device__ __forceinline__ void proj_store(const Params& p, int row, int n, float v) {
    if (n < C_KV) p.QN[(size_t)row * 1024 + n] = f2bf(v * 0.125f);
    else if (n < C_G) {
        const int c = n - C_KV; p.KV6[(size_t)row * 1536 + c] = f2bf(v); const int j = c >> 8, cc = c & 255;
        if (row < NPT) { const int b = row >> 11, t = row & 2047;
            if (j < 4) p.out[OFF_PCK + j * SZ_PROW + (size_t)row * 256 + cc] = v;
            else if (t >= 1536) p.out[OFF_PWK + (j - 4) * SZ_PWIN + ((size_t)b * 512 + t - 1536) * 256 + cc] = v; }
        else { const int b = row - NPT;
            if (j < 4) p.out[OFF_SCK + j * SZ_SROW + (size_t)b * 256 + cc] = v;
            else p.out[OFF_SWK + (j - 4) * SZ_SWIN + ((size_t)b * 512 + 511) * 256 + cc] = v; }
    }
    else if (n < C_QL) { const int c = n - C_G; p.GATE[(size_t)row * 48 + c] = sigmoidf_(v + p.b_gate[c]); }
    else if (n < C_KL) p.GQ[(size_t)row * 512 + (n - C_QL)] = f2bf(v * 0.08838834764831845f);
    else if (n < C_VL) p.GK[(size_t)row * 512 + (n - C_KL)] = f2bf(v);
    else if (n < C_RL) p.GV[(size_t)row * 1024 + (n - C_VL)] = f2bf(v);
    else if (n < C_LR) p.GR[(size_t)row * 1024 + (n - C_RL)] = f2bf(siluf_(v));
    else if (n < C_BR) p.LR[(size_t)row * 16 + (n - C_LR)] = v;
    else p.BR[(size_t)row * 4096 + (n - C_BR)] = f2bf(sigmoidf_(v));
}

__global__ void __launch_bounds__(256) k_prep_x(Params p) {
    const int lane = threadIdx.x & 63, row = blockIdx.x * 4 + (threadIdx.x >> 6);
    if (row >= NTOK) return;
    const float* xr = row < NPT ? p.x_prompt + (size_t)row * DM : p.x_sample + (size_t)(row - NPT) * DM;
    float ss = 0.f;
    for (int i = lane; i < DM; i += 64) { const float v = xr[i]; ss += v * v; p.XB[(size_t)row * DM + i] = f2bf(v); }
    ss = wave_sum(ss);
    if (lane == 0) p.RSTD1[row] = rsqrtf(ss * (1.f / DM) + EPS);
}
__global__ void __launch_bounds__(256) k_copy_swin(Params p) {
    const size_t i = (size_t)blockIdx.x * 256 + threadIdx.x;
    if (i >= (size_t)DB * 511 * 256) return;
    const int c = (int)(i & 255); const int r = (int)((i >> 8) % 511); const int b = (int)((i >> 8) / 511);
    p.out[OFF_SWK + ((size_t)b * 512 + r) * 256 + c] = p.cwk[((size_t)b * 512 + r + 1) * 256 + c];
    p.out[OFF_SWK + SZ_SWIN + ((size_t)b * 512 + r) * 256 + c] = p.cwv[((size_t)b * 512 + r + 1) * 256 + c];
}
__global__ void __launch_bounds__(256) k_rms_rows(const float* X, float* rstd, int nrows) {
    const int lane = threadIdx.x & 63, row = blockIdx.x * 4 + (threadIdx.x >> 6);
    if (row >= nrows) return;
    float ss = 0.f;
    for (int i = lane; i < DM; i += 64) { const float v = X[(size_t)row * DM + i]; ss += v * v; }
    ss = wave_sum(ss);
    if (lane == 0) rstd[row] = rsqrtf(ss * (1.f / DM) + EPS);
}
__global__ void __launch_bounds__(256) k_final_norm(Params p) {
    const int lane = threadIdx.x & 63, row = blockIdx.x * 4 + (threadIdx.x >> 6);
    if (row >= NTOK) return;
    float* yr = row < NPT ? p.out + OFF_Y + (size_t)row * DM : p.out + OFF_YS + (size_t)(row - NPT) * DM;
    float ss = 0.f;
    for (int i = lane; i < DM; i += 64) { const float v = yr[i]; ss += v * v; }
    ss = wave_sum(ss);
    const float r = rsqrtf(ss * (1.f / DM) + EPS);
    for (int i = lane; i < DM; i += 64) yr[i] = yr[i] * r * p.norm_f[i];
}

template <class AF, class BF, class EF>
__global__ void __launch_bounds__(256) k_gemm_naive(int m_off, int M, int N, int K, AF af, BF bf, EF ef) {
    __shared__ float As[16][68], Bs[16][68];
    const int tid = threadIdx.x, tx = tid & 15, ty = tid >> 4, m0 = m_off + blockIdx.y * 64, n0 = blockIdx.x * 64;
    float acc[4][4];
#pragma unroll
    for (int i = 0; i < 4; ++i)
#pragma unroll
        for (int j = 0; j < 4; ++j) acc[i][j] = 0.f;
    for (int k0 = 0; k0 < K; k0 += 16) {
#pragma unroll
        for (int i = 0; i < 4; ++i) { const int idx = tid + 256 * i, r = idx >> 4, kk = idx & 15; As[kk][r] = (m0 + r < M) ? af(m0 + r, k0 + kk) : 0.f; }
#pragma unroll
        for (int i = 0; i < 4; ++i) { const int idx = tid + 256 * i, kk = idx >> 6, c = idx & 63; Bs[kk][c] = (n0 + c < N) ? bf(k0 + kk, n0 + c) : 0.f; }
        __syncthreads();
#pragma unroll
        for (int kk = 0; kk < 16; ++kk) {
            float a[4], b[4];
#pragma unroll
            for (int i = 0; i < 4; ++i) { a[i] = As[kk][ty * 4 + i]; b[i] = Bs[kk][tx * 4 + i]; }
#pragma unroll
            for (int i = 0; i < 4; ++i)
#pragma unroll
                for (int j = 0; j < 4; ++j) acc[i][j] += a[i] * b[j];
        }
        __syncthreads();
    }
#pragma unroll
    for (int i = 0; i < 4; ++i)
#pragma unroll
        for (int j = 0; j < 4; ++j) { const int r = m0 + ty * 4 + i, c = n0 + tx * 4 + j; if (r < M && c < N) ef(r, c, acc[i][j]); }
}
struct AF_x_g1 { Params p; __device__ float operator()(int r, int k) const { return xval(p, r, k) * p.norm1_g[k]; } };
struct BF_rowmajor { const float* W; long ld; __device__ float operator()(int k, int n) const { return W[(size_t)k * ld + n]; } };
struct EF_proj { Params p; __device__ void operator()(int r, int n, float acc) const { proj_store(p, r, n, acc * p.RSTD1[r]); } };
struct AF_bf { const bf16_t* A; long ld; __device__ float operator()(int r, int k) const { return bf2f(A[(size_t)r * ld + k]); } };
struct EF_bra { Params p; __device__ void operator()(int r, int n, float acc) const { p.TMP[(size_t)r * DM + n] = acc * bf2f(p.BR[(size_t)r * 4096 + n]); } };
struct EF_brb { Params p; __device__ void operator()(int r, int n, float acc) const { p.MB[(size_t)r * DM + n] = f2bf(p.TMP[(size_t)r * DM + n] + acc * bf2f(p.BR[(size_t)r * 4096 + 2048 + n])); } };
struct EF_wo { Params p; __device__ void operator()(int r, int n, float acc) const { const float x1 = xval(p, r, n) + acc; p.X1[(size_t)r * DM + n] = x1; p.X1B[(size_t)r * DM + n] = f2bf(x1); } };
struct AF_x1_g2 { Params p; __device__ float operator()(int r, int k) const { return bf2f(p.X1B[(size_t)r * DM + k]) * p.norm2_g[k]; } };
struct EF_up { Params p; __device__ void operator()(int r, int n, float acc) const { const float v = fmaxf(acc * p.RSTD2[r], 0.f); p.HF[(size_t)r * DFF + n] = f2bf(v * v); } };
struct EF_down { Params p; __device__ void operator()(int r, int n, float acc) const { const float x2 = p.X1[(size_t)r * DM + n] + acc;
    if (r < NPT) p.out[OFF_Y + (size_t)r * DM + n] = x2; else p.out[OFF_YS + (size_t)(r - NPT) * DM + n] = x2; } };

__global__ void __launch_bounds__(128) k_compress_naive(Params p, int is_s) {
    const int n_cmp = is_s ? 1023 : 127, n_pad = is_s ? 1024 : 128;
    const int kv = blockIdx.y, tid = threadIdx.x;
    const int i = blockIdx.x % n_pad, bg = blockIdx.x / n_pad, b = bg >> 2, g = bg & 3;
    __shared__ float blk[2048]; __shared__ float hid[128];
    if (i >= n_cmp) {
        if (tid < 64) { if (is_s) { (kv ? p.VCMP_S : p.KCMP_S)[((size_t)bg * 1024 + i) * 64 + tid] = 0; }
                        else { if (kv) p.VCMPT_P[((size_t)bg * 64 + tid) * 128 + i] = 0; else p.KCMP_P[((size_t)bg * 128 + i) * 64 + tid] = 0; } }
        return;
    }
    const float* pe = kv ? p.pe_v : p.pe_k; const float* w1 = kv ? p.w1v : p.w1k; const float* w2 = kv ? p.w2v : p.w2k;
    for (int e = tid; e < 2048; e += 128) { const int l = e >> 6, d = e & 63; const int pos = 16 * i + l; float v;
        if (is_s) { const int page = p.page_table[b * NPAGES + (pos >> 7)]; v = (kv ? p.ccv : p.cck)[(((size_t)page * PAGE + (pos & 127)) * 4 + g) * 64 + d]; }
        else v = bf2f(p.KV6[((size_t)b * SEQ + pos) * 1536 + kv * 256 + g * 64 + d]);
        blk[e] = v + pe[e]; }
    __syncthreads();
    float h = 0.f;
    for (int k = 0; k < 2048; ++k) h += blk[k] * w1[(size_t)k * 128 + tid];
    hid[tid] = gelu_tanh(h);
    __syncthreads();
    if (tid < 64) { float o = 0.f; for (int j = 0; j < 128; ++j) o += hid[j] * w2[j * 64 + tid];
        if (is_s) (kv ? p.VCMP_S : p.KCMP_S)[((size_t)bg * 1024 + i) * 64 + tid] = f2bf(o);
        else { if (kv) p.VCMPT_P[((size_t)bg * 64 + tid) * 128 + i] = f2bf(o); else p.KCMP_P[((size_t)bg * 128 + i) * 64 + tid] = f2bf(o); } }
}

struct RowRef { const float* pf; const bf16_t* pb; };
__device__ __forceinline__ float rr_get(const RowRef& r, int d) { return r.pf ? r.pf[d] : bf2f(r.pb[d]); }

template <class KF, class VF>
__device__ __forceinline__ void attend_naive(int nk, KF keyf, VF valf, const float (*q)[64], float (*sc)[1088], float (*oacc)[64], const float* gate3, int gsel, int tid) {
    const int lane = tid & 63, wv = tid >> 6;
    for (int kk = tid; kk < nk; kk += 256) { bool valid; const RowRef r = keyf(kk, valid);
        if (valid) { float d0 = 0.f, d1 = 0.f, d2 = 0.f, d3 = 0.f;
            for (int d = 0; d < 64; ++d) { const float kx = rr_get(r, d); d0 += q[0][d] * kx; d1 += q[1][d] * kx; d2 += q[2][d] * kx; d3 += q[3][d] * kx; }
            sc[0][kk] = d0; sc[1][kk] = d1; sc[2][kk] = d2; sc[3][kk] = d3; }
        else { sc[0][kk] = -INFINITY; sc[1][kk] = -INFINITY; sc[2][kk] = -INFINITY; sc[3][kk] = -INFINITY; } }
    __syncthreads();
    {
        float m = -INFINITY; for (int kk = lane; kk < nk; kk += 64) m = fmaxf(m, sc[wv][kk]);
        m = wave_max(m);
        float s = 0.f;
        for (int kk = lane; kk < nk; kk += 64) { const float x = sc[wv][kk]; const float e = (x == -INFINITY) ? 0.f : __expf(x - m); sc[wv][kk] = e; s += e; }
        s = wave_sum(s);
        const float inv = s > 0.f ? 1.f / s : 0.f;
        for (int kk = lane; kk < nk; kk += 64) sc[wv][kk] *= inv;
    }
    __syncthreads();
    {
        float o = 0.f;
        for (int kk = 0; kk < nk; ++kk) { const float pr = sc[wv][kk]; if (pr != 0.f) o += pr * valf(kk, lane); }
        oacc[wv][lane] += gate3[wv * 3 + gsel] * o;
    }
    __syncthreads();
}

__device__ __forceinline__ void nsa_naive_body(const Params& p, int row, int g, int tid, float (*q)[64], float (*sc)[1088], float (*oacc)[64], float* gate3, float* score, int* selidx) {
    const bool is_s = row >= NPT; const int b = is_s ? row - NPT : row >> 11, t = is_s ? 0 : row & 2047;
    const int start = is_s ? PAST : 0, pos = start + t, rowbase = is_s ? NPT + b : b * SEQ;
    const int n_cmp = is_s ? 1023 : 127, n_slc = is_s ? 257 : 32;
    { const int hd = tid >> 6, d = tid & 63; q[hd][d] = bf2f(p.QN[(size_t)row * 1024 + (g * 4 + hd) * 64 + d]); oacc[hd][d] = 0.f; }
    if (tid < 12) gate3[tid] = p.GATE[(size_t)row * 48 + g * 12 + tid];
    __syncthreads();
    const int bg = b * 4 + g;
    const bf16_t* kc = is_s ? p.KCMP_S + (size_t)bg * 1024 * 64 : p.KCMP_P + (size_t)bg * 128 * 64;
    const bf16_t* vc_s = p.VCMP_S + (size_t)bg * 1024 * 64; const bf16_t* vc_p = p.VCMPT_P + (size_t)bg * 64 * 128;
    auto kf_c = [&](int kk, bool& valid) { valid = (16 * kk + 31 <= pos); return RowRef{nullptr, kc + (size_t)kk * 64}; };
    auto vf_c = [&](int kk, int d) { return is_s ? bf2f(vc_s[(size_t)kk * 64 + d]) : bf2f(vc_p[(size_t)d * 128 + kk]); };
    attend_naive(n_cmp, kf_c, vf_c, q, sc, oacc, gate3, 0, tid);
    for (int j = tid; j < n_slc; j += 256) { float s = 0.f;
        for (int i = 4 * j - 1; i <= 4 * j + 3; ++i) if (i >= 0 && i < n_cmp) s += (sc[0][i] + sc[1][i]) + (sc[2][i] + sc[3][i]);
        score[j] = (j * 64 <= pos) ? s + ((j == 0 || j == pos / 64) ? 1e4f : 0.f) : -1e30f; }
    __syncthreads();
    for (int j = tid; j < n_slc; j += 256) { const float sj = score[j]; int rank = 0;
        for (int j2 = 0; j2 < n_slc; ++j2) { const float s2 = score[j2]; rank += (s2 > sj || (s2 == sj && j2 < j)) ? 1 : 0; }
        if (rank < 16) selidx[rank] = j; }
    __syncthreads();
    auto row_at = [&](int kp, int which) -> RowRef {
        if (kp < start) {
            if (which < 4) { const int page = p.page_table[b * NPAGES + (kp >> 7)]; const float* c = (which == 2) ? p.csk : p.csv; return RowRef{c + (((size_t)page * PAGE + (kp & 127)) * 4 + g) * 64, nullptr}; }
            const float* c = (which == 4) ? p.cwk : p.cwv; return RowRef{c + (((size_t)b * 512 + (kp - (PAST - 512))) * 4 + g) * 64, nullptr};
        }
        return RowRef{nullptr, p.KV6 + (size_t)(rowbase + kp - start) * 1536 + which * 256 + g * 64};
    };
    auto kf_s = [&](int kk, bool& valid) { const int kp = selidx[kk >> 6] * 64 + (kk & 63); valid = (kp <= pos); return valid ? row_at(kp, 2) : RowRef{nullptr, nullptr}; };
    auto vf_s = [&](int kk, int d) { const int kp = selidx[kk >> 6] * 64 + (kk & 63); return rr_get(row_at(kp, 3), d); };
    attend_naive(1024, kf_s, vf_s, q, sc, oacc, gate3, 1, tid);
    auto kf_w = [&](int kk, bool& valid) { const int kp = pos - 512 + kk; valid = (kp >= 0); return valid ? row_at(kp, 4) : RowRef{nullptr, nullptr}; };
    auto vf_w = [&](int kk, int d) { const int kp = pos - 512 + kk; return rr_get(row_at(kp, 5), d); };
    attend_naive(513, kf_w, vf_w, q, sc, oacc, gate3, 2, tid);
    { const int hd = tid >> 6, d = tid & 63; p.OA[(size_t)row * 1024 + (g * 4 + hd) * 64 + d] = f2bf(oacc[hd][d]); }
}
__global__ void __launch_bounds__(256) k_nsa_naive(Params p, int row0) {
    __shared__ float q[4][64]; __shared__ float sc[4][1088]; __shared__ float oacc[4][64]; __shared__ float gate3[12];
    __shared__ float score[260]; __shared__ int selidx[16];
    nsa_naive_body(p, row0 + blockIdx.x, blockIdx.y, threadIdx.x, q, sc, oacc, gate3, score, selidx);
}

__global__ void __launch_bounds__(512) k_gla_naive(Params p, int is_s) {
    const int b = blockIdx.x >> 2, h = blockIdx.x & 3, tid = threadIdx.x, e = tid & 255, half = tid >> 8;
    const int T = is_s ? 1 : SEQ, rowbase = is_s ? NPT + b : b * SEQ;
    __shared__ float a_s[128], q_s[128], k_s[128], part[2][256], red[8];
    float S[64];
#pragma unroll
    for (int dd = 0; dd < 64; ++dd) S[dd] = is_s ? p.state[(((size_t)b * 4 + h) * 128 + half * 64 + dd) * 256 + e] : 0.f;
    for (int t = 0; t < T; ++t) {
        const int row = rowbase + t;
        if (tid < 128) { float x = p.b_a[h * 128 + tid];
            for (int r = 0; r < 16; ++r) x += p.LR[(size_t)row * 16 + r] * p.w_a2[r * 512 + h * 128 + tid];
            a_s[tid] = __expf(logsigmoidf_(x) * (1.f / 16.f));
            q_s[tid] = bf2f(p.GQ[(size_t)row * 512 + h * 128 + tid]); k_s[tid] = bf2f(p.GK[(size_t)row * 512 + h * 128 + tid]); }
        const float v = bf2f(p.GV[(size_t)row * 1024 + h * 256 + e]);
        __syncthreads();
        float po = 0.f;
#pragma unroll
        for (int dd = 0; dd < 64; ++dd) { const int d = half * 64 + dd; S[dd] = a_s[d] * S[dd] + k_s[d] * v; po += q_s[d] * S[dd]; }
        part[half][e] = po;
        __syncthreads();
        float o = 0.f;
        if (tid < 256) { o = part[0][e] + part[1][e]; const float ss = wave_sum(o * o); if ((tid & 63) == 0) red[tid >> 6] = ss; }
        __syncthreads();
        if (tid < 256) { const float ss = (red[0] + red[1]) + (red[2] + red[3]); const float r = rsqrtf(ss * (1.f / 256.f) + EPS);
            p.OB[(size_t)row * 1024 + h * 256 + e] = f2bf(o * r * p.gnorm[e] * bf2f(p.GR[(size_t)row * 1024 + h * 256 + e])); }
    }
    float* so = p.out + (is_s ? OFF_SGLA : OFF_PGLA);
#pragma unroll
    for (int dd = 0; dd < 64; ++dd) so[(((size_t)b * 4 + h) * 128 + half * 64 + dd) * 256 + e] = S[dd];
}

#define REP_MASK 0
#define PROBE_PHASE -1
#define PROBE_A -1
#define PROBE_B -1
#define PROBE_BID 0
#define LATE_PRO 9600
#define GAS __attribute__((address_space(1)))
#define LAS __attribute__((address_space(3)))
typedef unsigned v4u __attribute__((ext_vector_type(4)));
typedef unsigned v2u __attribute__((ext_vector_type(2)));
#define LDS_WAIT() asm volatile("s_waitcnt lgkmcnt(0)" ::: "memory")
#define VM_WAIT() asm volatile("s_waitcnt vmcnt(0)" ::: "memory")
#define LDS_BARRIER() do { asm volatile("s_waitcnt lgkmcnt(0)" ::: "memory"); __builtin_amdgcn_s_barrier(); asm volatile("" ::: "memory"); } while (0)
typedef float f32x2_t __attribute__((ext_vector_type(2)));
typedef __bf16 bf16x2_t __attribute__((ext_vector_type(2)));
__device__ __forceinline__ unsigned cvtpk(float lo, float hi) { f32x2_t v = {lo, hi}; bf16x2_t b = __builtin_convertvector(v, bf16x2_t); return __builtin_bit_cast(unsigned, b); }
__device__ __forceinline__ unsigned pk2(float lo, float hi) { return cvtpk(lo, hi); }
__device__ __forceinline__ float sigmoid_fast(float x) { return __builtin_amdgcn_rcpf(1.f + __expf(-x)); }
__device__ __forceinline__ float silu_fast(float x) { return x * __builtin_amdgcn_rcpf(1.f + __expf(-x)); }
__device__ __forceinline__ float gelu_fast(float x) { return x * __builtin_amdgcn_rcpf(1.f + __expf(-1.5957691216057308f * (x + 0.044715f * x * x * x))); }
constexpr int NIN_PAD = 9984;
__host__ __device__ __forceinline__ int in_colmap(int n) {
    if (n < 2560) return n; if (n < 3072) return C_QL + (n - 2560); if (n < 3584) return C_KL + (n - 3072); if (n < 4608) return C_VL + (n - 3584);
    if (n < 5632) return C_RL + (n - 4608); if (n < 9728) return C_BR + (n - 5632); if (n < 9776) return C_G + (n - 9728); if (n < 9792) return C_LR + (n - 9776); return -1;
}
namespace pg8 {
#define PG8_LAS __attribute__((address_space(3)))
typedef unsigned short bf16_t;
typedef short bf16x8 __attribute__((ext_vector_type(8)));
typedef float f32x4 __attribute__((ext_vector_type(4)));
typedef unsigned u32x4 __attribute__((ext_vector_type(4)));
constexpr int BM = 256, BK = 64, HALF = 128, HTB = HALF * BK * 2  , STAGE_BYTES = 8 * HTB, NXCD = 8, WGM = 8;

__host__ __device__ __forceinline__ int lds_byte(int r, int c) { const int st = (r >> 4) * 2 + (c >> 5), rr = r & 15, cc = c & 31, ob = rr * 64 + cc * 2; return st * 1024 + (ob ^ (((ob >> 9) & 1) << 5)); }
__host__ __device__ __forceinline__ void stage_rc(int b, int& R, int& C) { const int st = b / 1024, sb = b % 1024, swz = sb ^ (((sb >> 9) & 1) << 5); R = (st >> 1) * 16 + swz / 64; C = (st & 1) * 32 + (swz % 64) / 2; }
__host__ __device__ __forceinline__ int perm32(int rho) { const int n = rho >> 4, i = rho & 15; return 8 * (i >> 2) + 4 * n + (i & 3); }

struct Unit { int pm, pn; };
struct Gemm { const bf16_t* A; const bf16_t* Bt; int M, N, K; };

struct StaticOrder {
    int nM, nN, nwg, G, c;
    __host__ __device__ void init(int M, int N, int G_, int c_) { nM = M / BM; nN = N / BM; nwg = nM * nN; G = G_; c = c_; }
    __host__ __device__ bool next(int i, Unit& u) const {
        const long L = (long)i * G + c; if (L >= nwg) return false;
        int wgid = (int)L; { const int q = nwg / NXCD, r = nwg % NXCD, xcd = wgid % NXCD, off = wgid / NXCD; wgid = (xcd < r ? xcd * (q + 1) : r * (q + 1) + (xcd - r) * q) + off; }
        const int nig = WGM * nN, gid = wgid / nig, fm = gid * WGM, gsz = (nM - fm) < WGM ? (nM - fm) : WGM;
        u.pm = fm + ((wgid % nig) % gsz); u.pn = (wgid % nig) / gsz; return true;
    }
    __device__ __forceinline__ void a_ready(const Unit&) const {}
    __device__ __forceinline__ void done(const Unit&) const {}
};

template <class Epi, class Sched, bool ALIGN_EPI = false, bool SP2 = false>
__device__ __forceinline__ void gemm_phase(PG8_LAS unsigned char* lds, const Gemm g, const Sched& S, const Epi& E) {
    const int tid = threadIdx.x, wid = __builtin_amdgcn_readfirstlane(tid >> 6), lane = tid & 63, wr = wid >> 2, wc = wid & 3, fr = lane & 15, fq = lane >> 4;
    const int K = g.K, nt = K / BK;
    unsigned voffA[2], voffB[2];
#pragma unroll
    for (int i = 0; i < 2; ++i) { int R, C; stage_rc(tid * 16 + i * 8192, R, C); const int Rb = Epi::PERM ? ((R & ~31) + perm32(R & 31)) : R;
        voffA[i] = (unsigned)(R * K + C) * 2u; voffB[i] = (unsigned)(Rb * K + C) * 2u; }
    const size_t kstep = (size_t)(BK * 2);
    const size_t hstep = (size_t)HALF * K * 2;
    const size_t tstep = 2 * hstep;
    const unsigned ldsw = (unsigned)wid * 1024u;
    const int aoff = lds_byte(wr * 64 + fr, fq * 8), boff = lds_byte(wc * 32 + fr, fq * 8);
#define PG8_SA(b, h) (((b) * 2 + (h)) * HTB)
#define PG8_SB(b, h) ((4 + (b) * 2 + (h)) * HTB)
#define PG8_STAGE(bufoff, gbase, voff) do { _Pragma("unroll") for (int _i = 0; _i < 2; ++_i) \
        __builtin_amdgcn_global_load_lds((const unsigned*)((const char*)(gbase) + (voff)[_i]), (PG8_LAS unsigned*)(lds + (bufoff) + ldsw + _i * 8192), 16, 0, 0); } while (0)
#define PG8_LDA(dst, b, h) do { _Pragma("unroll") for (int m = 0; m < 4; ++m) _Pragma("unroll") for (int k = 0; k < 2; ++k) dst[m][k] = *(const PG8_LAS bf16x8*)(lds + PG8_SA(b, h) + aoff + m * 2048 + k * 1024); } while (0)
#define PG8_LDB(dst, b, h) do { _Pragma("unroll") for (int n = 0; n < 2; ++n) _Pragma("unroll") for (int k = 0; k < 2; ++k) dst[n][k] = *(const PG8_LAS bf16x8*)(lds + PG8_SB(b, h) + boff + n * 2048 + k * 1024); } while (0)
#define PG8_MMA(ai, bj, At, Bt) do { __builtin_amdgcn_s_setprio(1); _Pragma("unroll") for (int m = 0; m < 4; ++m) _Pragma("unroll") for (int n = 0; n < 2; ++n) _Pragma("unroll") for (int k = 0; k < 2; ++k) \
        acc[ai][bj][m][n] = __builtin_amdgcn_mfma_f32_16x16x32_bf16(Bt[n][k], At[m][k], acc[ai][bj][m][n], 0, 0, 0); __builtin_amdgcn_s_setprio(0); } while (0)
#define PG8_WAIT_V(n) asm volatile("s_waitcnt vmcnt(" #n ")" ::: "memory")
#define PG8_WAIT_L(n) asm volatile("s_waitcnt lgkmcnt(" #n ")" ::: "memory")
#define PG8_BAR __builtin_amdgcn_s_barrier()
#define PG8_SCHED __builtin_amdgcn_sched_barrier(0)
    Unit cur, nxt; int ui = 0;
    if (!S.next(0, cur)) return;
    if (PROBE_A >= 0 && threadIdx.x == 0) *(PG8_LAS unsigned long long*)(lds + 135168 + 8 * 0) = __builtin_amdgcn_s_memrealtime();
    f32x4 acc[2][2][4][2];
#pragma unroll
    for (int a = 0; a < 2; ++a)
#pragma unroll
        for (int b = 0; b < 2; ++b)
#pragma unroll
            for (int m = 0; m < 4; ++m)
#pragma unroll
                for (int n = 0; n < 2; ++n) acc[a][b][m][n] = (f32x4){0.f, 0.f, 0.f, 0.f};
    bf16x8 At[4][2], B0[2][2], B1[2][2];
    const char* cA = (const char*)g.A + (size_t)cur.pm * tstep; const char* cB = (const char*)g.Bt + (size_t)cur.pn * tstep;
    S.a_ready(cur);
    if constexpr (SP2) {
        PG8_STAGE(PG8_SB(0, 0), cB, voffB); PG8_STAGE(PG8_SB(0, 1), cB + hstep, voffB); PG8_STAGE(PG8_SA(0, 0), cA, voffA); PG8_STAGE(PG8_SA(0, 1), cA + hstep, voffA);
        if (wr == 1) PG8_BAR;
        PG8_WAIT_V(2); PG8_BAR;
        PG8_STAGE(PG8_SB(1, 0), cB + kstep, voffB); PG8_STAGE(PG8_SA(1, 0), cA + kstep, voffA); PG8_STAGE(PG8_SB(1, 1), cB + hstep + kstep, voffB);
        PG8_WAIT_V(6); PG8_BAR;
    } else {
        PG8_STAGE(PG8_SB(0, 0), cB, voffB); PG8_STAGE(PG8_SA(0, 0), cA, voffA); PG8_STAGE(PG8_SB(0, 1), cB + hstep, voffB); PG8_STAGE(PG8_SA(0, 1), cA + hstep, voffA);
        if (wr == 1) PG8_BAR;
        PG8_WAIT_V(4); PG8_BAR;
        PG8_STAGE(PG8_SB(1, 0), cB + kstep, voffB); PG8_STAGE(PG8_SA(1, 0), cA + kstep, voffA); PG8_STAGE(PG8_SB(1, 1), cB + hstep + kstep, voffB);
        PG8_WAIT_V(6); PG8_BAR;
    }
    for (;;) {
        const bool has_next = S.next(ui + 1, nxt);
        const char* nA = has_next ? (const char*)g.A + (size_t)nxt.pm * tstep : cA; const char* nB = has_next ? (const char*)g.Bt + (size_t)nxt.pn * tstep : cB;
        for (int t = 0; t < nt; t += 2) {
            const bool last = (t == nt - 2);
            const char* a1 = cA + (size_t)(t + 1) * kstep;
            const char* a2 = last ? nA : cA + (size_t)(t + 2) * kstep; const char* b2 = last ? nB : cB + (size_t)(t + 2) * kstep;
            const char* a3 = a2 + kstep; const char* b3 = b2 + kstep;
            if (last && has_next) S.a_ready(nxt);
            if constexpr (SP2) {
            PG8_LDB(B0, 0, 0); PG8_LDB(B1, 0, 1); PG8_SCHED; PG8_LDA(At, 0, 0); PG8_STAGE(PG8_SA(1, 1), a1 + hstep, voffA);
            PG8_WAIT_V(8); PG8_WAIT_L(0); PG8_BAR; PG8_MMA(0, 0, At, B0); PG8_MMA(0, 1, At, B1); PG8_BAR; PG8_SCHED;
            PG8_LDA(At, 0, 1); PG8_STAGE(PG8_SB(0, 0), b2, voffB); PG8_STAGE(PG8_SB(0, 1), b2 + hstep, voffB); PG8_STAGE(PG8_SA(0, 0), a2, voffA);
            PG8_WAIT_V(8); PG8_WAIT_L(0); PG8_BAR; PG8_MMA(1, 0, At, B0); PG8_MMA(1, 1, At, B1); PG8_BAR; PG8_SCHED;
            PG8_LDB(B0, 1, 0); PG8_LDB(B1, 1, 1); PG8_SCHED; PG8_LDA(At, 1, 0); PG8_STAGE(PG8_SA(0, 1), a2 + hstep, voffA);
            PG8_WAIT_V(8); PG8_WAIT_L(0); PG8_BAR; PG8_MMA(0, 0, At, B0); PG8_MMA(0, 1, At, B1); PG8_BAR; PG8_SCHED;
            PG8_LDA(At, 1, 1); PG8_STAGE(PG8_SB(1, 0), b3, voffB); PG8_STAGE(PG8_SB(1, 1), b3 + hstep, voffB); PG8_STAGE(PG8_SA(1, 0), a3, voffA);
            PG8_WAIT_V(8); PG8_WAIT_L(0); PG8_BAR; PG8_MMA(1, 0, At, B0); PG8_MMA(1, 1, At, B1); PG8_BAR; PG8_SCHED;
            } else {
            PG8_LDB(B0, 0, 0); PG8_SCHED; PG8_LDA(At, 0, 0); PG8_STAGE(PG8_SA(1, 1), a1 + hstep, voffA);
            PG8_WAIT_L(8); PG8_BAR; PG8_WAIT_L(0); PG8_MMA(0, 0, At, B0); PG8_BAR; PG8_SCHED;
            PG8_LDB(B1, 0, 1); PG8_STAGE(PG8_SB(0, 0), b2, voffB);
            PG8_BAR; PG8_WAIT_L(0); PG8_MMA(0, 1, At, B1); PG8_BAR;
            PG8_LDA(At, 0, 1); PG8_STAGE(PG8_SA(0, 0), a2, voffA);
            PG8_BAR; PG8_WAIT_L(0); PG8_MMA(1, 0, At, B0); PG8_BAR; PG8_SCHED;
            PG8_STAGE(PG8_SB(0, 1), b2 + hstep, voffB);
            PG8_WAIT_V(6); PG8_BAR; PG8_MMA(1, 1, At, B1); PG8_BAR;
            PG8_LDB(B0, 1, 0); PG8_SCHED; PG8_LDA(At, 1, 0); PG8_STAGE(PG8_SA(0, 1), a2 + hstep, voffA);
            PG8_WAIT_L(8); PG8_BAR; PG8_WAIT_L(0); PG8_MMA(0, 0, At, B0); PG8_BAR; PG8_SCHED;
            PG8_LDB(B1, 1, 1); PG8_STAGE(PG8_SB(1, 0), b3, voffB);
            PG8_BAR; PG8_WAIT_L(0); PG8_MMA(0, 1, At, B1); PG8_BAR;
            PG8_LDA(At, 1, 1); PG8_STAGE(PG8_SA(1, 0), a3, voffA);
            PG8_BAR; PG8_WAIT_L(0); PG8_MMA(1, 0, At, B0); PG8_BAR; PG8_SCHED;
            PG8_STAGE(PG8_SB(1, 1), b3 + hstep, voffB);
            PG8_WAIT_V(6); PG8_BAR; PG8_MMA(1, 1, At, B1); PG8_BAR;
            }
        }
        if (PROBE_A >= 0 && threadIdx.x == 0) *(PG8_LAS unsigned long long*)(lds + 135168 + 8 * 1) = __builtin_amdgcn_s_memrealtime();
        if constexpr (ALIGN_EPI) { if (wr == 0) PG8_BAR; }
        if (PROBE_A >= 0 && threadIdx.x == 0) *(PG8_LAS unsigned long long*)(lds + 135168 + 8 * 2) = __builtin_amdgcn_s_memrealtime();
        if constexpr (!Epi::AFTER_DRAIN) { E(acc, cur, wr, wc, fr, fq); S.done(cur); }   if (PROBE_A >= 0 && threadIdx.x == 0) *(PG8_LAS unsigned long long*)(lds + 135168 + 8 * 3) = __builtin_amdgcn_s_memrealtime();
        if (!has_next) break;
#pragma unroll
        for (int a = 0; a < 2; ++a)
#pragma unroll
            for (int b = 0; b < 2; ++b)
#pragma unroll
                for (int m = 0; m < 4; ++m)
#pragma unroll
                    for (int n = 0; n < 2; ++n) acc[a][b][m][n] = (f32x4){0.f, 0.f, 0.f, 0.f};
        cur = nxt; cA = nA; cB = nB; ++ui;
        if constexpr (ALIGN_EPI) { if (wr == 1) PG8_BAR; }
    }
    PG8_WAIT_V(0);
    if constexpr (!ALIGN_EPI) { if (wr == 0) PG8_BAR; }
    PG8_BAR;
    if constexpr (Epi::AFTER_DRAIN) { E.fused(acc, cur, wr, wc, fr, fq, lds, wid, lane); S.done(cur); }
#undef PG8_SA
#undef PG8_SB
#undef PG8_STAGE
#undef PG8_LDA
#undef PG8_LDB
#undef PG8_MMA
#undef PG8_WAIT_V
#undef PG8_WAIT_L
#undef PG8_BAR
#undef PG8_SCHED
}
}
#define SSTAMP(i) do { if (PROBE_A >= 0 && (int)blockIdx.x == PROBE_BID && tid == 0) { ((unsigned long long*)(p.CTL + 2048))[i] = __builtin_amdgcn_s_memrealtime(); } } while (0)
typedef pg8::f32x4 f32x4;
struct NoIn {};
template <class F> struct EpiGen {
    static constexpr bool PERM = true, AFTER_DRAIN = false; F f;
    __device__ __forceinline__ void operator()(const f32x4 (&acc)[2][2][4][2], const pg8::Unit& u, int wr, int wc, int fr, int fq) const {
        const int row0 = u.pm * 256 + wr * 64 + fr, col0 = u.pn * 256 + wc * 32 + 8 * fq;
        float ctx[8];
#pragma unroll
        for (int r = 0; r < 8; ++r) ctx[r] = f.row_begin(row0 + (r >> 2) * 128 + (r & 3) * 16);
        typename F::In8 cur[2], nxt[2];
#pragma unroll
        for (int g = 0; g < 2; ++g) cur[g] = f.load8(row0, col0 + g * 128);
#pragma unroll
        for (int r = 0; r < 8; ++r) { const int row = row0 + (r >> 2) * 128 + (r & 3) * 16;
            if (r < 7) { const int rn = row0 + ((r + 1) >> 2) * 128 + ((r + 1) & 3) * 16;
#pragma unroll
                for (int g = 0; g < 2; ++g) nxt[g] = f.load8(rn, col0 + g * 128); }
            float part = 0.f;
#pragma unroll
            for (int g = 0; g < 2; ++g) part += f.store8(ctx[r], row, col0 + g * 128, acc[r >> 2][g][r & 3][0], acc[r >> 2][g][r & 3][1], cur[g]);
            f.row_end(row, part, fq, true);
#pragma unroll
            for (int g = 0; g < 2; ++g) cur[g] = nxt[g]; }
    }
};
__device__ __forceinline__ f32x4 bf4lo(v4u w) { return (f32x4){bf2f((bf16_t)(w.x & 0xffff)), bf2f((bf16_t)(w.x >> 16)), bf2f((bf16_t)(w.y & 0xffff)), bf2f((bf16_t)(w.y >> 16))}; }
__device__ __forceinline__ f32x4 bf4hi(v4u w) { return (f32x4){bf2f((bf16_t)(w.z & 0xffff)), bf2f((bf16_t)(w.z >> 16)), bf2f((bf16_t)(w.w & 0xffff)), bf2f((bf16_t)(w.w >> 16))}; }
__device__ __forceinline__ v4u pk8(f32x4 a, f32x4 c) { v4u w; w.x = pk2(a[0], a[1]); w.y = pk2(a[2], a[3]); w.z = pk2(c[0], c[1]); w.w = pk2(c[2], c[3]); return w; }
template <int ACT  >
__device__ __forceinline__ void store_tile_bf16(const f32x4 (&acc)[2][2][4][2], int row0, int col0, const float (&rsv)[8], float scale, bf16_t* dst, int ld) {
#pragma unroll
    for (int ai = 0; ai < 2; ++ai)
#pragma unroll
        for (int m = 0; m < 4; ++m) { const int row = row0 + ai * 128 + m * 16; const float rs = rsv[ai * 4 + m] * scale; bf16_t* rp = dst + (size_t)row * ld + col0;
#pragma unroll
            for (int bj = 0; bj < 2; ++bj) { f32x4 v = acc[ai][bj][m][0] * rs, w = acc[ai][bj][m][1] * rs;
                if (ACT == 1) { v[0] = silu_fast(v[0]); v[1] = silu_fast(v[1]); v[2] = silu_fast(v[2]); v[3] = silu_fast(v[3]); w[0] = silu_fast(w[0]); w[1] = silu_fast(w[1]); w[2] = silu_fast(w[2]); w[3] = silu_fast(w[3]); }
                if (ACT == 2) { v[0] = sigmoid_fast(v[0]); v[1] = sigmoid_fast(v[1]); v[2] = sigmoid_fast(v[2]); v[3] = sigmoid_fast(v[3]); w[0] = sigmoid_fast(w[0]); w[1] = sigmoid_fast(w[1]); w[2] = sigmoid_fast(w[2]); w[3] = sigmoid_fast(w[3]); }
                *(v4u*)(rp + bj * 128) = pk8(v, w); } }
}
struct EpiProj {
    static constexpr bool PERM = true, AFTER_DRAIN = false;
    const float* rstd; const float* b_gate; bf16_t *QN, *KV6, *GQ, *GK, *GV, *GR, *BR; float *GATE, *LR, *out;
    __device__ __forceinline__ void operator()(const f32x4 (&acc)[2][2][4][2], const pg8::Unit& u, int wr, int wc, int fr, int fq) const {
        const int row0 = u.pm * 256 + wr * 64 + fr, cl0 = wc * 32 + 8 * fq, pn = u.pn;
        float rsv[8];
#pragma unroll
        for (int r = 0; r < 8; ++r) rsv[r] = rstd[row0 + (r >> 2) * 128 + (r & 3) * 16];
        if (pn < 4) store_tile_bf16<0>(acc, row0, pn * 256 + cl0, rsv, 0.125f, QN, 1024);
        else if (pn < 10) { const int j = pn - 4;
            store_tile_bf16<0>(acc, row0, j * 256 + cl0, rsv, 1.f, KV6, 1536);
#pragma unroll
            for (int ai = 0; ai < 2; ++ai)
#pragma unroll
                for (int m = 0; m < 4; ++m) { const int row = row0 + ai * 128 + m * 16; const float rs = rsv[ai * 4 + m]; const int b = row >> 11, t = row & 2047;
                    float* rp = nullptr;
                    if (j < 4) rp = out + OFF_PCK + j * SZ_PROW + (size_t)row * 256 + cl0;
                    else if (t >= 1536) rp = out + OFF_PWK + (j - 4) * SZ_PWIN + ((size_t)b * 512 + (t - 1536)) * 256 + cl0;
                    if (rp) {
#pragma unroll
                        for (int bj = 0; bj < 2; ++bj)
#pragma unroll
                            for (int n = 0; n < 2; ++n) *(f32x4*)(rp + bj * 128 + n * 4) = acc[ai][bj][m][n] * rs; } }
        }
        else if (pn < 12) store_tile_bf16<0>(acc, row0, (pn - 10) * 256 + cl0, rsv, 0.08838834764831845f, GQ, 512);
        else if (pn < 14) store_tile_bf16<0>(acc, row0, (pn - 12) * 256 + cl0, rsv, 1.f, GK, 512);
        else if (pn < 18) store_tile_bf16<0>(acc, row0, (pn - 14) * 256 + cl0, rsv, 1.f, GV, 1024);
        else if (pn < 22) store_tile_bf16<1>(acc, row0, (pn - 18) * 256 + cl0, rsv, 1.f, GR, 1024);
        else if (pn < 38) store_tile_bf16<2>(acc, row0, (pn - 22) * 256 + cl0, rsv, 1.f, BR, 4096);
        else if (wc < 2) {
#pragma unroll
            for (int ai = 0; ai < 2; ++ai)
#pragma unroll
                for (int m = 0; m < 4; ++m) { const int row = row0 + ai * 128 + m * 16; const float rs = rsv[ai * 4 + m];
#pragma unroll
                    for (int n = 0; n < 2; ++n) { const int cl = cl0 + n * 4; const f32x4 v = acc[ai][0][m][n] * rs;
                        if (cl < 48) { const f32x4 bg = *(const f32x4*)(b_gate + cl); f32x4 o; o[0] = sigmoid_fast(v[0] + bg[0]); o[1] = sigmoid_fast(v[1] + bg[1]); o[2] = sigmoid_fast(v[2] + bg[2]); o[3] = sigmoid_fast(v[3] + bg[3]);
                            *(f32x4*)(GATE + (size_t)row * 48 + cl) = o; }
                        else *(f32x4*)(LR + (size_t)row * 16 + (cl - 48)) = v; } }
        }
    }
};
struct F_bra { const bf16_t* BR; bf16_t* TMPB; typedef v2u In;
    typedef v4u In8;
    __device__ __forceinline__ In8 load8(int row, int col) const { return *(const v4u*)(BR + (size_t)row * 4096 + col); }
    __device__ __forceinline__ float store8(float, int row, int col, f32x4 v, f32x4 w, const In8& g) const { *(v4u*)(TMPB + (size_t)row * DM + col) = pk8(v * bf4lo(g), w * bf4hi(g)); return 0.f; }
    __device__ __forceinline__ float row_begin(int) const { return 0.f; }
    __device__ __forceinline__ In load4(int row, int col) const { return *(const v2u*)(BR + (size_t)row * 4096 + col); }
    __device__ __forceinline__ float store4(float, int row, int col, f32x4 v, const In& b) const {
        v2u w; w.x = pk2(v[0] * bf2f((bf16_t)(b.x & 0xffff)), v[1] * bf2f((bf16_t)(b.x >> 16))); w.y = pk2(v[2] * bf2f((bf16_t)(b.y & 0xffff)), v[3] * bf2f((bf16_t)(b.y >> 16)));
        *(v2u*)(TMPB + (size_t)row * DM + col) = w; return 0.f; }
    __device__ __forceinline__ void row_end(int, float, int, bool) const {}
};
struct F_brb { const bf16_t* BR; const bf16_t* TMPB; bf16_t* MB; struct In { v2u b; v2u t; };
    struct In8 { v4u b; v4u t; };
    __device__ __forceinline__ In8 load8(int row, int col) const { In8 i; i.b = *(const v4u*)(BR + (size_t)row * 4096 + 2048 + col); i.t = *(const v4u*)(TMPB + (size_t)row * DM + col); return i; }
    __device__ __forceinline__ float store8(float, int row, int col, f32x4 v, f32x4 w, const In8& i) const { *(v4u*)(MB + (size_t)row * DM + col) = pk8(bf4lo(i.t) + v * bf4lo(i.b), bf4hi(i.t) + w * bf4hi(i.b)); return 0.f; }
    __device__ __forceinline__ float row_begin(int) const { return 0.f; }
    __device__ __forceinline__ In load4(int row, int col) const { In i; i.b = *(const v2u*)(BR + (size_t)row * 4096 + 2048 + col); i.t = *(const v2u*)(TMPB + (size_t)row * DM + col); return i; }
    __device__ __forceinline__ float store4(float, int row, int col, f32x4 v, const In& i) const { const v2u b = i.b, t = i.t;
        const float o0 = bf2f((bf16_t)(t.x & 0xffff)) + v[0] * bf2f((bf16_t)(b.x & 0xffff)), o1 = bf2f((bf16_t)(t.x >> 16)) + v[1] * bf2f((bf16_t)(b.x >> 16));
        const float o2 = bf2f((bf16_t)(t.y & 0xffff)) + v[2] * bf2f((bf16_t)(b.y & 0xffff)), o3 = bf2f((bf16_t)(t.y >> 16)) + v[3] * bf2f((bf16_t)(b.y >> 16));
        v2u w; w.x = pk2(o0, o1); w.y = pk2(o2, o3); *(v2u*)(MB + (size_t)row * DM + col) = w; return 0.f; }
    __device__ __forceinline__ void row_end(int, float, int, bool) const {}
};
struct F_wo { const float* x; bf16_t* X1B; float* SUMSQ; typedef f32x4 In;
    struct In8 { f32x4 a, c; };
    __device__ __forceinline__ In8 load8(int row, int col) const { In8 i; i.a = *(const f32x4*)(x + (size_t)row * DM + col); i.c = *(const f32x4*)(x + (size_t)row * DM + col + 4); return i; }
    __device__ __forceinline__ float store8(float, int row, int col, f32x4 v, f32x4 w, const In8& i) const { const f32x4 a = i.a + v, c = i.c + w; *(v4u*)(X1B + (size_t)row * DM + col) = pk8(a, c);
        return ((a[0] * a[0] + a[1] * a[1]) + (a[2] * a[2] + a[3] * a[3])) + ((c[0] * c[0] + c[1] * c[1]) + (c[2] * c[2] + c[3] * c[3])); }
    __device__ __forceinline__ float row_begin(int) const { return 0.f; }
    __device__ __forceinline__ In load4(int row, int col) const { return *(const f32x4*)(x + (size_t)row * DM + col); }
    __device__ __forceinline__ float store4(float, int row, int col, f32x4 v, const In& xv) const { const f32x4 x1 = xv + v;
        v2u w; w.x = pk2(x1[0], x1[1]); w.y = pk2(x1[2], x1[3]); *(v2u*)(X1B + (size_t)row * DM + col) = w;
        return (x1[0] * x1[0] + x1[1] * x1[1]) + (x1[2] * x1[2] + x1[3] * x1[3]); }
    __device__ __forceinline__ void row_end(int row, float part, int fq, bool valid) const { part += __shfl_xor(part, 16); part += __shfl_xor(part, 32); if (fq == 0 && valid) atomicAdd(SUMSQ + row, part); }
};
struct F_up { const float* SUMSQ; bf16_t* HF; typedef NoIn In;
    typedef NoIn In8;
    __device__ __forceinline__ In8 load8(int, int) const { return NoIn{}; }
    __device__ __forceinline__ float store8(float rs, int row, int col, f32x4 v, f32x4 w, const In8&) const { f32x4 a, c;
#pragma unroll
        for (int i = 0; i < 4; ++i) { const float t = fmaxf(v[i] * rs, 0.f), s = fmaxf(w[i] * rs, 0.f); a[i] = t * t; c[i] = s * s; }
        *(v4u*)(HF + (size_t)row * DFF + col) = pk8(a, c); return 0.f; }
    __device__ __forceinline__ float row_begin(int row) const { return rsqrtf(SUMSQ[row] * (1.f / DM) + EPS); }
    __device__ __forceinline__ In load4(int, int) const { return NoIn{}; }
    __device__ __forceinline__ float store4(float rs, int row, int col, f32x4 v, const In&) const { float h[4];
#pragma unroll
        for (int i = 0; i < 4; ++i) { const float t = fmaxf(v[i] * rs, 0.f); h[i] = t * t; }
        v2u w; w.x = pk2(h[0], h[1]); w.y = pk2(h[2], h[3]); *(v2u*)(HF + (size_t)row * DFF + col) = w; return 0.f; }
    __device__ __forceinline__ void row_end(int, float, int, bool) const {}
};
struct F_down { const bf16_t* X1B; bf16_t* YB; float* SUMSQ; typedef v2u In;
    typedef v4u In8;
    __device__ __forceinline__ In8 load8(int row, int col) const { return *(const v4u*)(X1B + (size_t)row * DM + col); }
    __device__ __forceinline__ float store8(float, int row, int col, f32x4 v, f32x4 w, const In8& t) const { const f32x4 a = bf4lo(t) + v, c = bf4hi(t) + w; *(v4u*)(YB + (size_t)row * DM + col) = pk8(a, c);
        return ((a[0] * a[0] + a[1] * a[1]) + (a[2] * a[2] + a[3] * a[3])) + ((c[0] * c[0] + c[1] * c[1]) + (c[2] * c[2] + c[3] * c[3])); }
    __device__ __forceinline__ float row_begin(int) const { return 0.f; }
    __device__ __forceinline__ In load4(int row, int col) const { return *(const v2u*)(X1B + (size_t)row * DM + col); }
    __device__ __forceinline__ float store4(float, int row, int col, f32x4 v, const In& t) const {
        const float a0 = bf2f((bf16_t)(t.x & 0xffff)) + v[0], a1 = bf2f((bf16_t)(t.x >> 16)) + v[1], a2 = bf2f((bf16_t)(t.y & 0xffff)) + v[2], a3 = bf2f((bf16_t)(t.y >> 16)) + v[3];
        v2u w; w.x = pk2(a0, a1); w.y = pk2(a2, a3); *(v2u*)(YB + (size_t)row * DM + col) = w; return (a0 * a0 + a1 * a1) + (a2 * a2 + a3 * a3); }
    __device__ __forceinline__ void row_end(int row, float part, int fq, bool valid) const { part += __shfl_xor(part, 16); part += __shfl_xor(part, 32); if (fq == 0 && valid) atomicAdd(SUMSQ + row, part); }
};

struct EpiDownNorm {
    static constexpr bool PERM = true, AFTER_DRAIN = true;
    const bf16_t* X1B; float* SUMSQ; float* Y; const float* norm_f; unsigned* pcnt;
    __device__ __forceinline__ void fused(f32x4 (&acc)[2][2][4][2], const pg8::Unit& u, int wr, int wc, int fr, int fq, PG8_LAS unsigned char* lds, int wid, int lane) const {
        const int row0 = u.pm * 256 + wr * 64 + fr, col0 = u.pn * 256 + wc * 32 + 8 * fq;
        v4u cur[2], nxt[2];
#pragma unroll
        for (int g = 0; g < 2; ++g) cur[g] = *(const v4u*)(X1B + (size_t)row0 * DM + col0 + g * 128);
#pragma unroll
        for (int r = 0; r < 8; ++r) { const int row = row0 + (r >> 2) * 128 + (r & 3) * 16;
            if (r < 7) { const int rn = row0 + ((r + 1) >> 2) * 128 + ((r + 1) & 3) * 16;
#pragma unroll
                for (int g = 0; g < 2; ++g) nxt[g] = *(const v4u*)(X1B + (size_t)rn * DM + col0 + g * 128); }
            float part = 0.f;
#pragma unroll
            for (int g = 0; g < 2; ++g) { f32x4& a = acc[r >> 2][g][r & 3][0]; f32x4& c = acc[r >> 2][g][r & 3][1]; a = a + bf4lo(cur[g]); c = c + bf4hi(cur[g]);
                part += ((a[0] * a[0] + a[1] * a[1]) + (a[2] * a[2] + a[3] * a[3])) + ((c[0] * c[0] + c[1] * c[1]) + (c[2] * c[2] + c[3] * c[3])); }
            part += __shfl_xor(part, 16); part += __shfl_xor(part, 32); if (fq == 0) atomicAdd(SUMSQ + row, part);
#pragma unroll
            for (int g = 0; g < 2; ++g) cur[g] = nxt[g]; }
        asm volatile("s_waitcnt vmcnt(0)" ::: "memory"); __syncthreads();
        if (threadIdx.x == 0) { __builtin_amdgcn_fence(__ATOMIC_RELEASE, "agent"); asm volatile("s_waitcnt vmcnt(0)" ::: "memory");
            __hip_atomic_fetch_add(pcnt + 64 * u.pm, 1u, __ATOMIC_RELAXED, __HIP_MEMORY_SCOPE_AGENT);
            unsigned sp = 0; while (__hip_atomic_load(pcnt + 64 * u.pm, __ATOMIC_RELAXED, __HIP_MEMORY_SCOPE_AGENT) < 8u) { __builtin_amdgcn_s_sleep(1); if (++sp > (1u << 22)) break; }
            __builtin_amdgcn_fence(__ATOMIC_ACQUIRE, "agent"); asm volatile("s_waitcnt vmcnt(0)" ::: "memory"); }
        __syncthreads();
#pragma unroll
        for (int r = 0; r < 8; ++r) { const int row = row0 + (r >> 2) * 128 + (r & 3) * 16;
            const float rs = rsqrtf(__hip_atomic_load(SUMSQ + row, __ATOMIC_RELAXED, __HIP_MEMORY_SCOPE_AGENT) * (1.f / DM) + EPS);
#pragma unroll
            for (int g = 0; g < 2; ++g) { const int col = col0 + g * 128; const f32x4 g0 = *(const f32x4*)(norm_f + col), g1 = *(const f32x4*)(norm_f + col + 4);
                *(f32x4*)(Y + (size_t)row * DM + col) = acc[r >> 2][g][r & 3][0] * rs * g0; *(f32x4*)(Y + (size_t)row * DM + col + 4) = acc[r >> 2][g][r & 3][1] * rs * g1; } }
    }
    __device__ __forceinline__ void operator()(const f32x4 (&)[2][2][4][2], const pg8::Unit&, int, int, int, int) const {}
};

typedef short bf16x8_t __attribute__((ext_vector_type(8)));
template <class F>
__device__ __forceinline__ void skinny_gemm(LAS unsigned char* lds, const bf16_t* A, int lda, const bf16_t* Bt, int N, int K, const F& f, int bid, int G, int tid) {
    const int lane = tid & 63, wave = __builtin_amdgcn_readfirstlane(tid >> 6), j = lane & 15, g = lane >> 4;
    LAS f32x4* red = (LAS f32x4*)lds;
    const int ksl = K >> 3;
    for (int it = bid; it < (N >> 4); it += G) {
        const int n0 = it * 16;
        const bf16_t* bp = Bt + (size_t)(n0 + j) * K + wave * ksl + 8 * g;
        const bf16_t* ap = A + (size_t)(j & 7) * lda + wave * ksl + 8 * g;
        f32x4 acc = {0.f, 0.f, 0.f, 0.f};
#pragma unroll 4
        for (int k = 0; k < ksl; k += 32) {
            const bf16x8_t b = *(const bf16x8_t*)(bp + k); bf16x8_t a = *(const bf16x8_t*)(ap + k);
            if (j >= 8) a = (bf16x8_t){0, 0, 0, 0, 0, 0, 0, 0};
            acc = __builtin_amdgcn_mfma_f32_16x16x32_bf16(b, a, acc, 0, 0, 0);
        }
        red[wave * 64 + lane] = acc;
        __syncthreads();
        if (wave == 0) { f32x4 sacc = red[lane];
#pragma unroll
            for (int w = 1; w < 8; ++w) sacc = sacc + red[w * 64 + lane];
            const int row = NPT + (j & 7); const bool valid = j < 8; const float ctx = f.row_begin(row); float part = 0.f;
            const typename F::In in = f.load4(row, n0 + 4 * g);
            if (valid) part = f.store4(ctx, row, n0 + 4 * g, sacc, in);
            f.row_end(row, part, g, valid); }
        __syncthreads();
    }
}
struct F_proj_s { const Params& p; typedef NoIn In;
    __device__ __forceinline__ float row_begin(int row) const { return p.RSTD1[row]; }
    __device__ __forceinline__ In load4(int, int) const { return NoIn{}; }
    __device__ __forceinline__ float store4(float rs, int row, int col, f32x4 v, const In&) const { const int n0 = in_colmap(col); if (n0 >= 0) {
#pragma unroll
        for (int i = 0; i < 4; ++i) proj_store(p, row, n0 + i, v[i] * rs); } return 0.f; }
    __device__ __forceinline__ void row_end(int, float, int, bool) const {}
};

struct TrRegs { f32x4 v[8]; };
template <class CM>
__device__ __forceinline__ TrRegs transpose_load(const float* W, int ldw, const float* kscale, int item, int nblk, CM cm, int lane) {
    const int kb = item / nblk, nb = item % nblk, k0 = 64 * kb, n0 = 32 * nb;
    const int n4 = (lane & 7) * 4, kr = lane >> 3;
    const int sc = cm(n0 + n4);
    TrRegs t;
#pragma unroll
    for (int i = 0; i < 8; ++i) t.v[i] = sc >= 0 ? *(const f32x4*)(W + (size_t)(k0 + 8 * i + kr) * ldw + sc) : (f32x4){0.f, 0.f, 0.f, 0.f};
    if (kscale) {
#pragma unroll
        for (int i = 0; i < 8; ++i) t.v[i] = t.v[i] * kscale[k0 + 8 * i + kr]; }
    return t;
}
__device__ __forceinline__ void transpose_store(const TrRegs& t, bf16_t* WT, int K, int item, int nblk, LAS float* scr, int lane) {
    const int kb = item / nblk, nb = item % nblk, k0 = 64 * kb, n0 = 32 * nb;
    const int n4 = (lane & 7) * 4, kr = lane >> 3;
#pragma unroll
    for (int i = 0; i < 8; ++i) { LAS float* d = scr + (8 * i + kr) * 33 + n4; d[0] = t.v[i][0]; d[1] = t.v[i][1]; d[2] = t.v[i][2]; d[3] = t.v[i][3]; }
    LDS_WAIT(); asm volatile("" ::: "memory");
    const int c = lane & 7;
#pragma unroll
    for (int j = 0; j < 4; ++j) { const int n = (lane >> 3) + 8 * j; const LAS float* s = scr + (8 * c) * 33 + n;
        v4u o; o.x = pk2(s[0 * 33], s[1 * 33]); o.y = pk2(s[2 * 33], s[3 * 33]); o.z = pk2(s[4 * 33], s[5 * 33]); o.w = pk2(s[6 * 33], s[7 * 33]);
        *(v4u*)(WT + (size_t)(n0 + n) * K + k0 + 8 * c) = o; }
    LDS_WAIT(); asm volatile("" ::: "memory");
}
template <class CM>
__device__ __forceinline__ void transpose_item(const float* W, int ldw, const float* kscale, bf16_t* WT, int K, int item, int nblk, CM cm, LAS float* scr, int lane) {
    const TrRegs t = transpose_load(W, ldw, kscale, item, nblk, cm, lane); transpose_store(t, WT, K, item, nblk, scr, lane);
}
struct CM_id { __device__ __forceinline__ int operator()(int n) const { return n; } };
struct CM_in { __device__ __forceinline__ int operator()(int n) const { return in_colmap(n); } };

__device__ __forceinline__ void ph_prologue(const Params& p, LAS unsigned char* lds, int bid, int G, int tid, int parts  ) {
    const int lane = tid & 63, wave = tid >> 6, gw = bid * 8 + wave, NGW = G * 8;
    LAS float* scr = (LAS float*)(lds + wave * 16384);
    constexpr int I_IN = 32 * (NIN_PAD / 32);
    if ((parts & 1) && gw < I_IN) { TrRegs cur = transpose_load(p.w_in, DIN, p.norm1_g, gw, NIN_PAD / 32, CM_in{}, lane);
        for (int it = gw; it < I_IN; it += NGW) { const int nx = it + NGW; TrRegs nxt = cur; if (nx < I_IN) nxt = transpose_load(p.w_in, DIN, p.norm1_g, nx, NIN_PAD / 32, CM_in{}, lane);
            transpose_store(cur, p.WIN_T, DM, it, NIN_PAD / 32, scr, lane); cur = nxt; } }
    if (!(parts & 2)) return;
    for (int row = gw; row < NTOK; row += NGW) {
        const f32x4* xr = (const f32x4*)(row < NPT ? p.x_prompt + (size_t)row * DM : p.x_sample + (size_t)(row - NPT) * DM) + 2 * lane;
        f32x4 v[8]; float ss = 0.f;
#pragma unroll
        for (int j = 0; j < 4; ++j) { v[2 * j] = xr[128 * j]; v[2 * j + 1] = xr[128 * j + 1]; }
#pragma unroll
        for (int j = 0; j < 8; ++j) ss += (v[j][0] * v[j][0] + v[j][1] * v[j][1]) + (v[j][2] * v[j][2] + v[j][3] * v[j][3]);
        ss = wave_sum(ss);
        v4u* o = (v4u*)(p.XB + (size_t)row * DM) + lane;
#pragma unroll
        for (int j = 0; j < 4; ++j) o[64 * j] = pk8(v[2 * j], v[2 * j + 1]);
        if (lane == 0) p.RSTD1[row] = rsqrtf(ss * (1.f / DM) + EPS);
    }
    for (int i = bid * 512 + tid; i < DB * 511 * 64; i += G * 512) { const int c4 = i & 63, r = (i >> 6) % 511, b = (i >> 6) / 511;
        const size_t so = ((size_t)b * 512 + r + 1) * 256 + c4 * 4, dofs = ((size_t)b * 512 + r) * 256 + c4 * 4;
        *(f32x4*)(p.out + OFF_SWK + dofs) = *(const f32x4*)(p.cwk + so); *(f32x4*)(p.out + OFF_SWK + SZ_SWIN + dofs) = *(const f32x4*)(p.cwv + so); }
}
__device__ __forceinline__ void ph_late_weights(const Params& p, LAS unsigned char* lds, int gw, int ngw, int tid, int it0 = 0, int it1 = 1 << 30) {
    const int lane = tid & 63, wave = tid >> 6;
    LAS float* scr = (LAS float*)(lds + wave * 16384);
    constexpr int I_BR = 16 * 64, I_O = 32 * 64, I_UP = 32 * 256, I_DN = 128 * 64, TOTAL = 2 * I_BR + I_O + I_UP + I_DN;
    struct Desc { const float* W; const float* ks; bf16_t* WT; int ldw, K, r, nblk; };
    auto desc = [&](int it) { Desc d; int r = it;
        if (r < I_BR) { d = Desc{p.w_br_a, nullptr, p.WBRA_T, DM, 1024, r, 64}; return d; } r -= I_BR;
        if (r < I_BR) { d = Desc{p.w_br_b, nullptr, p.WBRB_T, DM, 1024, r, 64}; return d; } r -= I_BR;
        if (r < I_O) { d = Desc{p.w_o, nullptr, p.WO_T, DM, DM, r, 64}; return d; } r -= I_O;
        if (r < I_UP) { d = Desc{p.w_up, p.norm2_g, p.WUP_T, DFF, DM, r, 256}; return d; } r -= I_UP;
        d = Desc{p.w_down, nullptr, p.WDN_T, DM, DFF, r, 64}; return d; };
    const int iend = it1 < TOTAL ? it1 : TOTAL;
    if (it0 + gw < iend) { Desc dc = desc(it0 + gw); TrRegs cur = transpose_load(dc.W, dc.ldw, dc.ks, dc.r, dc.nblk, CM_id{}, lane);
        for (int it = it0 + gw; it < iend; it += ngw) { const int nx = it + ngw; Desc dn = dc; TrRegs nxt = cur;
            if (nx < iend) { dn = desc(nx); nxt = transpose_load(dn.W, dn.ldw, dn.ks, dn.r, dn.nblk, CM_id{}, lane); }
            transpose_store(cur, dc.WT, dc.K, dc.r, dc.nblk, scr, lane); cur = nxt; dc = dn; } }
}
__device__ __forceinline__ void ph_final_norm(const Params& p, int bid, int G, int tid, int rbeg = 0) {
    const int lane = tid & 63, wave = tid >> 6, gw = rbeg + bid * 8 + wave, NGW = G * 8;
    const bf16_t* YB = (const bf16_t*)p.X1;
    for (int row = gw; row < NTOK; row += NGW) {
        float* yr = row < NPT ? p.out + OFF_Y + (size_t)row * DM : p.out + OFF_YS + (size_t)(row - NPT) * DM;
        const float r = rsqrtf(p.SUMSQ3[row] * (1.f / DM) + EPS);
        const v4u* s8 = (const v4u*)(YB + (size_t)row * DM) + lane; f32x4* y4 = (f32x4*)yr + 2 * lane; const f32x4* g4 = (const f32x4*)p.norm_f + 2 * lane;
        v4u t[4];
#pragma unroll
        for (int j = 0; j < 4; ++j) t[j] = s8[64 * j];
#pragma unroll
        for (int j = 0; j < 4; ++j) { y4[128 * j] = bf4lo(t[j]) * r * g4[128 * j]; y4[128 * j + 1] = bf4hi(t[j]) * r * g4[128 * j + 1]; }
    }
}

__device__ __forceinline__ unsigned pk2t(float lo, float hi) { return pk2(lo, hi); }
template <bool IS_S>
__device__ __forceinline__ void cmp_gemm_tile(const Params& p, LAS unsigned char* lds, int tile, int tid) {
    const int lane = tid & 63, wave = __builtin_amdgcn_readfirstlane(tid >> 6), wm = wave >> 2, wn = wave & 3, fr = lane & 15, fg = lane >> 4;
    int kv, b, ct = 0, g = 0;
    if (IS_S) { ct = tile % 33; b = (tile / 33) & 7; kv = tile / 264; } else { g = tile & 3; b = (tile >> 2) & 3; kv = tile >> 4; }
    const int c0 = IS_S ? 31 * ct : 0;
    const bf16_t* W = p.W1T + (size_t)kv * 256 * 1024;
    const float* abasef = kv ? p.ccv : p.cck; const bf16_t* abaseb = p.KV6;
    unsigned aof[4];
#pragma unroll
    for (int q = 0; q < 4; ++q) { const int i = q * 32 + (tid >> 4), d4 = (tid & 15) * 4;
        if (IS_S) { const int cl = i >> 2, gg = i & 3, c = c0 + cl; const int page = p.page_table[b * NPAGES + (c >> 3)];
            aof[q] = (unsigned)((((size_t)page * PAGE + (c & 7) * 16) * 4 + gg) * 64 + d4); }
        else aof[q] = (unsigned)(((size_t)(b * SEQ + 16 * i)) * 1536 + kv * 256 + g * 64 + d4); }
    const unsigned bof = (unsigned)((tid >> 3) * 1024 + (tid & 7) * 8);
    f32x4 ra0[4], ra1[4], ra2[4]; v2u rab0[4], rab1[4], rab2[4]; v4u rb0[4];
#define CMP_LOADA(S, r) do { _Pragma("unroll") for (int q = 0; q < 4; ++q) { if (IS_S) ra##S[q] = __builtin_nontemporal_load((const f32x4*)(abasef + aof[q] + (unsigned)(r) * 256u)); else rab##S[q] = *(const v2u*)(abaseb + aof[q] + (unsigned)(r) * 1536u); } } while (0)
#define CMP_LOADB(T, r) do { _Pragma("unroll") for (int q = 0; q < 4; ++q) rb##T[q] = *(const v4u*)(W + bof + (unsigned)(q * 64 * 1024 + (r) * 64)); } while (0)
#define CMP_WRITE(S, T, s) do { LAS unsigned char* ab_ = lds + (s) * 55296; LAS unsigned char* bb_ = ab_ + 18432; \
        _Pragma("unroll") for (int q = 0; q < 4; ++q) { const int i_ = q * 32 + (tid >> 4), d4_ = (tid & 15) * 4; v2u w_; \
            if (IS_S) { w_.x = pk2(ra##S[q][0], ra##S[q][1]); w_.y = pk2(ra##S[q][2], ra##S[q][3]); } else w_ = rab##S[q]; \
            *(LAS v2u*)(ab_ + i_ * 144 + d4_ * 2) = w_; *(LAS v4u*)(bb_ + (q * 64 + (tid >> 3)) * 144 + (tid & 7) * 16) = rb##T[q]; } } while (0)
#define CMP_COMPUTE(s) do { const LAS unsigned char* ab_ = lds + (s) * 55296; const LAS unsigned char* bb_ = ab_ + 18432; \
        _Pragma("unroll") for (int ks = 0; ks < 2; ++ks) { bf16x8_t bfr[4]; \
            _Pragma("unroll") for (int ni = 0; ni < 4; ++ni) bfr[ni] = *(const LAS bf16x8_t*)(bb_ + (64 * wn + 16 * ni + fr) * 144 + (32 * ks + 8 * fg) * 2); \
            _Pragma("unroll") for (int mi = 0; mi < 4; ++mi) { const bf16x8_t af = *(const LAS bf16x8_t*)(ab_ + (64 * wm + 16 * mi + fr) * 144 + (32 * ks + 8 * fg) * 2); \
                _Pragma("unroll") for (int ni = 0; ni < 4; ++ni) acc[mi][ni] = __builtin_amdgcn_mfma_f32_16x16x32_bf16(bfr[ni], af, acc[mi][ni], 0, 0, 0); } } } while (0)
#define CMP_STEP(r, AF, AW, BC, BW) do { if ((r) < 16) { if ((r) + 3 < 16) CMP_LOADA(AF, (r) + 3); if ((r) + 1 < 16) CMP_LOADB(0, (r) + 1); CMP_COMPUTE(BC); if ((r) + 1 < 16) CMP_WRITE(AW, 0, BW); LDS_BARRIER(); } } while (0)
    f32x4 acc[4][4];
#pragma unroll
    for (int mi = 0; mi < 4; ++mi)
#pragma unroll
        for (int ni = 0; ni < 4; ++ni) acc[mi][ni] = (f32x4){0.f, 0.f, 0.f, 0.f};
    CMP_LOADA(0, 0); CMP_LOADB(0, 0); CMP_LOADA(1, 1); CMP_LOADA(2, 2); CMP_WRITE(0, 0, 0); LDS_BARRIER();
#pragma unroll 1
    for (int r = 0; r < 16; r += 6) {
        CMP_STEP(r, 0, 1, 0, 1); CMP_STEP(r + 1, 1, 2, 1, 0); CMP_STEP(r + 2, 2, 0, 0, 1);
        CMP_STEP(r + 3, 0, 1, 1, 0); CMP_STEP(r + 4, 1, 2, 0, 1); CMP_STEP(r + 5, 2, 0, 1, 0);
    }
#undef CMP_LOADA
#undef CMP_LOADB
#undef CMP_STEP
#undef CMP_WRITE
#undef CMP_COMPUTE
    if (!IS_S) {
        float* AB = p.AB_P + (size_t)kv * 2048 * 256;
#pragma unroll
        for (int mi = 0; mi < 4; ++mi) { const int i = 64 * wm + 16 * mi + fr; const size_t R = (size_t)(b * 4 + g) * 128 + i;
#pragma unroll
            for (int ni = 0; ni < 4; ++ni) *(f32x4*)(AB + R * 256 + 64 * wn + 16 * ni + 4 * fg) = acc[mi][ni]; }
    } else {
        LAS float* BH = (LAS float*)lds;
        LAS unsigned char* H = lds + 67584; LAS unsigned char* W2T = lds + 67584 + 34816;
        const float* bias = p.BIAS1 + kv * 128;
        if (wn >= 2) {
#pragma unroll
            for (int mi = 0; mi < 4; ++mi) { const int i = 64 * wm + 16 * mi + fr;
#pragma unroll
                for (int ni = 0; ni < 4; ++ni) *(LAS f32x4*)(BH + i * 132 + 64 * (wn - 2) + 16 * ni + 4 * fg) = acc[mi][ni]; } }
#pragma unroll
        for (int k = 0; k < 2; ++k) { const int idx8 = tid * 8 + 4096 * k, d = idx8 >> 7, j = idx8 & 127; *(LAS v4u*)(W2T + d * 272 + j * 2) = *(const v4u*)(p.W2TG + kv * 8192 + idx8); }
        __syncthreads();
        if (wn < 2) {
#pragma unroll
            for (int mi = 0; mi < 4; ++mi) { const int i = 64 * wm + 16 * mi + fr;
#pragma unroll
                for (int ni = 0; ni < 4; ++ni) { const int j = 64 * wn + 16 * ni + 4 * fg; v2u w; w.x = 0u; w.y = 0u;
                    if (i < 124) { const f32x4 bq = *(const LAS f32x4*)(BH + (i + 4) * 132 + j), bi = *(const f32x4*)(bias + j); const f32x4 hv = acc[mi][ni] + bq + bi;
                        w.x = pk2(gelu_fast(hv[0]), gelu_fast(hv[1])); w.y = pk2(gelu_fast(hv[2]), gelu_fast(hv[3])); }
                    *(LAS v2u*)(H + i * 272 + j * 2) = w; } } }
        __syncthreads();
        f32x4 a2[4];
#pragma unroll
        for (int ni = 0; ni < 4; ++ni) a2[ni] = (f32x4){0.f, 0.f, 0.f, 0.f};
#pragma unroll
        for (int ks = 0; ks < 4; ++ks) { const bf16x8_t hb = *(const LAS bf16x8_t*)(H + (16 * wave + fr) * 272 + (32 * ks + 8 * fg) * 2);
#pragma unroll
            for (int ni = 0; ni < 4; ++ni) { const bf16x8_t wa = *(const LAS bf16x8_t*)(W2T + (16 * ni + fr) * 272 + (32 * ks + 8 * fg) * 2);
                a2[ni] = __builtin_amdgcn_mfma_f32_16x16x32_bf16(wa, hb, a2[ni], 0, 0, 0); } }
        { const int i = 16 * wave + fr, cl = i >> 2, gg = i & 3;
          if (cl < 31 || ct == 32) { bf16_t* dst = (kv ? p.VCMP_S : p.KCMP_S) + ((size_t)(b * 4 + gg) * 1024 + c0 + cl) * 64;
#pragma unroll
              for (int ni = 0; ni < 4; ++ni) { v2u w; w.x = pk2(a2[ni][0], a2[ni][1]); w.y = pk2(a2[ni][2], a2[ni][3]); *(v2u*)(dst + 16 * ni + 4 * fg) = w; } } }
        __syncthreads();
    }
}
template <bool IS_S>
__device__ __forceinline__ void cmp_part2(const Params& p, LAS unsigned char* lds, int kv, int bg, int i0, int tid) {
    constexpr int n_cmp = IS_S ? 1023 : 127, nrs = IS_S ? 1024 : 128;
    const int lane = tid & 63, wave = __builtin_amdgcn_readfirstlane(tid >> 6), fr = lane & 15, fg = lane >> 4;
    const float* AB = (IS_S ? p.AB_S + (size_t)kv * 32768 * 256 : p.AB_P + (size_t)kv * 2048 * 256) + (size_t)bg * nrs * 256;
    LAS unsigned char* H = lds; LAS unsigned char* W2T = lds + 128 * 272;
    const float* w2 = kv ? p.w2v : p.w2k; const float* bias = p.BIAS1 + kv * 128;
    for (int idx = tid; idx < 128 * 32; idx += 512) { const int row = idx >> 5, j4 = (idx & 31) * 4, i = i0 + row; v2u w; w.x = 0u; w.y = 0u;
        if (i < n_cmp) { const f32x4 a = *(const f32x4*)(AB + (size_t)i * 256 + j4), bq = *(const f32x4*)(AB + (size_t)(i + 1) * 256 + 128 + j4), bi = *(const f32x4*)(bias + j4);
            const f32x4 h = a + bq + bi; w.x = pk2(gelu_fast(h[0]), gelu_fast(h[1])); w.y = pk2(gelu_fast(h[2]), gelu_fast(h[3])); }
        *(LAS v2u*)(H + row * 272 + j4 * 2) = w; }
    for (int idx = tid; idx < 8192; idx += 512) { const int j = idx >> 6, d = idx & 63; *(LAS bf16_t*)(W2T + d * 272 + j * 2) = f2bf(w2[idx]); }
    __syncthreads();
    f32x4 acc[4];
#pragma unroll
    for (int ni = 0; ni < 4; ++ni) acc[ni] = (f32x4){0.f, 0.f, 0.f, 0.f};
#pragma unroll
    for (int ks = 0; ks < 4; ++ks) { const bf16x8_t hb = *(const LAS bf16x8_t*)(H + (16 * wave + fr) * 272 + (32 * ks + 8 * fg) * 2);
#pragma unroll
        for (int ni = 0; ni < 4; ++ni) { const bf16x8_t wa = *(const LAS bf16x8_t*)(W2T + (16 * ni + fr) * 272 + (32 * ks + 8 * fg) * 2);
            acc[ni] = __builtin_amdgcn_mfma_f32_16x16x32_bf16(wa, hb, acc[ni], 0, 0, 0); } }
    const int i = i0 + 16 * wave + fr;
    if (i < nrs) {
#pragma unroll
        for (int ni = 0; ni < 4; ++ni) { const int d = 16 * ni + 4 * fg;
            if (IS_S) { v2u w; w.x = pk2(acc[ni][0], acc[ni][1]); w.y = pk2(acc[ni][2], acc[ni][3]); *(v2u*)((kv ? p.VCMP_S : p.KCMP_S) + ((size_t)bg * 1024 + i) * 64 + d) = w; }
            else if (kv == 0) { v2u w; w.x = pk2(acc[ni][0], acc[ni][1]); w.y = pk2(acc[ni][2], acc[ni][3]); *(v2u*)(p.KCMP_P + ((size_t)bg * 128 + i) * 64 + d) = w; }
            else {
#pragma unroll
                for (int r = 0; r < 4; ++r) p.VCMPT_P[((size_t)bg * 64 + d + r) * 128 + i] = f2bf(acc[ni][r]); } } }
    __syncthreads();
}
__device__ __forceinline__ void ph_pro0(const Params& p, LAS unsigned char* lds, int bid, int G, int tid) {
    const int lane = tid & 63, wave = tid >> 6, gw = bid * 8 + wave, NGW = G * 8;
    LAS float* scr = (LAS float*)(lds + wave * 16384);
    for (int it = gw; it < 4 * 64; it += NGW) { const int q = it >> 6, r = it & 63, kv = q >> 1, half = q & 1;
        transpose_item((kv ? p.w1v : p.w1k) + (size_t)half * 1024 * 128, 128, nullptr, p.W1T + ((size_t)kv * 256 + half * 128) * 1024, 1024, r, 4, CM_id{}, scr, lane); }
    for (int i = bid * 512 + tid; i < NTOK; i += G * 512) { p.SUMSQ2[i] = 0.f; p.SUMSQ3[i] = 0.f; }
    for (int idx = bid * 512 + tid; idx < 2 * 8192; idx += G * 512) { const int kv = idx >> 13, r = idx & 8191, j = r & 127, d = r >> 7; p.W2TG[idx] = f2bf((kv ? p.w2v : p.w2k)[j * 64 + d]); }
    __syncthreads();
    for (int it = bid; it < 4; it += G) { const int kv = it >> 1, jh = it & 1, j = jh * 64 + (tid & 63), ks = tid >> 6;
        const float* pe = kv ? p.pe_v : p.pe_k; const float* w1 = kv ? p.w1v : p.w1k; float s = 0.f;
#pragma unroll 1
        for (int k0 = ks * 256; k0 < ks * 256 + 256; k0 += 32) { float pv[32], wv[32];
#pragma unroll
            for (int u = 0; u < 32; ++u) { pv[u] = pe[k0 + u]; wv[u] = w1[(size_t)(k0 + u) * 128 + j]; }
#pragma unroll
            for (int u = 0; u < 32; ++u) s += pv[u] * wv[u]; }
        LAS float* red = (LAS float*)lds; red[tid] = s; __syncthreads();
        if (tid < 64) { float t = 0.f; for (int w = 0; w < 8; ++w) t += red[w * 64 + tid]; p.BIAS1[kv * 128 + j] = t; }
        __syncthreads(); }
}

constexpr int GL_BC = 0, GL_SEG = 32768, GL_QT = 34816, GL_KT = GL_QT + 64 * 272, GL_AM = GL_KT + 64 * 272, GL_VT = GL_AM + 64 * 144, GL_SSQ = GL_VT + 256 * 144, GL_END = GL_SSQ + 2048;
static_assert(GL_END <= 131072, "gla lds");
struct GateRegs { f32x4 lr[8]; float wv[8]; float ba; };
__device__ __forceinline__ GateRegs gla_gates_issue(const Params& p, int row0, int h, int tid) {
    const int lane = tid & 63, wave = tid >> 6, fr = lane & 15, fg = lane >> 4, d = 16 * wave + fr; GateRegs g;
#pragma unroll
    for (int j = 0; j < 8; ++j) { g.wv[j] = 0.f; g.lr[j] = (f32x4){0.f, 0.f, 0.f, 0.f}; }
    if (fg < 2) {
#pragma unroll
        for (int j = 0; j < 8; ++j) g.wv[j] = p.w_a2[(8 * fg + j) * 512 + h * 128 + d];
#pragma unroll
        for (int cb = 0; cb < 4; ++cb) { const f32x4* lr = (const f32x4*)(p.LR + (size_t)(row0 + 16 * cb + fr) * 16 + 8 * fg); g.lr[2 * cb] = lr[0]; g.lr[2 * cb + 1] = lr[1]; } }
    g.ba = p.b_a[h * 128 + d];
    return g;
}
__device__ __forceinline__ void gla_gates(const GateRegs& gr, LAS unsigned char* lds, int tid) {
    LAS float* BC = (LAS float*)(lds + GL_BC);
    const int lane = tid & 63, wave = tid >> 6, fr = lane & 15, fg = lane >> 4, d = 16 * wave + fr;
    const bf16x8_t wb = __builtin_bit_cast(bf16x8_t, pk8((f32x4){gr.wv[0], gr.wv[1], gr.wv[2], gr.wv[3]}, (f32x4){gr.wv[4], gr.wv[5], gr.wv[6], gr.wv[7]}));
    const float ba = gr.ba;
    float run = 0.f;
#pragma unroll
    for (int cb = 0; cb < 4; ++cb) { const bf16x8_t la = __builtin_bit_cast(bf16x8_t, pk8(gr.lr[2 * cb], gr.lr[2 * cb + 1]));
        f32x4 x = __builtin_amdgcn_mfma_f32_16x16x32_bf16(la, wb, (f32x4){0.f, 0.f, 0.f, 0.f}, 0, 0, 0);
        float g4[4];
#pragma unroll
        for (int r = 0; r < 4; ++r) { const float xv = x[r] + ba; g4[r] = (fminf(xv, 0.f) - __logf(1.f + __expf(-fabsf(xv)))) * (1.f / 16.f); }
        g4[1] += g4[0]; g4[2] += g4[1]; g4[3] += g4[2];
        const float t0 = __shfl(g4[3], fr), t1 = __shfl(g4[3], fr + 16), t2 = __shfl(g4[3], fr + 32), t3 = __shfl(g4[3], fr + 48);
        const float off = run + (fg > 0 ? t0 : 0.f) + (fg > 1 ? t1 : 0.f) + (fg > 2 ? t2 : 0.f);
#pragma unroll
        for (int r = 0; r < 4; ++r) BC[(16 * cb + 4 * fg + r) * 128 + d] = off + g4[r];
        run += (t0 + t1) + (t2 + t3); }
    LDS_BARRIER();
}
struct GlaVRegs { v4u v[4]; };
__device__ __forceinline__ GlaVRegs gla_vt_issue(const Params& p, int row0, int h, int tid) {
    const int c = tid & 63, e0 = (tid >> 6) * 32; const bf16_t* src = p.GV + (size_t)(row0 + c) * 1024 + h * 256 + e0; GlaVRegs r;
#pragma unroll
    for (int q = 0; q < 4; ++q) r.v[q] = *(const v4u*)(src + 8 * q);
    return r;
}
__device__ __forceinline__ void gla_vt_commit(const GlaVRegs& r, LAS unsigned char* lds, int tid) {
    LAS bf16_t* VT = (LAS bf16_t*)(lds + GL_VT); const int c = tid & 63, e0 = (tid >> 6) * 32;
#pragma unroll
    for (int q = 0; q < 4; ++q) { const unsigned wv[4] = {r.v[q].x, r.v[q].y, r.v[q].z, r.v[q].w};
#pragma unroll
        for (int i = 0; i < 8; ++i) VT[(e0 + 8 * q + i) * 72 + c] = (bf16_t)((wv[i >> 1] >> ((i & 1) * 16)) & 0xffff); }
}
struct GlaAIn { GateRegs g; GlaVRegs v; v4u k[2]; };
__device__ __forceinline__ GlaAIn gla_a_issue(const Params& p, int item, int tid) {
    const int bh = item >> 5, n = item & 31, b = bh >> 2, h = bh & 3, row0 = b * SEQ + n * 64; GlaAIn in;
    in.g = gla_gates_issue(p, row0, h, tid); in.v = gla_vt_issue(p, row0, h, tid);
    { const int c = tid & 63, d0 = (tid >> 6) * 16;
#pragma unroll
      for (int q = 0; q < 2; ++q) in.k[q] = *(const v4u*)(p.GK + (size_t)(row0 + c) * 512 + h * 128 + d0 + 8 * q); }
    return in;
}
__device__ __forceinline__ void gla_pass_a(const Params& p, LAS unsigned char* lds, int item, int tid, const GlaAIn& in) {
    const int bh = item >> 5, n = item & 31, b = bh >> 2, h = bh & 3, row0 = b * SEQ + n * 64;
    const int lane = tid & 63, wave = __builtin_amdgcn_readfirstlane(tid >> 6), fr = lane & 15, fg = lane >> 4;
    SSTAMP(80);
    const GlaVRegs& vr = in.v; const v4u (&kreg)[2] = in.k;
    gla_gates(in.g, lds, tid); SSTAMP(81);
    { const LAS f32x4* bs = (const LAS f32x4*)(lds + GL_BC); f32x4* bg = (f32x4*)(p.BCG + (size_t)item * 8192);
#pragma unroll
      for (int k = 0; k < 4; ++k) bg[tid + 512 * k] = bs[tid + 512 * k]; }
    const LAS float* BC = (const LAS float*)(lds + GL_BC);
    LAS bf16_t* KST = (LAS bf16_t*)(lds + GL_QT);
    gla_vt_commit(vr, lds, tid);
    { const int c = tid & 63, d0 = (tid >> 6) * 16;
#pragma unroll
      for (int q = 0; q < 2; ++q) { const v4u kk = kreg[q];
          const unsigned wv[4] = {kk.x, kk.y, kk.z, kk.w};
#pragma unroll
          for (int i = 0; i < 8; ++i) { const int d = d0 + 8 * q + i; const float kx = bf2f((bf16_t)((wv[i >> 1] >> ((i & 1) * 16)) & 0xffff));
              KST[d * 72 + c] = f2bf(kx * __expf(BC[63 * 128 + d] - BC[c * 128 + d])); } } }
    if (tid < 128) p.DEC[((size_t)bh * 32 + n) * 128 + tid] = __expf(BC[63 * 128 + tid]);
    LDS_BARRIER(); SSTAMP(82);
    const LAS unsigned char* VTb = lds + GL_VT; const LAS unsigned char* KSb = lds + GL_QT;
    f32x4 acc[8][2];
#pragma unroll
    for (int mb = 0; mb < 8; ++mb) { acc[mb][0] = (f32x4){0.f, 0.f, 0.f, 0.f}; acc[mb][1] = (f32x4){0.f, 0.f, 0.f, 0.f}; }
#pragma unroll
    for (int ks = 0; ks < 2; ++ks) { bf16x8_t vb[2];
#pragma unroll
        for (int nb = 0; nb < 2; ++nb) vb[nb] = *(const LAS bf16x8_t*)(VTb + (32 * wave + 16 * nb + fr) * 144 + (32 * ks + 8 * fg) * 2);
#pragma unroll
        for (int mb = 0; mb < 8; ++mb) { const bf16x8_t ka = *(const LAS bf16x8_t*)(KSb + (16 * mb + fr) * 144 + (32 * ks + 8 * fg) * 2);
            acc[mb][0] = __builtin_amdgcn_mfma_f32_16x16x32_bf16(ka, vb[0], acc[mb][0], 0, 0, 0); acc[mb][1] = __builtin_amdgcn_mfma_f32_16x16x32_bf16(ka, vb[1], acc[mb][1], 0, 0, 0); } }
    SSTAMP(83);
    bf16_t* U = (bf16_t*)p.UT + ((size_t)bh * 32 + n) * 256 * 128;
#pragma unroll
    for (int nb = 0; nb < 2; ++nb) { const int e = 32 * wave + 16 * nb + fr;
#pragma unroll
        for (int mb = 0; mb < 8; ++mb) { v2u w; w.x = pk2(acc[mb][nb][0], acc[mb][nb][1]); w.y = pk2(acc[mb][nb][2], acc[mb][nb][3]); *(v2u*)(U + (size_t)e * 128 + 16 * mb + 4 * fg) = w; } }
    LDS_BARRIER(); SSTAMP(84);
}
__device__ __forceinline__ void gla_pass_b(const Params& p, int bid, int G, int tid) {
    for (int idx = bid * 512 + tid; idx < 16 * 256 * 16; idx += G * 512) { const int d8 = (idx & 15) * 8, e = (idx >> 4) & 255, bh = idx >> 12;
        f32x4 S0 = {0.f, 0.f, 0.f, 0.f}, S1 = {0.f, 0.f, 0.f, 0.f};
        const bf16_t* U = (const bf16_t*)p.UT + (size_t)bh * 32 * 256 * 128 + (size_t)e * 128 + d8; const float* D = p.DEC + (size_t)bh * 32 * 128 + d8;
        bf16_t* SN = p.SNT + (size_t)bh * 32 * 256 * 128 + (size_t)e * 128 + d8;
#pragma unroll 8
        for (int n = 0; n < 32; ++n) { const v4u ub = *(const v4u*)(U + (size_t)n * 256 * 128); const f32x4 d0 = *(const f32x4*)(D + n * 128), d1 = *(const f32x4*)(D + n * 128 + 4);
            *(v4u*)(SN + (size_t)n * 256 * 128) = pk8(S0, S1);
            S0 = d0 * S0 + bf4lo(ub); S1 = d1 * S1 + bf4hi(ub); }
        float* so = p.out + OFF_PGLA + ((size_t)bh * 128 + d8) * 256 + e;
#pragma unroll
        for (int i = 0; i < 4; ++i) { so[(size_t)i * 256] = S0[i]; so[(size_t)(4 + i) * 256] = S1[i]; } }
}
__device__ __forceinline__ void gla_pass_c(const Params& p, LAS unsigned char* lds, int item, int tid) {
    const int bh = item >> 5, n = item & 31, b = bh >> 2, h = bh & 3, row0 = b * SEQ + n * 64;
    const int lane = tid & 63, wave = __builtin_amdgcn_readfirstlane(tid >> 6), fr = lane & 15, fg = lane >> 4;
    bf16x8_t sa[4][2];
    { const bf16_t* SN = p.SNT + ((size_t)bh * 32 + n) * 256 * 128;
#pragma unroll
      for (int ks = 0; ks < 4; ++ks)
#pragma unroll
          for (int eb = 0; eb < 2; ++eb) sa[ks][eb] = *(const bf16x8_t*)(SN + (size_t)(32 * wave + 16 * eb + fr) * 128 + 32 * ks + 8 * fg); }
    const GlaVRegs vr = gla_vt_issue(p, row0, h, tid);
    v4u qreg[2], kreg[2];
    { const int d8 = (tid & 15) * 8;
#pragma unroll
      for (int q = 0; q < 2; ++q) { const int c = (tid >> 4) + 32 * q; qreg[q] = *(const v4u*)(p.GQ + (size_t)(row0 + c) * 512 + h * 128 + d8); kreg[q] = *(const v4u*)(p.GK + (size_t)(row0 + c) * 512 + h * 128 + d8); } }
    { LAS f32x4* bs = (LAS f32x4*)(lds + GL_BC); const f32x4* bg = (const f32x4*)(p.BCG + (size_t)item * 8192);
      f32x4 t4[4];
#pragma unroll
      for (int k = 0; k < 4; ++k) t4[k] = bg[tid + 512 * k];
#pragma unroll
      for (int k = 0; k < 4; ++k) bs[tid + 512 * k] = t4[k]; }
    LDS_BARRIER();
    const LAS float* BC = (const LAS float*)(lds + GL_BC);
    LAS unsigned char* QTb = lds + GL_QT; LAS unsigned char* KTb = lds + GL_KT; LAS unsigned char* AMb = lds + GL_AM; const LAS unsigned char* VTb = lds + GL_VT;
    gla_vt_commit(vr, lds, tid);
    { const int d8 = (tid & 15) * 8;
#pragma unroll
      for (int q = 0; q < 2; ++q) { const int c = (tid >> 4) + 32 * q; const v4u qq = qreg[q], kk = kreg[q];
          const unsigned qv[4] = {qq.x, qq.y, qq.z, qq.w}, kw[4] = {kk.x, kk.y, kk.z, kk.w}; unsigned qo[4], ko[4];
#pragma unroll
          for (int i = 0; i < 4; ++i) { const float b0 = BC[c * 128 + d8 + 2 * i], b1 = BC[c * 128 + d8 + 2 * i + 1]; const float e0 = __expf(b0), e1 = __expf(b1), i0 = __expf(-b0), i1 = __expf(-b1);
              qo[i] = pk2(bf2f((bf16_t)(qv[i] & 0xffff)) * e0, bf2f((bf16_t)(qv[i] >> 16)) * e1);
              ko[i] = pk2(bf2f((bf16_t)(kw[i] & 0xffff)) * i0, bf2f((bf16_t)(kw[i] >> 16)) * i1); }
          *(LAS v4u*)(QTb + c * 272 + d8 * 2) = (v4u){qo[0], qo[1], qo[2], qo[3]}; *(LAS v4u*)(KTb + c * 272 + d8 * 2) = (v4u){ko[0], ko[1], ko[2], ko[3]}; } }
    LDS_BARRIER();
    { const int sb = wave >> 1;
#pragma unroll
      for (int u = 0; u < 2; ++u) { const int cb = 2 * (wave & 1) + u; f32x4 a = {0.f, 0.f, 0.f, 0.f};
          if (sb <= cb) {
#pragma unroll
              for (int ks = 0; ks < 4; ++ks) { const bf16x8_t ka = *(const LAS bf16x8_t*)(KTb + (16 * sb + fr) * 272 + (32 * ks + 8 * fg) * 2); const bf16x8_t qb = *(const LAS bf16x8_t*)(QTb + (16 * cb + fr) * 272 + (32 * ks + 8 * fg) * 2);
                  a = __builtin_amdgcn_mfma_f32_16x16x32_bf16(ka, qb, a, 0, 0, 0); } }
          const int c = 16 * cb + fr, s0 = 16 * sb + 4 * fg;
          v2u w; w.x = pk2(s0 <= c ? a[0] : 0.f, s0 + 1 <= c ? a[1] : 0.f); w.y = pk2(s0 + 2 <= c ? a[2] : 0.f, s0 + 3 <= c ? a[3] : 0.f);
          *(LAS v2u*)(AMb + c * 144 + s0 * 2) = w; } }
    LDS_BARRIER();
    f32x4 acc[2][4];
#pragma unroll
    for (int eb = 0; eb < 2; ++eb)
#pragma unroll
        for (int cb = 0; cb < 4; ++cb) acc[eb][cb] = (f32x4){0.f, 0.f, 0.f, 0.f};
#pragma unroll
    for (int ks = 0; ks < 4; ++ks) { bf16x8_t qb[4];
#pragma unroll
        for (int cb = 0; cb < 4; ++cb) qb[cb] = *(const LAS bf16x8_t*)(QTb + (16 * cb + fr) * 272 + (32 * ks + 8 * fg) * 2);
#pragma unroll
        for (int eb = 0; eb < 2; ++eb)
#pragma unroll
            for (int cb = 0; cb < 4; ++cb) acc[eb][cb] = __builtin_amdgcn_mfma_f32_16x16x32_bf16(sa[ks][eb], qb[cb], acc[eb][cb], 0, 0, 0); }
#pragma unroll
    for (int ks = 0; ks < 2; ++ks) { bf16x8_t va[2], ab[4];
#pragma unroll
        for (int eb = 0; eb < 2; ++eb) va[eb] = *(const LAS bf16x8_t*)(VTb + (32 * wave + 16 * eb + fr) * 144 + (32 * ks + 8 * fg) * 2);
#pragma unroll
        for (int cb = 0; cb < 4; ++cb) ab[cb] = *(const LAS bf16x8_t*)(AMb + (16 * cb + fr) * 144 + (32 * ks + 8 * fg) * 2);
#pragma unroll
        for (int eb = 0; eb < 2; ++eb)
#pragma unroll
            for (int cb = 0; cb < 4; ++cb) acc[eb][cb] = __builtin_amdgcn_mfma_f32_16x16x32_bf16(va[eb], ab[cb], acc[eb][cb], 0, 0, 0); }
    LAS float* SSQ = (LAS float*)(lds + GL_SSQ);
#pragma unroll
    for (int cb = 0; cb < 4; ++cb) { float s = 0.f;
#pragma unroll
        for (int eb = 0; eb < 2; ++eb) s += (acc[eb][cb][0] * acc[eb][cb][0] + acc[eb][cb][1] * acc[eb][cb][1]) + (acc[eb][cb][2] * acc[eb][cb][2] + acc[eb][cb][3] * acc[eb][cb][3]);
        s += __shfl_xor(s, 16); s += __shfl_xor(s, 32);
        if (fg == 0) SSQ[wave * 64 + 16 * cb + fr] = s; }
    LDS_BARRIER();
#pragma unroll
    for (int cb = 0; cb < 4; ++cb) { const int c = 16 * cb + fr; float s = 0.f;
#pragma unroll
        for (int w = 0; w < 8; ++w) s += SSQ[w * 64 + c];
        const float rs = rsqrtf(s * (1.f / 256.f) + EPS);
#pragma unroll
        for (int eb = 0; eb < 2; ++eb) { const int e = 32 * wave + 16 * eb + 4 * fg; const f32x4 gn = *(const f32x4*)(p.gnorm + e);
            const v2u rr = *(const v2u*)(p.GR + (size_t)(row0 + c) * 1024 + h * 256 + e);
            const float o0 = acc[eb][cb][0] * rs * gn[0] * bf2f((bf16_t)(rr.x & 0xffff)), o1 = acc[eb][cb][1] * rs * gn[1] * bf2f((bf16_t)(rr.x >> 16));
            const float o2 = acc[eb][cb][2] * rs * gn[2] * bf2f((bf16_t)(rr.y & 0xffff)), o3 = acc[eb][cb][3] * rs * gn[3] * bf2f((bf16_t)(rr.y >> 16));
            v2u w; w.x = pk2(o0, o1); w.y = pk2(o2, o3); *(v2u*)(p.OB + (size_t)(row0 + c) * 1024 + h * 256 + e) = w; } }
    LDS_BARRIER();
}
__device__ __forceinline__ void gla_sample_item(const Params& p, LAS unsigned char* lds, int item, int tid) {
    const int b = item >> 2, h = item & 3, e = tid & 255, half = tid >> 8, row = NPT + b;
    LAS float* a_s = (LAS float*)lds; LAS float* q_s = a_s + 128; LAS float* k_s = q_s + 128; LAS float* part = k_s + 128; LAS float* red = part + 512;
    if (tid < 128) { float x = p.b_a[h * 128 + tid];
        for (int r = 0; r < 16; ++r) x += p.LR[(size_t)row * 16 + r] * p.w_a2[r * 512 + h * 128 + tid];
        a_s[tid] = __expf(logsigmoidf_(x) * (1.f / 16.f)); q_s[tid] = bf2f(p.GQ[(size_t)row * 512 + h * 128 + tid]); k_s[tid] = bf2f(p.GK[(size_t)row * 512 + h * 128 + tid]); }
    const float v = bf2f(p.GV[(size_t)row * 1024 + h * 256 + e]);
    __syncthreads();
    float po = 0.f; const float* s0 = p.state + (((size_t)b * 4 + h) * 128 + half * 64) * 256 + e; float* so = p.out + OFF_SGLA + (((size_t)b * 4 + h) * 128 + half * 64) * 256 + e;
#pragma unroll 1
    for (int d0 = 0; d0 < 64; d0 += 32) { float sv[32];
#pragma unroll
        for (int dd = 0; dd < 32; ++dd) sv[dd] = s0[(size_t)(d0 + dd) * 256];
#pragma unroll
        for (int dd = 0; dd < 32; ++dd) { const int d = half * 64 + d0 + dd; const float s = a_s[d] * sv[dd] + k_s[d] * v; so[(size_t)(d0 + dd) * 256] = s; po += q_s[d] * s; } }
    part[half * 256 + e] = po;
    __syncthreads();
    float o = 0.f;
    if (tid < 256) { o = part[e] + part[256 + e]; const float ss = wave_sum(o * o); if ((tid & 63) == 0) red[tid >> 6] = ss; }
    __syncthreads();
    if (tid < 256) { const float ss = (red[0] + red[1]) + (red[2] + red[3]); const float r = rsqrtf(ss * (1.f / 256.f) + EPS);
        p.OB[(size_t)row * 1024 + h * 256 + e] = f2bf(o * r * p.gnorm[e] * bf2f(p.GR[(size_t)row * 1024 + h * 256 + e])); }
    __syncthreads();
}

typedef float f32x16 __attribute__((ext_vector_type(16)));
constexpr int NS_STAGE = 17920, NS_KOFF = 0, NS_VOFF = 9216, NS_PCS = 35840, NS_SC = NS_PCS + 32768, NS_OUT = NS_PCS  , NS_SEL = NS_OUT + 256 * 272, NS_END = NS_SEL + 256;
static_assert(NS_END <= 131072, "nsa lds");
constexpr float LOG2E = 1.4426950408889634f, NEGBIG = -1e30f;
__device__ __forceinline__ int crow(int r, int hh) { return (r & 3) + 8 * (r >> 2) + 4 * hh; }

__device__ __forceinline__ void nsa_vt_tile(const Params& p, LAS unsigned char* scr  , int item, int lane) {
    const int tt = item & 31, bg = (item >> 5) & 15, which = item >> 9, b = bg >> 2, g = bg & 3;
    const bf16_t* src = p.KV6 + (size_t)(b * SEQ + tt * 64) * 1536 + (which ? 5 : 3) * 256 + g * 64;
    LAS bf16_t* TT = (LAS bf16_t*)scr;
    const int ch = lane & 7, r0 = lane >> 3;
#pragma unroll
    for (int q = 0; q < 8; ++q) { const v4u v = *(const v4u*)(src + (size_t)lane * 1536 + q * 8); const unsigned wv[4] = {v.x, v.y, v.z, v.w};
#pragma unroll
        for (int i = 0; i < 8; ++i) TT[(q * 8 + i) * 72 + lane] = (bf16_t)((wv[i >> 1] >> ((i & 1) * 16)) & 0xffff); }
    LDS_WAIT(); asm volatile("" ::: "memory");
    bf16_t* dst = (which ? p.VTW : p.VTS) + (size_t)bg * 64 * SEQ + tt * 64;
#pragma unroll
    for (int q = 0; q < 8; ++q) { const int d = r0 + 8 * q; const v4u v = *(const LAS v4u*)((LAS unsigned char*)scr + d * 144 + ch * 16); *(v4u*)(dst + (size_t)d * SEQ + ch * 8) = v; }
    LDS_WAIT(); asm volatile("" ::: "memory");
}

__device__ __forceinline__ float max3f(float a, float b, float c) { float r; asm("v_max3_f32 %0, %1, %2, %3" : "=v"(r) : "v"(a), "v"(b), "v"(c)); return r; }
struct NsaState { float m, l; f32x16 o0, o1; };
template <int MODE  >
__device__ __forceinline__ void nsa_tile(const LAS unsigned char* st, const bf16x8_t (&q)[4], NsaState& s, int lo, int hi, int r32, int hh, LAS float* pcs = nullptr, int kbase = 0) {
    f32x16 s0 = {}, s1 = {};
    const LAS unsigned char* kb = st + NS_KOFF + r32 * 144 + hh * 16;
#pragma unroll
    for (int ks = 0; ks < 4; ++ks) { const bf16x8_t a0 = *(const LAS bf16x8_t*)(kb + ks * 32), a1 = *(const LAS bf16x8_t*)(kb + 32 * 144 + ks * 32);
        s0 = __builtin_amdgcn_mfma_f32_32x32x16_bf16(a0, q[ks], s0, 0, 0, 0); s1 = __builtin_amdgcn_mfma_f32_32x32x16_bf16(a1, q[ks], s1, 0, 0, 0); }
    asm volatile("s_nop 15\n\ts_nop 7" : "+v"(s0), "+v"(s1));
    const bool full = lo <= 0 && hi >= 63, on = hi >= 0;
    const bool nomask = __all(full), laneonly = !nomask && __all(full || !on);
    if (!nomask && !laneonly) {
#pragma unroll
        for (int r = 0; r < 16; ++r) { const int k0 = crow(r, hh), k1 = k0 + 32; s0[r] = (k0 >= lo && k0 <= hi) ? s0[r] : -INFINITY; s1[r] = (k1 >= lo && k1 <= hi) ? s1[r] : -INFINITY; }
    }
    const bool off = laneonly && !on;
    float tmax;
    { float a = max3f(s0[0], s0[1], s1[0]), c = max3f(s0[2], s0[3], s1[1]); a = max3f(a, s1[2], s1[3]);
#pragma unroll
      for (int r = 4; r < 16; r += 4) { a = max3f(a, s0[r], s0[r + 1]); c = max3f(c, s0[r + 2], s0[r + 3]); a = max3f(a, s1[r], s1[r + 1]); c = max3f(c, s1[r + 2], s1[r + 3]); }
      tmax = off ? NEGBIG : max3f(a, c, NEGBIG); }
    if (MODE == 2) {
        const float mL = off ? INFINITY : s.m * LOG2E, inv = s.l;
#pragma unroll
        for (int r = 0; r < 16; ++r) { s0[r] = __builtin_amdgcn_exp2f(s0[r] * LOG2E - mL) * inv; s1[r] = __builtin_amdgcn_exp2f(s1[r] * LOG2E - mL) * inv; }
        if (pcs) {
#pragma unroll
            for (int r = 0; r < 16; ++r) { float v0 = s0[r], v1 = s1[r]; v0 += __shfl_xor(v0, 8); v1 += __shfl_xor(v1, 8); v0 += __shfl_xor(v0, 16); v1 += __shfl_xor(v1, 16);
                pcs[kbase + crow(r, hh)] = v0; pcs[kbase + 32 + crow(r, hh)] = v1; } }
    } else {
        tmax = max3f(tmax, __shfl_xor(tmax, 32), s.m);
        const float mn = tmax, alpha = __builtin_amdgcn_exp2f((s.m - mn) * LOG2E), mL = off ? INFINITY : mn * LOG2E;
        s.m = mn;
        float ps = 0.f;
#pragma unroll
        for (int r = 0; r < 16; ++r) { const float p0 = __builtin_amdgcn_exp2f(s0[r] * LOG2E - mL), p1 = __builtin_amdgcn_exp2f(s1[r] * LOG2E - mL); s0[r] = p0; s1[r] = p1; ps += p0 + p1; }
        s.l = s.l * alpha + ps;
        if (MODE == 1) return;
        if (!__all(alpha == 1.f)) {
#pragma unroll
            for (int r = 0; r < 16; ++r) { s.o0[r] *= alpha; s.o1[r] *= alpha; } }
    }
    const LAS unsigned char* vb = st + NS_VOFF + r32 * 136 + hh * 8;
#pragma unroll
    for (int blk = 0; blk < 2; ++blk)
#pragma unroll
        for (int sp = 0; sp < 2; ++sp) { const f32x16& pp = blk ? s1 : s0; const int rb = 8 * sp;
            v4u pw; pw.x = cvtpk(pp[rb + 0], pp[rb + 1]); pw.y = cvtpk(pp[rb + 2], pp[rb + 3]); pw.z = cvtpk(pp[rb + 4], pp[rb + 5]); pw.w = cvtpk(pp[rb + 6], pp[rb + 7]);
            const bf16x8_t pf = __builtin_bit_cast(bf16x8_t, pw);
            const int ko = (32 * blk + 16 * sp) * 2;
            const v2u a0l = *(const LAS v2u*)(vb + ko), a0h = *(const LAS v2u*)(vb + ko + 16), a1l = *(const LAS v2u*)(vb + 32 * 136 + ko), a1h = *(const LAS v2u*)(vb + 32 * 136 + ko + 16);
            const bf16x8_t v0 = __builtin_bit_cast(bf16x8_t, (v4u){a0l.x, a0l.y, a0h.x, a0h.y}), v1 = __builtin_bit_cast(bf16x8_t, (v4u){a1l.x, a1l.y, a1h.x, a1h.y});
            s.o0 = __builtin_amdgcn_mfma_f32_32x32x16_bf16(v0, pf, s.o0, 0, 0, 0); s.o1 = __builtin_amdgcn_mfma_f32_32x32x16_bf16(v1, pf, s.o1, 0, 0, 0); }
}
template <bool FIRST>
__device__ __forceinline__ void nsa_finish(NsaState& s, float gate, LAS float* outp) {
    const float lt = s.l + __shfl_xor(s.l, 32); const float sc = lt > 0.f ? gate / lt : 0.f;
#pragma unroll
    for (int k = 0; k < 4; ++k) { f32x4 a = {s.o0[4 * k], s.o0[4 * k + 1], s.o0[4 * k + 2], s.o0[4 * k + 3]}, c = {s.o1[4 * k], s.o1[4 * k + 1], s.o1[4 * k + 2], s.o1[4 * k + 3]};
        a = a * sc; c = c * sc;
        if (!FIRST) { a = a + *(const LAS f32x4*)(outp + 8 * k); c = c + *(const LAS f32x4*)(outp + 32 + 8 * k); }
        *(LAS f32x4*)(outp + 8 * k) = a; *(LAS f32x4*)(outp + 32 + 8 * k) = c; }
    s.m = NEGBIG; s.l = 0.f; s.o0 = (f32x16){}; s.o1 = (f32x16){};
}

__device__ __forceinline__ void nsa_prompt_item(const Params& p, LAS unsigned char* lds, int bg, int qi, int tid) {
    const int lane = tid & 63, wave = __builtin_amdgcn_readfirstlane(tid >> 6), r32 = lane & 31, hh = lane >> 5;
    const int b = bg >> 2, g = bg & 3, tl = 8 * wave + (r32 & 7), hd = r32 >> 3, t = 64 * qi + tl, row = b * SEQ + t;
    const int srow = tid >> 3, sch = tid & 7;
    v4u rk, rv;
    auto issue = [&](const bf16_t* kbase, size_t kstride, const bf16_t* vbase, size_t vstride) { rk = *(const v4u*)(kbase + (size_t)srow * kstride + sch * 8); rv = *(const v4u*)(vbase + (size_t)srow * vstride + sch * 8); };
    auto commit = [&](int s) { LAS unsigned char* st = lds + s * NS_STAGE; *(LAS v4u*)(st + NS_KOFF + srow * 144 + sch * 16) = rk;
        *(LAS v2u*)(st + NS_VOFF + srow * 136 + sch * 16) = (v2u){rv.x, rv.y}; *(LAS v2u*)(st + NS_VOFF + srow * 136 + sch * 16 + 8) = (v2u){rv.z, rv.w}; };
    bf16x8_t q[4];
    { const bf16_t* qp = p.QN + (size_t)row * 1024 + (g * 4 + hd) * 64 + 8 * hh;
#pragma unroll
      for (int ks = 0; ks < 4; ++ks) q[ks] = *(const bf16x8_t*)(qp + 16 * ks); }
    const float g0 = p.GATE[(size_t)row * 48 + (g * 4 + hd) * 3 + 0], g1 = p.GATE[(size_t)row * 48 + (g * 4 + hd) * 3 + 1], g2 = p.GATE[(size_t)row * 48 + (g * 4 + hd) * 3 + 2];
    LAS float* outp = (LAS float*)(lds + NS_OUT) + (wave * 32 + r32) * 68 + 4 * hh;
    NsaState s; s.m = NEGBIG; s.l = 0.f; s.o0 = (f32x16){}; s.o1 = (f32x16){};
    const bf16_t* kc = p.KCMP_P + (size_t)bg * 128 * 64; const bf16_t* vct = p.VCMPT_P + (size_t)bg * 64 * 128;
    issue(kc, 64, vct, 128); commit(0); issue(kc + 64 * 64, 64, vct + 64, 128); commit(1);
    __syncthreads();
    const int limc = (t >= 31) ? ((t - 31) >> 4) : -1;
    {
        nsa_tile<1>(lds, q, s, 0, limc, r32, hh); if (qi >= 16) nsa_tile<1>(lds + NS_STAGE, q, s, 0, limc - 64, r32, hh);
        const float lt = s.l + __shfl_xor(s.l, 32); s.l = lt > 0.f ? 1.f / lt : 0.f;
        LAS float* PCS = (hd == 0) ? (LAS float*)(lds + NS_PCS) + tl * 128 : (LAS float*)(lds + NS_SC);
        nsa_tile<2>(lds, q, s, 0, limc, r32, hh, qi >= 16 ? PCS : nullptr, 0); if (qi >= 16) nsa_tile<2>(lds + NS_STAGE, q, s, 0, limc - 64, r32, hh, PCS, 64);
        __syncthreads();
    }
    if (qi >= 16) {
        const LAS float* PCS = (const LAS float*)(lds + NS_PCS);
        LAS float* SCR = (LAS float*)(lds + NS_SC); LAS unsigned* SEL = (LAS unsigned*)(lds + NS_SEL);
        { const int tk = tid >> 3, jq = tid & 7;
#pragma unroll
          for (int u = 0; u < 4; ++u) { const int j = jq * 4 + u; float sm = 0.f;
#pragma unroll
              for (int o = 0; o < 5; ++o) { const int ki = 4 * j - 1 + o; if (ki >= 0 && ki < 127) sm += PCS[tk * 128 + ki]; }
              SCR[tk * 32 + j] = (j <= qi) ? sm + ((j == 0 || j == qi) ? 1e4f : 0.f) : NEGBIG; }
        }
        __syncthreads();
        { const int tk = tid >> 3, jq = tid & 7; unsigned bits = 0u;
#pragma unroll
          for (int u = 0; u < 4; ++u) { const int j = jq * 4 + u; const float sj = SCR[tk * 32 + j]; int rank = 0;
              for (int j2 = 0; j2 < 32; ++j2) { const float s2 = SCR[tk * 32 + j2]; rank += (s2 > sj || (s2 == sj && j2 < j)) ? 1 : 0; }
              if (rank < 16) bits |= 1u << j; }
          bits |= __shfl_xor(bits, 1); bits |= __shfl_xor(bits, 2); bits |= __shfl_xor(bits, 4);
          if (jq == 0) SEL[tk] = bits; }
        __syncthreads();
    }
    s.l = 0.5f; nsa_finish<true>(s, g0, outp);
    const unsigned selmask = (qi < 16) ? 0xffffffffu : ((LAS unsigned*)(lds + NS_SEL))[tl];
    const int wlo = qi > 8 ? qi - 8 : 0, nslc = qi + 1, nsteps = nslc + (qi - wlo + 1);
    const bf16_t* ksl = p.KV6 + (size_t)(b * SEQ) * 1536 + 2 * 256 + g * 64; const bf16_t* kwn = ksl + 2 * 256;
    const bf16_t* vsl = p.VTS + (size_t)bg * 64 * SEQ; const bf16_t* vwn = p.VTW + (size_t)bg * 64 * SEQ;
    v4u rkB, rvB;
#define NSA_ISSUE(RK, RV, u) do { const int u_ = (u); const bf16_t* kb_; const bf16_t* vb_; \
        if (u_ < nslc) { kb_ = ksl + (size_t)(64 * u_) * 1536; vb_ = vsl + 64 * u_; } else { const int j_ = wlo + (u_ - nslc); kb_ = kwn + (size_t)(64 * j_) * 1536; vb_ = vwn + 64 * j_; } \
        RK = *(const v4u*)(kb_ + (size_t)srow * 1536 + sch * 8); RV = *(const v4u*)(vb_ + (size_t)srow * SEQ + sch * 8); } while (0)
#define NSA_COMMIT(RK, RV, s_) do { LAS unsigned char* st_ = lds + (s_) * NS_STAGE; *(LAS v4u*)(st_ + NS_KOFF + srow * 144 + sch * 16) = RK; \
        *(LAS v2u*)(st_ + NS_VOFF + srow * 136 + sch * 16) = (v2u){RV.x, RV.y}; *(LAS v2u*)(st_ + NS_VOFF + srow * 136 + sch * 16 + 8) = (v2u){RV.z, RV.w}; } while (0)
#define NSA_STEP(u) do { const int u__ = (u); int lo = 0, hi = 63; \
        if (u__ < nslc) { if (!((selmask >> u__) & 1u)) hi = -1; else if (u__ == qi) hi = tl; } \
        else { const int j_ = wlo + (u__ - nslc); if (j_ == qi) hi = tl; if (j_ == qi - 8) lo = tl; } \
        if (u__ == nslc) nsa_finish<false>(s, g1, outp); \
        nsa_tile<0>(lds + (u__ & 1) * NS_STAGE, q, s, lo, hi, r32, hh); } while (0)
    NSA_ISSUE(rk, rv, 0); NSA_COMMIT(rk, rv, 0);
    if (nsteps > 1) NSA_ISSUE(rk, rv, 1);
    __syncthreads();
    for (int u = 0; u < nsteps; u += 2) {
        if (u + 2 < nsteps) NSA_ISSUE(rkB, rvB, u + 2);
        NSA_STEP(u);
        if (u + 1 < nsteps) NSA_COMMIT(rk, rv, 1);
        LDS_BARRIER();
        if (u + 1 < nsteps) {
            if (u + 3 < nsteps) NSA_ISSUE(rk, rv, u + 3);
            NSA_STEP(u + 1);
            if (u + 2 < nsteps) NSA_COMMIT(rkB, rvB, 0);
            LDS_BARRIER();
        }
    }
#undef NSA_ISSUE
#undef NSA_COMMIT
#undef NSA_STEP
    { const float lt = s.l + __shfl_xor(s.l, 32); const float sc = lt > 0.f ? g2 / lt : 0.f;
      bf16_t* op = p.OA + (size_t)row * 1024 + (g * 4 + hd) * 64 + 4 * hh;
#pragma unroll
      for (int k = 0; k < 4; ++k) { const f32x4 a = *(const LAS f32x4*)(outp + 8 * k), c = *(const LAS f32x4*)(outp + 32 + 8 * k);
          v2u w; w.x = cvtpk(a[0] + s.o0[4 * k] * sc, a[1] + s.o0[4 * k + 1] * sc); w.y = cvtpk(a[2] + s.o0[4 * k + 2] * sc, a[3] + s.o0[4 * k + 3] * sc); *(v2u*)(op + 8 * k) = w;
          v2u w1; w1.x = cvtpk(c[0] + s.o1[4 * k] * sc, c[1] + s.o1[4 * k + 1] * sc); w1.y = cvtpk(c[2] + s.o1[4 * k + 2] * sc, c[3] + s.o1[4 * k + 3] * sc); *(v2u*)(op + 32 + 8 * k) = w1; } }
}

constexpr int SS_Q = 0, SS_SC = 256, SS_PART = SS_SC + 4 * 1088, SS_REDM = SS_PART + 2048, SS_REDS = SS_REDM + 8, SS_GATE = SS_REDS + 8, SS_SCORE = SS_GATE + 16, SS_SEL = SS_SCORE + 272, SS_SELO = SS_SEL + 16, SS_OACC = SS_SELO + 16, SS_END = SS_OACC + 256;
__device__ __forceinline__ f32x4 ld4_bf(const bf16_t* ptr) { const v2u w = *(const v2u*)ptr; return (f32x4){bf2f((bf16_t)(w.x & 0xffff)), bf2f((bf16_t)(w.x >> 16)), bf2f((bf16_t)(w.y & 0xffff)), bf2f((bf16_t)(w.y >> 16))}; }
template <int N> __device__ __forceinline__ float dpp_ror(float v) { return __builtin_bit_cast(float, __builtin_amdgcn_update_dpp(0, __builtin_bit_cast(int, v), 0x120 + N, 0xf, 0xf, false)); }
__device__ __forceinline__ float row16_sum(float t) { t += dpp_ror<8>(t); t += dpp_ror<4>(t); t += dpp_ror<2>(t); t += dpp_ror<1>(t); return t; }
template <class KF, class VF>
__device__ __forceinline__ void nsa_s_branch(LAS float* L, int nk, KF keyf, VF valf, int gsel, int tid) {
    const int lane = tid & 63, wave = tid >> 6, d4 = (lane & 15) * 4, ksub = lane >> 4;
    LAS float* q = L + SS_Q; LAS float* sc = L + SS_SC; LAS float* part = L + SS_PART; LAS float* redm = L + SS_REDM; LAS float* reds = L + SS_REDS;
    f32x4 qv[4];
#pragma unroll
    for (int hd = 0; hd < 4; ++hd) qv[hd] = *(const LAS f32x4*)(q + hd * 64 + d4);
    for (int base = wave * 4; base < nk; base += 256) {
        f32x4 kx[8]; bool vld[8];
#pragma unroll
        for (int u = 0; u < 8; ++u) { int kk = base + 32 * u + ksub; kk = kk < nk ? kk : nk - 1; kx[u] = keyf(kk, d4, vld[u]); }
#pragma unroll
        for (int u = 0; u < 8; ++u) { const int kk = base + 32 * u + ksub; float pd[4];
#pragma unroll
            for (int hd = 0; hd < 4; ++hd) pd[hd] = row16_sum((qv[hd][0] * kx[u][0] + qv[hd][1] * kx[u][1]) + (qv[hd][2] * kx[u][2] + qv[hd][3] * kx[u][3]));
            if (kk < nk && (lane & 15) == 0) {
#pragma unroll
                for (int hd = 0; hd < 4; ++hd) sc[hd * 1088 + kk] = vld[u] ? pd[hd] : -INFINITY; } } }
    __syncthreads();
    { const int hd = wave & 3, half = wave >> 2; LAS float* sh = sc + hd * 1088;
      float m = -INFINITY; for (int kk = half * 64 + lane; kk < nk; kk += 128) m = fmaxf(m, sh[kk]);
      m = wave_max(m); if (lane == 0) redm[wave] = m;
      __syncthreads();
      m = fmaxf(redm[hd], redm[hd + 4]); float sm = 0.f;
      for (int kk = half * 64 + lane; kk < nk; kk += 128) { const float x = sh[kk]; const float e = (x == -INFINITY) ? 0.f : __expf(x - m); sh[kk] = e; sm += e; }
      sm = wave_sum(sm); if (lane == 0) reds[wave] = sm;
      __syncthreads();
      const float tot = reds[hd] + reds[hd + 4]; const float inv = tot > 0.f ? 1.f / tot : 0.f;
      for (int kk = half * 64 + lane; kk < nk; kk += 128) sh[kk] *= inv; }
    __syncthreads();
    { f32x4 o[4];
#pragma unroll
      for (int hd = 0; hd < 4; ++hd) o[hd] = (f32x4){0.f, 0.f, 0.f, 0.f};
      for (int base = wave * 4; base < nk; base += 256) { f32x4 vv[8];
#pragma unroll
          for (int u = 0; u < 8; ++u) { int kk = base + 32 * u + ksub; kk = kk < nk ? kk : nk - 1; vv[u] = valf(kk, d4); }
#pragma unroll
          for (int u = 0; u < 8; ++u) { const int kk = base + 32 * u + ksub; const bool inr = kk < nk; const int kc2 = inr ? kk : nk - 1;
#pragma unroll
              for (int hd = 0; hd < 4; ++hd) { const float pr = inr ? sc[hd * 1088 + kc2] : 0.f; o[hd] = o[hd] + vv[u] * pr; } } }
#pragma unroll
      for (int hd = 0; hd < 4; ++hd)
#pragma unroll
          for (int e = 0; e < 4; ++e) { float t = o[hd][e]; t += __shfl_xor(t, 16); t += __shfl_xor(t, 32); o[hd][e] = t; }
      if (ksub == 0) {
#pragma unroll
          for (int hd = 0; hd < 4; ++hd) *(LAS f32x4*)(part + (wave * 4 + hd) * 64 + d4) = o[hd]; } }
    __syncthreads();
    if (tid < 256) { float o = 0.f;
#pragma unroll
        for (int w = 0; w < 8; ++w) o += part[w * 256 + tid];
        L[SS_OACC + tid] += L[SS_GATE + (tid >> 6) * 3 + gsel] * o; }
    __syncthreads();
}
__device__ __forceinline__ void nsa_sample_item(const Params& p, LAS unsigned char* lds, int item, int tid) {
    const int b = item >> 2, g = item & 3, bg = item, row = NPT + b;
    constexpr int pos = PAST, n_cmp = 1023, n_slc = 257;
    LAS float* L = (LAS float*)lds; LAS float* sc = L + SS_SC; LAS float* score = L + SS_SCORE; LAS int* selidx = (LAS int*)(L + SS_SEL); LAS unsigned* selofs = (LAS unsigned*)(L + SS_SELO);
    if (tid < 256) { L[SS_Q + tid] = bf2f(p.QN[(size_t)row * 1024 + g * 256 + tid]); L[SS_OACC + tid] = 0.f; }
    if (tid < 12) L[SS_GATE + tid] = p.GATE[(size_t)row * 48 + g * 12 + tid];
    __syncthreads();
    SSTAMP(40);
    const bf16_t* kc = p.KCMP_S + (size_t)bg * 1024 * 64; const bf16_t* vc = p.VCMP_S + (size_t)bg * 1024 * 64;
    nsa_s_branch(L, n_cmp, [&](int kk, int d4, bool& valid) { valid = true; return ld4_bf(kc + (size_t)kk * 64 + d4); }, [&](int kk, int d4) { return ld4_bf(vc + (size_t)kk * 64 + d4); }, 0, tid);
    SSTAMP(41);
    for (int j = tid; j < n_slc; j += 512) { float s = 0.f;
        for (int i = 4 * j - 1; i <= 4 * j + 3; ++i) if (i >= 0 && i < n_cmp) s += (sc[i] + sc[1088 + i]) + (sc[2 * 1088 + i] + sc[3 * 1088 + i]);
        score[j] = s + ((j == 0 || j == pos / 64) ? 1e4f : 0.f); }
    __syncthreads();
    { const int j = tid >> 1, half = tid & 1, jb = half ? 129 : 0, je = half ? 257 : 129; const float sj = score[j]; int cnt = 0;
#pragma unroll 8
      for (int j2 = jb; j2 < je; ++j2) { const float s2 = score[j2]; cnt += (s2 > sj || (s2 == sj && j2 < j)) ? 1 : 0; }
      cnt += __shfl_xor(cnt, 1);
      if (half == 0 && cnt < 16) { selidx[cnt] = j; selofs[cnt] = (unsigned)((((size_t)p.page_table[b * NPAGES + (j >> 1)] * PAGE + (j & 1) * 64) * 4 + g) * 64); }
      if (tid == 0) { selidx[1] = 256; selofs[1] = 0xffffffffu; } }
    __syncthreads();
    SSTAMP(42);
    const bf16_t* newrow = p.KV6 + (size_t)row * 1536 + g * 64;
    nsa_s_branch(L, 1024,
        [&](int kk, int d4, bool& valid) { const unsigned so = selofs[kk >> 6]; const int r = kk & 63;
            if (so != 0xffffffffu) { valid = true; return *(const f32x4*)(p.csk + so + (size_t)r * 256 + d4); } valid = (r == 0); return ld4_bf(newrow + 2 * 256 + d4); },
        [&](int kk, int d4) { const unsigned so = selofs[kk >> 6]; const int r = kk & 63;
            if (so != 0xffffffffu) return *(const f32x4*)(p.csv + so + (size_t)r * 256 + d4); return ld4_bf(newrow + 3 * 256 + d4); }, 1, tid);
    SSTAMP(43);
    nsa_s_branch(L, 513,
        [&](int kk, int d4, bool& valid) { valid = true; if (kk < 512) return *(const f32x4*)(p.cwk + (((size_t)b * 512 + kk) * 4 + g) * 64 + d4); return ld4_bf(newrow + 4 * 256 + d4); },
        [&](int kk, int d4) { if (kk < 512) return *(const f32x4*)(p.cwv + (((size_t)b * 512 + kk) * 4 + g) * 64 + d4); return ld4_bf(newrow + 5 * 256 + d4); }, 2, tid);
    SSTAMP(44);
    if (tid < 256) p.OA[(size_t)row * 1024 + g * 256 + tid] = f2bf(L[SS_OACC + tid]);
    __syncthreads();
}

#define XB_TMO      128
#define XB_XCNT(j)  (256  + 64 * (j))
#define XB_XSUB(j)  (1280 + 64 * (j))
#define XB_XGEN(j)  (2304 + 64 * (j))
#define XB_TOP      3328
#define XB_TOPGEN   3392
#define XCD_BAR_WORDS 3456
#define XB_SPIN_CAP (1u << 22)

__device__ __forceinline__ unsigned xb_ld(unsigned* p)              { return __hip_atomic_load(p, __ATOMIC_RELAXED, __HIP_MEMORY_SCOPE_AGENT); }
__device__ __forceinline__ unsigned xb_add(unsigned* p, unsigned v) { return __hip_atomic_fetch_add(p, v, __ATOMIC_RELAXED, __HIP_MEMORY_SCOPE_AGENT); }
__device__ __forceinline__ unsigned xb_xcc_id() { return (unsigned)__builtin_amdgcn_s_getreg((3 << 11) | 20) & 0xFu; }
#define XB_SPIN(cond, bar) do { unsigned _sp = 0; while (cond) { __builtin_amdgcn_s_sleep(1); \
    if ((++_sp & 255u) == 0u) { if (xb_ld(&(bar)[XB_TMO])) break; if (_sp > XB_SPIN_CAP) { atomicAdd(&(bar)[XB_TMO], 1u); break; } } } } while (0)

struct XcdBarrier {
    unsigned* bar; unsigned x;
    volatile LAS unsigned* st;
};

__device__ __forceinline__ XcdBarrier xcd_barrier_post(unsigned* bar, volatile LAS unsigned* st) {
    XcdBarrier b; b.bar = bar; b.x = xb_xcc_id(); b.st = st;
    if (threadIdx.x == 0) (void)xb_add(&bar[XB_XCNT(b.x)], 1u);
    return b;
}
__device__ __forceinline__ void xcd_barrier_complete(unsigned* bar, unsigned x, unsigned& nloc, unsigned& nx) {
    const unsigned G = gridDim.x * gridDim.y * gridDim.z;
    unsigned sum, cnt, mine, sp = 0u;
    for (;;) {
        sum = 0u; cnt = 0u; mine = 0u;
#pragma unroll
        for (unsigned j = 0; j < 16; ++j) { const unsigned c = xb_ld(&bar[XB_XCNT(j)]); sum += c; cnt += (c > 0u) ? 1u : 0u; mine = (j == x) ? c : mine; }
        if (sum == G) break;
        __builtin_amdgcn_s_sleep(1);
        if ((++sp & 255u) == 0u) { if (xb_ld(&bar[XB_TMO])) break; if (sp > XB_SPIN_CAP) { atomicAdd(&bar[XB_TMO], 1u); break; } }
    }
    nloc = mine > 0u ? mine : 1u; nx = cnt > 0u ? cnt : 1u;
}

__device__ __forceinline__ void xcd_barrier(const XcdBarrier& b) {
    asm volatile("s_waitcnt vmcnt(0)" ::: "memory");
    __syncthreads();
    if (threadIdx.x == 0) {
        unsigned* bar = b.bar;
        __builtin_amdgcn_s_waitcnt(0);
        unsigned nloc = b.st[0], nx = b.st[1];
        if (nloc == 0u) { xcd_barrier_complete(bar, b.x, nloc, nx); b.st[0] = nloc; b.st[1] = nx; }
        const unsigned old = xb_add(&bar[XB_XSUB(b.x)], 1u);
        const unsigned gen = old / nloc;
        if (old + 1u == (gen + 1u) * nloc) {
            __builtin_amdgcn_fence(__ATOMIC_RELEASE, "agent");
            asm volatile("s_waitcnt vmcnt(0)" ::: "memory");
            const unsigned og = xb_add(&bar[XB_TOP], 1u);
            const unsigned tg = og / nx;
            if (og + 1u == (tg + 1u) * nx) xb_add(&bar[XB_TOPGEN], 1u);
            else XB_SPIN(xb_ld(&bar[XB_TOPGEN]) == tg, bar);
            __builtin_amdgcn_fence(__ATOMIC_ACQUIRE, "agent");
            xb_add(&bar[XB_XGEN(b.x)], 1u);
            asm volatile("s_waitcnt vmcnt(0)" ::: "memory");
        } else {
            XB_SPIN(xb_ld(&bar[XB_XGEN(b.x)]) == gen, bar);
            __builtin_amdgcn_fence(__ATOMIC_ACQUIRE, "agent");
            asm volatile("s_waitcnt vmcnt(0)" ::: "memory");
        }
    }
    __syncthreads();
}

constexpr int LDS_BYTES = 147456;
constexpr int LDSCTL_OFF = 131072, MISC_OFF = LDSCTL_OFF + 320;
constexpr int CW_BAR = 4096;
enum Phase { PH_PRO0 = 0, PH_PRO = 1, PH_IN = 2, PH_MID = 3, PH_ATT = 4, PH_BRA = 5, PH_BRB = 6, PH_WO = 7, PH_UP = 8, PH_DOWN = 9, PH_NORM = 10, PH_END = 11 };
__global__ void __launch_bounds__(512, 2) mk_fwd(Params p, int ph_lo, int ph_hi, int li) {
    extern __shared__ __attribute__((aligned(16))) unsigned char lds_raw[];
    LAS unsigned char* lds = (LAS unsigned char*)lds_raw;
    const int tid = threadIdx.x, bid = blockIdx.x, G = gridDim.x;
    for (int u = tid; u < (LDS_BYTES - LDSCTL_OFF) / 4; u += 512) ((LAS unsigned*)(lds + LDSCTL_OFF))[u] = 0u;
    __syncthreads();
    XcdBarrier bar; bar.bar = p.CTL + CW_BAR + li * XCD_BAR_WORDS; bar.x = 0; bar.st = nullptr;
    if (ph_hi - ph_lo > 1) bar = xcd_barrier_post(p.CTL + CW_BAR + li * XCD_BAR_WORDS, (volatile LAS unsigned*)(lds + MISC_OFF) + 8);
    if (PROBE_PHASE >= 0 && bid == 0 && tid == 0) ((LAS unsigned long long*)(lds + LDSCTL_OFF + 512))[0] = __builtin_amdgcn_s_memrealtime();
#define IN(k) (ph_lo <= (k) && (k) < ph_hi)
#define STAMP(i) do { if (PROBE_A >= 0 && bid == PROBE_BID && tid == 0) { ((unsigned long long*)(p.CTL + 2048))[i] = __builtin_amdgcn_s_memrealtime(); } } while (0)
#define SEAM(k) do { if (ph_lo <= (k) && (k) + 1 < ph_hi) xcd_barrier(bar); if (PROBE_PHASE >= 0 && bid == 0 && tid == 0) ((LAS unsigned long long*)(lds + LDSCTL_OFF + 512))[(k) + 1] = __builtin_amdgcn_s_memrealtime(); } while (0)
#define REP(k) _Pragma("unroll 1") for (int rep_ = 0; rep_ < 1 + ((REP_MASK >> (k)) & 1); ++rep_)
    if (IN(PH_PRO)) { if (PROBE_PHASE >= 0 && bid == 0 && tid == 0) ((LAS unsigned long long*)(lds + LDSCTL_OFF + 512))[PH_PRO] = __builtin_amdgcn_s_memrealtime();
      REP(PH_PRO) {
        STAMP(10); ph_pro0(p, lds, bid, G, tid);
        VM_WAIT(); __syncthreads(); STAMP(11);
        if (tid == 0) { __builtin_amdgcn_fence(__ATOMIC_RELEASE, "agent"); VM_WAIT(); __hip_atomic_fetch_add(p.CTL + 1088, 1u, __ATOMIC_RELAXED, __HIP_MEMORY_SCOPE_AGENT); }
        if (G > 32) { if (bid < G - 16) ph_prologue(p, lds, bid, G - 16, tid, 2); } else ph_prologue(p, lds, bid, G, tid, 2);
        __syncthreads(); STAMP(12);
        if (tid == 0) { unsigned sp = 0; while (__hip_atomic_load(p.CTL + 1088, __ATOMIC_RELAXED, __HIP_MEMORY_SCOPE_AGENT) < (unsigned)G * (1 + rep_)) { __builtin_amdgcn_s_sleep(2); if (++sp > (1u << 22)) break; }
            __builtin_amdgcn_fence(__ATOMIC_ACQUIRE, "agent"); VM_WAIT(); }
        __syncthreads(); STAMP(13);
        { const int lim = (G > 32) ? 512 : 528, extra = (G > 32 && bid >= G - 16) ? 512 + (bid - (G - 16)) : -1;
          int t = bid; bool fin = false;
#pragma unroll 1
          while (!fin) { int tt = t; if (t >= lim) { if (extra < 0) break; tt = extra; fin = true; } cmp_gemm_tile<true>(p, lds, tt, tid); t += G; } }
        __syncthreads(); STAMP(14); if (G > 32) { if (bid >= 4 && bid < G - 16) ph_prologue(p, lds, bid - 4, G - 20, tid, 1); } else ph_prologue(p, lds, bid, G, tid, 1);
        if (G > 32 && bid < G - 16) ph_late_weights(p, lds, bid * 8 + (tid >> 6), (G - 16) * 8, tid, 0, LATE_PRO);
        __syncthreads(); STAMP(15); } SEAM(PH_PRO); STAMP(16); }
    if (IN(PH_IN)) { REP(PH_IN) {
        STAMP(30); skinny_gemm(lds, p.XB + (size_t)NPT * DM, DM, p.WIN_T, NIN_PAD, DM, F_proj_s{p}, bid, G, tid);
        VM_WAIT(); __syncthreads();
        if (tid == 0) { __builtin_amdgcn_fence(__ATOMIC_RELEASE, "agent"); VM_WAIT(); __hip_atomic_fetch_add(p.CTL + 1024, 1u, __ATOMIC_RELAXED, __HIP_MEMORY_SCOPE_AGENT); }
        { pg8::Gemm g{p.XB, p.WIN_T, NPT, NIN_PAD, DM}; pg8::StaticOrder S; S.init(NPT, NIN_PAD, G, bid);
          EpiProj E{p.RSTD1, p.b_gate, p.QN, p.KV6, p.GQ, p.GK, p.GV, p.GR, p.BR, p.GATE, p.LR, p.out};
          pg8::gemm_phase<EpiProj, pg8::StaticOrder, true, true>(lds, g, S, E); } STAMP(31);
        for (int it = G - 1 - bid; it < 32; it += G) {
            if (tid == 0) { unsigned sp = 0; while (__hip_atomic_load(p.CTL + 1024, __ATOMIC_RELAXED, __HIP_MEMORY_SCOPE_AGENT) < (unsigned)G * (1 + rep_)) { __builtin_amdgcn_s_sleep(2); if (++sp > (1u << 22)) break; }
                __builtin_amdgcn_fence(__ATOMIC_ACQUIRE, "agent"); VM_WAIT(); }
            __syncthreads();
            nsa_sample_item(p, lds, it, tid); }
        STAMP(32); }
        SEAM(PH_IN); STAMP(33); }
    if (IN(PH_MID)) { REP(PH_MID) { STAMP(20);
        for (int t = bid; t < 32; t += G) { cmp_gemm_tile<false>(p, lds, t, tid); __builtin_amdgcn_fence(__ATOMIC_RELEASE, "workgroup"); VM_WAIT(); __syncthreads(); cmp_part2<false>(p, lds, t >> 4, t & 15, 0, tid); }
        STAMP(21);
        const int gsplit = (G * 20) / 32;
        const int lw0 = (G > 32) ? LATE_PRO : 0;
        { int ga0 = bid, gas = G; if (G >= 128) { ga0 = (bid >= 32 && bid < gsplit) ? bid - 32 : 512; gas = gsplit - 32; }
          if (ga0 < 512) { GlaAIn cur = gla_a_issue(p, ga0, tid);
#pragma unroll 1
              for (int it = ga0; it < 512; it += gas) { const GlaAIn nxt = gla_a_issue(p, (it + gas < 512) ? it + gas : it, tid); gla_pass_a(p, lds, it, tid, cur); cur = nxt; } } }
        STAMP(23);
        for (int it = G - 1 - bid; it < 32; it += G) gla_sample_item(p, lds, it, tid); STAMP(24);
        { const int wave = tid >> 6;
          if (G == 256) { const int vt = (bid >= 32 && bid < 128) ? bid * 8 + wave : (bid >= 128 && bid < 160) ? (bid - 128) * 8 + wave : -1; if (vt >= 0) nsa_vt_tile(p, lds + wave * 16384, vt, tid & 63); }
          else for (int it = bid * 8 + wave; it < 1024; it += G * 8) nsa_vt_tile(p, lds + wave * 16384, it, tid & 63); } __syncthreads(); STAMP(25);
        if (G >= 128) {
            const int lsp = 20480 - 2048;
            if (bid >= gsplit) { ph_late_weights(p, lds, (bid - gsplit) * 8 + (tid >> 6), (G - gsplit) * 8, tid, lw0, lsp);
                if (bid < G - 32) ph_late_weights(p, lds, (bid - gsplit) * 8 + (tid >> 6), (G - 32 - gsplit) * 8, tid, lsp); } }
        else ph_late_weights(p, lds, bid * 8 + (tid >> 6), G * 8, tid, lw0);
        __syncthreads(); STAMP(26); }
        SEAM(PH_MID); }
    if (IN(PH_ATT)) { REP(PH_ATT) {
        gla_pass_b(p, bid, G, tid);
        VM_WAIT(); __syncthreads();
        if (tid == 0) { __builtin_amdgcn_fence(__ATOMIC_RELEASE, "agent"); VM_WAIT(); __hip_atomic_fetch_add(p.CTL + 1152, 1u, __ATOMIC_RELAXED, __HIP_MEMORY_SCOPE_AGENT); }
        STAMP(53);
        for (int it = bid; it < 256; it += G) { const int bg = it & 15, sq = it >> 4;
#pragma unroll 1
            for (int k = 0; k < 2; ++k) { STAMP(50 + k); nsa_prompt_item(p, lds, bg, k ? sq : 31 - sq, tid); __syncthreads(); } }
        STAMP(52);
        if (tid == 0) { unsigned sp = 0; while (__hip_atomic_load(p.CTL + 1152, __ATOMIC_RELAXED, __HIP_MEMORY_SCOPE_AGENT) < (unsigned)G * (1 + rep_)) { __builtin_amdgcn_s_sleep(2); if (++sp > (1u << 22)) break; }
            __builtin_amdgcn_fence(__ATOMIC_ACQUIRE, "agent"); VM_WAIT(); }
        __syncthreads();
        { volatile LAS int* slot = (volatile LAS int*)(lds + LDSCTL_OFF + 2048);
          int it = bid; STAMP(30);
#pragma unroll 1
          while (it < 512) { int nxt = 0; if (tid == 0) nxt = G + (int)__hip_atomic_fetch_add(p.CTL + 1344, 1u, __ATOMIC_RELAXED, __HIP_MEMORY_SCOPE_AGENT);
              gla_pass_c(p, lds, it, tid);
              if (tid == 0) *slot = nxt;
              __syncthreads(); it = __builtin_amdgcn_readfirstlane(*slot); }
          STAMP(31); } __syncthreads(); }
        SEAM(PH_ATT); }
    if (IN(PH_BRA)) { if (PROBE_PHASE >= 0 && bid == 0 && tid == 0) ((LAS unsigned long long*)(lds + LDSCTL_OFF + 512))[PH_BRB] = __builtin_amdgcn_s_memrealtime();
      REP(PH_BRA) {
        { const F_bra f{p.BR, (bf16_t*)p.TMP};
          { pg8::Gemm g{p.OA, p.WBRA_T, NPT, DM, 1024}; pg8::StaticOrder S; S.init(NPT, DM, G, bid); EpiGen<F_bra> E{f}; pg8::gemm_phase<EpiGen<F_bra>, pg8::StaticOrder, true, true>(lds, g, S, E); }
          skinny_gemm(lds, p.OA + (size_t)NPT * 1024, 1024, p.WBRA_T, DM, 1024, f, bid, G, tid); }
        { const F_brb f{p.BR, (const bf16_t*)p.TMP, p.MB};
          { pg8::Gemm g{p.OB, p.WBRB_T, NPT, DM, 1024}; pg8::StaticOrder S; S.init(NPT, DM, G, bid); EpiGen<F_brb> E{f}; pg8::gemm_phase<EpiGen<F_brb>, pg8::StaticOrder, true, true>(lds, g, S, E); }
          skinny_gemm(lds, p.OB + (size_t)NPT * 1024, 1024, p.WBRB_T, DM, 1024, f, bid, G, tid); } }
        SEAM(PH_BRB); }
    if (IN(PH_WO)) { STAMP(60);
        { const F_wo f{p.x_prompt, p.X1B, p.SUMSQ2}; pg8::Gemm g{p.MB, p.WO_T, NPT, DM, DM}; pg8::StaticOrder S; S.init(NPT, DM, G, bid); EpiGen<F_wo> E{f}; pg8::gemm_phase<EpiGen<F_wo>, pg8::StaticOrder, true, true>(lds, g, S, E); } STAMP(61);
        if (PROBE_A >= 0 && bid == PROBE_BID && tid == 0) { for (int i = 0; i < 4; ++i) ((unsigned long long*)(p.CTL + 2048))[70 + i] = ((LAS unsigned long long*)(lds + 135168))[i]; }
        { const F_wo f{p.x_sample - (size_t)NPT * DM, p.X1B, p.SUMSQ2}; skinny_gemm(lds, p.MB + (size_t)NPT * DM, DM, p.WO_T, DM, DM, f, bid, G, tid); } STAMP(62); SEAM(PH_WO); STAMP(63); }
    if (IN(PH_UP)) { REP(PH_UP) { const F_up f{p.SUMSQ2, p.HF};
        { pg8::Gemm g{p.X1B, p.WUP_T, NPT, DFF, DM}; pg8::StaticOrder S; S.init(NPT, DFF, G, bid); EpiGen<F_up> E{f}; pg8::gemm_phase<EpiGen<F_up>, pg8::StaticOrder, true, true>(lds, g, S, E); }
        skinny_gemm(lds, p.X1B + (size_t)NPT * DM, DM, p.WUP_T, DFF, DM, f, bid, G, tid); } SEAM(PH_UP); }
    const bool fusedn = (G == 256) && PROBE_A < 0 && PROBE_PHASE < 0;
    if (IN(PH_DOWN)) {
        { const F_down f{p.X1B, (bf16_t*)p.X1, p.SUMSQ3}; skinny_gemm(lds, p.HF + (size_t)NPT * DFF, DFF, p.WDN_T, DM, DFF, f, bid, G, tid); }
        if (fusedn) {
            volatile LAS unsigned* lastf = (volatile LAS unsigned*)(lds + LDSCTL_OFF + 64);
            VM_WAIT(); __syncthreads();
            if (tid == 0) { __builtin_amdgcn_fence(__ATOMIC_RELEASE, "agent"); VM_WAIT(); const unsigned old = __hip_atomic_fetch_add(p.CTL + 1280, 1u, __ATOMIC_RELAXED, __HIP_MEMORY_SCOPE_AGENT);
                const unsigned last = (old == (unsigned)G - 1u) ? 1u : 0u; if (last) { __builtin_amdgcn_fence(__ATOMIC_ACQUIRE, "agent"); VM_WAIT(); } lastf[0] = last; }
            __syncthreads();
            if (lastf[0]) ph_final_norm(p, 0, 1, tid, NPT);
            __syncthreads();
            pg8::Gemm g{p.HF, p.WDN_T, NPT, DM, DFF}; pg8::StaticOrder S; S.init(NPT, DM, G, bid); EpiDownNorm E{p.X1B, p.SUMSQ3, p.out + OFF_Y, p.norm_f, p.CTL + 8192};
            pg8::gemm_phase<EpiDownNorm, pg8::StaticOrder, false, true>(lds, g, S, E);
        } else {
            { const F_down f{p.X1B, (bf16_t*)p.X1, p.SUMSQ3}; pg8::Gemm g{p.HF, p.WDN_T, NPT, DM, DFF}; pg8::StaticOrder S; S.init(NPT, DM, G, bid); EpiGen<F_down> E{f}; pg8::gemm_phase<EpiGen<F_down>, pg8::StaticOrder, true, true>(lds, g, S, E); }
            SEAM(PH_DOWN); } }
    if (IN(PH_NORM) && !fusedn) { ph_final_norm(p, bid, G, tid);
        if (PROBE_A >= 0 && bid == 0) { const unsigned long long* tg = (const unsigned long long*)(p.CTL + 2048); const float X = (float)(tg[PROBE_B] - tg[PROBE_A]) * 1e-7f, f = 1.f + sqrtf(X);
            for (int i = tid; i < 2048; i += 512) p.out[OFF_SCK + i] *= f; }
        if (PROBE_PHASE >= 0 && bid == 0) { __syncthreads(); const LAS unsigned long long* ts = (const LAS unsigned long long*)(lds + LDSCTL_OFF + 512);
            const float X = (float)(ts[PROBE_PHASE + 1] - ts[PROBE_PHASE]) * 1e-7f, f = 1.f + sqrtf(X);
            for (int i = tid; i < 2048; i += 512) p.out[OFF_SCK + i] *= f; } }
#undef IN
#undef SEAM
#undef REP
}
__global__ void __launch_bounds__(256) k_sumsq_rows(const float* X, size_t ld, float* ss_out, int nrows) {
    const int lane = threadIdx.x & 63, row = blockIdx.x * 4 + (threadIdx.x >> 6);
    if (row >= nrows) return;
    float ss = 0.f;
    for (int i = lane; i < DM; i += 64) { const float v = X[(size_t)row * ld + i]; ss += v * v; }
    ss = wave_sum(ss);
    if (lane == 0) ss_out[row] = ss;
}
struct EF_up2 { Params p; __device__ void operator()(int r, int n, float acc) const { const float v = fmaxf(acc * rsqrtf(p.SUMSQ2[r] * (1.f / DM) + EPS), 0.f); p.HF[(size_t)r * DFF + n] = f2bf(v * v); } };

static inline size_t align_up(size_t x) { return (x + 255) & ~(size_t)255; }

extern "C" void kernel_launch(void* const* d_in, const int* in_sizes, int n_in, void* d_out, int out_size, void* d_ws, size_t ws_size, hipStream_t stream) {
    if (n_in != 29 || out_size != (int)OUT_TOTAL) { fprintf(stderr, "kernel_launch: unexpected n_in %d / out_size %d\n", n_in, out_size); return; }
    static int grid = 0;
    if (grid == 0) {
        int dev = 0, cus = 0, per_cu = 0;
        if (hipGetDevice(&dev) != hipSuccess || hipDeviceGetAttribute(&cus, hipDeviceAttributeMultiprocessorCount, dev) != hipSuccess) { fprintf(stderr, "kernel_launch: device query failed\n"); grid = -1; return; }
        if (hipFuncSetAttribute((const void*)mk_fwd, hipFuncAttributeMaxDynamicSharedMemorySize, LDS_BYTES) != hipSuccess) { fprintf(stderr, "kernel_launch: hipFuncSetAttribute failed\n"); grid = -1; return; }
        if (hipOccupancyMaxActiveBlocksPerMultiprocessor(&per_cu, (const void*)mk_fwd, 512, LDS_BYTES) != hipSuccess || per_cu < 1) { fprintf(stderr, "kernel_launch: occupancy query says %d\n", per_cu); per_cu = 1; }
        (void)hipGetLastError();
        grid = cus;
    }
    if (grid < 0) return;
    Params p{};
    p.x_prompt = (const float*)d_in[0]; p.x_sample = (const float*)d_in[1]; p.cck = (const float*)d_in[2]; p.ccv = (const float*)d_in[3];
    p.csk = (const float*)d_in[4]; p.csv = (const float*)d_in[5]; p.cwk = (const float*)d_in[6]; p.cwv = (const float*)d_in[7]; p.state = (const float*)d_in[8];
    p.page_table = (const int*)d_in[9]; p.norm1_g = (const float*)d_in[10]; p.w_in = (const float*)d_in[11]; p.b_gate = (const float*)d_in[12];
    p.pe_k = (const float*)d_in[13]; p.pe_v = (const float*)d_in[14]; p.w1k = (const float*)d_in[15]; p.w2k = (const float*)d_in[16]; p.w1v = (const float*)d_in[17]; p.w2v = (const float*)d_in[18];
    p.w_a2 = (const float*)d_in[19]; p.b_a = (const float*)d_in[20]; p.gnorm = (const float*)d_in[21]; p.w_br_a = (const float*)d_in[22]; p.w_br_b = (const float*)d_in[23];
    p.w_o = (const float*)d_in[24]; p.norm2_g = (const float*)d_in[25]; p.w_up = (const float*)d_in[26]; p.w_down = (const float*)d_in[27]; p.norm_f = (const float*)d_in[28];
    p.out = (float*)d_out;
    char* ws = (char*)d_ws; size_t off = 0;
    auto take = [&](size_t bytes) { char* r = ws + off; off = align_up(off + bytes); return r; };
    p.CTL = (unsigned*)take(1 << 20);
    p.XB = (bf16_t*)take((size_t)NTOK * DM * 2); p.RSTD1 = (float*)take(NTOK * 4); p.QN = (bf16_t*)take((size_t)NTOK * 1024 * 2); p.KV6 = (bf16_t*)take((size_t)NTOK * 1536 * 2);
    p.GATE = (float*)take((size_t)NTOK * 48 * 4); p.GQ = (bf16_t*)take((size_t)NTOK * 512 * 2); p.GK = (bf16_t*)take((size_t)NTOK * 512 * 2); p.GV = (bf16_t*)take((size_t)NTOK * 1024 * 2);
    p.GR = (bf16_t*)take((size_t)NTOK * 1024 * 2); p.LR = (float*)take((size_t)NTOK * 16 * 4); p.BR = (bf16_t*)take((size_t)NTOK * 4096 * 2);
    p.KCMP_P = (bf16_t*)take(16 * 128 * 64 * 2); p.VCMPT_P = (bf16_t*)take(16 * 128 * 64 * 2); p.KCMP_S = (bf16_t*)take(32 * 1024 * 64 * 2); p.VCMP_S = (bf16_t*)take(32 * 1024 * 64 * 2);
    p.OA = (bf16_t*)take((size_t)NTOK * 1024 * 2); p.OB = (bf16_t*)take((size_t)NTOK * 1024 * 2); p.TMP = (float*)take((size_t)NTOK * DM * 4); p.MB = (bf16_t*)take((size_t)NTOK * DM * 2);
    p.X1 = (float*)take((size_t)NTOK * DM * 4); p.X1B = (bf16_t*)take((size_t)NTOK * DM * 2); p.RSTD2 = (float*)take(NTOK * 4); p.HF = (bf16_t*)take((size_t)NTOK * DFF * 2);
    p.WIN_T = (bf16_t*)take((size_t)NIN_PAD * DM * 2); p.WBRA_T = (bf16_t*)take((size_t)DM * 1024 * 2); p.WBRB_T = (bf16_t*)take((size_t)DM * 1024 * 2); p.WO_T = (bf16_t*)take((size_t)DM * DM * 2);
    p.WUP_T = (bf16_t*)take((size_t)DFF * DM * 2); p.WDN_T = (bf16_t*)take((size_t)DM * DFF * 2); p.SUMSQ2 = (float*)take(NTOK * 4); p.SUMSQ3 = (float*)take(NTOK * 4);
    p.W1T = (bf16_t*)take(2 * 256 * 1024 * 2); p.W2TG = (bf16_t*)take(2 * 8192 * 2); p.BIAS1 = (float*)take(256 * 4); p.AB_S = (float*)take((size_t)2 * 32768 * 256 * 4); p.AB_P = (float*)take((size_t)2 * 2048 * 256 * 4);
    p.UT = (float*)take((size_t)512 * 256 * 128 * 2); p.BCG = (float*)take((size_t)512 * 8192 * 4); p.DEC = (float*)take(512 * 128 * 4); p.SNT = (bf16_t*)take((size_t)512 * 256 * 128 * 2);
    p.VTS = (bf16_t*)take((size_t)16 * 64 * SEQ * 2); p.VTW = (bf16_t*)take((size_t)16 * 64 * SEQ * 2);
    if (off > ws_size) { fprintf(stderr, "kernel_launch: workspace too small: need %zu have %zu\n", off, ws_size); return; }
    hipMemsetAsync(p.CTL, 0, 1 << 20, stream);
#define MK(lo, hi, li) hipLaunchKernelGGL(mk_fwd, dim3(grid), dim3(512), LDS_BYTES, stream, p, (int)(lo), (int)(hi), (int)(li))
    MK(PH_PRO0, PH_END, 0);
}
```

```cpp
#include <hip/hip_runtime.h>
#include <stdint.h>
#include <cstdio>

typedef unsigned short bf16_t;

constexpr int DM = 2048, NB = 4, SEQ = 2048, NPT = NB * SEQ, DB = 8, NTOK = NPT + DB;
constexpr int PAST = 16384, PAGE = 128, NPAGES = 128;
constexpr int NG = 4, HPG = 4, DH = 64;
constexpr int DIN = 9792, DFF = 8192;
constexpr int C_Q = 0, C_KV = 1024, C_G = 2560, C_QL = 2608, C_KL = 3120, C_VL = 3632, C_RL = 4656, C_LR = 5680, C_BR = 5696;
constexpr float EPS = 1e-6f;
constexpr size_t OFF_Y = 0, OFF_YS = (size_t)NPT * DM, OFF_PCK = OFF_YS + (size_t)DB * DM;
constexpr size_t SZ_PROW = (size_t)NPT * 256;
constexpr size_t OFF_PWK = OFF_PCK + 4 * SZ_PROW, SZ_PWIN = (size_t)NB * 512 * 256;
constexpr size_t OFF_PGLA = OFF_PWK + 2 * SZ_PWIN, SZ_PGLA = (size_t)NB * 4 * 128 * 256;
constexpr size_t OFF_SCK = OFF_PGLA + SZ_PGLA, SZ_SROW = (size_t)DB * 256;
constexpr size_t OFF_SWK = OFF_SCK + 4 * SZ_SROW, SZ_SWIN = (size_t)DB * 512 * 256;
constexpr size_t OFF_SGLA = OFF_SWK + 2 * SZ_SWIN, SZ_SGLA = (size_t)DB * 4 * 128 * 256;
constexpr size_t OUT_TOTAL = OFF_SGLA + SZ_SGLA;
static_assert(OUT_TOTAL == 29908992, "output size");

__device__ __forceinline__ bf16_t f2bf(float f) { unsigned u = __builtin_bit_cast(unsigned, f); return (bf16_t)((u + 0x7fffu + ((u >> 16) & 1u)) >> 16); }
__device__ __forceinline__ float bf2f(bf16_t h) { return __builtin_bit_cast(float, (unsigned)h << 16); }
__device__ __forceinline__ float sigmoidf_(float x) { return 1.f / (1.f + __expf(-x)); }
__device__ __forceinline__ float siluf_(float x) { return x / (1.f + __expf(-x)); }
__device__ __forceinline__ float gelu_tanh(float x) { const float u = 0.7978845608028654f * (x + 0.044715f * x * x * x); return 0.5f * x * (1.f + tanhf(u)); }
__device__ __forceinline__ float logsigmoidf_(float x) { return fminf(x, 0.f) - log1pf(__expf(-fabsf(x))); }
__device__ __forceinline__ float wave_sum(float v) {
#pragma unroll
    for (int o = 1; o < 64; o <<= 1) v += __shfl_xor(v, o);
    return v;
}
__device__ __forceinline__ float wave_max(float v) {
#pragma unroll
    for (int o = 1; o < 64; o <<= 1) v = fmaxf(v, __shfl_xor(v, o));
    return v;
}

struct Params {
    const float *x_prompt, *x_sample, *cck, *ccv, *csk, *csv, *cwk, *cwv, *state;
    const int* page_table;
    const float *norm1_g, *w_in, *b_gate, *pe_k, *pe_v, *w1k, *w2k, *w1v, *w2v, *w_a2, *b_a, *gnorm, *w_br_a, *w_br_b, *w_o, *norm2_g, *w_up, *w_down, *norm_f;
    float* out;
    bf16_t *XB, *QN, *KV6, *GQ, *GK, *GV, *GR, *BR, *KCMP_P, *VCMPT_P, *KCMP_S, *VCMP_S, *OA, *OB, *MB, *X1B, *HF;
    float *RSTD1, *GATE, *LR, *TMP, *X1, *RSTD2;
    bf16_t *WIN_T, *WBRA_T, *WBRB_T, *WO_T, *WUP_T, *WDN_T;
    float *SUMSQ2, *SUMSQ3;
    unsigned* CTL;
    bf16_t *W1T, *W2TG; float *BIAS1, *AB_S, *AB_P;
    float *UT, *DEC, *BCG; bf16_t* SNT;
    bf16_t *VTS, *VTW;
};

__device__ __forceinline__ float xval(const Params& p, int row, int n) { return row < NPT ? p.x_prompt[(size_t)row * DM + n] : p.x_sample[(size_t)(row - NPT) * DM + n]; }

__device__ __forceinline__ void proj_store(const Params& p, int row, int n, float v) {
    if (n < C_KV) p.QN[(size_t)row * 1024 + n] = f2bf(v * 0.125f);
    else if (n < C_G) {
        const int c = n - C_KV; p.KV6[(size_t)row * 1536 + c] = f2bf(v); const int j = c >> 8, cc = c & 255;
        if (row < NPT) { const int b = row >> 11, t = row & 2047;
            if (j < 4) p.out[OFF_PCK + j * SZ_PROW + (size_t)row * 256 + cc] = v;
            else if (t >= 1536) p.out[OFF_PWK + (j - 4) * SZ_PWIN + ((size_t)b * 512 + t - 1536) * 256 + cc] = v; }
        else { const int b = row - NPT;
            if (j < 4) p.out[OFF_SCK + j * SZ_SROW + (size_t)b * 256 + cc] = v;
            else p.out[OFF_SWK + (j - 4) * SZ_SWIN + ((size_t)b * 512 + 511) * 256 + cc] = v; }
    }
    else if (n < C_QL) { const int c = n - C_G; p.GATE[(size_t)row * 48 + c] = sigmoidf_(v + p.b_gate[c]); }
    else if (n < C_KL) p.GQ[(size_t)row * 512 + (n - C_QL)] = f2bf(v * 0.08838834764831845f);
    else if (n < C_VL) p.GK[(size_t)row * 512 + (n - C_KL)] = f2bf(v);
    else if (n < C_RL) p.GV[(size_t)row * 1024 + (n - C_VL)] = f2bf(v);
    else if (n < C_LR) p.GR[(size_t)row * 1024 + (n - C_RL)] = f2bf(siluf_(v));
    else if (n < C_BR) p.LR[(size_t)row * 16 + (n - C_LR)] = v;
    else p.BR[(size_t)row * 4096 + (n - C_BR)] = f2bf(sigmoidf_(v));
}

__global__ void __launch_bounds__(256) k_prep_x(Params p) {
    const int lane = threadIdx.x & 63, row = blockIdx.x * 4 + (threadIdx.x >> 6);
    if (row >= NTOK) return;
    const float* xr = row < NPT ? p.x_prompt + (size_t)row * DM : p.x_sample + (size_t)(row - NPT) * DM;
    float ss = 0.f;
    for (int i = lane; i < DM; i += 64) { const float v = xr[i]; ss += v * v; p.XB[(size_t)row * DM + i] = f2bf(v); }
    ss = wave_sum(ss);
    if (lane == 0) p.RSTD1[row] = rsqrtf(ss * (1.f / DM) + EPS);
}
__global__ void __launch_bounds__(256) k_copy_swin(Params p) {
    const size_t i = (size_t)blockIdx.x * 256 + threadIdx.x;
    if (i >= (size_t)DB * 511 * 256) return;
    const int c = (int)(i & 255); const int r = (int)((i >> 8) % 511); const int b = (int)((i >> 8) / 511);
    p.out[OFF_SWK + ((size_t)b * 512 + r) * 256 + c] = p.cwk[((size_t)b * 512 + r + 1) * 256 + c];
    p.out[OFF_SWK + SZ_SWIN + ((size_t)b * 512 + r) * 256 + c] = p.cwv[((size_t)b * 512 + r + 1) * 256 + c];
}
__global__ void __launch_bounds__(256) k_rms_rows(const float* X, float* rstd, int nrows) {
    const int lane = threadIdx.x & 63, row = blockIdx.x * 4 + (threadIdx.x >> 6);
    if (row >= nrows) return;
    float ss = 0.f;
    for (int i = lane; i < DM; i += 64) { const float v = X[(size_t)row * DM + i]; ss += v * v; }
    ss = wave_sum(ss);
    if (lane == 0) rstd[row] = rsqrtf(ss * (1.f / DM) + EPS);
}
__global__ void __launch_bounds__(256) k_final_norm(Params p) {
    const int lane = threadIdx.x & 63, row = blockIdx.x * 4 + (threadIdx.x >> 6);
    if (row >= NTOK) return;
    float* yr = row < NPT ? p.out + OFF_Y + (size_t)row * DM : p.out + OFF_YS + (size_t)(row - NPT) * DM;
    float ss = 0.f;
    for (int i = lane; i < DM; i += 64) { const float v = yr[i]; ss += v * v; }
    ss = wave_sum(ss);
    const float r = rsqrtf(ss * (1.f / DM) + EPS);
    for (int i = lane; i < DM; i += 64) yr[i] = yr[i] * r * p.norm_f[i];
}

template <class AF, class BF, class EF>
__global__ void __launch_bounds__(256) k_gemm_naive(int m_off, int M, int N, int K, AF af, BF bf, EF ef) {
    __shared__ float As[16][68], Bs[16][68];
    const int tid = threadIdx.x, tx = tid & 15, ty = tid >> 4, m0 = m_off + blockIdx.y * 64, n0 = blockIdx.x * 64;
    float acc[4][4];
#pragma unroll
    for (int i = 0; i < 4; ++i)
#pragma unroll
        for (int j = 0; j < 4; ++j) acc[i][j] = 0.f;
    for (int k0 = 0; k0 < K; k0 += 16) {
#pragma unroll
        for (int i = 0; i < 4; ++i) { const int idx = tid + 256 * i, r = idx >> 4, kk = idx & 15; As[kk][r] = (m0 + r < M) ? af(m0 + r, k0 + kk) : 0.f; }
#pragma unroll
        for (int i = 0; i < 4; ++i) { const int idx = tid + 256 * i, kk = idx >> 6, c = idx & 63; Bs[kk][c] = (n0 + c < N) ? bf(k0 + kk, n0 + c) : 0.f; }
        __syncthreads();
#pragma unroll
        for (int kk = 0; kk < 16; ++kk) {
            float a[4], b[4];
#pragma unroll
            for (int i = 0; i < 4; ++i) { a[i] = As[kk][ty * 4 + i]; b[i] = Bs[kk][tx * 4 + i]; }
#pragma unroll
            for (int i = 0; i < 4; ++i)
#pragma unroll
                for (int j = 0; j < 4; ++j) acc[i][j] += a[i] * b[j];
        }
        __syncthreads();
    }
#pragma unroll
    for (int i = 0; i < 4; ++i)
#pragma unroll
        for (int j = 0; j < 4; ++j) { const int r = m0 + ty * 4 + i, c = n0 + tx * 4 + j; if (r < M && c < N) ef(r, c, acc[i][j]); }
}
struct AF_x_g1 { Params p; __device__ float operator()(int r, int k) const { return xval(p, r, k) * p.norm1_g[k]; } };
struct BF_rowmajor { const float* W; long ld; __device__ float operator()(int k, int n) const { return W[(size_t)k * ld + n]; } };
struct EF_proj { Params p; __device__ void operator()(int r, int n, float acc) const { proj_store(p, r, n, acc * p.RSTD1[r]); } };
struct AF_bf { const bf16_t* A; long ld; __device__ float operator()(int r, int k) const { return bf2f(A[(size_t)r * ld + k]); } };
struct EF_bra { Params p; __device__ void operator()(int r, int n, float acc) const { p.TMP[(size_t)r * DM + n] = acc * bf2f(p.BR[(size_t)r * 4096 + n]); } };
struct EF_brb { Params p; __device__ void operator()(int r, int n, float acc) const { p.MB[(size_t)r * DM + n] = f2bf(p.TMP[(size_t)r * DM + n] + acc * bf2f(p.BR[(size_t)r * 4096 + 2048 + n])); } };
struct EF_wo { Params p; __device__ void operator()(int r, int n, float acc) const { const float x1 = xval(p, r, n) + acc; p.X1[(size_t)r * DM + n] = x1; p.X1B[(size_t)r * DM + n] = f2bf(x1); } };
struct AF_x1_g2 { Params p; __device__ float operator()(int r, int k) const { return bf2f(p.X1B[(size_t)r * DM + k]) * p.norm2_g[k]; } };
struct EF_up { Params p; __device__ void operator()(int r, int n, float acc) const { const float v = fmaxf(acc * p.RSTD2[r], 0.f); p.HF[(size_t)r * DFF + n] = f2bf(v * v); } };
struct EF_down { Params p; __device__ void operator()(int r, int n, float acc) const { const float x2 = p.X1[(size_t)r * DM + n] + acc;
    if (r < NPT) p.out[OFF_Y + (size_t)r * DM + n] = x2; else p.out[OFF_YS + (size_t)(r - NPT) * DM + n] = x2; } };

__global__ void __launch_bounds__(128) k_compress_naive(Params p, int is_s) {
    const int n_cmp = is_s ? 1023 : 127, n_pad = is_s ? 1024 : 128;
    const int kv = blockIdx.y, tid = threadIdx.x;
    const int i = blockIdx.x % n_pad, bg = blockIdx.x / n_pad, b = bg >> 2, g = bg & 3;
    __shared__ float blk[2048]; __shared__ float hid[128];
    if (i >= n_cmp) {
        if (tid < 64) { if (is_s) { (kv ? p.VCMP_S : p.KCMP_S)[((size_t)bg * 1024 + i) * 64 + tid] = 0; }
                        else { if (kv) p.VCMPT_P[((size_t)bg * 64 + tid) * 128 + i] = 0; else p.KCMP_P[((size_t)bg * 128 + i) * 64 + tid] = 0; } }
        return;
    }
    const float* pe = kv ? p.pe_v : p.pe_k; const float* w1 = kv ? p.w1v : p.w1k; const float* w2 = kv ? p.w2v : p.w2k;
    for (int e = tid; e < 2048; e += 128) { const int l = e >> 6, d = e & 63; const int pos = 16 * i + l; float v;
        if (is_s) { const int page = p.page_table[b * NPAGES + (pos >> 7)]; v = (kv ? p.ccv : p.cck)[(((size_t)page * PAGE + (pos & 127)) * 4 + g) * 64 + d]; }
        else v = bf2f(p.KV6[((size_t)b * SEQ + pos) * 1536 + kv * 256 + g * 64 + d]);
        blk[e] = v + pe[e]; }
    __syncthreads();
    float h = 0.f;
    for (int k = 0; k < 2048; ++k) h += blk[k] * w1[(size_t)k * 128 + tid];
    hid[tid] = gelu_tanh(h);
    __syncthreads();
    if (tid < 64) { float o = 0.f; for (int j = 0; j < 128; ++j) o += hid[j] * w2[j * 64 + tid];
        if (is_s) (kv ? p.VCMP_S : p.KCMP_S)[((size_t)bg * 1024 + i) * 64 + tid] = f2bf(o);
        else { if (kv) p.VCMPT_P[((size_t)bg * 64 + tid) * 128 + i] = f2bf(o); else p.KCMP_P[((size_t)bg * 128 + i) * 64 + tid] = f2bf(o); } }
}

struct RowRef { const float* pf; const bf16_t* pb; };
__device__ __forceinline__ float rr_get(const RowRef& r, int d) { return r.pf ? r.pf[d] : bf2f(r.pb[d]); }

template <class KF, class VF>
__device__ __forceinline__ void attend_naive(int nk, KF keyf, VF valf, const float (*q)[64], float (*sc)[1088], float (*oacc)[64], const float* gate3, int gsel, int tid) {
    const int lane = tid & 63, wv = tid >> 6;
    for (int kk = tid; kk < nk; kk += 256) { bool valid; const RowRef r = keyf(kk, valid);
        if (valid) { float d0 = 0.f, d1 = 0.f, d2 = 0.f, d3 = 0.f;
            for (int d = 0; d < 64; ++d) { const float kx = rr_get(r, d); d0 += q[0][d] * kx; d1 += q[1][d] * kx; d2 += q[2][d] * kx; d3 += q[3][d] * kx; }
            sc[0][kk] = d0; sc[1][kk] = d1; sc[2][kk] = d2; sc[3][kk] = d3; }
        else { sc[0][kk] = -INFINITY; sc[1][kk] = -INFINITY; sc[2][kk] = -INFINITY; sc[3][kk] = -INFINITY; } }
    __syncthreads();
    {
        float m = -INFINITY; for (int kk = lane; kk < nk; kk += 64) m = fmaxf(m, sc[wv][kk]);
        m = wave_max(m);
        float s = 0.f;
        for (int kk = lane; kk < nk; kk += 64) { const float x = sc[wv][kk]; const float e = (x == -INFINITY) ? 0.f : __expf(x - m); sc[wv][kk] = e; s += e; }
        s = wave_sum(s);
        const float inv = s > 0.f ? 1.f / s : 0.f;
        for (int kk = lane; kk < nk; kk += 64) sc[wv][kk] *= inv;
    }
    __syncthreads();
    {
        float o = 0.f;
        for (int kk = 0; kk < nk; ++kk) { const float pr = sc[wv][kk]; if (pr != 0.f) o += pr * valf(kk, lane); }
        oacc[wv][lane] += gate3[wv * 3 + gsel] * o;
    }
    __syncthreads();
}

__device__ __forceinline__ void nsa_naive_body(const Params& p, int row, int g, int tid, float (*q)[64], float (*sc)[1088], float (*oacc)[64], float* gate3, float* score, int* selidx) {
    const bool is_s = row >= NPT; const int b = is_s ? row - NPT : row >> 11, t = is_s ? 0 : row & 2047;
    const int start = is_s ? PAST : 0, pos = start + t, rowbase = is_s ? NPT + b : b * SEQ;
    const int n_cmp = is_s ? 1023 : 127, n_slc = is_s ? 257 : 32;
    { const int hd = tid >> 6, d = tid & 63; q[hd][d] = bf2f(p.QN[(size_t)row * 1024 + (g * 4 + hd) * 64 + d]); oacc[hd][d] = 0.f; }
    if (tid < 12) gate3[tid] = p.GATE[(size_t)row * 48 + g * 12 + tid];
    __syncthreads();
    const int bg = b * 4 + g;
    const bf16_t* kc = is_s ? p.KCMP_S + (size_t)bg * 1024 * 64 : p.KCMP_P + (size_t)bg * 128 * 64;
    const bf16_t* vc_s = p.VCMP_S + (size_t)bg * 1024 * 64; const bf16_t* vc_p = p.VCMPT_P + (size_t)bg * 64 * 128;
    auto kf_c = [&](int kk, bool& valid) { valid = (16 * kk + 31 <= pos); return RowRef{nullptr, kc + (size_t)kk * 64}; };
    auto vf_c = [&](int kk, int d) { return is_s ? bf2f(vc_s[(size_t)kk * 64 + d]) : bf2f(vc_p[(size_t)d * 128 + kk]); };
    attend_naive(n_cmp, kf_c, vf_c, q, sc, oacc, gate3, 0, tid);
    for (int j = tid; j < n_slc; j += 256) { float s = 0.f;
        for (int i = 4 * j - 1; i <= 4 * j + 3; ++i) if (i >= 0 && i < n_cmp) s += (sc[0][i] + sc[1][i]) + (sc[2][i] + sc[3][i]);
        score[j] = (j * 64 <= pos) ? s + ((j == 0 || j == pos / 64) ? 1e4f : 0.f) : -1e30f; }
    __syncthreads();
    for (int j = tid; j < n_slc; j += 256) { const float sj = score[j]; int rank = 0;
        for (int j2 = 0; j2 < n_slc; ++j2) { const float s2 = score[j2]; rank += (s2 > sj || (s2 == sj && j2 < j)) ? 1 : 0; }
        if (rank < 16) selidx[rank] = j; }
    __syncthreads();
    auto row_at = [&](int kp, int which) -> RowRef {
        if (kp < start) {
            if (which < 4) { const int page = p.page_table[b * NPAGES + (kp >> 7)]; const float* c = (which == 2) ? p.csk : p.csv; return RowRef{c + (((size_t)page * PAGE + (kp & 127)) * 4 + g) * 64, nullptr}; }
            const float* c = (which == 4) ? p.cwk : p.cwv; return RowRef{c + (((size_t)b * 512 + (kp - (PAST - 512))) * 4 + g) * 64, nullptr};
        }
        return RowRef{nullptr, p.KV6 + (size_t)(rowbase + kp - start) * 1536 + which * 256 + g * 64};
    };
    auto kf_s = [&](int kk, bool& valid) { const int kp = selidx[kk >> 6] * 64 + (kk & 63); valid = (kp <= pos); return valid ? row_at(kp, 2) : RowRef{nullptr, nullptr}; };
    auto vf_s = [&](int kk, int d) { const int kp = selidx[kk >> 6] * 64 + (kk & 63); return rr_get(row_at(kp, 3), d); };
    attend_naive(1024, kf_s, vf_s, q, sc, oacc, gate3, 1, tid);
    auto kf_w = [&](int kk, bool& valid) { const int kp = pos - 512 + kk; valid = (kp >= 0); return valid ? row_at(kp, 4) : RowRef{nullptr, nullptr}; };
    auto vf_w = [&](int kk, int d) { const int kp = pos - 512 + kk; return rr_get(row_at(kp, 5), d); };
    attend_naive(513, kf_w, vf_w, q, sc, oacc, gate3, 2, tid);
    { const int hd = tid >> 6, d = tid & 63; p.OA[(size_t)row * 1024 + (g * 4 + hd) * 64 + d] = f2bf(oacc[hd][d]); }
}
__global__ void __launch_bounds__(256) k_nsa_naive(Params p, int row0) {
    __shared__ float q[4][64]; __shared__ float sc[4][1088]; __shared__ float oacc[4][64]; __shared__ float gate3[12];
    __shared__ float score[260]; __shared__ int selidx[16];
    nsa_naive_body(p, row0 + blockIdx.x, blockIdx.y, threadIdx.x, q, sc, oacc, gate3, score, selidx);
}

__global__ void __launch_bounds__(512) k_gla_naive(Params p, int is_s) {
    const int b = blockIdx.x >> 2, h = blockIdx.x & 3, tid = threadIdx.x, e = tid & 255, half = tid >> 8;
    const int T = is_s ? 1 : SEQ, rowbase = is_s ? NPT + b : b * SEQ;
    __shared__ float a_s[128], q_s[128], k_s[128], part[2][256], red[8];
    float S[64];
#pragma unroll
    for (int dd = 0; dd < 64; ++dd) S[dd] = is_s ? p.state[(((size_t)b * 4 + h) * 128 + half * 64 + dd) * 256 + e] : 0.f;
    for (int t = 0; t < T; ++t) {
        const int row = rowbase + t;
        if (tid < 128) { float x = p.b_a[h * 128 + tid];
            for (int r = 0; r < 16; ++r) x += p.LR[(size_t)row * 16 + r] * p.w_a2[r * 512 + h * 128 + tid];
            a_s[tid] = __expf(logsigmoidf_(x) * (1.f / 16.f));
            q_s[tid] = bf2f(p.GQ[(size_t)row * 512 + h * 128 + tid]); k_s[tid] = bf2f(p.GK[(size_t)row * 512 + h * 128 + tid]); }
        const float v = bf2f(p.GV[(size_t)row * 1024 + h * 256 + e]);
        __syncthreads();
        float po = 0.f;
#pragma unroll
        for (int dd = 0; dd < 64; ++dd) { const int d = half * 64 + dd; S[dd] = a_s[d] * S[dd] + k_s[d] * v; po += q_s[d] * S[dd]; }
        part[half][e] = po;
        __syncthreads();
        float o = 0.f;
        if (tid < 256) { o = part[0][e] + part[1][e]; const float ss = wave_sum(o * o); if ((tid & 63) == 0) red[tid >> 6] = ss; }
        __syncthreads();
        if (tid < 256) { const float ss = (red[0] + red[1]) + (red[2] + red[3]); const float r = rsqrtf(ss * (1.f / 256.f) + EPS);
            p.OB[(size_t)row * 1024 + h * 256 + e] = f2bf(o * r * p.gnorm[e] * bf2f(p.GR[(size_t)row * 1024 + h * 256 + e])); }
    }
    float* so = p.out + (is_s ? OFF_SGLA : OFF_PGLA);
#pragma unroll
    for (int dd = 0; dd < 64; ++dd) so[(((size_t)b * 4 + h) * 128 + half * 64 + dd) * 256 + e] = S[dd];
}

#define REP_MASK 0
#define PROBE_PHASE -1
#define PROBE_A -1
#define PROBE_B -1
#define PROBE_BID 0
#define LATE_PRO 11520
#define GAS __attribute__((address_space(1)))
#define LAS __attribute__((address_space(3)))
typedef unsigned v4u __attribute__((ext_vector_type(4)));
typedef unsigned v2u __attribute__((ext_vector_type(2)));
#define LDS_WAIT() asm volatile("s_waitcnt lgkmcnt(0)" ::: "memory")
#define VM_WAIT() asm volatile("s_waitcnt vmcnt(0)" ::: "memory")
#define LDS_BARRIER() do { asm volatile("s_waitcnt lgkmcnt(0)" ::: "memory"); __builtin_amdgcn_s_barrier(); asm volatile("" ::: "memory"); } while (0)
typedef float f32x2_t __attribute__((ext_vector_type(2)));
typedef __bf16 bf16x2_t __attribute__((ext_vector_type(2)));
__device__ __forceinline__ unsigned cvtpk(float lo, float hi) { f32x2_t v = {lo, hi}; bf16x2_t b = __builtin_convertvector(v, bf16x2_t); return __builtin_bit_cast(unsigned, b); }
__device__ __forceinline__ unsigned pk2(float lo, float hi) { return cvtpk(lo, hi); }
__device__ __forceinline__ float sigmoid_fast(float x) { return __builtin_amdgcn_rcpf(1.f + __expf(-x)); }
__device__ __forceinline__ float silu_fast(float x) { return x * __builtin_amdgcn_rcpf(1.f + __expf(-x)); }
__device__ __forceinline__ float gelu_fast(float x) { return x * __builtin_amdgcn_rcpf(1.f + __expf(-1.5957691216057308f * (x + 0.044715f * x * x * x))); }
constexpr int NIN_PAD = 9984;
__host__ __device__ __forceinline__ int in_colmap(int n) {
    if (n < 2560) return n; if (n < 3072) return C_QL + (n - 2560); if (n < 3584) return C_KL + (n - 3072); if (n < 4608) return C_VL + (n - 3584);
    if (n < 5632) return C_RL + (n - 4608); if (n < 9728) return C_BR + (n - 5632); if (n < 9776) return C_G + (n - 9728); if (n < 9792) return C_LR + (n - 9776); return -1;
}
namespace pg8 {
#define PG8_LAS __attribute__((address_space(3)))
typedef unsigned short bf16_t;
typedef short bf16x8 __attribute__((ext_vector_type(8)));
typedef float f32x4 __attribute__((ext_vector_type(4)));
typedef unsigned u32x4 __attribute__((ext_vector_type(4)));
constexpr int BM = 256, BK = 64, HALF = 128, HTB = HALF * BK * 2  , STAGE_BYTES = 8 * HTB, NXCD = 8, WGM = 8;

__host__ __device__ __forceinline__ int lds_byte(int r, int c) { const int st = (r >> 4) * 2 + (c >> 5), rr = r & 15, cc = c & 31, ob = rr * 64 + cc * 2; return st * 1024 + (ob ^ (((ob >> 9) & 1) << 5)); }
__host__ __device__ __forceinline__ void stage_rc(int b, int& R, int& C) { const int st = b / 1024, sb = b % 1024, swz = sb ^ (((sb >> 9) & 1) << 5); R = (st >> 1) * 16 + swz / 64; C = (st & 1) * 32 + (swz % 64) / 2; }
__host__ __device__ __forceinline__ int perm32(int rho) { const int n = rho >> 4, i = rho & 15; return 8 * (i >> 2) + 4 * n + (i & 3); }

struct Unit { int pm, pn; };
struct Gemm { const bf16_t* A; const bf16_t* Bt; int M, N, K; };

struct StaticOrder {
    int nM, nN, nwg, G, c;
    __host__ __device__ void init(int M, int N, int G_, int c_) { nM = M / BM; nN = N / BM; nwg = nM * nN; G = G_; c = c_; }
    __host__ __device__ bool next(int i, Unit& u) const {
        const long L = (long)i * G + c; if (L >= nwg) return false;
        int wgid = (int)L; { const int q = nwg / NXCD, r = nwg % NXCD, xcd = wgid % NXCD, off = wgid / NXCD; wgid = (xcd < r ? xcd * (q + 1) : r * (q + 1) + (xcd - r) * q) + off; }
        const int nig = WGM * nN, gid = wgid / nig, fm = gid * WGM, gsz = (nM - fm) < WGM ? (nM - fm) : WGM;
        u.pm = fm + ((wgid % nig) % gsz); u.pn = (wgid % nig) / gsz; return true;
    }
    __device__ __forceinline__ void a_ready(const Unit&) const {}
    __device__ __forceinline__ void done(const Unit&) const {}
};

template <class Epi, class Sched, bool ALIGN_EPI = false, bool SP2 = false>
__device__ __forceinline__ void gemm_phase(PG8_LAS unsigned char* lds, const Gemm g, const Sched& S, const Epi& E) {
    const int tid = threadIdx.x, wid = __builtin_amdgcn_readfirstlane(tid >> 6), lane = tid & 63, wr = wid >> 2, wc = wid & 3, fr = lane & 15, fq = lane >> 4;
    const int K = g.K, nt = K / BK;
    unsigned voffA[2], voffB[2];
#pragma unroll
    for (int i = 0; i < 2; ++i) { int R, C; stage_rc(tid * 16 + i * 8192, R, C); const int Rb = Epi::PERM ? ((R & ~31) + perm32(R & 31)) : R;
        voffA[i] = (unsigned)(R * K + C) * 2u; voffB[i] = (unsigned)(Rb * K + C) * 2u; }
    const size_t kstep = (size_t)(BK * 2);
    const size_t hstep = (size_t)HALF * K * 2;
    const size_t tstep = 2 * hstep;
    const unsigned ldsw = (unsigned)wid * 1024u;
    const int aoff = lds_byte(wr * 64 + fr, fq * 8), boff = lds_byte(wc * 32 + fr, fq * 8);
#define PG8_SA(b, h) (((b) * 2 + (h)) * HTB)
#define PG8_SB(b, h) ((4 + (b) * 2 + (h)) * HTB)
#define PG8_STAGE(bufoff, gbase, voff) do { _Pragma("unroll") for (int _i = 0; _i < 2; ++_i) \
        __builtin_amdgcn_global_load_lds((const unsigned*)((const char*)(gbase) + (voff)[_i]), (PG8_LAS unsigned*)(lds + (bufoff) + ldsw + _i * 8192), 16, 0, 0); } while (0)
#define PG8_LDA(dst, b, h) do { _Pragma("unroll") for (int m = 0; m < 4; ++m) _Pragma("unroll") for (int k = 0; k < 2; ++k) dst[m][k] = *(const PG8_LAS bf16x8*)(lds + PG8_SA(b, h) + aoff + m * 2048 + k * 1024); } while (0)
#define PG8_LDB(dst, b, h) do { _Pragma("unroll") for (int n = 0; n < 2; ++n) _Pragma("unroll") for (int k = 0; k < 2; ++k) dst[n][k] = *(const PG8_LAS bf16x8*)(lds + PG8_SB(b, h) + boff + n * 2048 + k * 1024); } while (0)
#define PG8_MMA(ai, bj, At, Bt) do { __builtin_amdgcn_s_setprio(1); _Pragma("unroll") for (int m = 0; m < 4; ++m) _Pragma("unroll") for (int n = 0; n < 2; ++n) _Pragma("unroll") for (int k = 0; k < 2; ++k) \
        acc[ai][bj][m][n] = __builtin_amdgcn_mfma_f32_16x16x32_bf16(Bt[n][k], At[m][k], acc[ai][bj][m][n], 0, 0, 0); __builtin_amdgcn_s_setprio(0); } while (0)
#define PG8_WAIT_V(n) asm volatile("s_waitcnt vmcnt(" #n ")" ::: "memory")
#define PG8_WAIT_L(n) asm volatile("s_waitcnt lgkmcnt(" #n ")" ::: "memory")
#define PG8_BAR __builtin_amdgcn_s_barrier()
#define PG8_SCHED __builtin_amdgcn_sched_barrier(0)
    Unit cur, nxt; int ui = 0;
    if (!S.next(0, cur)) return;
    if (PROBE_A >= 0 && threadIdx.x == 0) *(PG8_LAS unsigned long long*)(lds + 135168 + 8 * 0) = __builtin_amdgcn_s_memrealtime();
    f32x4 acc[2][2][4][2];
#pragma unroll
    for (int a = 0; a < 2; ++a)
#pragma unroll
        for (int b = 0; b < 2; ++b)
#pragma unroll
            for (int m = 0; m < 4; ++m)
#pragma unroll
                for (int n = 0; n < 2; ++n) acc[a][b][m][n] = (f32x4){0.f, 0.f, 0.f, 0.f};
    bf16x8 At[4][2], B0[2][2], B1[2][2];
    const char* cA = (const char*)g.A + (size_t)cur.pm * tstep; const char* cB = (const char*)g.Bt + (size_t)cur.pn * tstep;
    S.a_ready(cur);
    if constexpr (SP2) {
        PG8_STAGE(PG8_SB(0, 0), cB, voffB); PG8_STAGE(PG8_SB(0, 1), cB + hstep, voffB); PG8_STAGE(PG8_SA(0, 0), cA, voffA); PG8_STAGE(PG8_SA(0, 1), cA + hstep, voffA);
        if (wr == 1) PG8_BAR;
        PG8_WAIT_V(2); PG8_BAR;
        PG8_STAGE(PG8_SB(1, 0), cB + kstep, voffB); PG8_STAGE(PG8_SA(1, 0), cA + kstep, voffA); PG8_STAGE(PG8_SB(1, 1), cB + hstep + kstep, voffB);
        PG8_WAIT_V(6); PG8_BAR;
    } else {
        PG8_STAGE(PG8_SB(0, 0), cB, voffB); PG8_STAGE(PG8_SA(0, 0), cA, voffA); PG8_STAGE(PG8_SB(0, 1), cB + hstep, voffB); PG8_STAGE(PG8_SA(0, 1), cA + hstep, voffA);
        if (wr == 1) PG8_BAR;
        PG8_WAIT_V(4); PG8_BAR;
        PG8_STAGE(PG8_SB(1, 0), cB + kstep, voffB); PG8_STAGE(PG8_SA(1, 0), cA + kstep, voffA); PG8_STAGE(PG8_SB(1, 1), cB + hstep + kstep, voffB);
        PG8_WAIT_V(6); PG8_BAR;
    }
    for (;;) {
        const bool has_next = S.next(ui + 1, nxt);
        const char* nA = has_next ? (const char*)g.A + (size_t)nxt.pm * tstep : cA; const char* nB = has_next ? (const char*)g.Bt + (size_t)nxt.pn * tstep : cB;
        for (int t = 0; t < nt; t += 2) {
            const bool last = (t == nt - 2);
            const char* a1 = cA + (size_t)(t + 1) * kstep;
            const char* a2 = last ? nA : cA + (size_t)(t + 2) * kstep; const char* b2 = last ? nB : cB + (size_t)(t + 2) * kstep;
            const char* a3 = a2 + kstep; const char* b3 = b2 + kstep;
            if (last && has_next) S.a_ready(nxt);
            if constexpr (SP2) {
            PG8_LDB(B0, 0, 0); PG8_LDB(B1, 0, 1); PG8_SCHED; PG8_LDA(At, 0, 0); PG8_STAGE(PG8_SA(1, 1), a1 + hstep, voffA);
            PG8_WAIT_V(8); PG8_WAIT_L(0); PG8_BAR; PG8_MMA(0, 0, At, B0); PG8_MMA(0, 1, At, B1); PG8_BAR; PG8_SCHED;
            PG8_LDA(At, 0, 1); PG8_STAGE(PG8_SB(0, 0), b2, voffB); PG8_STAGE(PG8_SB(0, 1), b2 + hstep, voffB); PG8_STAGE(PG8_SA(0, 0), a2, voffA);
            PG8_WAIT_V(8); PG8_WAIT_L(0); PG8_BAR; PG8_MMA(1, 0, At, B0); PG8_MMA(1, 1, At, B1); PG8_BAR; PG8_SCHED;
            PG8_LDB(B0, 1, 0); PG8_LDB(B1, 1, 1); PG8_SCHED; PG8_LDA(At, 1, 0); PG8_STAGE(PG8_SA(0, 1), a2 + hstep, voffA);
            PG8_WAIT_V(8); PG8_WAIT_L(0); PG8_BAR; PG8_MMA(0, 0, At, B0); PG8_MMA(0, 1, At, B1); PG8_BAR; PG8_SCHED;
            PG8_LDA(At, 1, 1); PG8_STAGE(PG8_SB(1, 0), b3, voffB); PG8_STAGE(PG8_SB(1, 1), b3 + hstep, voffB); PG8_STAGE(PG8_SA(1, 0), a3, voffA);
            PG8_WAIT_V(8); PG8_WAIT_L(0); PG8_BAR; PG8_MMA(1, 0, At, B0); PG8_MMA(1, 1, At, B1); PG8_BAR; PG8_SCHED;
            } else {
            PG8_LDB(B0, 0, 0); PG8_SCHED; PG8_LDA(At, 0, 0); PG8_STAGE(PG8_SA(1, 1), a1 + hstep, voffA);
            PG8_WAIT_L(8); PG8_BAR; PG8_WAIT_L(0); PG8_MMA(0, 0, At, B0); PG8_BAR; PG8_SCHED;
            PG8_LDB(B1, 0, 1); PG8_STAGE(PG8_SB(0, 0), b2, voffB);
            PG8_BAR; PG8_WAIT_L(0); PG8_MMA(0, 1, At, B1); PG8_BAR;
            PG8_LDA(At, 0, 1); PG8_STAGE(PG8_SA(0, 0), a2, voffA);
            PG8_BAR; PG8_WAIT_L(0); PG8_MMA(1, 0, At, B0); PG8_BAR; PG8_SCHED;
            PG8_STAGE(PG8_SB(0, 1), b2 + hstep, voffB);
            PG8_WAIT_V(6); PG8_BAR; PG8_MMA(1, 1, At, B1); PG8_BAR;
            PG8_LDB(B0, 1, 0); PG8_SCHED; PG8_LDA(At, 1, 0); PG8_STAGE(PG8_SA(0, 1), a2 + hstep, voffA);
            PG8_WAIT_L(8); PG8_BAR; PG8_WAIT_L(0); PG8_MMA(0, 0, At, B0); PG8_BAR; PG8_SCHED;
            PG8_LDB(B1, 1, 1); PG8_STAGE(PG8_SB(1, 0), b3, voffB);
            PG8_BAR; PG8_WAIT_L(0); PG8_MMA(0, 1, At, B1); PG8_BAR;
            PG8_LDA(At, 1, 1); PG8_STAGE(PG8_SA(1, 0), a3, voffA);
            PG8_BAR; PG8_WAIT_L(0); PG8_MMA(1, 0, At, B0); PG8_BAR; PG8_SCHED;
            PG8_STAGE(PG8_SB(1, 1), b3 + hstep, voffB);
            PG8_WAIT_V(6); PG8_BAR; PG8_MMA(1, 1, At, B1); PG8_BAR;
            }
        }
        if (PROBE_A >= 0 && threadIdx.x == 0) *(PG8_LAS unsigned long long*)(lds + 135168 + 8 * 1) = __builtin_amdgcn_s_memrealtime();
        if constexpr (ALIGN_EPI) { if (wr == 0) PG8_BAR; }
        if (PROBE_A >= 0 && threadIdx.x == 0) *(PG8_LAS unsigned long long*)(lds + 135168 + 8 * 2) = __builtin_amdgcn_s_memrealtime();
        if constexpr (!Epi::AFTER_DRAIN) { E(acc, cur, wr, wc, fr, fq); S.done(cur); }   if (PROBE_A >= 0 && threadIdx.x == 0) *(PG8_LAS unsigned long long*)(lds + 135168 + 8 * 3) = __builtin_amdgcn_s_memrealtime();
        if (!has_next) break;
#pragma unroll
        for (int a = 0; a < 2; ++a)
#pragma unroll
            for (int b = 0; b < 2; ++b)
#pragma unroll
                for (int m = 0; m < 4; ++m)
#pragma unroll
                    for (int n = 0; n < 2; ++n) acc[a][b][m][n] = (f32x4){0.f, 0.f, 0.f, 0.f};
        cur = nxt; cA = nA; cB = nB; ++ui;
        if constexpr (ALIGN_EPI) { if (wr == 1) PG8_BAR; }
    }
    PG8_WAIT_V(0);
    if constexpr (!ALIGN_EPI) { if (wr == 0) PG8_BAR; }
    PG8_BAR;
    if constexpr (Epi::AFTER_DRAIN) { E.fused(acc, cur, wr, wc, fr, fq, lds, wid, lane); S.done(cur); }
#undef PG8_SA
#undef PG8_SB
#undef PG8_STAGE
#undef PG8_LDA
#undef PG8_LDB
#undef PG8_MMA
#undef PG8_WAIT_V
#undef PG8_WAIT_L
#undef PG8_BAR
#undef PG8_SCHED
}
}
#define SSTAMP(i) do { if (PROBE_A >= 0 && (int)blockIdx.x == PROBE_BID && tid == 0) { ((unsigned long long*)(p.CTL + 2048))[i] = __builtin_amdgcn_s_memrealtime(); } } while (0)
typedef pg8::f32x4 f32x4;
struct NoIn {};
template <class F> struct EpiGen {
    static constexpr bool PERM = true, AFTER_DRAIN = false; F f;
    __device__ __forceinline__ void operator()(const f32x4 (&acc)[2][2][4][2], const pg8::Unit& u, int wr, int wc, int fr, int fq) const {
        const int row0 = u.pm * 256 + wr * 64 + fr, col0 = u.pn * 256 + wc * 32 + 8 * fq;
        float ctx[8];
#pragma unroll
        for (int r = 0; r < 8; ++r) ctx[r] = f.row_begin(row0 + (r >> 2) * 128 + (r & 3) * 16);
        typename F::In8 cur[2], nxt[2];
#pragma unroll
        for (int g = 0; g < 2; ++g) cur[g] = f.load8(row0, col0 + g * 128);
#pragma unroll
        for (int r = 0; r < 8; ++r) { const int row = row0 + (r >> 2) * 128 + (r & 3) * 16;
            if (r < 7) { const int rn = row0 + ((r + 1) >> 2) * 128 + ((r + 1) & 3) * 16;
#pragma unroll
                for (int g = 0; g < 2; ++g) nxt[g] = f.load8(rn, col0 + g * 128); }
            float part = 0.f;
#pragma unroll
            for (int g = 0; g < 2; ++g) part += f.store8(ctx[r], row, col0 + g * 128, acc[r >> 2][g][r & 3][0], acc[r >> 2][g][r & 3][1], cur[g]);
            f.row_end(row, part, fq, true);
#pragma unroll
            for (int g = 0; g < 2; ++g) cur[g] = nxt[g]; }
    }
};
__device__ __forceinline__ f32x4 bf4lo(v4u w) { return (f32x4){bf2f((bf16_t)(w.x & 0xffff)), bf2f((bf16_t)(w.x >> 16)), bf2f((bf16_t)(w.y & 0xffff)), bf2f((bf16_t)(w.y >> 16))}; }
__device__ __forceinline__ f32x4 bf4hi(v4u w) { return (f32x4){bf2f((bf16_t)(w.z & 0xffff)), bf2f((bf16_t)(w.z >> 16)), bf2f((bf16_t)(w.w & 0xffff)), bf2f((bf16_t)(w.w >> 16))}; }
__device__ __forceinline__ v4u pk8(f32x4 a, f32x4 c) { v4u w; w.x = pk2(a[0], a[1]); w.y = pk2(a[2], a[3]); w.z = pk2(c[0], c[1]); w.w = pk2(c[2], c[3]); return w; }
template <int ACT  >
__device__ __forceinline__ void store_tile_bf16(const f32x4 (&acc)[2][2][4][2], int row0, int col0, const float (&rsv)[8], float scale, bf16_t* dst, int ld) {
#pragma unroll
    for (int ai = 0; ai < 2; ++ai)
#pragma unroll
        for (int m = 0; m < 4; ++m) { const int row = row0 + ai * 128 + m * 16; const float rs = rsv[ai * 4 + m] * scale; bf16_t* rp = dst + (size_t)row * ld + col0;
#pragma unroll
            for (int bj = 0; bj < 2; ++bj) { f32x4 v = acc[ai][bj][m][0] * rs, w = acc[ai][bj][m][1] * rs;
                if (ACT == 1) { v[0] = silu_fast(v[0]); v[1] = silu_fast(v[1]); v[2] = silu_fast(v[2]); v[3] = silu_fast(v[3]); w[0] = silu_fast(w[0]); w[1] = silu_fast(w[1]); w[2] = silu_fast(w[2]); w[3] = silu_fast(w[3]); }
                if (ACT == 2) { v[0] = sigmoid_fast(v[0]); v[1] = sigmoid_fast(v[1]); v[2] = sigmoid_fast(v[2]); v[3] = sigmoid_fast(v[3]); w[0] = sigmoid_fast(w[0]); w[1] = sigmoid_fast(w[1]); w[2] = sigmoid_fast(w[2]); w[3] = sigmoid_fast(w[3]); }
                *(v4u*)(rp + bj * 128) = pk8(v, w); } }
}
struct EpiProj {
    static constexpr bool PERM = true, AFTER_DRAIN = false;
    const float* rstd; const float* b_gate; bf16_t *QN, *KV6, *GQ, *GK, *GV, *GR, *BR; float *GATE, *LR, *out;
    __device__ __forceinline__ void operator()(const f32x4 (&acc)[2][2][4][2], const pg8::Unit& u, int wr, int wc, int fr, int fq) const {
        const int row0 = u.pm * 256 + wr * 64 + fr, cl0 = wc * 32 + 8 * fq, pn = u.pn;
        float rsv[8];
#pragma unroll
        for (int r = 0; r < 8; ++r) rsv[r] = rstd[row0 + (r >> 2) * 128 + (r & 3) * 16];
        if (pn < 4) store_tile_bf16<0>(acc, row0, pn * 256 + cl0, rsv, 0.125f, QN, 1024);
        else if (pn < 10) { const int j = pn - 4;
            store_tile_bf16<0>(acc, row0, j * 256 + cl0, rsv, 1.f, KV6, 1536);
#pragma unroll
            for (int ai = 0; ai < 2; ++ai)
#pragma unroll
                for (int m = 0; m < 4; ++m) { const int row = row0 + ai * 128 + m * 16; const float rs = rsv[ai * 4 + m]; const int b = row >> 11, t = row & 2047;
                    float* rp = nullptr;
                    if (j < 4) rp = out + OFF_PCK + j * SZ_PROW + (size_t)row * 256 + cl0;
                    else if (t >= 1536) rp = out + OFF_PWK + (j - 4) * SZ_PWIN + ((size_t)b * 512 + (t - 1536)) * 256 + cl0;
                    if (rp) {
#pragma unroll
                        for (int bj = 0; bj < 2; ++bj)
#pragma unroll
                            for (int n = 0; n < 2; ++n) *(f32x4*)(rp + bj * 128 + n * 4) = acc[ai][bj][m][n] * rs; } }
        }
        else if (pn < 12) store_tile_bf16<0>(acc, row0, (pn - 10) * 256 + cl0, rsv, 0.08838834764831845f, GQ, 512);
        else if (pn < 14) store_tile_bf16<0>(acc, row0, (pn - 12) * 256 + cl0, rsv, 1.f, GK, 512);
        else if (pn < 18) store_tile_bf16<0>(acc, row0, (pn - 14) * 256 + cl0, rsv, 1.f, GV, 1024);
        else if (pn < 22) store_tile_bf16<1>(acc, row0, (pn - 18) * 256 + cl0, rsv, 1.f, GR, 1024);
        else if (pn < 38) store_tile_bf16<2>(acc, row0, (pn - 22) * 256 + cl0, rsv, 1.f, BR, 4096);
        else if (wc < 2) {
#pragma unroll
            for (int ai = 0; ai < 2; ++ai)
#pragma unroll
                for (int m = 0; m < 4; ++m) { const int row = row0 + ai * 128 + m * 16; const float rs = rsv[ai * 4 + m];
#pragma unroll
                    for (int n = 0; n < 2; ++n) { const int cl = cl0 + n * 4; const f32x4 v = acc[ai][0][m][n] * rs;
                        if (cl < 48) { const f32x4 bg = *(const f32x4*)(b_gate + cl); f32x4 o; o[0] = sigmoid_fast(v[0] + bg[0]); o[1] = sigmoid_fast(v[1] + bg[1]); o[2] = sigmoid_fast(v[2] + bg[2]); o[3] = sigmoid_fast(v[3] + bg[3]);
                            *(f32x4*)(GATE + (size_t)row * 48 + cl) = o; }
                        else *(f32x4*)(LR + (size_t)row * 16 + (cl - 48)) = v; } }
        }
    }
};
struct F_bra { const bf16_t* BR; bf16_t* TMPB; typedef v2u In;
    typedef v4u In8;
    __device__ __forceinline__ In8 load8(int row, int col) const { return *(const v4u*)(BR + (size_t)row * 4096 + col); }
    __device__ __forceinline__ float store8(float, int row, int col, f32x4 v, f32x4 w, const In8& g) const { *(v4u*)(TMPB + (size_t)row * DM + col) = pk8(v * bf4lo(g), w * bf4hi(g)); return 0.f; }
    __device__ __forceinline__ float row_begin(int) const { return 0.f; }
    __device__ __forceinline__ In load4(int row, int col) const { return *(const v2u*)(BR + (size_t)row * 4096 + col); }
    __device__ __forceinline__ float store4(float, int row, int col, f32x4 v, const In& b) const {
        v2u w; w.x = pk2(v[0] * bf2f((bf16_t)(b.x & 0xffff)), v[1] * bf2f((bf16_t)(b.x >> 16))); w.y = pk2(v[2] * bf2f((bf16_t)(b.y & 0xffff)), v[3] * bf2f((bf16_t)(b.y >> 16)));
        *(v2u*)(TMPB + (size_t)row * DM + col) = w; return 0.f; }
    __device__ __forceinline__ void row_end(int, float, int, bool) const {}
};
struct F_brb { const bf16_t* BR; const bf16_t* TMPB; bf16_t* MB; struct In { v2u b; v2u t; };
    struct In8 { v4u b; v4u t; };
    __device__ __forceinline__ In8 load8(int row, int col) const { In8 i; i.b = *(const v4u*)(BR + (size_t)row * 4096 + 2048 + col); i.t = *(const v4u*)(TMPB + (size_t)row * DM + col); return i; }
    __device__ __forceinline__ float store8(float, int row, int col, f32x4 v, f32x4 w, const In8& i) const { *(v4u*)(MB + (size_t)row * DM + col) = pk8(bf4lo(i.t) + v * bf4lo(i.b), bf4hi(i.t) + w * bf4hi(i.b)); return 0.f; }
    __device__ __forceinline__ float row_begin(int) const { return 0.f; }
    __device__ __forceinline__ In load4(int row, int col) const { In i; i.b = *(const v2u*)(BR + (size_t)row * 4096 + 2048 + col); i.t = *(const v2u*)(TMPB + (size_t)row * DM + col); return i; }
    __device__ __forceinline__ float store4(float, int row, int col, f32x4 v, const In& i) const { const v2u b = i.b, t = i.t;
        const float o0 = bf2f((bf16_t)(t.x & 0xffff)) + v[0] * bf2f((bf16_t)(b.x & 0xffff)), o1 = bf2f((bf16_t)(t.x >> 16)) + v[1] * bf2f((bf16_t)(b.x >> 16));
        const float o2 = bf2f((bf16_t)(t.y & 0xffff)) + v[2] * bf2f((bf16_t)(b.y & 0xffff)), o3 = bf2f((bf16_t)(t.y >> 16)) + v[3] * bf2f((bf16_t)(b.y >> 16));
        v2u w; w.x = pk2(o0, o1); w.y = pk2(o2, o3); *(v2u*)(MB + (size_t)row * DM + col) = w; return 0.f; }
    __device__ __forceinline__ void row_end(int, float, int, bool) const {}
};
struct F_wo { const float* x; bf16_t* X1B; float* SUMSQ; typedef f32x4 In;
    struct In8 { f32x4 a, c; };
    __device__ __forceinline__ In8 load8(int row, int col) const { In8 i; i.a = *(const f32x4*)(x + (size_t)row * DM + col); i.c = *(const f32x4*)(x + (size_t)row * DM + col + 4); return i; }
    __device__ __forceinline__ float store8(float, int row, int col, f32x4 v, f32x4 w, const In8& i) const { const f32x4 a = i.a + v, c = i.c + w; *(v4u*)(X1B + (size_t)row * DM + col) = pk8(a, c);
        return ((a[0] * a[0] + a[1] * a[1]) + (a[2] * a[2] + a[3] * a[3])) + ((c[0] * c[0] + c[1] * c[1]) + (c[2] * c[2] + c[3] * c[3])); }
    __device__ __forceinline__ float row_begin(int) const { return 0.f; }
    __device__ __forceinline__ In load4(int row, int col) const { return *(const f32x4*)(x + (size_t)row * DM + col); }
    __device__ __forceinline__ float store4(float, int row, int col, f32x4 v, const In& xv) const { const f32x4 x1 = xv + v;
        v2u w; w.x = pk2(x1[0], x1[1]); w.y = pk2(x1[2], x1[3]); *(v2u*)(X1B + (size_t)row * DM + col) = w;
        return (x1[0] * x1[0] + x1[1] * x1[1]) + (x1[2] * x1[2] + x1[3] * x1[3]); }
    __device__ __forceinline__ void row_end(int row, float part, int fq, bool valid) const { part += __shfl_xor(part, 16); part += __shfl_xor(part, 32); if (fq == 0 && valid) atomicAdd(SUMSQ + row, part); }
};
struct F_up { const float* SUMSQ; bf16_t* HF; typedef NoIn In;
    typedef NoIn In8;
    __device__ __forceinline__ In8 load8(int, int) const { return NoIn{}; }
    __device__ __forceinline__ float store8(float rs, int row, int col, f32x4 v, f32x4 w, const In8&) const { f32x4 a, c;
#pragma unroll
        for (int i = 0; i < 4; ++i) { const float t = fmaxf(v[i] * rs, 0.f), s = fmaxf(w[i] * rs, 0.f); a[i] = t * t; c[i] = s * s; }
        *(v4u*)(HF + (size_t)row * DFF + col) = pk8(a, c); return 0.f; }
    __device__ __forceinline__ float row_begin(int row) const { return rsqrtf(SUMSQ[row] * (1.f / DM) + EPS); }
    __device__ __forceinline__ In load4(int, int) const { return NoIn{}; }
    __device__ __forceinline__ float store4(float rs, int row, int col, f32x4 v, const In&) const { float h[4];
#pragma unroll
        for (int i = 0; i < 4; ++i) { const float t = fmaxf(v[i] * rs, 0.f); h[i] = t * t; }
        v2u w; w.x = pk2(h[0], h[1]); w.y = pk2(h[2], h[3]); *(v2u*)(HF + (size_t)row * DFF + col) = w; return 0.f; }
    __device__ __forceinline__ void row_end(int, float, int, bool) const {}
};
struct F_down { const bf16_t* X1B; bf16_t* YB; float* SUMSQ; typedef v2u In;
    typedef v4u In8;
    __device__ __forceinline__ In8 load8(int row, int col) const { return *(const v4u*)(X1B + (size_t)row * DM + col); }
    __device__ __forceinline__ float store8(float, int row, int col, f32x4 v, f32x4 w, const In8& t) const { const f32x4 a = bf4lo(t) + v, c = bf4hi(t) + w; *(v4u*)(YB + (size_t)row * DM + col) = pk8(a, c);
        return ((a[0] * a[0] + a[1] * a[1]) + (a[2] * a[2] + a[3] * a[3])) + ((c[0] * c[0] + c[1] * c[1]) + (c[2] * c[2] + c[3] * c[3])); }
    __device__ __forceinline__ float row_begin(int) const { return 0.f; }
    __device__ __forceinline__ In load4(int row, int col) const { return *(const v2u*)(X1B + (size_t)row * DM + col); }
    __device__ __forceinline__ float store4(float, int row, int col, f32x4 v, const In& t) const {
        const float a0 = bf2f((bf16_t)(t.x & 0xffff)) + v[0], a1 = bf2f((bf16_t)(t.x >> 16)) + v[1], a2 = bf2f((bf16_t)(t.y & 0xffff)) + v[2], a3 = bf2f((bf16_t)(t.y >> 16)) + v[3];
        v2u w; w.x = pk2(a0, a1); w.y = pk2(a2, a3); *(v2u*)(YB + (size_t)row * DM + col) = w; return (a0 * a0 + a1 * a1) + (a2 * a2 + a3 * a3); }
    __device__ __forceinline__ void row_end(int row, float part, int fq, bool valid) const { part += __shfl_xor(part, 16); part += __shfl_xor(part, 32); if (fq == 0 && valid) atomicAdd(SUMSQ + row, part); }
};

struct EpiDownNorm {
    static constexpr bool PERM = true, AFTER_DRAIN = true;
    const bf16_t* X1B; float* SUMSQ; float* Y; const float* norm_f; unsigned* pcnt;
    __device__ __forceinline__ void fused(f32x4 (&acc)[2][2][4][2], const pg8::Unit& u, int wr, int wc, int fr, int fq, PG8_LAS unsigned char* lds, int wid, int lane) const {
        const int row0 = u.pm * 256 + wr * 64 + fr, col0 = u.pn * 256 + wc * 32 + 8 * fq;
        v4u cur[2], nxt[2];
#pragma unroll
        for (int g = 0; g < 2; ++g) cur[g] = *(const v4u*)(X1B + (size_t)row0 * DM + col0 + g * 128);
#pragma unroll
        for (int r = 0; r < 8; ++r) { const int row = row0 + (r >> 2) * 128 + (r & 3) * 16;
            if (r < 7) { const int rn = row0 + ((r + 1) >> 2) * 128 + ((r + 1) & 3) * 16;
#pragma unroll
                for (int g = 0; g < 2; ++g) nxt[g] = *(const v4u*)(X1B + (size_t)rn * DM + col0 + g * 128); }
            float part = 0.f;
#pragma unroll
            for (int g = 0; g < 2; ++g) { f32x4& a = acc[r >> 2][g][r & 3][0]; f32x4& c = acc[r >> 2][g][r & 3][1]; a = a + bf4lo(cur[g]); c = c + bf4hi(cur[g]);
                part += ((a[0] * a[0] + a[1] * a[1]) + (a[2] * a[2] + a[3] * a[3])) + ((c[0] * c[0] + c[1] * c[1]) + (c[2] * c[2] + c[3] * c[3])); }
            part += __shfl_xor(part, 16); part += __shfl_xor(part, 32); if (fq == 0) atomicAdd(SUMSQ + row, part);
#pragma unroll
            for (int g = 0; g < 2; ++g) cur[g] = nxt[g]; }
        asm volatile("s_waitcnt vmcnt(0)" ::: "memory"); __syncthreads();
        if (threadIdx.x == 0) { __builtin_amdgcn_fence(__ATOMIC_RELEASE, "agent"); asm volatile("s_waitcnt vmcnt(0)" ::: "memory");
            __hip_atomic_fetch_add(pcnt + 64 * u.pm, 1u, __ATOMIC_RELAXED, __HIP_MEMORY_SCOPE_AGENT);
            unsigned sp = 0; while (__hip_atomic_load(pcnt + 64 * u.pm, __ATOMIC_RELAXED, __HIP_MEMORY_SCOPE_AGENT) < 8u) { __builtin_amdgcn_s_sleep(1); if (++sp > (1u << 22)) break; }
            __builtin_amdgcn_fence(__ATOMIC_ACQUIRE, "agent"); asm volatile("s_waitcnt vmcnt(0)" ::: "memory"); }
        __syncthreads();
#pragma unroll
        for (int r = 0; r < 8; ++r) { const int row = row0 + (r >> 2) * 128 + (r & 3) * 16;
            const float rs = rsqrtf(__hip_atomic_load(SUMSQ + row, __ATOMIC_RELAXED, __HIP_MEMORY_SCOPE_AGENT) * (1.f / DM) + EPS);
#pragma unroll
            for (int g = 0; g < 2; ++g) { const int col = col0 + g * 128; const f32x4 g0 = *(const f32x4*)(norm_f + col), g1 = *(const f32x4*)(norm_f + col + 4);
                *(f32x4*)(Y + (size_t)row * DM + col) = acc[r >> 2][g][r & 3][0] * rs * g0; *(f32x4*)(Y + (size_t)row * DM + col + 4) = acc[r >> 2][g][r & 3][1] * rs * g1; } }
    }
    __device__ __forceinline__ void operator()(const f32x4 (&)[2][2][4][2], const pg8::Unit&, int, int, int, int) const {}
};

typedef short bf16x8_t __attribute__((ext_vector_type(8)));
template <class F>
__device__ __forceinline__ void skinny_gemm(LAS unsigned char* lds, const bf16_t* A, int lda, const bf16_t* Bt, int N, int K, const F& f, int bid, int G, int tid) {
    const int lane = tid & 63, wave = __builtin_amdgcn_readfirstlane(tid >> 6), j = lane & 15, g = lane >> 4;
    LAS f32x4* red = (LAS f32x4*)lds;
    const int ksl = K >> 3;
    for (int it = bid; it < (N >> 4); it += G) {
        const int n0 = it * 16;
        const bf16_t* bp = Bt + (size_t)(n0 + j) * K + wave * ksl + 8 * g;
        const bf16_t* ap = A + (size_t)(j & 7) * lda + wave * ksl + 8 * g;
        f32x4 acc = {0.f, 0.f, 0.f, 0.f};
#pragma unroll 4
        for (int k = 0; k < ksl; k += 32) {
            const bf16x8_t b = *(const bf16x8_t*)(bp + k); bf16x8_t a = *(const bf16x8_t*)(ap + k);
            if (j >= 8) a = (bf16x8_t){0, 0, 0, 0, 0, 0, 0, 0};
            acc = __builtin_amdgcn_mfma_f32_16x16x32_bf16(b, a, acc, 0, 0, 0);
        }
        red[wave * 64 + lane] = acc;
        __syncthreads();
        if (wave == 0) { f32x4 sacc = red[lane];
#pragma unroll
            for (int w = 1; w < 8; ++w) sacc = sacc + red[w * 64 + lane];
            const int row = NPT + (j & 7); const bool valid = j < 8; const float ctx = f.row_begin(row); float part = 0.f;
            const typename F::In in = f.load4(row, n0 + 4 * g);
            if (valid) part = f.store4(ctx, row, n0 + 4 * g, sacc, in);
            f.row_end(row, part, g, valid); }
        __syncthreads();
    }
}
struct F_proj_s { const Params& p; typedef NoIn In;
    __device__ __forceinline__ float row_begin(int row) const { return p.RSTD1[row]; }
    __device__ __forceinline__ In load4(int, int) const { return NoIn{}; }
    __device__ __forceinline__ float store4(float rs, int row, int col, f32x4 v, const In&) const { const int n0 = in_colmap(col); if (n0 >= 0) {
#pragma unroll
        for (int i = 0; i < 4; ++i) proj_store(p, row, n0 + i, v[i] * rs); } return 0.f; }
    __device__ __forceinline__ void row_end(int, float, int, bool) const {}
};

struct TrRegs { f32x4 v[8]; };
template <class CM>
__device__ __forceinline__ TrRegs transpose_load(const float* W, int ldw, const float* kscale, int item, int nblk, CM cm, int lane) {
    const int kb = item / nblk, nb = item % nblk, k0 = 64 * kb, n0 = 32 * nb;
    const int n4 = (lane & 7) * 4, kr = lane >> 3;
    const int sc = cm(n0 + n4);
    TrRegs t;
#pragma unroll
    for (int i = 0; i < 8; ++i) t.v[i] = sc >= 0 ? *(const f32x4*)(W + (size_t)(k0 + 8 * i + kr) * ldw + sc) : (f32x4){0.f, 0.f, 0.f, 0.f};
    if (kscale) {
#pragma unroll
        for (int i = 0; i < 8; ++i) t.v[i] = t.v[i] * kscale[k0 + 8 * i + kr]; }
    return t;
}
__device__ __forceinline__ void transpose_store(const TrRegs& t, bf16_t* WT, int K, int item, int nblk, LAS float* scr, int lane) {
    const int kb = item / nblk, nb = item % nblk, k0 = 64 * kb, n0 = 32 * nb;
    const int n4 = (lane & 7) * 4, kr = lane >> 3;
#pragma unroll
    for (int i = 0; i < 8; ++i) { LAS float* d = scr + (8 * i + kr) * 33 + n4; d[0] = t.v[i][0]; d[1] = t.v[i][1]; d[2] = t.v[i][2]; d[3] = t.v[i][3]; }
    LDS_WAIT(); asm volatile("" ::: "memory");
    const int c = lane & 7;
#pragma unroll
    for (int j = 0; j < 4; ++j) { const int n = (lane >> 3) + 8 * j; const LAS float* s = scr + (8 * c) * 33 + n;
        v4u o; o.x = pk2(s[0 * 33], s[1 * 33]); o.y = pk2(s[2 * 33], s[3 * 33]); o.z = pk2(s[4 * 33], s[5 * 33]); o.w = pk2(s[6 * 33], s[7 * 33]);
        *(v4u*)(WT + (size_t)(n0 + n) * K + k0 + 8 * c) = o; }
    LDS_WAIT(); asm volatile("" ::: "memory");
}
template <class CM>
__device__ __forceinline__ void transpose_item(const float* W, int ldw, const float* kscale, bf16_t* WT, int K, int item, int nblk, CM cm, LAS float* scr, int lane) {
    const TrRegs t = transpose_load(W, ldw, kscale, item, nblk, cm, lane); transpose_store(t, WT, K, item, nblk, scr, lane);
}
struct CM_id { __device__ __forceinline__ int operator()(int n) const { return n; } };
struct CM_in { __device__ __forceinline__ int operator()(int n) const { return in_colmap(n); } };

__device__ __forceinline__ void ph_prologue(const Params& p, LAS unsigned char* lds, int bid, int G, int tid, int parts  ) {
    const int lane = tid & 63, wave = tid >> 6, gw = bid * 8 + wave, NGW = G * 8;
    LAS float* scr = (LAS float*)(lds + wave * 16384);
    constexpr int I_IN = 32 * (NIN_PAD / 32);
    if ((parts & 1) && gw < I_IN) { TrRegs cur = transpose_load(p.w_in, DIN, p.norm1_g, gw, NIN_PAD / 32, CM_in{}, lane);
        for (int it = gw; it < I_IN; it += NGW) { const int nx = it + NGW; TrRegs nxt = cur; if (nx < I_IN) nxt = transpose_load(p.w_in, DIN, p.norm1_g, nx, NIN_PAD / 32, CM_in{}, lane);
            transpose_store(cur, p.WIN_T, DM, it, NIN_PAD / 32, scr, lane); cur = nxt; } }
    if (!(parts & 2)) return;
    for (int row = gw; row < NTOK; row += NGW) {
        const f32x4* xr = (const f32x4*)(row < NPT ? p.x_prompt + (size_t)row * DM : p.x_sample + (size_t)(row - NPT) * DM) + 2 * lane;
        f32x4 v[8]; float ss = 0.f;
#pragma unroll
        for (int j = 0; j < 4; ++j) { v[2 * j] = xr[128 * j]; v[2 * j + 1] = xr[128 * j + 1]; }
#pragma unroll
        for (int j = 0; j < 8; ++j) ss += (v[j][0] * v[j][0] + v[j][1] * v[j][1]) + (v[j][2] * v[j][2] + v[j][3] * v[j][3]);
        ss = wave_sum(ss);
        v4u* o = (v4u*)(p.XB + (size_t)row * DM) + lane;
#pragma unroll
        for (int j = 0; j < 4; ++j) o[64 * j] = pk8(v[2 * j], v[2 * j + 1]);
        if (lane == 0) p.RSTD1[row] = rsqrtf(ss * (1.f / DM) + EPS);
    }
    for (int i = bid * 512 + tid; i < DB * 511 * 64; i += G * 512) { const int c4 = i & 63, r = (i >> 6) % 511, b = (i >> 6) / 511;
        const size_t so = ((size_t)b * 512 + r + 1) * 256 + c4 * 4, dofs = ((size_t)b * 512 + r) * 256 + c4 * 4;
        *(f32x4*)(p.out + OFF_SWK + dofs) = *(const f32x4*)(p.cwk + so); *(f32x4*)(p.out + OFF_SWK + SZ_SWIN + dofs) = *(const f32x4*)(p.cwv + so); }
}
__device__ __forceinline__ void ph_late_weights(const Params& p, LAS unsigned char* lds, int gw, int ngw, int tid, int it0 = 0, int it1 = 1 << 30) {
    const int lane = tid & 63, wave = tid >> 6;
    LAS float* scr = (LAS float*)(lds + wave * 16384);
    constexpr int I_BR = 16 * 64, I_O = 32 * 64, I_UP = 32 * 256, I_DN = 128 * 64, TOTAL = 2 * I_BR + I_O + I_UP + I_DN;
    struct Desc { const float* W; const float* ks; bf16_t* WT; int ldw, K, r, nblk; };
    auto desc = [&](int it) { Desc d; int r = it;
        if (r < I_BR) { d = Desc{p.w_br_a, nullptr, p.WBRA_T, DM, 1024, r, 64}; return d; } r -= I_BR;
        if (r < I_BR) { d = Desc{p.w_br_b, nullptr, p.WBRB_T, DM, 1024, r, 64}; return d; } r -= I_BR;
        if (r < I_O) { d = Desc{p.w_o, nullptr, p.WO_T, DM, DM, r, 64}; return d; } r -= I_O;
        if (r < I_UP) { d = Desc{p.w_up, p.norm2_g, p.WUP_T, DFF, DM, r, 256}; return d; } r -= I_UP;
        d = Desc{p.w_down, nullptr, p.WDN_T, DM, DFF, r, 64}; return d; };
    const int iend = it1 < TOTAL ? it1 : TOTAL;
    if (it0 + gw < iend) { Desc dc = desc(it0 + gw); TrRegs cur = transpose_load(dc.W, dc.ldw, dc.ks, dc.r, dc.nblk, CM_id{}, lane);
        for (int it = it0 + gw; it < iend; it += ngw) { const int nx = it + ngw; Desc dn = dc; TrRegs nxt = cur;
            if (nx < iend) { dn = desc(nx); nxt = transpose_load(dn.W, dn.ldw, dn.ks, dn.r, dn.nblk, CM_id{}, lane); }
            transpose_store(cur, dc.WT, dc.K, dc.r, dc.nblk, scr, lane); cur = nxt; dc = dn; } }
}
__device__ __forceinline__ void ph_final_norm(const Params& p, int bid, int G, int tid, int rbeg = 0) {
    const int lane = tid & 63, wave = tid >> 6, gw = rbeg + bid * 8 + wave, NGW = G * 8;
    const bf16_t* YB = (const bf16_t*)p.X1;
    for (int row = gw; row < NTOK; row += NGW) {
        float* yr = row < NPT ? p.out + OFF_Y + (size_t)row * DM : p.out + OFF_YS + (size_t)(row - NPT) * DM;
        const float r = rsqrtf(p.SUMSQ3[row] * (1.f / DM) + EPS);
        const v4u* s8 = (const v4u*)(YB + (size_t)row * DM) + lane; f32x4* y4 = (f32x4*)yr + 2 * lane; const f32x4* g4 = (const f32x4*)p.norm_f + 2 * lane;
        v4u t[4];
#pragma unroll
        for (int j = 0; j < 4; ++j) t[j] = s8[64 * j];
#pragma unroll
        for (int j = 0; j < 4; ++j) { y4[128 * j] = bf4lo(t[j]) * r * g4[128 * j]; y4[128 * j + 1] = bf4hi(t[j]) * r * g4[128 * j + 1]; }
    }
}

__device__ __forceinline__ unsigned pk2t(float lo, float hi) { return pk2(lo, hi); }
template <bool IS_S>
__device__ __forceinline__ void cmp_gemm_tile(const Params& p, LAS unsigned char* lds, int tile, int tid) {
    const int lane = tid & 63, wave = __builtin_amdgcn_readfirstlane(tid >> 6), wm = wave >> 2, wn = wave & 3, fr = lane & 15, fg = lane >> 4;
    int kv, b, ct = 0, g = 0;
    if (IS_S) { ct = tile % 33; b = (tile / 33) & 7; kv = tile / 264; } else { g = tile & 3; b = (tile >> 2) & 3; kv = tile >> 4; }
    const int c0 = IS_S ? 31 * ct : 0;
    const bf16_t* W = p.W1T + (size_t)kv * 256 * 1024;
    const float* abasef = kv ? p.ccv : p.cck; const bf16_t* abaseb = p.KV6;
    unsigned aof[4];
#pragma unroll
    for (int q = 0; q < 4; ++q) { const int i = q * 32 + (tid >> 4), d4 = (tid & 15) * 4;
        if (IS_S) { const int cl = i >> 2, gg = i & 3, c = c0 + cl; const int page = p.page_table[b * NPAGES + (c >> 3)];
            aof[q] = (unsigned)((((size_t)page * PAGE + (c & 7) * 16) * 4 + gg) * 64 + d4); }
        else aof[q] = (unsigned)(((size_t)(b * SEQ + 16 * i)) * 1536 + kv * 256 + g * 64 + d4); }
    const unsigned bof = (unsigned)((tid >> 3) * 1024 + (tid & 7) * 8);
    f32x4 ra0[4], ra1[4], ra2[4]; v2u rab0[4], rab1[4], rab2[4]; v4u rb0[4];
#define CMP_LOADA(S, r) do { _Pragma("unroll") for (int q = 0; q < 4; ++q) { if (IS_S) ra##S[q] = __builtin_nontemporal_load((const f32x4*)(abasef + aof[q] + (unsigned)(r) * 256u)); else rab##S[q] = *(const v2u*)(abaseb + aof[q] + (unsigned)(r) * 1536u); } } while (0)
#define CMP_LOADB(T, r) do { _Pragma("unroll") for (int q = 0; q < 4; ++q) rb##T[q] = *(const v4u*)(W + bof + (unsigned)(q * 64 * 1024 + (r) * 64)); } while (0)
#define CMP_WRITE(S, T, s) do { LAS unsigned char* ab_ = lds + (s) * 55296; LAS unsigned char* bb_ = ab_ + 18432; \
        _Pragma("unroll") for (int q = 0; q < 4; ++q) { const int i_ = q * 32 + (tid >> 4), d4_ = (tid & 15) * 4; v2u w_; \
            if (IS_S) { w_.x = pk2(ra##S[q][0], ra##S[q][1]); w_.y = pk2(ra##S[q][2], ra##S[q][3]); } else w_ = rab##S[q]; \
            *(LAS v2u*)(ab_ + i_ * 144 + d4_ * 2) = w_; *(LAS v4u*)(bb_ + (q * 64 + (tid >> 3)) * 144 + (tid & 7) * 16) = rb##T[q]; } } while (0)
#define CMP_COMPUTE(s) do { const LAS unsigned char* ab_ = lds + (s) * 55296; const LAS unsigned char* bb_ = ab_ + 18432; \
        _Pragma("unroll") for (int ks = 0; ks < 2; ++ks) { bf16x8_t bfr[4]; \
            _Pragma("unroll") for (int ni = 0; ni < 4; ++ni) bfr[ni] = *(const LAS bf16x8_t*)(bb_ + (64 * wn + 16 * ni + fr) * 144 + (32 * ks + 8 * fg) * 2); \
            _Pragma("unroll") for (int mi = 0; mi < 4; ++mi) { const bf16x8_t af = *(const LAS bf16x8_t*)(ab_ + (64 * wm + 16 * mi + fr) * 144 + (32 * ks + 8 * fg) * 2); \
                _Pragma("unroll") for (int ni = 0; ni < 4; ++ni) acc[mi][ni] = __builtin_amdgcn_mfma_f32_16x16x32_bf16(bfr[ni], af, acc[mi][ni], 0, 0, 0); } } } while (0)
#define CMP_STEP(r, AF, AW, BC, BW) do { if ((r) < 16) { if ((r) + 3 < 16) CMP_LOADA(AF, (r) + 3); if ((r) + 1 < 16) CMP_LOADB(0, (r) + 1); CMP_COMPUTE(BC); if ((r) + 1 < 16) CMP_WRITE(AW, 0, BW); LDS_BARRIER(); } } while (0)
    f32x4 acc[4][4];
#pragma unroll
    for (int mi = 0; mi < 4; ++mi)
#pragma unroll
        for (int ni = 0; ni < 4; ++ni) acc[mi][ni] = (f32x4){0.f, 0.f, 0.f, 0.f};
    CMP_LOADA(0, 0); CMP_LOADB(0, 0); CMP_LOADA(1, 1); CMP_LOADA(2, 2); CMP_WRITE(0, 0, 0); LDS_BARRIER();
#pragma unroll 1
    for (int r = 0; r < 16; r += 6) {
        CMP_STEP(r, 0, 1, 0, 1); CMP_STEP(r + 1, 1, 2, 1, 0); CMP_STEP(r + 2, 2, 0, 0, 1);
        CMP_STEP(r + 3, 0, 1, 1, 0); CMP_STEP(r + 4, 1, 2, 0, 1); CMP_STEP(r + 5, 2, 0, 1, 0);
    }
#undef CMP_LOADA
#undef CMP_LOADB
#undef CMP_STEP
#undef CMP_WRITE
#undef CMP_COMPUTE
    if (!IS_S) {
        float* AB = p.AB_P + (size_t)kv * 2048 * 256;
#pragma unroll
        for (int mi = 0; mi < 4; ++mi) { const int i = 64 * wm + 16 * mi + fr; const size_t R = (size_t)(b * 4 + g) * 128 + i;
#pragma unroll
            for (int ni = 0; ni < 4; ++ni) *(f32x4*)(AB + R * 256 + 64 * wn + 16 * ni + 4 * fg) = acc[mi][ni]; }
    } else {
        LAS float* BH = (LAS float*)lds;
        LAS unsigned char* H = lds + 67584; LAS unsigned char* W2T = lds + 67584 + 34816;
        const float* bias = p.BIAS1 + kv * 128;
        if (wn >= 2) {
#pragma unroll
            for (int mi = 0; mi < 4; ++mi) { const int i = 64 * wm + 16 * mi + fr;
#pragma unroll
                for (int ni = 0; ni < 4; ++ni) *(LAS f32x4*)(BH + i * 132 + 64 * (wn - 2) + 16 * ni + 4 * fg) = acc[mi][ni]; } }
#pragma unroll
        for (int k = 0; k < 2; ++k) { const int idx8 = tid * 8 + 4096 * k, d = idx8 >> 7, j = idx8 & 127; *(LAS v4u*)(W2T + d * 272 + j * 2) = *(const v4u*)(p.W2TG + kv * 8192 + idx8); }
        __syncthreads();
        if (wn < 2) {
#pragma unroll
            for (int mi = 0; mi < 4; ++mi) { const int i = 64 * wm + 16 * mi + fr;
#pragma unroll
                for (int ni = 0; ni < 4; ++ni) { const int j = 64 * wn + 16 * ni + 4 * fg; v2u w; w.x = 0u; w.y = 0u;
                    if (i < 124) { const f32x4 bq = *(const LAS f32x4*)(BH + (i + 4) * 132 + j), bi = *(const f32x4*)(bias + j); const f32x4 hv = acc[mi][ni] + bq + bi;
                        w.x = pk2(gelu_fast(hv[0]), gelu_fast(hv[1])); w.y = pk2(gelu_fast(hv[2]), gelu_fast(hv[3])); }
                    *(LAS v2u*)(H + i * 272 + j * 2) = w; } } }
        __syncthreads();
        f32x4 a2[4];
#pragma unroll
        for (int ni = 0; ni < 4; ++ni) a2[ni] = (f32x4){0.f, 0.f, 0.f, 0.f};
#pragma unroll
        for (int ks = 0; ks < 4; ++ks) { const bf16x8_t hb = *(const LAS bf16x8_t*)(H + (16 * wave + fr) * 272 + (32 * ks + 8 * fg) * 2);
#pragma unroll
            for (int ni = 0; ni < 4; ++ni) { const bf16x8_t wa = *(const LAS bf16x8_t*)(W2T + (16 * ni + fr) * 272 + (32 * ks + 8 * fg) * 2);
                a2[ni] = __builtin_amdgcn_mfma_f32_16x16x32_bf16(wa, hb, a2[ni], 0, 0, 0); } }
        { const int i = 16 * wave + fr, cl = i >> 2, gg = i & 3;
          if (cl < 31 || ct == 32) { bf16_t* dst = (kv ? p.VCMP_S : p.KCMP_S) + ((size_t)(b * 4 + gg) * 1024 + c0 + cl) * 64;
#pragma unroll
              for (int ni = 0; ni < 4; ++ni) { v2u w; w.x = pk2(a2[ni][0], a2[ni][1]); w.y = pk2(a2[ni][2], a2[ni][3]); *(v2u*)(dst + 16 * ni + 4 * fg) = w; } } }
        __syncthreads();
    }
}
template <bool IS_S>
__device__ __forceinline__ void cmp_part2(const Params& p, LAS unsigned char* lds, int kv, int bg, int i0, int tid) {
    constexpr int n_cmp = IS_S ? 1023 : 127, nrs = IS_S ? 1024 : 128;
    const int lane = tid & 63, wave = __builtin_amdgcn_readfirstlane(tid >> 6), fr = lane & 15, fg = lane >> 4;
    const float* AB = (IS_S ? p.AB_S + (size_t)kv * 32768 * 256 : p.AB_P + (size_t)kv * 2048 * 256) + (size_t)bg * nrs * 256;
    LAS unsigned char* H = lds; LAS unsigned char* W2T = lds + 128 * 272;
    const float* w2 = kv ? p.w2v : p.w2k; const float* bias = p.BIAS1 + kv * 128;
    for (int idx = tid; idx < 128 * 32; idx += 512) { const int row = idx >> 5, j4 = (idx & 31) * 4, i = i0 + row; v2u w; w.x = 0u; w.y = 0u;
        if (i < n_cmp) { const f32x4 a = *(const f32x4*)(AB + (size_t)i * 256 + j4), bq = *(const f32x4*)(AB + (size_t)(i + 1) * 256 + 128 + j4), bi = *(const f32x4*)(bias + j4);
            const f32x4 h = a + bq + bi; w.x = pk2(gelu_fast(h[0]), gelu_fast(h[1])); w.y = pk2(gelu_fast(h[2]), gelu_fast(h[3])); }
        *(LAS v2u*)(H + row * 272 + j4 * 2) = w; }
    for (int idx = tid; idx < 8192; idx += 512) { const int j = idx >> 6, d = idx & 63; *(LAS bf16_t*)(W2T + d * 272 + j * 2) = f2bf(w2[idx]); }
    __syncthreads();
    f32x4 acc[4];
#pragma unroll
    for (int ni = 0; ni < 4; ++ni) acc[ni] = (f32x4){0.f, 0.f, 0.f, 0.f};
#pragma unroll
    for (int ks = 0; ks < 4; ++ks) { const bf16x8_t hb = *(const LAS bf16x8_t*)(H + (16 * wave + fr) * 272 + (32 * ks + 8 * fg) * 2);
#pragma unroll
        for (int ni = 0; ni < 4; ++ni) { const bf16x8_t wa = *(const LAS bf16x8_t*)(W2T + (16 * ni + fr) * 272 + (32 * ks + 8 * fg) * 2);
            acc[ni] = __builtin_amdgcn_mfma_f32_16x16x32_bf16(wa, hb, acc[ni], 0, 0, 0); } }
    const int i = i0 + 16 * wave + fr;
    if (i < nrs) {
#pragma unroll
        for (int ni = 0; ni < 4; ++ni) { const int d = 16 * ni + 4 * fg;
            if (IS_S) { v2u w; w.x = pk2(acc[ni][0], acc[ni][1]); w.y = pk2(acc[ni][2], acc[ni][3]); *(v2u*)((kv ? p.VCMP_S : p.KCMP_S) + ((size_t)bg * 1024 + i) * 64 + d) = w; }
            else if (kv == 0) { v2u w; w.x = pk2(acc[ni][0], acc[ni][1]); w.y = pk2(acc[ni][2], acc[ni][3]); *(v2u*)(p.KCMP_P + ((size_t)bg * 128 + i) * 64 + d) = w; }
            else {
#pragma unroll
                for (int r = 0; r < 4; ++r) p.VCMPT_P[((size_t)bg * 64 + d + r) * 128 + i] = f2bf(acc[ni][r]); } } }
    __syncthreads();
}
__device__ __forceinline__ void ph_pro0(const Params& p, LAS unsigned char* lds, int bid, int G, int tid) {
    const int lane = tid & 63, wave = tid >> 6, gw = bid * 8 + wave, NGW = G * 8;
    LAS float* scr = (LAS float*)(lds + wave * 16384);
    for (int it = gw; it < 4 * 64; it += NGW) { const int q = it >> 6, r = it & 63, kv = q >> 1, half = q & 1;
        transpose_item((kv ? p.w1v : p.w1k) + (size_t)half * 1024 * 128, 128, nullptr, p.W1T + ((size_t)kv * 256 + half * 128) * 1024, 1024, r, 4, CM_id{}, scr, lane); }
    for (int i = bid * 512 + tid; i < NTOK; i += G * 512) { p.SUMSQ2[i] = 0.f; p.SUMSQ3[i] = 0.f; }
    for (int idx = bid * 512 + tid; idx < 2 * 8192; idx += G * 512) { const int kv = idx >> 13, r = idx & 8191, j = r & 127, d = r >> 7; p.W2TG[idx] = f2bf((kv ? p.w2v : p.w2k)[j * 64 + d]); }
    __syncthreads();
    for (int it = bid; it < 4; it += G) { const int kv = it >> 1, jh = it & 1, j = jh * 64 + (tid & 63), ks = tid >> 6;
        const float* pe = kv ? p.pe_v : p.pe_k; const float* w1 = kv ? p.w1v : p.w1k; float s = 0.f;
#pragma unroll 1
        for (int k0 = ks * 256; k0 < ks * 256 + 256; k0 += 32) { float pv[32], wv[32];
#pragma unroll
            for (int u = 0; u < 32; ++u) { pv[u] = pe[k0 + u]; wv[u] = w1[(size_t)(k0 + u) * 128 + j]; }
#pragma unroll
            for (int u = 0; u < 32; ++u) s += pv[u] * wv[u]; }
        LAS float* red = (LAS float*)lds; red[tid] = s; __syncthreads();
        if (tid < 64) { float t = 0.f; for (int w = 0; w < 8; ++w) t += red[w * 64 + tid]; p.BIAS1[kv * 128 + j] = t; }
        __syncthreads(); }
}

constexpr int GL_BC = 0, GL_SEG = 32768, GL_QT = 34816, GL_KT = GL_QT + 64 * 272, GL_AM = GL_KT + 64 * 272, GL_VT = GL_AM + 64 * 144, GL_SSQ = GL_VT + 256 * 144, GL_END = GL_SSQ + 2048;
static_assert(GL_END <= 131072, "gla lds");
struct GateRegs { f32x4 lr[8]; float wv[8]; float ba; };
__device__ __forceinline__ GateRegs gla_gates_issue(const Params& p, int row0, int h, int tid) {
    const int lane = tid & 63, wave = tid >> 6, fr = lane & 15, fg = lane >> 4, d = 16 * wave + fr; GateRegs g;
#pragma unroll
    for (int j = 0; j < 8; ++j) { g.wv[j] = 0.f; g.lr[j] = (f32x4){0.f, 0.f, 0.f, 0.f}; }
    if (fg < 2) {
#pragma unroll
        for (int j = 0; j < 8; ++j) g.wv[j] = p.w_a2[(8 * fg + j) * 512 + h * 128 + d];
#pragma unroll
        for (int cb = 0; cb < 4; ++cb) { const f32x4* lr = (const f32x4*)(p.LR + (size_t)(row0 + 16 * cb + fr) * 16 + 8 * fg); g.lr[2 * cb] = lr[0]; g.lr[2 * cb + 1] = lr[1]; } }
    g.ba = p.b_a[h * 128 + d];
    return g;
}
__device__ __forceinline__ void gla_gates(const GateRegs& gr, LAS unsigned char* lds, int tid) {
    LAS float* BC = (LAS float*)(lds + GL_BC);
    const int lane = tid & 63, wave = tid >> 6, fr = lane & 15, fg = lane >> 4, d = 16 * wave + fr;
    const bf16x8_t wb = __builtin_bit_cast(bf16x8_t, pk8((f32x4){gr.wv[0], gr.wv[1], gr.wv[2], gr.wv[3]}, (f32x4){gr.wv[4], gr.wv[5], gr.wv[6], gr.wv[7]}));
    const float ba = gr.ba;
    float run = 0.f;
#pragma unroll
    for (int cb = 0; cb < 4; ++cb) { const bf16x8_t la = __builtin_bit_cast(bf16x8_t, pk8(gr.lr[2 * cb], gr.lr[2 * cb + 1]));
        f32x4 x = __builtin_amdgcn_mfma_f32_16x16x32_bf16(la, wb, (f32x4){0.f, 0.f, 0.f, 0.f}, 0, 0, 0);
        float g4[4];
#pragma unroll
        for (int r = 0; r < 4; ++r) { const float xv = x[r] + ba; g4[r] = (fminf(xv, 0.f) - __logf(1.f + __expf(-fabsf(xv)))) * (1.f / 16.f); }
        g4[1] += g4[0]; g4[2] += g4[1]; g4[3] += g4[2];
        const float t0 = __shfl(g4[3], fr), t1 = __shfl(g4[3], fr + 16), t2 = __shfl(g4[3], fr + 32), t3 = __shfl(g4[3], fr + 48);
        const float off = run + (fg > 0 ? t0 : 0.f) + (fg > 1 ? t1 : 0.f) + (fg > 2 ? t2 : 0.f);
#pragma unroll
        for (int r = 0; r < 4; ++r) BC[(16 * cb + 4 * fg + r) * 128 + d] = off + g4[r];
        run += (t0 + t1) + (t2 + t3); }
    LDS_BARRIER();
}
struct GlaVRegs { v4u v[4]; };
__device__ __forceinline__ GlaVRegs gla_vt_issue(const Params& p, int row0, int h, int tid) {
    const int c = tid & 63, e0 = (tid >> 6) * 32; const bf16_t* src = p.GV + (size_t)(row0 + c) * 1024 + h * 256 + e0; GlaVRegs r;
#pragma unroll
    for (int q = 0; q < 4; ++q) r.v[q] = *(const v4u*)(src + 8 * q);
    return r;
}
__device__ __forceinline__ void gla_vt_commit(const GlaVRegs& r, LAS unsigned char* lds, int tid) {
    LAS bf16_t* VT = (LAS bf16_t*)(lds + GL_VT); const int c = tid & 63, e0 = (tid >> 6) * 32;
#pragma unroll
    for (int q = 0; q < 4; ++q) { const unsigned wv[4] = {r.v[q].x, r.v[q].y, r.v[q].z, r.v[q].w};
#pragma unroll
        for (int i = 0; i < 8; ++i) VT[(e0 + 8 * q + i) * 72 + c] = (bf16_t)((wv[i >> 1] >> ((i & 1) * 16)) & 0xffff); }
}
struct GlaAIn { GateRegs g; GlaVRegs v; v4u k[2]; };
__device__ __forceinline__ GlaAIn gla_a_issue(const Params& p, int item, int tid) {
    const int bh = item >> 5, n = item & 31, b = bh >> 2, h = bh & 3, row0 = b * SEQ + n * 64; GlaAIn in;
    in.g = gla_gates_issue(p, row0, h, tid); in.v = gla_vt_issue(p, row0, h, tid);
    { const int c = tid & 63, d0 = (tid >> 6) * 16;
#pragma unroll
      for (int q = 0; q < 2; ++q) in.k[q] = *(const v4u*)(p.GK + (size_t)(row0 + c) * 512 + h * 128 + d0 + 8 * q); }
    return in;
}
__device__ __forceinline__ void gla_pass_a(const Params& p, LAS unsigned char* lds, int item, int tid, const GlaAIn& in) {
    const int bh = item >> 5, n = item & 31, b = bh >> 2, h = bh & 3, row0 = b * SEQ + n * 64;
    const int lane = tid & 63, wave = __builtin_amdgcn_readfirstlane(tid >> 6), fr = lane & 15, fg = lane >> 4;
    SSTAMP(80);
    const GlaVRegs& vr = in.v; const v4u (&kreg)[2] = in.k;
    gla_gates(in.g, lds, tid); SSTAMP(81);
    { const LAS f32x4* bs = (const LAS f32x4*)(lds + GL_BC); f32x4* bg = (f32x4*)(p.BCG + (size_t)item * 8192);
#pragma unroll
      for (int k = 0; k < 4; ++k) bg[tid + 512 * k] = bs[tid + 512 * k]; }
    const LAS float* BC = (const LAS float*)(lds + GL_BC);
    LAS bf16_t* KST = (LAS bf16_t*)(lds + GL_QT);
    gla_vt_commit(vr, lds, tid);
    { const int c = tid & 63, d0 = (tid >> 6) * 16;
#pragma unroll
      for (int q = 0; q < 2; ++q) { const v4u kk = kreg[q];
          const unsigned wv[4] = {kk.x, kk.y, kk.z, kk.w};
#pragma unroll
          for (int i = 0; i < 8; ++i) { const int d = d0 + 8 * q + i; const float kx = bf2f((bf16_t)((wv[i >> 1] >> ((i & 1) * 16)) & 0xffff));
              KST[d * 72 + c] = f2bf(kx * __expf(BC[63 * 128 + d] - BC[c * 128 + d])); } } }
    if (tid < 128) p.DEC[((size_t)bh * 32 + n) * 128 + tid] = __expf(BC[63 * 128 + tid]);
    LDS_BARRIER(); SSTAMP(82);
    const LAS unsigned char* VTb = lds + GL_VT; const LAS unsigned char* KSb = lds + GL_QT;
    f32x4 acc[8][2];
#pragma unroll
    for (int mb = 0; mb < 8; ++mb) { acc[mb][0] = (f32x4){0.f, 0.f, 0.f, 0.f}; acc[mb][1] = (f32x4){0.f, 0.f, 0.f, 0.f}; }
#pragma unroll
    for (int ks = 0; ks < 2; ++ks) { bf16x8_t vb[2];
#pragma unroll
        for (int nb = 0; nb < 2; ++nb) vb[nb] = *(const LAS bf16x8_t*)(VTb + (32 * wave + 16 * nb + fr) * 144 + (32 * ks + 8 * fg) * 2);
#pragma unroll
        for (int mb = 0; mb < 8; ++mb) { const bf16x8_t ka = *(const LAS bf16x8_t*)(KSb + (16 * mb + fr) * 144 + (32 * ks + 8 * fg) * 2);
            acc[mb][0] = __builtin_amdgcn_mfma_f32_16x16x32_bf16(ka, vb[0], acc[mb][0], 0, 0, 0); acc[mb][1] = __builtin_amdgcn_mfma_f32_16x16x32_bf16(ka, vb[1], acc[mb][1], 0, 0, 0); } }
    SSTAMP(83);
    bf16_t* U = (bf16_t*)p.UT + ((size_t)bh * 32 + n) * 256 * 128;
#pragma unroll
    for (int nb = 0; nb < 2; ++nb) { const int e = 32 * wave + 16 * nb + fr;
#pragma unroll
        for (int mb = 0; mb < 8; ++mb) { v2u w; w.x = pk2(acc[mb][nb][0], acc[mb][nb][1]); w.y = pk2(acc[mb][nb][2], acc[mb][nb][3]); *(v2u*)(U + (size_t)e * 128 + 16 * mb + 4 * fg) = w; } }
    LDS_BARRIER(); SSTAMP(84);
}
__device__ __forceinline__ void gla_pass_b(const Params& p, int bid, int G, int tid) {
    for (int idx = bid * 512 + tid; idx < 16 * 256 * 16; idx += G * 512) { const int d8 = (idx & 15) * 8, e = (idx >> 4) & 255, bh = idx >> 12;
        f32x4 S0 = {0.f, 0.f, 0.f, 0.f}, S1 = {0.f, 0.f, 0.f, 0.f};
        const bf16_t* U = (const bf16_t*)p.UT + (size_t)bh * 32 * 256 * 128 + (size_t)e * 128 + d8; const float* D = p.DEC + (size_t)bh * 32 * 128 + d8;
        bf16_t* SN = p.SNT + (size_t)bh * 32 * 256 * 128 + (size_t)e * 128 + d8;
#pragma unroll 8
        for (int n = 0; n < 32; ++n) { const v4u ub = *(const v4u*)(U + (size_t)n * 256 * 128); const f32x4 d0 = *(const f32x4*)(D + n * 128), d1 = *(const f32x4*)(D + n * 128 + 4);
            *(v4u*)(SN + (size_t)n * 256 * 128) = pk8(S0, S1);
            S0 = d0 * S0 + bf4lo(ub); S1 = d1 * S1 + bf4hi(ub); }
        float* so = p.out + OFF_PGLA + ((size_t)bh * 128 + d8) * 256 + e;
#pragma unroll
        for (int i = 0; i < 4; ++i) { so[(size_t)i * 256] = S0[i]; so[(size_t)(4 + i) * 256] = S1[i]; } }
}
__device__ __forceinline__ void gla_pass_c(const Params& p, LAS unsigned char* lds, int item, int tid) {
    const int bh = item >> 5, n = item & 31, b = bh >> 2, h = bh & 3, row0 = b * SEQ + n * 64;
    const int lane = tid & 63, wave = __builtin_amdgcn_readfirstlane(tid >> 6), fr = lane & 15, fg = lane >> 4;
    bf16x8_t sa[4][2];
    { const bf16_t* SN = p.SNT + ((size_t)bh * 32 + n) * 256 * 128;
#pragma unroll
      for (int ks = 0; ks < 4; ++ks)
#pragma unroll
          for (int eb = 0; eb < 2; ++eb) sa[ks][eb] = *(const bf16x8_t*)(SN + (size_t)(32 * wave + 16 * eb + fr) * 128 + 32 * ks + 8 * fg); }
    const GlaVRegs vr = gla_vt_issue(p, row0, h, tid);
    v4u qreg[2], kreg[2];
    { const int d8 = (tid & 15) * 8;
#pragma unroll
      for (int q = 0; q < 2; ++q) { const int c = (tid >> 4) + 32 * q; qreg[q] = *(const v4u*)(p.GQ + (size_t)(row0 + c) * 512 + h * 128 + d8); kreg[q] = *(const v4u*)(p.GK + (size_t)(row0 + c) * 512 + h * 128 + d8); } }
    { LAS f32x4* bs = (LAS f32x4*)(lds + GL_BC); const f32x4* bg = (const f32x4*)(p.BCG + (size_t)item * 8192);
      f32x4 t4[4];
#pragma unroll
      for (int k = 0; k < 4; ++k) t4[k] = bg[tid + 512 * k];
#pragma unroll
      for (int k = 0; k < 4; ++k) bs[tid + 512 * k] = t4[k]; }
    LDS_BARRIER();
    const LAS float* BC = (const LAS float*)(lds + GL_BC);
    LAS unsigned char* QTb = lds + GL_QT; LAS unsigned char* KTb = lds + GL_KT; LAS unsigned char* AMb = lds + GL_AM; const LAS unsigned char* VTb = lds + GL_VT;
    gla_vt_commit(vr, lds, tid);
    { const int d8 = (tid & 15) * 8;
#pragma unroll
      for (int q = 0; q < 2; ++q) { const int c = (tid >> 4) + 32 * q; const v4u qq = qreg[q], kk = kreg[q];
          const unsigned qv[4] = {qq.x, qq.y, qq.z, qq.w}, kw[4] = {kk.x, kk.y, kk.z, kk.w}; unsigned qo[4], ko[4];
#pragma unroll
          for (int i = 0; i < 4; ++i) { const float b0 = BC[c * 128 + d8 + 2 * i], b1 = BC[c * 128 + d8 + 2 * i + 1]; const float e0 = __expf(b0), e1 = __expf(b1), i0 = __expf(-b0), i1 = __expf(-b1);
              qo[i] = pk2(bf2f((bf16_t)(qv[i] & 0xffff)) * e0, bf2f((bf16_t)(qv[i] >> 16)) * e1);
              ko[i] = pk2(bf2f((bf16_t)(kw[i] & 0xffff)) * i0, bf2f((bf16_t)(kw[i] >> 16)) * i1); }
          *(LAS v4u*)(QTb + c * 272 + d8 * 2) = (v4u){qo[0], qo[1], qo[2], qo[3]}; *(LAS v4u*)(KTb + c * 272 + d8 * 2) = (v4u){ko[0], ko[1], ko[2], ko[3]}; } }
    LDS_BARRIER();
    { const int sb = wave >> 1;
#pragma unroll
      for (int u = 0; u < 2; ++u) { const int cb = 2 * (wave & 1) + u; f32x4 a = {0.f, 0.f, 0.f, 0.f};
          if (sb <= cb) {
#pragma unroll
              for (int ks = 0; ks < 4; ++ks) { const bf16x8_t ka = *(const LAS bf16x8_t*)(KTb + (16 * sb + fr) * 272 + (32 * ks + 8 * fg) * 2); const bf16x8_t qb = *(const LAS bf16x8_t*)(QTb + (16 * cb + fr) * 272 + (32 * ks + 8 * fg) * 2);
                  a = __builtin_amdgcn_mfma_f32_16x16x32_bf16(ka, qb, a, 0, 0, 0); } }
          const int c = 16 * cb + fr, s0 = 16 * sb + 4 * fg;
          v2u w; w.x = pk2(s0 <= c ? a[0] : 0.f, s0 + 1 <= c ? a[1] : 0.f); w.y = pk2(s0 + 2 <= c ? a[2] : 0.f, s0 + 3 <= c ? a[3] : 0.f);
          *(LAS v2u*)(AMb + c * 144 + s0 * 2) = w; } }
    LDS_BARRIER();
    f32x4 acc[2][4];
#pragma unroll
    for (int eb = 0; eb < 2; ++eb)
#pragma unroll
        for (int cb = 0; cb < 4; ++cb) acc[eb][cb] = (f32x4){0.f, 0.f, 0.f, 0.f};
#pragma unroll
    for (int ks = 0; ks < 4; ++ks) { bf16x8_t qb[4];
#pragma unroll
        for (int cb = 0; cb < 4; ++cb) qb[cb] = *(const LAS bf16x8_t*)(QTb + (16 * cb + fr) * 272 + (32 * ks + 8 * fg) * 2);
#pragma unroll
        for (int eb = 0; eb < 2; ++eb)
#pragma unroll
            for (int cb = 0; cb < 4; ++cb) acc[eb][cb] = __builtin_amdgcn_mfma_f32_16x16x32_bf16(sa[ks][eb], qb[cb], acc[eb][cb], 0, 0, 0); }
#pragma unroll
    for (int ks = 0; ks < 2; ++ks) { bf16x8_t va[2], ab[4];
#pragma unroll
        for (int eb = 0; eb < 2; ++eb) va[eb] = *(const LAS bf16x8_t*)(VTb + (32 * wave + 16 * eb + fr) * 144 + (32 * ks + 8 * fg) * 2);
#pragma unroll
        for (int cb = 0; cb < 4; ++cb) ab[cb] = *(const LAS bf16x8_t*)(AMb + (16 * cb + fr) * 144 + (32 * ks + 8 * fg) * 2);
#pragma unroll
        for (int eb = 0; eb < 2; ++eb)
#pragma unroll
            for (int cb = 0; cb < 4; ++cb) acc[eb][cb] = __builtin_amdgcn_mfma_f32_16x16x32_bf16(va[eb], ab[cb], acc[eb][cb], 0, 0, 0); }
    LAS float* SSQ = (LAS float*)(lds + GL_SSQ);
#pragma unroll
    for (int cb = 0; cb < 4; ++cb) { float s = 0.f;
#pragma unroll
        for (int eb = 0; eb < 2; ++eb) s += (acc[eb][cb][0] * acc[eb][cb][0] + acc[eb][cb][1] * acc[eb][cb][1]) + (acc[eb][cb][2] * acc[eb][cb][2] + acc[eb][cb][3] * acc[eb][cb][3]);
        s += __shfl_xor(s, 16); s += __shfl_xor(s, 32);
        if (fg == 0) SSQ[wave * 64 + 16 * cb + fr] = s; }
    LDS_BARRIER();
#pragma unroll
    for (int cb = 0; cb < 4; ++cb) { const int c = 16 * cb + fr; float s = 0.f;
#pragma unroll
        for (int w = 0; w < 8; ++w) s += SSQ[w * 64 + c];
        const float rs = rsqrtf(s * (1.f / 256.f) + EPS);
#pragma unroll
        for (int eb = 0; eb < 2; ++eb) { const int e = 32 * wave + 16 * eb + 4 * fg; const f32x4 gn = *(const f32x4*)(p.gnorm + e);
            const v2u rr = *(const v2u*)(p.GR + (size_t)(row0 + c) * 1024 + h * 256 + e);
            const float o0 = acc[eb][cb][0] * rs * gn[0] * bf2f((bf16_t)(rr.x & 0xffff)), o1 = acc[eb][cb][1] * rs * gn[1] * bf2f((bf16_t)(rr.x >> 16));
            const float o2 = acc[eb][cb][2] * rs * gn[2] * bf2f((bf16_t)(rr.y & 0xffff)), o3 = acc[eb][cb][3] * rs * gn[3] * bf2f((bf16_t)(rr.y >> 16));
            v2u w; w.x = pk2(o0, o1); w.y = pk2(o2, o3); *(v2u*)(p.OB + (size_t)(row0 + c) * 1024 + h * 256 + e) = w; } }
    LDS_BARRIER();
}
__device__ __forceinline__ void gla_sample_item(const Params& p, LAS unsigned char* lds, int item, int tid) {
    const int b = item >> 2, h = item & 3, e = tid & 255, half = tid >> 8, row = NPT + b;
    LAS float* a_s = (LAS float*)lds; LAS float* q_s = a_s + 128; LAS float* k_s = q_s + 128; LAS float* part = k_s + 128; LAS float* red = part + 512;
    if (tid < 128) { float x = p.b_a[h * 128 + tid];
        for (int r = 0; r < 16; ++r) x += p.LR[(size_t)row * 16 + r] * p.w_a2[r * 512 + h * 128 + tid];
        a_s[tid] = __expf(logsigmoidf_(x) * (1.f / 16.f)); q_s[tid] = bf2f(p.GQ[(size_t)row * 512 + h * 128 + tid]); k_s[tid] = bf2f(p.GK[(size_t)row * 512 + h * 128 + tid]); }
    const float v = bf2f(p.GV[(size_t)row * 1024 + h * 256 + e]);
    __syncthreads();
    float po = 0.f; const float* s0 = p.state + (((size_t)b * 4 + h) * 128 + half * 64) * 256 + e; float* so = p.out + OFF_SGLA + (((size_t)b * 4 + h) * 128 + half * 64) * 256 + e;
#pragma unroll 1
    for (int d0 = 0; d0 < 64; d0 += 32) { float sv[32];
#pragma unroll
        for (int dd = 0; dd < 32; ++dd) sv[dd] = s0[(size_t)(d0 + dd) * 256];
#pragma unroll
        for (int dd = 0; dd < 32; ++dd) { const int d = half * 64 + d0 + dd; const float s = a_s[d] * sv[dd] + k_s[d] * v; so[(size_t)(d0 + dd) * 256] = s; po += q_s[d] * s; } }
    part[half * 256 + e] = po;
    __syncthreads();
    float o = 0.f;
    if (tid < 256) { o = part[e] + part[256 + e]; const float ss = wave_sum(o * o); if ((tid & 63) == 0) red[tid >> 6] = ss; }
    __syncthreads();
    if (tid < 256) { const float ss = (red[0] + red[1]) + (red[2] + red[3]); const float r = rsqrtf(ss * (1.f / 256.f) + EPS);
        p.OB[(size_t)row * 1024 + h * 256 + e] = f2bf(o * r * p.gnorm[e] * bf2f(p.GR[(size_t)row * 1024 + h * 256 + e])); }
    __syncthreads();
}

typedef float f32x16 __attribute__((ext_vector_type(16)));
constexpr int NS_STAGE = 17920, NS_KOFF = 0, NS_VOFF = 9216, NS_PCS = 35840, NS_SC = NS_PCS + 32768, NS_OUT = NS_PCS  , NS_SEL = NS_OUT + 256 * 272, NS_END = NS_SEL + 256;
static_assert(NS_END <= 131072, "nsa lds");
constexpr float LOG2E = 1.4426950408889634f, NEGBIG = -1e30f;
__device__ __forceinline__ int crow(int r, int hh) { return (r & 3) + 8 * (r >> 2) + 4 * hh; }

__device__ __forceinline__ void nsa_vt_tile(const Params& p, LAS unsigned char* scr  , int item, int lane) {
    const int tt = item & 31, bg = (item >> 5) & 15, which = item >> 9, b = bg >> 2, g = bg & 3;
    const bf16_t* src = p.KV6 + (size_t)(b * SEQ + tt * 64) * 1536 + (which ? 5 : 3) * 256 + g * 64;
    LAS bf16_t* TT = (LAS bf16_t*)scr;
    const int ch = lane & 7, r0 = lane >> 3;
#pragma unroll
    for (int q = 0; q < 8; ++q) { const v4u v = *(const v4u*)(src + (size_t)lane * 1536 + q * 8); const unsigned wv[4] = {v.x, v.y, v.z, v.w};
#pragma unroll
        for (int i = 0; i < 8; ++i) TT[(q * 8 + i) * 72 + lane] = (bf16_t)((wv[i >> 1] >> ((i & 1) * 16)) & 0xffff); }
    LDS_WAIT(); asm volatile("" ::: "memory");
    bf16_t* dst = (which ? p.VTW : p.VTS) + (size_t)bg * 64 * SEQ + tt * 64;
#pragma unroll
    for (int q = 0; q < 8; ++q) { const int d = r0 + 8 * q; const v4u v = *(const LAS v4u*)((LAS unsigned char*)scr + d * 144 + ch * 16); *(v4u*)(dst + (size_t)d * SEQ + ch * 8) = v; }
    LDS_WAIT(); asm volatile("" ::: "memory");
}

__device__ __forceinline__ float max3f(float a, float b, float c) { float r; asm("v_max3_f32 %0, %1, %2, %3" : "=v"(r) : "v"(a), "v"(b), "v"(c)); return r; }
struct NsaState { float m, l; f32x16 o0, o1; };
template <int MODE  >
__device__ __forceinline__ void nsa_tile(const LAS unsigned char* st, const bf16x8_t (&q)[4], NsaState& s, int lo, int hi, int r32, int hh, LAS float* pcs = nullptr, int kbase = 0) {
    f32x16 s0 = {}, s1 = {};
    const LAS unsigned char* kb = st + NS_KOFF + r32 * 144 + hh * 16;
#pragma unroll
    for (int ks = 0; ks < 4; ++ks) { const bf16x8_t a0 = *(const LAS bf16x8_t*)(kb + ks * 32), a1 = *(const LAS bf16x8_t*)(kb + 32 * 144 + ks * 32);
        s0 = __builtin_amdgcn_mfma_f32_32x32x16_bf16(a0, q[ks], s0, 0, 0, 0); s1 = __builtin_amdgcn_mfma_f32_32x32x16_bf16(a1, q[ks], s1, 0, 0, 0); }
    asm volatile("s_nop 15\n\ts_nop 7" : "+v"(s0), "+v"(s1));
    const bool full = lo <= 0 && hi >= 63, on = hi >= 0;
    const bool nomask = __all(full), laneonly = !nomask && __all(full || !on);
    if (!nomask && !laneonly) {
#pragma unroll
        for (int r = 0; r < 16; ++r) { const int k0 = crow(r, hh), k1 = k0 + 32; s0[r] = (k0 >= lo && k0 <= hi) ? s0[r] : -INFINITY; s1[r] = (k1 >= lo && k1 <= hi) ? s1[r] : -INFINITY; }
    }
    const bool off = laneonly && !on;
    float tmax;
    { float a = max3f(s0[0], s0[1], s1[0]), c = max3f(s0[2], s0[3], s1[1]); a = max3f(a, s1[2], s1[3]);
#pragma unroll
      for (int r = 4; r < 16; r += 4) { a = max3f(a, s0[r], s0[r + 1]); c = max3f(c, s0[r + 2], s0[r + 3]); a = max3f(a, s1[r], s1[r + 1]); c = max3f(c, s1[r + 2], s1[r + 3]); }
      tmax = off ? NEGBIG : max3f(a, c, NEGBIG); }
    if (MODE == 2) {
        const float mL = off ? INFINITY : s.m * LOG2E, inv = s.l;
#pragma unroll
        for (int r = 0; r < 16; ++r) { s0[r] = __builtin_amdgcn_exp2f(s0[r] * LOG2E - mL) * inv; s1[r] = __builtin_amdgcn_exp2f(s1[r] * LOG2E - mL) * inv; }
        if (pcs) {
#pragma unroll
            for (int r = 0; r < 16; ++r) { float v0 = s0[r], v1 = s1[r]; v0 += __shfl_xor(v0, 8); v1 += __shfl_xor(v1, 8); v0 += __shfl_xor(v0, 16); v1 += __shfl_xor(v1, 16);
                pcs[kbase + crow(r, hh)] = v0; pcs[kbase + 32 + crow(r, hh)] = v1; } }
    } else {
        tmax = max3f(tmax, __shfl_xor(tmax, 32), s.m);
        const float mn = tmax, alpha = __builtin_amdgcn_exp2f((s.m - mn) * LOG2E), mL = off ? INFINITY : mn * LOG2E;
        s.m = mn;
        float ps = 0.f;
#pragma unroll
        for (int r = 0; r < 16; ++r) { const float p0 = __builtin_amdgcn_exp2f(s0[r] * LOG2E - mL), p1 = __builtin_amdgcn_exp2f(s1[r] * LOG2E - mL); s0[r] = p0; s1[r] = p1; ps += p0 + p1; }
        s.l = s.l * alpha + ps;
        if (MODE == 1) return;
        if (!__all(alpha == 1.f)) {
#pragma unroll
            for (int r = 0; r < 16; ++r) { s.o0[r] *= alpha; s.o1[r] *= alpha; } }
    }
    const LAS unsigned char* vb = st + NS_VOFF + r32 * 136 + hh * 8;
#pragma unroll
    for (int blk = 0; blk < 2; ++blk)
#pragma unroll
        for (int sp = 0; sp < 2; ++sp) { const f32x16& pp = blk ? s1 : s0; const int rb = 8 * sp;
            v4u pw; pw.x = cvtpk(pp[rb + 0], pp[rb + 1]); pw.y = cvtpk(pp[rb + 2], pp[rb + 3]); pw.z = cvtpk(pp[rb + 4], pp[rb + 5]); pw.w = cvtpk(pp[rb + 6], pp[rb + 7]);
            const bf16x8_t pf = __builtin_bit_cast(bf16x8_t, pw);
            const int ko = (32 * blk + 16 * sp) * 2;
            const v2u a0l = *(const LAS v2u*)(vb + ko), a0h = *(const LAS v2u*)(vb + ko + 16), a1l = *(const LAS v2u*)(vb + 32 * 136 + ko), a1h = *(const LAS v2u*)(vb + 32 * 136 + ko + 16);
            const bf16x8_t v0 = __builtin_bit_cast(bf16x8_t, (v4u){a0l.x, a0l.y, a0h.x, a0h.y}), v1 = __builtin_bit_cast(bf16x8_t, (v4u){a1l.x, a1l.y, a1h.x, a1h.y});
            s.o0 = __builtin_amdgcn_mfma_f32_32x32x16_bf16(v0, pf, s.o0, 0, 0, 0); s.o1 = __builtin_amdgcn_mfma_f32_32x32x16_bf16(v1, pf, s.o1, 0, 0, 0); }
}
template <bool FIRST>
__device__ __forceinline__ void nsa_finish(NsaState& s, float gate, LAS float* outp) {
    const float lt = s.l + __shfl_xor(s.l, 32); const float sc = lt > 0.f ? gate / lt : 0.f;
#pragma unroll
    for (int k = 0; k < 4; ++k) { f32x4 a = {s.o0[4 * k], s.o0[4 * k + 1], s.o0[4 * k + 2], s.o0[4 * k + 3]}, c = {s.o1[4 * k], s.o1[4 * k + 1], s.o1[4 * k + 2], s.o1[4 * k + 3]};
        a = a * sc; c = c * sc;
        if (!FIRST) { a = a + *(const LAS f32x4*)(outp + 8 * k); c = c + *(const LAS f32x4*)(outp + 32 + 8 * k); }
        *(LAS f32x4*)(outp + 8 * k) = a; *(LAS f32x4*)(outp + 32 + 8 * k) = c; }
    s.m = NEGBIG; s.l = 0.f; s.o0 = (f32x16){}; s.o1 = (f32x16){};
}

__device__ __forceinline__ void nsa_prompt_item(const Params& p, LAS unsigned char* lds, int bg, int qi, int tid) {
    const int lane = tid & 63, wave = __builtin_amdgcn_readfirstlane(tid >> 6), r32 = lane & 31, hh = lane >> 5;
    const int b = bg >> 2, g = bg & 3, tl = 8 * wave + (r32 & 7), hd = r32 >> 3, t = 64 * qi + tl, row = b * SEQ + t;
    const int srow = tid >> 3, sch = tid & 7;
    v4u rk, rv;
    auto issue = [&](const bf16_t* kbase, size_t kstride, const bf16_t* vbase, size_t vstride) { rk = *(const v4u*)(kbase + (size_t)srow * kstride + sch * 8); rv = *(const v4u*)(vbase + (size_t)srow * vstride + sch * 8); };
    auto commit = [&](int s) { LAS unsigned char* st = lds + s * NS_STAGE; *(LAS v4u*)(st + NS_KOFF + srow * 144 + sch * 16) = rk;
        *(LAS v2u*)(st + NS_VOFF + srow * 136 + sch * 16) = (v2u){rv.x, rv.y}; *(LAS v2u*)(st + NS_VOFF + srow * 136 + sch * 16 + 8) = (v2u){rv.z, rv.w}; };
    bf16x8_t q[4];
    { const bf16_t* qp = p.QN + (size_t)row * 1024 + (g * 4 + hd) * 64 + 8 * hh;
#pragma unroll
      for (int ks = 0; ks < 4; ++ks) q[ks] = *(const bf16x8_t*)(qp + 16 * ks); }
    const float g0 = p.GATE[(size_t)row * 48 + (g * 4 + hd) * 3 + 0], g1 = p.GATE[(size_t)row * 48 + (g * 4 + hd) * 3 + 1], g2 = p.GATE[(size_t)row * 48 + (g * 4 + hd) * 3 + 2];
    LAS float* outp = (LAS float*)(lds + NS_OUT) + (wave * 32 + r32) * 68 + 4 * hh;
    NsaState s; s.m = NEGBIG; s.l = 0.f; s.o0 = (f32x16){}; s.o1 = (f32x16){};
    const bf16_t* kc = p.KCMP_P + (size_t)bg * 128 * 64; const bf16_t* vct = p.VCMPT_P + (size_t)bg * 64 * 128;
    issue(kc, 64, vct, 128); commit(0); issue(kc + 64 * 64, 64, vct + 64, 128); commit(1);
    __syncthreads();
    const int limc = (t >= 31) ? ((t - 31) >> 4) : -1;
    {
        nsa_tile<1>(lds, q, s, 0, limc, r32, hh); if (qi >= 16) nsa_tile<1>(lds + NS_STAGE, q, s, 0, limc - 64, r32, hh);
        const float lt = s.l + __shfl_xor(s.l, 32); s.l = lt > 0.f ? 1.f / lt : 0.f;
        LAS float* PCS = (hd == 0) ? (LAS float*)(lds + NS_PCS) + tl * 128 : (LAS float*)(lds + NS_SC);
        nsa_tile<2>(lds, q, s, 0, limc, r32, hh, qi >= 16 ? PCS : nullptr, 0); if (qi >= 16) nsa_tile<2>(lds + NS_STAGE, q, s, 0, limc - 64, r32, hh, PCS, 64);
        __syncthreads();
    }
    if (qi >= 16) {
        const LAS float* PCS = (const LAS float*)(lds + NS_PCS);
        LAS float* SCR = (LAS float*)(lds + NS_SC); LAS unsigned* SEL = (LAS unsigned*)(lds + NS_SEL);
        { const int tk = tid >> 3, jq = tid & 7;
#pragma unroll
          for (int u = 0; u < 4; ++u) { const int j = jq * 4 + u; float sm = 0.f;
#pragma unroll
              for (int o = 0; o < 5; ++o) { const int ki = 4 * j - 1 + o; if (ki >= 0 && ki < 127) sm += PCS[tk * 128 + ki]; }
              SCR[tk * 32 + j] = (j <= qi) ? sm + ((j == 0 || j == qi) ? 1e4f : 0.f) : NEGBIG; }
        }
        __syncthreads();
        { const int tk = tid >> 3, jq = tid & 7; unsigned bits = 0u;
#pragma unroll
          for (int u = 0; u < 4; ++u) { const int j = jq * 4 + u; const float sj = SCR[tk * 32 + j]; int rank = 0;
              for (int j2 = 0; j2 < 32; ++j2) { const float s2 = SCR[tk * 32 + j2]; rank += (s2 > sj || (s2 == sj && j2 < j)) ? 1 : 0; }
              if (rank < 16) bits |= 1u << j; }
          bits |= __shfl_xor(bits, 1); bits |= __shfl_xor(bits, 2); bits |= __shfl_xor(bits, 4);
          if (jq == 0) SEL[tk] = bits; }
        __syncthreads();
    }
    s.l = 0.5f; nsa_finish<true>(s, g0, outp);
    const unsigned selmask = (qi < 16) ? 0xffffffffu : ((LAS unsigned*)(lds + NS_SEL))[tl];
    const int wlo = qi > 8 ? qi - 8 : 0, nslc = qi + 1, nsteps = nslc + (qi - wlo + 1);
    const bf16_t* ksl = p.KV6 + (size_t)(b * SEQ) * 1536 + 2 * 256 + g * 64; const bf16_t* kwn = ksl + 2 * 256;
    const bf16_t* vsl = p.VTS + (size_t)bg * 64 * SEQ; const bf16_t* vwn = p.VTW + (size_t)bg * 64 * SEQ;
    v4u rkB, rvB;
#define NSA_ISSUE(RK, RV, u) do { const int u_ = (u); const bf16_t* kb_; const bf16_t* vb_; \
        if (u_ < nslc) { kb_ = ksl + (size_t)(64 * u_) * 1536; vb_ = vsl + 64 * u_; } else { const int j_ = wlo + (u_ - nslc); kb_ = kwn + (size_t)(64 * j_) * 1536; vb_ = vwn + 64 * j_; } \
        RK = *(const v4u*)(kb_ + (size_t)srow * 1536 + sch * 8); RV = *(const v4u*)(vb_ + (size_t)srow * SEQ + sch * 8); } while (0)
#define NSA_COMMIT(RK, RV, s_) do { LAS unsigned char* st_ = lds + (s_) * NS_STAGE; *(LAS v4u*)(st_ + NS_KOFF + srow * 144 + sch * 16) = RK; \
        *(LAS v2u*)(st_ + NS_VOFF + srow * 136 + sch * 16) = (v2u){RV.x, RV.y}; *(LAS v2u*)(st_ + NS_VOFF + srow * 136 + sch * 16 + 8) = (v2u){RV.z, RV.w}; } while (0)
#define NSA_STEP(u) do { const int u__ = (u); int lo = 0, hi = 63; \
        if (u__ < nslc) { if (!((selmask >> u__) & 1u)) hi = -1; else if (u__ == qi) hi = tl; } \
        else { const int j_ = wlo + (u__ - nslc); if (j_ == qi) hi = tl; if (j_ == qi - 8) lo = tl; } \
        if (u__ == nslc) nsa_finish<false>(s, g1, outp); \
        nsa_tile<0>(lds + (u__ & 1) * NS_STAGE, q, s, lo, hi, r32, hh); } while (0)
    NSA_ISSUE(rk, rv, 0); NSA_COMMIT(rk, rv, 0);
    if (nsteps > 1) NSA_ISSUE(rk, rv, 1);
    __syncthreads();
    for (int u = 0; u < nsteps; u += 2) {
        if (u + 2 < nsteps) NSA_ISSUE(rkB, rvB, u + 2);
        NSA_STEP(u);
        if (u + 1 < nsteps) NSA_COMMIT(rk, rv, 1);
        LDS_BARRIER();
        if (u + 1 < nsteps) {
            if (u + 3 < nsteps) NSA_ISSUE(rk, rv, u + 3);
            NSA_STEP(u + 1);
            if (u + 2 < nsteps) NSA_COMMIT(rkB, rvB, 0);
            LDS_BARRIER();
        }
    }
#undef NSA_ISSUE
#undef NSA_COMMIT
#undef NSA_STEP
    { const float lt = s.l + __shfl_xor(s.l, 32); const float sc = lt > 0.f ? g2 / lt : 0.f;
      bf16_t* op = p.OA + (size_t)row * 1024 + (g * 4 + hd) * 64 + 4 * hh;
#pragma unroll
      for (int k = 0; k < 4; ++k) { const f32x4 a = *(const LAS f32x4*)(outp + 8 * k), c = *(const LAS f32x4*)(outp + 32 + 8 * k);
          v2u w; w.x = cvtpk(a[0] + s.o0[4 * k] * sc, a[1] + s.o0[4 * k + 1] * sc); w.y = cvtpk(a[2] + s.o0[4 * k + 2] * sc, a[3] + s.o0[4 * k + 3] * sc); *(v2u*)(op + 8 * k) = w;
          v2u w1; w1.x = cvtpk(c[0] + s.o1[4 * k] * sc, c[1] + s.o1[4 * k + 1] * sc); w1.y = cvtpk(c[2] + s.o1[4 * k + 2] * sc, c[3] + s.o1[4 * k + 3] * sc); *(v2u*)(op + 32 + 8 * k) = w1; } }
}

constexpr int SS_Q = 0, SS_SC = 256, SS_PART = SS_SC + 4 * 1088, SS_REDM = SS_PART + 2048, SS_REDS = SS_REDM + 8, SS_GATE = SS_REDS + 8, SS_SCORE = SS_GATE + 16, SS_SEL = SS_SCORE + 272, SS_SELO = SS_SEL + 16, SS_OACC = SS_SELO + 16, SS_END = SS_OACC + 256;
__device__ __forceinline__ f32x4 ld4_bf(const bf16_t* ptr) { const v2u w = *(const v2u*)ptr; return (f32x4){bf2f((bf16_t)(w.x & 0xffff)), bf2f((bf16_t)(w.x >> 16)), bf2f((bf16_t)(w.y & 0xffff)), bf2f((bf16_t)(w.y >> 16))}; }
template <int N> __device__ __forceinline__ float dpp_ror(float v) { return __builtin_bit_cast(float, __builtin_amdgcn_update_dpp(0, __builtin_bit_cast(int, v), 0x120 + N, 0xf, 0xf, false)); }
__device__ __forceinline__ float row16_sum(float t) { t += dpp_ror<8>(t); t += dpp_ror<4>(t); t += dpp_ror<2>(t); t += dpp_ror<1>(t); return t; }
template <class KF, class VF>
__device__ __forceinline__ void nsa_s_branch(LAS float* L, int nk, KF keyf, VF valf, int gsel, int tid) {
    const int lane = tid & 63, wave = tid >> 6, d4 = (lane & 15) * 4, ksub = lane >> 4;
    LAS float* q = L + SS_Q; LAS float* sc = L + SS_SC; LAS float* part = L + SS_PART; LAS float* redm = L + SS_REDM; LAS float* reds = L + SS_REDS;
    f32x4 qv[4];
#pragma unroll
    for (int hd = 0; hd < 4; ++hd) qv[hd] = *(const LAS f32x4*)(q + hd * 64 + d4);
    for (int base = wave * 4; base < nk; base += 256) {
        f32x4 kx[8]; bool vld[8];
#pragma unroll
        for (int u = 0; u < 8; ++u) { int kk = base + 32 * u + ksub; kk = kk < nk ? kk : nk - 1; kx[u] = keyf(kk, d4, vld[u]); }
#pragma unroll
        for (int u = 0; u < 8; ++u) { const int kk = base + 32 * u + ksub; float pd[4];
#pragma unroll
            for (int hd = 0; hd < 4; ++hd) pd[hd] = row16_sum((qv[hd][0] * kx[u][0] + qv[hd][1] * kx[u][1]) + (qv[hd][2] * kx[u][2] + qv[hd][3] * kx[u][3]));
            if (kk < nk && (lane & 15) == 0) {
#pragma unroll
                for (int hd = 0; hd < 4; ++hd) sc[hd * 1088 + kk] = vld[u] ? pd[hd] : -INFINITY; } } }
    __syncthreads();
    { const int hd = wave & 3, half = wave >> 2; LAS float* sh = sc + hd * 1088;
      float m = -INFINITY; for (int kk = half * 64 + lane; kk < nk; kk += 128) m = fmaxf(m, sh[kk]);
      m = wave_max(m); if (lane == 0) redm[wave] = m;
      __syncthreads();
      m = fmaxf(redm[hd], redm[hd + 4]); float sm = 0.f;
      for (int kk = half * 64 + lane; kk < nk; kk += 128) { const float x = sh[kk]; const float e = (x == -INFINITY) ? 0.f : __expf(x - m); sh[kk] = e; sm += e; }
      sm = wave_sum(sm); if (lane == 0) reds[wave] = sm;
      __syncthreads();
      const float tot = reds[hd] + reds[hd + 4]; const float inv = tot > 0.f ? 1.f / tot : 0.f;
      for (int kk = half * 64 + lane; kk < nk; kk += 128) sh[kk] *= inv; }
    __syncthreads();
    { f32x4 o[4];
#pragma unroll
      for (int hd = 0; hd < 4; ++hd) o[hd] = (f32x4){0.f, 0.f, 0.f, 0.f};
      for (int base = wave * 4; base < nk; base += 256) { f32x4 vv[8];
#pragma unroll
          for (int u = 0; u < 8; ++u) { int kk = base + 32 * u + ksub; kk = kk < nk ? kk : nk - 1; vv[u] = valf(kk, d4); }
#pragma unroll
          for (int u = 0; u < 8; ++u) { const int kk = base + 32 * u + ksub; const bool inr = kk < nk; const int kc2 = inr ? kk : nk - 1;
#pragma unroll
              for (int hd = 0; hd < 4; ++hd) { const float pr = inr ? sc[hd * 1088 + kc2] : 0.f; o[hd] = o[hd] + vv[u] * pr; } } }
#pragma unroll
      for (int hd = 0; hd < 4; ++hd)
#pragma unroll
          for (int e = 0; e < 4; ++e) { float t = o[hd][e]; t += __shfl_xor(t, 16); t += __shfl_xor(t, 32); o[hd][e] = t; }
      if (ksub == 0) {
#pragma unroll
          for (int hd = 0; hd < 4; ++hd) *(LAS f32x4*)(part + (wave * 4 + hd) * 64 + d4) = o[hd]; } }
    __syncthreads();
    if (tid < 256) { float o = 0.f;
#pragma unroll
        for (int w = 0; w < 8; ++w) o += part[w * 256 + tid];
        L[SS_OACC + tid] += L[SS_GATE + (tid >> 6) * 3 + gsel] * o; }
    __syncthreads();
}
__device__ __forceinline__ void nsa_sample_item(const Params& p, LAS unsigned char* lds, int item, int tid) {
    const int b = item >> 2, g = item & 3, bg = item, row = NPT + b;
    constexpr int pos = PAST, n_cmp = 1023, n_slc = 257;
    LAS float* L = (LAS float*)lds; LAS float* sc = L + SS_SC; LAS float* score = L + SS_SCORE; LAS int* selidx = (LAS int*)(L + SS_SEL); LAS unsigned* selofs = (LAS unsigned*)(L + SS_SELO);
    if (tid < 256) { L[SS_Q + tid] = bf2f(p.QN[(size_t)row * 1024 + g * 256 + tid]); L[SS_OACC + tid] = 0.f; }
    if (tid < 12) L[SS_GATE + tid] = p.GATE[(size_t)row * 48 + g * 12 + tid];
    __syncthreads();
    SSTAMP(40);
    const bf16_t* kc = p.KCMP_S + (size_t)bg * 1024 * 64; const bf16_t* vc = p.VCMP_S + (size_t)bg * 1024 * 64;
    nsa_s_branch(L, n_cmp, [&](int kk, int d4, bool& valid) { valid = true; return ld4_bf(kc + (size_t)kk * 64 + d4); }, [&](int kk, int d4) { return ld4_bf(vc + (size_t)kk * 64 + d4); }, 0, tid);
    SSTAMP(41);
    for (int j = tid; j < n_slc; j += 512) { float s = 0.f;
        for (int i = 4 * j - 1; i <= 4 * j + 3; ++i) if (i >= 0 && i < n_cmp) s += (sc[i] + sc[1088 + i]) + (sc[2 * 1088 + i] + sc[3 * 1088 + i]);
        score[j] = s + ((j == 0 || j == pos / 64) ? 1e4f : 0.f); }
    __syncthreads();
    { const int j = tid >> 1, half = tid & 1, jb = half ? 129 : 0, je = half ? 257 : 129; const float sj = score[j]; int cnt = 0;
#pragma unroll 8
      for (int j2 = jb; j2 < je; ++j2) { const float s2 = score[j2]; cnt += (s2 > sj || (s2 == sj && j2 < j)) ? 1 : 0; }
      cnt += __shfl_xor(cnt, 1);
      if (half == 0 && cnt < 16) { selidx[cnt] = j; selofs[cnt] = (unsigned)((((size_t)p.page_table[b * NPAGES + (j >> 1)] * PAGE + (j & 1) * 64) * 4 + g) * 64); }
      if (tid == 0) { selidx[1] = 256; selofs[1] = 0xffffffffu; } }
    __syncthreads();
    SSTAMP(42);
    const bf16_t* newrow = p.KV6 + (size_t)row * 1536 + g * 64;
    nsa_s_branch(L, 1024,
        [&](int kk, int d4, bool& valid) { const unsigned so = selofs[kk >> 6]; const int r = kk & 63;
            if (so != 0xffffffffu) { valid = true; return *(const f32x4*)(p.csk + so + (size_t)r * 256 + d4); } valid = (r == 0); return ld4_bf(newrow + 2 * 256 + d4); },
        [&](int kk, int d4) { const unsigned so = selofs[kk >> 6]; const int r = kk & 63;
            if (so != 0xffffffffu) return *(const f32x4*)(p.csv + so + (size_t)r * 256 + d4); return ld4_bf(newrow + 3 * 256 + d4); }, 1, tid);
    SSTAMP(43);
    nsa_s_branch(L, 513,
        [&](int kk, int d4, bool& valid) { valid = true; if (kk < 512) return *(const f32x4*)(p.cwk + (((size_t)b * 512 + kk) * 4 + g) * 64 + d4); return ld4_bf(newrow + 4 * 256 + d4); },
        [&](int kk, int d4) { if (kk < 512) return *(const f32x4*)(p.cwv + (((size_t)b * 512 + kk) * 4 + g) * 64 + d4); return ld4_bf(newrow + 5 * 256 + d4); }, 2, tid);
    SSTAMP(44);
    if (tid < 256) p.OA[(size_t)row * 1024 + g * 256 + tid] = f2bf(L[SS_OACC + tid]);
    __syncthreads();
}

#define XB_TMO      128
#define XB_XCNT(j)  (256  + 64 * (j))
#define XB_XSUB(j)  (1280 + 64 * (j))
#define XB_XGEN(j)  (2304 + 64 * (j))
#define XB_TOP      3328
#define XB_TOPGEN   3392
#define XCD_BAR_WORDS 3456
#define XB_SPIN_CAP (1u << 22)

__device__ __forceinline__ unsigned xb_ld(unsigned* p)              { return __hip_atomic_load(p, __ATOMIC_RELAXED, __HIP_MEMORY_SCOPE_AGENT); }
__device__ __forceinline__ unsigned xb_add(unsigned* p, unsigned v) { return __hip_atomic_fetch_add(p, v, __ATOMIC_RELAXED, __HIP_MEMORY_SCOPE_AGENT); }
__device__ __forceinline__ unsigned xb_xcc_id() { return (unsigned)__builtin_amdgcn_s_getreg((3 << 11) | 20) & 0xFu; }
#define XB_SPIN(cond, bar) do { unsigned _sp = 0; while (cond) { __builtin_amdgcn_s_sleep(1); \
    if ((++_sp & 255u) == 0u) { if (xb_ld(&(bar)[XB_TMO])) break; if (_sp > XB_SPIN_CAP) { atomicAdd(&(bar)[XB_TMO], 1u); break; } } } } while (0)

struct XcdBarrier {
    unsigned* bar; unsigned x;
    volatile LAS unsigned* st;
};

__device__ __forceinline__ XcdBarrier xcd_barrier_post(unsigned* bar, volatile LAS unsigned* st) {
    XcdBarrier b; b.bar = bar; b.x = xb_xcc_id(); b.st = st;
    if (threadIdx.x == 0) (void)xb_add(&bar[XB_XCNT(b.x)], 1u);
    return b;
}
__device__ __forceinline__ void xcd_barrier_complete(unsigned* bar, unsigned x, unsigned& nloc, unsigned& nx) {
    const unsigned G = gridDim.x * gridDim.y * gridDim.z;
    unsigned sum, cnt, mine, sp = 0u;
    for (;;) {
        sum = 0u; cnt = 0u; mine = 0u;
#pragma unroll
        for (unsigned j = 0; j < 16; ++j) { const unsigned c = xb_ld(&bar[XB_XCNT(j)]); sum += c; cnt += (c > 0u) ? 1u : 0u; mine = (j == x) ? c : mine; }
        if (sum == G) break;
        __builtin_amdgcn_s_sleep(1);
        if ((++sp & 255u) == 0u) { if (xb_ld(&bar[XB_TMO])) break; if (sp > XB_SPIN_CAP) { atomicAdd(&bar[XB_TMO], 1u); break; } }
    }
    nloc = mine > 0u ? mine : 1u; nx = cnt > 0u ? cnt : 1u;
}

__device__ __forceinline__ void xcd_barrier(const XcdBarrier& b) {
    asm volatile("s_waitcnt vmcnt(0)" ::: "memory");
    __syncthreads();
    if (threadIdx.x == 0) {
        unsigned* bar = b.bar;
        __builtin_amdgcn_s_waitcnt(0);
        unsigned nloc = b.st[0], nx = b.st[1];
        if (nloc == 0u) { xcd_barrier_complete(bar, b.x, nloc, nx); b.st[0] = nloc; b.st[1] = nx; }
        const unsigned old = xb_add(&bar[XB_XSUB(b.x)], 1u);
        const unsigned gen = old / nloc;
        if (old + 1u == (gen + 1u) * nloc) {
            __builtin_amdgcn_fence(__ATOMIC_RELEASE, "agent");
            asm volatile("s_waitcnt vmcnt(0)" ::: "memory");
            const unsigned og = xb_add(&bar[XB_TOP], 1u);
            const unsigned tg = og / nx;
            if (og + 1u == (tg + 1u) * nx) xb_add(&bar[XB_TOPGEN], 1u);
            else XB_SPIN(xb_ld(&bar[XB_TOPGEN]) == tg, bar);
            __builtin_amdgcn_fence(__ATOMIC_ACQUIRE, "agent");
            xb_add(&bar[XB_XGEN(b.x)], 1u);
            asm volatile("s_waitcnt vmcnt(0)" ::: "memory");
        } else {
            XB_SPIN(xb_ld(&bar[XB_XGEN(b.x)]) == gen, bar);
            __builtin_amdgcn_fence(__ATOMIC_ACQUIRE, "agent");
            asm volatile("s_waitcnt vmcnt(0)" ::: "memory");
        }
    }
    __syncthreads();
}

constexpr int LDS_BYTES = 147456;
constexpr int LDSCTL_OFF = 131072, MISC_OFF = LDSCTL_OFF + 320;
constexpr int CW_BAR = 4096;
enum Phase { PH_PRO0 = 0, PH_PRO = 1, PH_IN = 2, PH_MID = 3, PH_ATT = 4, PH_BRA = 5, PH_BRB = 6, PH_WO = 7, PH_UP = 8, PH_DOWN = 9, PH_NORM = 10, PH_END = 11 };
__global__ void __launch_bounds__(512, 2) mk_fwd(Params p, int ph_lo, int ph_hi, int li) {
    extern __shared__ __attribute__((aligned(16))) unsigned char lds_raw[];
    LAS unsigned char* lds = (LAS unsigned char*)lds_raw;
    const int tid = threadIdx.x, bid = blockIdx.x, G = gridDim.x;
    for (int u = tid; u < (LDS_BYTES - LDSCTL_OFF) / 4; u += 512) ((LAS unsigned*)(lds + LDSCTL_OFF))[u] = 0u;
    __syncthreads();
    XcdBarrier bar; bar.bar = p.CTL + CW_BAR + li * XCD_BAR_WORDS; bar.x = 0; bar.st = nullptr;
    if (ph_hi - ph_lo > 1) bar = xcd_barrier_post(p.CTL + CW_BAR + li * XCD_BAR_WORDS, (volatile LAS unsigned*)(lds + MISC_OFF) + 8);
    if (PROBE_PHASE >= 0 && bid == 0 && tid == 0) ((LAS unsigned long long*)(lds + LDSCTL_OFF + 512))[0] = __builtin_amdgcn_s_memrealtime();
#define IN(k) (ph_lo <= (k) && (k) < ph_hi)
#define STAMP(i) do { if (PROBE_A >= 0 && bid == PROBE_BID && tid == 0) { ((unsigned long long*)(p.CTL + 2048))[i] = __builtin_amdgcn_s_memrealtime(); } } while (0)
#define SEAM(k) do { if (ph_lo <= (k) && (k) + 1 < ph_hi) xcd_barrier(bar); if (PROBE_PHASE >= 0 && bid == 0 && tid == 0) ((LAS unsigned long long*)(lds + LDSCTL_OFF + 512))[(k) + 1] = __builtin_amdgcn_s_memrealtime(); } while (0)
#define REP(k) _Pragma("unroll 1") for (int rep_ = 0; rep_ < 1 + ((REP_MASK >> (k)) & 1); ++rep_)
    if (IN(PH_PRO)) { if (PROBE_PHASE >= 0 && bid == 0 && tid == 0) ((LAS unsigned long long*)(lds + LDSCTL_OFF + 512))[PH_PRO] = __builtin_amdgcn_s_memrealtime();
      REP(PH_PRO) {
        STAMP(10); ph_pro0(p, lds, bid, G, tid);
        VM_WAIT(); __syncthreads(); STAMP(11);
        if (tid == 0) { __builtin_amdgcn_fence(__ATOMIC_RELEASE, "agent"); VM_WAIT(); __hip_atomic_fetch_add(p.CTL + 1088, 1u, __ATOMIC_RELAXED, __HIP_MEMORY_SCOPE_AGENT); }
        if (G > 32) { if (bid < G - 16) ph_prologue(p, lds, bid, G - 16, tid, 2); } else ph_prologue(p, lds, bid, G, tid, 2);
        __syncthreads(); STAMP(12);
        if (tid == 0) { unsigned sp = 0; while (__hip_atomic_load(p.CTL + 1088, __ATOMIC_RELAXED, __HIP_MEMORY_SCOPE_AGENT) < (unsigned)G * (1 + rep_)) { __builtin_amdgcn_s_sleep(2); if (++sp > (1u << 22)) break; }
            __builtin_amdgcn_fence(__ATOMIC_ACQUIRE, "agent"); VM_WAIT(); }
        __syncthreads(); STAMP(13);
        { const int lim = (G > 32) ? 512 : 528, extra = (G > 32 && bid >= G - 16) ? 512 + (bid - (G - 16)) : -1;
          int t = bid; bool fin = false;
#pragma unroll 1
          while (!fin) { int tt = t; if (t >= lim) { if (extra < 0) break; tt = extra; fin = true; } cmp_gemm_tile<true>(p, lds, tt, tid); t += G; } }
        __syncthreads(); STAMP(14); if (G > 32) { if (bid >= 4 && bid < G - 16) ph_prologue(p, lds, bid - 4, G - 20, tid, 1); } else ph_prologue(p, lds, bid, G, tid, 1);
        if (G > 32 && bid < G - 16) ph_late_weights(p, lds, bid * 8 + (tid >> 6), (G - 16) * 8, tid, 0, LATE_PRO);
        __syncthreads(); STAMP(15); } SEAM(PH_PRO); STAMP(16); }
    if (IN(PH_IN)) { REP(PH_IN) {
        STAMP(30); skinny_gemm(lds, p.XB + (size_t)NPT * DM, DM, p.WIN_T, NIN_PAD, DM, F_proj_s{p}, bid, G, tid);
        VM_WAIT(); __syncthreads();
        if (tid == 0) { __builtin_amdgcn_fence(__ATOMIC_RELEASE, "agent"); VM_WAIT(); __hip_atomic_fetch_add(p.CTL + 1024, 1u, __ATOMIC_RELAXED, __HIP_MEMORY_SCOPE_AGENT); }
        { pg8::Gemm g{p.XB, p.WIN_T, NPT, NIN_PAD, DM}; pg8::StaticOrder S; S.init(NPT, NIN_PAD, G, bid);
          EpiProj E{p.RSTD1, p.b_gate, p.QN, p.KV6, p.GQ, p.GK, p.GV, p.GR, p.BR, p.GATE, p.LR, p.out};
          pg8::gemm_phase<EpiProj, pg8::StaticOrder, true, true>(lds, g, S, E); } STAMP(31);
        for (int it = G - 1 - bid; it < 32; it += G) {
            if (tid == 0) { unsigned sp = 0; while (__hip_atomic_load(p.CTL + 1024, __ATOMIC_RELAXED, __HIP_MEMORY_SCOPE_AGENT) < (unsigned)G * (1 + rep_)) { __builtin_amdgcn_s_sleep(2); if (++sp > (1u << 22)) break; }
                __builtin_amdgcn_fence(__ATOMIC_ACQUIRE, "agent"); VM_WAIT(); }
            __syncthreads();
            nsa_sample_item(p, lds, it, tid); }
        STAMP(32); }
        SEAM(PH_IN); STAMP(33); }
    if (IN(PH_MID)) { REP(PH_MID) { STAMP(20);
        for (int t = bid; t < 32; t += G) { cmp_gemm_tile<false>(p, lds, t, tid); __builtin_amdgcn_fence(__ATOMIC_RELEASE, "workgroup"); VM_WAIT(); __syncthreads(); cmp_part2<false>(p, lds, t >> 4, t & 15, 0, tid); }
        STAMP(21);
        const int gsplit = (G * 20) / 32;
        const int lw0 = (G > 32) ? LATE_PRO : 0;
        { int ga0 = bid, gas = G; if (G >= 128) { ga0 = (bid >= 32 && bid < gsplit) ? bid - 32 : 512; gas = gsplit - 32; }
          if (ga0 < 512) { GlaAIn cur = gla_a_issue(p, ga0, tid);
#pragma unroll 1
              for (int it = ga0; it < 512; it += gas) { const GlaAIn nxt = gla_a_issue(p, (it + gas < 512) ? it + gas : it, tid); gla_pass_a(p, lds, it, tid, cur); cur = nxt; } } }
        STAMP(23);
        for (int it = G - 1 - bid; it < 32; it += G) gla_sample_item(p, lds, it, tid); STAMP(24);
        { const int wave = tid >> 6; for (int it = bid * 8 + wave; it < 1024; it += G * 8) nsa_vt_tile(p, lds + wave * 16384, it, tid & 63); } __syncthreads(); STAMP(25);
        if (G >= 128) { int lg = bid * 8 + (tid >> 6), ln = 32 * 8, l0 = lw0, l1 = lw0;
            if (bid >= gsplit) { lg = (bid - gsplit) * 8 + (tid >> 6); ln = (G - gsplit) * 8; l0 = lw0 + 640; l1 = 1 << 30; } else if (bid >= 32) { lg = (bid - 32) * 8 + (tid >> 6); ln = (gsplit - 32) * 8; l0 = lw0; l1 = lw0 + 640; }
            ph_late_weights(p, lds, lg, ln, tid, l0, l1); }
        else ph_late_weights(p, lds, bid * 8 + (tid >> 6), G * 8, tid, lw0);
        __syncthreads(); STAMP(26); }
        SEAM(PH_MID); }
    if (IN(PH_ATT)) { REP(PH_ATT) {
        gla_pass_b(p, bid, G, tid);
        VM_WAIT(); __syncthreads();
        if (tid == 0) { __builtin_amdgcn_fence(__ATOMIC_RELEASE, "agent"); VM_WAIT(); __hip_atomic_fetch_add(p.CTL + 1152, 1u, __ATOMIC_RELAXED, __HIP_MEMORY_SCOPE_AGENT); }
        STAMP(53);
        for (int it = bid; it < 256; it += G) { const int bg = it & 15, sq = it >> 4;
#pragma unroll 1
            for (int k = 0; k < 2; ++k) { STAMP(50 + k); nsa_prompt_item(p, lds, bg, k ? sq : 31 - sq, tid); __syncthreads(); } }
        STAMP(52);
        if (tid == 0) { unsigned sp = 0; while (__hip_atomic_load(p.CTL + 1152, __ATOMIC_RELAXED, __HIP_MEMORY_SCOPE_AGENT) < (unsigned)G * (1 + rep_)) { __builtin_amdgcn_s_sleep(2); if (++sp > (1u << 22)) break; }
            __builtin_amdgcn_fence(__ATOMIC_ACQUIRE, "agent"); VM_WAIT(); }
        __syncthreads();
        { volatile LAS int* slot = (volatile LAS int*)(lds + LDSCTL_OFF + 2048);
          int it = bid; STAMP(30);
#pragma unroll 1
          while (it < 512) { int nxt = 0; if (tid == 0) nxt = G + (int)__hip_atomic_fetch_add(p.CTL + 1344, 1u, __ATOMIC_RELAXED, __HIP_MEMORY_SCOPE_AGENT);
              gla_pass_c(p, lds, it, tid);
              if (tid == 0) *slot = nxt;
              __syncthreads(); it = __builtin_amdgcn_readfirstlane(*slot); }
          STAMP(31); } __syncthreads(); }
        SEAM(PH_ATT); }
    if (IN(PH_BRA)) { if (PROBE_PHASE >= 0 && bid == 0 && tid == 0) ((LAS unsigned long long*)(lds + LDSCTL_OFF + 512))[PH_BRB] = __builtin_amdgcn_s_memrealtime();
      REP(PH_BRA) {
        { const F_bra f{p.BR, (bf16_t*)p.TMP};
          { pg8::Gemm g{p.OA, p.WBRA_T, NPT, DM, 1024}; pg8::StaticOrder S; S.init(NPT, DM, G, bid); EpiGen<F_bra> E{f}; pg8::gemm_phase<EpiGen<F_bra>, pg8::StaticOrder, true, true>(lds, g, S, E); }
          skinny_gemm(lds, p.OA + (size_t)NPT * 1024, 1024, p.WBRA_T, DM, 1024, f, bid, G, tid); }
        { const F_brb f{p.BR, (const bf16_t*)p.TMP, p.MB};
          { pg8::Gemm g{p.OB, p.WBRB_T, NPT, DM, 1024}; pg8::StaticOrder S; S.init(NPT, DM, G, bid); EpiGen<F_brb> E{f}; pg8::gemm_phase<EpiGen<F_brb>, pg8::StaticOrder, true, true>(lds, g, S, E); }
          skinny_gemm(lds, p.OB + (size_t)NPT * 1024, 1024, p.WBRB_T, DM, 1024, f, bid, G, tid); } }
        SEAM(PH_BRB); }
    if (IN(PH_WO)) { STAMP(60);
        { const F_wo f{p.x_prompt, p.X1B, p.SUMSQ2}; pg8::Gemm g{p.MB, p.WO_T, NPT, DM, DM}; pg8::StaticOrder S; S.init(NPT, DM, G, bid); EpiGen<F_wo> E{f}; pg8::gemm_phase<EpiGen<F_wo>, pg8::StaticOrder, true, true>(lds, g, S, E); } STAMP(61);
        if (PROBE_A >= 0 && bid == PROBE_BID && tid == 0) { for (int i = 0; i < 4; ++i) ((unsigned long long*)(p.CTL + 2048))[70 + i] = ((LAS unsigned long long*)(lds + 135168))[i]; }
        { const F_wo f{p.x_sample - (size_t)NPT * DM, p.X1B, p.SUMSQ2}; skinny_gemm(lds, p.MB + (size_t)NPT * DM, DM, p.WO_T, DM, DM, f, bid, G, tid); } STAMP(62); SEAM(PH_WO); STAMP(63); }
    if (IN(PH_UP)) { REP(PH_UP) { const F_up f{p.SUMSQ2, p.HF};
        { pg8::Gemm g{p.X1B, p.WUP_T, NPT, DFF, DM}; pg8::StaticOrder S; S.init(NPT, DFF, G, bid); EpiGen<F_up> E{f}; pg8::gemm_phase<EpiGen<F_up>, pg8::StaticOrder, true, true>(lds, g, S, E); }
        skinny_gemm(lds, p.X1B + (size_t)NPT * DM, DM, p.WUP_T, DFF, DM, f, bid, G, tid); } SEAM(PH_UP); }
    const bool fusedn = (G == 256) && PROBE_A < 0 && PROBE_PHASE < 0;
    if (IN(PH_DOWN)) {
        { const F_down f{p.X1B, (bf16_t*)p.X1, p.SUMSQ3}; skinny_gemm(lds, p.HF + (size_t)NPT * DFF, DFF, p.WDN_T, DM, DFF, f, bid, G, tid); }
        if (fusedn) {
            volatile LAS unsigned* lastf = (volatile LAS unsigned*)(lds + LDSCTL_OFF + 64);
            VM_WAIT(); __syncthreads();
            if (tid == 0) { __builtin_amdgcn_fence(__ATOMIC_RELEASE, "agent"); VM_WAIT(); const unsigned old = __hip_atomic_fetch_add(p.CTL + 1280, 1u, __ATOMIC_RELAXED, __HIP_MEMORY_SCOPE_AGENT);
                const unsigned last = (old == (unsigned)G - 1u) ? 1u : 0u; if (last) { __builtin_amdgcn_fence(__ATOMIC_ACQUIRE, "agent"); VM_WAIT(); } lastf[0] = last; }
            __syncthreads();
            if (lastf[0]) ph_final_norm(p, 0, 1, tid, NPT);
            __syncthreads();
            pg8::Gemm g{p.HF, p.WDN_T, NPT, DM, DFF}; pg8::StaticOrder S; S.init(NPT, DM, G, bid); EpiDownNorm E{p.X1B, p.SUMSQ3, p.out + OFF_Y, p.norm_f, p.CTL + 8192};
            pg8::gemm_phase<EpiDownNorm, pg8::StaticOrder, false, true>(lds, g, S, E);
        } else {
            { const F_down f{p.X1B, (bf16_t*)p.X1, p.SUMSQ3}; pg8::Gemm g{p.HF, p.WDN_T, NPT, DM, DFF}; pg8::StaticOrder S; S.init(NPT, DM, G, bid); EpiGen<F_down> E{f}; pg8::gemm_phase<EpiGen<F_down>, pg8::StaticOrder, true, true>(lds, g, S, E); }
            SEAM(PH_DOWN); } }
    if (IN(PH_NORM) && !fusedn) { ph_final_norm(p, bid, G, tid);
        if (PROBE_A >= 0 && bid == 0) { const unsigned long long* tg = (const unsigned long long*)(p.CTL + 2048); const float X = (float)(tg[PROBE_B] - tg[PROBE_A]) * 1e-7f, f = 1.f + sqrtf(X);
            for (int i = tid; i < 2048; i += 512) p.out[OFF_SCK + i] *= f; }
        if (PROBE_PHASE >= 0 && bid == 0) { __syncthreads(); const LAS unsigned long long* ts = (const LAS unsigned long long*)(lds + LDSCTL_OFF + 512);
            const float X = (float)(ts[PROBE_PHASE + 1] - ts[PROBE_PHASE]) * 1e-7f, f = 1.f + sqrtf(X);
            for (int i = tid; i < 2048; i += 512) p.out[OFF_SCK + i] *= f; } }
#undef IN
#undef SEAM
#undef REP
}
__global__ void __launch_bounds__(256) k_sumsq_rows(const float* X, size_t ld, float* ss_out, int nrows) {
    const int lane = threadIdx.x & 63, row = blockIdx.x * 4 + (threadIdx.x >> 6);
    if (row >= nrows) return;
    float ss = 0.f;
    for (int i = lane; i < DM; i += 64) { const float v = X[(size_t)row * ld + i]; ss += v * v; }
    ss = wave_sum(ss);
    if (lane == 0) ss_out[row] = ss;
}
struct EF_up2 { Params p; __device__ void operator()(int r, int n, float acc) const { const float v = fmaxf(acc * rsqrtf(p.SUMSQ2[r] * (1.f / DM) + EPS), 0.f); p.HF[(size_t)r * DFF + n] = f2bf(v * v); } };

static inline size_t align_up(size_t x) { return (x + 255) & ~(size_t)255; }

extern "C" void kernel_launch(void* const* d_in, const int* in_sizes, int n_in, void* d_out, int out_size, void* d_ws, size_t ws_size, hipStream_t stream) {
    if (n_in != 29 || out_size != (int)OUT_TOTAL) { fprintf(stderr, "kernel_launch: unexpected n_in %d / out_size %d\n", n_in, out_size); return; }
    static int grid = 0;
    if (grid == 0) {
        int dev = 0, cus = 0, per_cu = 0;
        if (hipGetDevice(&dev) != hipSuccess || hipDeviceGetAttribute(&cus, hipDeviceAttributeMultiprocessorCount, dev) != hipSuccess) { fprintf(stderr, "kernel_launch: device query failed\n"); grid = -1; return; }
        if (hipFuncSetAttribute((const void*)mk_fwd, hipFuncAttributeMaxDynamicSharedMemorySize, LDS_BYTES) != hipSuccess) { fprintf(stderr, "kernel_launch: hipFuncSetAttribute failed\n"); grid = -1; return; }
        if (hipOccupancyMaxActiveBlocksPerMultiprocessor(&per_cu, (const void*)mk_fwd, 512, LDS_BYTES) != hipSuccess || per_cu < 1) { fprintf(stderr, "kernel_launch: occupancy query says %d\n", per_cu); per_cu = 1; }
        (void)hipGetLastError();
        grid = cus;
    }
    if (grid < 0) return;
    Params p{};
    p.x_prompt = (const float*)d_in[0]; p.x_sample = (const float*)d_in[1]; p.cck = (const float*)d_in[2]; p.ccv = (const float*)d_in[3];
    p.csk = (const float*)d_in[4]; p.csv = (const float*)d_in[5]; p.cwk = (const float*)d_in[6]; p.cwv = (const float*)d_in[7]; p.state = (const float*)d_in[8];
    p.page_table = (const int*)d_in[9]; p.norm1_g = (const float*)d_in[10]; p.w_in = (const float*)d_in[11]; p.b_gate = (const float*)d_in[12];
    p.pe_k = (const float*)d_in[13]; p.pe_v = (const float*)d_in[14]; p.w1k = (const float*)d_in[15]; p.w2k = (const float*)d_in[16]; p.w1v = (const float*)d_in[17]; p.w2v = (const float*)d_in[18];
    p.w_a2 = (const float*)d_in[19]; p.b_a = (const float*)d_in[20]; p.gnorm = (const float*)d_in[21]; p.w_br_a = (const float*)d_in[22]; p.w_br_b = (const float*)d_in[23];
    p.w_o = (const float*)d_in[24]; p.norm2_g = (const float*)d_in[25]; p.w_up = (const float*)d_in[26]; p.w_down = (const float*)d_in[27]; p.norm_f = (const float*)d_in[28];
    p.out = (float*)d_out;
    char* ws = (char*)d_ws; size_t off = 0;
    auto take = [&](size_t bytes) { char* r = ws + off; off = align_up(off + bytes); return r; };
    p.CTL = (unsigned*)take(1 << 20);
    p.XB = (bf16_t*)take((size_t)NTOK * DM * 2); p.RSTD1 = (float*)take(NTOK * 4); p.QN = (bf16_t*)take((size_t)NTOK * 1024 * 2); p.KV6 = (bf16_t*)take((size_t)NTOK * 1536 * 2);
    p.GATE = (float*)take((size_t)NTOK * 48 * 4); p.GQ = (bf16_t*)take((size_t)NTOK * 512 * 2); p.GK = (bf16_t*)take((size_t)NTOK * 512 * 2); p.GV = (bf16_t*)take((size_t)NTOK * 1024 * 2);
    p.GR = (bf16_t*)take((size_t)NTOK * 1024 * 2); p.LR = (float*)take((size_t)NTOK * 16 * 4); p.BR = (bf16_t*)take((size_t)NTOK * 4096 * 2);
    p.KCMP_P = (bf16_t*)take(16 * 128 * 64 * 2); p.VCMPT_P = (bf16_t*)take(16 * 128 * 64 * 2); p.KCMP_S = (bf16_t*)take(32 * 1024 * 64 * 2); p.VCMP_S = (bf16_t*)take(32 * 1024 * 64 * 2);
    p.OA = (bf16_t*)take((size_t)NTOK * 1024 * 2); p.OB = (bf16_t*)take((size_t)NTOK * 1024 * 2); p.TMP = (float*)take((size_t)NTOK * DM * 4); p.MB = (bf16_t*)take((size_t)NTOK * DM * 2);
    p.X1 = (float*)take((size_t)NTOK * DM * 4); p.X1B = (bf16_t*)take((size_t)NTOK * DM * 2); p.RSTD2 = (float*)take(NTOK * 4); p.HF = (bf16_t*)take((size_t)NTOK * DFF * 2);
    p.WIN_T = (bf16_t*)take((size_t)NIN_PAD * DM * 2); p.WBRA_T = (bf16_t*)take((size_t)DM * 1024 * 2); p.WBRB_T = (bf16_t*)take((size_t)DM * 1024 * 2); p.WO_T = (bf16_t*)take((size_t)DM * DM * 2);
    p.WUP_T = (bf16_t*)take((size_t)DFF * DM * 2); p.WDN_T = (bf16_t*)take((size_t)DM * DFF * 2); p.SUMSQ2 = (float*)take(NTOK * 4); p.SUMSQ3 = (float*)take(NTOK * 4);
    p.W1T = (bf16_t*)take(2 * 256 * 1024 * 2); p.W2TG = (bf16_t*)take(2 * 8192 * 2); p.BIAS1 = (float*)take(256 * 4); p.AB_S = (float*)take((size_t)2 * 32768 * 256 * 4); p.AB_P = (float*)take((size_t)2 * 2048 * 256 * 4);
    p.UT = (float*)take((size_t)512 * 256 * 128 * 2); p.BCG = (float*)take((size_t)512 * 8192 * 4); p.DEC = (float*)take(512 * 128 * 4); p.SNT = (bf16_t*)take((size_t)512 * 256 * 128 * 2);
    p.VTS = (bf16_t*)take((size_t)16 * 64 * SEQ * 2); p.VTW = (bf16_t*)take((size_t)16 * 64 * SEQ * 2);
    if (off > ws_size) { fprintf(stderr, "kernel_launch: workspace too small: need %zu have %zu\n", off, ws_size); return; }
    hipMemsetAsync(p.CTL, 0, 1 << 20, stream);
#define MK(lo, hi, li) hipLaunchKernelGGL(mk_fwd, dim3(grid), dim3(512), LDS_BYTES, stream, p, (int)(lo), (int)(hi), (int)(li))
    MK(PH_PRO0, PH_END, 0);
}
```

```cpp
#include <hip/hip_runtime.h>
#include <stdint.h>
#include <cstdio>

typedef unsigned short bf16_t;

constexpr int DM = 2048, NB = 4, SEQ = 2048, NPT = NB * SEQ, DB = 8, NTOK = NPT + DB;
constexpr int PAST = 16384, PAGE = 128, NPAGES = 128;
constexpr int NG = 4, HPG = 4, DH = 64;
constexpr int DIN = 9792, DFF = 8192;
constexpr int C_Q = 0, C_KV = 1024, C_G = 2560, C_QL = 2608, C_KL = 3120, C_VL = 3632, C_RL = 4656, C_LR = 5680, C_BR = 5696;
constexpr float EPS = 1e-6f;
constexpr size_t OFF_Y = 0, OFF_YS = (size_t)NPT * DM, OFF_PCK = OFF_YS + (size_t)DB * DM;
constexpr size_t SZ_PROW = (size_t)NPT * 256;
constexpr size_t OFF_PWK = OFF_PCK + 4 * SZ_PROW, SZ_PWIN = (size_t)NB * 512 * 256;
constexpr size_t OFF_PGLA = OFF_PWK + 2 * SZ_PWIN, SZ_PGLA = (size_t)NB * 4 * 128 * 256;
constexpr size_t OFF_SCK = OFF_PGLA + SZ_PGLA, SZ_SROW = (size_t)DB * 256;
constexpr size_t OFF_SWK = OFF_SCK + 4 * SZ_SROW, SZ_SWIN = (size_t)DB * 512 * 256;
constexpr size_t OFF_SGLA = OFF_SWK + 2 * SZ_SWIN, SZ_SGLA = (size_t)DB * 4 * 128 * 256;
constexpr size_t OUT_TOTAL = OFF_SGLA + SZ_SGLA;
static_assert(OUT_TOTAL == 29908992, "output size");

__device__ __forceinline__ bf16_t f2bf(float f) { unsigned u = __builtin_bit_cast(unsigned, f); return (bf16_t)((u + 0x7fffu + ((u >> 16) & 1u)) >> 16); }
__device__ __forceinline__ float bf2f(bf16_t h) { return __builtin_bit_cast(float, (unsigned)h << 16); }
__device__ __forceinline__ float sigmoidf_(float x) { return 1.f / (1.f + __expf(-x)); }
__device__ __forceinline__ float siluf_(float x) { return x / (1.f + __expf(-x)); }
__device__ __forceinline__ float gelu_tanh(float x) { const float u = 0.7978845608028654f * (x + 0.044715f * x * x * x); return 0.5f * x * (1.f + tanhf(u)); }
__device__ __forceinline__ float logsigmoidf_(float x) { return fminf(x, 0.f) - log1pf(__expf(-fabsf(x))); }
__device__ __forceinline__ float wave_sum(float v) {
#pragma unroll
    for (int o = 1; o < 64; o <<= 1) v += __shfl_xor(v, o);
    return v;
}
__device__ __forceinline__ float wave_max(float v) {
#pragma unroll
    for (int o = 1; o < 64; o <<= 1) v = fmaxf(v, __shfl_xor(v, o));
    return v;
}

struct Params {
    const float *x_prompt, *x_sample, *cck, *ccv, *csk, *csv, *cwk, *cwv, *state;
    const int* page_table;
    const float *norm1_g, *w_in, *b_gate, *pe_k, *pe_v, *w1k, *w2k, *w1v, *w2v, *w_a2, *b_a, *gnorm, *w_br_a, *w_br_b, *w_o, *norm2_g, *w_up, *w_down, *norm_f;
    float* out;
    bf16_t *XB, *QN, *KV6, *GQ, *GK, *GV, *GR, *BR, *KCMP_P, *VCMPT_P, *KCMP_S, *VCMP_S, *OA, *OB, *MB, *X1B, *HF;
    float *RSTD1, *GATE, *LR, *TMP, *X1, *RSTD2;
    bf16_t *WIN_T, *WBRA_T, *WBRB_T, *WO_T, *WUP_T, *WDN_T;
    float *SUMSQ2, *SUMSQ3;
    unsigned* CTL;
    bf16_t *W1T, *W2TG; float *BIAS1, *AB_S, *AB_P;
    float *UT, *DEC, *BCG; bf16_t* SNT;
    bf16_t *VTS, *VTW;
};

__device__ __forceinline__ float xval(const Params& p, int row, int n) { return row < NPT ? p.x_prompt[(size_t)row * DM + n] : p.x_sample[(size_t)(row - NPT) * DM + n]; }

__device__ __forceinline__ void proj_store(const Params& p, int row, int n, float v) {
    if (n < C_KV) p.QN[(size_t)row * 1024 + n] = f2bf(v * 0.125f);
    else if (n < C_G) {
        const int c = n - C_KV; p.KV6[(size_t)row * 1536 + c] = f2bf(v); const int j = c >> 8, cc = c & 255;
        if (row < NPT) { const int b = row >> 11, t = row & 2047;
            if (j < 4) p.out[OFF_PCK + j * SZ_PROW + (size_t)row * 256 + cc] = v;
            else if (t >= 1536) p.out[OFF_PWK + (j - 4) * SZ_PWIN + ((size_t)b * 512 + t - 1536) * 256 + cc] = v; }
        else { const int b = row - NPT;
            if (j < 4) p.out[OFF_SCK + j * SZ_SROW + (size_t)b * 256 + cc] = v;
            else p.out[OFF_SWK + (j - 4) * SZ_SWIN + ((size_t)b * 512 + 511) * 256 + cc] = v; }
    }
    else if (n < C_QL) { const int c = n - C_G; p.GATE[(size_t)row * 48 + c] = sigmoidf_(v + p.b_gate[c]); }
    else if (n < C_KL) p.GQ[(size_t)row * 512 + (n - C_QL)] = f2bf(v * 0.08838834764831845f);
    else if (n < C_VL) p.GK[(size_t)row * 512 + (n - C_KL)] = f2bf(v);
    else if (n < C_RL) p.GV[(size_t)row * 1024 + (n - C_VL)] = f2bf(v);
    else if (n < C_LR) p.GR[(size_t)row * 1024 + (n - C_RL)] = f2bf(siluf_(v));
    else if (n < C_BR) p.LR[(size_t)row * 16 + (n - C_LR)] = v;
    else p.BR[(size_t)row * 4096 + (n - C_BR)] = f2bf(sigmoidf_(v));
}

__global__ void __launch_bounds__(256) k_prep_x(Params p) {
    const int lane = threadIdx.x & 63, row = blockIdx.x * 4 + (threadIdx.x >> 6);
    if (row >= NTOK) return;
    const float* xr = row < NPT ? p.x_prompt + (size_t)row * DM : p.x_sample + (size_t)(row - NPT) * DM;
    float ss = 0.f;
    for (int i = lane; i < DM; i += 64) { const float v = xr[i]; ss += v * v; p.XB[(size_t)row * DM + i] = f2bf(v); }
    ss = wave_sum(ss);
    if (lane == 0) p.RSTD1[row] = rsqrtf(ss * (1.f / DM) + EPS);
}
__global__ void __launch_bounds__(256) k_copy_swin(Params p) {
    const size_t i = (size_t)blockIdx.x * 256 + threadIdx.x;
    if (i >= (size_t)DB * 511 * 256) return;
    const int c = (int)(i & 255); const int r = (int)((i >> 8) % 511); const int b = (int)((i >> 8) / 511);
    p.out[OFF_SWK + ((size_t)b * 512 + r) * 256 + c] = p.cwk[((size_t)b * 512 + r + 1) * 256 + c];
    p.out[OFF_SWK + SZ_SWIN + ((size_t)b * 512 + r) * 256 + c] = p.cwv[((size_t)b * 512 + r + 1) * 256 + c];
}
__global__ void __launch_bounds__(256) k_rms_rows(const float* X, float* rstd, int nrows) {
    const int lane = threadIdx.x & 63, row = blockIdx.x * 4 + (threadIdx.x >> 6);
    if (row >= nrows) return;
    float ss = 0.f;
    for (int i = lane; i < DM; i += 64) { const float v = X[(size_t)row * DM + i]; ss += v * v; }
    ss = wave_sum(ss);
    if (lane == 0) rstd[row] = rsqrtf(ss * (1.f / DM) + EPS);
}
__global__ void __launch_bounds__(256) k_final_norm(Params p) {
    const int lane = threadIdx.x & 63, row = blockIdx.x * 4 + (threadIdx.x >> 6);
    if (row >= NTOK) return;
    float* yr = row < NPT ? p.out + OFF_Y + (size_t)row * DM : p.out + OFF_YS + (size_t)(row - NPT) * DM;
    float ss = 0.f;
    for (int i = lane; i < DM; i += 64) { const float v = yr[i]; ss += v * v; }
    ss = wave_sum(ss);
    const float r = rsqrtf(ss * (1.f / DM) + EPS);
    for (int i = lane; i < DM; i += 64) yr[i] = yr[i] * r * p.norm_f[i];
}

template <class AF, class BF, class EF>
__global__ void __launch_bounds__(256) k_gemm_naive(int m_off, int M, int N, int K, AF af, BF bf, EF ef) {
    __shared__ float As[16][68], Bs[16][68];
    const int tid = threadIdx.x, tx = tid & 15, ty = tid >> 4, m0 = m_off + blockIdx.y * 64, n0 = blockIdx.x * 64;
    float acc[4][4];
#pragma unroll
    for (int i = 0; i < 4; ++i)
#pragma unroll
        for (int j = 0; j < 4; ++j) acc[i][j] = 0.f;
    for (int k0 = 0; k0 < K; k0 += 16) {
#pragma unroll
        for (int i = 0; i < 4; ++i) { const int idx = tid + 256 * i, r = idx >> 4, kk = idx & 15; As[kk][r] = (m0 + r < M) ? af(m0 + r, k0 + kk) : 0.f; }
#pragma unroll
        for (int i = 0; i < 4; ++i) { const int idx = tid + 256 * i, kk = idx >> 6, c = idx & 63; Bs[kk][c] = (n0 + c < N) ? bf(k0 + kk, n0 + c) : 0.f; }
        __syncthreads();
#pragma unroll
        for (int kk = 0; kk < 16; ++kk) {
            float a[4], b[4];
#pragma unroll
            for (int i = 0; i < 4; ++i) { a[i] = As[kk][ty * 4 + i]; b[i] = Bs[kk][tx * 4 + i]; }
#pragma unroll
            for (int i = 0; i < 4; ++i)
#pragma unroll
                for (int j = 0; j < 4; ++j) acc[i][j] += a[i] * b[j];
        }
        __syncthreads();
    }
#pragma unroll
    for (int i = 0; i < 4; ++i)
#pragma unroll
        for (int j = 0; j < 4; ++j) { const int r = m0 + ty * 4 + i, c = n0 + tx * 4 + j; if (r < M && c < N) ef(r, c, acc[i][j]); }
}
struct AF_x_g1 { Params p; __device__ float operator()(int r, int k) const { return xval(p, r, k) * p.norm1_g[k]; } };
struct BF_rowmajor { const float* W; long ld; __device__ float operator()(int k, int n) const { return W[(size_t)k * ld + n]; } };
struct EF_proj { Params p; __device__ void operator()(int r, int n, float acc) const { proj_store(p, r, n, acc * p.RSTD1[r]); } };
struct AF_bf { const bf16_t* A; long ld; __device__ float operator()(int r, int k) const { return bf2f(A[(size_t)r * ld + k]); } };
struct EF_bra { Params p; __device__ void operator()(int r, int n, float acc) const { p.TMP[(size_t)r * DM + n] = acc * bf2f(p.BR[(size_t)r * 4096 + n]); } };
struct EF_brb { Params p; __device__ void operator()(int r, int n, float acc) const { p.MB[(size_t)r * DM + n] = f2bf(p.TMP[(size_t)r * DM + n] + acc * bf2f(p.BR[(size_t)r * 4096 + 2048 + n])); } };
struct EF_wo { Params p; __device__ void operator()(int r, int n, float acc) const { const float x1 = xval(p, r, n) + acc; p.X1[(size_t)r * DM + n] = x1; p.X1B[(size_t)r * DM + n] = f2bf(x1); } };
struct AF_x1_g2 { Params p; __device__ float operator()(int r, int k) const { return bf2f(p.X1B[(size_t)r * DM + k]) * p.norm2_g[k]; } };
struct EF_up { Params p; __device__ void operator()(int r, int n, float acc) const { const float v = fmaxf(acc * p.RSTD2[r], 0.f); p.HF[(size_t)r * DFF + n] = f2bf(v * v); } };
struct EF_down { Params p; __device__ void operator()(int r, int n, float acc) const { const float x2 = p.X1[(size_t)r * DM + n] + acc;
    if (r < NPT) p.out[OFF_Y + (size_t)r * DM + n] = x2; else p.out[OFF_YS + (size_t)(r - NPT) * DM + n] = x2; } };

__global__ void __launch_bounds__(128) k_compress_naive(Params p, int is_s) {
    const int n_cmp = is_s ? 1023 : 127, n_pad = is_s ? 1024 : 128;
    const int kv = blockIdx.y, tid = threadIdx.x;
    const int i = blockIdx.x % n_pad, bg = blockIdx.x / n_pad, b = bg >> 2, g = bg & 3;
    __shared__ float blk[2048]; __shared__ float hid[128];
    if (i >= n_cmp) {
        if (tid < 64) { if (is_s) { (kv ? p.VCMP_S : p.KCMP_S)[((size_t)bg * 1024 + i) * 64 + tid] = 0; }
                        else { if (kv) p.VCMPT_P[((size_t)bg * 64 + tid) * 128 + i] = 0; else p.KCMP_P[((size_t)bg * 128 + i) * 64 + tid] = 0; } }
        return;
    }
    const float* pe = kv ? p.pe_v : p.pe_k; const float* w1 = kv ? p.w1v : p.w1k; const float* w2 = kv ? p.w2v : p.w2k;
    for (int e = tid; e < 2048; e += 128) { const int l = e >> 6, d = e & 63; const int pos = 16 * i + l; float v;
        if (is_s) { const int page = p.page_table[b * NPAGES + (pos >> 7)]; v = (kv ? p.ccv : p.cck)[(((size_t)page * PAGE + (pos & 127)) * 4 + g) * 64 + d]; }
        else v = bf2f(p.KV6[((size_t)b * SEQ + pos) * 1536 + kv * 256 + g * 64 + d]);
        blk[e] = v + pe[e]; }
    __syncthreads();
    float h = 0.f;
    for (int k = 0; k < 2048; ++k) h += blk[k] * w1[(size_t)k * 128 + tid];
    hid[tid] = gelu_tanh(h);
    __syncthreads();
    if (tid < 64) { float o = 0.f; for (int j = 0; j < 128; ++j) o += hid[j] * w2[j * 64 + tid];
        if (is_s) (kv ? p.VCMP_S : p.KCMP_S)[((size_t)bg * 1024 + i) * 64 + tid] = f2bf(o);
        else { if (kv) p.VCMPT_P[((size_t)bg * 64 + tid) * 128 + i] = f2bf(o); else p.KCMP_P[((size_t)bg * 128 + i) * 64 + tid] = f2bf(o); } }
}

struct RowRef { const float* pf; const bf16_t* pb; };
__device__ __forceinline__ float rr_get(const RowRef& r, int d) { return r.pf ? r.pf[d] : bf2f(r.pb[d]); }

template <class KF, class VF>
__device__ __forceinline__ void attend_naive(int nk, KF keyf, VF valf, const float (*q)[64], float (*sc)[1088], float (*oacc)[64], const float* gate3, int gsel, int tid) {
    const int lane = tid & 63, wv = tid >> 6;
    for (int kk = tid; kk < nk; kk += 256) { bool valid; const RowRef r = keyf(kk, valid);
        if (valid) { float d0 = 0.f, d1 = 0.f, d2 = 0.f, d3 = 0.f;
            for (int d = 0; d < 64; ++d) { const float kx = rr_get(r, d); d0 += q[0][d] * kx; d1 += q[1][d] * kx; d2 += q[2][d] * kx; d3 += q[3][d] * kx; }
            sc[0][kk] = d0; sc[1][kk] = d1; sc[2][kk] = d2; sc[3][kk] = d3; }
        else { sc[0][kk] = -INFINITY; sc[1][kk] = -INFINITY; sc[2][kk] = -INFINITY; sc[3][kk] = -INFINITY; } }
    __syncthreads();
    {
        float m = -INFINITY; for (int kk = lane; kk < nk; kk += 64) m = fmaxf(m, sc[wv][kk]);
        m = wave_max(m);
        float s = 0.f;
        for (int kk = lane; kk < nk; kk += 64) { const float x = sc[wv][kk]; const float e = (x == -INFINITY) ? 0.f : __expf(x - m); sc[wv][kk] = e; s += e; }
        s = wave_sum(s);
        const float inv = s > 0.f ? 1.f / s : 0.f;
        for (int kk = lane; kk < nk; kk += 64) sc[wv][kk] *= inv;
    }
    __syncthreads();
    {
        float o = 0.f;
        for (int kk = 0; kk < nk; ++kk) { const float pr = sc[wv][kk]; if (pr != 0.f) o += pr * valf(kk, lane); }
        oacc[wv][lane] += gate3[wv * 3 + gsel] * o;
    }
    __syncthreads();
}

__device__ __forceinline__ void nsa_naive_body(const Params& p, int row, int g, int tid, float (*q)[64], float (*sc)[1088], float (*oacc)[64], float* gate3, float* score, int* selidx) {
    const bool is_s = row >= NPT; const int b = is_s ? row - NPT : row >> 11, t = is_s ? 0 : row & 2047;
    const int start = is_s ? PAST : 0, pos = start + t, rowbase = is_s ? NPT + b : b * SEQ;
    const int n_cmp = is_s ? 1023 : 127, n_slc = is_s ? 257 : 32;
    { const int hd = tid >> 6, d = tid & 63; q[hd][d] = bf2f(p.QN[(size_t)row * 1024 + (g * 4 + hd) * 64 + d]); oacc[hd][d] = 0.f; }
    if (tid < 12) gate3[tid] = p.GATE[(size_t)row * 48 + g * 12 + tid];
    __syncthreads();
    const int bg = b * 4 + g;
    const bf16_t* kc = is_s ? p.KCMP_S + (size_t)bg * 1024 * 64 : p.KCMP_P + (size_t)bg * 128 * 64;
    const bf16_t* vc_s = p.VCMP_S + (size_t)bg * 1024 * 64; const bf16_t* vc_p = p.VCMPT_P + (size_t)bg * 64 * 128;
    auto kf_c = [&](int kk, bool& valid) { valid = (16 * kk + 31 <= pos); return RowRef{nullptr, kc + (size_t)kk * 64}; };
    auto vf_c = [&](int kk, int d) { return is_s ? bf2f(vc_s[(size_t)kk * 64 + d]) : bf2f(vc_p[(size_t)d * 128 + kk]); };
    attend_naive(n_cmp, kf_c, vf_c, q, sc, oacc, gate3, 0, tid);
    for (int j = tid; j < n_slc; j += 256) { float s = 0.f;
        for (int i = 4 * j - 1; i <= 4 * j + 3; ++i) if (i >= 0 && i < n_cmp) s += (sc[0][i] + sc[1][i]) + (sc[2][i] + sc[3][i]);
        score[j] = (j * 64 <= pos) ? s + ((j == 0 || j == pos / 64) ? 1e4f : 0.f) : -1e30f; }
    __syncthreads();
    for (int j = tid; j < n_slc; j += 256) { const float sj = score[j]; int rank = 0;
        for (int j2 = 0; j2 < n_slc; ++j2) { const float s2 = score[j2]; rank += (s2 > sj || (s2 == sj && j2 < j)) ? 1 : 0; }
        if (rank < 16) selidx[rank] = j; }
    __syncthreads();
    auto row_at = [&](int kp, int which) -> RowRef {
        if (kp < start) {
            if (which < 4) { const int page = p.page_table[b * NPAGES + (kp >> 7)]; const float* c = (which == 2) ? p.csk : p.csv; return RowRef{c + (((size_t)page * PAGE + (kp & 127)) * 4 + g) * 64, nullptr}; }
            const float* c = (which == 4) ? p.cwk : p.cwv; return RowRef{c + (((size_t)b * 512 + (kp - (PAST - 512))) * 4 + g) * 64, nullptr};
        }
        return RowRef{nullptr, p.KV6 + (size_t)(rowbase + kp - start) * 1536 + which * 256 + g * 64};
    };
    auto kf_s = [&](int kk, bool& valid) { const int kp = selidx[kk >> 6] * 64 + (kk & 63); valid = (kp <= pos); return valid ? row_at(kp, 2) : RowRef{nullptr, nullptr}; };
    auto vf_s = [&](int kk, int d) { const int kp = selidx[kk >> 6] * 64 + (kk & 63); return rr_get(row_at(kp, 3), d); };
    attend_naive(1024, kf_s, vf_s, q, sc, oacc, gate3, 1, tid);
    auto kf_w = [&](int kk, bool& valid) { const int kp = pos - 512 + kk; valid = (kp >= 0); return valid ? row_at(kp, 4) : RowRef{nullptr, nullptr}; };
    auto vf_w = [&](int kk, int d) { const int kp = pos - 512 + kk; return rr_get(row_at(kp, 5), d); };
    attend_naive(513, kf_w, vf_w, q, sc, oacc, gate3, 2, tid);
    { const int hd = tid >> 6, d = tid & 63; p.OA[(size_t)row * 1024 + (g * 4 + hd) * 64 + d] = f2bf(oacc[hd][d]); }
}
__global__ void __launch_bounds__(256) k_nsa_naive(Params p, int row0) {
    __shared__ float q[4][64]; __shared__ float sc[4][1088]; __shared__ float oacc[4][64]; __shared__ float gate3[12];
    __shared__ float score[260]; __shared__ int selidx[16];
    nsa_naive_body(p, row0 + blockIdx.x, blockIdx.y, threadIdx.x, q, sc, oacc, gate3, score, selidx);
}

__global__ void __launch_bounds__(512) k_gla_naive(Params p, int is_s) {
    const int b = blockIdx.x >> 2, h = blockIdx.x & 3, tid = threadIdx.x, e = tid & 255, half = tid >> 8;
    const int T = is_s ? 1 : SEQ, rowbase = is_s ? NPT + b : b * SEQ;
    __shared__ float a_s[128], q_s[128], k_s[128], part[2][256], red[8];
    float S[64];
#pragma unroll
    for (int dd = 0; dd < 64; ++dd) S[dd] = is_s ? p.state[(((size_t)b * 4 + h) * 128 + half * 64 + dd) * 256 + e] : 0.f;
    for (int t = 0; t < T; ++t) {
        const int row = rowbase + t;
        if (tid < 128) { float x = p.b_a[h * 128 + tid];
            for (int r = 0; r < 16; ++r) x += p.LR[(size_t)row * 16 + r] * p.w_a2[r * 512 + h * 128 + tid];
            a_s[tid] = __expf(logsigmoidf_(x) * (1.f / 16.f));
            q_s[tid] = bf2f(p.GQ[(size_t)row * 512 + h * 128 + tid]); k_s[tid] = bf2f(p.GK[(size_t)row * 512 + h * 128 + tid]); }
        const float v = bf2f(p.GV[(size_t)row * 1024 + h * 256 + e]);
        __syncthreads();
        float po = 0.f;
#pragma unroll
        for (int dd = 0; dd < 64; ++dd) { const int d = half * 64 + dd; S[dd] = a_s[d] * S[dd] + k_s[d] * v; po += q_s[d] * S[dd]; }
        part[half][e] = po;
        __syncthreads();
        float o = 0.f;
        if (tid < 256) { o = part[0][e] + part[1][e]; const float ss = wave_sum(o * o); if ((tid & 63) == 0) red[tid >> 6] = ss; }
        __syncthreads();
        if (tid < 256) { const float ss = (red[0] + red[1]) + (red[2] + red[3]); const float r = rsqrtf(ss * (1.f / 256.f) + EPS);
            p.OB[(size_t)row * 1024 + h * 256 + e] = f2bf(o * r * p.gnorm[e] * bf2f(p.GR[(size_t)row * 1024 + h * 256 + e])); }
    }
    float* so = p.out + (is_s ? OFF_SGLA : OFF_PGLA);
#pragma unroll
    for (int dd = 0; dd < 64; ++dd) so[(((size_t)b * 4 + h) * 128 + half * 64 + dd) * 256 + e] = S[dd];
}

#define REP_MASK 0
#define PROBE_PHASE -1
#define PROBE_A -1
#define PROBE_B -1
#define PROBE_BID 0
#define LATE_PRO 9600
#define GAS __attribute__((address_space(1)))
#define LAS __attribute__((address_space(3)))
typedef unsigned v4u __attribute__((ext_vector_type(4)));
typedef unsigned v2u __attribute__((ext_vector_type(2)));
#define LDS_WAIT() asm volatile("s_waitcnt lgkmcnt(0)" ::: "memory")
#define VM_WAIT() asm volatile("s_waitcnt vmcnt(0)" ::: "memory")
#define LDS_BARRIER() do { asm volatile("s_waitcnt lgkmcnt(0)" ::: "memory"); __builtin_amdgcn_s_barrier(); asm volatile("" ::: "memory"); } while (0)
typedef float f32x2_t __attribute__((ext_vector_type(2)));
typedef __bf16 bf16x2_t __attribute__((ext_vector_type(2)));
__device__ __forceinline__ unsigned cvtpk(float lo, float hi) { f32x2_t v = {lo, hi}; bf16x2_t b = __builtin_convertvector(v, bf16x2_t); return __builtin_bit_cast(unsigned, b); }
__device__ __forceinline__ unsigned pk2(float lo, float hi) { return cvtpk(lo, hi); }
__device__ __forceinline__ float sigmoid_fast(float x) { return __builtin_amdgcn_rcpf(1.f + __expf(-x)); }
__device__ __forceinline__ float silu_fast(float x) { return x * __builtin_amdgcn_rcpf(1.f + __expf(-x)); }
__device__ __forceinline__ float gelu_fast(float x) { return x * __builtin_amdgcn_rcpf(1.f + __expf(-1.5957691216057308f * (x + 0.044715f * x * x * x))); }
constexpr int NIN_PAD = 9984;
__host__ __device__ __forceinline__ int in_colmap(int n) {
    if (n < 2560) return n; if (n < 3072) return C_QL + (n - 2560); if (n < 3584) return C_KL + (n - 3072); if (n < 4608) return C_VL + (n - 3584);
    if (n < 5632) return C_RL + (n - 4608); if (n < 9728) return C_BR + (n - 5632); if (n < 9776) return C_G + (n - 9728); if (n < 9792) return C_LR + (n - 9776); return -1;
}
namespace pg8 {
#define PG8_LAS __attribute__((address_space(3)))
typedef unsigned short bf16_t;
typedef short bf16x8 __attribute__((ext_vector_type(8)));
typedef float f32x4 __attribute__((ext_vector_type(4)));
typedef unsigned u32x4 __attribute__((ext_vector_type(4)));
constexpr int BM = 256, BK = 64, HALF = 128, HTB = HALF * BK * 2  , STAGE_BYTES = 8 * HTB, NXCD = 8, WGM = 8;

__host__ __device__ __forceinline__ int lds_byte(int r, int c) { const int st = (r >> 4) * 2 + (c >> 5), rr = r & 15, cc = c & 31, ob = rr * 64 + cc * 2; return st * 1024 + (ob ^ (((ob >> 9) & 1) << 5)); }
__host__ __device__ __forceinline__ void stage_rc(int b, int& R, int& C) { const int st = b / 1024, sb = b % 1024, swz = sb ^ (((sb >> 9) & 1) << 5); R = (st >> 1) * 16 + swz / 64; C = (st & 1) * 32 + (swz % 64) / 2; }
__host__ __device__ __forceinline__ int perm32(int rho) { const int n = rho >> 4, i = rho & 15; return 8 * (i >> 2) + 4 * n + (i & 3); }

struct Unit { int pm, pn; };
struct Gemm { const bf16_t* A; const bf16_t* Bt; int M, N, K; };

struct StaticOrder {
    int nM, nN, nwg, G, c;
    __host__ __device__ void init(int M, int N, int G_, int c_) { nM = M / BM; nN = N / BM; nwg = nM * nN; G = G_; c = c_; }
    __host__ __device__ bool next(int i, Unit& u) const {
        const long L = (long)i * G + c; if (L >= nwg) return false;
        int wgid = (int)L; { const int q = nwg / NXCD, r = nwg % NXCD, xcd = wgid % NXCD, off = wgid / NXCD; wgid = (xcd < r ? xcd * (q + 1) : r * (q + 1) + (xcd - r) * q) + off; }
        const int nig = WGM * nN, gid = wgid / nig, fm = gid * WGM, gsz = (nM - fm) < WGM ? (nM - fm) : WGM;
        u.pm = fm + ((wgid % nig) % gsz); u.pn = (wgid % nig) / gsz; return true;
    }
    __device__ __forceinline__ void a_ready(const Unit&) const {}
    __device__ __forceinline__ void done(const Unit&) const {}
};

template <class Epi, class Sched, bool ALIGN_EPI = false, bool SP2 = false>
__device__ __forceinline__ void gemm_phase(PG8_LAS unsigned char* lds, const Gemm g, const Sched& S, const Epi& E) {
    const int tid = threadIdx.x, wid = __builtin_amdgcn_readfirstlane(tid >> 6), lane = tid & 63, wr = wid >> 2, wc = wid & 3, fr = lane & 15, fq = lane >> 4;
    const int K = g.K, nt = K / BK;
    unsigned voffA[2], voffB[2];
#pragma unroll
    for (int i = 0; i < 2; ++i) { int R, C; stage_rc(tid * 16 + i * 8192, R, C); const int Rb = Epi::PERM ? ((R & ~31) + perm32(R & 31)) : R;
        voffA[i] = (unsigned)(R * K + C) * 2u; voffB[i] = (unsigned)(Rb * K + C) * 2u; }
    const size_t kstep = (size_t)(BK * 2);
    const size_t hstep = (size_t)HALF * K * 2;
    const size_t tstep = 2 * hstep;
    const unsigned ldsw = (unsigned)wid * 1024u;
    const int aoff = lds_byte(wr * 64 + fr, fq * 8), boff = lds_byte(wc * 32 + fr, fq * 8);
#define PG8_SA(b, h) (((b) * 2 + (h)) * HTB)
#define PG8_SB(b, h) ((4 + (b) * 2 + (h)) * HTB)
#define PG8_STAGE(bufoff, gbase, voff) do { _Pragma("unroll") for (int _i = 0; _i < 2; ++_i) \
        __builtin_amdgcn_global_load_lds((const unsigned*)((const char*)(gbase) + (voff)[_i]), (PG8_LAS unsigned*)(lds + (bufoff) + ldsw + _i * 8192), 16, 0, 0); } while (0)
#define PG8_LDA(dst, b, h) do { _Pragma("unroll") for (int m = 0; m < 4; ++m) _Pragma("unroll") for (int k = 0; k < 2; ++k) dst[m][k] = *(const PG8_LAS bf16x8*)(lds + PG8_SA(b, h) + aoff + m * 2048 + k * 1024); } while (0)
#define PG8_LDB(dst, b, h) do { _Pragma("unroll") for (int n = 0; n < 2; ++n) _Pragma("unroll") for (int k = 0; k < 2; ++k) dst[n][k] = *(const PG8_LAS bf16x8*)(lds + PG8_SB(b, h) + boff + n * 2048 + k * 1024); } while (0)
#define PG8_MMA(ai, bj, At, Bt) do { __builtin_amdgcn_s_setprio(1); _Pragma("unroll") for (int m = 0; m < 4; ++m) _Pragma("unroll") for (int n = 0; n < 2; ++n) _Pragma("unroll") for (int k = 0; k < 2; ++k) \
        acc[ai][bj][m][n] = __builtin_amdgcn_mfma_f32_16x16x32_bf16(Bt[n][k], At[m][k], acc[ai][bj][m][n], 0, 0, 0); __builtin_amdgcn_s_setprio(0); } while (0)
#define PG8_WAIT_V(n) asm volatile("s_waitcnt vmcnt(" #n ")" ::: "memory")
#define PG8_WAIT_L(n) asm volatile("s_waitcnt lgkmcnt(" #n ")" ::: "memory")
#define PG8_BAR __builtin_amdgcn_s_barrier()
#define PG8_SCHED __builtin_amdgcn_sched_barrier(0)
    Unit cur, nxt; int ui = 0;
    if (!S.next(0, cur)) return;
    if (PROBE_A >= 0 && threadIdx.x == 0) *(PG8_LAS unsigned long long*)(lds + 135168 + 8 * 0) = __builtin_amdgcn_s_memrealtime();
    f32x4 acc[2][2][4][2];
#pragma unroll
    for (int a = 0; a < 2; ++a)
#pragma unroll
        for (int b = 0; b < 2; ++b)
#pragma unroll
            for (int m = 0; m < 4; ++m)
#pragma unroll
                for (int n = 0; n < 2; ++n) acc[a][b][m][n] = (f32x4){0.f, 0.f, 0.f, 0.f};
    bf16x8 At[4][2], B0[2][2], B1[2][2];
    const char* cA = (const char*)g.A + (size_t)cur.pm * tstep; const char* cB = (const char*)g.Bt + (size_t)cur.pn * tstep;
    S.a_ready(cur);
    if constexpr (SP2) {
        PG8_STAGE(PG8_SB(0, 0), cB, voffB); PG8_STAGE(PG8_SB(0, 1), cB + hstep, voffB); PG8_STAGE(PG8_SA(0, 0), cA, voffA); PG8_STAGE(PG8_SA(0, 1), cA + hstep, voffA);
        if (wr == 1) PG8_BAR;
        PG8_WAIT_V(2); PG8_BAR;
        PG8_STAGE(PG8_SB(1, 0), cB + kstep, voffB); PG8_STAGE(PG8_SA(1, 0), cA + kstep, voffA); PG8_STAGE(PG8_SB(1, 1), cB + hstep + kstep, voffB);
        PG8_WAIT_V(6); PG8_BAR;
    } else {
        PG8_STAGE(PG8_SB(0, 0), cB, voffB); PG8_STAGE(PG8_SA(0, 0), cA, voffA); PG8_STAGE(PG8_SB(0, 1), cB + hstep, voffB); PG8_STAGE(PG8_SA(0, 1), cA + hstep, voffA);
        if (wr == 1) PG8_BAR;
        PG8_WAIT_V(4); PG8_BAR;
        PG8_STAGE(PG8_SB(1, 0), cB + kstep, voffB); PG8_STAGE(PG8_SA(1, 0), cA + kstep, voffA); PG8_STAGE(PG8_SB(1, 1), cB + hstep + kstep, voffB);
        PG8_WAIT_V(6); PG8_BAR;
    }
    for (;;) {
        const bool has_next = S.next(ui + 1, nxt);
        const char* nA = has_next ? (const char*)g.A + (size_t)nxt.pm * tstep : cA; const char* nB = has_next ? (const char*)g.Bt + (size_t)nxt.pn * tstep : cB;
        for (int t = 0; t < nt; t += 2) {
            const bool last = (t == nt - 2);
            const char* a1 = cA + (size_t)(t + 1) * kstep;
            const char* a2 = last ? nA : cA + (size_t)(t + 2) * kstep; const char* b2 = last ? nB : cB + (size_t)(t + 2) * kstep;
            const char* a3 = a2 + kstep; const char* b3 = b2 + kstep;
            if (last && has_next) S.a_ready(nxt);
            if constexpr (SP2) {
            PG8_LDB(B0, 0, 0); PG8_LDB(B1, 0, 1); PG8_SCHED; PG8_LDA(At, 0, 0); PG8_STAGE(PG8_SA(1, 1), a1 + hstep, voffA);
            PG8_WAIT_V(8); PG8_WAIT_L(0); PG8_BAR; PG8_MMA(0, 0, At, B0); PG8_MMA(0, 1, At, B1); PG8_BAR; PG8_SCHED;
            PG8_LDA(At, 0, 1); PG8_STAGE(PG8_SB(0, 0), b2, voffB); PG8_STAGE(PG8_SB(0, 1), b2 + hstep, voffB); PG8_STAGE(PG8_SA(0, 0), a2, voffA);
            PG8_WAIT_V(8); PG8_WAIT_L(0); PG8_BAR; PG8_MMA(1, 0, At, B0); PG8_MMA(1, 1, At, B1); PG8_BAR; PG8_SCHED;
            PG8_LDB(B0, 1, 0); PG8_LDB(B1, 1, 1); PG8_SCHED; PG8_LDA(At, 1, 0); PG8_STAGE(PG8_SA(0, 1), a2 + hstep, voffA);
            PG8_WAIT_V(8); PG8_WAIT_L(0); PG8_BAR; PG8_MMA(0, 0, At, B0); PG8_MMA(0, 1, At, B1); PG8_BAR; PG8_SCHED;
            PG8_LDA(At, 1, 1); PG8_STAGE(PG8_SB(1, 0), b3, voffB); PG8_STAGE(PG8_SB(1, 1), b3 + hstep, voffB); PG8_STAGE(PG8_SA(1, 0), a3, voffA);
            PG8_WAIT_V(8); PG8_WAIT_L(0); PG8_BAR; PG8_MMA(1, 0, At, B0); PG8_MMA(1, 1, At, B1); PG8_BAR; PG8_SCHED;
            } else {
            PG8_LDB(B0, 0, 0); PG8_SCHED; PG8_LDA(At, 0, 0); PG8_STAGE(PG8_SA(1, 1), a1 + hstep, voffA);
            PG8_WAIT_L(8); PG8_BAR; PG8_WAIT_L(0); PG8_MMA(0, 0, At, B0); PG8_BAR; PG8_SCHED;
            PG8_LDB(B1, 0, 1); PG8_STAGE(PG8_SB(0, 0), b2, voffB);
            PG8_BAR; PG8_WAIT_L(0); PG8_MMA(0, 1, At, B1); PG8_BAR;
            PG8_LDA(At, 0, 1); PG8_STAGE(PG8_SA(0, 0), a2, voffA);
            PG8_BAR; PG8_WAIT_L(0); PG8_MMA(1, 0, At, B0); PG8_BAR; PG8_SCHED;
            PG8_STAGE(PG8_SB(0, 1), b2 + hstep, voffB);
            PG8_WAIT_V(6); PG8_BAR; PG8_MMA(1, 1, At, B1); PG8_BAR;
            PG8_LDB(B0, 1, 0); PG8_SCHED; PG8_LDA(At, 1, 0); PG8_STAGE(PG8_SA(0, 1), a2 + hstep, voffA);
            PG8_WAIT_L(8); PG8_BAR; PG8_WAIT_L(0); PG8_MMA(0, 0, At, B0); PG8_BAR; PG8_SCHED;
            PG8_LDB(B1, 1, 1); PG8_STAGE(PG8_SB(1, 0), b3, voffB);
            PG8_BAR; PG8_WAIT_L(0); PG8_MMA(0, 1, At, B1); PG8_BAR;
            PG8_LDA(At, 1, 1); PG8_STAGE(PG8_SA(1, 0), a3, voffA);
            PG8_BAR; PG8_WAIT_L(0); PG8_MMA(1, 0, At, B0); PG8_BAR; PG8_SCHED;
            PG8_STAGE(PG8_SB(1, 1), b3 + hstep, voffB);
            PG8_WAIT_V(6); PG8_BAR; PG8_MMA(1, 1, At, B1); PG8_BAR;
            }
        }
        if (PROBE_A >= 0 && threadIdx.x == 0) *(PG8_LAS unsigned long long*)(lds + 135168 + 8 * 1) = __builtin_amdgcn_s_memrealtime();
        if constexpr (ALIGN_EPI) { if (wr == 0) PG8_BAR; }
        if (PROBE_A >= 0 && threadIdx.x == 0) *(PG8_LAS unsigned long long*)(lds + 135168 + 8 * 2) = __builtin_amdgcn_s_memrealtime();
        if constexpr (!Epi::AFTER_DRAIN) { E(acc, cur, wr, wc, fr, fq); S.done(cur); }   if (PROBE_A >= 0 && threadIdx.x == 0) *(PG8_LAS unsigned long long*)(lds + 135168 + 8 * 3) = __builtin_amdgcn_s_memrealtime();
        if (!has_next) break;
#pragma unroll
        for (int a = 0; a < 2; ++a)
#pragma unroll
            for (int b = 0; b < 2; ++b)
#pragma unroll
                for (int m = 0; m < 4; ++m)
#pragma unroll
                    for (int n = 0; n < 2; ++n) acc[a][b][m][n] = (f32x4){0.f, 0.f, 0.f, 0.f};
        cur = nxt; cA = nA; cB = nB; ++ui;
        if constexpr (ALIGN_EPI) { if (wr == 1) PG8_BAR; }
    }
    PG8_WAIT_V(0);
    if constexpr (!ALIGN_EPI) { if (wr == 0) PG8_BAR; }
    PG8_BAR;
    if constexpr (Epi::AFTER_DRAIN) { E.fused(acc, cur, wr, wc, fr, fq, lds, wid, lane); S.done(cur); }
#undef PG8_SA
#undef PG8_SB
#undef PG8_STAGE
#undef PG8_LDA
#undef PG8_LDB
#undef PG8_MMA
#undef PG8_WAIT_V
#undef PG8_WAIT_L
#undef PG8_BAR
#undef PG8_SCHED
}
}
#define SSTAMP(i) do { if (PROBE_A >= 0 && (int)blockIdx.x == PROBE_BID && tid == 0) { ((unsigned long long*)(p.CTL + 2048))[i] = __builtin_amdgcn_s_memrealtime(); } } while (0)
typedef pg8::f32x4 f32x4;
struct NoIn {};
template <class F> struct EpiGen {
    static constexpr bool PERM = true, AFTER_DRAIN = false; F f;
    __device__ __forceinline__ void operator()(const f32x4 (&acc)[2][2][4][2], const pg8::Unit& u, int wr, int wc, int fr, int fq) const {
        const int row0 = u.pm * 256 + wr * 64 + fr, col0 = u.pn * 256 + wc * 32 + 8 * fq;
        float ctx[8];
#pragma unroll
        for (int r = 0; r < 8; ++r) ctx[r] = f.row_begin(row0 + (r >> 2) * 128 + (r & 3) * 16);
        typename F::In8 cur[2], nxt[2];
#pragma unroll
        for (int g = 0; g < 2; ++g) cur[g] = f.load8(row0, col0 + g * 128);
#pragma unroll
        for (int r = 0; r < 8; ++r) { const int row = row0 + (r >> 2) * 128 + (r & 3) * 16;
            if (r < 7) { const int rn = row0 + ((r + 1) >> 2) * 128 + ((r + 1) & 3) * 16;
#pragma unroll
                for (int g = 0; g < 2; ++g) nxt[g] = f.load8(rn, col0 + g * 128); }
            float part = 0.f;
#pragma unroll
            for (int g = 0; g < 2; ++g) part += f.store8(ctx[r], row, col0 + g * 128, acc[r >> 2][g][r & 3][0], acc[r >> 2][g][r & 3][1], cur[g]);
            f.row_end(row, part, fq, true);
#pragma unroll
            for (int g = 0; g < 2; ++g) cur[g] = nxt[g]; }
    }
};
__device__ __forceinline__ f32x4 bf4lo(v4u w) { return (f32x4){bf2f((bf16_t)(w.x & 0xffff)), bf2f((bf16_t)(w.x >> 16)), bf2f((bf16_t)(w.y & 0xffff)), bf2f((bf16_t)(w.y >> 16))}; }
__device__ __forceinline__ f32x4 bf4hi(v4u w) { return (f32x4){bf2f((bf16_t)(w.z & 0xffff)), bf2f((bf16_t)(w.z >> 16)), bf2f((bf16_t)(w.w & 0xffff)), bf2f((bf16_t)(w.w >> 16))}; }
__device__ __forceinline__ v4u pk8(f32x4 a, f32x4 c) { v4u w; w.x = pk2(a[0], a[1]); w.y = pk2(a[2], a[3]); w.z = pk2(c[0], c[1]); w.w = pk2(c[2], c[3]); return w; }
template <int ACT  >
__device__ __forceinline__ void store_tile_bf16(const f32x4 (&acc)[2][2][4][2], int row0, int col0, const float (&rsv)[8], float scale, bf16_t* dst, int ld) {
#pragma unroll
    for (int ai = 0; ai < 2; ++ai)
#pragma unroll
        for (int m = 0; m < 4; ++m) { const int row = row0 + ai * 128 + m * 16; const float rs = rsv[ai * 4 + m] * scale; bf16_t* rp = dst + (size_t)row * ld + col0;
#pragma unroll
            for (int bj = 0; bj < 2; ++bj) { f32x4 v = acc[ai][bj][m][0] * rs, w = acc[ai][bj][m][1] * rs;
                if (ACT == 1) { v[0] = silu_fast(v[0]); v[1] = silu_fast(v[1]); v[2] = silu_fast(v[2]); v[3] = silu_fast(v[3]); w[0] = silu_fast(w[0]); w[1] = silu_fast(w[1]); w[2] = silu_fast(w[2]); w[3] = silu_fast(w[3]); }
                if (ACT == 2) { v[0] = sigmoid_fast(v[0]); v[1] = sigmoid_fast(v[1]); v[2] = sigmoid_fast(v[2]); v[3] = sigmoid_fast(v[3]); w[0] = sigmoid_fast(w[0]); w[1] = sigmoid_fast(w[1]); w[2] = sigmoid_fast(w[2]); w[3] = sigmoid_fast(w[3]); }
                *(v4u*)(rp + bj * 128) = pk8(v, w); } }
}
struct EpiProj {
    static constexpr bool PERM = true, AFTER_DRAIN = false;
    const float* rstd; const float* b_gate; bf16_t *QN, *KV6, *GQ, *GK, *GV, *GR, *BR; float *GATE, *LR, *out;
    __device__ __forceinline__ void operator()(const f32x4 (&acc)[2][2][4][2], const pg8::Unit& u, int wr, int wc, int fr, int fq) const {
        const int row0 = u.pm * 256 + wr * 64 + fr, cl0 = wc * 32 + 8 * fq, pn = u.pn;
        float rsv[8];
#pragma unroll
        for (int r = 0; r < 8; ++r) rsv[r] = rstd[row0 + (r >> 2) * 128 + (r & 3) * 16];
        if (pn < 4) store_tile_bf16<0>(acc, row0, pn * 256 + cl0, rsv, 0.125f, QN, 1024);
        else if (pn < 10) { const int j = pn - 4;
            store_tile_bf16<0>(acc, row0, j * 256 + cl0, rsv, 1.f, KV6, 1536);
#pragma unroll
            for (int ai = 0; ai < 2; ++ai)
#pragma unroll
                for (int m = 0; m < 4; ++m) { const int row = row0 + ai * 128 + m * 16; const float rs = rsv[ai * 4 + m]; const int b = row >> 11, t = row & 2047;
                    float* rp = nullptr;
                    if (j < 4) rp = out + OFF_PCK + j * SZ_PROW + (size_t)row * 256 + cl0;
                    else if (t >= 1536) rp = out + OFF_PWK + (j - 4) * SZ_PWIN + ((size_t)b * 512 + (t - 1536)) * 256 + cl0;
                    if (rp) {
#pragma unroll
                        for (int bj = 0; bj < 2; ++bj)
#pragma unroll
                            for (int n = 0; n < 2; ++n) *(f32x4*)(rp + bj * 128 + n * 4) = acc[ai][bj][m][n] * rs; } }
        }
        else if (pn < 12) store_tile_bf16<0>(acc, row0, (pn - 10) * 256 + cl0, rsv, 0.08838834764831845f, GQ, 512);
        else if (pn < 14) store_tile_bf16<0>(acc, row0, (pn - 12) * 256 + cl0, rsv, 1.f, GK, 512);
        else if (pn < 18) store_tile_bf16<0>(acc, row0, (pn - 14) * 256 + cl0, rsv, 1.f, GV, 1024);
        else if (pn < 22) store_tile_bf16<1>(acc, row0, (pn - 18) * 256 + cl0, rsv, 1.f, GR, 1024);
        else if (pn < 38) store_tile_bf16<2>(acc, row0, (pn - 22) * 256 + cl0, rsv, 1.f, BR, 4096);
        else if (wc < 2) {
#pragma unroll
            for (int ai = 0; ai < 2; ++ai)
#pragma unroll
                for (int m = 0; m < 4; ++m) { const int row = row0 + ai * 128 + m * 16; const float rs = rsv[ai * 4 + m];
#pragma unroll
                    for (int n = 0; n < 2; ++n) { const int cl = cl0 + n * 4; const f32x4 v = acc[ai][0][m][n] * rs;
                        if (cl < 48) { const f32x4 bg = *(const f32x4*)(b_gate + cl); f32x4 o; o[0] = sigmoid_fast(v[0] + bg[0]); o[1] = sigmoid_fast(v[1] + bg[1]); o[2] = sigmoid_fast(v[2] + bg[2]); o[3] = sigmoid_fast(v[3] + bg[3]);
                            *(f32x4*)(GATE + (size_t)row * 48 + cl) = o; }
                        else *(f32x4*)(LR + (size_t)row * 16 + (cl - 48)) = v; } }
        }
    }
};
struct F_bra { const bf16_t* BR; bf16_t* TMPB; typedef v2u In;
    typedef v4u In8;
    __device__ __forceinline__ In8 load8(int row, int col) const { return *(const v4u*)(BR + (size_t)row * 4096 + col); }
    __device__ __forceinline__ float store8(float, int row, int col, f32x4 v, f32x4 w, const In8& g) const { *(v4u*)(TMPB + (size_t)row * DM + col) = pk8(v * bf4lo(g), w * bf4hi(g)); return 0.f; }
    __device__ __forceinline__ float row_begin(int) const { return 0.f; }
    __device__ __forceinline__ In load4(int row, int col) const { return *(const v2u*)(BR + (size_t)row * 4096 + col); }
    __device__ __forceinline__ float store4(float, int row, int col, f32x4 v, const In& b) const {
        v2u w; w.x = pk2(v[0] * bf2f((bf16_t)(b.x & 0xffff)), v[1] * bf2f((bf16_t)(b.x >> 16))); w.y = pk2(v[2] * bf2f((bf16_t)(b.y & 0xffff)), v[3] * bf2f((bf16_t)(b.y >> 16)));
        *(v2u*)(TMPB + (size_t)row * DM + col) = w; return 0.f; }
    __device__ __forceinline__ void row_end(int, float, int, bool) const {}
};
struct F_brb { const bf16_t* BR; const bf16_t* TMPB; bf16_t* MB; struct In { v2u b; v2u t; };
    struct In8 { v4u b; v4u t; };
    __device__ __forceinline__ In8 load8(int row, int col) const { In8 i; i.b = *(const v4u*)(BR + (size_t)row * 4096 + 2048 + col); i.t = *(const v4u*)(TMPB + (size_t)row * DM + col); return i; }
    __device__ __forceinline__ float store8(float, int row, int col, f32x4 v, f32x4 w, const In8& i) const { *(v4u*)(MB + (size_t)row * DM + col) = pk8(bf4lo(i.t) + v * bf4lo(i.b), bf4hi(i.t) + w * bf4hi(i.b)); return 0.f; }
    __device__ __forceinline__ float row_begin(int) const { return 0.f; }
    __device__ __forceinline__ In load4(int row, int col) const { In i; i.b = *(const v2u*)(BR + (size_t)row * 4096 + 2048 + col); i.t = *(const v2u*)(TMPB + (size_t)row * DM + col); return i; }
    __device__ __forceinline__ float store4(float, int row, int col, f32x4 v, const In& i) const { const v2u b = i.b, t = i.t;
        const float o0 = bf2f((bf16_t)(t.x & 0xffff)) + v[0] * bf2f((bf16_t)(b.x & 0xffff)), o1 = bf2f((bf16_t)(t.x >> 16)) + v[1] * bf2f((bf16_t)(b.x >> 16));
        const float o2 = bf2f((bf16_t)(t.y & 0xffff)) + v[2] * bf2f((bf16_t)(b.y & 0xffff)), o3 = bf2f((bf16_t)(t.y >> 16)) + v[3] * bf2f((bf16_t)(b.y >> 16));
        v2u w; w.x = pk2(o0, o1); w.y = pk2(o2, o3); *(v2u*)(MB + (size_t)row * DM + col) = w; return 0.f; }
    __device__ __forceinline__ void row_end(int, float, int, bool) const {}
};
struct F_wo { const float* x; bf16_t* X1B; float* SUMSQ; typedef f32x4 In;
    struct In8 { f32x4 a, c; };
    __device__ __forceinline__ In8 load8(int row, int col) const { In8 i; i.a = *(const f32x4*)(x + (size_t)row * DM + col); i.c = *(const f32x4*)(x + (size_t)row * DM + col + 4); return i; }
    __device__ __forceinline__ float store8(float, int row, int col, f32x4 v, f32x4 w, const In8& i) const { const f32x4 a = i.a + v, c = i.c + w; *(v4u*)(X1B + (size_t)row * DM + col) = pk8(a, c);
        return ((a[0] * a[0] + a[1] * a[1]) + (a[2] * a[2] + a[3] * a[3])) + ((c[0] * c[0] + c[1] * c[1]) + (c[2] * c[2] + c[3] * c[3])); }
    __device__ __forceinline__ float row_begin(int) const { return 0.f; }
    __device__ __forceinline__ In load4(int row, int col) const { return *(const f32x4*)(x + (size_t)row * DM + col); }
    __device__ __forceinline__ float store4(float, int row, int col, f32x4 v, const In& xv) const { const f32x4 x1 = xv + v;
        v2u w; w.x = pk2(x1[0], x1[1]); w.y = pk2(x1[2], x1[3]); *(v2u*)(X1B + (size_t)row * DM + col) = w;
        return (x1[0] * x1[0] + x1[1] * x1[1]) + (x1[2] * x1[2] + x1[3] * x1[3]); }
    __device__ __forceinline__ void row_end(int row, float part, int fq, bool valid) const { part += __shfl_xor(part, 16); part += __shfl_xor(part, 32); if (fq == 0 && valid) atomicAdd(SUMSQ + row, part); }
};
struct F_up { const float* SUMSQ; bf16_t* HF; typedef NoIn In;
    typedef NoIn In8;
    __device__ __forceinline__ In8 load8(int, int) const { return NoIn{}; }
    __device__ __forceinline__ float store8(float rs, int row, int col, f32x4 v, f32x4 w, const In8&) const { f32x4 a, c;
#pragma unroll
        for (int i = 0; i < 4; ++i) { const float t = fmaxf(v[i] * rs, 0.f), s = fmaxf(w[i] * rs, 0.f); a[i] = t * t; c[i] = s * s; }
        *(v4u*)(HF + (size_t)row * DFF + col) = pk8(a, c); return 0.f; }
    __device__ __forceinline__ float row_begin(int row) const { return rsqrtf(SUMSQ[row] * (1.f / DM) + EPS); }
    __device__ __forceinline__ In load4(int, int) const { return NoIn{}; }
    __device__ __forceinline__ float store4(float rs, int row, int col, f32x4 v, const In&) const { float h[4];
#pragma unroll
        for (int i = 0; i < 4; ++i) { const float t = fmaxf(v[i] * rs, 0.f); h[i] = t * t; }
        v2u w; w.x = pk2(h[0], h[1]); w.y = pk2(h[2], h[3]); *(v2u*)(HF + (size_t)row * DFF + col) = w; return 0.f; }
    __device__ __forceinline__ void row_end(int, float, int, bool) const {}
};
struct F_down { const bf16_t* X1B; bf16_t* YB; float* SUMSQ; typedef v2u In;
    typedef v4u In8;
    __device__ __forceinline__ In8 load8(int row, int col) const { return *(const v4u*)(X1B + (size_t)row * DM + col); }
    __device__ __forceinline__ float store8(float, int row, int col, f32x4 v, f32x4 w, const In8& t) const { const f32x4 a = bf4lo(t) + v, c = bf4hi(t) + w; *(v4u*)(YB + (size_t)row * DM + col) = pk8(a, c);
        return ((a[0] * a[0] + a[1] * a[1]) + (a[2] * a[2] + a[3] * a[3])) + ((c[0] * c[0] + c[1] * c[1]) + (c[2] * c[2] + c[3] * c[3])); }
    __device__ __forceinline__ float row_begin(int) const { return 0.f; }
    __device__ __forceinline__ In load4(int row, int col) const { return *(const v2u*)(X1B + (size_t)row * DM + col); }
    __device__ __forceinline__ float store4(float, int row, int col, f32x4 v, const In& t) const {
        const float a0 = bf2f((bf16_t)(t.x & 0xffff)) + v[0], a1 = bf2f((bf16_t)(t.x >> 16)) + v[1], a2 = bf2f((bf16_t)(t.y & 0xffff)) + v[2], a3 = bf2f((bf16_t)(t.y >> 16)) + v[3];
        v2u w; w.x = pk2(a0, a1); w.y = pk2(a2, a3); *(v2u*)(YB + (size_t)row * DM + col) = w; return (a0 * a0 + a1 * a1) + (a2 * a2 + a3 * a3); }
    __device__ __forceinline__ void row_end(int row, float part, int fq, bool valid) const { part += __shfl_xor(part, 16); part += __shfl_xor(part, 32); if (fq == 0 && valid) atomicAdd(SUMSQ + row, part); }
};

struct EpiDownNorm {
    static constexpr bool PERM = true, AFTER_DRAIN = true;
    const bf16_t* X1B; float* SUMSQ; float* Y; const float* norm_f; unsigned* pcnt;
    __device__ __forceinline__ void fused(f32x4 (&acc)[2][2][4][2], const pg8::Unit& u, int wr, int wc, int fr, int fq, PG8_LAS unsigned char* lds, int wid, int lane) const {
        const int row0 = u.pm * 256 + wr * 64 + fr, col0 = u.pn * 256 + wc * 32 + 8 * fq;
        v4u cur[2], nxt[2];
#pragma unroll
        for (int g = 0; g < 2; ++g) cur[g] = *(const v4u*)(X1B + (size_t)row0 * DM + col0 + g * 128);
#pragma unroll
        for (int r = 0; r < 8; ++r) { const int row = row0 + (r >> 2) * 128 + (r & 3) * 16;
            if (r < 7) { const int rn = row0 + ((r + 1) >> 2) * 128 + ((r + 1) & 3) * 16;
#pragma unroll
                for (int g = 0; g < 2; ++g) nxt[g] = *(const v4u*)(X1B + (size_t)rn * DM + col0 + g * 128); }
            float part = 0.f;
#pragma unroll
            for (int g = 0; g < 2; ++g) { f32x4& a = acc[r >> 2][g][r & 3][0]; f32x4& c = acc[r >> 2][g][r & 3][1]; a = a + bf4lo(cur[g]); c = c + bf4hi(cur[g]);
                part += ((a[0] * a[0] + a[1] * a[1]) + (a[2] * a[2] + a[3] * a[3])) + ((c[0] * c[0] + c[1] * c[1]) + (c[2] * c[2] + c[3] * c[3])); }
            part += __shfl_xor(part, 16); part += __shfl_xor(part, 32); if (fq == 0) atomicAdd(SUMSQ + row, part);
#pragma unroll
            for (int g = 0; g < 2; ++g) cur[g] = nxt[g]; }
        asm volatile("s_waitcnt vmcnt(0)" ::: "memory"); __syncthreads();
        if (threadIdx.x == 0) { __builtin_amdgcn_fence(__ATOMIC_RELEASE, "agent"); asm volatile("s_waitcnt vmcnt(0)" ::: "memory");
            __hip_atomic_fetch_add(pcnt + 64 * u.pm, 1u, __ATOMIC_RELAXED, __HIP_MEMORY_SCOPE_AGENT);
            unsigned sp = 0; while (__hip_atomic_load(pcnt + 64 * u.pm, __ATOMIC_RELAXED, __HIP_MEMORY_SCOPE_AGENT) < 8u) { __builtin_amdgcn_s_sleep(1); if (++sp > (1u << 22)) break; }
            __builtin_amdgcn_fence(__ATOMIC_ACQUIRE, "agent"); asm volatile("s_waitcnt vmcnt(0)" ::: "memory"); }
        __syncthreads();
#pragma unroll
        for (int r = 0; r < 8; ++r) { const int row = row0 + (r >> 2) * 128 + (r & 3) * 16;
            const float rs = rsqrtf(__hip_atomic_load(SUMSQ + row, __ATOMIC_RELAXED, __HIP_MEMORY_SCOPE_AGENT) * (1.f / DM) + EPS);
#pragma unroll
            for (int g = 0; g < 2; ++g) { const int col = col0 + g * 128; const f32x4 g0 = *(const f32x4*)(norm_f + col), g1 = *(const f32x4*)(norm_f + col + 4);
                *(f32x4*)(Y + (size_t)row * DM + col) = acc[r >> 2][g][r & 3][0] * rs * g0; *(f32x4*)(Y + (size_t)row * DM + col + 4) = acc[r >> 2][g][r & 3][1] * rs * g1; } }
    }
    __device__ __forceinline__ void operator()(const f32x4 (&)[2][2][4][2], const pg8::Unit&, int, int, int, int) const {}
};

typedef short bf16x8_t __attribute__((ext_vector_type(8)));
template <class F>
__device__ __forceinline__ void skinny_gemm(LAS unsigned char* lds, const bf16_t* A, int lda, const bf16_t* Bt, int N, int K, const F& f, int bid, int G, int tid) {
    const int lane = tid & 63, wave = __builtin_amdgcn_readfirstlane(tid >> 6), j = lane & 15, g = lane >> 4;
    LAS f32x4* red = (LAS f32x4*)lds;
    const int ksl = K >> 3;
    for (int it = bid; it < (N >> 4); it += G) {
        const int n0 = it * 16;
        const bf16_t* bp = Bt + (size_t)(n0 + j) * K + wave * ksl + 8 * g;
        const bf16_t* ap = A + (size_t)(j & 7) * lda + wave * ksl + 8 * g;
        f32x4 acc = {0.f, 0.f, 0.f, 0.f};
#pragma unroll 4
        for (int k = 0; k < ksl; k += 32) {
            const bf16x8_t b = *(const bf16x8_t*)(bp + k); bf16x8_t a = *(const bf16x8_t*)(ap + k);
            if (j >= 8) a = (bf16x8_t){0, 0, 0, 0, 0, 0, 0, 0};
            acc = __builtin_amdgcn_mfma_f32_16x16x32_bf16(b, a, acc, 0, 0, 0);
        }
        red[wave * 64 + lane] = acc;
        __syncthreads();
        if (wave == 0) { f32x4 sacc = red[lane];
#pragma unroll
            for (int w = 1; w < 8; ++w) sacc = sacc + red[w * 64 + lane];
            const int row = NPT + (j & 7); const bool valid = j < 8; const float ctx = f.row_begin(row); float part = 0.f;
            const typename F::In in = f.load4(row, n0 + 4 * g);
            if (valid) part = f.store4(ctx, row, n0 + 4 * g, sacc, in);
            f.row_end(row, part, g, valid); }
        __syncthreads();
    }
}
struct F_proj_s { const Params& p; typedef NoIn In;
    __device__ __forceinline__ float row_begin(int row) const { return p.RSTD1[row]; }
    __device__ __forceinline__ In load4(int, int) const { return NoIn{}; }
    __device__ __forceinline__ float store4(float rs, int row, int col, f32x4 v, const In&) const { const int n0 = in_colmap(col); if (n0 >= 0) {
#pragma unroll
        for (int i = 0; i < 4; ++i) proj_store(p, row, n0 + i, v[i] * rs); } return 0.f; }
    __device__ __forceinline__ void row_end(int, float, int, bool) const {}
};

struct TrRegs { f32x4 v[8]; };
template <class CM>
__device__ __forceinline__ TrRegs transpose_load(const float* W, int ldw, const float* kscale, int item, int nblk, CM cm, int lane) {
    const int kb = item / nblk, nb = item % nblk, k0 = 64 * kb, n0 = 32 * nb;
    const int n4 = (lane & 7) * 4, kr = lane >> 3;
    const int sc = cm(n0 + n4);
    TrRegs t;
#pragma unroll
    for (int i = 0; i < 8; ++i) t.v[i] = sc >= 0 ? *(const f32x4*)(W + (size_t)(k0 + 8 * i + kr) * ldw + sc) : (f32x4){0.f, 0.f, 0.f, 0.f};
    if (kscale) {
#pragma unroll
        for (int i = 0; i < 8; ++i) t.v[i] = t.v[i] * kscale[k0 + 8 * i + kr]; }
    return t;
}
__device__ __forceinline__ void transpose_store(const TrRegs& t, bf16_t* WT, int K, int item, int nblk, LAS float* scr, int lane) {
    const int kb = item / nblk, nb = item % nblk, k0 = 64 * kb, n0 = 32 * nb;
    const int n4 = (lane & 7) * 4, kr = lane >> 3;
#pragma unroll
    for (int i = 0; i < 8; ++i) { LAS float* d = scr + (8 * i + kr) * 33 + n4; d[0] = t.v[i][0]; d[1] = t.v[i][1]; d[2] = t.v[i][2]; d[3] = t.v[i][3]; }
    LDS_WAIT(); asm volatile("" ::: "memory");
    const int c = lane & 7;
#pragma unroll
    for (int j = 0; j < 4; ++j) { const int n = (lane >> 3) + 8 * j; const LAS float* s = scr + (8 * c) * 33 + n;
        v4u o; o.x = pk2(s[0 * 33], s[1 * 33]); o.y = pk2(s[2 * 33], s[3 * 33]); o.z = pk2(s[4 * 33], s[5 * 33]); o.w = pk2(s[6 * 33], s[7 * 33]);
        *(v4u*)(WT + (size_t)(n0 + n) * K + k0 + 8 * c) = o; }
    LDS_WAIT(); asm volatile("" ::: "memory");
}
template <class CM>
__device__ __forceinline__ void transpose_item(const float* W, int ldw, const float* kscale, bf16_t* WT, int K, int item, int nblk, CM cm, LAS float* scr, int lane) {
    const TrRegs t = transpose_load(W, ldw, kscale, item, nblk, cm, lane); transpose_store(t, WT, K, item, nblk, scr, lane);
}
struct CM_id { __device__ __forceinline__ int operator()(int n) const { return n; } };
struct CM_in { __device__ __forceinline__ int operator()(int n) const { return in_colmap(n); } };

__device__ __forceinline__ void ph_prologue(const Params& p, LAS unsigned char* lds, int bid, int G, int tid, int parts  ) {
    const int lane = tid & 63, wave = tid >> 6, gw = bid * 8 + wave, NGW = G * 8;
    LAS float* scr = (LAS float*)(lds + wave * 16384);
    constexpr int I_IN = 32 * (NIN_PAD / 32);
    if ((parts & 1) && gw < I_IN) { TrRegs cur = transpose_load(p.w_in, DIN, p.norm1_g, gw, NIN_PAD / 32, CM_in{}, lane);
        for (int it = gw; it < I_IN; it += NGW) { const int nx = it + NGW; TrRegs nxt = cur; if (nx < I_IN) nxt = transpose_load(p.w_in, DIN, p.norm1_g, nx, NIN_PAD / 32, CM_in{}, lane);
            transpose_store(cur, p.WIN_T, DM, it, NIN_PAD / 32, scr, lane); cur = nxt; } }
    if (!(parts & 2)) return;
    for (int row = gw; row < NTOK; row += NGW) {
        const f32x4* xr = (const f32x4*)(row < NPT ? p.x_prompt + (size_t)row * DM : p.x_sample + (size_t)(row - NPT) * DM) + 2 * lane;
        f32x4 v[8]; float ss = 0.f;
#pragma unroll
        for (int j = 0; j < 4; ++j) { v[2 * j] = xr[128 * j]; v[2 * j + 1] = xr[128 * j + 1]; }
#pragma unroll
        for (int j = 0; j < 8; ++j) ss += (v[j][0] * v[j][0] + v[j][1] * v[j][1]) + (v[j][2] * v[j][2] + v[j][3] * v[j][3]);
        ss = wave_sum(ss);
        v4u* o = (v4u*)(p.XB + (size_t)row * DM) + lane;
#pragma unroll
        for (int j = 0; j < 4; ++j) o[64 * j] = pk8(v[2 * j], v[2 * j + 1]);
        if (lane == 0) p.RSTD1[row] = rsqrtf(ss * (1.f / DM) + EPS);
    }
    for (int i = bid * 512 + tid; i < DB * 511 * 64; i += G * 512) { const int c4 = i & 63, r = (i >> 6) % 511, b = (i >> 6) / 511;
        const size_t so = ((size_t)b * 512 + r + 1) * 256 + c4 * 4, dofs = ((size_t)b * 512 + r) * 256 + c4 * 4;
        *(f32x4*)(p.out + OFF_SWK + dofs) = *(const f32x4*)(p.cwk + so); *(f32x4*)(p.out + OFF_SWK + SZ_SWIN + dofs) = *(const f32x4*)(p.cwv + so); }
}
__device__ __forceinline__ void ph_late_weights(const Params& p, LAS unsigned char* lds, int gw, int ngw, int tid, int it0 = 0, int it1 = 1 << 30) {
    const int lane = tid & 63, wave = tid >> 6;
    LAS float* scr = (LAS float*)(lds + wave * 16384);
    constexpr int I_BR = 16 * 64, I_O = 32 * 64, I_UP = 32 * 256, I_DN = 128 * 64, TOTAL = 2 * I_BR + I_O + I_UP + I_DN;
    struct Desc { const float* W; const float* ks; bf16_t* WT; int ldw, K, r, nblk; };
    auto desc = [&](int it) { Desc d; int r = it;
        if (r < I_BR) { d = Desc{p.w_br_a, nullptr, p.WBRA_T, DM, 1024, r, 64}; return d; } r -= I_BR;
        if (r < I_BR) { d = Desc{p.w_br_b, nullptr, p.WBRB_T, DM, 1024, r, 64}; return d; } r -= I_BR;
        if (r < I_O) { d = Desc{p.w_o, nullptr, p.WO_T, DM, DM, r, 64}; return d; } r -= I_O;
        if (r < I_UP) { d = Desc{p.w_up, p.norm2_g, p.WUP_T, DFF, DM, r, 256}; return d; } r -= I_UP;
        d = Desc{p.w_down, nullptr, p.WDN_T, DM, DFF, r, 64}; return d; };
    const int iend = it1 < TOTAL ? it1 : TOTAL;
    if (it0 + gw < iend) { Desc dc = desc(it0 + gw); TrRegs cur = transpose_load(dc.W, dc.ldw, dc.ks, dc.r, dc.nblk, CM_id{}, lane);
        for (int it = it0 + gw; it < iend; it += ngw) { const int nx = it + ngw; Desc dn = dc; TrRegs nxt = cur;
            if (nx < iend) { dn = desc(nx); nxt = transpose_load(dn.W, dn.ldw, dn.ks, dn.r, dn.nblk, CM_id{}, lane); }
            transpose_store(cur, dc.WT, dc.K, dc.r, dc.nblk, scr, lane); cur = nxt; dc = dn; } }
}
__device__ __forceinline__ void ph_final_norm(const Params& p, int bid, int G, int tid, int rbeg = 0) {
    const int lane = tid & 63, wave = tid >> 6, gw = rbeg + bid * 8 + wave, NGW = G * 8;
    const bf16_t* YB = (const bf16_t*)p.X1;
    for (int row = gw; row < NTOK; row += NGW) {
        float* yr = row < NPT ? p.out + OFF_Y + (size_t)row * DM : p.out + OFF_YS + (size_t)(row - NPT) * DM;
        const float r = rsqrtf(p.SUMSQ3[row] * (1.f / DM) + EPS);
        const v4u* s8 = (const v4u*)(YB + (size_t)row * DM) + lane; f32x4* y4 = (f32x4*)yr + 2 * lane; const f32x4* g4 = (const f32x4*)p.norm_f + 2 * lane;
        v4u t[4];
#pragma unroll
        for (int j = 0; j < 4; ++j) t[j] = s8[64 * j];
#pragma unroll
        for (int j = 0; j < 4; ++j) { y4[128 * j] = bf4lo(t[j]) * r * g4[128 * j]; y4[128 * j + 1] = bf4hi(t[j]) * r * g4[128 * j + 1]; }
    }
}

__device__ __forceinline__ unsigned pk2t(float lo, float hi) { return pk2(lo, hi); }
template <bool IS_S>
__device__ __forceinline__ void cmp_gemm_tile(const Params& p, LAS unsigned char* lds, int tile, int tid) {
    const int lane = tid & 63, wave = __builtin_amdgcn_readfirstlane(tid >> 6), wm = wave >> 2, wn = wave & 3, fr = lane & 15, fg = lane >> 4;
    int kv, b, ct = 0, g = 0;
    if (IS_S) { ct = tile % 33; b = (tile / 33) & 7; kv = tile / 264; } else { g = tile & 3; b = (tile >> 2) & 3; kv = tile >> 4; }
    const int c0 = IS_S ? 31 * ct : 0;
    const bf16_t* W = p.W1T + (size_t)kv * 256 * 1024;
    const float* abasef = kv ? p.ccv : p.cck; const bf16_t* abaseb = p.KV6;
    unsigned aof[4];
#pragma unroll
    for (int q = 0; q < 4; ++q) { const int i = q * 32 + (tid >> 4), d4 = (tid & 15) * 4;
        if (IS_S) { const int cl = i >> 2, gg = i & 3, c = c0 + cl; const int page = p.page_table[b * NPAGES + (c >> 3)];
            aof[q] = (unsigned)((((size_t)page * PAGE + (c & 7) * 16) * 4 + gg) * 64 + d4); }
        else aof[q] = (unsigned)(((size_t)(b * SEQ + 16 * i)) * 1536 + kv * 256 + g * 64 + d4); }
    const unsigned bof = (unsigned)((tid >> 3) * 1024 + (tid & 7) * 8);
    f32x4 ra0[4], ra1[4], ra2[4]; v2u rab0[4], rab1[4], rab2[4]; v4u rb0[4];
#define CMP_LOADA(S, r) do { _Pragma("unroll") for (int q = 0; q < 4; ++q) { if (IS_S) ra##S[q] = __builtin_nontemporal_load((const f32x4*)(abasef + aof[q] + (unsigned)(r) * 256u)); else rab##S[q] = *(const v2u*)(abaseb + aof[q] + (unsigned)(r) * 1536u); } } while (0)
#define CMP_LOADB(T, r) do { _Pragma("unroll") for (int q = 0; q < 4; ++q) rb##T[q] = *(const v4u*)(W + bof + (unsigned)(q * 64 * 1024 + (r) * 64)); } while (0)
#define CMP_WRITE(S, T, s) do { LAS unsigned char* ab_ = lds + (s) * 55296; LAS unsigned char* bb_ = ab_ + 18432; \
        _Pragma("unroll") for (int q = 0; q < 4; ++q) { const int i_ = q * 32 + (tid >> 4), d4_ = (tid & 15) * 4; v2u w_; \
            if (IS_S) { w_.x = pk2(ra##S[q][0], ra##S[q][1]); w_.y = pk2(ra##S[q][2], ra##S[q][3]); } else w_ = rab##S[q]; \
            *(LAS v2u*)(ab_ + i_ * 144 + d4_ * 2) = w_; *(LAS v4u*)(bb_ + (q * 64 + (tid >> 3)) * 144 + (tid & 7) * 16) = rb##T[q]; } } while (0)
#define CMP_COMPUTE(s) do { const LAS unsigned char* ab_ = lds + (s) * 55296; const LAS unsigned char* bb_ = ab_ + 18432; \
        _Pragma("unroll") for (int ks = 0; ks < 2; ++ks) { bf16x8_t bfr[4]; \
            _Pragma("unroll") for (int ni = 0; ni < 4; ++ni) bfr[ni] = *(const LAS bf16x8_t*)(bb_ + (64 * wn + 16 * ni + fr) * 144 + (32 * ks + 8 * fg) * 2); \
            _Pragma("unroll") for (int mi = 0; mi < 4; ++mi) { const bf16x8_t af = *(const LAS bf16x8_t*)(ab_ + (64 * wm + 16 * mi + fr) * 144 + (32 * ks + 8 * fg) * 2); \
                _Pragma("unroll") for (int ni = 0; ni < 4; ++ni) acc[mi][ni] = __builtin_amdgcn_mfma_f32_16x16x32_bf16(bfr[ni], af, acc[mi][ni], 0, 0, 0); } } } while (0)
#define CMP_STEP(r, AF, AW, BC, BW) do { if ((r) < 16) { if ((r) + 3 < 16) CMP_LOADA(AF, (r) + 3); if ((r) + 1 < 16) CMP_LOADB(0, (r) + 1); CMP_COMPUTE(BC); if ((r) + 1 < 16) CMP_WRITE(AW, 0, BW); LDS_BARRIER(); } } while (0)
    f32x4 acc[4][4];
#pragma unroll
    for (int mi = 0; mi < 4; ++mi)
#pragma unroll
        for (int ni = 0; ni < 4; ++ni) acc[mi][ni] = (f32x4){0.f, 0.f, 0.f, 0.f};
    CMP_LOADA(0, 0); CMP_LOADB(0, 0); CMP_LOADA(1, 1); CMP_LOADA(2, 2); CMP_WRITE(0, 0, 0); LDS_BARRIER();
#pragma unroll 1
    for (int r = 0; r < 16; r += 6) {
        CMP_STEP(r, 0, 1, 0, 1); CMP_STEP(r + 1, 1, 2, 1, 0); CMP_STEP(r + 2, 2, 0, 0, 1);
        CMP_STEP(r + 3, 0, 1, 1, 0); CMP_STEP(r + 4, 1, 2, 0, 1); CMP_STEP(r + 5, 2, 0, 1, 0);
    }
#undef CMP_LOADA
#undef CMP_LOADB
#undef CMP_STEP
#undef CMP_WRITE
#undef CMP_COMPUTE
    if (!IS_S) {
        float* AB = p.AB_P + (size_t)kv * 2048 * 256;
#pragma unroll
        for (int mi = 0; mi < 4; ++mi) { const int i = 64 * wm + 16 * mi + fr; const size_t R = (size_t)(b * 4 + g) * 128 + i;
#pragma unroll
            for (int ni = 0; ni < 4; ++ni) *(f32x4*)(AB + R * 256 + 64 * wn + 16 * ni + 4 * fg) = acc[mi][ni]; }
    } else {
        LAS float* BH = (LAS float*)lds;
        LAS unsigned char* H = lds + 67584; LAS unsigned char* W2T = lds + 67584 + 34816;
        const float* bias = p.BIAS1 + kv * 128;
        if (wn >= 2) {
#pragma unroll
            for (int mi = 0; mi < 4; ++mi) { const int i = 64 * wm + 16 * mi + fr;
#pragma unroll
                for (int ni = 0; ni < 4; ++ni) *(LAS f32x4*)(BH + i * 132 + 64 * (wn - 2) + 16 * ni + 4 * fg) = acc[mi][ni]; } }
#pragma unroll
        for (int k = 0; k < 2; ++k) { const int idx8 = tid * 8 + 4096 * k, d = idx8 >> 7, j = idx8 & 127; *(LAS v4u*)(W2T + d * 272 + j * 2) = *(const v4u*)(p.W2TG + kv * 8192 + idx8); }
        __syncthreads();
        if (wn < 2) {
#pragma unroll
            for (int mi = 0; mi < 4; ++mi) { const int i = 64 * wm + 16 * mi + fr;
#pragma unroll
                for (int ni = 0; ni < 4; ++ni) { const int j = 64 * wn + 16 * ni + 4 * fg; v2u w; w.x = 0u; w.y = 0u;
                    if (i < 124) { const f32x4 bq = *(const LAS f32x4*)(BH + (i + 4) * 132 + j), bi = *(const f32x4*)(bias + j); const f32x4 hv = acc[mi][ni] + bq + bi;
                        w.x = pk2(gelu_fast(hv[0]), gelu_fast(hv[1])); w.y = pk2(gelu_fast(hv[2]), gelu_fast(hv[3])); }
                    *(LAS v2u*)(H + i * 272 + j * 2) = w; } } }
        __syncthreads();
        f32x4 a2[4];
#pragma unroll
        for (int ni = 0; ni < 4; ++ni) a2[ni] = (f32x4){0.f, 0.f, 0.f, 0.f};
#pragma unroll
        for (int ks = 0; ks < 4; ++ks) { const bf16x8_t hb = *(const LAS bf16x8_t*)(H + (16 * wave + fr) * 272 + (32 * ks + 8 * fg) * 2);
#pragma unroll
            for (int ni = 0; ni < 4; ++ni) { const bf16x8_t wa = *(const LAS bf16x8_t*)(W2T + (16 * ni + fr) * 272 + (32 * ks + 8 * fg) * 2);
                a2[ni] = __builtin_amdgcn_mfma_f32_16x16x32_bf16(wa, hb, a2[ni], 0, 0, 0); } }
        { const int i = 16 * wave + fr, cl = i >> 2, gg = i & 3;
          if (cl < 31 || ct == 32) { bf16_t* dst = (kv ? p.VCMP_S : p.KCMP_S) + ((size_t)(b * 4 + gg) * 1024 + c0 + cl) * 64;
#pragma unroll
              for (int ni = 0; ni < 4; ++ni) { v2u w; w.x = pk2(a2[ni][0], a2[ni][1]); w.y = pk2(a2[ni][2], a2[ni][3]); *(v2u*)(dst + 16 * ni + 4 * fg) = w; } } }
        __syncthreads();
    }
}
template <bool IS_S>
__device__ __forceinline__ void cmp_part2(const Params& p, LAS unsigned char* lds, int kv, int bg, int i0, int tid) {
    constexpr int n_cmp = IS_S ? 1023 : 127, nrs = IS_S ? 1024 : 128;
    const int lane = tid & 63, wave = __builtin_amdgcn_readfirstlane(tid >> 6), fr = lane & 15, fg = lane >> 4;
    const float* AB = (IS_S ? p.AB_S + (size_t)kv * 32768 * 256 : p.AB_P + (size_t)kv * 2048 * 256) + (size_t)bg * nrs * 256;
    LAS unsigned char* H = lds; LAS unsigned char* W2T = lds + 128 * 272;
    const float* w2 = kv ? p.w2v : p.w2k; const float* bias = p.BIAS1 + kv * 128;
    for (int idx = tid; idx < 128 * 32; idx += 512) { const int row = idx >> 5, j4 = (idx & 31) * 4, i = i0 + row; v2u w; w.x = 0u; w.y = 0u;
        if (i < n_cmp) { const f32x4 a = *(const f32x4*)(AB + (size_t)i * 256 + j4), bq = *(const f32x4*)(AB + (size_t)(i + 1) * 256 + 128 + j4), bi = *(const f32x4*)(bias + j4);
            const f32x4 h = a + bq + bi; w.x = pk2(gelu_fast(h[0]), gelu_fast(h[1])); w.y = pk2(gelu_fast(h[2]), gelu_fast(h[3])); }
        *(LAS v2u*)(H + row * 272 + j4 * 2) = w; }
    for (int idx = tid; idx < 8192; idx += 512) { const int j = idx >> 6, d = idx & 63; *(LAS bf16_t*)(W2T + d * 272 + j * 2) = f2bf(w2[idx]); }
    __syncthreads();
    f32x4 acc[4];
#pragma unroll
    for (int ni = 0; ni < 4; ++ni) acc[ni] = (f32x4){0.f, 0.f, 0.f, 0.f};
#pragma unroll
    for (int ks = 0; ks < 4; ++ks) { const bf16x8_t hb = *(const LAS bf16x8_t*)(H + (16 * wave + fr) * 272 + (32 * ks + 8 * fg) * 2);
#pragma unroll
        for (int ni = 0; ni < 4; ++ni) { const bf16x8_t wa = *(const LAS bf16x8_t*)(W2T + (16 * ni + fr) * 272 + (32 * ks + 8 * fg) * 2);
            acc[ni] = __builtin_amdgcn_mfma_f32_16x16x32_bf16(wa, hb, acc[ni], 0, 0, 0); } }
    const int i = i0 + 16 * wave + fr;
    if (i < nrs) {
#pragma unroll
        for (int ni = 0; ni < 4; ++ni) { const int d = 16 * ni + 4 * fg;
            if (IS_S) { v2u w; w.x = pk2(acc[ni][0], acc[ni][1]); w.y = pk2(acc[ni][2], acc[ni][3]); *(v2u*)((kv ? p.VCMP_S : p.KCMP_S) + ((size_t)bg * 1024 + i) * 64 + d) = w; }
            else if (kv == 0) { v2u w; w.x = pk2(acc[ni][0], acc[ni][1]); w.y = pk2(acc[ni][2], acc[ni][3]); *(v2u*)(p.KCMP_P + ((size_t)bg * 128 + i) * 64 + d) = w; }
            else {
#pragma unroll
                for (int r = 0; r < 4; ++r) p.VCMPT_P[((size_t)bg * 64 + d + r) * 128 + i] = f2bf(acc[ni][r]); } } }
    __syncthreads();
}
__device__ __forceinline__ void ph_pro0(const Params& p, LAS unsigned char* lds, int bid, int G, int tid) {
    const int lane = tid & 63, wave = tid >> 6, gw = bid * 8 + wave, NGW = G * 8;
    LAS float* scr = (LAS float*)(lds + wave * 16384);
    for (int it = gw; it < 4 * 64; it += NGW) { const int q = it >> 6, r = it & 63, kv = q >> 1, half = q & 1;
        transpose_item((kv ? p.w1v : p.w1k) + (size_t)half * 1024 * 128, 128, nullptr, p.W1T + ((size_t)kv * 256 + half * 128) * 1024, 1024, r, 4, CM_id{}, scr, lane); }
    for (int i = bid * 512 + tid; i < NTOK; i += G * 512) { p.SUMSQ2[i] = 0.f; p.SUMSQ3[i] = 0.f; }
    for (int idx = bid * 512 + tid; idx < 2 * 8192; idx += G * 512) { const int kv = idx >> 13, r = idx & 8191, j = r & 127, d = r >> 7; p.W2TG[idx] = f2bf((kv ? p.w2v : p.w2k)[j * 64 + d]); }
    __syncthreads();
    for (int it = bid; it < 4; it += G) { const int kv = it >> 1, jh = it & 1, j = jh * 64 + (tid & 63), ks = tid >> 6;
        const float* pe = kv ? p.pe_v : p.pe_k; const float* w1 = kv ? p.w1v : p.w1k; float s = 0.f;
#pragma unroll 1
        for (int k0 = ks * 256; k0 < ks * 256 + 256; k0 += 32) { float pv[32], wv[32];
#pragma unroll
            for (int u = 0; u < 32; ++u) { pv[u] = pe[k0 + u]; wv[u] = w1[(size_t)(k0 + u) * 128 + j]; }
#pragma unroll
            for (int u = 0; u < 32; ++u) s += pv[u] * wv[u]; }
        LAS float* red = (LAS float*)lds; red[tid] = s; __syncthreads();
        if (tid < 64) { float t = 0.f; for (int w = 0; w < 8; ++w) t += red[w * 64 + tid]; p.BIAS1[kv * 128 + j] = t; }
        __syncthreads(); }
}

constexpr int GL_BC = 0, GL_SEG = 32768, GL_QT = 34816, GL_KT = GL_QT + 64 * 272, GL_AM = GL_KT + 64 * 272, GL_VT = GL_AM + 64 * 144, GL_SSQ = GL_VT + 256 * 144, GL_END = GL_SSQ + 2048;
static_assert(GL_END <= 131072, "gla lds");
struct GateRegs { f32x4 lr[8]; float wv[8]; float ba; };
__device__ __forceinline__ GateRegs gla_gates_issue(const Params& p, int row0, int h, int tid) {
    const int lane = tid & 63, wave = tid >> 6, fr = lane & 15, fg = lane >> 4, d = 16 * wave + fr; GateRegs g;
#pragma unroll
    for (int j = 0; j < 8; ++j) { g.wv[j] = 0.f; g.lr[j] = (f32x4){0.f, 0.f, 0.f, 0.f}; }
    if (fg < 2) {
#pragma unroll
        for (int j = 0; j < 8; ++j) g.wv[j] = p.w_a2[(8 * fg + j) * 512 + h * 128 + d];
#pragma unroll
        for (int cb = 0; cb < 4; ++cb) { const f32x4* lr = (const f32x4*)(p.LR + (size_t)(row0 + 16 * cb + fr) * 16 + 8 * fg); g.lr[2 * cb] = lr[0]; g.lr[2 * cb + 1] = lr[1]; } }
    g.ba = p.b_a[h * 128 + d];
    return g;
}
__device__ __forceinline__ void gla_gates(const GateRegs& gr, LAS unsigned char* lds, int tid) {
    LAS float* BC = (LAS float*)(lds + GL_BC);
    const int lane = tid & 63, wave = tid >> 6, fr = lane & 15, fg = lane >> 4, d = 16 * wave + fr;
    const bf16x8_t wb = __builtin_bit_cast(bf16x8_t, pk8((f32x4){gr.wv[0], gr.wv[1], gr.wv[2], gr.wv[3]}, (f32x4){gr.wv[4], gr.wv[5], gr.wv[6], gr.wv[7]}));
    const float ba = gr.ba;
    float run = 0.f;
#pragma unroll
    for (int cb = 0; cb < 4; ++cb) { const bf16x8_t la = __builtin_bit_cast(bf16x8_t, pk8(gr.lr[2 * cb], gr.lr[2 * cb + 1]));
        f32x4 x = __builtin_amdgcn_mfma_f32_16x16x32_bf16(la, wb, (f32x4){0.f, 0.f, 0.f, 0.f}, 0, 0, 0);
        float g4[4];
#pragma unroll
        for (int r = 0; r < 4; ++r) { const float xv = x[r] + ba; g4[r] = (fminf(xv, 0.f) - __logf(1.f + __expf(-fabsf(xv)))) * (1.f / 16.f); }
        g4[1] += g4[0]; g4[2] += g4[1]; g4[3] += g4[2];
        const float t0 = __shfl(g4[3], fr), t1 = __shfl(g4[3], fr + 16), t2 = __shfl(g4[3], fr + 32), t3 = __shfl(g4[3], fr + 48);
        const float off = run + (fg > 0 ? t0 : 0.f) + (fg > 1 ? t1 : 0.f) + (fg > 2 ? t2 : 0.f);
#pragma unroll
        for (int r = 0; r < 4; ++r) BC[(16 * cb + 4 * fg + r) * 128 + d] = off + g4[r];
        run += (t0 + t1) + (t2 + t3); }
    LDS_BARRIER();
}
struct GlaVRegs { v4u v[4]; };
__device__ __forceinline__ GlaVRegs gla_vt_issue(const Params& p, int row0, int h, int tid) {
    const int c = tid & 63, e0 = (tid >> 6) * 32; const bf16_t* src = p.GV + (size_t)(row0 + c) * 1024 + h * 256 + e0; GlaVRegs r;
#pragma unroll
    for (int q = 0; q < 4; ++q) r.v[q] = *(const v4u*)(src + 8 * q);
    return r;
}
__device__ __forceinline__ void gla_vt_commit(const GlaVRegs& r, LAS unsigned char* lds, int tid) {
    LAS bf16_t* VT = (LAS bf16_t*)(lds + GL_VT); const int c = tid & 63, e0 = (tid >> 6) * 32;
#pragma unroll
    for (int q = 0; q < 4; ++q) { const unsigned wv[4] = {r.v[q].x, r.v[q].y, r.v[q].z, r.v[q].w};
#pragma unroll
        for (int i = 0; i < 8; ++i) VT[(e0 + 8 * q + i) * 72 + c] = (bf16_t)((wv[i >> 1] >> ((i & 1) * 16)) & 0xffff); }
}
struct GlaAIn { GateRegs g; GlaVRegs v; v4u k[2]; };
__device__ __forceinline__ GlaAIn gla_a_issue(const Params& p, int item, int tid) {
    const int bh = item >> 5, n = item & 31, b = bh >> 2, h = bh & 3, row0 = b * SEQ + n * 64; GlaAIn in;
    in.g = gla_gates_issue(p, row0, h, tid); in.v = gla_vt_issue(p, row0, h, tid);
    { const int c = tid & 63, d0 = (tid >> 6) * 16;
#pragma unroll
      for (int q = 0; q < 2; ++q) in.k[q] = *(const v4u*)(p.GK + (size_t)(row0 + c) * 512 + h * 128 + d0 + 8 * q); }
    return in;
}
__device__ __forceinline__ void gla_pass_a(const Params& p, LAS unsigned char* lds, int item, int tid, const GlaAIn& in) {
    const int bh = item >> 5, n = item & 31, b = bh >> 2, h = bh & 3, row0 = b * SEQ + n * 64;
    const int lane = tid & 63, wave = __builtin_amdgcn_readfirstlane(tid >> 6), fr = lane & 15, fg = lane >> 4;
    SSTAMP(80);
    const GlaVRegs& vr = in.v; const v4u (&kreg)[2] = in.k;
    gla_gates(in.g, lds, tid); SSTAMP(81);
    { const LAS f32x4* bs = (const LAS f32x4*)(lds + GL_BC); f32x4* bg = (f32x4*)(p.BCG + (size_t)item * 8192);
#pragma unroll
      for (int k = 0; k < 4; ++k) bg[tid + 512 * k] = bs[tid + 512 * k]; }
    const LAS float* BC = (const LAS float*)(lds + GL_BC);
    LAS bf16_t* KST = (LAS bf16_t*)(lds + GL_QT);
    gla_vt_commit(vr, lds, tid);
    { const int c = tid & 63, d0 = (tid >> 6) * 16;
#pragma unroll
      for (int q = 0; q < 2; ++q) { const v4u kk = kreg[q];
          const unsigned wv[4] = {kk.x, kk.y, kk.z, kk.w};
#pragma unroll
          for (int i = 0; i < 8; ++i) { const int d = d0 + 8 * q + i; const float kx = bf2f((bf16_t)((wv[i >> 1] >> ((i & 1) * 16)) & 0xffff));
              KST[d * 72 + c] = f2bf(kx * __expf(BC[63 * 128 + d] - BC[c * 128 + d])); } } }
    if (tid < 128) p.DEC[((size_t)bh * 32 + n) * 128 + tid] = __expf(BC[63 * 128 + tid]);
    LDS_BARRIER(); SSTAMP(82);
    const LAS unsigned char* VTb = lds + GL_VT; const LAS unsigned char* KSb = lds + GL_QT;
    f32x4 acc[8][2];
#pragma unroll
    for (int mb = 0; mb < 8; ++mb) { acc[mb][0] = (f32x4){0.f, 0.f, 0.f, 0.f}; acc[mb][1] = (f32x4){0.f, 0.f, 0.f, 0.f}; }
#pragma unroll
    for (int ks = 0; ks < 2; ++ks) { bf16x8_t vb[2];
#pragma unroll
        for (int nb = 0; nb < 2; ++nb) vb[nb] = *(const LAS bf16x8_t*)(VTb + (32 * wave + 16 * nb + fr) * 144 + (32 * ks + 8 * fg) * 2);
#pragma unroll
        for (int mb = 0; mb < 8; ++mb) { const bf16x8_t ka = *(const LAS bf16x8_t*)(KSb + (16 * mb + fr) * 144 + (32 * ks + 8 * fg) * 2);
            acc[mb][0] = __builtin_amdgcn_mfma_f32_16x16x32_bf16(ka, vb[0], acc[mb][0], 0, 0, 0); acc[mb][1] = __builtin_amdgcn_mfma_f32_16x16x32_bf16(ka, vb[1], acc[mb][1], 0, 0, 0); } }
    SSTAMP(83);
    bf16_t* U = (bf16_t*)p.UT + ((size_t)bh * 32 + n) * 256 * 128;
#pragma unroll
    for (int nb = 0; nb < 2; ++nb) { const int e = 32 * wave + 16 * nb + fr;
#pragma unroll
        for (int mb = 0; mb < 8; ++mb) { v2u w; w.x = pk2(acc[mb][nb][0], acc[mb][nb][1]); w.y = pk2(acc[mb][nb][2], acc[mb][nb][3]); *(v2u*)(U + (size_t)e * 128 + 16 * mb + 4 * fg) = w; } }
    LDS_BARRIER(); SSTAMP(84);
}
__device__ __forceinline__ void gla_pass_b(const Params& p, int bid, int G, int tid) {
    for (int idx = bid * 512 + tid; idx < 16 * 256 * 16; idx += G * 512) { const int d8 = (idx & 15) * 8, e = (idx >> 4) & 255, bh = idx >> 12;
        f32x4 S0 = {0.f, 0.f, 0.f, 0.f}, S1 = {0.f, 0.f, 0.f, 0.f};
        const bf16_t* U = (const bf16_t*)p.UT + (size_t)bh * 32 * 256 * 128 + (size_t)e * 128 + d8; const float* D = p.DEC + (size_t)bh * 32 * 128 + d8;
        bf16_t* SN = p.SNT + (size_t)bh * 32 * 256 * 128 + (size_t)e * 128 + d8;
#pragma unroll 16
        for (int n = 0; n < 32; ++n) { const v4u ub = *(const v4u*)(U + (size_t)n * 256 * 128); const f32x4 d0 = *(const f32x4*)(D + n * 128), d1 = *(const f32x4*)(D + n * 128 + 4);
            *(v4u*)(SN + (size_t)n * 256 * 128) = pk8(S0, S1);
            S0 = d0 * S0 + bf4lo(ub); S1 = d1 * S1 + bf4hi(ub); }
        float* so = p.out + OFF_PGLA + ((size_t)bh * 128 + d8) * 256 + e;
#pragma unroll
        for (int i = 0; i < 4; ++i) { so[(size_t)i * 256] = S0[i]; so[(size_t)(4 + i) * 256] = S1[i]; } }
}
__device__ __forceinline__ void gla_pass_c(const Params& p, LAS unsigned char* lds, int item, int tid) {
    const int bh = item >> 5, n = item & 31, b = bh >> 2, h = bh & 3, row0 = b * SEQ + n * 64;
    const int lane = tid & 63, wave = __builtin_amdgcn_readfirstlane(tid >> 6), fr = lane & 15, fg = lane >> 4;
    bf16x8_t sa[4][2];
    { const bf16_t* SN = p.SNT + ((size_t)bh * 32 + n) * 256 * 128;
#pragma unroll
      for (int ks = 0; ks < 4; ++ks)
#pragma unroll
          for (int eb = 0; eb < 2; ++eb) sa[ks][eb] = *(const bf16x8_t*)(SN + (size_t)(32 * wave + 16 * eb + fr) * 128 + 32 * ks + 8 * fg); }
    const GlaVRegs vr = gla_vt_issue(p, row0, h, tid);
    v4u qreg[2], kreg[2];
    { const int d8 = (tid & 15) * 8;
#pragma unroll
      for (int q = 0; q < 2; ++q) { const int c = (tid >> 4) + 32 * q; qreg[q] = *(const v4u*)(p.GQ + (size_t)(row0 + c) * 512 + h * 128 + d8); kreg[q] = *(const v4u*)(p.GK + (size_t)(row0 + c) * 512 + h * 128 + d8); } }
    { LAS f32x4* bs = (LAS f32x4*)(lds + GL_BC); const f32x4* bg = (const f32x4*)(p.BCG + (size_t)item * 8192);
      f32x4 t4[4];
#pragma unroll
      for (int k = 0; k < 4; ++k) t4[k] = bg[tid + 512 * k];
#pragma unroll
      for (int k = 0; k < 4; ++k) bs[tid + 512 * k] = t4[k]; }
    LDS_BARRIER();
    const LAS float* BC = (const LAS float*)(lds + GL_BC);
    LAS unsigned char* QTb = lds + GL_QT; LAS unsigned char* KTb = lds + GL_KT; LAS unsigned char* AMb = lds + GL_AM; const LAS unsigned char* VTb = lds + GL_VT;
    gla_vt_commit(vr, lds, tid);
    { const int d8 = (tid & 15) * 8;
#pragma unroll
      for (int q = 0; q < 2; ++q) { const int c = (tid >> 4) + 32 * q; const v4u qq = qreg[q], kk = kreg[q];
          const unsigned qv[4] = {qq.x, qq.y, qq.z, qq.w}, kw[4] = {kk.x, kk.y, kk.z, kk.w}; unsigned qo[4], ko[4];
#pragma unroll
          for (int i = 0; i < 4; ++i) { const float b0 = BC[c * 128 + d8 + 2 * i], b1 = BC[c * 128 + d8 + 2 * i + 1]; const float e0 = __expf(b0), e1 = __expf(b1), i0 = __expf(-b0), i1 = __expf(-b1);
              qo[i] = pk2(bf2f((bf16_t)(qv[i] & 0xffff)) * e0, bf2f((bf16_t)(qv[i] >> 16)) * e1);
              ko[i] = pk2(bf2f((bf16_t)(kw[i] & 0xffff)) * i0, bf2f((bf16_t)(kw[i] >> 16)) * i1); }
          *(LAS v4u*)(QTb + c * 272 + d8 * 2) = (v4u){qo[0], qo[1], qo[2], qo[3]}; *(LAS v4u*)(KTb + c * 272 + d8 * 2) = (v4u){ko[0], ko[1], ko[2], ko[3]}; } }
    LDS_BARRIER();
    { const int sb = wave >> 1;
#pragma unroll
      for (int u = 0; u < 2; ++u) { const int cb = 2 * (wave & 1) + u; f32x4 a = {0.f, 0.f, 0.f, 0.f};
          if (sb <= cb) {
#pragma unroll
              for (int ks = 0; ks < 4; ++ks) { const bf16x8_t ka = *(const LAS bf16x8_t*)(KTb + (16 * sb + fr) * 272 + (32 * ks + 8 * fg) * 2); const bf16x8_t qb = *(const LAS bf16x8_t*)(QTb + (16 * cb + fr) * 272 + (32 * ks + 8 * fg) * 2);
                  a = __builtin_amdgcn_mfma_f32_16x16x32_bf16(ka, qb, a, 0, 0, 0); } }
          const int c = 16 * cb + fr, s0 = 16 * sb + 4 * fg;
          v2u w; w.x = pk2(s0 <= c ? a[0] : 0.f, s0 + 1 <= c ? a[1] : 0.f); w.y = pk2(s0 + 2 <= c ? a[2] : 0.f, s0 + 3 <= c ? a[3] : 0.f);
          *(LAS v2u*)(AMb + c * 144 + s0 * 2) = w; } }
    LDS_BARRIER();
    f32x4 acc[2][4];
#pragma unroll
    for (int eb = 0; eb < 2; ++eb)
#pragma unroll
        for (int cb = 0; cb < 4; ++cb) acc[eb][cb] = (f32x4){0.f, 0.f, 0.f, 0.f};
#pragma unroll
    for (int ks = 0; ks < 4; ++ks) { bf16x8_t qb[4];
#pragma unroll
        for (int cb = 0; cb < 4; ++cb) qb[cb] = *(const LAS bf16x8_t*)(QTb + (16 * cb + fr) * 272 + (32 * ks + 8 * fg) * 2);
#pragma unroll
        for (int eb = 0; eb < 2; ++eb)
#pragma unroll
            for (int cb = 0; cb < 4; ++cb) acc[eb][cb] = __builtin_amdgcn_mfma_f32_16x16x32_bf16(sa[ks][eb], qb[cb], acc[eb][cb], 0, 0, 0); }
#pragma unroll
    for (int ks = 0; ks < 2; ++ks) { bf16x8_t va[2], ab[4];
#pragma unroll
        for (int eb = 0; eb < 2; ++eb) va[eb] = *(const LAS bf16x8_t*)(VTb + (32 * wave + 16 * eb + fr) * 144 + (32 * ks + 8 * fg) * 2);
#pragma unroll
        for (int cb = 0; cb < 4; ++cb) ab[cb] = *(const LAS bf16x8_t*)(AMb + (16 * cb + fr) * 144 + (32 * ks + 8 * fg) * 2);
#pragma unroll
        for (int eb = 0; eb < 2; ++eb)
#pragma unroll
            for (int cb = 0; cb < 4; ++cb) acc[eb][cb] = __builtin_amdgcn_mfma_f32_16x16x32_bf16(va[eb], ab[cb], acc[eb][cb], 0, 0, 0); }
    LAS float* SSQ = (LAS float*)(lds + GL_SSQ);
#pragma unroll
    for (int cb = 0; cb < 4; ++cb) { float s = 0.f;
#pragma unroll
        for (int eb = 0; eb < 2; ++eb) s += (acc[eb][cb][0] * acc[eb][cb][0] + acc[eb][cb][1] * acc[eb][cb][1]) + (acc[eb][cb][2] * acc[eb][cb][2] + acc[eb][cb][3] * acc[eb][cb][3]);
        s += __shfl_xor(s, 16); s += __shfl_xor(s, 32);
        if (fg == 0) SSQ[wave * 64 + 16 * cb + fr] = s; }
    LDS_BARRIER();
#pragma unroll
    for (int cb = 0; cb < 4; ++cb) { const int c = 16 * cb + fr; float s = 0.f;
#pragma unroll
        for (int w = 0; w < 8; ++w) s += SSQ[w * 64 + c];
        const float rs = rsqrtf(s * (1.f / 256.f) + EPS);
#pragma unroll
        for (int eb = 0; eb < 2; ++eb) { const int e = 32 * wave + 16 * eb + 4 * fg; const f32x4 gn = *(const f32x4*)(p.gnorm + e);
            const v2u rr = *(const v2u*)(p.GR + (size_t)(row0 + c) * 1024 + h * 256 + e);
            const float o0 = acc[eb][cb][0] * rs * gn[0] * bf2f((bf16_t)(rr.x & 0xffff)), o1 = acc[eb][cb][1] * rs * gn[1] * bf2f((bf16_t)(rr.x >> 16));
            const float o2 = acc[eb][cb][2] * rs * gn[2] * bf2f((bf16_t)(rr.y & 0xffff)), o3 = acc[eb][cb][3] * rs * gn[3] * bf2f((bf16_t)(rr.y >> 16));
            v2u w; w.x = pk2(o0, o1); w.y = pk2(o2, o3); *(v2u*)(p.OB + (size_t)(row0 + c) * 1024 + h * 256 + e) = w; } }
    LDS_BARRIER();
}
__device__ __forceinline__ void gla_sample_item(const Params& p, LAS unsigned char* lds, int item, int tid) {
    const int b = item >> 2, h = item & 3, e = tid & 255, half = tid >> 8, row = NPT + b;
    LAS float* a_s = (LAS float*)lds; LAS float* q_s = a_s + 128; LAS float* k_s = q_s + 128; LAS float* part = k_s + 128; LAS float* red = part + 512;
    if (tid < 128) { float x = p.b_a[h * 128 + tid];
        for (int r = 0; r < 16; ++r) x += p.LR[(size_t)row * 16 + r] * p.w_a2[r * 512 + h * 128 + tid];
        a_s[tid] = __expf(logsigmoidf_(x) * (1.f / 16.f)); q_s[tid] = bf2f(p.GQ[(size_t)row * 512 + h * 128 + tid]); k_s[tid] = bf2f(p.GK[(size_t)row * 512 + h * 128 + tid]); }
    const float v = bf2f(p.GV[(size_t)row * 1024 + h * 256 + e]);
    __syncthreads();
    float po = 0.f; const float* s0 = p.state + (((size_t)b * 4 + h) * 128 + half * 64) * 256 + e; float* so = p.out + OFF_SGLA + (((size_t)b * 4 + h) * 128 + half * 64) * 256 + e;
#pragma unroll 1
    for (int d0 = 0; d0 < 64; d0 += 32) { float sv[32];
#pragma unroll
        for (int dd = 0; dd < 32; ++dd) sv[dd] = s0[(size_t)(d0 + dd) * 256];
#pragma unroll
        for (int dd = 0; dd < 32; ++dd) { const int d = half * 64 + d0 + dd; const float s = a_s[d] * sv[dd] + k_s[d] * v; so[(size_t)(d0 + dd) * 256] = s; po += q_s[d] * s; } }
    part[half * 256 + e] = po;
    __syncthreads();
    float o = 0.f;
    if (tid < 256) { o = part[e] + part[256 + e]; const float ss = wave_sum(o * o); if ((tid & 63) == 0) red[tid >> 6] = ss; }
    __syncthreads();
    if (tid < 256) { const float ss = (red[0] + red[1]) + (red[2] + red[3]); const float r = rsqrtf(ss * (1.f / 256.f) + EPS);
        p.OB[(size_t)row * 1024 + h * 256 + e] = f2bf(o * r * p.gnorm[e] * bf2f(p.GR[(size_t)row * 1024 + h * 256 + e])); }
    __syncthreads();
}

typedef float f32x16 __attribute__((ext_vector_type(16)));
constexpr int NS_STAGE = 17920, NS_KOFF = 0, NS_VOFF = 9216, NS_PCS = 35840, NS_SC = NS_PCS + 32768, NS_OUT = NS_PCS  , NS_SEL = NS_OUT + 256 * 272, NS_END = NS_SEL + 256;
static_assert(NS_END <= 131072, "nsa lds");
constexpr float LOG2E = 1.4426950408889634f, NEGBIG = -1e30f;
__device__ __forceinline__ int crow(int r, int hh) { return (r & 3) + 8 * (r >> 2) + 4 * hh; }

__device__ __forceinline__ void nsa_vt_tile(const Params& p, LAS unsigned char* scr  , int item, int lane) {
    const int tt = item & 31, bg = (item >> 5) & 15, which = item >> 9, b = bg >> 2, g = bg & 3;
    const bf16_t* src = p.KV6 + (size_t)(b * SEQ + tt * 64) * 1536 + (which ? 5 : 3) * 256 + g * 64;
    LAS bf16_t* TT = (LAS bf16_t*)scr;
    const int ch = lane & 7, r0 = lane >> 3;
#pragma unroll
    for (int q = 0; q < 8; ++q) { const v4u v = *(const v4u*)(src + (size_t)lane * 1536 + q * 8); const unsigned wv[4] = {v.x, v.y, v.z, v.w};
#pragma unroll
        for (int i = 0; i < 8; ++i) TT[(q * 8 + i) * 72 + lane] = (bf16_t)((wv[i >> 1] >> ((i & 1) * 16)) & 0xffff); }
    LDS_WAIT(); asm volatile("" ::: "memory");
    bf16_t* dst = (which ? p.VTW : p.VTS) + (size_t)bg * 64 * SEQ + tt * 64;
#pragma unroll
    for (int q = 0; q < 8; ++q) { const int d = r0 + 8 * q; const v4u v = *(const LAS v4u*)((LAS unsigned char*)scr + d * 144 + ch * 16); *(v4u*)(dst + (size_t)d * SEQ + ch * 8) = v; }
    LDS_WAIT(); asm volatile("" ::: "memory");
}

__device__ __forceinline__ float max3f(float a, float b, float c) { float r; asm("v_max3_f32 %0, %1, %2, %3" : "=v"(r) : "v"(a), "v"(b), "v"(c)); return r; }
struct NsaState { float m, l; f32x16 o0, o1; };
template <int MODE  >
__device__ __forceinline__ void nsa_tile(const LAS unsigned char* st, const bf16x8_t (&q)[4], NsaState& s, int lo, int hi, int r32, int hh, LAS float* pcs = nullptr, int kbase = 0) {
    f32x16 s0 = {}, s1 = {};
    const LAS unsigned char* kb = st + NS_KOFF + r32 * 144 + hh * 16;
#pragma unroll
    for (int ks = 0; ks < 4; ++ks) { const bf16x8_t a0 = *(const LAS bf16x8_t*)(kb + ks * 32), a1 = *(const LAS bf16x8_t*)(kb + 32 * 144 + ks * 32);
        s0 = __builtin_amdgcn_mfma_f32_32x32x16_bf16(a0, q[ks], s0, 0, 0, 0); s1 = __builtin_amdgcn_mfma_f32_32x32x16_bf16(a1, q[ks], s1, 0, 0, 0); }
    asm volatile("s_nop 15\n\ts_nop 7" : "+v"(s0), "+v"(s1));
    const bool full = lo <= 0 && hi >= 63, on = hi >= 0;
    const bool nomask = __all(full), laneonly = !nomask && __all(full || !on);
    if (!nomask && !laneonly) {
#pragma unroll
        for (int r = 0; r < 16; ++r) { const int k0 = crow(r, hh), k1 = k0 + 32; s0[r] = (k0 >= lo && k0 <= hi) ? s0[r] : -INFINITY; s1[r] = (k1 >= lo && k1 <= hi) ? s1[r] : -INFINITY; }
    }
    const bool off = laneonly && !on;
    float tmax;
    { float a = max3f(s0[0], s0[1], s1[0]), c = max3f(s0[2], s0[3], s1[1]); a = max3f(a, s1[2], s1[3]);
#pragma unroll
      for (int r = 4; r < 16; r += 4) { a = max3f(a, s0[r], s0[r + 1]); c = max3f(c, s0[r + 2], s0[r + 3]); a = max3f(a, s1[r], s1[r + 1]); c = max3f(c, s1[r + 2], s1[r + 3]); }
      tmax = off ? NEGBIG : max3f(a, c, NEGBIG); }
    if (MODE == 2) {
        const float mL = off ? INFINITY : s.m * LOG2E, inv = s.l;
#pragma unroll
        for (int r = 0; r < 16; ++r) { s0[r] = __builtin_amdgcn_exp2f(s0[r] * LOG2E - mL) * inv; s1[r] = __builtin_amdgcn_exp2f(s1[r] * LOG2E - mL) * inv; }
        if (pcs) {
#pragma unroll
            for (int r = 0; r < 16; ++r) { float v0 = s0[r], v1 = s1[r]; v0 += __shfl_xor(v0, 8); v1 += __shfl_xor(v1, 8); v0 += __shfl_xor(v0, 16); v1 += __shfl_xor(v1, 16);
                pcs[kbase + crow(r, hh)] = v0; pcs[kbase + 32 + crow(r, hh)] = v1; } }
    } else {
        tmax = max3f(tmax, __shfl_xor(tmax, 32), s.m);
        const float mn = tmax, alpha = __builtin_amdgcn_exp2f((s.m - mn) * LOG2E), mL = off ? INFINITY : mn * LOG2E;
        s.m = mn;
        float ps = 0.f;
#pragma unroll
        for (int r = 0; r < 16; ++r) { const float p0 = __builtin_amdgcn_exp2f(s0[r] * LOG2E - mL), p1 = __builtin_amdgcn_exp2f(s1[r] * LOG2E - mL); s0[r] = p0; s1[r] = p1; ps += p0 + p1; }
        s.l = s.l * alpha + ps;
        if (MODE == 1) return;
        if (!__all(alpha == 1.f)) {
#pragma unroll
            for (int r = 0; r < 16; ++r) { s.o0[r] *= alpha; s.o1[r] *= alpha; } }
    }
    const LAS unsigned char* vb = st + NS_VOFF + r32 * 136 + hh * 8;
#pragma unroll
    for (int blk = 0; blk < 2; ++blk)
#pragma unroll
        for (int sp = 0; sp < 2; ++sp) { const f32x16& pp = blk ? s1 : s0; const int rb = 8 * sp;
            v4u pw; pw.x = cvtpk(pp[rb + 0], pp[rb + 1]); pw.y = cvtpk(pp[rb + 2], pp[rb + 3]); pw.z = cvtpk(pp[rb + 4], pp[rb + 5]); pw.w = cvtpk(pp[rb + 6], pp[rb + 7]);
            const bf16x8_t pf = __builtin_bit_cast(bf16x8_t, pw);
            const int ko = (32 * blk + 16 * sp) * 2;
            const v2u a0l = *(const LAS v2u*)(vb + ko), a0h = *(const LAS v2u*)(vb + ko + 16), a1l = *(const LAS v2u*)(vb + 32 * 136 + ko), a1h = *(const LAS v2u*)(vb + 32 * 136 + ko + 16);
            const bf16x8_t v0 = __builtin_bit_cast(bf16x8_t, (v4u){a0l.x, a0l.y, a0h.x, a0h.y}), v1 = __builtin_bit_cast(bf16x8_t, (v4u){a1l.x, a1l.y, a1h.x, a1h.y});
            s.o0 = __builtin_amdgcn_mfma_f32_32x32x16_bf16(v0, pf, s.o0, 0, 0, 0); s.o1 = __builtin_amdgcn_mfma_f32_32x32x16_bf16(v1, pf, s.o1, 0, 0, 0); }
}
template <bool FIRST>
__device__ __forceinline__ void nsa_finish(NsaState& s, float gate, LAS float* outp) {
    const float lt = s.l + __shfl_xor(s.l, 32); const float sc = lt > 0.f ? gate / lt : 0.f;
#pragma unroll
    for (int k = 0; k < 4; ++k) { f32x4 a = {s.o0[4 * k], s.o0[4 * k + 1], s.o0[4 * k + 2], s.o0[4 * k + 3]}, c = {s.o1[4 * k], s.o1[4 * k + 1], s.o1[4 * k + 2], s.o1[4 * k + 3]};
        a = a * sc; c = c * sc;
        if (!FIRST) { a = a + *(const LAS f32x4*)(outp + 8 * k); c = c + *(const LAS f32x4*)(outp + 32 + 8 * k); }
        *(LAS f32x4*)(outp + 8 * k) = a; *(LAS f32x4*)(outp + 32 + 8 * k) = c; }
    s.m = NEGBIG; s.l = 0.f; s.o0 = (f32x16){}; s.o1 = (f32x16){};
}

__device__ __forceinline__ void nsa_prompt_item(const Params& p, LAS unsigned char* lds, int bg, int qi, int tid) {
    const int lane = tid & 63, wave = __builtin_amdgcn_readfirstlane(tid >> 6), r32 = lane & 31, hh = lane >> 5;
    const int b = bg >> 2, g = bg & 3, tl = 8 * wave + (r32 & 7), hd = r32 >> 3, t = 64 * qi + tl, row = b * SEQ + t;
    const int srow = tid >> 3, sch = tid & 7;
    v4u rk, rv;
    auto issue = [&](const bf16_t* kbase, size_t kstride, const bf16_t* vbase, size_t vstride) { rk = *(const v4u*)(kbase + (size_t)srow * kstride + sch * 8); rv = *(const v4u*)(vbase + (size_t)srow * vstride + sch * 8); };
    auto commit = [&](int s) { LAS unsigned char* st = lds + s * NS_STAGE; *(LAS v4u*)(st + NS_KOFF + srow * 144 + sch * 16) = rk;
        *(LAS v2u*)(st + NS_VOFF + srow * 136 + sch * 16) = (v2u){rv.x, rv.y}; *(LAS v2u*)(st + NS_VOFF + srow * 136 + sch * 16 + 8) = (v2u){rv.z, rv.w}; };
    bf16x8_t q[4];
    { const bf16_t* qp = p.QN + (size_t)row * 1024 + (g * 4 + hd) * 64 + 8 * hh;
#pragma unroll
      for (int ks = 0; ks < 4; ++ks) q[ks] = *(const bf16x8_t*)(qp + 16 * ks); }
    const float g0 = p.GATE[(size_t)row * 48 + (g * 4 + hd) * 3 + 0], g1 = p.GATE[(size_t)row * 48 + (g * 4 + hd) * 3 + 1], g2 = p.GATE[(size_t)row * 48 + (g * 4 + hd) * 3 + 2];
    LAS float* outp = (LAS float*)(lds + NS_OUT) + (wave * 32 + r32) * 68 + 4 * hh;
    NsaState s; s.m = NEGBIG; s.l = 0.f; s.o0 = (f32x16){}; s.o1 = (f32x16){};
    const bf16_t* kc = p.KCMP_P + (size_t)bg * 128 * 64; const bf16_t* vct = p.VCMPT_P + (size_t)bg * 64 * 128;
    issue(kc, 64, vct, 128); commit(0); issue(kc + 64 * 64, 64, vct + 64, 128); commit(1);
    __syncthreads();
    const int limc = (t >= 31) ? ((t - 31) >> 4) : -1;
    {
        nsa_tile<1>(lds, q, s, 0, limc, r32, hh); if (qi >= 16) nsa_tile<1>(lds + NS_STAGE, q, s, 0, limc - 64, r32, hh);
        const float lt = s.l + __shfl_xor(s.l, 32); s.l = lt > 0.f ? 1.f / lt : 0.f;
        LAS float* PCS = (hd == 0) ? (LAS float*)(lds + NS_PCS) + tl * 128 : (LAS float*)(lds + NS_SC);
        nsa_tile<2>(lds, q, s, 0, limc, r32, hh, qi >= 16 ? PCS : nullptr, 0); if (qi >= 16) nsa_tile<2>(lds + NS_STAGE, q, s, 0, limc - 64, r32, hh, PCS, 64);
        __syncthreads();
    }
    if (qi >= 16) {
        const LAS float* PCS = (const LAS float*)(lds + NS_PCS);
        LAS float* SCR = (LAS float*)(lds + NS_SC); LAS unsigned* SEL = (LAS unsigned*)(lds + NS_SEL);
        { const int tk = tid >> 3, jq = tid & 7;
#pragma unroll
          for (int u = 0; u < 4; ++u) { const int j = jq * 4 + u; float sm = 0.f;
#pragma unroll
              for (int o = 0; o < 5; ++o) { const int ki = 4 * j - 1 + o; if (ki >= 0 && ki < 127) sm += PCS[tk * 128 + ki]; }
              SCR[tk * 32 + j] = (j <= qi) ? sm + ((j == 0 || j == qi) ? 1e4f : 0.f) : NEGBIG; }
        }
        __syncthreads();
        { const int tk = tid >> 3, jq = tid & 7; unsigned bits = 0u;
#pragma unroll
          for (int u = 0; u < 4; ++u) { const int j = jq * 4 + u; const float sj = SCR[tk * 32 + j]; int rank = 0;
              for (int j2 = 0; j2 < 32; ++j2) { const float s2 = SCR[tk * 32 + j2]; rank += (s2 > sj || (s2 == sj && j2 < j)) ? 1 : 0; }
              if (rank < 16) bits |= 1u << j; }
          bits |= __shfl_xor(bits, 1); bits |= __shfl_xor(bits, 2); bits |= __shfl_xor(bits, 4);
          if (jq == 0) SEL[tk] = bits; }
        __syncthreads();
    }
    s.l = 0.5f; nsa_finish<true>(s, g0, outp);
    const unsigned selmask = (qi < 16) ? 0xffffffffu : ((LAS unsigned*)(lds + NS_SEL))[tl];
    const int wlo = qi > 8 ? qi - 8 : 0, nslc = qi + 1, nsteps = nslc + (qi - wlo + 1);
    const bf16_t* ksl = p.KV6 + (size_t)(b * SEQ) * 1536 + 2 * 256 + g * 64; const bf16_t* kwn = ksl + 2 * 256;
    const bf16_t* vsl = p.VTS + (size_t)bg * 64 * SEQ; const bf16_t* vwn = p.VTW + (size_t)bg * 64 * SEQ;
    v4u rkB, rvB;
#define NSA_ISSUE(RK, RV, u) do { const int u_ = (u); const bf16_t* kb_; const bf16_t* vb_; \
        if (u_ < nslc) { kb_ = ksl + (size_t)(64 * u_) * 1536; vb_ = vsl + 64 * u_; } else { const int j_ = wlo + (u_ - nslc); kb_ = kwn + (size_t)(64 * j_) * 1536; vb_ = vwn + 64 * j_; } \
        RK = *(const v4u*)(kb_ + (size_t)srow * 1536 + sch * 8); RV = *(const v4u*)(vb_ + (size_t)srow * SEQ + sch * 8); } while (0)
#define NSA_COMMIT(RK, RV, s_) do { LAS unsigned char* st_ = lds + (s_) * NS_STAGE; *(LAS v4u*)(st_ + NS_KOFF + srow * 144 + sch * 16) = RK; \
        *(LAS v2u*)(st_ + NS_VOFF + srow * 136 + sch * 16) = (v2u){RV.x, RV.y}; *(LAS v2u*)(st_ + NS_VOFF + srow * 136 + sch * 16 + 8) = (v2u){RV.z, RV.w}; } while (0)
#define NSA_STEP(u) do { const int u__ = (u); int lo = 0, hi = 63; \
        if (u__ < nslc) { if (!((selmask >> u__) & 1u)) hi = -1; else if (u__ == qi) hi = tl; } \
        else { const int j_ = wlo + (u__ - nslc); if (j_ == qi) hi = tl; if (j_ == qi - 8) lo = tl; } \
        if (u__ == nslc) nsa_finish<false>(s, g1, outp); \
        nsa_tile<0>(lds + (u__ & 1) * NS_STAGE, q, s, lo, hi, r32, hh); } while (0)
    NSA_ISSUE(rk, rv, 0); NSA_COMMIT(rk, rv, 0);
    if (nsteps > 1) NSA_ISSUE(rk, rv, 1);
    __syncthreads();
    for (int u = 0; u < nsteps; u += 2) {
        if (u + 2 < nsteps) NSA_ISSUE(rkB, rvB, u + 2);
        NSA_STEP(u);
        if (u + 1 < nsteps) NSA_COMMIT(rk, rv, 1);
        LDS_BARRIER();
        if (u + 1 < nsteps) {
            if (u + 3 < nsteps) NSA_ISSUE(rk, rv, u + 3);
            NSA_STEP(u + 1);
            if (u + 2 < nsteps) NSA_COMMIT(rkB, rvB, 0);
            LDS_BARRIER();
        }
    }
#undef NSA_ISSUE
#undef NSA_COMMIT
#undef NSA_STEP
    { const float lt = s.l + __shfl_xor(s.l, 32); const float sc = lt > 0.f ? g2 / lt : 0.f;
      bf16_t* op = p.OA + (size_t)row * 1024 + (g * 4 + hd) * 64 + 4 * hh;
#pragma unroll
      for (int k = 0; k < 4; ++k) { const f32x4 a = *(const LAS f32x4*)(outp + 8 * k), c = *(const LAS f32x4*)(outp + 32 + 8 * k);
          v2u w; w.x = cvtpk(a[0] + s.o0[4 * k] * sc, a[1] + s.o0[4 * k + 1] * sc); w.y = cvtpk(a[2] + s.o0[4 * k + 2] * sc, a[3] + s.o0[4 * k + 3] * sc); *(v2u*)(op + 8 * k) = w;
          v2u w1; w1.x = cvtpk(c[0] + s.o1[4 * k] * sc, c[1] + s.o1[4 * k + 1] * sc); w1.y = cvtpk(c[2] + s.o1[4 * k + 2] * sc, c[3] + s.o1[4 * k + 3] * sc); *(v2u*)(op + 32 + 8 * k) = w1; } }
}

constexpr int SS_Q = 0, SS_SC = 256, SS_PART = SS_SC + 4 * 1088, SS_REDM = SS_PART + 2048, SS_REDS = SS_REDM + 8, SS_GATE = SS_REDS + 8, SS_SCORE = SS_GATE + 16, SS_SEL = SS_SCORE + 272, SS_SELO = SS_SEL + 16, SS_OACC = SS_SELO + 16, SS_END = SS_OACC + 256;
__device__ __forceinline__ f32x4 ld4_bf(const bf16_t* ptr) { const v2u w = *(const v2u*)ptr; return (f32x4){bf2f((bf16_t)(w.x & 0xffff)), bf2f((bf16_t)(w.x >> 16)), bf2f((bf16_t)(w.y & 0xffff)), bf2f((bf16_t)(w.y >> 16))}; }
template <int N> __device__ __forceinline__ float dpp_ror(float v) { return __builtin_bit_cast(float, __builtin_amdgcn_update_dpp(0, __builtin_bit_cast(int, v), 0x120 + N, 0xf, 0xf, false)); }
__device__ __forceinline__ float row16_sum(float t) { t += dpp_ror<8>(t); t += dpp_ror<4>(t); t += dpp_ror<2>(t); t += dpp_ror<1>(t); return t; }
template <class KF, class VF>
__device__ __forceinline__ void nsa_s_branch(LAS float* L, int nk, KF keyf, VF valf, int gsel, int tid) {
    const int lane = tid & 63, wave = tid >> 6, d4 = (lane & 15) * 4, ksub = lane >> 4;
    LAS float* q = L + SS_Q; LAS float* sc = L + SS_SC; LAS float* part = L + SS_PART; LAS float* redm = L + SS_REDM; LAS float* reds = L + SS_REDS;
    f32x4 qv[4];
#pragma unroll
    for (int hd = 0; hd < 4; ++hd) qv[hd] = *(const LAS f32x4*)(q + hd * 64 + d4);
    for (int base = wave * 4; base < nk; base += 256) {
        f32x4 kx[8]; bool vld[8];
#pragma unroll
        for (int u = 0; u < 8; ++u) { int kk = base + 32 * u + ksub; kk = kk < nk ? kk : nk - 1; kx[u] = keyf(kk, d4, vld[u]); }
#pragma unroll
        for (int u = 0; u < 8; ++u) { const int kk = base + 32 * u + ksub; float pd[4];
#pragma unroll
            for (int hd = 0; hd < 4; ++hd) pd[hd] = row16_sum((qv[hd][0] * kx[u][0] + qv[hd][1] * kx[u][1]) + (qv[hd][2] * kx[u][2] + qv[hd][3] * kx[u][3]));
            if (kk < nk && (lane & 15) == 0) {
#pragma unroll
                for (int hd = 0; hd < 4; ++hd) sc[hd * 1088 + kk] = vld[u] ? pd[hd] : -INFINITY; } } }
    __syncthreads();
    { const int hd = wave & 3, half = wave >> 2; LAS float* sh = sc + hd * 1088;
      float m = -INFINITY; for (int kk = half * 64 + lane; kk < nk; kk += 128) m = fmaxf(m, sh[kk]);
      m = wave_max(m); if (lane == 0) redm[wave] = m;
      __syncthreads();
      m = fmaxf(redm[hd], redm[hd + 4]); float sm = 0.f;
      for (int kk = half * 64 + lane; kk < nk; kk += 128) { const float x = sh[kk]; const float e = (x == -INFINITY) ? 0.f : __expf(x - m); sh[kk] = e; sm += e; }
      sm = wave_sum(sm); if (lane == 0) reds[wave] = sm;
      __syncthreads();
      const float tot = reds[hd] + reds[hd + 4]; const float inv = tot > 0.f ? 1.f / tot : 0.f;
      for (int kk = half * 64 + lane; kk < nk; kk += 128) sh[kk] *= inv; }
    __syncthreads();
    { f32x4 o[4];
#pragma unroll
      for (int hd = 0; hd < 4; ++hd) o[hd] = (f32x4){0.f, 0.f, 0.f, 0.f};
      for (int base = wave * 4; base < nk; base += 256) { f32x4 vv[8];
#pragma unroll
          for (int u = 0; u < 8; ++u) { int kk = base + 32 * u + ksub; kk = kk < nk ? kk : nk - 1; vv[u] = valf(kk, d4); }
#pragma unroll
          for (int u = 0; u < 8; ++u) { const int kk = base + 32 * u + ksub; const bool inr = kk < nk; const int kc2 = inr ? kk : nk - 1;
#pragma unroll
              for (int hd = 0; hd < 4; ++hd) { const float pr = inr ? sc[hd * 1088 + kc2] : 0.f; o[hd] = o[hd] + vv[u] * pr; } } }
#pragma unroll
      for (int hd = 0; hd < 4; ++hd)
#pragma unroll
          for (int e = 0; e < 4; ++e) { float t = o[hd][e]; t += __shfl_xor(t, 16); t += __shfl_xor(t, 32); o[hd][e] = t; }
      if (ksub == 0) {
#pragma unroll
          for (int hd = 0; hd < 4; ++hd) *(LAS f32x4*)(part + (wave * 4 + hd) * 64 + d4) = o[hd]; } }
    __syncthreads();
    if (tid < 256) { float o = 0.f;
#pragma unroll
        for (int w = 0; w < 8; ++w) o += part[w * 256 + tid];
        L[SS_OACC + tid] += L[SS_GATE + (tid >> 6) * 3 + gsel] * o; }
    __syncthreads();
}
__device__ __forceinline__ void nsa_sample_item(const Params& p, LAS unsigned char* lds, int item, int tid) {
    const int b = item >> 2, g = item & 3, bg = item, row = NPT + b;
    constexpr int pos = PAST, n_cmp = 1023, n_slc = 257;
    LAS float* L = (LAS float*)lds; LAS float* sc = L + SS_SC; LAS float* score = L + SS_SCORE; LAS int* selidx = (LAS int*)(L + SS_SEL); LAS unsigned* selofs = (LAS unsigned*)(L + SS_SELO);
    if (tid < 256) { L[SS_Q + tid] = bf2f(p.QN[(size_t)row * 1024 + g * 256 + tid]); L[SS_OACC + tid] = 0.f; }
    if (tid < 12) L[SS_GATE + tid] = p.GATE[(size_t)row * 48 + g * 12 + tid];
    __syncthreads();
    SSTAMP(40);
    const bf16_t* kc = p.KCMP_S + (size_t)bg * 1024 * 64; const bf16_t* vc = p.VCMP_S + (size_t)bg * 1024 * 64;
    nsa_s_branch(L, n_cmp, [&](int kk, int d4, bool& valid) { valid = true; return ld4_bf(kc + (size_t)kk * 64 + d4); }, [&](int kk, int d4) { return ld4_bf(vc + (size_t)kk * 64 + d4); }, 0, tid);
    SSTAMP(41);
    for (int j = tid; j < n_slc; j += 512) { float s = 0.f;
        for (int i = 4 * j - 1; i <= 4 * j + 3; ++i) if (i >= 0 && i < n_cmp) s += (sc[i] + sc[1088 + i]) + (sc[2 * 1088 + i] + sc[3 * 1088 + i]);
        score[j] = s + ((j == 0 || j == pos / 64) ? 1e4f : 0.f); }
    __syncthreads();
    { const int j = tid >> 1, half = tid & 1, jb = half ? 129 : 0, je = half ? 257 : 129; const float sj = score[j]; int cnt = 0;
#pragma unroll 8
      for (int j2 = jb; j2 < je; ++j2) { const float s2 = score[j2]; cnt += (s2 > sj || (s2 == sj && j2 < j)) ? 1 : 0; }
      cnt += __shfl_xor(cnt, 1);
      if (half == 0 && cnt < 16) { selidx[cnt] = j; selofs[cnt] = (unsigned)((((size_t)p.page_table[b * NPAGES + (j >> 1)] * PAGE + (j & 1) * 64) * 4 + g) * 64); }
      if (tid == 0) { selidx[1] = 256; selofs[1] = 0xffffffffu; } }
    __syncthreads();
    SSTAMP(42);
    const bf16_t* newrow = p.KV6 + (size_t)row * 1536 + g * 64;
    nsa_s_branch(L, 1024,
        [&](int kk, int d4, bool& valid) { const unsigned so = selofs[kk >> 6]; const int r = kk & 63;
            if (so != 0xffffffffu) { valid = true; return *(const f32x4*)(p.csk + so + (size_t)r * 256 + d4); } valid = (r == 0); return ld4_bf(newrow + 2 * 256 + d4); },
        [&](int kk, int d4) { const unsigned so = selofs[kk >> 6]; const int r = kk & 63;
            if (so != 0xffffffffu) return *(const f32x4*)(p.csv + so + (size_t)r * 256 + d4); return ld4_bf(newrow + 3 * 256 + d4); }, 1, tid);
    SSTAMP(43);
    nsa_s_branch(L, 513,
        [&](int kk, int d4, bool& valid) { valid = true; if (kk < 512) return *(const f32x4*)(p.cwk + (((size_t)b * 512 + kk) * 4 + g) * 64 + d4); return ld4_bf(newrow + 4 * 256 + d4); },
        [&](int kk, int d4) { if (kk < 512) return *(const f32x4*)(p.cwv + (((size_t)b * 512 + kk) * 4 + g) * 64 + d4); return ld4_bf(newrow + 5 * 256 + d4); }, 2, tid);
    SSTAMP(44);
    if (tid < 256) p.OA[(size_t)row * 1024 + g * 256 + tid] = f2bf(L[SS_OACC + tid]);
    __syncthreads();
}

#define XB_TMO      128
#define XB_XCNT(j)  (256  + 64 * (j))
#define XB_XSUB(j)  (1280 + 64 * (j))
#define XB_XGEN(j)  (2304 + 64 * (j))
#define XB_TOP      3328
#define XB_TOPGEN   3392
#define XCD_BAR_WORDS 3456
#define XB_SPIN_CAP (1u << 22)

__device__ __forceinline__ unsigned xb_ld(unsigned* p)              { return __hip_atomic_load(p, __ATOMIC_RELAXED, __HIP_MEMORY_SCOPE_AGENT); }
__device__ __forceinline__ unsigned xb_add(unsigned* p, unsigned v) { return __hip_atomic_fetch_add(p, v, __ATOMIC_RELAXED, __HIP_MEMORY_SCOPE_AGENT); }
__device__ __forceinline__ unsigned xb_xcc_id() { return (unsigned)__builtin_amdgcn_s_getreg((3 << 11) | 20) & 0xFu; }
#define XB_SPIN(cond, bar) do { unsigned _sp = 0; while (cond) { __builtin_amdgcn_s_sleep(1); \
    if ((++_sp & 255u) == 0u) { if (xb_ld(&(bar)[XB_TMO])) break; if (_sp > XB_SPIN_CAP) { atomicAdd(&(bar)[XB_TMO], 1u); break; } } } } while (0)

struct XcdBarrier {
    unsigned* bar; unsigned x;
    volatile LAS unsigned* st;
};

__device__ __forceinline__ XcdBarrier xcd_barrier_post(unsigned* bar, volatile LAS unsigned* st) {
    XcdBarrier b; b.bar = bar; b.x = xb_xcc_id(); b.st = st;
    if (threadIdx.x == 0) (void)xb_add(&bar[XB_XCNT(b.x)], 1u);
    return b;
}
__device__ __forceinline__ void xcd_barrier_complete(unsigned* bar, unsigned x, unsigned& nloc, unsigned& nx) {
    const unsigned G = gridDim.x * gridDim.y * gridDim.z;
    unsigned sum, cnt, mine, sp = 0u;
    for (;;) {
        sum = 0u; cnt = 0u; mine = 0u;
#pragma unroll
        for (unsigned j = 0; j < 16; ++j) { const unsigned c = xb_ld(&bar[XB_XCNT(j)]); sum += c; cnt += (c > 0u) ? 1u : 0u; mine = (j == x) ? c : mine; }
        if (sum == G) break;
        __builtin_amdgcn_s_sleep(1);
        if ((++sp & 255u) == 0u) { if (xb_ld(&bar[XB_TMO])) break; if (sp > XB_SPIN_CAP) { atomicAdd(&bar[XB_TMO], 1u); break; } }
    }
    nloc = mine > 0u ? mine : 1u; nx = cnt > 0u ? cnt : 1u;
}

__device__ __forceinline__ void xcd_barrier(const XcdBarrier& b) {
    asm volatile("s_waitcnt vmcnt(0)" ::: "memory");
    __syncthreads();
    if (threadIdx.x == 0) {
        unsigned* bar = b.bar;
        __builtin_amdgcn_s_waitcnt(0);
        unsigned nloc = b.st[0], nx = b.st[1];
        if (nloc == 0u) { xcd_barrier_complete(bar, b.x, nloc, nx); b.st[0] = nloc; b.st[1] = nx; }
        const unsigned old = xb_add(&bar[XB_XSUB(b.x)], 1u);
        const unsigned gen = old / nloc;
        if (old + 1u == (gen + 1u) * nloc) {
            __builtin_amdgcn_fence(__ATOMIC_RELEASE, "agent");
            asm volatile("s_waitcnt vmcnt(0)" ::: "memory");
            const unsigned og = xb_add(&bar[XB_TOP], 1u);
            const unsigned tg = og / nx;
            if (og + 1u == (tg + 1u) * nx) xb_add(&bar[XB_TOPGEN], 1u);
            else XB_SPIN(xb_ld(&bar[XB_TOPGEN]) == tg, bar);
            __builtin_amdgcn_fence(__ATOMIC_ACQUIRE, "agent");
            xb_add(&bar[XB_XGEN(b.x)], 1u);
            asm volatile("s_waitcnt vmcnt(0)" ::: "memory");
        } else {
            XB_SPIN(xb_ld(&bar[XB_XGEN(b.x)]) == gen, bar);
            __builtin_amdgcn_fence(__ATOMIC_ACQUIRE, "agent");
            asm volatile("s_waitcnt vmcnt(0)" ::: "memory");
        }
    }
    __syncthreads();
}

constexpr int LDS_BYTES = 147456;
constexpr int LDSCTL_OFF = 131072, MISC_OFF = LDSCTL_OFF + 320;
constexpr int CW_BAR = 4096;
enum Phase { PH_PRO0 = 0, PH_PRO = 1, PH_IN = 2, PH_MID = 3, PH_ATT = 4, PH_BRA = 5, PH_BRB = 6, PH_WO = 7, PH_UP = 8, PH_DOWN = 9, PH_NORM = 10, PH_END = 11 };
__global__ void __launch_bounds__(512, 2) mk_fwd(Params p, int ph_lo, int ph_hi, int li) {
    extern __shared__ __attribute__((aligned(16))) unsigned char lds_raw[];
    LAS unsigned char* lds = (LAS unsigned char*)lds_raw;
    const int tid = threadIdx.x, bid = blockIdx.x, G = gridDim.x;
    for (int u = tid; u < (LDS_BYTES - LDSCTL_OFF) / 4; u += 512) ((LAS unsigned*)(lds + LDSCTL_OFF))[u] = 0u;
    __syncthreads();
    XcdBarrier bar; bar.bar = p.CTL + CW_BAR + li * XCD_BAR_WORDS; bar.x = 0; bar.st = nullptr;
    if (ph_hi - ph_lo > 1) bar = xcd_barrier_post(p.CTL + CW_BAR + li * XCD_BAR_WORDS, (volatile LAS unsigned*)(lds + MISC_OFF) + 8);
    if (PROBE_PHASE >= 0 && bid == 0 && tid == 0) ((LAS unsigned long long*)(lds + LDSCTL_OFF + 512))[0] = __builtin_amdgcn_s_memrealtime();
#define IN(k) (ph_lo <= (k) && (k) < ph_hi)
#define STAMP(i) do { if (PROBE_A >= 0 && bid == PROBE_BID && tid == 0) { ((unsigned long long*)(p.CTL + 2048))[i] = __builtin_amdgcn_s_memrealtime(); } } while (0)
#define SEAM(k) do { if (ph_lo <= (k) && (k) + 1 < ph_hi) xcd_barrier(bar); if (PROBE_PHASE >= 0 && bid == 0 && tid == 0) ((LAS unsigned long long*)(lds + LDSCTL_OFF + 512))[(k) + 1] = __builtin_amdgcn_s_memrealtime(); } while (0)
#define REP(k) _Pragma("unroll 1") for (int rep_ = 0; rep_ < 1 + ((REP_MASK >> (k)) & 1); ++rep_)
    if (IN(PH_PRO)) { if (PROBE_PHASE >= 0 && bid == 0 && tid == 0) ((LAS unsigned long long*)(lds + LDSCTL_OFF + 512))[PH_PRO] = __builtin_amdgcn_s_memrealtime();
      REP(PH_PRO) {
        STAMP(10); ph_pro0(p, lds, bid, G, tid);
        VM_WAIT(); __syncthreads(); STAMP(11);
        if (tid == 0) { __builtin_amdgcn_fence(__ATOMIC_RELEASE, "agent"); VM_WAIT(); __hip_atomic_fetch_add(p.CTL + 1088, 1u, __ATOMIC_RELAXED, __HIP_MEMORY_SCOPE_AGENT); }
        if (G > 32) { if (bid < G - 16) ph_prologue(p, lds, bid, G - 16, tid, 2); } else ph_prologue(p, lds, bid, G, tid, 2);
        __syncthreads(); STAMP(12);
        if (tid == 0) { unsigned sp = 0; while (__hip_atomic_load(p.CTL + 1088, __ATOMIC_RELAXED, __HIP_MEMORY_SCOPE_AGENT) < (unsigned)G * (1 + rep_)) { __builtin_amdgcn_s_sleep(2); if (++sp > (1u << 22)) break; }
            __builtin_amdgcn_fence(__ATOMIC_ACQUIRE, "agent"); VM_WAIT(); }
        __syncthreads(); STAMP(13);
        { const int lim = (G > 32) ? 512 : 528, extra = (G > 32 && bid >= G - 16) ? 512 + (bid - (G - 16)) : -1;
          int t = bid; bool fin = false;
#pragma unroll 1
          while (!fin) { int tt = t; if (t >= lim) { if (extra < 0) break; tt = extra; fin = true; } cmp_gemm_tile<true>(p, lds, tt, tid); t += G; } }
        __syncthreads(); STAMP(14); if (G > 32) { if (bid >= 4 && bid < G - 16) ph_prologue(p, lds, bid - 4, G - 20, tid, 1); } else ph_prologue(p, lds, bid, G, tid, 1);
        if (G > 32 && bid < G - 16) ph_late_weights(p, lds, bid * 8 + (tid >> 6), (G - 16) * 8, tid, 0, LATE_PRO);
        __syncthreads(); STAMP(15); } SEAM(PH_PRO); STAMP(16); }
    if (IN(PH_IN)) { REP(PH_IN) {
        STAMP(30); skinny_gemm(lds, p.XB + (size_t)NPT * DM, DM, p.WIN_T, NIN_PAD, DM, F_proj_s{p}, bid, G, tid);
        VM_WAIT(); __syncthreads();
        if (tid == 0) { __builtin_amdgcn_fence(__ATOMIC_RELEASE, "agent"); VM_WAIT(); __hip_atomic_fetch_add(p.CTL + 1024, 1u, __ATOMIC_RELAXED, __HIP_MEMORY_SCOPE_AGENT); }
        { pg8::Gemm g{p.XB, p.WIN_T, NPT, NIN_PAD, DM}; pg8::StaticOrder S; S.init(NPT, NIN_PAD, G, bid);
          EpiProj E{p.RSTD1, p.b_gate, p.QN, p.KV6, p.GQ, p.GK, p.GV, p.GR, p.BR, p.GATE, p.LR, p.out};
          pg8::gemm_phase<EpiProj, pg8::StaticOrder, true, true>(lds, g, S, E); } STAMP(31);
        for (int it = G - 1 - bid; it < 32; it += G) {
            if (tid == 0) { unsigned sp = 0; while (__hip_atomic_load(p.CTL + 1024, __ATOMIC_RELAXED, __HIP_MEMORY_SCOPE_AGENT) < (unsigned)G * (1 + rep_)) { __builtin_amdgcn_s_sleep(2); if (++sp > (1u << 22)) break; }
                __builtin_amdgcn_fence(__ATOMIC_ACQUIRE, "agent"); VM_WAIT(); }
            __syncthreads();
            nsa_sample_item(p, lds, it, tid); }
        STAMP(32); }
        SEAM(PH_IN); STAMP(33); }
    if (IN(PH_MID)) { REP(PH_MID) { STAMP(20);
        for (int t = bid; t < 32; t += G) { cmp_gemm_tile<false>(p, lds, t, tid); __builtin_amdgcn_fence(__ATOMIC_RELEASE, "workgroup"); VM_WAIT(); __syncthreads(); cmp_part2<false>(p, lds, t >> 4, t & 15, 0, tid); }
        STAMP(21);
        const int gsplit = (G * 20) / 32;
        const int lw0 = (G > 32) ? LATE_PRO : 0;
        { int ga0 = bid, gas = G; if (G >= 128) { ga0 = (bid >= 32 && bid < gsplit) ? bid - 32 : 512; gas = gsplit - 32; }
          if (ga0 < 512) { GlaAIn cur = gla_a_issue(p, ga0, tid);
#pragma unroll 1
              for (int it = ga0; it < 512; it += gas) { const GlaAIn nxt = gla_a_issue(p, (it + gas < 512) ? it + gas : it, tid); gla_pass_a(p, lds, it, tid, cur); cur = nxt; } } }
        STAMP(23);
        for (int it = G - 1 - bid; it < 32; it += G) gla_sample_item(p, lds, it, tid); STAMP(24);
        { const int wave = tid >> 6; for (int it = bid * 8 + wave; it < 1024; it += G * 8) nsa_vt_tile(p, lds + wave * 16384, it, tid & 63); } __syncthreads(); STAMP(25);
        if (G >= 128) { int lg = bid * 8 + (tid >> 6), ln = 32 * 8, l0 = lw0, l1 = lw0;
            if (bid >= gsplit) { lg = (bid - gsplit) * 8 + (tid >> 6); ln = (G - gsplit) * 8; l0 = lw0 + 640; l1 = 1 << 30; } else if (bid >= 32) { lg = (bid - 32) * 8 + (tid >> 6); ln = (gsplit - 32) * 8; l0 = lw0; l1 = lw0 + 640; }
            ph_late_weights(p, lds, lg, ln, tid, l0, l1); }
        else ph_late_weights(p, lds, bid * 8 + (tid >> 6), G * 8, tid, lw0);
        __syncthreads(); STAMP(26); }
        SEAM(PH_MID); }
    if (IN(PH_ATT)) { REP(PH_ATT) {
        gla_pass_b(p, bid, G, tid);
        VM_WAIT(); __syncthreads();
        if (tid == 0) { __builtin_amdgcn_fence(__ATOMIC_RELEASE, "agent"); VM_WAIT(); __hip_atomic_fetch_add(p.CTL + 1152, 1u, __ATOMIC_RELAXED, __HIP_MEMORY_SCOPE_AGENT); }
        STAMP(53);
        for (int it = bid; it < 256; it += G) { const int bg = it & 15, sq = it >> 4;
#pragma unroll 1
            for (int k = 0; k < 2; ++k) { STAMP(50 + k); nsa_prompt_item(p, lds, bg, k ? sq : 31 - sq, tid); __syncthreads(); } }
        STAMP(52);
        if (tid == 0) { unsigned sp = 0; while (__hip_atomic_load(p.CTL + 1152, __ATOMIC_RELAXED, __HIP_MEMORY_SCOPE_AGENT) < (unsigned)G * (1 + rep_)) { __builtin_amdgcn_s_sleep(2); if (++sp > (1u << 22)) break; }
            __builtin_amdgcn_fence(__ATOMIC_ACQUIRE, "agent"); VM_WAIT(); }
        __syncthreads();
        { volatile LAS int* slot = (volatile LAS int*)(lds + LDSCTL_OFF + 2048);
          int it = bid; STAMP(30);
#pragma unroll 1
          while (it < 512) { int nxt = 0; if (tid == 0) nxt = G + (int)__hip_atomic_fetch_add(p.CTL + 1344, 1u, __ATOMIC_RELAXED, __HIP_MEMORY_SCOPE_AGENT);
              gla_pass_c(p, lds, it, tid);
              if (tid == 0) *slot = nxt;
              __syncthreads(); it = __builtin_amdgcn_readfirstlane(*slot); }
          STAMP(31); } __syncthreads(); }
        SEAM(PH_ATT); }
    if (IN(PH_BRA)) { if (PROBE_PHASE >= 0 && bid == 0 && tid == 0) ((LAS unsigned long long*)(lds + LDSCTL_OFF + 512))[PH_BRB] = __builtin_amdgcn_s_memrealtime();
      REP(PH_BRA) {
        { const F_bra f{p.BR, (bf16_t*)p.TMP};
          { pg8::Gemm g{p.OA, p.WBRA_T, NPT, DM, 1024}; pg8::StaticOrder S; S.init(NPT, DM, G, bid); EpiGen<F_bra> E{f}; pg8::gemm_phase<EpiGen<F_bra>, pg8::StaticOrder, true, true>(lds, g, S, E); }
          skinny_gemm(lds, p.OA + (size_t)NPT * 1024, 1024, p.WBRA_T, DM, 1024, f, bid, G, tid); }
        { const F_brb f{p.BR, (const bf16_t*)p.TMP, p.MB};
          { pg8::Gemm g{p.OB, p.WBRB_T, NPT, DM, 1024}; pg8::StaticOrder S; S.init(NPT, DM, G, bid); EpiGen<F_brb> E{f}; pg8::gemm_phase<EpiGen<F_brb>, pg8::StaticOrder, true, true>(lds, g, S, E); }
          skinny_gemm(lds, p.OB + (size_t)NPT * 1024, 1024, p.WBRB_T, DM, 1024, f, bid, G, tid); } }
        SEAM(PH_BRB); }
    if (IN(PH_WO)) { STAMP(60);
        { const F_wo f{p.x_prompt, p.X1B, p.SUMSQ2}; pg8::Gemm g{p.MB, p.WO_T, NPT, DM, DM}; pg8::StaticOrder S; S.init(NPT, DM, G, bid); EpiGen<F_wo> E{f}; pg8::gemm_phase<EpiGen<F_wo>, pg8::StaticOrder, true, true>(lds, g, S, E); } STAMP(61);
        if (PROBE_A >= 0 && bid == PROBE_BID && tid == 0) { for (int i = 0; i < 4; ++i) ((unsigned long long*)(p.CTL + 2048))[70 + i] = ((LAS unsigned long long*)(lds + 135168))[i]; }
        { const F_wo f{p.x_sample - (size_t)NPT * DM, p.X1B, p.SUMSQ2}; skinny_gemm(lds, p.MB + (size_t)NPT * DM, DM, p.WO_T, DM, DM, f, bid, G, tid); } STAMP(62); SEAM(PH_WO); STAMP(63); }
    if (IN(PH_UP)) { REP(PH_UP) { const F_up f{p.SUMSQ2, p.HF};
        { pg8::Gemm g{p.X1B, p.WUP_T, NPT, DFF, DM}; pg8::StaticOrder S; S.init(NPT, DFF, G, bid); EpiGen<F_up> E{f}; pg8::gemm_phase<EpiGen<F_up>, pg8::StaticOrder, true, true>(lds, g, S, E); }
        skinny_gemm(lds, p.X1B + (size_t)NPT * DM, DM, p.WUP_T, DFF, DM, f, bid, G, tid); } SEAM(PH_UP); }
    const bool fusedn = (G == 256) && PROBE_A < 0 && PROBE_PHASE < 0;
    if (IN(PH_DOWN)) {
        { const F_down f{p.X1B, (bf16_t*)p.X1, p.SUMSQ3}; skinny_gemm(lds, p.HF + (size_t)NPT * DFF, DFF, p.WDN_T, DM, DFF, f, bid, G, tid); }
        if (fusedn) {
            volatile LAS unsigned* lastf = (volatile LAS unsigned*)(lds + LDSCTL_OFF + 64);
            VM_WAIT(); __syncthreads();
            if (tid == 0) { __builtin_amdgcn_fence(__ATOMIC_RELEASE, "agent"); VM_WAIT(); const unsigned old = __hip_atomic_fetch_add(p.CTL + 1280, 1u, __ATOMIC_RELAXED, __HIP_MEMORY_SCOPE_AGENT);
                const unsigned last = (old == (unsigned)G - 1u) ? 1u : 0u; if (last) { __builtin_amdgcn_fence(__ATOMIC_ACQUIRE, "agent"); VM_WAIT(); } lastf[0] = last; }
            __syncthreads();
            if (lastf[0]) ph_final_norm(p, 0, 1, tid, NPT);
            __syncthreads();
            pg8::Gemm g{p.HF, p.WDN_T, NPT, DM, DFF}; pg8::StaticOrder S; S.init(NPT, DM, G, bid); EpiDownNorm E{p.X1B, p.SUMSQ3, p.out + OFF_Y, p.norm_f, p.CTL + 8192};
            pg8::gemm_phase<EpiDownNorm, pg8::StaticOrder, false, true>(lds, g, S, E);
        } else {
            { const F_down f{p.X1B, (bf16_t*)p.X1, p.SUMSQ3}; pg8::Gemm g{p.HF, p.WDN_T, NPT, DM, DFF}; pg8::StaticOrder S; S.init(NPT, DM, G, bid); EpiGen<F_down> E{f}; pg8::gemm_phase<EpiGen<F_down>, pg8::StaticOrder, true, true>(lds, g, S, E); }
            SEAM(PH_DOWN); } }
    if (IN(PH_NORM) && !fusedn) { ph_final_norm(p, bid, G, tid);
        if (PROBE_A >= 0 && bid == 0) { const unsigned long long* tg = (const unsigned long long*)(p.CTL + 2048); const float X = (float)(tg[PROBE_B] - tg[PROBE_A]) * 1e-7f, f = 1.f + sqrtf(X);
            for (int i = tid; i < 2048; i += 512) p.out[OFF_SCK + i] *= f; }
        if (PROBE_PHASE >= 0 && bid == 0) { __syncthreads(); const LAS unsigned long long* ts = (const LAS unsigned long long*)(lds + LDSCTL_OFF + 512);
            const float X = (float)(ts[PROBE_PHASE + 1] - ts[PROBE_PHASE]) * 1e-7f, f = 1.f + sqrtf(X);
            for (int i = tid; i < 2048; i += 512) p.out[OFF_SCK + i] *= f; } }
#undef IN
#undef SEAM
#undef REP
}
__global__ void __launch_bounds__(256) k_sumsq_rows(const float* X, size_t ld, float* ss_out, int nrows) {
    const int lane = threadIdx.x & 63, row = blockIdx.x * 4 + (threadIdx.x >> 6);
    if (row >= nrows) return;
    float ss = 0.f;
    for (int i = lane; i < DM; i += 64) { const float v = X[(size_t)row * ld + i]; ss += v * v; }
    ss = wave_sum(ss);
    if (lane == 0) ss_out[row] = ss;
}
struct EF_up2 { Params p; __device__ void operator()(int r, int n, float acc) const { const float v = fmaxf(acc * rsqrtf(p.SUMSQ2[r] * (1.f / DM) + EPS), 0.f); p.HF[(size_t)r * DFF + n] = f2bf(v * v); } };

static inline size_t align_up(size_t x) { return (x + 255) & ~(size_t)255; }

extern "C" void kernel_launch(void* const* d_in, const int* in_sizes, int n_in, void* d_out, int out_size, void* d_ws, size_t ws_size, hipStream_t stream) {
    if (n_in != 29 || out_size != (int)OUT_TOTAL) { fprintf(stderr, "kernel_launch: unexpected n_in %d / out_size %d\n", n_in, out_size); return; }
    static int grid = 0;
    if (grid == 0) {
        int dev = 0, cus = 0, per_cu = 0;
        if (hipGetDevice(&dev) != hipSuccess || hipDeviceGetAttribute(&cus, hipDeviceAttributeMultiprocessorCount, dev) != hipSuccess) { fprintf(stderr, "kernel_launch: device query failed\n"); grid = -1; return; }
        if (hipFuncSetAttribute((const void*)mk_fwd, hipFuncAttributeMaxDynamicSharedMemorySize, LDS_BYTES) != hipSuccess) { fprintf(stderr, "kernel_launch: hipFuncSetAttribute failed\n"); grid = -1; return; }
        if (hipOccupancyMaxActiveBlocksPerMultiprocessor(&per_cu, (const void*)mk_fwd, 512, LDS_BYTES) != hipSuccess || per_cu < 1) { fprintf(stderr, "kernel_launch: occupancy query says %d\n", per_cu); per_cu = 1; }
        (void)hipGetLastError();
        grid = cus;
    }
    if (grid < 0) return;
    Params p{};
    p.x_prompt = (const float*)d_in[0]; p.x_sample = (const float*)d_in[1]; p.cck = (const float*)d_in[2]; p.ccv = (const float*)d_in[3];
    p.csk = (const float*)d_in[4]; p.csv = (const float*)d_in[5]; p.cwk = (const float*)d_in[6]; p.cwv = (const float*)d_in[7]; p.state = (const float*)d_in[8];
    p.page_table = (const int*)d_in[9]; p.norm1_g = (const float*)d_in[10]; p.w_in = (const float*)d_in[11]; p.b_gate = (const float*)d_in[12];
    p.pe_k = (const float*)d_in[13]; p.pe_v = (const float*)d_in[14]; p.w1k = (const float*)d_in[15]; p.w2k = (const float*)d_in[16]; p.w1v = (const float*)d_in[17]; p.w2v = (const float*)d_in[18];
    p.w_a2 = (const float*)d_in[19]; p.b_a = (const float*)d_in[20]; p.gnorm = (const float*)d_in[21]; p.w_br_a = (const float*)d_in[22]; p.w_br_b = (const float*)d_in[23];
    p.w_o = (const float*)d_in[24]; p.norm2_g = (const float*)d_in[25]; p.w_up = (const float*)d_in[26]; p.w_down = (const float*)d_in[27]; p.norm_f = (const float*)d_in[28];
    p.out = (float*)d_out;
    char* ws = (char*)d_ws; size_t off = 0;
    auto take = [&](size_t bytes) { char* r = ws + off; off = align_up(off + bytes); return r; };
    p.CTL = (unsigned*)take(1 << 20);
    p.XB = (bf16_t*)take((size_t)NTOK * DM * 2); p.RSTD1 = (float*)take(NTOK * 4); p.QN = (bf16_t*)take((size_t)NTOK * 1024 * 2); p.KV6 = (bf16_t*)take((size_t)NTOK * 1536 * 2);
    p.GATE = (float*)take((size_t)NTOK * 48 * 4); p.GQ = (bf16_t*)take((size_t)NTOK * 512 * 2); p.GK = (bf16_t*)take((size_t)NTOK * 512 * 2); p.GV = (bf16_t*)take((size_t)NTOK * 1024 * 2);
    p.GR = (bf16_t*)take((size_t)NTOK * 1024 * 2); p.LR = (float*)take((size_t)NTOK * 16 * 4); p.BR = (bf16_t*)take((size_t)NTOK * 4096 * 2);
    p.KCMP_P = (bf16_t*)take(16 * 128 * 64 * 2); p.VCMPT_P = (bf16_t*)take(16 * 128 * 64 * 2); p.KCMP_S = (bf16_t*)take(32 * 1024 * 64 * 2); p.VCMP_S = (bf16_t*)take(32 * 1024 * 64 * 2);
    p.OA = (bf16_t*)take((size_t)NTOK * 1024 * 2); p.OB = (bf16_t*)take((size_t)NTOK * 1024 * 2); p.TMP = (float*)take((size_t)NTOK * DM * 4); p.MB = (bf16_t*)take((size_t)NTOK * DM * 2);
    p.X1 = (float*)take((size_t)NTOK * DM * 4); p.X1B = (bf16_t*)take((size_t)NTOK * DM * 2); p.RSTD2 = (float*)take(NTOK * 4); p.HF = (bf16_t*)take((size_t)NTOK * DFF * 2);
    p.WIN_T = (bf16_t*)take((size_t)NIN_PAD * DM * 2); p.WBRA_T = (bf16_t*)take((size_t)DM * 1024 * 2); p.WBRB_T = (bf16_t*)take((size_t)DM * 1024 * 2); p.WO_T = (bf16_t*)take((size_t)DM * DM * 2);
    p.WUP_T = (bf16_t*)take((size_t)DFF * DM * 2); p.WDN_T = (bf16_t*)take((size_t)DM * DFF * 2); p.SUMSQ2 = (float*)take(NTOK * 4); p.SUMSQ3 = (float*)take(NTOK * 4);
    p.W1T = (bf16_t*)take(2 * 256 * 1024 * 2); p.W2TG = (bf16_t*)take(2 * 8192 * 2); p.BIAS1 = (float*)take(256 * 4); p.AB_S = (float*)take((size_t)2 * 32768 * 256 * 4); p.AB_P = (float*)take((size_t)2 * 2048 * 256 * 4);
    p.UT = (float*)take((size_t)512 * 256 * 128 * 2); p.BCG = (float*)take((size_t)512 * 8192 * 4); p.DEC = (float*)take(512 * 128 * 4); p.SNT = (bf16_t*)take((size_t)512 * 256 * 128 * 2);
    p.VTS = (bf16_t*)take((size_t)16 * 64 * SEQ * 2); p.VTW = (bf16_t*)take((size_t)16 * 64 * SEQ * 2);
    if (off > ws_size) { fprintf(stderr, "kernel_launch: workspace too small: need %zu have %zu\n", off, ws_size); return; }
    hipMemsetAsync(p.CTL, 0, 1 << 20, stream);
#define MK(lo, hi, li) hipLaunchKernelGGL(mk_fwd, dim3(grid), dim3(512), LDS_BYTES, stream, p, (int)(lo), (int)(hi), (int)(li))
    MK(PH_PRO0, PH_END, 0);
}
```
